# Optimizing an MI355X kernel written in HIP

```python
import math
import jax, jax.numpy as jnp
from jax import lax
import numpy as np

D_MODEL = 1024
BATCH = 2
SEQ = 8192
DEPTH = 2

EPS = 1e-6
MEM_LEN = 256
CONV_W = 4
N_EVEN = (DEPTH + 1) // 2
N_ODD = DEPTH // 2
RG_WIDTH = D_MODEL
RG_BLOCKS = 8
RG_BW = RG_WIDTH // RG_BLOCKS
RG_C = 8.0
NSA_HEADS = 8
NSA_KV_GROUPS = 2
NSA_REP = NSA_HEADS // NSA_KV_GROUPS
NSA_DK = 128
NSA_DV = NSA_DK
CMP_LEN = 32
CMP_STRIDE = 16
CMP_HID = 256
SLC_LEN = 64
SLC_TOPN = 16
WINDOW = 512
NSA_QBLOCK = 64
FORCE_BONUS = 100.0
EV_IN = 2 * RG_WIDTH + NSA_HEADS * NSA_DK + 6 * NSA_KV_GROUPS * NSA_DK + 3 * NSA_HEADS
EV_MIX = RG_WIDTH + NSA_HEADS * NSA_DV
D_INNER = 2 * D_MODEL
SSM_HEADDIM = 64
SSM_HEADS = D_INNER // SSM_HEADDIM
SSM_GROUPS = 4
SSM_REP = SSM_HEADS // SSM_GROUPS
SSM_STATE = 128
SSD_CHUNK = 128
CONV_CH = D_INNER + 2 * SSM_GROUPS * SSM_STATE
OD_IN = D_INNER + CONV_CH + SSM_HEADS
X_HEADS = 4
X_HEADDIM = 128
X_INNER = X_HEADS * X_HEADDIM
FF_DENSE = 2816
N_EXPERTS = 8
TOP_K = 2
FF_EXPERT = 3584

kernel_name = "hybrid_rglru_nsa_ssd_moe_block"


def rmsnorm(x, g):
    xf = x.astype(jnp.float32)
    y = xf * lax.rsqrt(jnp.mean(xf * xf, axis=-1, keepdims=True) + EPS)
    return (y * g.astype(jnp.float32)).astype(x.dtype)


def masked_softmax(s, mask):
    s = jnp.where(mask, s.astype(jnp.float32), -jnp.inf)
    m = jnp.max(s, axis=-1, keepdims=True)
    m = jnp.where(jnp.isfinite(m), m, 0.0)
    e = jnp.where(mask, jnp.exp(s - m), 0.0)
    return e / jnp.maximum(jnp.sum(e, axis=-1, keepdims=True), 1e-30)


def split_cols(x, sizes):
    return jnp.split(x, np.cumsum(sizes)[:-1].tolist(), axis=-1)


def causal_dwconv(x, w, b):
    k = w.shape[0]
    s = x.shape[1]
    xp = jnp.pad(x, ((0, 0), (k - 1, 0), (0, 0)))
    y = b
    for j in range(k):
        y = y + xp[:, j:j + s] * w[j]
    return y


def rglru(x, wa, ba, wx, bx, lam):
    b_, s_, c_ = x.shape
    xb = x.reshape(b_, s_, RG_BLOCKS, RG_BW)
    r = jax.nn.sigmoid(jnp.einsum("bshi,hij->bshj", xb, wa).reshape(b_, s_, c_) + ba)
    ig = jax.nn.sigmoid(jnp.einsum("bshi,hij->bshj", xb, wx).reshape(b_, s_, c_) + bx)
    log_a = -RG_C * r * jax.nn.softplus(-lam)
    a = jnp.exp(log_a)
    u = jnp.sqrt(-jnp.expm1(2.0 * log_a)) * (ig * x)

    def combine(lhs, rhs):
        a1, b1 = lhs
        a2, b2 = rhs
        return a1 * a2, a2 * b1 + b2

    _, h = lax.associative_scan(combine, (a, u), axis=1)
    return h


def nsa_compress(k, pos, w1, w2):
    b_, s_, g_, d_ = k.shape
    n_cmp = (s_ - CMP_LEN) // CMP_STRIDE + 1
    idx = jnp.arange(n_cmp)[:, None] * CMP_STRIDE + jnp.arange(CMP_LEN)[None, :]
    kb = k[:, idx] + pos[:, None, :]
    kb = kb.transpose(0, 1, 3, 2, 4).reshape(b_, n_cmp, g_, CMP_LEN * d_)
    return jax.nn.gelu(kb @ w1) @ w2


def nsa(q, kc, vc, ks, vs, kw, vw, gates, q_norm, k_norm, cmp_pos, ck_w1, ck_w2, cv_w1, cv_w2):
    b_, s_ = q.shape[:2]
    G, R, DK = NSA_KV_GROUPS, NSA_REP, NSA_DK
    scale = DK ** -0.5
    qr = rmsnorm(q, q_norm).reshape(b_, s_, G, R, DK)
    kcmp = rmsnorm(nsa_compress(kc, cmp_pos, ck_w1, ck_w2), k_norm[0])
    vcmp = nsa_compress(vc, cmp_pos, cv_w1, cv_w2)
    n_cmp = kcmp.shape[1]
    n_slc = s_ // SLC_LEN
    n_sel = min(SLC_TOPN, n_slc)
    ks_blk = rmsnorm(ks, k_norm[1]).reshape(b_, n_slc, SLC_LEN, G, DK).transpose(0, 3, 1, 2, 4)
    vs_blk = vs.reshape(b_, n_slc, SLC_LEN, G, NSA_DV).transpose(0, 3, 1, 2, 4)
    pad = ((0, 0), (WINDOW, 0), (0, 0), (0, 0))
    kw_pad = jnp.pad(rmsnorm(kw, k_norm[2]), pad)
    vw_pad = jnp.pad(vw, pad)
    g = jax.nn.sigmoid(gates).reshape(b_, s_, G, R, 3)
    cmp_start = jnp.arange(n_cmp) * CMP_STRIDE
    cmp_end = cmp_start + CMP_LEN - 1
    slc_start = jnp.arange(n_slc) * SLC_LEN
    overlap = ((cmp_start[:, None] <= slc_start[None, :] + SLC_LEN - 1)
               & (cmp_end[:, None] >= slc_start[None, :])).astype(jnp.float32)
    gather = jax.vmap(jax.vmap(lambda blocks, i: blocks[i]))
    j = jnp.arange(n_slc)

    def query_block(qb):
        t0 = qb * NSA_QBLOCK
        t = t0 + jnp.arange(NSA_QBLOCK)
        qblk = lax.dynamic_slice_in_dim(qr, t0, NSA_QBLOCK, axis=1)
        s = jnp.einsum("bqgrd,bngd->bgrqn", qblk, kcmp) * scale
        p_cmp = masked_softmax(s, cmp_end[None, :] <= t[:, None])
        o_cmp = jnp.einsum("bgrqn,bngd->bqgrd", p_cmp.astype(vcmp.dtype), vcmp)
        imp = jnp.einsum("bgrqn,nj->bgqj", p_cmp, overlap)
        cur = t // SLC_LEN
        forced = (j[None, :] == 0) | (j[None, :] == cur[:, None]) | (j[None, :] == cur[:, None] - 1)
        valid = slc_start[None, :] <= t[:, None]
        score = jnp.where(valid, imp + FORCE_BONUS * forced, -1.0)
        _, sel = lax.top_k(score, n_sel)
        ksel = gather(ks_blk, sel).reshape(b_, G, NSA_QBLOCK, n_sel * SLC_LEN, DK)
        vsel = gather(vs_blk, sel).reshape(b_, G, NSA_QBLOCK, n_sel * SLC_LEN, NSA_DV)
        key_pos = (sel[..., None] * SLC_LEN + jnp.arange(SLC_LEN)).reshape(b_, G, NSA_QBLOCK, n_sel * SLC_LEN)
        s = jnp.einsum("bqgrd,bgqkd->bgrqk", qblk, ksel) * scale
        p = masked_softmax(s, key_pos[:, :, None] <= t[:, None])
        o_slc = jnp.einsum("bgrqk,bgqkd->bqgrd", p.astype(vsel.dtype), vsel)
        kwb = lax.dynamic_slice_in_dim(kw_pad, t0, WINDOW + NSA_QBLOCK, axis=1)
        vwb = lax.dynamic_slice_in_dim(vw_pad, t0, WINDOW + NSA_QBLOCK, axis=1)
        kpos = t0 - WINDOW + jnp.arange(WINDOW + NSA_QBLOCK)
        diff = t[:, None] - kpos[None, :]
        s = jnp.einsum("bqgrd,bkgd->bgrqk", qblk, kwb) * scale
        p = masked_softmax(s, (diff >= 0) & (diff < WINDOW) & (kpos[None, :] >= 0))
        o_win = jnp.einsum("bgrqk,bkgd->bqgrd", p.astype(vwb.dtype), vwb)
        gb = lax.dynamic_slice_in_dim(g, t0, NSA_QBLOCK, axis=1)
        return gb[..., 0:1] * o_cmp + gb[..., 1:2] * o_slc + gb[..., 2:3] * o_win

    out = lax.map(query_block, jnp.arange(s_ // NSA_QBLOCK))
    return out.transpose(1, 0, 2, 3, 4, 5).reshape(b_, s_, NSA_HEADS * NSA_DV)


def even_mixer(h, w_in, conv_w, conv_b, wa, ba, wx, bx, lam, gate_b, q_norm, k_norm,
               cmp_pos, ck_w1, ck_w2, cv_w1, cv_w2, w_out):
    b_, s_, _ = h.shape
    gdk = NSA_KV_GROUPS * NSA_DK
    rg_x, rg_g, q, kc, vc, ks, vs, kw, vw, gates = split_cols(
        h @ w_in, [RG_WIDTH, RG_WIDTH, NSA_HEADS * NSA_DK] + [gdk] * 6 + [3 * NSA_HEADS])
    rg = jax.nn.gelu(rg_g) * rglru(causal_dwconv(rg_x, conv_w, conv_b), wa, ba, wx, bx, lam)

    def kv4(t):
        return t.reshape(b_, s_, NSA_KV_GROUPS, NSA_DK)

    att = nsa(q.reshape(b_, s_, NSA_HEADS, NSA_DK), kv4(kc), kv4(vc), kv4(ks), kv4(vs), kv4(kw), kv4(vw),
              gates + gate_b, q_norm, k_norm, cmp_pos, ck_w1, ck_w2, cv_w1, cv_w2)
    return jnp.concatenate([rg, att], axis=-1) @ w_out


def ssd(x, a, bm, cm):
    b_, s_, g_, r_, p_ = x.shape
    q_ = SSD_CHUNK
    c_ = s_ // q_
    x = x.reshape(b_, c_, q_, g_, r_, p_)
    bm = bm.reshape(b_, c_, q_, g_, -1)
    cm = cm.reshape(b_, c_, q_, g_, -1)
    a = a.reshape(b_, c_, q_, g_, r_).transpose(0, 3, 4, 1, 2)
    a_cs = jnp.cumsum(a, axis=-1)
    causal = jnp.tril(jnp.ones((q_, q_), dtype=bool))
    decay = jnp.exp(jnp.where(causal, a_cs[..., :, None] - a_cs[..., None, :], -jnp.inf))
    y_diag = jnp.einsum("bcqgn,bcsgn,bgrcqs,bcsgrp->bcqgrp", cm, bm, decay, x)
    decay_states = jnp.exp(a_cs[..., -1:] - a_cs)
    states = jnp.einsum("bcsgn,bgrcs,bcsgrp->bcgrpn", bm, decay_states, x)
    chunk_decay = jnp.exp(a_cs[..., -1])

    def step(hc, inp):
        st, dec = inp
        return dec[..., None, None] * hc + st, hc

    _, prev = lax.scan(step, jnp.zeros_like(states[:, 0]),
                       (jnp.moveaxis(states, 1, 0), jnp.moveaxis(chunk_decay, -1, 0)))
    y_off = jnp.einsum("bcqgn,cbgrpn,bgrcq->bcqgrp", cm, prev, jnp.exp(a_cs))
    return (y_diag + y_off).reshape(b_, s_, g_, r_, p_)


def mamba2(h, w_in, conv_w, conv_b, dt_bias, a_log, d_skip, norm_g, w_out):
    b_, s_, _ = h.shape
    gn = SSM_GROUPS * SSM_STATE
    z, xbc, dt = split_cols(h @ w_in, [D_INNER, CONV_CH, SSM_HEADS])
    xbc = jax.nn.silu(causal_dwconv(xbc, conv_w, conv_b))
    xs, bm, cm = split_cols(xbc, [D_INNER, gn, gn])
    xs = xs.reshape(b_, s_, SSM_GROUPS, SSM_REP, SSM_HEADDIM).astype(jnp.float32)
    bm = bm.reshape(b_, s_, SSM_GROUPS, SSM_STATE).astype(jnp.float32)
    cm = cm.reshape(b_, s_, SSM_GROUPS, SSM_STATE).astype(jnp.float32)
    dt = jax.nn.softplus(dt.astype(jnp.float32) + dt_bias.astype(jnp.float32)).reshape(b_, s_, SSM_GROUPS, SSM_REP)
    a = -jnp.exp(a_log.astype(jnp.float32)).reshape(SSM_GROUPS, SSM_REP)
    y = ssd(xs * dt[..., None], dt * a, bm, cm) + d_skip.astype(jnp.float32).reshape(SSM_GROUPS, SSM_REP, 1) * xs
    y = y.reshape(b_, s_, D_INNER).astype(h.dtype) * jax.nn.silu(z)
    y = rmsnorm(y.reshape(b_, s_, SSM_GROUPS, D_INNER // SSM_GROUPS),
                norm_g.reshape(SSM_GROUPS, D_INNER // SSM_GROUPS)).reshape(b_, s_, D_INNER)
    return y @ w_out


def cross_attn(xn, memn, wq, wkv, qn, kn, wo):
    b_, s_, _ = xn.shape
    m_ = memn.shape[1]
    q = rmsnorm((xn @ wq).reshape(b_, s_, X_HEADS, X_HEADDIM), qn)
    k, v = jnp.split(memn @ wkv, 2, axis=-1)
    k = rmsnorm(k.reshape(b_, m_, X_HEADS, X_HEADDIM), kn)
    v = v.reshape(b_, m_, X_HEADS, X_HEADDIM)
    s = jnp.einsum("bqhd,bmhd->bhqm", q, k).astype(jnp.float32) * (X_HEADDIM ** -0.5)
    p = jax.nn.softmax(s, axis=-1).astype(v.dtype)
    o = jnp.einsum("bhqm,bmhd->bqhd", p, v).reshape(b_, s_, X_INNER)
    return o @ wo


def swiglu(h, w13, w2):
    up, gate = jnp.split(h @ w13, 2, axis=-1)
    return (jax.nn.silu(gate) * up) @ w2


def moe(h, router, w13, w2):
    logits = (h @ router).astype(jnp.float32)
    top_v, top_i = lax.top_k(logits, TOP_K)
    w = jax.nn.softmax(top_v, axis=-1)
    gate = jnp.sum(jax.nn.one_hot(top_i, N_EXPERTS, dtype=jnp.float32) * w[..., None], axis=-2)
    y = jnp.zeros_like(h)
    for e in range(N_EXPERTS):
        y = y + gate[..., e:e + 1].astype(h.dtype) * swiglu(h, w13[e], w2[e])
    return y


def setup_inputs(seed: int = 0) -> dict:
    key = jax.random.key(seed)
    keys = iter(jax.random.split(key, 64))
    f32 = jnp.float32

    def nrm(shape, fan_in):
        return jax.random.normal(next(keys), shape, f32) * (fan_in ** -0.5)

    def gain(shape):
        return 1.0 + 0.02 * jax.random.normal(next(keys), shape, f32)

    def bias(shape):
        return 0.01 * jax.random.normal(next(keys), shape, f32)

    a0 = jax.random.uniform(next(keys), (N_EVEN, RG_WIDTH), f32, minval=0.9, maxval=0.999)
    s0 = a0 ** (1.0 / RG_C)
    lam = jnp.log(s0) - jnp.log1p(-s0)
    dt0 = jnp.exp(jax.random.uniform(next(keys), (N_ODD, SSM_HEADS), f32,
                                     minval=math.log(1e-3), maxval=math.log(1e-1)))
    dt_bias = dt0 + jnp.log(-jnp.expm1(-dt0))
    a_log = jnp.log(jax.random.uniform(next(keys), (N_ODD, SSM_HEADS), f32, minval=1.0, maxval=16.0))
    return {
        "x": jax.random.normal(next(keys), (BATCH, SEQ, D_MODEL), f32),
        "mem": jax.random.normal(next(keys), (BATCH, MEM_LEN, D_MODEL), f32),
        "norm_mix": gain((DEPTH, D_MODEL)),
        "norm_cross": gain((DEPTH, D_MODEL)),
        "norm_mem": gain((DEPTH, D_MODEL)),
        "norm_ffn": gain((DEPTH, D_MODEL)),
        "ev_w_in": nrm((N_EVEN, D_MODEL, EV_IN), D_MODEL),
        "ev_rg_conv_w": nrm((N_EVEN, CONV_W, RG_WIDTH), CONV_W),
        "ev_rg_conv_b": bias((N_EVEN, RG_WIDTH)),
        "ev_rg_wa": nrm((N_EVEN, RG_BLOCKS, RG_BW, RG_BW), RG_BW),
        "ev_rg_ba": bias((N_EVEN, RG_WIDTH)),
        "ev_rg_wx": nrm((N_EVEN, RG_BLOCKS, RG_BW, RG_BW), RG_BW),
        "ev_rg_bx": bias((N_EVEN, RG_WIDTH)),
        "ev_rg_lambda": lam,
        "ev_nsa_gate_b": bias((N_EVEN, 3 * NSA_HEADS)),
        "ev_q_norm": gain((N_EVEN, NSA_DK)),
        "ev_k_norm": gain((N_EVEN, 3, NSA_DK)),
        "ev_cmp_pos": 0.1 * jax.random.normal(next(keys), (N_EVEN, CMP_LEN, NSA_DK), f32),
        "ev_cmp_k_w1": nrm((N_EVEN, CMP_LEN * NSA_DK, CMP_HID), CMP_LEN * NSA_DK),
        "ev_cmp_k_w2": nrm((N_EVEN, CMP_HID, NSA_DK), CMP_HID),
        "ev_cmp_v_w1": nrm((N_EVEN, CMP_LEN * NSA_DK, CMP_HID), CMP_LEN * NSA_DK),
        "ev_cmp_v_w2": nrm((N_EVEN, CMP_HID, NSA_DV), CMP_HID),
        "ev_w_out": nrm((N_EVEN, EV_MIX, D_MODEL), EV_MIX),
        "od_w_in": nrm((N_ODD, D_MODEL, OD_IN), D_MODEL),
        "od_conv_w": nrm((N_ODD, CONV_W, CONV_CH), CONV_W),
        "od_conv_b": bias((N_ODD, CONV_CH)),
        "od_dt_bias": dt_bias,
        "od_a_log": a_log,
        "od_d_skip": gain((N_ODD, SSM_HEADS)),
        "od_norm": gain((N_ODD, D_INNER)),
        "od_w_out": nrm((N_ODD, D_INNER, D_MODEL), D_INNER),
        "x_wq": nrm((DEPTH, D_MODEL, X_INNER), D_MODEL),
        "x_wkv": nrm((DEPTH, D_MODEL, 2 * X_INNER), D_MODEL),
        "x_q_norm": gain((DEPTH, X_HEADDIM)),
        "x_k_norm": gain((DEPTH, X_HEADDIM)),
        "x_wo": nrm((DEPTH, X_INNER, D_MODEL), X_INNER),
        "ff_w13": nrm((N_EVEN, D_MODEL, 2 * FF_DENSE), D_MODEL),
        "ff_w2": nrm((N_EVEN, FF_DENSE, D_MODEL), FF_DENSE),
        "moe_router": nrm((N_ODD, D_MODEL, N_EXPERTS), D_MODEL),
        "moe_w13": nrm((N_ODD, N_EXPERTS, D_MODEL, 2 * FF_EXPERT), D_MODEL),
        "moe_w2": nrm((N_ODD, N_EXPERTS, FF_EXPERT, D_MODEL), FF_EXPERT),
    }


def reference(x, mem, norm_mix, norm_cross, norm_mem, norm_ffn,
              ev_w_in, ev_rg_conv_w, ev_rg_conv_b, ev_rg_wa, ev_rg_ba, ev_rg_wx, ev_rg_bx, ev_rg_lambda,
              ev_nsa_gate_b, ev_q_norm, ev_k_norm, ev_cmp_pos, ev_cmp_k_w1, ev_cmp_k_w2, ev_cmp_v_w1,
              ev_cmp_v_w2, ev_w_out,
              od_w_in, od_conv_w, od_conv_b, od_dt_bias, od_a_log, od_d_skip, od_norm, od_w_out,
              x_wq, x_wkv, x_q_norm, x_k_norm, x_wo,
              ff_w13, ff_w2, moe_router, moe_w13, moe_w2):
    for layer in range(DEPTH):
        i = layer // 2
        h = rmsnorm(x, norm_mix[layer])
        if layer % 2 == 0:
            mix = even_mixer(h, ev_w_in[i], ev_rg_conv_w[i], ev_rg_conv_b[i], ev_rg_wa[i], ev_rg_ba[i],
                             ev_rg_wx[i], ev_rg_bx[i], ev_rg_lambda[i], ev_nsa_gate_b[i], ev_q_norm[i],
                             ev_k_norm[i], ev_cmp_pos[i], ev_cmp_k_w1[i], ev_cmp_k_w2[i], ev_cmp_v_w1[i],
                             ev_cmp_v_w2[i], ev_w_out[i])
        else:
            mix = mamba2(h, od_w_in[i], od_conv_w[i], od_conv_b[i], od_dt_bias[i], od_a_log[i],
                         od_d_skip[i], od_norm[i], od_w_out[i])
        x = x + mix
        x = x + cross_attn(rmsnorm(x, norm_cross[layer]), rmsnorm(mem, norm_mem[layer]),
                           x_wq[layer], x_wkv[layer], x_q_norm[layer], x_k_norm[layer], x_wo[layer])
        h = rmsnorm(x, norm_ffn[layer])
        if layer % 2 == 0:
            x = x + swiglu(h, ff_w13[i], ff_w2[i])
        else:
            x = x + moe(h, moe_router[i], moe_w13[i], moe_w2[i])
    return x
```

```cpp
#include <hip/hip_runtime.h>
#include <cstdio>
#include <cstdint>

namespace pg8 {
#define PG8_LAS __attribute__((address_space(3)))
typedef unsigned short bf16_t;
typedef short bf16x8 __attribute__((ext_vector_type(8)));
typedef float f32x4 __attribute__((ext_vector_type(4)));
typedef unsigned u32x4 __attribute__((ext_vector_type(4)));
typedef unsigned u32x2 __attribute__((ext_vector_type(2)));
constexpr int BM = 256, BK = 64, HALF = 128, HTB = HALF * BK * 2  , STAGE_BYTES = 8 * HTB, NXCD = 8, WGM = 8;

__host__ __device__ __forceinline__ int lds_byte(int r, int c) { const int st = (r >> 4) * 2 + (c >> 5), rr = r & 15, cc = c & 31, ob = rr * 64 + cc * 2; return st * 1024 + (ob ^ (((ob >> 9) & 1) << 5)); }
__host__ __device__ __forceinline__ void stage_rc(int b, int& R, int& C) { const int st = b / 1024, sb = b % 1024, swz = sb ^ (((sb >> 9) & 1) << 5); R = (st >> 1) * 16 + swz / 64; C = (st & 1) * 32 + (swz % 64) / 2; }
__host__ __device__ __forceinline__ int perm32(int rho) { const int n = rho >> 4, i = rho & 15; return 8 * (i >> 2) + 4 * n + (i & 3); }

struct Unit { int pm, pn, bn, idx; };
struct Gemm { const bf16_t* A; const bf16_t* Bt; int M, N, K, lda, ldb; };

struct StaticOrder {
    int nM, nN, nwg, G, c;
    __host__ __device__ void init(int M, int N, int G_, int c_) { nM = M / BM; nN = N / BM; nwg = nM * nN; G = G_; c = c_; }
    __host__ __device__ bool next(int i, Unit& u) const {
        const long L = (long)i * G + c; if (L >= nwg) return false;
        int wgid = (int)L; { const int q = nwg / NXCD, r = nwg % NXCD, xcd = wgid % NXCD, off = wgid / NXCD; wgid = (xcd < r ? xcd * (q + 1) : r * (q + 1) + (xcd - r) * q) + off; }
        const int nig = WGM * nN, gid = wgid / nig, fm = gid * WGM, gsz = (nM - fm) < WGM ? (nM - fm) : WGM;
        u.pm = fm + ((wgid % nig) % gsz); u.pn = (wgid % nig) / gsz; u.bn = u.pn; u.idx = i; return true;
    }
    __device__ __forceinline__ void a_ready(const Unit&) const {}
    __device__ __forceinline__ void done(const Unit&) const {}
};
struct ListOrder {
    int nN, nwg, G, c;
    __host__ __device__ void init(int nM_, int nN_, int G_, int c_) { nN = nN_; nwg = nM_ * nN_; G = G_; c = c_; }
    __host__ __device__ bool next(int i, Unit& u) const { const long L = (long)i * G + c; if (c < 0 || L >= nwg) return false; u.pm = (int)(L / nN); u.pn = (int)(L % nN); u.bn = u.pn; u.idx = i; return true; }
    __device__ __forceinline__ void a_ready(const Unit&) const {}
    __device__ __forceinline__ void done(const Unit&) const {}
};

__device__ __forceinline__ unsigned cvt_pk_bf16(float lo, float hi) { unsigned r; asm volatile("v_cvt_pk_bf16_f32 %0, %1, %2" : "=v"(r) : "v"(lo), "v"(hi)); return r; }
__device__ __forceinline__ float fsigmoid(float x) { return __builtin_amdgcn_rcpf(1.0f + __expf(-x)); }
__device__ __forceinline__ float gelu_tanh(float x) { const float u = 1.5957691216f * (x + 0.044715f * x * x * x); return x * fsigmoid(u); }
__device__ __forceinline__ float fsilu(float x) { return x * fsigmoid(x); }

__device__ __forceinline__ float row_rstd(const float* ssq, int row) {
    const f32x4 a = *(const f32x4*)(ssq + (size_t)row * 16), b = *(const f32x4*)(ssq + (size_t)row * 16 + 4), c = *(const f32x4*)(ssq + (size_t)row * 16 + 8), d = *(const f32x4*)(ssq + (size_t)row * 16 + 12);
    const f32x4 s = (a + b) + (c + d); return 1.0f / sqrtf(((s[0] + s[1]) + (s[2] + s[3])) * (1.0f / 1024.0f) + 1e-6f);
}
template <class Sched> __device__ __forceinline__ void fill_rstd_table(PG8_LAS float* tab, const Sched& S, const float* ssq, int tid) {
    Unit u; for (int i = 0; S.next(i, u); ++i) if (tid < 256) { const int ai = tid >> 7, wr = (tid >> 6) & 1, m = (tid >> 4) & 3, fr = tid & 15; tab[i * 256 + ((ai * 2 + wr) * 16 + fr) * 4 + m] = row_rstd(ssq, u.pm * BM + tid); }
    __syncthreads();
}
template <int ACT, bool SPLIT_ = false> struct EpiBf16 {
    static constexpr bool PERM = true, AFTER_DRAIN = false, SPLIT = SPLIT_, PACK = false; static constexpr int NST = 16; struct Pk {};
    bf16_t* O; int ldc; const float* bias; const PG8_LAS float* rsT;
    __device__ __forceinline__ void operator()(const f32x4 (&acc)[2][2][4][2], const Unit& u, int wr, int wc, int fr, int fq) const { half<0>(acc, u, wr, wc, fr, fq); half<1>(acc, u, wr, wc, fr, fq); }
    template <int AI> __device__ __forceinline__ void half(const f32x4 (&acc)[2][2][4][2], const Unit& u, int wr, int wc, int fr, int fq) const {
        const int row0 = u.pm * BM + wr * 64 + fr; const int col0 = u.pn * BM + wc * 32 + 8 * fq;
        f32x4 bv[2][2];
#pragma unroll
        for (int bj = 0; bj < 2; ++bj)
#pragma unroll
            for (int n = 0; n < 2; ++n) bv[bj][n] = bias ? *(const f32x4*)(bias + col0 + bj * HALF + 4 * n) : (f32x4){0.f, 0.f, 0.f, 0.f};
        { constexpr int ai = AI; const f32x4 rs4 = rsT ? *(const PG8_LAS f32x4*)(rsT + u.idx * 256 + ((ai * 2 + wr) * 16 + fr) * 4) : (f32x4){1.f, 1.f, 1.f, 1.f};
#pragma unroll
            for (int m = 0; m < 4; ++m) { bf16_t* rowp = O + (size_t)(row0 + ai * HALF + m * 16) * ldc + col0; const float rs = rs4[m];
#pragma unroll
                for (int bj = 0; bj < 2; ++bj) { f32x4 v0 = acc[ai][bj][m][0] * rs + bv[bj][0], v1 = acc[ai][bj][m][1] * rs + bv[bj][1];
                    if (ACT == 1) {
#pragma unroll
                        for (int j = 0; j < 4; ++j) { v0[j] = gelu_tanh(v0[j]); v1[j] = gelu_tanh(v1[j]); } }
                    u32x4 w; w.x = cvt_pk_bf16(v0[0], v0[1]); w.y = cvt_pk_bf16(v0[2], v0[3]); w.z = cvt_pk_bf16(v1[0], v1[1]); w.w = cvt_pk_bf16(v1[2], v1[3]);
                    *(u32x4*)(rowp + bj * HALF) = w; } } }
    }
};
struct EpiEvIn {
    static constexpr bool PERM = true, AFTER_DRAIN = false, SPLIT = true, PACK = false; static constexpr int NST = 16; struct Pk {};
    bf16_t* O; int ldc; bf16_t* KV6; int S;
    __device__ __forceinline__ void operator()(const f32x4 (&acc)[2][2][4][2], const Unit& u, int wr, int wc, int fr, int fq) const { half<0>(acc, u, wr, wc, fr, fq); half<1>(acc, u, wr, wc, fr, fq); }
    template <int AI> __device__ __forceinline__ void half(const f32x4 (&acc)[2][2][4][2], const Unit& u, int wr, int wc, int fr, int fq) const {
        const int row0 = u.pm * BM + wr * 64 + fr; const int col0 = u.pn * BM + wc * 32 + 8 * fq;
        const bool kv = (u.pn >= 12 && u.pn < 18);
        { constexpr int ai = AI;
#pragma unroll
            for (int m = 0; m < 4; ++m) { const int row = row0 + ai * HALF + m * 16;
#pragma unroll
                for (int bj = 0; bj < 2; ++bj) { const f32x4 v0 = acc[ai][bj][m][0], v1 = acc[ai][bj][m][1];
                    u32x4 w; w.x = cvt_pk_bf16(v0[0], v0[1]); w.y = cvt_pk_bf16(v0[2], v0[3]); w.z = cvt_pk_bf16(v1[0], v1[1]); w.w = cvt_pk_bf16(v1[2], v1[3]);
                    if (kv) { const int b = row / S, t = row - b * S;
                        bf16_t* p = KV6 + ((((size_t)(u.pn - 12) * 2 + b) * 2 + bj) * S + t) * 128 + wc * 32 + 8 * fq; *(u32x4*)p = w; }
                    else *(u32x4*)(O + (size_t)row * ldc + col0 + bj * HALF) = w; } } }
    }
};
struct EpiResid {
    static constexpr bool PERM = false, AFTER_DRAIN = false, SPLIT = false, PACK = false; static constexpr int NST = 0; struct Pk {};
    const float* base; float* out; int ldc;
    __device__ __forceinline__ void operator()(const f32x4 (&acc)[2][2][4][2], const Unit& u, int wr, int wc, int fr, int fq) const {
        const int row0 = u.pm * BM + wr * 64 + fr, col0 = u.pn * BM + wc * 32 + 4 * fq;
#pragma unroll
        for (int ai = 0; ai < 2; ++ai)
#pragma unroll
            for (int m = 0; m < 4; ++m) { const size_t off = (size_t)(row0 + ai * HALF + m * 16) * ldc + col0;
#pragma unroll
                for (int bj = 0; bj < 2; ++bj)
#pragma unroll
                    for (int n = 0; n < 2; ++n) { const f32x4 b = *(const f32x4*)(base + off + bj * HALF + n * 16); *(f32x4*)(out + off + bj * HALF + n * 16) = b + acc[ai][bj][m][n]; } }
    }
};
struct EpiResidN {
    static constexpr bool PERM = false, AFTER_DRAIN = false, SPLIT = false, PACK = false; static constexpr int NST = 0; struct Pk {};
    const float* base; float* out; int ldc; bf16_t* XB; float* SSQ;
    __device__ __forceinline__ void operator()(const f32x4 (&acc)[2][2][4][2], const Unit& u, int wr, int wc, int fr, int fq) const {
        const int row0 = u.pm * BM + wr * 64 + fr, col0 = u.pn * BM + wc * 32 + 4 * fq;
#pragma unroll
        for (int ai = 0; ai < 2; ++ai)
#pragma unroll
            for (int m = 0; m < 4; ++m) { const int row = row0 + ai * HALF + m * 16; const size_t off = (size_t)row * ldc + col0; float ss = 0.f;
#pragma unroll
                for (int bj = 0; bj < 2; ++bj)
#pragma unroll
                    for (int n = 0; n < 2; ++n) { const f32x4 b = *(const f32x4*)(base + off + bj * HALF + n * 16); const f32x4 v = b + acc[ai][bj][m][n]; *(f32x4*)(out + off + bj * HALF + n * 16) = v;
                        if (XB) { u32x2 w; w.x = cvt_pk_bf16(v[0], v[1]); w.y = cvt_pk_bf16(v[2], v[3]); *(u32x2*)(XB + off + bj * HALF + n * 16) = w; }
                        ss += (v[0] * v[0] + v[1] * v[1]) + (v[2] * v[2] + v[3] * v[3]); }
                ss += __shfl_xor(ss, 16); ss += __shfl_xor(ss, 32);
                if (XB && fq == 0) SSQ[(size_t)row * 16 + u.pn * 4 + wc] = ss; }
    }
};
struct EpiNull {
    static constexpr bool PERM = false, AFTER_DRAIN = false, SPLIT = false, PACK = false; static constexpr int NST = 0; struct Pk {};
    __device__ __forceinline__ void operator()(const f32x4 (&acc)[2][2][4][2], const Unit&, int, int, int, int) const {
#pragma unroll
        for (int ai = 0; ai < 2; ++ai)
#pragma unroll
            for (int bj = 0; bj < 2; ++bj)
#pragma unroll
                for (int m = 0; m < 4; ++m)
#pragma unroll
                    for (int n = 0; n < 2; ++n) asm volatile("" :: "v"(acc[ai][bj][m][n]));
    }
};
struct EpiF32 {
    static constexpr bool PERM = false, AFTER_DRAIN = false, SPLIT = false, PACK = false; static constexpr int NST = 0; struct Pk {};
    float* C; int ldc;
    __device__ __forceinline__ void operator()(const f32x4 (&acc)[2][2][4][2], const Unit& u, int wr, int wc, int fr, int fq) const {
        const int row0 = u.pm * BM + wr * 64 + fr, col0 = u.pn * BM + wc * 32 + 4 * fq;
#pragma unroll
        for (int ai = 0; ai < 2; ++ai)
#pragma unroll
            for (int m = 0; m < 4; ++m) { float* rowp = C + (size_t)(row0 + ai * HALF + m * 16) * ldc + col0;
#pragma unroll
                for (int bj = 0; bj < 2; ++bj)
#pragma unroll
                    for (int n = 0; n < 2; ++n) *(f32x4*)(rowp + bj * HALF + n * 16) = acc[ai][bj][m][n]; }
    }
};
template <bool SPLIT_, bool PACK_ = false> struct EpiSwiglu {
    static constexpr bool PERM = true, AFTER_DRAIN = false, SPLIT = SPLIT_, PACK = PACK_; static constexpr int NST = 8;
    bf16_t* H; int ldh; const PG8_LAS float* rsT;
    __device__ __forceinline__ void operator()(const f32x4 (&acc)[2][2][4][2], const Unit& u, int wr, int wc, int fr, int fq) const { half<0>(acc, u, wr, wc, fr, fq); half<1>(acc, u, wr, wc, fr, fq); }
    struct Pk { u32x4 w[4]; };
    __device__ __forceinline__ void pack1(const f32x4 (&acc)[2][2][4][2], const Unit& u, int wr, int fr, Pk& pk) const {
        constexpr int ai = 1; const f32x4 rs4 = rsT ? *(const PG8_LAS f32x4*)(rsT + u.idx * 256 + ((ai * 2 + wr) * 16 + fr) * 4) : (f32x4){1.f, 1.f, 1.f, 1.f};
#pragma unroll
        for (int m = 0; m < 4; ++m) { const float rs = rs4[m];
            const f32x4 u0 = acc[ai][0][m][0] * rs, u1 = acc[ai][0][m][1] * rs, g0 = acc[ai][1][m][0] * rs, g1 = acc[ai][1][m][1] * rs;
            pk.w[m].x = cvt_pk_bf16(fsilu(g0[0]) * u0[0], fsilu(g0[1]) * u0[1]); pk.w[m].y = cvt_pk_bf16(fsilu(g0[2]) * u0[2], fsilu(g0[3]) * u0[3]);
            pk.w[m].z = cvt_pk_bf16(fsilu(g1[0]) * u1[0], fsilu(g1[1]) * u1[1]); pk.w[m].w = cvt_pk_bf16(fsilu(g1[2]) * u1[2], fsilu(g1[3]) * u1[3]); }
    }
    __device__ __forceinline__ void store1(const Pk& pk, const Unit& u, int wr, int wc, int fr, int fq) const {
        bf16_t* p = H + (size_t)(u.pm * BM + wr * 64 + fr + HALF) * ldh + u.pn * 128 + wc * 32 + 8 * fq;
#pragma unroll
        for (int m = 0; m < 4; ++m) *(u32x4*)(p + (size_t)(m * 16) * ldh) = pk.w[m];
    }
    template <int AI> __device__ __forceinline__ void half(const f32x4 (&acc)[2][2][4][2], const Unit& u, int wr, int wc, int fr, int fq) const {
        const int row0 = u.pm * BM + wr * 64 + fr, col0 = u.pn * 128 + wc * 32 + 8 * fq;
        constexpr int ai = AI; const f32x4 rs4 = rsT ? *(const PG8_LAS f32x4*)(rsT + u.idx * 256 + ((ai * 2 + wr) * 16 + fr) * 4) : (f32x4){1.f, 1.f, 1.f, 1.f};
#pragma unroll
        for (int m = 0; m < 4; ++m) { bf16_t* rowp = H + (size_t)(row0 + ai * HALF + m * 16) * ldh + col0; const float rs = rs4[m];
            const f32x4 u0 = acc[ai][0][m][0] * rs, u1 = acc[ai][0][m][1] * rs, g0 = acc[ai][1][m][0] * rs, g1 = acc[ai][1][m][1] * rs;
            u32x4 w; w.x = cvt_pk_bf16(fsilu(g0[0]) * u0[0], fsilu(g0[1]) * u0[1]); w.y = cvt_pk_bf16(fsilu(g0[2]) * u0[2], fsilu(g0[3]) * u0[3]);
            w.z = cvt_pk_bf16(fsilu(g1[0]) * u1[0], fsilu(g1[1]) * u1[1]); w.w = cvt_pk_bf16(fsilu(g1[2]) * u1[2], fsilu(g1[3]) * u1[3]);
            *(u32x4*)rowp = w; }
    }
};
__host__ __device__ __forceinline__ int swiglu_row(int h, int gate) { return (h >> 7) * 256 + gate * 128 + (h & 127); }

template <class Epi, class Sched, bool ALIGN_EPI = false, bool SP2 = false>
__device__ __forceinline__ void gemm_phase(PG8_LAS unsigned char* lds, const Gemm g, const Sched& S, const Epi& E) {
    int tid = threadIdx.x; asm volatile("" : "+v"(tid));
    const int wid = __builtin_amdgcn_readfirstlane(tid >> 6), lane = tid & 63, wr = wid >> 2, wc = wid & 3, fr = lane & 15, fq = lane >> 4;
    const int K = g.K, nt = K / BK;
    unsigned voffA, voffB;
    { int R, C; stage_rc(tid * 16, R, C); const int Rb = Epi::PERM ? ((R & ~31) + perm32(R & 31)) : R;
      voffA = (unsigned)(R * g.lda + C) * 2u; voffB = (unsigned)(Rb * g.ldb + C) * 2u; }
    const size_t q64A = (size_t)64 * g.lda * 2, q64B = (size_t)64 * g.ldb * 2;
    const size_t kstep = (size_t)(BK * 2);
    const size_t hstepA = (size_t)HALF * g.lda * 2, hstepB = (size_t)HALF * g.ldb * 2;
    const size_t tstepA = 2 * hstepA, tstepB = 2 * hstepB;
    const unsigned ldsw = (unsigned)wid * 1024u;
    const int aoff = lds_byte(wr * 64 + fr, fq * 8), boff = lds_byte(wc * 32 + fr, fq * 8);
#define PG8_SA(b, h) (((b) * 2 + (h)) * HTB)
#define PG8_SB(b, h) ((4 + (b) * 2 + (h)) * HTB)
#define PG8_STAGE(bufoff, gbase, voff) do { __builtin_amdgcn_global_load_lds((const unsigned*)((const char*)(gbase) + (voff)), (PG8_LAS unsigned*)(lds + (bufoff) + ldsw), 16, 0, 0); \
        __builtin_amdgcn_global_load_lds((const unsigned*)((const char*)(gbase) + PG8_Q64(voff) + (voff)), (PG8_LAS unsigned*)(lds + (bufoff) + ldsw + 8192), 16, 0, 0); } while (0)
#define PG8_Q64(v) PG8_Q64_##v
#define PG8_Q64_voffA q64A
#define PG8_Q64_voffB q64B
#define PG8_LDA(dst, b, h) do { _Pragma("unroll") for (int m = 0; m < 4; ++m) _Pragma("unroll") for (int k = 0; k < 2; ++k) dst[m][k] = *(const PG8_LAS bf16x8*)(lds + PG8_SA(b, h) + aoff + m * 2048 + k * 1024); } while (0)
#define PG8_LDB(dst, b, h) do { _Pragma("unroll") for (int n = 0; n < 2; ++n) _Pragma("unroll") for (int k = 0; k < 2; ++k) dst[n][k] = *(const PG8_LAS bf16x8*)(lds + PG8_SB(b, h) + boff + n * 2048 + k * 1024); } while (0)
#define PG8_MMA(ai, bj, At, Bt) do { __builtin_amdgcn_s_setprio(1); _Pragma("unroll") for (int m = 0; m < 4; ++m) _Pragma("unroll") for (int n = 0; n < 2; ++n) _Pragma("unroll") for (int k = 0; k < 2; ++k) \
        acc[ai][bj][m][n] = __builtin_amdgcn_mfma_f32_16x16x32_bf16(Bt[n][k], At[m][k], acc[ai][bj][m][n], 0, 0, 0); __builtin_amdgcn_s_setprio(0); } while (0)
#define PG8_WAIT_V(n) asm volatile("s_waitcnt vmcnt(" #n ")" ::: "memory")
#define PG8_WAIT_L(n) asm volatile("s_waitcnt lgkmcnt(" #n ")" ::: "memory")
#define PG8_WAIT_REL(NN) do { if (rel) asm volatile("s_waitcnt vmcnt(%0)" :: "n"(NN) : "memory"); else PG8_WAIT_V(8); } while (0)
#define PG8_BAR __builtin_amdgcn_s_barrier()
#define PG8_SCHED __builtin_amdgcn_sched_barrier(0)
    typename Epi::Pk pk; Unit cur, nxt, pend; int ui = 0; bool pending = false; pend.pm = pend.pn = pend.bn = pend.idx = 0;
    if (!S.next(0, cur)) return;
    f32x4 acc[2][2][4][2];
#pragma unroll
    for (int a = 0; a < 2; ++a)
#pragma unroll
        for (int b = 0; b < 2; ++b)
#pragma unroll
            for (int m = 0; m < 4; ++m)
#pragma unroll
                for (int n = 0; n < 2; ++n) acc[a][b][m][n] = (f32x4){0.f, 0.f, 0.f, 0.f};
    bf16x8 At[4][2], B0[2][2], B1[2][2];
    const char* cA = (const char*)g.A + (size_t)cur.pm * tstepA; const char* cB = (const char*)g.Bt + (size_t)cur.bn * tstepB;
    S.a_ready(cur);
    if constexpr (SP2) {
        PG8_STAGE(PG8_SB(0, 0), cB, voffB); PG8_STAGE(PG8_SB(0, 1), cB + hstepB, voffB); PG8_STAGE(PG8_SA(0, 0), cA, voffA); PG8_STAGE(PG8_SA(0, 1), cA + hstepA, voffA);
        if (wr == 1) PG8_BAR;
        PG8_WAIT_V(2); PG8_BAR;
        PG8_STAGE(PG8_SB(1, 0), cB + kstep, voffB); PG8_STAGE(PG8_SA(1, 0), cA + kstep, voffA); PG8_STAGE(PG8_SB(1, 1), cB + hstepB + kstep, voffB);
        PG8_WAIT_V(6); PG8_BAR;
    } else {
        PG8_STAGE(PG8_SB(0, 0), cB, voffB); PG8_STAGE(PG8_SA(0, 0), cA, voffA); PG8_STAGE(PG8_SB(0, 1), cB + hstepB, voffB); PG8_STAGE(PG8_SA(0, 1), cA + hstepA, voffA);
        if (wr == 1) PG8_BAR;
        PG8_WAIT_V(4); PG8_BAR;
        PG8_STAGE(PG8_SB(1, 0), cB + kstep, voffB); PG8_STAGE(PG8_SA(1, 0), cA + kstep, voffA); PG8_STAGE(PG8_SB(1, 1), cB + hstepB + kstep, voffB);
        PG8_WAIT_V(6); PG8_BAR;
    }
    for (;;) {
        const bool has_next = S.next(ui + 1, nxt);
        const char* nA = has_next ? (const char*)g.A + (size_t)nxt.pm * tstepA : cA; const char* nB = has_next ? (const char*)g.Bt + (size_t)nxt.bn * tstepB : cB;
        for (int t = 0; t < nt; t += 2) {
            const bool last = (t == nt - 2);
            const char* a1 = cA + (size_t)(t + 1) * kstep;
            const char* a2 = last ? nA : cA + (size_t)(t + 2) * kstep; const char* b2 = last ? nB : cB + (size_t)(t + 2) * kstep;
            const char* a3 = a2 + kstep; const char* b3 = b2 + kstep;
            if (last && has_next) S.a_ready(nxt);
            if constexpr (SP2) {
            const bool rel = Epi::SPLIT && pending && t == 0;
            if (rel) { if constexpr (Epi::SPLIT) { PG8_STAGE(PG8_SA(1, 1), a1 + hstepA, voffA); PG8_SCHED;
                if constexpr (Epi::PACK) { E.store1(pk, pend, wr, wc, fr, fq); }
                else { E.template half<1>(acc, pend, wr, wc, fr, fq);
#pragma unroll
                for (int b = 0; b < 2; ++b)
#pragma unroll
                    for (int m = 0; m < 4; ++m)
#pragma unroll
                        for (int n = 0; n < 2; ++n) acc[1][b][m][n] = (f32x4){0.f, 0.f, 0.f, 0.f}; }
                S.done(pend); pending = false;
                PG8_SCHED; PG8_LDB(B0, 0, 0); PG8_LDB(B1, 0, 1); PG8_SCHED; PG8_LDA(At, 0, 0); } }
            else { PG8_LDB(B0, 0, 0); PG8_LDB(B1, 0, 1); PG8_SCHED; PG8_LDA(At, 0, 0); PG8_STAGE(PG8_SA(1, 1), a1 + hstepA, voffA); }
            PG8_WAIT_REL(8 + Epi::NST); PG8_WAIT_L(0); PG8_BAR; PG8_MMA(0, 0, At, B0); PG8_MMA(0, 1, At, B1); PG8_BAR; PG8_SCHED;
            PG8_LDA(At, 0, 1); PG8_STAGE(PG8_SB(0, 0), b2, voffB); PG8_STAGE(PG8_SB(0, 1), b2 + hstepB, voffB); PG8_STAGE(PG8_SA(0, 0), a2, voffA);
            PG8_WAIT_REL(8 + Epi::NST); PG8_WAIT_L(0); PG8_BAR; PG8_MMA(1, 0, At, B0); PG8_MMA(1, 1, At, B1); PG8_BAR; PG8_SCHED;
            PG8_LDB(B0, 1, 0); PG8_LDB(B1, 1, 1); PG8_SCHED; PG8_LDA(At, 1, 0); PG8_STAGE(PG8_SA(0, 1), a2 + hstepA, voffA);
            PG8_WAIT_REL(8 + Epi::NST / 2); PG8_WAIT_L(0); PG8_BAR; PG8_MMA(0, 0, At, B0); PG8_MMA(0, 1, At, B1); PG8_BAR; PG8_SCHED;
            PG8_LDA(At, 1, 1); PG8_STAGE(PG8_SB(1, 0), b3, voffB); PG8_STAGE(PG8_SB(1, 1), b3 + hstepB, voffB); PG8_STAGE(PG8_SA(1, 0), a3, voffA);
            PG8_WAIT_V(8); PG8_WAIT_L(0); PG8_BAR; PG8_MMA(1, 0, At, B0); PG8_MMA(1, 1, At, B1); PG8_BAR; PG8_SCHED;
            } else {
            PG8_LDB(B0, 0, 0); PG8_SCHED; PG8_LDA(At, 0, 0); PG8_STAGE(PG8_SA(1, 1), a1 + hstepA, voffA);
            PG8_WAIT_L(8); PG8_BAR; PG8_WAIT_L(0); PG8_MMA(0, 0, At, B0); PG8_BAR; PG8_SCHED;
            PG8_LDB(B1, 0, 1); PG8_STAGE(PG8_SB(0, 0), b2, voffB);
            PG8_BAR; PG8_WAIT_L(0); PG8_MMA(0, 1, At, B1); PG8_BAR;
            PG8_LDA(At, 0, 1); PG8_STAGE(PG8_SA(0, 0), a2, voffA);
            PG8_BAR; PG8_WAIT_L(0); PG8_MMA(1, 0, At, B0); PG8_BAR; PG8_SCHED;
            PG8_STAGE(PG8_SB(0, 1), b2 + hstepB, voffB);
            PG8_WAIT_V(6); PG8_BAR; PG8_MMA(1, 1, At, B1); PG8_BAR;
            PG8_LDB(B0, 1, 0); PG8_SCHED; PG8_LDA(At, 1, 0); PG8_STAGE(PG8_SA(0, 1), a2 + hstepA, voffA);
            PG8_WAIT_L(8); PG8_BAR; PG8_WAIT_L(0); PG8_MMA(0, 0, At, B0); PG8_BAR; PG8_SCHED;
            PG8_LDB(B1, 1, 1); PG8_STAGE(PG8_SB(1, 0), b3, voffB);
            PG8_BAR; PG8_WAIT_L(0); PG8_MMA(0, 1, At, B1); PG8_BAR;
            PG8_LDA(At, 1, 1); PG8_STAGE(PG8_SA(1, 0), a3, voffA);
            PG8_BAR; PG8_WAIT_L(0); PG8_MMA(1, 0, At, B0); PG8_BAR; PG8_SCHED;
            PG8_STAGE(PG8_SB(1, 1), b3 + hstepB, voffB);
            PG8_WAIT_V(6); PG8_BAR; PG8_MMA(1, 1, At, B1); PG8_BAR;
            }
        }
        if constexpr (ALIGN_EPI) { if (wr == 0) PG8_BAR; }
        if constexpr (Epi::SPLIT) { static_assert(SP2, "split epilogues need the SP2 loop");
            if (has_next) { E.template half<0>(acc, cur, wr, wc, fr, fq); if constexpr (Epi::PACK) E.pack1(acc, cur, wr, fr, pk); pend = cur; pending = true; }
            else { E.template half<0>(acc, cur, wr, wc, fr, fq); E.template half<1>(acc, cur, wr, wc, fr, fq); S.done(cur); } }
        else if constexpr (!Epi::AFTER_DRAIN) { E(acc, cur, wr, wc, fr, fq); S.done(cur); }
        if (!has_next) break;
#pragma unroll
        for (int a = 0; a < ((Epi::SPLIT && !Epi::PACK) ? 1 : 2); ++a)
#pragma unroll
            for (int b = 0; b < 2; ++b)
#pragma unroll
                for (int m = 0; m < 4; ++m)
#pragma unroll
                    for (int n = 0; n < 2; ++n) acc[a][b][m][n] = (f32x4){0.f, 0.f, 0.f, 0.f};
        cur = nxt; cA = nA; cB = nB; ++ui;
        if constexpr (ALIGN_EPI) { if (wr == 1) PG8_BAR; }
    }
    PG8_WAIT_V(0);
    if constexpr (!ALIGN_EPI) { if (wr == 0) PG8_BAR; }
    PG8_BAR;
    if constexpr (Epi::AFTER_DRAIN) { E.fused(acc, cur, wr, wc, fr, fq, lds, wid, lane); S.done(cur); }
#undef PG8_SA
#undef PG8_SB
#undef PG8_STAGE
#undef PG8_Q64
#undef PG8_Q64_voffA
#undef PG8_Q64_voffB
#undef PG8_LDA
#undef PG8_LDB
#undef PG8_MMA
#undef PG8_WAIT_V
#undef PG8_WAIT_L
#undef PG8_WAIT_REL
#undef PG8_BAR
#undef PG8_SCHED
}
}
#define PG8_SP2 true
#define PG8_ALIGN true
constexpr int NWAVES = 8, NTHR = 512;
constexpr int BATCH = 2, SEQ = 8192, D = 1024, M = BATCH * SEQ;
constexpr int MEMLEN = 256, MMEM = BATCH * MEMLEN;
constexpr int EV_IN = 4632, EV_INP = 4864;
constexpr int OD_IN = 5152, OD_INP = 5376;
constexpr int FF = 2816, FFE = 3584, NEXP = 8;
constexpr int NQB = SEQ / 64;
constexpr int XH = 4;
constexpr float EPS = 1e-6f;
constexpr int MOE_ROWS = 2 * M + NEXP * 256;
constexpr int MOE_TILES = MOE_ROWS / 256;

constexpr size_t MiB = 1u << 20;
constexpr size_t WS_CTL = 0, CTL_ZERO_BYTES = 1 * MiB;
constexpr size_t WS_SMALL = 1 * MiB;
constexpr size_t WS_CMPB_PART = WS_SMALL;
constexpr size_t WS_CMPB = WS_SMALL + 256 * 1024;
constexpr size_t WS_OV = WS_SMALL + 512 * 1024;
constexpr size_t WS_MEMN = 2 * MiB;
constexpr size_t WS_KVM = 4 * MiB;
constexpr size_t WS_KM = 6 * MiB;
constexpr size_t WS_HID = 7 * MiB;
constexpr size_t WS_KVCMP = 9 * MiB;
constexpr size_t WS_MOEIDX = 10 * MiB;
constexpr size_t WS_SSQ = 14 * MiB;
constexpr size_t WS_W = 16 * MiB;
constexpr size_t WS_W_EVIN = WS_W, WS_W_EVOUT = WS_W_EVIN + 10 * MiB, WS_W_CK1 = WS_W_EVOUT + 4 * MiB, WS_W_CV1 = WS_W_CK1 + 2 * MiB, WS_W_ODIN = WS_W_CV1 + 2 * MiB,
                 WS_W_ODOUT = WS_W_ODIN + 11 * MiB, WS_W_XQ = WS_W_ODOUT + 4 * MiB, WS_W_XKV = WS_W_XQ + 2 * MiB, WS_W_XO = WS_W_XKV + 4 * MiB, WS_W_FF13 = WS_W_XO + 2 * MiB,
                 WS_W_FF2 = WS_W_FF13 + 11 * MiB, WS_W_M13 = WS_W_FF2 + 6 * MiB, WS_W_M2 = WS_W_M13 + 112 * MiB, WS_W_END = WS_W_M2 + 56 * MiB;
constexpr size_t WS_XN = WS_W_END;
constexpr size_t WS_QX = WS_XN + 32 * MiB, WS_OX = WS_QX + 16 * MiB, WS_R = WS_OX + 16 * MiB;
constexpr size_t WS_Y0 = WS_R, WS_KV6 = WS_R + 152 * MiB, WS_MIX = WS_R + 201 * MiB, WS_H = WS_R + 265 * MiB;
constexpr size_t WS_Y1 = WS_R, WS_YG = WS_R + 168 * MiB;
constexpr size_t WS_XP = WS_R, WS_HP = WS_R + 68 * MiB, WS_YP = WS_R + 306 * MiB, WS_END = WS_R + 442 * MiB;
static_assert(WS_W_END == 242 * MiB && WS_END == 748 * MiB, "ws map");
constexpr int CW_TMO = 0, CW_CODE = 1, CW_CHK = 2;
constexpr int CW_BAR = 4096;
constexpr int CW_MOECNT = 16384;
constexpr int CW_MOEOFF = 20480;

constexpr int LDS_BYTES = 159744;
constexpr int MISC_OFF = LDS_BYTES - 512;
constexpr int SCR_BYTES = MISC_OFF;

#define GAS __attribute__((address_space(1)))
#define LAS __attribute__((address_space(3)))
typedef unsigned short bf16;
typedef unsigned v4u __attribute__((ext_vector_type(4)));
typedef unsigned v2u __attribute__((ext_vector_type(2)));
typedef float f32x4 __attribute__((ext_vector_type(4)));
typedef float f32x16 __attribute__((ext_vector_type(16)));
typedef short bf16x8 __attribute__((ext_vector_type(8)));
typedef short s16x4 __attribute__((ext_vector_type(4)));
typedef GAS unsigned gu32;
#define RLX_AGENT __ATOMIC_RELAXED, __HIP_MEMORY_SCOPE_AGENT
#define LDS_WAIT() asm volatile("s_waitcnt lgkmcnt(0)" ::: "memory")
#define VM_WAIT() asm volatile("s_waitcnt vmcnt(0)" ::: "memory")
#define SBAR() __builtin_amdgcn_sched_barrier(0)
__device__ __forceinline__ int lane_id() { return (int)threadIdx.x & 63; }
__device__ __forceinline__ unsigned f2bf(float f) { unsigned u = __builtin_bit_cast(unsigned, f); return (u + 0x7fffu + ((u >> 16) & 1u)) >> 16; }
__device__ __forceinline__ unsigned pk2(float lo, float hi) { return f2bf(lo) | (f2bf(hi) << 16); }
__device__ __forceinline__ float bf2f(unsigned short b) { return __builtin_bit_cast(float, ((unsigned)b) << 16); }
__device__ __forceinline__ float bflo(unsigned w) { return __builtin_bit_cast(float, w << 16); }
__device__ __forceinline__ float bfhi(unsigned w) { return __builtin_bit_cast(float, w & 0xffff0000u); }
__device__ __forceinline__ unsigned cvtpk(float lo, float hi) { unsigned r; asm volatile("v_cvt_pk_bf16_f32 %0, %1, %2" : "=v"(r) : "v"(lo), "v"(hi)); return r; }
__device__ __forceinline__ float wave_sum(float v) {
#pragma unroll
    for (int o = 1; o < 64; o <<= 1) v += __shfl_xor(v, o);
    return v;
}
using pg8::fsigmoid; using pg8::gelu_tanh; using pg8::fsilu;
__device__ __forceinline__ float fsoftplus(float x) { return x > 20.f ? x : log1pf(__expf(x)); }

#define XB_TMO      128
#define XB_XCNT(j)  (256  + 64 * (j))
#define XB_XSUB(j)  (1280 + 64 * (j))
#define XB_XGEN(j)  (2304 + 64 * (j))
#define XB_TOP      3328
#define XB_TOPGEN   3392
#define XCD_BAR_WORDS 3456
#define XB_SPIN_CAP (1u << 18)

__device__ __forceinline__ unsigned xb_ld(unsigned* p)              { return __hip_atomic_load(p, __ATOMIC_RELAXED, __HIP_MEMORY_SCOPE_AGENT); }
__device__ __forceinline__ unsigned xb_add(unsigned* p, unsigned v) { return __hip_atomic_fetch_add(p, v, __ATOMIC_RELAXED, __HIP_MEMORY_SCOPE_AGENT); }
__device__ __forceinline__ unsigned xb_xcc_id() { return (unsigned)__builtin_amdgcn_s_getreg((3 << 11) | 20) & 0xFu; }
#define XB_SPIN(cond, bar) do { unsigned _sp = 0; while (cond) { __builtin_amdgcn_s_sleep(1); \
    if ((++_sp & 255u) == 0u) { if (xb_ld(&(bar)[XB_TMO])) break; if (_sp > XB_SPIN_CAP) { atomicAdd(&(bar)[XB_TMO], 1u); break; } } } } while (0)

struct XcdBarrier {
    unsigned* bar; unsigned x;
    volatile LAS unsigned* st;
};

__device__ __forceinline__ XcdBarrier xcd_barrier_post(unsigned* bar, volatile LAS unsigned* st) {
    XcdBarrier b; b.bar = bar; b.x = xb_xcc_id(); b.st = st;
    if (threadIdx.x == 0) (void)xb_add(&bar[XB_XCNT(b.x)], 1u);
    return b;
}
__device__ __forceinline__ void xcd_barrier_complete(unsigned* bar, unsigned x, unsigned& nloc, unsigned& nx) {
    const unsigned G = gridDim.x * gridDim.y * gridDim.z;
    unsigned sum, cnt, mine, sp = 0u;
    for (;;) {
        sum = 0u; cnt = 0u; mine = 0u;
#pragma unroll
        for (unsigned j = 0; j < 16; ++j) { const unsigned c = xb_ld(&bar[XB_XCNT(j)]); sum += c; cnt += (c > 0u) ? 1u : 0u; mine = (j == x) ? c : mine; }
        if (sum == G) break;
        __builtin_amdgcn_s_sleep(1);
        if ((++sp & 255u) == 0u) { if (xb_ld(&bar[XB_TMO])) break; if (sp > XB_SPIN_CAP) { atomicAdd(&bar[XB_TMO], 1u); break; } }
    }
    nloc = mine > 0u ? mine : 1u; nx = cnt > 0u ? cnt : 1u;
}

__device__ __forceinline__ void xcd_barrier(const XcdBarrier& b) {
    asm volatile("s_waitcnt vmcnt(0)" ::: "memory");
    __syncthreads();
    if (threadIdx.x == 0) {
        unsigned* bar = b.bar;
        __builtin_amdgcn_s_waitcnt(0);
        unsigned nloc = b.st[0], nx = b.st[1];
        if (nloc == 0u) { xcd_barrier_complete(bar, b.x, nloc, nx); b.st[0] = nloc; b.st[1] = nx; }
        const unsigned old = xb_add(&bar[XB_XSUB(b.x)], 1u);
        const unsigned gen = old / nloc;
        if (old + 1u == (gen + 1u) * nloc) {
            __builtin_amdgcn_fence(__ATOMIC_RELEASE, "agent");
            asm volatile("s_waitcnt vmcnt(0)" ::: "memory");
            const unsigned og = xb_add(&bar[XB_TOP], 1u);
            const unsigned tg = og / nx;
            if (og + 1u == (tg + 1u) * nx) xb_add(&bar[XB_TOPGEN], 1u);
            else XB_SPIN(xb_ld(&bar[XB_TOPGEN]) == tg, bar);
            __builtin_amdgcn_fence(__ATOMIC_ACQUIRE, "agent");
            xb_add(&bar[XB_XGEN(b.x)], 1u);
            asm volatile("s_waitcnt vmcnt(0)" ::: "memory");
        } else {
            XB_SPIN(xb_ld(&bar[XB_XGEN(b.x)]) == gen, bar);
            __builtin_amdgcn_fence(__ATOMIC_ACQUIRE, "agent");
            asm volatile("s_waitcnt vmcnt(0)" ::: "memory");
        }
    }
    __syncthreads();
}

struct Args { const float* in[41]; float* out; unsigned char* ws; int ph_lo, ph_hi, li, pad; };
struct Frame { LAS unsigned char* lds; volatile LAS unsigned* MISC; gu32* ctl; unsigned char* ws; int tid, lane, wave, G, bid; };
enum { I_X = 0, I_MEM, I_NMIX, I_NCROSS, I_NMEM, I_NFFN, I_EVWIN, I_RGCW, I_RGCB, I_RGWA, I_RGBA, I_RGWX, I_RGBX, I_RGLAM, I_GATEB, I_QNORM, I_KNORM, I_CMPPOS,
       I_CKW1, I_CKW2, I_CVW1, I_CVW2, I_EVWOUT, I_ODWIN, I_ODCW, I_ODCB, I_DTB, I_ALOG, I_DSKIP, I_ODNORM, I_ODWOUT, I_XWQ, I_XWKV, I_XQN, I_XKN, I_XWO,
       I_FFW13, I_FFW2, I_ROUTER, I_MW13, I_MW2, N_IN };
static_assert(N_IN == 41, "input count");

template <int MAP>
__device__ __forceinline__ void transpose_item(const float* W, int N, bf16* WT, int ldt, LAS float* scr, int kb, int nb, int lane, int ffs, const float* kg = nullptr) {
    const int k0 = 64 * kb, n0 = 64 * nb; const int c4 = (lane & 15) * 4, r4 = lane >> 4;
    f32x4 tv[16];
    if ((N & 3) == 0) {
#pragma unroll
        for (int i = 0; i < 16; ++i) { const int kk = 4 * i + r4; tv[i] = (n0 + c4 < N) ? *(const GAS f32x4*)(W + (size_t)(k0 + kk) * N + n0 + c4) : (f32x4){0.f, 0.f, 0.f, 0.f}; }
    } else {
#pragma unroll
        for (int i = 0; i < 16; ++i) { const int kk = 4 * i + r4; const float* src = W + (size_t)(k0 + kk) * N + n0 + c4;
#pragma unroll
            for (int j = 0; j < 4; ++j) tv[i][j] = (n0 + c4 + j < N) ? src[j] : 0.f; }
    }
#pragma unroll
    for (int i = 0; i < 16; ++i) { const int kk = 4 * i + r4; const float gk = kg ? kg[k0 + kk] : 1.f;
#pragma unroll
        for (int j = 0; j < 4; ++j) scr[kk * 65 + c4 + j] = tv[i][j] * gk; }
    LDS_WAIT(); asm volatile("" ::: "memory");
    const int c = lane & 7;
#pragma unroll
    for (int j = 0; j < 8; ++j) { const int nl = (lane >> 3) + 8 * j, n = n0 + nl; const LAS float* s = scr + (8 * c) * 65 + nl;
        v4u o; o.x = pk2(s[0 * 65], s[1 * 65]); o.y = pk2(s[2 * 65], s[3 * 65]); o.z = pk2(s[4 * 65], s[5 * 65]); o.w = pk2(s[6 * 65], s[7 * 65]);
        int row = n; if (MAP == 1) row = (n < ffs) ? pg8::swiglu_row(n, 0) : pg8::swiglu_row(n - ffs, 1);
        if (n < ((N + 31) & ~31)) *(GAS v4u*)(WT + (size_t)row * ldt + k0 + 8 * c) = o; }
    LDS_WAIT(); asm volatile("" ::: "memory");
}
constexpr int MOE_CONV_ITEMS = NEXP * (16 * 112 + 56 * 16);

__device__ __forceinline__ void rms_row_to_bf16(const float* xrow, const float* g, bf16* orow, int lane) {
    const GAS f32x4* xr = (const GAS f32x4*)xrow + lane; const GAS f32x4* gr = (const GAS f32x4*)g + lane;
    f32x4 v[4]; float s = 0.f;
#pragma unroll
    for (int j = 0; j < 4; ++j) { v[j] = xr[64 * j]; s += (v[j].x * v[j].x + v[j].y * v[j].y) + (v[j].z * v[j].z + v[j].w * v[j].w); }
    const float rstd = 1.f / sqrtf(wave_sum(s) * (1.f / D) + EPS);
    GAS unsigned long long* o8 = (GAS unsigned long long*)orow + lane;
#pragma unroll
    for (int j = 0; j < 4; ++j) { const f32x4 gg = gr[64 * j];
        o8[64 * j] = (unsigned long long)pk2(v[j].x * rstd * gg.x, v[j].y * rstd * gg.y) | ((unsigned long long)pk2(v[j].z * rstd * gg.z, v[j].w * rstd * gg.w) << 32); }
}
__device__ __forceinline__ void phase_rmsnorm(const Frame& F, const float* x, const float* g, bf16* xn, int rows) {
    const int gw = F.bid * NWAVES + F.wave, NGW = F.G * NWAVES;
    for (int m = gw; m < rows; m += NGW) rms_row_to_bf16(x + (size_t)m * D, g, xn + (size_t)m * D, F.lane);
}
#define TR_MAT(cnt_, W_, K_, N_, WT_, ldt_, MAPK_, ffs_, kg_) \
    if (r < (cnt_)) { const int nblk_ = ((N_) + 63) / 64; transpose_item<MAPK_>((W_), (N_), (WT_), (ldt_), scr, r / nblk_, r % nblk_, F.lane, (ffs_), (kg_)); continue; } r -= (cnt_);
constexpr int C_EVIN = 16 * 73, C_EVOUT = 32 * 16, C_CW1 = 64 * 4, C_ODIN = 16 * 81, C_ODOUT = 32 * 16, C_XQ = 16 * 8, C_XKV = 16 * 16, C_XO = 8 * 16, C_FF13 = 16 * 88, C_FF2 = 44 * 16;
constexpr int CONV_A = C_EVIN + 2 * C_XKV + 2 * C_CW1, CONV_B = C_EVOUT + 2 * C_XQ + 2 * C_XO + C_FF13 + C_FF2 + C_ODIN + C_ODOUT;
constexpr int CONV_ALL = CONV_A + CONV_B + MOE_CONV_ITEMS, CONV_Q = 4480, CONV_P2_END = CONV_ALL - 2 * CONV_Q;
__device__ __forceinline__ void convert_range(const Frame& F, const Args& a, int gw, int NGW, int it_lo, int it_hi) {
    LAS float* scr = (LAS float*)(F.lds + F.wave * 16640); unsigned char* ws = F.ws;
    for (int it = it_lo + gw; it < it_hi; it += NGW) {
        int r = it;
        TR_MAT(C_EVIN, a.in[I_EVWIN], D, EV_IN, (bf16*)(ws + WS_W_EVIN), D, 0, 0, nullptr)
        TR_MAT(C_XKV, a.in[I_XWKV], D, 1024, (bf16*)(ws + WS_W_XKV), D, 0, 0, nullptr)
        TR_MAT(C_XKV, a.in[I_XWKV] + (size_t)D * 1024, D, 1024, (bf16*)(ws + WS_W_XKV) + (size_t)1024 * D, D, 0, 0, nullptr)
        TR_MAT(C_CW1, a.in[I_CKW1], 4096, 256, (bf16*)(ws + WS_W_CK1), 4096, 0, 0, nullptr)
        TR_MAT(C_CW1, a.in[I_CVW1], 4096, 256, (bf16*)(ws + WS_W_CV1), 4096, 0, 0, nullptr)
        TR_MAT(C_EVOUT, a.in[I_EVWOUT], 2048, D, (bf16*)(ws + WS_W_EVOUT), 2048, 0, 0, nullptr)
        TR_MAT(C_XQ, a.in[I_XWQ], D, 512, (bf16*)(ws + WS_W_XQ), D, 0, 0, a.in[I_NCROSS])
        TR_MAT(C_XO, a.in[I_XWO], 512, D, (bf16*)(ws + WS_W_XO), 512, 0, 0, nullptr)
        TR_MAT(C_FF13, a.in[I_FFW13], D, 2 * FF, (bf16*)(ws + WS_W_FF13), D, 1, FF, a.in[I_NFFN])
        TR_MAT(C_FF2, a.in[I_FFW2], FF, D, (bf16*)(ws + WS_W_FF2), FF, 0, 0, nullptr)
        TR_MAT(C_ODIN, a.in[I_ODWIN], D, OD_IN, (bf16*)(ws + WS_W_ODIN), D, 0, 0, a.in[I_NMIX] + D)
        TR_MAT(C_ODOUT, a.in[I_ODWOUT], 2048, D, (bf16*)(ws + WS_W_ODOUT), 2048, 0, 0, nullptr)
        TR_MAT(C_XQ, a.in[I_XWQ] + (size_t)D * 512, D, 512, (bf16*)(ws + WS_W_XQ) + (size_t)512 * D, D, 0, 0, a.in[I_NCROSS] + D)
        TR_MAT(C_XO, a.in[I_XWO] + (size_t)512 * D, 512, D, (bf16*)(ws + WS_W_XO) + (size_t)D * 512, 512, 0, 0, nullptr)
        { constexpr int C_M13 = 16 * 112, C_M2 = 56 * 16;
          if (r < NEXP * C_M13) { const int e = r / C_M13, q = r % C_M13; transpose_item<1>(a.in[I_MW13] + (size_t)e * D * 2 * FFE, 2 * FFE, (bf16*)(ws + WS_W_M13) + (size_t)e * 2 * FFE * D, D, scr, q / 112, q % 112, F.lane, FFE); continue; } r -= NEXP * C_M13;
          { const int e = r / C_M2, q = r % C_M2; transpose_item<0>(a.in[I_MW2] + (size_t)e * FFE * D, D, (bf16*)(ws + WS_W_M2) + (size_t)e * D * FFE, FFE, scr, q / 16, q % 16, F.lane, 0); } }
    }
}
__device__ __forceinline__ void p0_prologue(const Frame& F, const Args& a) {
    const int gw = F.bid * NWAVES + F.wave, NGW = F.G * NWAVES;
    unsigned char* ws = F.ws;
    convert_range(F, a, gw, NGW, 0, CONV_A);
    for (int i = F.bid * NTHR + F.tid; i < 2 * 224 * 128; i += F.G * NTHR) { const int w = i / (224 * 128), q = i % (224 * 128);
        bf16* base = w == 0 ? (bf16*)(ws + WS_W_EVIN) + (size_t)4640 * D : (bf16*)(ws + WS_W_ODIN) + (size_t)5152 * D; *(GAS v4u*)(base + (size_t)q * 8) = (v4u){0u, 0u, 0u, 0u}; }
    phase_rmsnorm(F, a.in[I_X], a.in[I_NMIX], (bf16*)(ws + WS_XN), M);
    phase_rmsnorm(F, a.in[I_MEM], a.in[I_NMEM], (bf16*)(ws + WS_MEMN), MMEM);
    phase_rmsnorm(F, a.in[I_MEM], a.in[I_NMEM] + D, (bf16*)(ws + WS_MEMN) + (size_t)MMEM * D, MMEM);
    for (int i = F.bid * NTHR + F.tid; i < 512 * 128; i += F.G * NTHR) { const int n = i >> 7, j = i & 127; ((bf16*)(ws + WS_OV))[i] = (n <= 510 && n >= 4 * j - 1 && n <= 4 * j + 3) ? (bf16)0x3F80 : (bf16)0; }
    for (int it = gw; it < 128; it += NGW) { const int mm = it >> 6, ic = it & 63; const float* w1 = a.in[mm ? I_CVW1 : I_CKW1]; const float* pos = a.in[I_CMPPOS];
        f32x4 acc = {0.f, 0.f, 0.f, 0.f};
        for (int rr = 0; rr < 64; ++rr) { const int i = ic * 64 + rr; const float p = pos[i]; const f32x4 w = *(const GAS f32x4*)(w1 + (size_t)i * 256 + 4 * F.lane); acc += w * p; }
        *(GAS f32x4*)((float*)(ws + WS_CMPB_PART) + (size_t)(mm * 64 + ic) * 256 + 4 * F.lane) = acc; }
}
#undef TR_MAT
namespace att {
constexpr float SCALE = 0.08838834764831845f;
constexpr float THR = 8.f;
constexpr int KVBLK = 64, DH = 128;
constexpr int SHM_V = KVBLK * DH * 2, SHM_K = KVBLK * DH * 2;
constexpr int NSLOT = 3;
constexpr int LDS_ATT = NSLOT * SHM_V + NSLOT * SHM_K + NWAVES * 64 * 4;
#define KSWZ(row, colB) ((row) * 256 + ((colB) ^ (((row) & 7) << 4)))
__device__ __forceinline__ int v_st(int k, int c) { const int kk = (k & ~0xC) | ((k & 4) << 1) | ((k & 8) >> 1); return ((kk >> 3) * 4 + (c >> 5)) * 512 + ((kk & 7) * 32 + (c & 31)) * 2; }
__device__ __forceinline__ int v_rd_base(int lane) { return ((lane & 3) << 3) | (((lane >> 2) & 3) << 6) | (((lane >> 4) & 1) << 5) | (((lane >> 5) & 1) << 8); }
constexpr int v_rd_off(int d0, int ks, int half) { return d0 * 512 + ks * 4096 + half * 2048; }
__device__ __forceinline__ int crow(int r, int hi) { return (r & 3) + 8 * (r >> 2) + 4 * hi; }
__device__ __forceinline__ bf16x8 pack8(f32x4 a, f32x4 b) { v4u w = {cvtpk(a[0], a[1]), cvtpk(a[2], a[3]), cvtpk(b[0], b[1]), cvtpk(b[2], b[3])}; return *reinterpret_cast<bf16x8*>(&w); }

__device__ __forceinline__ void mask_tile(f32x16& p0, f32x16& p1, int dq, unsigned W) {
    asm volatile("" : "+v"(dq));
    const float NEG = -__builtin_inff();
#pragma unroll
    for (int r = 0; r < 16; ++r) { const int c = (r & 3) + 8 * (r >> 2);
        if ((unsigned)(dq - c) >= W) p0[r] = NEG;
        if ((unsigned)(dq - c - 32) >= W) p1[r] = NEG; }
}
__device__ __forceinline__ void mask_all(f32x16& p0, f32x16& p1) { const float NEG = -__builtin_inff();
#pragma unroll
    for (int r = 0; r < 16; ++r) { p0[r] = NEG; p1[r] = NEG; } }
__device__ __forceinline__ void partialSM(f32x16& p0, f32x16& p1, float& m_reg, float& mn, float& alpha, bool keep = true) {
    float pmax = p0[0];
#pragma unroll
    for (int r = 1; r < 16; ++r) pmax = fmaxf(pmax, p0[r]);
#pragma unroll
    for (int r = 0; r < 16; ++r) pmax = fmaxf(pmax, p1[r]);
    pmax = keep ? pmax : -__builtin_inff();
    { auto rr = __builtin_amdgcn_permlane32_swap(__float_as_uint(pmax), __float_as_uint(pmax), false, false);
      pmax = fmaxf(__uint_as_float(rr[0]), __uint_as_float(rr[1])); }
    constexpr float C2 = 1.4426950408889634f * SCALE;
    if (__builtin_expect(__all((pmax - m_reg) * SCALE <= THR), 1)) { mn = m_reg; alpha = 1.f; }
    else { mn = fmaxf(m_reg, pmax); alpha = __builtin_amdgcn_exp2f((m_reg - mn) * C2); m_reg = mn; }
    const float mnL = keep ? -mn * C2 : -__builtin_inff();
#pragma unroll
    for (int r = 0; r < 16; ++r) p0[r] = fmaf(p0[r], C2, mnL);
#pragma unroll
    for (int r = 0; r < 16; ++r) p1[r] = fmaf(p1[r], C2, mnL);
#pragma unroll
    for (int r = 0; r < 16; ++r) p0[r] = __builtin_amdgcn_exp2f(p0[r]);
}
__device__ __forceinline__ void finishSM(f32x16& p0, f32x16& p1, float alpha, float& l_reg, bf16x8& pa0, bf16x8& pa1, bf16x8& pa2, bf16x8& pa3) {
#pragma unroll
    for (int r = 0; r < 16; ++r) p1[r] = __builtin_amdgcn_exp2f(p1[r]);
    float ps = 0;
#pragma unroll
    for (int r = 0; r < 16; ++r) ps += p0[r];
#pragma unroll
    for (int r = 0; r < 16; ++r) ps += p1[r];
    { auto rr = __builtin_amdgcn_permlane32_swap(__float_as_uint(ps), __float_as_uint(ps), false, false);
      ps = __uint_as_float(rr[0]) + __uint_as_float(rr[1]); }
    l_reg = l_reg * alpha + ps;
#define PK4(P, B_, OUT) do { unsigned a0 = cvtpk(P[B_+0], P[B_+1]), a1 = cvtpk(P[B_+2], P[B_+3]);                          \
        unsigned b0 = cvtpk(P[B_+4], P[B_+5]), b1 = cvtpk(P[B_+6], P[B_+7]);                                             \
        auto r0 = __builtin_amdgcn_permlane32_swap(a0, b0, false, false); auto r1 = __builtin_amdgcn_permlane32_swap(a1, b1, false, false); \
        v4u w = {r0[0], r1[0], r0[1], r1[1]}; OUT = *reinterpret_cast<bf16x8*>(&w); } while (0)
    PK4(p0, 0, pa0); PK4(p0, 8, pa1); PK4(p1, 0, pa2); PK4(p1, 8, pa3);
#undef PK4
}
__device__ __forceinline__ void qkt(f32x16& p0, f32x16& p1, const char* Kslot, int r32, int hi, const bf16x8* qr) {
    p0 = f32x16{}; p1 = f32x16{};
    const char* kb[4];
#pragma unroll
    for (int dd = 0; dd < 4; ++dd) kb[dd] = Kslot + KSWZ(r32, (dd * 16 + hi * 8) * 2);
#pragma unroll
    for (int d0 = 0; d0 < 8; ++d0) { const char* a = kb[d0 & 3] + (d0 >> 2) * 128;
        bf16x8 b0 = *reinterpret_cast<const bf16x8*>(a);
        bf16x8 b1 = *reinterpret_cast<const bf16x8*>(a + 32 * 256);
        p0 = __builtin_amdgcn_mfma_f32_32x32x16_bf16(b0, qr[d0], p0, 0, 0, 0);
        p1 = __builtin_amdgcn_mfma_f32_32x32x16_bf16(b1, qr[d0], p1, 0, 0, 0); }
}
__device__ __forceinline__ void pv_tile(f32x16* o, int vbs, bf16x8 pa0, bf16x8 pa1, bf16x8 pa2, bf16x8 pa3) {
#define TRRD(dst, off) asm volatile("ds_read_b64_tr_b16 %0, %1 offset:%2" : "=&v"(dst) : "v"(vbs), "i"(off) : "memory")
#define PV_D0(d0) do { s16x4 l0, l1, l2, l3, h0, h1, h2, h3; constexpr int b_ = v_rd_off(d0, 0, 0); \
        TRRD(l0, b_); TRRD(h0, b_ + 2048); TRRD(l1, b_ + 4096); TRRD(h1, b_ + 6144); TRRD(l2, b_ + 8192); TRRD(h2, b_ + 10240); TRRD(l3, b_ + 12288); TRRD(h3, b_ + 14336); \
        asm volatile("s_waitcnt lgkmcnt(0)" ::: "memory"); SBAR();   \
        o[d0] = __builtin_amdgcn_mfma_f32_32x32x16_bf16(pa0, (bf16x8){l0[0], l0[1], l0[2], l0[3], h0[0], h0[1], h0[2], h0[3]}, o[d0], 0, 0, 0);   \
        o[d0] = __builtin_amdgcn_mfma_f32_32x32x16_bf16(pa1, (bf16x8){l1[0], l1[1], l1[2], l1[3], h1[0], h1[1], h1[2], h1[3]}, o[d0], 0, 0, 0);   \
        o[d0] = __builtin_amdgcn_mfma_f32_32x32x16_bf16(pa2, (bf16x8){l2[0], l2[1], l2[2], l2[3], h2[0], h2[1], h2[2], h2[3]}, o[d0], 0, 0, 0);   \
        o[d0] = __builtin_amdgcn_mfma_f32_32x32x16_bf16(pa3, (bf16x8){l3[0], l3[1], l3[2], l3[3], h3[0], h3[1], h3[2], h3[3]}, o[d0], 0, 0, 0); } while (0)
    PV_D0(0); PV_D0(1); PV_D0(2); PV_D0(3);
#undef PV_D0
#undef TRRD
}
__device__ __forceinline__ void q_issue(const bf16* qrow, int hi, v4u (&raw)[8]) {
#pragma unroll
    for (int d0 = 0; d0 < 8; ++d0) raw[d0] = *(const GAS v4u*)(qrow + d0 * 16 + hi * 8);
}
__device__ __forceinline__ void q_finish(const v4u (&raw)[8], const float* g, int hi, bf16x8* qr) {
    float ss = 0.f;
#pragma unroll
    for (int d0 = 0; d0 < 8; ++d0)
#pragma unroll
        for (int j = 0; j < 4; ++j) { const float a = bflo(raw[d0][j]), b = bfhi(raw[d0][j]); ss += a * a + b * b; }
    ss += __shfl_xor(ss, 32);
    const float rstd = 1.f / sqrtf(ss * (1.f / 128.f) + EPS);
#pragma unroll
    for (int d0 = 0; d0 < 8; ++d0) { const f32x4 g0 = *(const GAS f32x4*)(g + d0 * 16 + hi * 8), g1 = *(const GAS f32x4*)(g + d0 * 16 + hi * 8 + 4);
        v4u w; w.x = cvtpk(bflo(raw[d0][0]) * rstd * g0[0], bfhi(raw[d0][0]) * rstd * g0[1]); w.y = cvtpk(bflo(raw[d0][1]) * rstd * g0[2], bfhi(raw[d0][1]) * rstd * g0[3]);
        w.z = cvtpk(bflo(raw[d0][2]) * rstd * g1[0], bfhi(raw[d0][2]) * rstd * g1[1]); w.w = cvtpk(bflo(raw[d0][3]) * rstd * g1[2], bfhi(raw[d0][3]) * rstd * g1[3]);
        qr[d0] = *reinterpret_cast<bf16x8*>(&w); }
}
__device__ __forceinline__ void load_q(const bf16* qrow, const float* g, int hi, bf16x8* qr) { v4u raw[8]; q_issue(qrow, hi, raw); q_finish(raw, g, hi, qr); }
struct PassIO { const bf16* Kp; int ldk; const bf16* Vp; int ldv; int t_lo, t_hi; };
__device__ __forceinline__ void dma_offsets(int wid, int lane, int ldk, int ldv, unsigned& koff, unsigned& voff) {
    const int row = 4 * wid + (lane >> 4); koff = (unsigned)(row * ldk * 2 + (((lane & 15) ^ (row & 7)) << 4));
    const int st = 2 * wid + (lane >> 5), kk = ((st >> 2) << 3) | ((lane & 31) >> 2), k = (kk & ~0xC) | ((kk & 4) << 1) | ((kk & 8) >> 1); voff = (unsigned)(k * ldv * 2 + ((st & 3) * 32 + 8 * (lane & 3)) * 2);
}
#define ATT_DMA(io_, t, slot) do { const char* kt_ = (const char*)(io_).Kp + (size_t)(t) * (KVBLK * 2) * (io_).ldk; const char* vt_ = (const char*)(io_).Vp + (size_t)(t) * (KVBLK * 2) * (io_).ldv;          \
        LAS unsigned* kd_ = (LAS unsigned*)(ldsl + NSLOT * SHM_V + (slot) * SHM_K + wid * 1024); LAS unsigned* vd_ = (LAS unsigned*)(ldsl + (slot) * SHM_V + wid * 1024);                \
        __builtin_amdgcn_global_load_lds((const unsigned*)(kt_ + koff), kd_, 16, 0, 0); __builtin_amdgcn_global_load_lds((const unsigned*)(kt_ + koff + (size_t)64 * (io_).ldk), kd_ + 2048, 16, 0, 0); \
        __builtin_amdgcn_global_load_lds((const unsigned*)(vt_ + voff), vd_, 16, 0, 0); __builtin_amdgcn_global_load_lds((const unsigned*)(vt_ + voff + (size_t)64 * (io_).ldv), vd_ + 2048, 16, 0, 0); } while (0)
__device__ __forceinline__ void attn_prefetch(char* lds, const PassIO& io) {
    int tid = threadIdx.x; asm volatile("" : "+v"(tid));
    const int wid = __builtin_amdgcn_readfirstlane(tid >> 6), lane = tid & 63;
    unsigned koff, voff; dma_offsets(wid, lane, io.ldk, io.ldv, koff, voff);
    LAS unsigned char* ldsl = (LAS unsigned char*)lds;
    ATT_DMA(io, io.t_lo, 0); if (io.t_hi - io.t_lo > 1) ATT_DMA(io, io.t_lo + 1, 1);
}
template <class MaskF>
__device__ __forceinline__ void attn_pass(char* lds, const bf16x8* qr, const PassIO& io, const MaskF& mf, f32x16 (&o)[4], float& l_out) {
    int tid = threadIdx.x; asm volatile("" : "+v"(tid));
    const int wid = __builtin_amdgcn_readfirstlane(tid >> 6), lane = tid & 63, r32 = lane & 31, hi = lane >> 5;
    char* V_lds = lds; char* K_lds = lds + NSLOT * SHM_V;
    float* wsc = (float*)(lds + NSLOT * SHM_V + NSLOT * SHM_K) + wid * 64; float* al_l = wsc + 32;
    float m_reg = -1e30f, l_reg = 0.f;
#pragma unroll
    for (int d = 0; d < 4; ++d) o[d] = f32x16{};
    const int vb0 = (int)(uintptr_t)V_lds + v_rd_base(lane);
    const int t_lo = io.t_lo, NT = io.t_hi - io.t_lo;
    unsigned koff, voff; dma_offsets(wid, lane, io.ldk, io.ldv, koff, voff);
    LAS unsigned char* ldsl = (LAS unsigned char*)lds;
    f32x16 p0, p1; float mn, alpha = 1.f; bf16x8 pa0, pa1, pa2, pa3;
#define A_RESC(a) do { if (__any((a) < 1.f)) { if (hi == 0) al_l[r32] = (a); asm volatile("s_waitcnt lgkmcnt(0)" ::: "memory"); \
        _Pragma("unroll") for (int d_ = 0; d_ < 4; ++d_) _Pragma("unroll") for (int r = 0; r < 16; ++r) o[d_][r] *= al_l[crow(r, hi)]; } } while (0)
#define A_BAR() do { asm volatile("" ::: "memory"); __builtin_amdgcn_s_barrier(); asm volatile("" ::: "memory"); } while (0)
    const bool lead = wid < 4;
    VM_WAIT();
    __syncthreads();
    if (!lead) A_BAR();
    int sK = 0, sV = 2, sW = 1;
    bool act_prev = false;
    for (int i = 0; i < NT; ++i) {
        if (lead && i >= 1 && i + 1 < NT) ATT_DMA(io, t_lo + i + 1, sW);
        const bool act = mf.active(t_lo + i);
        SBAR(); if (act) qkt(p0, p1, K_lds + sK * SHM_K, r32, hi, qr);
        if (i > 0 && act_prev) pv_tile(o, vb0 + sV * SHM_V, pa0, pa1, pa2, pa3);
        if (!lead && i + 1 < NT) VM_WAIT();
        A_BAR();
        if (!lead && i + 2 < NT) ATT_DMA(io, t_lo + i + 2, sV);
        if (act) { mf(p0, p1, t_lo + i); partialSM(p0, p1, m_reg, mn, alpha, mf.keep(t_lo + i)); A_RESC(alpha); finishSM(p0, p1, alpha, l_reg, pa0, pa1, pa2, pa3); }
        act_prev = act;
        if (lead && i + 1 < NT) VM_WAIT();
        A_BAR();
        { const int t_ = sV; sV = sK; sK = sW; sW = t_; }
    }
    if (act_prev) pv_tile(o, vb0 + sV * SHM_V, pa0, pa1, pa2, pa3);
    if (lead) A_BAR();
    __syncthreads();
#undef A_RESC
#undef A_BAR
    l_out = l_reg;
}
__device__ __forceinline__ void row_inv_l(char* lds, float l_reg, float (&rli)[16]) {
    const int tid = threadIdx.x, wid = __builtin_amdgcn_readfirstlane(tid >> 6), lane = tid & 63, r32 = lane & 31, hi = lane >> 5;
    float* wsc = (float*)(lds + NSLOT * SHM_V + NSLOT * SHM_K) + wid * 64;
    if (hi == 0) wsc[r32] = l_reg;
    asm volatile("s_waitcnt lgkmcnt(0)" ::: "memory");
#pragma unroll
    for (int r = 0; r < 16; ++r) { const float l = wsc[crow(r, hi)]; rli[r] = l > 0.f ? __builtin_amdgcn_rcpf(l) : 0.f; }
    asm volatile("s_waitcnt lgkmcnt(0)" ::: "memory");
}
struct NoMask { __device__ __forceinline__ void operator()(f32x16&, f32x16&, int) const {} __device__ __forceinline__ bool active(int) const { return true; } __device__ __forceinline__ bool keep(int) const { return true; } };
}
__device__ __forceinline__ void norm128_rows(const Frame& F, const bf16* src, size_t lds_, bf16* dst, size_t ldd, int nrows, const float* g, int gw, int NGW) {
    const int sub = F.lane >> 4, l16 = F.lane & 15;
    const f32x4 g0 = *(const GAS f32x4*)(g + l16 * 8), g1 = *(const GAS f32x4*)(g + l16 * 8 + 4);
    for (int r0 = gw * 4; r0 < nrows; r0 += NGW * 4) { const int r = r0 + sub;
        const v4u raw = *(const GAS v4u*)(src + (size_t)r * lds_ + l16 * 8);
        float ss = 0.f;
#pragma unroll
        for (int j = 0; j < 4; ++j) { const float a = bflo(raw[j]), b = bfhi(raw[j]); ss += a * a + b * b; }
        ss += __shfl_xor(ss, 1); ss += __shfl_xor(ss, 2); ss += __shfl_xor(ss, 4); ss += __shfl_xor(ss, 8);
        const float rstd = 1.f / sqrtf(ss * (1.f / 128.f) + EPS);
        v4u w; w.x = cvtpk(bflo(raw[0]) * rstd * g0[0], bfhi(raw[0]) * rstd * g0[1]); w.y = cvtpk(bflo(raw[1]) * rstd * g0[2], bfhi(raw[1]) * rstd * g0[3]);
        w.z = cvtpk(bflo(raw[2]) * rstd * g1[0], bfhi(raw[2]) * rstd * g1[1]); w.w = cvtpk(bflo(raw[3]) * rstd * g1[2], bfhi(raw[3]) * rstd * g1[3]);
        *(GAS v4u*)(dst + (size_t)r * ldd + l16 * 8) = w; }
}
__device__ __forceinline__ void phase_memk_norm(const Frame& F, const Args& a, int l, int gw, int NGW) {
    const bf16* kvm = (const bf16*)(F.ws + WS_KVM) + (size_t)l * MMEM * 1024; bf16* km = (bf16*)(F.ws + WS_KM) + (size_t)l * MMEM * 512;
    for (int bh = 0; bh < BATCH * XH; ++bh) { const int b = bh >> 2, h = bh & 3;
        norm128_rows(F, kvm + (size_t)b * MEMLEN * 1024 + h * 128, 1024, km + (size_t)bh * MEMLEN * 128, 128, MEMLEN, a.in[I_XKN] + l * 128, gw, NGW); }
}

__device__ __forceinline__ void phase_cross_attn(const Frame& F, const Args& a, int l) {
    char* lds = (char*)F.lds; const int r32 = F.lane & 31, hi = F.lane >> 5;
    const bf16* QX = (const bf16*)(F.ws + WS_QX); bf16* OX = (bf16*)(F.ws + WS_OX);
    for (int u = F.bid; u < BATCH * XH * (SEQ / 256); u += F.G) {
        const int tb = u % (SEQ / 256), bh = u / (SEQ / 256), b = bh >> 2, h = bh & 3;
        const size_t row0 = (size_t)b * SEQ + tb * 256 + F.wave * 32;
        const bf16* Kp = (const bf16*)(F.ws + WS_KM) + (size_t)l * MMEM * 512 + (size_t)bh * MEMLEN * 128;
        const bf16* Vp = (const bf16*)(F.ws + WS_KVM) + (size_t)l * MMEM * 1024 + (size_t)b * MEMLEN * 1024 + 512 + h * 128;
        const att::PassIO io{Kp, 128, Vp, 1024, 0, MEMLEN / 64}; att::attn_prefetch(lds, io);
        bf16x8 qr[8]; att::load_q(QX + (row0 + r32) * 512 + h * 128, a.in[I_XQN] + l * 128, hi, qr);
        f32x16 o[4]; float l_reg; att::attn_pass(lds, qr, io, att::NoMask{}, o, l_reg);
        float rli[16]; att::row_inv_l(lds, l_reg, rli);
#pragma unroll
        for (int r = 0; r < 16; ++r) { bf16* orow = OX + (row0 + att::crow(r, hi)) * 512 + h * 128;
#pragma unroll
            for (int d0 = 0; d0 < 4; ++d0) { const float v = o[d0][r] * rli[r]; const float vn = __shfl_xor(v, 1);
                if ((r32 & 1) == 0) *(GAS unsigned*)(orow + d0 * 32 + r32) = cvtpk(v, vn); } }
    }
}

constexpr int NSA_GSC = att::LDS_ATT, NSA_IMP = NSA_GSC + NWAVES * 32 * 3 * 4, NSA_SEL = NSA_IMP + NWAVES * 8 * 128 * 4, NSA_SELU = NSA_SEL + 64 * 4 * 4, NSA_LDS_END = NSA_SELU + NWAVES * 4 * 4;
static_assert(NSA_LDS_END <= SCR_BYTES, "nsa lds");
struct CmpMask { int nmax, hi, nmin_wave;
    __device__ __forceinline__ void operator()(f32x16& p0, f32x16& p1, int t) const { if (t * 64 + 63 <= nmin_wave) return; att::mask_tile(p0, p1, nmax - t * 64 - 4 * hi, 0x40000000u); }
    __device__ __forceinline__ bool active(int) const { return true; } __device__ __forceinline__ bool keep(int) const { return true; } };
struct WinMask { int P, hi, qb;
    __device__ __forceinline__ void operator()(f32x16& p0, f32x16& p1, int t) const { if (t == qb || t == qb - 8) att::mask_tile(p0, p1, P - t * 64 - 4 * hi, 512u); }
    __device__ __forceinline__ bool active(int) const { return true; } __device__ __forceinline__ bool keep(int) const { return true; } };
struct SlcMask { const LAS unsigned* selw; const LAS unsigned* uni; int P, hi, qb;
    __device__ __forceinline__ void operator()(f32x16& p0, f32x16& p1, int t) const { if (t == qb) att::mask_tile(p0, p1, P - t * 64 - 4 * hi, 0x40000000u); }
    __device__ __forceinline__ bool keep(int t) const { return (selw[t >> 5] >> (t & 31)) & 1u; }
    __device__ __forceinline__ bool active(int t) const { return (__builtin_amdgcn_readfirstlane(uni[t >> 5]) >> (t & 31)) & 1u; } };

__device__ __forceinline__ void nsa_unit(const Frame& F, const Args& a, int b, int g, int qb, int dry = 0) {
    char* lds = (char*)F.lds; const int w = F.wave; const int t0 = qb * 64;
#define NSA_LANE() int lane = F.lane; asm volatile("" : "+v"(lane)); const int r32 = lane & 31, hi = lane >> 5; const int tok = 8 * w + (r32 >> 2), head = 4 * g + (r32 & 3), P = t0 + tok; (void)head; (void)P; (void)tok
    unsigned char* wsl = F.ws; asm volatile("" : "+s"(wsl));
    const bf16* Y0 = (const bf16*)(wsl + WS_Y0); const bf16* KV6 = (const bf16*)(wsl + WS_KV6);
    const size_t slab = (size_t)SEQ * 128, bg = (size_t)(b * 2 + g);
    LAS float* gsc = (LAS float*)(F.lds + NSA_GSC) + w * 96; LAS float* imp = (LAS float*)(F.lds + NSA_IMP) + w * 1024; LAS unsigned* selm = (LAS unsigned*)(F.lds + NSA_SEL);
    { NSA_LANE();
      if (hi == 0) {
#pragma unroll
        for (int br = 0; br < 3; ++br) gsc[r32 * 3 + br] = fsigmoid(bf2f(Y0[((size_t)b * SEQ + P) * EV_INP + 4608 + head * 3 + br]) + a.in[I_GATEB][head * 3 + br]); }
      LDS_WAIT(); }
    f32x16 o[4]; float l_reg; float rli[16];
    const bf16* KCMP = (const bf16*)(wsl + WS_KVCMP) + bg * 512 * 128; const bf16* VCMP = (const bf16*)(wsl + WS_KVCMP) + (size_t)2048 * 128 + bg * 512 * 128;
    const int ncmp_t = ((4 * qb + 2) >> 6) + 1;
    const att::PassIO io_imp{KCMP, 128, (const bf16*)(wsl + WS_OV), 128, 0, ncmp_t}, io_cmp{KCMP, 128, VCMP, 128, 0, ncmp_t},
                      io_slc{KV6 + (2 * 4 + bg) * slab, 128, KV6 + (3 * 4 + bg) * slab, 128, 0, qb + 1}, io_win{KV6 + (4 * 4 + bg) * slab, 128, KV6 + (5 * 4 + bg) * slab, 128, qb >= 8 ? qb - 8 : 0, qb + 1};
    v4u qraw[8];
#define NSA_QISSUE() do { NSA_LANE(); att::q_issue(Y0 + ((size_t)b * SEQ + P) * EV_INP + 2048 + head * 128, hi, qraw); } while (0)
    att::attn_prefetch(lds, io_imp); NSA_QISSUE();
    { NSA_LANE(); const CmpMask cm{(P - 31) >> 4, hi, (t0 + 8 * w - 31) >> 4};
      bf16x8 qr[8]; att::q_finish(qraw, a.in[I_QNORM], hi, qr);
      if (dry < 2) att::attn_pass(lds, qr, io_imp, cm, o, l_reg); else { VM_WAIT(); __syncthreads(); l_reg = 1.f; } }
    att::attn_prefetch(lds, io_cmp); NSA_QISSUE();
    if (dry < 3) {
    att::row_inv_l(lds, l_reg, rli);
    { NSA_LANE();
#pragma unroll
    for (int q = 0; q < 4; ++q)
#pragma unroll
        for (int d = 0; d < 4; ++d) { float s = 0.f;
#pragma unroll
            for (int i = 0; i < 4; ++i) s += o[d][4 * q + i] * rli[4 * q + i];
            imp[(2 * q + hi) * 128 + d * 32 + r32] = s; }
    LDS_WAIT();
    { const unsigned long long lt = (1ull << lane) - 1ull;
#pragma unroll 1
    for (int tl = 0; tl < 8; ++tl) { unsigned k0, k1;
        { const int j0 = lane, j1 = lane + 64; const float v0 = imp[tl * 128 + j0], v1 = imp[tl * 128 + j1];
          const float s0 = v0 + (((j0 == 0) || (j0 == qb) || (j0 == qb - 1)) ? 100.f : 0.f), s1 = v1 + (((j1 == 0) || (j1 == qb) || (j1 == qb - 1)) ? 100.f : 0.f);
          k0 = (j0 <= qb) ? __float_as_uint(s0) + 1u : 0u; k1 = (j1 <= qb) ? __float_as_uint(s1) + 1u : 0u; }
        unsigned T = 0u;
#pragma unroll 1
        for (int bit = 30; bit >= 0; --bit) { const unsigned cand = T | (1u << bit);
            const int cnt = __popcll(__ballot(k0 >= cand)) + __popcll(__ballot(k1 >= cand)); if (cnt >= 16) T = cand; }
        const unsigned long long g0 = __ballot(k0 > T), g1 = __ballot(k1 > T), e0 = __ballot(k0 == T), e1 = __ballot(k1 == T);
        const int need = 16 - (__popcll(g0) + __popcll(g1));
        const bool sel0 = (k0 > T) || (k0 == T && __popcll(e0 & lt) < need), sel1 = (k1 > T) || (k1 == T && __popcll(e0) + __popcll(e1 & lt) < need);
        const unsigned long long m0 = __ballot(sel0 && lane <= qb), m1 = __ballot(sel1 && lane + 64 <= qb);
        if (lane == 0) { LAS unsigned* sw = selm + (8 * w + tl) * 4; sw[0] = (unsigned)m0; sw[1] = (unsigned)(m0 >> 32); sw[2] = (unsigned)m1; sw[3] = (unsigned)(m1 >> 32); } } }
    LDS_WAIT();
    if (lane < 4) { unsigned u = 0;
#pragma unroll
        for (int tl = 0; tl < 8; ++tl) u |= selm[(8 * w + tl) * 4 + lane];
        ((LAS unsigned*)(F.lds + NSA_SELU))[w * 4 + lane] = u; }
    LDS_WAIT(); }
    }
    { NSA_LANE(); const CmpMask cm{(P - 31) >> 4, hi, (t0 + 8 * w - 31) >> 4};
      bf16x8 qr[8]; att::q_finish(qraw, a.in[I_QNORM], hi, qr);
#if defined(MK_NSA_DUP) && MK_NSA_DUP == 2
      att::attn_pass(lds, qr, io_cmp, cm, o, l_reg); att::attn_prefetch(lds, io_cmp);
#endif
      if (dry < 2) att::attn_pass(lds, qr, io_cmp, cm, o, l_reg); else { VM_WAIT(); __syncthreads(); l_reg = 1.f; } }
    att::attn_prefetch(lds, io_slc); NSA_QISSUE();
    att::row_inv_l(lds, l_reg, rli);
    unsigned oacc[4][8];
    if (dry < 4) { NSA_LANE();
#pragma unroll
    for (int r = 0; r < 16; ++r) rli[r] *= gsc[att::crow(r, hi) * 3 + 0];
#pragma unroll
    for (int d = 0; d < 4; ++d)
#pragma unroll
        for (int r = 0; r < 16; r += 2) oacc[d][r >> 1] = cvtpk(o[d][r] * rli[r], o[d][r + 1] * rli[r + 1]); }
    { NSA_LANE(); const SlcMask sm{selm + tok * 4, (const LAS unsigned*)(F.lds + NSA_SELU) + w * 4, P, hi, qb};
      bf16x8 qr[8]; att::q_finish(qraw, a.in[I_QNORM], hi, qr);
#if defined(MK_NSA_DUP) && MK_NSA_DUP == 5
      { const size_t bg2 = (bg + 1) & 3; const att::PassIO io_cold{KV6 + (2 * 4 + bg2) * slab, 128, KV6 + (3 * 4 + bg2) * slab, 128, 0, qb + 1};
        att::attn_pass(lds, qr, io_cold, sm, o, l_reg); att::attn_prefetch(lds, io_slc); }
#endif
#if defined(MK_NSA_DUP) && MK_NSA_DUP == 3
      att::attn_pass(lds, qr, io_slc, sm, o, l_reg); att::attn_prefetch(lds, io_slc);
#endif
      if (!dry) att::attn_pass(lds, qr, io_slc, sm, o, l_reg); else { VM_WAIT(); __syncthreads(); } }
    att::attn_prefetch(lds, io_win); NSA_QISSUE();
    att::row_inv_l(lds, l_reg, rli);
    if (dry < 4) { NSA_LANE();
#pragma unroll
    for (int r = 0; r < 16; ++r) rli[r] *= gsc[att::crow(r, hi) * 3 + 1];
#pragma unroll
    for (int d = 0; d < 4; ++d)
#pragma unroll
        for (int r = 0; r < 16; r += 2) oacc[d][r >> 1] = cvtpk(bflo(oacc[d][r >> 1]) + o[d][r] * rli[r], bfhi(oacc[d][r >> 1]) + o[d][r + 1] * rli[r + 1]); }
    { NSA_LANE(); const WinMask wm{P, hi, qb};
      bf16x8 qr[8]; att::q_finish(qraw, a.in[I_QNORM], hi, qr);
#if defined(MK_NSA_DUP) && MK_NSA_DUP == 4
      att::attn_pass(lds, qr, io_win, wm, o, l_reg); att::attn_prefetch(lds, io_win);
#endif
      if (dry < 2) att::attn_pass(lds, qr, io_win, wm, o, l_reg); else { VM_WAIT(); __syncthreads(); l_reg = 1.f; } }
    att::row_inv_l(lds, l_reg, rli);
    if (dry < 4) { NSA_LANE();
    bf16* MIX = dry ? (bf16*)(wsl + WS_R + 400 * MiB) : (bf16*)(wsl + WS_MIX);
#pragma unroll
    for (int r = 0; r < 16; ++r) rli[r] *= gsc[att::crow(r, hi) * 3 + 2];
    bf16* obase = MIX + ((size_t)b * SEQ + t0 + 8 * w) * 2048 + 1024 + 4 * g * 128 + r32;
#pragma unroll
    for (int d0 = 0; d0 < 4; ++d0) {
#pragma unroll
        for (int r = 0; r < 16; ++r) { const int row = att::crow(r, hi); const float v = ((r & 1) ? bfhi(oacc[d0][r >> 1]) : bflo(oacc[d0][r >> 1])) + o[d0][r] * rli[r]; const float vn = __shfl_xor(v, 1);
            if ((r32 & 1) == 0) *(GAS unsigned*)(obase + (size_t)(row >> 2) * 2048 + (row & 3) * 128 + d0 * 32) = cvtpk(v, vn); }
        } }
    __syncthreads();
#undef NSA_QISSUE
#undef NSA_LANE
}
__device__ __forceinline__ void phase_nsa(const Frame& F, const Args& a) {
#pragma unroll 1
    for (int it = F.bid * 2; it < 512; it += F.G * 2)
#pragma unroll 1
        for (int k = 0; k < 2; ++k) { const int p = it >> 1, xcd = p & 7, bg = xcd >> 1, x = (xcd & 1) * 32 + (p >> 3);
#if defined(MK_NSA_DRY)
            nsa_unit(F, a, bg >> 1, bg & 1, k == 0 ? 127 - x : x, MK_NSA_DRY);
#endif
            nsa_unit(F, a, bg >> 1, bg & 1, k == 0 ? 127 - x : x); }
}
__device__ __forceinline__ f32x4 mma16(const LAS bf16* A, int pa, const LAS bf16* B, int pb, int K, f32x4 acc, int fr, int fq) {
    for (int k0 = 0; k0 < K; k0 += 32) { const bf16x8 af = *(const LAS bf16x8*)(A + fr * pa + k0 + 8 * fq); const bf16x8 bfv = *(const LAS bf16x8*)(B + fr * pb + k0 + 8 * fq);
        acc = __builtin_amdgcn_mfma_f32_16x16x32_bf16(af, bfv, acc, 0, 0, 0); }
    return acc;
}

__device__ __forceinline__ void phase_cmp2(const Frame& F, const Args& a, int u_lo, int u_hi, int u_step) {
    LAS bf16* hidS = (LAS bf16*)F.lds; LAS bf16* w2T = (LAS bf16*)(F.lds + 32 * 264 * 2); LAS float* outS = (LAS float*)(F.lds + 32 * 264 * 2 + 128 * 264 * 2);
    const int fr = F.lane & 15, fq = F.lane >> 4;
    for (int u = u_lo; u < u_hi; u += u_step) { const int mm = u >> 6, rb = u & 63;
        const bf16* hid = (const bf16*)(F.ws + WS_HID) + (size_t)mm * 2048 * 256 + (size_t)rb * 32 * 256; const float* w2 = a.in[mm ? I_CVW2 : I_CKW2];
        for (int i = F.tid; i < 32 * 32; i += NTHR) { const int r = i >> 5, c8 = i & 31; *(LAS v4u*)(hidS + r * 264 + c8 * 8) = *(const GAS v4u*)(hid + r * 256 + c8 * 8); }
        for (int i = F.tid; i < 256 * 128; i += NTHR) { const int k = i >> 7, c = i & 127; w2T[c * 264 + k] = (bf16)f2bf(w2[i]); }
        __syncthreads();
        const int rt = F.wave & 1;
#pragma unroll
        for (int cc = 0; cc < 2; ++cc) { const int ct = (F.wave >> 1) * 2 + cc; f32x4 acc = {0.f, 0.f, 0.f, 0.f};
            acc = mma16(hidS + rt * 16 * 264, 264, w2T + ct * 16 * 264, 264, 256, acc, fr, fq);
#pragma unroll
            for (int e = 0; e < 4; ++e) outS[(rt * 16 + 4 * fq + e) * 132 + ct * 16 + fr] = acc[e]; }
        __syncthreads();
        { const int r = F.wave * 4 + (F.lane >> 4), l16 = F.lane & 15; const int grow = rb * 32 + r, n = grow & 511;
          float v[8]; float ss = 0.f;
#pragma unroll
          for (int j = 0; j < 8; ++j) { v[j] = outS[r * 132 + l16 * 8 + j]; ss += v[j] * v[j]; }
          ss += __shfl_xor(ss, 1); ss += __shfl_xor(ss, 2); ss += __shfl_xor(ss, 4); ss += __shfl_xor(ss, 8);
          if (mm == 0) { const float rstd = 1.f / sqrtf(ss * (1.f / 128.f) + EPS); const float* g = a.in[I_KNORM];
#pragma unroll
              for (int j = 0; j < 8; ++j) v[j] = v[j] * rstd * g[l16 * 8 + j]; }
          if (n == 511) {
#pragma unroll
              for (int j = 0; j < 8; ++j) v[j] = 0.f; }
          v4u w; w.x = cvtpk(v[0], v[1]); w.y = cvtpk(v[2], v[3]); w.z = cvtpk(v[4], v[5]); w.w = cvtpk(v[6], v[7]);
          *(GAS v4u*)((bf16*)(F.ws + WS_KVCMP) + (size_t)mm * 2048 * 128 + (size_t)grow * 128 + l16 * 8) = w; }
        __syncthreads();
    }
}

__device__ __forceinline__ void rglru_unit(const Frame& F, const Args& a, int b, int h, int s) {
    const int w = F.wave, lane = F.lane, fr = lane & 15, fq = lane >> 4;
    LAS bf16* xcs = (LAS bf16*)F.lds + w * (16 * 136); LAS float* summ = (LAS float*)(F.lds + 8 * 16 * 136 * 2);
    const bf16* Y0 = (const bf16*)(F.ws + WS_Y0) + (size_t)b * SEQ * EV_INP; bf16* MIX = (bf16*)(F.ws + WS_MIX) + (size_t)b * SEQ * 2048;
    const int ch = h * 128 + s * 16 + fr;
    bf16x8 ba_f[4], bx_f[4];
    { const float* wa = a.in[I_RGWA] + (size_t)h * 128 * 128 + s * 16 + fr; const float* wx = a.in[I_RGWX] + (size_t)h * 128 * 128 + s * 16 + fr;
#pragma unroll
      for (int kk = 0; kk < 4; ++kk) { v4u ua, ux;
#pragma unroll
          for (int e2 = 0; e2 < 4; ++e2) { const int k = 32 * kk + 8 * fq + 2 * e2; ua[e2] = pk2(wa[(size_t)k * 128], wa[(size_t)(k + 1) * 128]); ux[e2] = pk2(wx[(size_t)k * 128], wx[(size_t)(k + 1) * 128]); }
          ba_f[kk] = *reinterpret_cast<bf16x8*>(&ua); bx_f[kk] = *reinterpret_cast<bf16x8*>(&ux); } }
    const float bias_a = a.in[I_RGBA][ch], bias_x = a.in[I_RGBX][ch], c8 = -8.f * fsoftplus(-a.in[I_RGLAM][ch]);
    const int cg = h * 128 + 2 * lane; float cw0[4], cw1[4];
#pragma unroll
    for (int j = 0; j < 4; ++j) { cw0[j] = a.in[I_RGCW][j * 1024 + cg]; cw1[j] = a.in[I_RGCW][j * 1024 + cg + 1]; }
    const float cb0 = a.in[I_RGCB][cg], cb1 = a.in[I_RGCB][cg + 1];
    float carry = 0.f;
    unsigned raw[19];
#define RG_LOAD(c_) do { const int T0_ = (c_) * 128 + 16 * w; _Pragma("unroll") for (int i = 0; i < 19; ++i) { const int t = T0_ - 3 + i; raw[i] = (t >= 0) ? *(const GAS unsigned*)(Y0 + (size_t)t * EV_INP + cg) : 0u; } } while (0)
    RG_LOAD(0);
#ifdef MK_DUP_RG
    for (int cc = 0; cc < 2 * (SEQ / 128); ++cc) { const int c = cc & (SEQ / 128 - 1); if (cc == SEQ / 128) { carry = 0.f; RG_LOAD(0); }
#else
    for (int c = 0; c < SEQ / 128; ++c) {
#endif
        const int T0 = c * 128 + 16 * w;
#pragma unroll
        for (int tt = 0; tt < 16; ++tt) { float y0 = cb0, y1 = cb1;
#pragma unroll
            for (int j = 0; j < 4; ++j) { y0 += cw0[j] * bflo(raw[tt + j]); y1 += cw1[j] * bfhi(raw[tt + j]); }
            *(LAS unsigned*)(xcs + tt * 136 + 2 * lane) = cvtpk(y0, y1); }
        LDS_WAIT();
        if (c + 1 < SEQ / 128) RG_LOAD(c + 1);
        unsigned short gg[4];
#pragma unroll
        for (int e = 0; e < 4; ++e) gg[e] = Y0[(size_t)(T0 + 4 * fq + e) * EV_INP + 1024 + ch];
        f32x4 acc_a = {0.f, 0.f, 0.f, 0.f}, acc_x = {0.f, 0.f, 0.f, 0.f};
#pragma unroll
        for (int kk = 0; kk < 4; ++kk) { const bf16x8 af = *(const LAS bf16x8*)(xcs + fr * 136 + 32 * kk + 8 * fq);
            acc_a = __builtin_amdgcn_mfma_f32_16x16x32_bf16(af, ba_f[kk], acc_a, 0, 0, 0); acc_x = __builtin_amdgcn_mfma_f32_16x16x32_bf16(af, bx_f[kk], acc_x, 0, 0, 0); }
        float hl[4], pl[4]; float hh = 0.f, pp = 1.f;
#pragma unroll
        for (int e = 0; e < 4; ++e) { const float xv = bf2f(xcs[(4 * fq + e) * 136 + s * 16 + fr]);
            const float r = fsigmoid(acc_a[e] + bias_a), ig = fsigmoid(acc_x[e] + bias_x); const float la = c8 * r; const float av = __expf(la);
            const float uu = __builtin_amdgcn_sqrtf((1.f - av) * (1.f + av)) * (ig * xv);
            hh = av * hh + uu; pp *= av; hl[e] = hh; pl[e] = pp; }
        float Apre = 1.f, Hpre = 0.f, Aw = 1.f, Hw = 0.f;
#pragma unroll
        for (int q = 0; q < 4; ++q) { const float Aq = __shfl(pp, fr + 16 * q), Hq = __shfl(hh, fr + 16 * q);
            if (q < fq) { Hpre = Aq * Hpre + Hq; Apre *= Aq; }
            Hw = Aq * Hw + Hq; Aw *= Aq; }
        LAS float* sm = summ + (c & 1) * 256;
        if (fq == 0) { sm[(w * 16 + fr) * 2] = Aw; sm[(w * 16 + fr) * 2 + 1] = Hw; }
        __syncthreads();
        float cin = carry, call = carry;
#pragma unroll
        for (int q = 0; q < 8; ++q) { const float Aq = sm[(q * 16 + fr) * 2], Hq = sm[(q * 16 + fr) * 2 + 1]; call = Aq * call + Hq; if (q < w) cin = call; }
        carry = call;
        const float cl = Apre * cin + Hpre;
#pragma unroll
        for (int e = 0; e < 4; ++e) { const float hv = hl[e] + pl[e] * cl; MIX[(size_t)(T0 + 4 * fq + e) * 2048 + ch] = (bf16)f2bf(gelu_tanh(bf2f(gg[e])) * hv); }
    }
#undef RG_LOAD
    __syncthreads();
}
constexpr size_t WS_M_CN = WS_R + 168 * MiB + 64 * MiB;
constexpr size_t WS_M_BN = WS_M_CN + 16 * MiB, WS_M_BT = WS_M_BN + 16 * MiB, WS_M_XT = WS_M_BT + 16 * MiB, WS_M_ACS = WS_M_XT + 64 * MiB, WS_M_DTV = WS_M_ACS + 2 * MiB,
                 WS_M_ST = WS_M_DTV + 2 * MiB, WS_M_PV = WS_M_ST + 128 * MiB, WS_M_END = WS_M_PV + 64 * MiB;
static_assert(WS_M_END <= WS_R + 560 * MiB, "mamba ws");
constexpr int MB_P = 136;
__device__ __forceinline__ void conv4_silu(const v4u (&rows)[7], const float* cw, int ldw, const float* cb, float (&out)[4][8]) {
    float wv[4][8], bv[8];
#pragma unroll
    for (int j = 0; j < 4; ++j) { const f32x4 w0 = *(const GAS f32x4*)(cw + (size_t)j * ldw), w1 = *(const GAS f32x4*)(cw + (size_t)j * ldw + 4);
#pragma unroll
        for (int i = 0; i < 4; ++i) { wv[j][i] = w0[i]; wv[j][4 + i] = w1[i]; } }
    { const f32x4 b0 = *(const GAS f32x4*)cb, b1 = *(const GAS f32x4*)(cb + 4);
#pragma unroll
      for (int i = 0; i < 4; ++i) { bv[i] = b0[i]; bv[4 + i] = b1[i]; } }
#pragma unroll
    for (int tt = 0; tt < 4; ++tt)
#pragma unroll
        for (int i2 = 0; i2 < 4; ++i2) { float y0 = bv[2 * i2], y1 = bv[2 * i2 + 1];
#pragma unroll
            for (int j = 0; j < 4; ++j) { y0 += wv[j][2 * i2] * bflo(rows[tt + j][i2]); y1 += wv[j][2 * i2 + 1] * bfhi(rows[tt + j][i2]); }
            out[tt][2 * i2] = fsilu(y0); out[tt][2 * i2 + 1] = fsilu(y1); }
}
__device__ __forceinline__ void phase_mamba_prep(const Frame& F, const Args& a) {
    LAS bf16* T = (LAS bf16*)F.lds;
    LAS float* acsS = (LAS float*)(F.lds + 128 * MB_P * 2); LAS float* dtS = acsS + 256;
    const int tid = F.tid, lane = F.lane, w = F.wave, sg = tid >> 4, cv = tid & 15;
    const float* cw = a.in[I_ODCW]; const float* cb = a.in[I_ODCB];
    v4u rows[7];
#define M0_LOAD(u_) do { const int bc_ = (u_) / 24, sl_ = (u_) % 24, T0_ = (bc_ & 63) * 128; const bf16* Y1_ = (const bf16*)(F.ws + WS_Y1) + (size_t)(bc_ >> 6) * SEQ * OD_INP; \
        _Pragma("unroll") for (int i = 0; i < 7; ++i) { const int t = T0_ + 4 * sg - 3 + i; rows[i] = (t >= 0) ? *(const GAS v4u*)(Y1_ + (size_t)t * OD_INP + 2048 + sl_ * 128 + cv * 8) : (v4u){0u, 0u, 0u, 0u}; } } while (0)
    if (F.bid < 128 * 24) M0_LOAD(F.bid);
    for (int u = F.bid; u < 128 * 24; u += F.G) { const int bc = u / 24, sl = u % 24, b = bc >> 6, c = bc & 63, T0 = c * 128;
        const bf16* Y1 = (const bf16*)(F.ws + WS_Y1) + (size_t)b * SEQ * OD_INP; const int ch0 = sl * 128;
        { float vals[4][8];
          conv4_silu(rows, cw + ch0 + cv * 8, 3072, cb + ch0 + cv * 8, vals);
          if (u + F.G < 128 * 24) M0_LOAD(u + F.G);
#pragma unroll
          for (int tt = 0; tt < 4; ++tt) { v4u o; o.x = cvtpk(vals[tt][0], vals[tt][1]); o.y = cvtpk(vals[tt][2], vals[tt][3]); o.z = cvtpk(vals[tt][4], vals[tt][5]); o.w = cvtpk(vals[tt][6], vals[tt][7]);
              *(LAS v4u*)(T + (4 * sg + tt) * MB_P + cv * 8) = o; } }
        if (sl < 16 && w < 2) { const int h = 2 * sl + w;
            const float Ah = -__expf(a.in[I_ALOG][h]), dtb = a.in[I_DTB][h];
            const float d0 = fsoftplus(bf2f(Y1[(size_t)(T0 + 2 * lane) * OD_INP + 5120 + h]) + dtb), d1 = fsoftplus(bf2f(Y1[(size_t)(T0 + 2 * lane + 1) * OD_INP + 5120 + h]) + dtb);
            const float a0 = d0 * Ah, a1 = d1 * Ah; float pr = a0 + a1;
#pragma unroll
            for (int off = 1; off < 64; off <<= 1) { const float t = __shfl_up(pr, off); if (lane >= off) pr += t; }
            const float ex = pr - (a0 + a1); const float c0 = ex + a0, c1 = ex + a0 + a1;
            acsS[w * 128 + 2 * lane] = c0; acsS[w * 128 + 2 * lane + 1] = c1; dtS[w * 128 + 2 * lane] = d0; dtS[w * 128 + 2 * lane + 1] = d1;
            float* ACS = (float*)(F.ws + WS_M_ACS) + ((size_t)bc * 32 + h) * 128; float* DTV = (float*)(F.ws + WS_M_DTV) + ((size_t)bc * 32 + h) * 128;
            typedef float f32x2v __attribute__((ext_vector_type(2))); *(GAS f32x2v*)(ACS + 2 * lane) = (f32x2v){c0, c1}; *(GAS f32x2v*)(DTV + 2 * lane) = (f32x2v){d0, d1}; }
        __syncthreads();
        if (sl < 16) {
            const int cc = tid >> 2, s0 = (tid & 3) * 32, hh = cc >> 6; bf16* XT = (bf16*)(F.ws + WS_M_XT) + (((size_t)bc * 32 + 2 * sl) * 64 + cc) * 128 + s0;
#pragma unroll
            for (int k8 = 0; k8 < 4; ++k8) { float v[8];
#pragma unroll
                for (int k = 0; k < 8; ++k) { const int s = s0 + 8 * k8 + k; v[k] = bf2f(T[s * MB_P + cc]) * dtS[hh * 128 + s]; }
                v4u o; o.x = cvtpk(v[0], v[1]); o.y = cvtpk(v[2], v[3]); o.z = cvtpk(v[4], v[5]); o.w = cvtpk(v[6], v[7]); *(GAS v4u*)(XT + 8 * k8) = o; } }
        else { const int g = (sl - 16) & 3; const bool isB = sl < 20;
            bf16* N = (bf16*)(F.ws + (isB ? WS_M_BN : WS_M_CN)) + ((size_t)b * SEQ + T0) * 512 + g * 128;
            for (int i = tid; i < 128 * 16; i += NTHR) { const int s = i >> 4, c8 = i & 15; *(GAS v4u*)(N + (size_t)s * 512 + c8 * 8) = *(const LAS v4u*)(T + s * MB_P + c8 * 8); }
            if (isB) { const int cc = tid >> 2, s0 = (tid & 3) * 32; bf16* BT = (bf16*)(F.ws + WS_M_BT) + (((size_t)bc * 4 + g) * 128 + cc) * 128 + s0;
#pragma unroll
                for (int k8 = 0; k8 < 4; ++k8) { unsigned short v[8];
#pragma unroll
                    for (int k = 0; k < 8; ++k) v[k] = T[(s0 + 8 * k8 + k) * MB_P + cc];
                    v4u o; o.x = v[0] | ((unsigned)v[1] << 16); o.y = v[2] | ((unsigned)v[3] << 16); o.z = v[4] | ((unsigned)v[5] << 16); o.w = v[6] | ((unsigned)v[7] << 16); *(GAS v4u*)(BT + 8 * k8) = o; } } }
        __syncthreads();
    }
#undef M0_LOAD
}
__device__ __forceinline__ void phase_mamba_states(const Frame& F) {
    LAS bf16* BTs = (LAS bf16*)F.lds; LAS bf16* XW = (LAS bf16*)(F.lds + 128 * MB_P * 2);
    const int tid = F.tid, lane = F.lane, w = F.wave, fr = lane & 15, fq = lane >> 4;
    for (int u = F.bid; u < 128 * 4; u += F.G) { const int bc = u >> 2, g = u & 3;
        const bf16* BT = (const bf16*)(F.ws + WS_M_BT) + ((size_t)bc * 4 + g) * 128 * 128;
        for (int i = tid; i < 128 * 16; i += NTHR) { const int n = i >> 4, c8 = i & 15; *(LAS v4u*)(BTs + n * MB_P + c8 * 8) = *(const GAS v4u*)(BT + (size_t)n * 128 + c8 * 8); }
#pragma unroll 1
        for (int hh = 0; hh < 8; ++hh) { const int h = g * 8 + hh;
            const bf16* XT = (const bf16*)(F.ws + WS_M_XT) + ((size_t)bc * 32 + h) * 64 * 128; const float* ACS = (const float*)(F.ws + WS_M_ACS) + ((size_t)bc * 32 + h) * 128;
            const float aL = ACS[127];
#pragma unroll
            for (int k = 0; k < 2; ++k) { const int i = tid + k * NTHR, p = i >> 4, c8 = i & 15; const v4u raw = *(const GAS v4u*)(XT + (size_t)p * 128 + c8 * 8);
                const f32x4 a0 = *(const GAS f32x4*)(ACS + c8 * 8), a1 = *(const GAS f32x4*)(ACS + c8 * 8 + 4);
                v4u o; o.x = cvtpk(bflo(raw[0]) * __expf(aL - a0[0]), bfhi(raw[0]) * __expf(aL - a0[1])); o.y = cvtpk(bflo(raw[1]) * __expf(aL - a0[2]), bfhi(raw[1]) * __expf(aL - a0[3]));
                o.z = cvtpk(bflo(raw[2]) * __expf(aL - a1[0]), bfhi(raw[2]) * __expf(aL - a1[1])); o.w = cvtpk(bflo(raw[3]) * __expf(aL - a1[2]), bfhi(raw[3]) * __expf(aL - a1[3]));
                *(LAS v4u*)(XW + p * MB_P + c8 * 8) = o; }
            __syncthreads();
            float* ST = (float*)(F.ws + WS_M_ST) + ((size_t)bc * 32 + h) * 64 * 128;
#pragma unroll
            for (int pt = 0; pt < 4; ++pt) { f32x4 acc = {0.f, 0.f, 0.f, 0.f}; acc = mma16(XW + pt * 16 * MB_P, MB_P, BTs + w * 16 * MB_P, MB_P, 128, acc, fr, fq);
#pragma unroll
                for (int e = 0; e < 4; ++e) ST[(size_t)(pt * 16 + 4 * fq + e) * 128 + w * 16 + fr] = acc[e]; }
            __syncthreads();
        }
    }
}
__device__ __forceinline__ void phase_mamba_scan(const Frame& F) {
    const int gt = F.bid * NTHR + F.tid;
    for (int i = gt; i < BATCH * 32 * 64 * 32; i += F.G * NTHR) { const int n4 = i & 31, p = (i >> 5) & 63, h = (i >> 11) & 31, b = i >> 16;
        f32x4 S = {0.f, 0.f, 0.f, 0.f};
#pragma unroll 4
        for (int c = 0; c < 64; ++c) { const size_t bc = (size_t)b * 64 + c; const size_t off = ((bc * 32 + h) * 64 + p) * 128 + n4 * 4;
            const f32x4 st = *(const GAS f32x4*)((const float*)(F.ws + WS_M_ST) + off); const float dec = __expf(((const float*)(F.ws + WS_M_ACS))[(bc * 32 + h) * 128 + 127]);
            v2u o; o.x = cvtpk(S[0], S[1]); o.y = cvtpk(S[2], S[3]); *(GAS v2u*)((bf16*)(F.ws + WS_M_PV) + off) = o;
            S = S * dec + st; } }
}
constexpr int M3_CS = 0, M3_BS = M3_CS + 128 * MB_P * 2, M3_MS = M3_BS + 128 * MB_P * 2, M3_XT = M3_MS + 128 * MB_P * 2, M3_PV = M3_XT + 64 * MB_P * 2, M3_ACS = M3_PV + 64 * MB_P * 2, M3_DT = M3_ACS + 512, M3_END = M3_DT + 512;
static_assert(M3_END <= SCR_BYTES, "mamba lds");
__device__ __forceinline__ void phase_mamba_out(const Frame& F, const Args& a) {
    LAS bf16* Cs = (LAS bf16*)(F.lds + M3_CS); LAS bf16* Bs = (LAS bf16*)(F.lds + M3_BS); LAS bf16* Ms = (LAS bf16*)(F.lds + M3_MS); LAS bf16* XTs = (LAS bf16*)(F.lds + M3_XT); LAS bf16* PVs = (LAS bf16*)(F.lds + M3_PV);
    LAS float* acs = (LAS float*)(F.lds + M3_ACS); LAS float* dtv = (LAS float*)(F.lds + M3_DT);
    const int tid = F.tid, lane = F.lane, w = F.wave, fr = lane & 15, fq = lane >> 4;
    for (int u = F.bid; u < 128 * 4; u += F.G) { const int bc = u >> 2, g = u & 3, b = bc >> 6, T0 = (bc & 63) * 128;
        const bf16* CN = (const bf16*)(F.ws + WS_M_CN) + ((size_t)b * SEQ + T0) * 512 + g * 128; const bf16* BN = (const bf16*)(F.ws + WS_M_BN) + ((size_t)b * SEQ + T0) * 512 + g * 128;
        for (int i = tid; i < 128 * 16; i += NTHR) { const int s = i >> 4, c8 = i & 15;
            *(LAS v4u*)(Cs + s * MB_P + c8 * 8) = *(const GAS v4u*)(CN + (size_t)s * 512 + c8 * 8); *(LAS v4u*)(Bs + s * MB_P + c8 * 8) = *(const GAS v4u*)(BN + (size_t)s * 512 + c8 * 8); }
        __syncthreads();
        f32x4 cbt[8];
#pragma unroll
        for (int st = 0; st < 8; ++st) { cbt[st] = (f32x4){0.f, 0.f, 0.f, 0.f}; if (st <= w) cbt[st] = mma16(Bs + st * 16 * MB_P, MB_P, Cs + w * 16 * MB_P, MB_P, 128, cbt[st], fr, fq); }
        const bf16* Y1 = (const bf16*)(F.ws + WS_Y1) + ((size_t)b * SEQ + T0) * OD_INP; bf16* YG = (bf16*)(F.ws + WS_YG) + ((size_t)b * SEQ + T0) * 2048;
        v4u pfx[2], pfp[2]; float pfa = 0.f, pfd = 0.f;
#define M3_PREFETCH(hh_) do { const int h_ = g * 8 + (hh_); const bf16* XT_ = (const bf16*)(F.ws + WS_M_XT) + ((size_t)bc * 32 + h_) * 64 * 128; const bf16* PV_ = (const bf16*)(F.ws + WS_M_PV) + ((size_t)bc * 32 + h_) * 64 * 128; \
            _Pragma("unroll") for (int k = 0; k < 2; ++k) { const int i = tid + k * NTHR, p = i >> 4, c8 = i & 15; pfx[k] = *(const GAS v4u*)(XT_ + (size_t)p * 128 + c8 * 8); pfp[k] = *(const GAS v4u*)(PV_ + (size_t)p * 128 + c8 * 8); } \
            if (tid < 128) { pfa = ((const float*)(F.ws + WS_M_ACS))[((size_t)bc * 32 + h_) * 128 + tid]; pfd = ((const float*)(F.ws + WS_M_DTV))[((size_t)bc * 32 + h_) * 128 + tid]; } } while (0)
        M3_PREFETCH(0);
#pragma unroll 1
        for (int hh = 0; hh < 8; ++hh) { const int h = g * 8 + hh; const float dsk = a.in[I_DSKIP][h];
#pragma unroll
            for (int k = 0; k < 2; ++k) { const int i = tid + k * NTHR, p = i >> 4, c8 = i & 15; *(LAS v4u*)(XTs + p * MB_P + c8 * 8) = pfx[k]; *(LAS v4u*)(PVs + p * MB_P + c8 * 8) = pfp[k]; }
            if (tid < 128) { acs[tid] = pfa; dtv[tid] = pfd; }
            __syncthreads();
            if (hh + 1 < 8) M3_PREFETCH(hh + 1);
            unsigned short zz[4][4];
#pragma unroll
            for (int pt = 0; pt < 4; ++pt)
#pragma unroll
                for (int e = 0; e < 4; ++e) zz[pt][e] = Y1[(size_t)(16 * w + 4 * fq + e) * OD_INP + h * 64 + pt * 16 + fr];
            const float aq = acs[16 * w + fr];
#pragma unroll
            for (int st = 0; st < 8; ++st) { if (st <= w) { float mv[4];
#pragma unroll
                for (int e = 0; e < 4; ++e) { const int s = 16 * st + 4 * fq + e; mv[e] = (s <= 16 * w + fr) ? cbt[st][e] * __expf(aq - acs[s]) : 0.f; }
                v2u o; o.x = cvtpk(mv[0], mv[1]); o.y = cvtpk(mv[2], mv[3]); *(LAS v2u*)(Ms + (16 * w + fr) * MB_P + 16 * st + 4 * fq) = o; } }
            if ((w & 1) == 0) *(LAS v2u*)(Ms + (16 * w + fr) * MB_P + 16 * (w + 1) + 4 * fq) = (v2u){0u, 0u};
            LDS_WAIT();
#pragma unroll
            for (int pt = 0; pt < 4; ++pt) { f32x4 yd = {0.f, 0.f, 0.f, 0.f}, yo = {0.f, 0.f, 0.f, 0.f};
                yd = mma16(Ms + w * 16 * MB_P, MB_P, XTs + pt * 16 * MB_P, MB_P, ((w + 2) >> 1) * 32, yd, fr, fq);
                yo = mma16(Cs + w * 16 * MB_P, MB_P, PVs + pt * 16 * MB_P, MB_P, 128, yo, fr, fq);
#pragma unroll
                for (int e = 0; e < 4; ++e) { const int q = 16 * w + 4 * fq + e, p = pt * 16 + fr;
                    const float xs = bf2f(XTs[p * MB_P + q]) * __builtin_amdgcn_rcpf(dtv[q]);
                    const float y = yd[e] + __expf(acs[q]) * yo[e] + dsk * xs;
                    YG[(size_t)q * 2048 + h * 64 + p] = (bf16)f2bf(y * fsilu(bf2f(zz[pt][e]))); } }
            __syncthreads();
        }
#undef M3_PREFETCH
        VM_WAIT(); __syncthreads();
        { const float* gn = a.in[I_ODNORM] + g * 512 + lane * 8; const f32x4 g0 = *(const GAS f32x4*)gn, g1 = *(const GAS f32x4*)(gn + 4);
#pragma unroll 4
          for (int t = 0; t < 16; ++t) { bf16* pq = YG + (size_t)(16 * w + t) * 2048 + g * 512 + lane * 8; const v4u raw = *(const GAS v4u*)pq; float ss = 0.f;
#pragma unroll
              for (int j = 0; j < 4; ++j) { const float x0 = bflo(raw[j]), x1 = bfhi(raw[j]); ss += x0 * x0 + x1 * x1; }
              const float rstd = 1.f / sqrtf(wave_sum(ss) * (1.f / 512.f) + EPS);
              v4u o; o.x = cvtpk(bflo(raw[0]) * rstd * g0[0], bfhi(raw[0]) * rstd * g0[1]); o.y = cvtpk(bflo(raw[1]) * rstd * g0[2], bfhi(raw[1]) * rstd * g0[3]);
              o.z = cvtpk(bflo(raw[2]) * rstd * g1[0], bfhi(raw[2]) * rstd * g1[1]); o.w = cvtpk(bflo(raw[3]) * rstd * g1[2], bfhi(raw[3]) * rstd * g1[3]);
              *(GAS v4u*)pq = o; } }
    }
}
__device__ __forceinline__ void phase_group_norm(const Frame& F, const Args& a) {
    const int gw = F.bid * NWAVES + F.wave, NGW = F.G * NWAVES; bf16* YG = (bf16*)(F.ws + WS_YG); const float* g = a.in[I_ODNORM];
    for (int m = gw; m < M; m += NGW) {
#pragma unroll
        for (int gi = 0; gi < 4; ++gi) { bf16* p = YG + (size_t)m * 2048 + gi * 512 + F.lane * 8; const v4u raw = *(const GAS v4u*)p; float ss = 0.f;
#pragma unroll
            for (int j = 0; j < 4; ++j) { const float x0 = bflo(raw[j]), x1 = bfhi(raw[j]); ss += x0 * x0 + x1 * x1; }
            const float rstd = 1.f / sqrtf(wave_sum(ss) * (1.f / 512.f) + EPS);
            const f32x4 g0 = *(const GAS f32x4*)(g + gi * 512 + F.lane * 8), g1 = *(const GAS f32x4*)(g + gi * 512 + F.lane * 8 + 4);
            v4u o; o.x = cvtpk(bflo(raw[0]) * rstd * g0[0], bfhi(raw[0]) * rstd * g0[1]); o.y = cvtpk(bflo(raw[1]) * rstd * g0[2], bfhi(raw[1]) * rstd * g0[3]);
            o.z = cvtpk(bflo(raw[2]) * rstd * g1[0], bfhi(raw[2]) * rstd * g1[1]); o.w = cvtpk(bflo(raw[3]) * rstd * g1[2], bfhi(raw[3]) * rstd * g1[3]);
            *(GAS v4u*)p = o; }
    }
}
constexpr int MOE_TAB = 131072;
static_assert(MOE_TAB + (32 + MOE_TILES + 24) * 4 <= SCR_BYTES, "moe lds");
__device__ __forceinline__ void phase_route(const Frame& F, const Args& a, const float* x) {
    LAS int* cntS = (LAS int*)F.lds;
    if (F.tid < 8) cntS[F.tid] = 0;
    __syncthreads();
    const float* g = a.in[I_NFFN] + D; const float* router = a.in[I_ROUTER]; bf16* XN = (bf16*)(F.ws + WS_XN);
    int* tokE = (int*)(F.ws + WS_MOEIDX); float* tokW = (float*)(F.ws + WS_MOEIDX + 1 * MiB);
    const int per = M / F.G;
    for (int i = F.wave; i < per; i += NWAVES) { const int m = F.bid * per + i;
        const GAS f32x4* xr = (const GAS f32x4*)(x + (size_t)m * D) + F.lane; const GAS f32x4* gr = (const GAS f32x4*)g + F.lane;
        f32x4 v[4]; float s = 0.f;
#pragma unroll
        for (int j = 0; j < 4; ++j) { v[j] = xr[64 * j]; s += (v[j].x * v[j].x + v[j].y * v[j].y) + (v[j].z * v[j].z + v[j].w * v[j].w); }
        const float rstd = 1.f / sqrtf(wave_sum(s) * (1.f / D) + EPS);
        float lg[8];
#pragma unroll
        for (int e = 0; e < 8; ++e) lg[e] = 0.f;
        GAS unsigned long long* o8 = (GAS unsigned long long*)(XN + (size_t)m * D) + F.lane;
#pragma unroll
        for (int j = 0; j < 4; ++j) { const f32x4 gg = gr[64 * j]; f32x4 hn = v[j] * rstd * gg;
            o8[64 * j] = (unsigned long long)pk2(hn.x, hn.y) | ((unsigned long long)pk2(hn.z, hn.w) << 32);
#pragma unroll
            for (int q = 0; q < 4; ++q) { const int k = 256 * j + 4 * F.lane + q; const f32x4 r0 = *(const GAS f32x4*)(router + (size_t)k * 8), r1 = *(const GAS f32x4*)(router + (size_t)k * 8 + 4);
#pragma unroll
                for (int e = 0; e < 4; ++e) { lg[e] += hn[q] * r0[e]; lg[4 + e] += hn[q] * r1[e]; } } }
#pragma unroll
        for (int e = 0; e < 8; ++e) lg[e] = wave_sum(lg[e]);
        int e1 = 0; float v1 = lg[0];
#pragma unroll
        for (int e = 1; e < 8; ++e) if (lg[e] > v1) { v1 = lg[e]; e1 = e; }
        int e2 = (e1 + 1) & 7; float v2 = -3.0e38f;
#pragma unroll
        for (int e = 0; e < 8; ++e) if (e != e1 && lg[e] > v2) { v2 = lg[e]; e2 = e; }
        if (F.lane == 0) { const float w1 = 1.f / (1.f + __expf(v2 - v1)); tokE[2 * m] = e1; tokE[2 * m + 1] = e2; tokW[2 * m] = w1; tokW[2 * m + 1] = 1.f - w1;
            atomicAdd((int*)cntS + e1, 1); atomicAdd((int*)cntS + e2, 1); }
    }
    __syncthreads();
    if (F.tid < 8) ((int*)(F.ctl + CW_MOECNT))[F.bid * 8 + F.tid] = cntS[F.tid];
    __syncthreads();
}
__device__ __forceinline__ void moe_layout(const Frame& F) {
    LAS int* tab = (LAS int*)(F.lds + MOE_TAB); const int* cnt = (const int*)(F.ctl + CW_MOECNT);
    if (F.tid < 16) tab[F.tid < 8 ? F.tid : 32 + MOE_TILES + F.tid] = 0;
    __syncthreads();
    { const int e = F.tid & 7; int tot = 0, pre = 0;
      for (int wg = F.tid >> 3; wg < F.G; wg += NTHR / 8) { const int c = cnt[wg * 8 + e]; tot += c; if (wg < F.bid) pre += c; }
      atomicAdd((int*)tab + e, tot); atomicAdd((int*)tab + 32 + MOE_TILES + 8 + e, pre); }
    __syncthreads();
    if (F.tid == 0) { int row = 0, tl = 0; for (int e = 0; e < 8; ++e) { const int nt = (tab[e] + 255) >> 8; tab[8 + e] = row; tab[16 + e] = nt; for (int i = 0; i < nt; ++i) tab[32 + tl + i] = e; tl += nt; row += nt * 256; } tab[24] = tl; }
    __syncthreads();
}
__device__ __forceinline__ void phase_scatter(const Frame& F) {
    moe_layout(F);
    LAS int* tab = (LAS int*)(F.lds + MOE_TAB); LAS int* slotS = (LAS int*)F.lds;
    const int per = M / F.G;
    const int* tokE = (const int*)(F.ws + WS_MOEIDX); int* tokS = (int*)(F.ws + WS_MOEIDX + 2 * MiB);
    if (F.wave == 0) { const int E0 = tokE[(size_t)F.bid * per * 2 + F.lane], E1 = tokE[(size_t)F.bid * per * 2 + 64 + F.lane]; int s0 = 0, s1 = 0;
        const unsigned long long lt = (1ull << F.lane) - 1ull;
#pragma unroll
        for (int e = 0; e < 8; ++e) { const unsigned long long m0 = __ballot(E0 == e), m1 = __ballot(E1 == e); const int base = tab[8 + e] + tab[32 + MOE_TILES + 8 + e];
            if (E0 == e) s0 = base + __popcll(m0 & lt); if (E1 == e) s1 = base + __popcll(m0) + __popcll(m1 & lt); }
        slotS[F.lane] = s0; slotS[64 + F.lane] = s1; tokS[(size_t)F.bid * per * 2 + F.lane] = s0; tokS[(size_t)F.bid * per * 2 + 64 + F.lane] = s1; }
    __syncthreads();
    const bf16* XN = (const bf16*)(F.ws + WS_XN); bf16* XP = (bf16*)(F.ws + WS_XP);
    for (int i = F.wave; i < per * 2; i += NWAVES) { const int m = F.bid * per + (i >> 1); const int sl = slotS[i];
        const GAS v4u* src = (const GAS v4u*)(XN + (size_t)m * D) + F.lane; GAS v4u* dst = (GAS v4u*)(XP + (size_t)sl * D) + F.lane;
        dst[0] = src[0]; dst[64] = src[64]; }
    __syncthreads();
}
struct MoeOrder {
    int nN, nwg, G, c; const LAS int* texp;
    __device__ __forceinline__ bool next(int i, pg8::Unit& u) const { const long L = (long)i * G + c; if (L >= nwg) return false; u.pm = (int)(L / nN); u.pn = (int)(L % nN); u.bn = texp[u.pm] * nN + u.pn; u.idx = i; return true; }
    __device__ __forceinline__ void a_ready(const pg8::Unit&) const {}
    __device__ __forceinline__ void done(const pg8::Unit&) const {}
};
struct MoeOrderX {
    int nM, nN, nwg, G, c; const LAS int* texp;
    __device__ __forceinline__ bool next(int i, pg8::Unit& u) const { const long L = (long)i * G + c; if (L >= nwg) return false;
        int wgid = (int)L; { const int q = nwg / 8, r = nwg % 8, xcd = wgid % 8, off = wgid / 8; wgid = (xcd < r ? xcd * (q + 1) : r * (q + 1) + (xcd - r) * q) + off; }
        const int nig = 8 * nN, gid = wgid / nig, fm = gid * 8, gsz = (nM - fm) < 8 ? (nM - fm) : 8;
        u.pm = fm + ((wgid % nig) % gsz); u.pn = (wgid % nig) / gsz; u.bn = texp[u.pm] * nN + u.pn; u.idx = i; return true; }
    __device__ __forceinline__ void a_ready(const pg8::Unit&) const {}
    __device__ __forceinline__ void done(const pg8::Unit&) const {}
};
struct MoeTail { int R, Lo, pm_min; bool split; };
__device__ __forceinline__ MoeTail moe_tail(const LAS int* tab, int G) { MoeTail t; const int U = tab[24] * 4; t.R = U / G; t.Lo = U - t.R * G; t.split = (t.Lo > 0 && t.Lo <= 64 && t.R > 0); t.pm_min = t.split ? (t.R * G) / 4 : (1 << 30); return t; }
struct MoeTailOrder { int pm, pn, bn; bool has;
    __device__ __forceinline__ bool next(int i, pg8::Unit& u) const { if (i > 0 || !has) return false; u.pm = pm; u.pn = pn; u.bn = bn; u.idx = 0; return true; }
    __device__ __forceinline__ void a_ready(const pg8::Unit&) const {}
    __device__ __forceinline__ void done(const pg8::Unit&) const {} };
constexpr size_t MOE_PART_STRIDE = (size_t)16 * 256 * 1024;
__device__ __forceinline__ void phase_moe_combine(const Frame& F, const float* x, float* xo) {
    moe_layout(F); const MoeTail mt = moe_tail((const LAS int*)(F.lds + MOE_TAB), F.G); const int srow = mt.pm_min == (1 << 30) ? (1 << 30) : mt.pm_min * 256; const float* PART = (const float*)(F.ws + WS_XP);
    const int gw = F.bid * NWAVES + F.wave, NGW = F.G * NWAVES;
    const float* tokW = (const float*)(F.ws + WS_MOEIDX + 1 * MiB); const int* tokS = (const int*)(F.ws + WS_MOEIDX + 2 * MiB); const int* tokE = (const int*)(F.ws + WS_MOEIDX);
    const float* YP = (const float*)(F.ws + WS_YP);
    for (int m = gw; m < M; m += NGW) { const int s0 = tokS[2 * m], s1 = tokS[2 * m + 1]; const float w0 = tokW[2 * m], w1 = tokW[2 * m + 1]; const bool sw = tokE[2 * m] > tokE[2 * m + 1];
        const GAS f32x4* xr = (const GAS f32x4*)(x + (size_t)m * D) + F.lane; GAS f32x4* xw = (GAS f32x4*)(xo + (size_t)m * D) + F.lane; const GAS f32x4* y0 = (const GAS f32x4*)(YP + (size_t)s0 * D) + F.lane; const GAS f32x4* y1 = (const GAS f32x4*)(YP + (size_t)s1 * D) + F.lane;
#pragma unroll
        for (int j = 0; j < 4; ++j) { f32x4 v0, v1;
            if (s0 >= srow) { const GAS f32x4* q = (const GAS f32x4*)(PART + (size_t)(s0 - srow) * D) + F.lane + 64 * j; v0 = (q[0] + q[MOE_PART_STRIDE / 4]) + (q[2 * (MOE_PART_STRIDE / 4)] + q[3 * (MOE_PART_STRIDE / 4)]); } else v0 = y0[64 * j];
            if (s1 >= srow) { const GAS f32x4* q = (const GAS f32x4*)(PART + (size_t)(s1 - srow) * D) + F.lane + 64 * j; v1 = (q[0] + q[MOE_PART_STRIDE / 4]) + (q[2 * (MOE_PART_STRIDE / 4)] + q[3 * (MOE_PART_STRIDE / 4)]); } else v1 = y1[64 * j];
            const f32x4 a0 = v0 * w0, a1 = v1 * w1; xw[64 * j] = xr[64 * j] + (sw ? (a1 + a0) : (a0 + a1)); } }
}
#ifndef MK_PHMASK
#define MK_PHMASK 0xFFFFFFFFFFFFull
#endif
#ifndef MK_DUPMASK
#define MK_DUPMASK 0ull
#endif
#ifndef MK_SPLIT
#define MK_SPLIT 0
#endif
#ifndef MK_LAST_PHASE
#define MK_LAST_PHASE 29
#endif
constexpr int N_PHASES = 30;
#ifndef MK_LB
#define MK_LB 2
#endif
__global__ void __launch_bounds__(NTHR, MK_LB) mega_fwd(Args args) {
    extern __shared__ __attribute__((aligned(16))) unsigned char lds_raw[];
    Frame F;
    F.lds = (LAS unsigned char*)lds_raw; F.MISC = (volatile LAS unsigned*)(F.lds + MISC_OFF);
    F.tid = threadIdx.x; F.lane = F.tid & 63; F.wave = __builtin_amdgcn_readfirstlane(F.tid >> 6); F.G = gridDim.x; F.bid = blockIdx.x;
    F.ws = args.ws; F.ctl = (gu32*)(args.ws + WS_CTL);
    for (int u = F.tid; u < (LDS_BYTES - MISC_OFF) / 4; u += NTHR) ((LAS unsigned*)(F.lds + MISC_OFF))[u] = 0u;
    __syncthreads();
    XcdBarrier bar; bar.bar = (unsigned*)(F.ctl + CW_BAR); bar.x = 0; bar.st = nullptr;
    if (!MK_SPLIT) bar = xcd_barrier_post((unsigned*)(F.ctl + CW_BAR), F.MISC + 8);
    const int lo = args.ph_lo, hi = args.ph_hi;
#define PF() Frame Fp = F; { int t_ = threadIdx.x; asm volatile("" : "+v"(t_)); Fp.tid = t_; Fp.lane = t_ & 63; int w_ = F.wave, b_ = F.bid; asm volatile("" : "+s"(w_), "+s"(b_)); Fp.wave = w_; Fp.bid = b_; }
#define IN(k) ((((unsigned long long)MK_PHMASK >> (k)) & 1ull) && lo <= (k) && (k) < hi)
#define DUP(k) ((((unsigned long long)MK_DUPMASK >> (k)) & 1ull) ? 2 : 1)
#define SEAM(k) do { if (!MK_SPLIT && IN((k) + 1)) xcd_barrier(bar); } while (0)
    unsigned char* ws = args.ws; float* out = args.out;
    const int gw = F.bid * NWAVES + F.wave, NGW = F.G * NWAVES;
    LAS unsigned char* glds = F.lds;
    bf16* XN = (bf16*)(ws + WS_XN);

    if (IN(0)) { PF();
#pragma unroll 1
        for (int rep = 0; rep < DUP(0); ++rep) p0_prologue(Fp, args);
        SEAM(0); }
    if (IN(1)) {
        PF();
#pragma unroll 1
        for (int rep = 0; rep < DUP(1); ++rep) {
        if (F.bid == 0) { float* part = (float*)(ws + WS_CMPB_PART); float s = 0.f; for (int ic = 0; ic < 64; ++ic) s += part[(size_t)((Fp.tid >> 8) * 64 + ic) * 256 + (Fp.tid & 255)]; ((float*)(ws + WS_CMPB))[Fp.tid] = s; }
        { pg8::Gemm g{XN, (const bf16*)(ws + WS_W_EVIN), M, EV_INP, D, D, D}; pg8::StaticOrder S; S.init(M, EV_INP, F.G, F.bid);
          pg8::EpiEvIn E{(bf16*)(ws + WS_Y0), EV_INP, (bf16*)(ws + WS_KV6), SEQ};
          pg8::gemm_phase<pg8::EpiEvIn, pg8::StaticOrder, PG8_ALIGN, PG8_SP2>(glds, g, S, E); }
#pragma unroll 1
        for (int l = 0; l < 2; ++l) { pg8::Gemm g{(const bf16*)(ws + WS_MEMN) + (size_t)l * MMEM * D, (const bf16*)(ws + WS_W_XKV) + (size_t)l * 1024 * D, MMEM, 1024, D, D, D};
          pg8::ListOrder S; S.init(2, 4, 8, F.bid - 192 - 8 * l);
          pg8::EpiBf16<0> E{(bf16*)(ws + WS_KVM) + (size_t)l * MMEM * 1024, 1024, nullptr, nullptr};
          pg8::gemm_phase<pg8::EpiBf16<0>, pg8::ListOrder, PG8_ALIGN, PG8_SP2>(glds, g, S, E); }
        }
        SEAM(1);
    }
    if (IN(2)) {
        PF();
#pragma unroll 1
        for (int rep = 0; rep < DUP(2); ++rep) {
        if (F.bid < 128) { rglru_unit(Fp, args, F.bid >> 6, (F.bid >> 3) & 7, F.bid & 7);
        }
        else if (F.bid < 144) { const int mm = (F.bid - 128) >> 3;
            pg8::Gemm g{(const bf16*)(ws + WS_KV6) + (size_t)mm * 4 * SEQ * 128, (const bf16*)(ws + (mm ? WS_W_CV1 : WS_W_CK1)), 2048, 256, 4096, 2048, 4096};
            pg8::ListOrder S; S.init(8, 1, 8, (F.bid - 128) & 7);
            pg8::EpiBf16<1> E{(bf16*)(ws + WS_HID) + (size_t)mm * 2048 * 256, 256, (const float*)(ws + WS_CMPB) + mm * 256, nullptr};
            pg8::gemm_phase<pg8::EpiBf16<1>, pg8::ListOrder, PG8_ALIGN, PG8_SP2>(glds, g, S, E);
#ifdef MK_DUP_CMP1
            pg8::gemm_phase<pg8::EpiBf16<1>, pg8::ListOrder, PG8_ALIGN, PG8_SP2>(glds, g, S, E);
#endif
            VM_WAIT(); __syncthreads(); { const int u0 = mm * 64 + ((F.bid - 128) & 7) * 8; phase_cmp2(Fp, args, u0, u0 + 8, 1); }
        }
        else if (rep == 0) { const int gw2 = (F.bid - 144) * NWAVES + F.wave, NGW2 = (F.G - 144) * NWAVES;
            bf16* ks = (bf16*)(ws + WS_KV6) + (size_t)2 * 4 * SEQ * 128; bf16* kw = (bf16*)(ws + WS_KV6) + (size_t)4 * 4 * SEQ * 128;
            norm128_rows(Fp, ks, 128, ks, 128, 4 * SEQ, args.in[I_KNORM] + 128, gw2, NGW2);
            norm128_rows(Fp, kw, 128, kw, 128, 4 * SEQ, args.in[I_KNORM] + 256, gw2, NGW2);
            phase_memk_norm(Fp, args, 0, gw2, NGW2); phase_memk_norm(Fp, args, 1, gw2, NGW2); convert_range(Fp, args, gw2, NGW2, CONV_A, CONV_P2_END);
#ifdef MK_DUP_P2CONV
            convert_range(Fp, args, gw2, NGW2, CONV_A + (CONV_P2_END - CONV_A) / 2, CONV_P2_END);
#endif
        }
        }
        SEAM(2);
    }
    if (IN(4)) { PF();
#pragma unroll 1
        for (int rep = 0; rep < DUP(4); ++rep) phase_nsa(Fp, args);
        SEAM(4); }
    if (IN(5)) {
        pg8::Gemm g{(const bf16*)(ws + WS_MIX), (const bf16*)(ws + WS_W_EVOUT), M, D, 2048, 2048, 2048}; pg8::StaticOrder S; S.init(M, D, F.G, F.bid);
#pragma unroll 1
        for (int rep = 0; rep < DUP(5); ++rep) { pg8::EpiResidN E{args.in[I_X], (rep + 1 < DUP(5)) ? (float*)(ws + WS_R + 400 * MiB) : out, D, XN, (float*)(ws + WS_SSQ)};
        pg8::gemm_phase<pg8::EpiResidN, pg8::StaticOrder, PG8_ALIGN, PG8_SP2>(glds, g, S, E); }
        SEAM(5);
#ifdef MK_PROBE_BARS
#pragma unroll 1
        for (int xb = 0; xb < MK_PROBE_BARS; ++xb) xcd_barrier(bar);
#endif
    }
#pragma unroll 1
    for (int l = 0; l < 2; ++l) {
        const int pb = l == 0 ? 6 : 21;
        if (IN(pb + 1)) { pg8::Gemm g{XN, (const bf16*)(ws + WS_W_XQ) + (size_t)l * 512 * D, M, 512, D, D, D}; pg8::StaticOrder S; S.init(M, 512, F.G, F.bid);
            pg8::fill_rstd_table((LAS float*)(F.lds + MOE_TAB), S, (const float*)(ws + WS_SSQ), F.tid);
            pg8::EpiBf16<0> E{(bf16*)(ws + WS_QX), 512, nullptr, (const LAS float*)(F.lds + MOE_TAB)};
#pragma unroll 1
            for (int rep = 0; rep < DUP(7); ++rep) pg8::gemm_phase<pg8::EpiBf16<0>, pg8::StaticOrder, PG8_ALIGN, PG8_SP2>(glds, g, S, E);
            if (F.bid >= 128) { PF(); const int lo_ = CONV_ALL - (2 - l) * CONV_Q;
                convert_range(Fp, args, (F.bid - 128) * NWAVES + F.wave, (F.G - 128) * NWAVES, lo_, lo_ + CONV_Q); }
            SEAM(pb + 1); }
        if (IN(pb + 2)) { PF();
#pragma unroll 1
            for (int rep = 0; rep < DUP(8); ++rep) phase_cross_attn(Fp, args, l);
            SEAM(pb + 2); }
        if (IN(pb + 3)) { pg8::Gemm g{(const bf16*)(ws + WS_OX), (const bf16*)(ws + WS_W_XO) + (size_t)l * D * 512, M, D, 512, 512, 512}; pg8::StaticOrder S; S.init(M, D, F.G, F.bid);
#pragma unroll 1
            for (int rep = 0; rep < DUP(9); ++rep) { pg8::EpiResidN E{out, (rep + 1 < DUP(9)) ? (float*)(ws + WS_R + 400 * MiB) : out, D, l == 0 ? XN : (bf16*)nullptr, (float*)(ws + WS_SSQ)};
            pg8::gemm_phase<pg8::EpiResidN, pg8::StaticOrder, PG8_ALIGN, PG8_SP2>(glds, g, S, E); }
            SEAM(pb + 3); }
        if (l == 0) {
            if (IN(11)) { pg8::Gemm g{XN, (const bf16*)(ws + WS_W_FF13), M, 2 * FF, D, D, D}; pg8::StaticOrder S; S.init(M, 2 * FF, F.G, F.bid);
                pg8::fill_rstd_table((LAS float*)(F.lds + MOE_TAB), S, (const float*)(ws + WS_SSQ), F.tid);
                pg8::EpiSwiglu<false> E{(bf16*)(ws + WS_H), FF, (const LAS float*)(F.lds + MOE_TAB)};
#ifdef MK_PROBE_NULLEPI
                { pg8::EpiNull EN; pg8::gemm_phase<pg8::EpiNull, pg8::StaticOrder, PG8_ALIGN, PG8_SP2>(glds, g, S, EN); }
#endif
#pragma unroll 1
                for (int rep = 0; rep < DUP(11); ++rep) pg8::gemm_phase<pg8::EpiSwiglu<false>, pg8::StaticOrder, PG8_ALIGN, PG8_SP2>(glds, g, S, E);
                SEAM(11); }
            if (IN(12)) { pg8::Gemm g{(const bf16*)(ws + WS_H), (const bf16*)(ws + WS_W_FF2), M, D, FF, FF, FF}; pg8::StaticOrder S; S.init(M, D, F.G, F.bid);
#pragma unroll 1
                for (int rep = 0; rep < DUP(12); ++rep) { pg8::EpiResidN E{out, (rep + 1 < DUP(12)) ? (float*)(ws + WS_R + 400 * MiB) : out, D, XN, (float*)(ws + WS_SSQ)};
                pg8::gemm_phase<pg8::EpiResidN, pg8::StaticOrder, PG8_ALIGN, PG8_SP2>(glds, g, S, E); }
                SEAM(12); }
            if (IN(14)) { pg8::Gemm g{XN, (const bf16*)(ws + WS_W_ODIN), M, OD_INP, D, D, D}; pg8::StaticOrder S; S.init(M, OD_INP, F.G, F.bid);
                pg8::fill_rstd_table((LAS float*)(F.lds + MOE_TAB), S, (const float*)(ws + WS_SSQ), F.tid);
                pg8::EpiBf16<0> E{(bf16*)(ws + WS_Y1), OD_INP, nullptr, (const LAS float*)(F.lds + MOE_TAB)};
#pragma unroll 1
                for (int rep = 0; rep < DUP(14); ++rep) pg8::gemm_phase<pg8::EpiBf16<0>, pg8::StaticOrder, PG8_ALIGN, PG8_SP2>(glds, g, S, E);
                SEAM(14); }
            if (IN(15)) { PF();
#pragma unroll 1
                for (int rep = 0; rep < DUP(15); ++rep) phase_mamba_prep(Fp, args);
                SEAM(15); }
            if (IN(16)) { PF();
#pragma unroll 1
                for (int rep = 0; rep < DUP(16); ++rep) phase_mamba_states(Fp);
                SEAM(16); }
            if (IN(17)) { PF();
#pragma unroll 1
                for (int rep = 0; rep < DUP(17); ++rep) phase_mamba_scan(Fp);
                SEAM(17); }
            if (IN(18)) { PF();
#pragma unroll 1
                for (int rep = 0; rep < DUP(18); ++rep) phase_mamba_out(Fp, args);
                SEAM(18); }
            if (IN(20)) { pg8::Gemm g{(const bf16*)(ws + WS_YG), (const bf16*)(ws + WS_W_ODOUT), M, D, 2048, 2048, 2048}; pg8::StaticOrder S; S.init(M, D, F.G, F.bid);
#pragma unroll 1
                for (int rep = 0; rep < DUP(20); ++rep) { pg8::EpiResidN E{out, (rep + 1 < DUP(20)) ? (float*)(ws + WS_R + 400 * MiB) : out, D, XN, (float*)(ws + WS_SSQ)};
                pg8::gemm_phase<pg8::EpiResidN, pg8::StaticOrder, PG8_ALIGN, PG8_SP2>(glds, g, S, E); }
                SEAM(20); }
        }
    }
    if (IN(25)) { PF();
#pragma unroll 1
        for (int rep = 0; rep < DUP(25); ++rep) phase_route(Fp, args, out);
        SEAM(25); }
    if (IN(26)) { PF();
#pragma unroll 1
        for (int rep = 0; rep < DUP(26); ++rep) phase_scatter(Fp);
        SEAM(26); }
    if (IN(27)) { PF(); moe_layout(Fp); const LAS int* tab = (const LAS int*)(F.lds + MOE_TAB);
        pg8::Gemm g{(const bf16*)(ws + WS_XP), (const bf16*)(ws + WS_W_M13), MOE_ROWS, 2 * FFE, D, D, D}; MoeOrderX S{tab[24], 2 * FFE / 256, tab[24] * (2 * FFE / 256), F.G, F.bid, tab + 32};
        pg8::EpiSwiglu<true> E{(bf16*)(ws + WS_HP), FFE, nullptr};
#pragma unroll 1
        for (int rep = 0; rep < DUP(27); ++rep) pg8::gemm_phase<pg8::EpiSwiglu<true>, MoeOrderX, PG8_ALIGN, PG8_SP2>(glds, g, S, E);
        SEAM(27); }
    if (IN(28)) { PF(); moe_layout(Fp); const LAS int* tab = (const LAS int*)(F.lds + MOE_TAB);
        const MoeTail mt = moe_tail(tab, F.G);
        pg8::Gemm g{(const bf16*)(ws + WS_HP), (const bf16*)(ws + WS_W_M2), MOE_ROWS, D, FFE, FFE, FFE}; MoeOrder S{D / 256, mt.split ? mt.R * F.G : tab[24] * (D / 256), F.G, F.bid, tab + 32};
        pg8::EpiF32 E{(float*)(ws + WS_YP), D};
#pragma unroll 1
        for (int rep = 0; rep < DUP(28); ++rep) pg8::gemm_phase<pg8::EpiF32, MoeOrder, PG8_ALIGN, PG8_SP2>(glds, g, S, E);
        if (mt.split) {
            const int piece = F.bid, L = mt.R * F.G + (piece >> 2), kq = piece & 3, pm = L / 4, pn = L % 4;
            MoeTailOrder S2{pm, pn, piece < mt.Lo * 4 ? tab[32 + pm] * 4 + pn : 0, piece < mt.Lo * 4};
            pg8::Gemm g2{(const bf16*)(ws + WS_HP) + kq * (FFE / 4), (const bf16*)(ws + WS_W_M2) + kq * (FFE / 4), MOE_ROWS, D, FFE / 4, FFE, FFE};
            pg8::EpiF32 E2{(float*)(ws + WS_XP) + (size_t)kq * MOE_PART_STRIDE - (size_t)mt.pm_min * 256 * D, D};
            pg8::gemm_phase<pg8::EpiF32, MoeTailOrder, PG8_ALIGN, PG8_SP2>(glds, g2, S2, E2); }
        SEAM(28); }
    if (IN(29)) { PF();
#pragma unroll 1
        for (int rep = 0; rep < DUP(29); ++rep) phase_moe_combine(Fp, out, (rep + 1 < DUP(29)) ? (float*)(ws + WS_H) : out); }
#undef IN
#undef SEAM
}

extern "C" void kernel_launch(void* const* d_in, const int* in_sizes, int n_in, void* d_out, int out_size, void* d_ws, size_t ws_size, hipStream_t stream) {
    static int grid = 0;
    if (grid == 0) {
        if (n_in != N_IN || in_sizes[0] != M * D || out_size != M * D || ws_size < (WS_M_END > WS_END ? WS_M_END : WS_END)) { fprintf(stderr, "kernel_launch: unexpected problem (n_in %d, in0 %d, out %d, ws %zu < %zu); nothing launched\n", n_in, n_in > 0 ? in_sizes[0] : -1, out_size, ws_size, (size_t)WS_END); grid = -1; return; }
        int dev = 0, cus = 0, per_cu = 0;
        if (hipGetDevice(&dev) != hipSuccess || hipDeviceGetAttribute(&cus, hipDeviceAttributeMultiprocessorCount, dev) != hipSuccess) { fprintf(stderr, "kernel_launch: device query failed\n"); grid = -1; return; }
        if (hipFuncSetAttribute((const void*)mega_fwd, hipFuncAttributeMaxDynamicSharedMemorySize, LDS_BYTES) != hipSuccess) { fprintf(stderr, "kernel_launch: hipFuncSetAttribute(%d B LDS) failed\n", LDS_BYTES); grid = -1; return; }
        if (hipOccupancyMaxActiveBlocksPerMultiprocessor(&per_cu, (const void*)mega_fwd, NTHR, LDS_BYTES) != hipSuccess || per_cu < 1) fprintf(stderr, "kernel_launch: note: occupancy query reports %d workgroups per CU\n", per_cu);
        (void)hipGetLastError();
        if (cus < 256) { fprintf(stderr, "kernel_launch: %d CUs < 256: the persistent grid of 256 workgroups would not be resident; nothing launched\n", cus); grid = -1; return; }
        grid = 256;
    }
    if (grid < 0) return;
    if (hipMemsetAsync((char*)d_ws + WS_CTL, 0, CTL_ZERO_BYTES, stream) != hipSuccess) { fprintf(stderr, "kernel_launch: memset failed\n"); return; }
    Args a{};
    for (int i = 0; i < N_IN; ++i) a.in[i] = (const float*)d_in[i];
    a.out = (float*)d_out; a.ws = (unsigned char*)d_ws;
#if MK_SPLIT
    for (int p = 0; p <= MK_LAST_PHASE && p < N_PHASES; ++p) { a.ph_lo = p; a.ph_hi = p + 1; a.li = p; hipLaunchKernelGGL(mega_fwd, dim3(grid), dim3(NTHR), LDS_BYTES, stream, a); }
#else
    a.ph_lo = 0; a.ph_hi = MK_LAST_PHASE + 1; a.li = 0;
    hipLaunchKernelGGL(mega_fwd, dim3(grid), dim3(NTHR), LDS_BYTES, stream, a);
#endif
    const hipError_t le = hipPeekAtLastError();
    if (le != hipSuccess) fprintf(stderr, "kernel_launch: launch failed: %s\n", hipGetErrorName(le));
}
```

```cpp
#include <hip/hip_runtime.h>
#include <cstdio>
#include <cstdint>

namespace pg8 {
#define PG8_LAS __attribute__((address_space(3)))
typedef unsigned short bf16_t;
typedef short bf16x8 __attribute__((ext_vector_type(8)));
typedef float f32x4 __attribute__((ext_vector_type(4)));
typedef unsigned u32x4 __attribute__((ext_vector_type(4)));
typedef unsigned u32x2 __attribute__((ext_vector_type(2)));
constexpr int BM = 256, BK = 64, HALF = 128, HTB = HALF * BK * 2  , STAGE_BYTES = 8 * HTB, NXCD = 8, WGM = 8;

__host__ __device__ __forceinline__ int lds_byte(int r, int c) { const int st = (r >> 4) * 2 + (c >> 5), rr = r & 15, cc = c & 31, ob = rr * 64 + cc * 2; return st * 1024 + (ob ^ (((ob >> 9) & 1) << 5)); }
__host__ __device__ __forceinline__ void stage_rc(int b, int& R, int& C) { const int st = b / 1024, sb = b % 1024, swz = sb ^ (((sb >> 9) & 1) << 5); R = (st >> 1) * 16 + swz / 64; C = (st & 1) * 32 + (swz % 64) / 2; }
__host__ __device__ __forceinline__ int perm32(int rho) { const int n = rho >> 4, i = rho & 15; return 8 * (i >> 2) + 4 * n + (i & 3); }

typedef int i32x8 __attribute__((ext_vector_type(8)));
typedef int i32x4 __attribute__((ext_vector_type(4)));
__device__ __forceinline__ i32x8 cat8(bf16x8 lo, bf16x8 hi) { const i32x4 a = __builtin_bit_cast(i32x4, lo), b = __builtin_bit_cast(i32x4, hi); return __builtin_shufflevector(a, b, 0, 1, 2, 3, 4, 5, 6, 7); }
struct Unit { int pm, pn, bn, idx; };
struct Gemm { const bf16_t* A; const bf16_t* Bt; int M, N, K, lda, ldb; };

struct StaticOrder {
    int nM, nN, nwg, G, c;
    __host__ __device__ void init(int M, int N, int G_, int c_) { nM = M / BM; nN = N / BM; nwg = nM * nN; G = G_; c = c_; }
    __host__ __device__ bool next(int i, Unit& u) const {
        const long L = (long)i * G + c; if (L >= nwg) return false;
        int wgid = (int)L; { const int q = nwg / NXCD, r = nwg % NXCD, xcd = wgid % NXCD, off = wgid / NXCD; wgid = (xcd < r ? xcd * (q + 1) : r * (q + 1) + (xcd - r) * q) + off; }
        const int nig = WGM * nN, gid = wgid / nig, fm = gid * WGM, gsz = (nM - fm) < WGM ? (nM - fm) : WGM;
        u.pm = fm + ((wgid % nig) % gsz); u.pn = (wgid % nig) / gsz; u.bn = u.pn; u.idx = i; return true;
    }
    __device__ __forceinline__ void a_ready(const Unit&) const {}
    __device__ __forceinline__ void done(const Unit&) const {}
};
struct ListOrder {
    int nN, nwg, G, c;
    __host__ __device__ void init(int nM_, int nN_, int G_, int c_) { nN = nN_; nwg = nM_ * nN_; G = G_; c = c_; }
    __host__ __device__ bool next(int i, Unit& u) const { const long L = (long)i * G + c; if (c < 0 || L >= nwg) return false; u.pm = (int)(L / nN); u.pn = (int)(L % nN); u.bn = u.pn; u.idx = i; return true; }
    __device__ __forceinline__ void a_ready(const Unit&) const {}
    __device__ __forceinline__ void done(const Unit&) const {}
};

__device__ __forceinline__ unsigned cvt_pk_bf16(float lo, float hi) { unsigned r; asm volatile("v_cvt_pk_bf16_f32 %0, %1, %2" : "=v"(r) : "v"(lo), "v"(hi)); return r; }
__device__ __forceinline__ float fsigmoid(float x) { return __builtin_amdgcn_rcpf(1.0f + __expf(-x)); }
__device__ __forceinline__ float gelu_tanh(float x) { const float u = 1.5957691216f * (x + 0.044715f * x * x * x); return x * fsigmoid(u); }
__device__ __forceinline__ float fsilu(float x) { return x * fsigmoid(x); }

__device__ __forceinline__ float row_rstd(const float* ssq, int row) {
    const f32x4 a = *(const f32x4*)(ssq + (size_t)row * 16), b = *(const f32x4*)(ssq + (size_t)row * 16 + 4), c = *(const f32x4*)(ssq + (size_t)row * 16 + 8), d = *(const f32x4*)(ssq + (size_t)row * 16 + 12);
    const f32x4 s = (a + b) + (c + d); return 1.0f / sqrtf(((s[0] + s[1]) + (s[2] + s[3])) * (1.0f / 1024.0f) + 1e-6f);
}
template <class Sched> __device__ __forceinline__ void fill_rstd_table(PG8_LAS float* tab, const Sched& S, const float* ssq, int tid) {
    Unit u; for (int i = 0; S.next(i, u); ++i) if (tid < 256) { const int ai = tid >> 7, wr = (tid >> 6) & 1, m = (tid >> 4) & 3, fr = tid & 15; tab[i * 256 + ((ai * 2 + wr) * 16 + fr) * 4 + m] = row_rstd(ssq, u.pm * BM + tid); }
    __syncthreads();
}
template <int ACT, bool SPLIT_ = false> struct EpiBf16 {
    static constexpr bool PERM = true, AFTER_DRAIN = false, SPLIT = SPLIT_, PACK = false; static constexpr int NST = 16; struct Pk {};
    bf16_t* O; int ldc; const float* bias; const PG8_LAS float* rsT;
    __device__ __forceinline__ void operator()(const f32x4 (&acc)[2][2][4][2], const Unit& u, int wr, int wc, int fr, int fq) const { half<0>(acc, u, wr, wc, fr, fq); half<1>(acc, u, wr, wc, fr, fq); }
    template <int AI> __device__ __forceinline__ void half(const f32x4 (&acc)[2][2][4][2], const Unit& u, int wr, int wc, int fr, int fq) const {
        const int row0 = u.pm * BM + wr * 64 + fr; const int col0 = u.pn * BM + wc * 32 + 8 * fq;
        f32x4 bv[2][2];
#pragma unroll
        for (int bj = 0; bj < 2; ++bj)
#pragma unroll
            for (int n = 0; n < 2; ++n) bv[bj][n] = bias ? *(const f32x4*)(bias + col0 + bj * HALF + 4 * n) : (f32x4){0.f, 0.f, 0.f, 0.f};
        { constexpr int ai = AI; const f32x4 rs4 = rsT ? *(const PG8_LAS f32x4*)(rsT + u.idx * 256 + ((ai * 2 + wr) * 16 + fr) * 4) : (f32x4){1.f, 1.f, 1.f, 1.f};
#pragma unroll
            for (int m = 0; m < 4; ++m) { bf16_t* rowp = O + (size_t)(row0 + ai * HALF + m * 16) * ldc + col0; const float rs = rs4[m];
#pragma unroll
                for (int bj = 0; bj < 2; ++bj) { f32x4 v0 = acc[ai][bj][m][0] * rs + bv[bj][0], v1 = acc[ai][bj][m][1] * rs + bv[bj][1];
                    if (ACT == 1) {
#pragma unroll
                        for (int j = 0; j < 4; ++j) { v0[j] = gelu_tanh(v0[j]); v1[j] = gelu_tanh(v1[j]); } }
                    u32x4 w; w.x = cvt_pk_bf16(v0[0], v0[1]); w.y = cvt_pk_bf16(v0[2], v0[3]); w.z = cvt_pk_bf16(v1[0], v1[1]); w.w = cvt_pk_bf16(v1[2], v1[3]);
                    *(u32x4*)(rowp + bj * HALF) = w; } } }
    }
};
struct EpiEvIn {
    static constexpr bool PERM = true, AFTER_DRAIN = false, SPLIT = true, PACK = false; static constexpr int NST = 16; struct Pk {};
    bf16_t* O; int ldc; bf16_t* KV6; int S;
    __device__ __forceinline__ void operator()(const f32x4 (&acc)[2][2][4][2], const Unit& u, int wr, int wc, int fr, int fq) const { half<0>(acc, u, wr, wc, fr, fq); half<1>(acc, u, wr, wc, fr, fq); }
    template <int AI> __device__ __forceinline__ void half(const f32x4 (&acc)[2][2][4][2], const Unit& u, int wr, int wc, int fr, int fq) const {
        const int row0 = u.pm * BM + wr * 64 + fr; const int col0 = u.pn * BM + wc * 32 + 8 * fq;
        const bool kv = (u.pn >= 12 && u.pn < 18);
        { constexpr int ai = AI;
#pragma unroll
            for (int m = 0; m < 4; ++m) { const int row = row0 + ai * HALF + m * 16;
#pragma unroll
                for (int bj = 0; bj < 2; ++bj) { const f32x4 v0 = acc[ai][bj][m][0], v1 = acc[ai][bj][m][1];
                    u32x4 w; w.x = cvt_pk_bf16(v0[0], v0[1]); w.y = cvt_pk_bf16(v0[2], v0[3]); w.z = cvt_pk_bf16(v1[0], v1[1]); w.w = cvt_pk_bf16(v1[2], v1[3]);
                    if (kv) { const int b = row / S, t = row - b * S;
                        bf16_t* p = KV6 + ((((size_t)(u.pn - 12) * 2 + b) * 2 + bj) * S + t) * 128 + wc * 32 + 8 * fq; *(u32x4*)p = w; }
                    else *(u32x4*)(O + (size_t)row * ldc + col0 + bj * HALF) = w; } } }
    }
};
struct EpiResid {
    static constexpr bool PERM = false, AFTER_DRAIN = false, SPLIT = false, PACK = false; static constexpr int NST = 0; struct Pk {};
    const float* base; float* out; int ldc;
    __device__ __forceinline__ void operator()(const f32x4 (&acc)[2][2][4][2], const Unit& u, int wr, int wc, int fr, int fq) const {
        const int row0 = u.pm * BM + wr * 64 + fr, col0 = u.pn * BM + wc * 32 + 4 * fq;
#pragma unroll
        for (int ai = 0; ai < 2; ++ai)
#pragma unroll
            for (int m = 0; m < 4; ++m) { const size_t off = (size_t)(row0 + ai * HALF + m * 16) * ldc + col0;
#pragma unroll
                for (int bj = 0; bj < 2; ++bj)
#pragma unroll
                    for (int n = 0; n < 2; ++n) { const f32x4 b = *(const f32x4*)(base + off + bj * HALF + n * 16); *(f32x4*)(out + off + bj * HALF + n * 16) = b + acc[ai][bj][m][n]; } }
    }
};
struct EpiResidN {
    static constexpr bool PERM = false, AFTER_DRAIN = false, SPLIT = false, PACK = false; static constexpr int NST = 0; struct Pk {};
    const float* base; float* out; int ldc; bf16_t* XB; float* SSQ;
    __device__ __forceinline__ void operator()(const f32x4 (&acc)[2][2][4][2], const Unit& u, int wr, int wc, int fr, int fq) const {
        const int row0 = u.pm * BM + wr * 64 + fr, col0 = u.pn * BM + wc * 32 + 4 * fq;
#pragma unroll
        for (int ai = 0; ai < 2; ++ai)
#pragma unroll
            for (int m = 0; m < 4; ++m) { const int row = row0 + ai * HALF + m * 16; const size_t off = (size_t)row * ldc + col0; float ss = 0.f;
#pragma unroll
                for (int bj = 0; bj < 2; ++bj)
#pragma unroll
                    for (int n = 0; n < 2; ++n) { const f32x4 b = *(const f32x4*)(base + off + bj * HALF + n * 16); const f32x4 v = b + acc[ai][bj][m][n]; *(f32x4*)(out + off + bj * HALF + n * 16) = v;
                        if (XB) { u32x2 w; w.x = cvt_pk_bf16(v[0], v[1]); w.y = cvt_pk_bf16(v[2], v[3]); *(u32x2*)(XB + off + bj * HALF + n * 16) = w; }
                        ss += (v[0] * v[0] + v[1] * v[1]) + (v[2] * v[2] + v[3] * v[3]); }
                ss += __shfl_xor(ss, 16); ss += __shfl_xor(ss, 32);
                if (XB && fq == 0) SSQ[(size_t)row * 16 + u.pn * 4 + wc] = ss; }
    }
};
struct EpiNull {
    static constexpr bool PERM = false, AFTER_DRAIN = false, SPLIT = false, PACK = false; static constexpr int NST = 0; struct Pk {};
    __device__ __forceinline__ void operator()(const f32x4 (&acc)[2][2][4][2], const Unit&, int, int, int, int) const {
#pragma unroll
        for (int ai = 0; ai < 2; ++ai)
#pragma unroll
            for (int bj = 0; bj < 2; ++bj)
#pragma unroll
                for (int m = 0; m < 4; ++m)
#pragma unroll
                    for (int n = 0; n < 2; ++n) asm volatile("" :: "v"(acc[ai][bj][m][n]));
    }
};
struct EpiF32 {
    static constexpr bool PERM = false, AFTER_DRAIN = false, SPLIT = false, PACK = false; static constexpr int NST = 0; struct Pk {};
    float* C; int ldc;
    __device__ __forceinline__ void operator()(const f32x4 (&acc)[2][2][4][2], const Unit& u, int wr, int wc, int fr, int fq) const {
        const int row0 = u.pm * BM + wr * 64 + fr, col0 = u.pn * BM + wc * 32 + 4 * fq;
#pragma unroll
        for (int ai = 0; ai < 2; ++ai)
#pragma unroll
            for (int m = 0; m < 4; ++m) { float* rowp = C + (size_t)(row0 + ai * HALF + m * 16) * ldc + col0;
#pragma unroll
                for (int bj = 0; bj < 2; ++bj)
#pragma unroll
                    for (int n = 0; n < 2; ++n) *(f32x4*)(rowp + bj * HALF + n * 16) = acc[ai][bj][m][n]; }
    }
};
template <bool SPLIT_, bool PACK_ = false> struct EpiSwiglu {
    static constexpr bool PERM = true, AFTER_DRAIN = false, SPLIT = SPLIT_, PACK = PACK_; static constexpr int NST = 8;
    bf16_t* H; int ldh; const PG8_LAS float* rsT; float sc = 1.f;
    __device__ __forceinline__ void operator()(const f32x4 (&acc)[2][2][4][2], const Unit& u, int wr, int wc, int fr, int fq) const { half<0>(acc, u, wr, wc, fr, fq); half<1>(acc, u, wr, wc, fr, fq); }
    struct Pk { u32x4 w[4]; };
    __device__ __forceinline__ void pack1(const f32x4 (&acc)[2][2][4][2], const Unit& u, int wr, int fr, Pk& pk) const {
        constexpr int ai = 1; const f32x4 rs4 = rsT ? *(const PG8_LAS f32x4*)(rsT + u.idx * 256 + ((ai * 2 + wr) * 16 + fr) * 4) : (f32x4){1.f, 1.f, 1.f, 1.f};
#pragma unroll
        for (int m = 0; m < 4; ++m) { const float rs = rs4[m] * sc;
            const f32x4 u0 = acc[ai][0][m][0] * rs, u1 = acc[ai][0][m][1] * rs, g0 = acc[ai][1][m][0] * rs, g1 = acc[ai][1][m][1] * rs;
            pk.w[m].x = cvt_pk_bf16(fsilu(g0[0]) * u0[0], fsilu(g0[1]) * u0[1]); pk.w[m].y = cvt_pk_bf16(fsilu(g0[2]) * u0[2], fsilu(g0[3]) * u0[3]);
            pk.w[m].z = cvt_pk_bf16(fsilu(g1[0]) * u1[0], fsilu(g1[1]) * u1[1]); pk.w[m].w = cvt_pk_bf16(fsilu(g1[2]) * u1[2], fsilu(g1[3]) * u1[3]); }
    }
    __device__ __forceinline__ void store1(const Pk& pk, const Unit& u, int wr, int wc, int fr, int fq) const {
        bf16_t* p = H + (size_t)(u.pm * BM + wr * 64 + fr + HALF) * ldh + u.pn * 128 + wc * 32 + 8 * fq;
#pragma unroll
        for (int m = 0; m < 4; ++m) *(u32x4*)(p + (size_t)(m * 16) * ldh) = pk.w[m];
    }
    template <int AI> __device__ __forceinline__ void half(const f32x4 (&acc)[2][2][4][2], const Unit& u, int wr, int wc, int fr, int fq) const {
        const int row0 = u.pm * BM + wr * 64 + fr, col0 = u.pn * 128 + wc * 32 + 8 * fq;
        constexpr int ai = AI; const f32x4 rs4 = rsT ? *(const PG8_LAS f32x4*)(rsT + u.idx * 256 + ((ai * 2 + wr) * 16 + fr) * 4) : (f32x4){1.f, 1.f, 1.f, 1.f};
#pragma unroll
        for (int m = 0; m < 4; ++m) { bf16_t* rowp = H + (size_t)(row0 + ai * HALF + m * 16) * ldh + col0; const float rs = rs4[m] * sc;
            const f32x4 u0 = acc[ai][0][m][0] * rs, u1 = acc[ai][0][m][1] * rs, g0 = acc[ai][1][m][0] * rs, g1 = acc[ai][1][m][1] * rs;
            u32x4 w; w.x = cvt_pk_bf16(fsilu(g0[0]) * u0[0], fsilu(g0[1]) * u0[1]); w.y = cvt_pk_bf16(fsilu(g0[2]) * u0[2], fsilu(g0[3]) * u0[3]);
            w.z = cvt_pk_bf16(fsilu(g1[0]) * u1[0], fsilu(g1[1]) * u1[1]); w.w = cvt_pk_bf16(fsilu(g1[2]) * u1[2], fsilu(g1[3]) * u1[3]);
            *(u32x4*)rowp = w; }
    }
};
__host__ __device__ __forceinline__ int swiglu_row(int h, int gate) { return (h >> 7) * 256 + gate * 128 + (h & 127); }

template <class Epi, class Sched, bool ALIGN_EPI = false, bool SP2 = false, bool F8 = false>
__device__ __forceinline__ void gemm_phase(PG8_LAS unsigned char* lds, const Gemm g, const Sched& S, const Epi& E) {
    int tid = threadIdx.x; asm volatile("" : "+v"(tid));
    const int wid = __builtin_amdgcn_readfirstlane(tid >> 6), lane = tid & 63, wr = wid >> 2, wc = wid & 3, fr = lane & 15, fq = lane >> 4;
    const int K = g.K, nt = K / BK;
    unsigned voffA, voffB;
    { int R, C; stage_rc(tid * 16, R, C); const int Rb = Epi::PERM ? ((R & ~31) + perm32(R & 31)) : R;
      voffA = (unsigned)(R * g.lda + C) * 2u; voffB = (unsigned)(Rb * g.ldb + C) * 2u; }
    const size_t q64A = (size_t)64 * g.lda * 2, q64B = (size_t)64 * g.ldb * 2;
    const size_t kstep = (size_t)(BK * 2);
    const size_t hstepA = (size_t)HALF * g.lda * 2, hstepB = (size_t)HALF * g.ldb * 2;
    const size_t tstepA = 2 * hstepA, tstepB = 2 * hstepB;
    const unsigned ldsw = (unsigned)wid * 1024u;
    const int aoff = lds_byte(wr * 64 + fr, fq * 8), boff = lds_byte(wc * 32 + fr, fq * 8);
#define PG8_SA(b, h) (((b) * 2 + (h)) * HTB)
#define PG8_SB(b, h) ((4 + (b) * 2 + (h)) * HTB)
#define PG8_STAGE(bufoff, gbase, voff) do { __builtin_amdgcn_global_load_lds((const unsigned*)((const char*)(gbase) + (voff)), (PG8_LAS unsigned*)(lds + (bufoff) + ldsw), 16, 0, 0); \
        __builtin_amdgcn_global_load_lds((const unsigned*)((const char*)(gbase) + PG8_Q64(voff) + (voff)), (PG8_LAS unsigned*)(lds + (bufoff) + ldsw + 8192), 16, 0, 0); } while (0)
#define PG8_Q64(v) PG8_Q64_##v
#define PG8_Q64_voffA q64A
#define PG8_Q64_voffB q64B
#define PG8_LDA(dst, b, h) do { _Pragma("unroll") for (int m = 0; m < 4; ++m) _Pragma("unroll") for (int k = 0; k < 2; ++k) dst[m][k] = *(const PG8_LAS bf16x8*)(lds + PG8_SA(b, h) + aoff + m * 2048 + k * 1024); } while (0)
#define PG8_LDB(dst, b, h) do { _Pragma("unroll") for (int n = 0; n < 2; ++n) _Pragma("unroll") for (int k = 0; k < 2; ++k) dst[n][k] = *(const PG8_LAS bf16x8*)(lds + PG8_SB(b, h) + boff + n * 2048 + k * 1024); } while (0)
#define PG8_MMA(ai, bj, At, Bt) do { __builtin_amdgcn_s_setprio(1); \
        if constexpr (F8) { _Pragma("unroll") for (int m = 0; m < 4; ++m) _Pragma("unroll") for (int n = 0; n < 2; ++n) \
            acc[ai][bj][m][n] = __builtin_amdgcn_mfma_scale_f32_16x16x128_f8f6f4(cat8(Bt[n][0], Bt[n][1]), cat8(At[m][0], At[m][1]), acc[ai][bj][m][n], 0, 0, 0, 0, 0, 0); } \
        else { _Pragma("unroll") for (int m = 0; m < 4; ++m) _Pragma("unroll") for (int n = 0; n < 2; ++n) _Pragma("unroll") for (int k = 0; k < 2; ++k) \
            acc[ai][bj][m][n] = __builtin_amdgcn_mfma_f32_16x16x32_bf16(Bt[n][k], At[m][k], acc[ai][bj][m][n], 0, 0, 0); } \
        __builtin_amdgcn_s_setprio(0); } while (0)
#define PG8_WAIT_V(n) asm volatile("s_waitcnt vmcnt(" #n ")" ::: "memory")
#define PG8_WAIT_L(n) asm volatile("s_waitcnt lgkmcnt(" #n ")" ::: "memory")
#define PG8_WAIT_REL(NN) do { if (rel) asm volatile("s_waitcnt vmcnt(%0)" :: "n"(NN) : "memory"); else PG8_WAIT_V(8); } while (0)
#define PG8_BAR __builtin_amdgcn_s_barrier()
#define PG8_SCHED __builtin_amdgcn_sched_barrier(0)
    typename Epi::Pk pk; Unit cur, nxt, pend; int ui = 0; bool pending = false; pend.pm = pend.pn = pend.bn = pend.idx = 0;
    if (!S.next(0, cur)) return;
    f32x4 acc[2][2][4][2];
#pragma unroll
    for (int a = 0; a < 2; ++a)
#pragma unroll
        for (int b = 0; b < 2; ++b)
#pragma unroll
            for (int m = 0; m < 4; ++m)
#pragma unroll
                for (int n = 0; n < 2; ++n) acc[a][b][m][n] = (f32x4){0.f, 0.f, 0.f, 0.f};
    bf16x8 At[4][2], B0[2][2], B1[2][2];
    const char* cA = (const char*)g.A + (size_t)cur.pm * tstepA; const char* cB = (const char*)g.Bt + (size_t)cur.bn * tstepB;
    S.a_ready(cur);
    if constexpr (SP2) {
        PG8_STAGE(PG8_SB(0, 0), cB, voffB); PG8_STAGE(PG8_SB(0, 1), cB + hstepB, voffB); PG8_STAGE(PG8_SA(0, 0), cA, voffA); PG8_STAGE(PG8_SA(0, 1), cA + hstepA, voffA);
        if (wr == 1) PG8_BAR;
        PG8_WAIT_V(2); PG8_BAR;
        PG8_STAGE(PG8_SB(1, 0), cB + kstep, voffB); PG8_STAGE(PG8_SA(1, 0), cA + kstep, voffA); PG8_STAGE(PG8_SB(1, 1), cB + hstepB + kstep, voffB);
        PG8_WAIT_V(6); PG8_BAR;
    } else {
        PG8_STAGE(PG8_SB(0, 0), cB, voffB); PG8_STAGE(PG8_SA(0, 0), cA, voffA); PG8_STAGE(PG8_SB(0, 1), cB + hstepB, voffB); PG8_STAGE(PG8_SA(0, 1), cA + hstepA, voffA);
        if (wr == 1) PG8_BAR;
        PG8_WAIT_V(4); PG8_BAR;
        PG8_STAGE(PG8_SB(1, 0), cB + kstep, voffB); PG8_STAGE(PG8_SA(1, 0), cA + kstep, voffA); PG8_STAGE(PG8_SB(1, 1), cB + hstepB + kstep, voffB);
        PG8_WAIT_V(6); PG8_BAR;
    }
    for (;;) {
        const bool has_next = S.next(ui + 1, nxt);
        const char* nA = has_next ? (const char*)g.A + (size_t)nxt.pm * tstepA : cA; const char* nB = has_next ? (const char*)g.Bt + (size_t)nxt.bn * tstepB : cB;
        for (int t = 0; t < nt; t += 2) {
            const bool last = (t == nt - 2);
            const char* a1 = cA + (size_t)(t + 1) * kstep;
            const char* a2 = last ? nA : cA + (size_t)(t + 2) * kstep; const char* b2 = last ? nB : cB + (size_t)(t + 2) * kstep;
            const char* a3 = a2 + kstep; const char* b3 = b2 + kstep;
            if (last && has_next) S.a_ready(nxt);
            if constexpr (SP2) {
            const bool rel = Epi::SPLIT && pending && t == 0;
            if (rel) { if constexpr (Epi::SPLIT) { PG8_STAGE(PG8_SA(1, 1), a1 + hstepA, voffA); PG8_SCHED;
                if constexpr (Epi::PACK) { E.store1(pk, pend, wr, wc, fr, fq); }
                else { E.template half<1>(acc, pend, wr, wc, fr, fq);
#pragma unroll
                for (int b = 0; b < 2; ++b)
#pragma unroll
                    for (int m = 0; m < 4; ++m)
#pragma unroll
                        for (int n = 0; n < 2; ++n) acc[1][b][m][n] = (f32x4){0.f, 0.f, 0.f, 0.f}; }
                S.done(pend); pending = false;
                PG8_SCHED; PG8_LDB(B0, 0, 0); PG8_LDB(B1, 0, 1); PG8_SCHED; PG8_LDA(At, 0, 0); } }
            else { PG8_LDB(B0, 0, 0); PG8_LDB(B1, 0, 1); PG8_SCHED; PG8_LDA(At, 0, 0); PG8_STAGE(PG8_SA(1, 1), a1 + hstepA, voffA); }
            PG8_WAIT_REL(8 + Epi::NST); PG8_WAIT_L(0); PG8_BAR; PG8_MMA(0, 0, At, B0); PG8_MMA(0, 1, At, B1); PG8_BAR; PG8_SCHED;
            PG8_LDA(At, 0, 1); PG8_STAGE(PG8_SB(0, 0), b2, voffB); PG8_STAGE(PG8_SB(0, 1), b2 + hstepB, voffB); PG8_STAGE(PG8_SA(0, 0), a2, voffA);
            PG8_WAIT_REL(8 + Epi::NST); PG8_WAIT_L(0); PG8_BAR; PG8_MMA(1, 0, At, B0); PG8_MMA(1, 1, At, B1); PG8_BAR; PG8_SCHED;
            PG8_LDB(B0, 1, 0); PG8_LDB(B1, 1, 1); PG8_SCHED; PG8_LDA(At, 1, 0); PG8_STAGE(PG8_SA(0, 1), a2 + hstepA, voffA);
            PG8_WAIT_REL(8 + Epi::NST / 2); PG8_WAIT_L(0); PG8_BAR; PG8_MMA(0, 0, At, B0); PG8_MMA(0, 1, At, B1); PG8_BAR; PG8_SCHED;
            PG8_LDA(At, 1, 1); PG8_STAGE(PG8_SB(1, 0), b3, voffB); PG8_STAGE(PG8_SB(1, 1), b3 + hstepB, voffB); PG8_STAGE(PG8_SA(1, 0), a3, voffA);
            PG8_WAIT_V(8); PG8_WAIT_L(0); PG8_BAR; PG8_MMA(1, 0, At, B0); PG8_MMA(1, 1, At, B1); PG8_BAR; PG8_SCHED;
            } else {
            PG8_LDB(B0, 0, 0); PG8_SCHED; PG8_LDA(At, 0, 0); PG8_STAGE(PG8_SA(1, 1), a1 + hstepA, voffA);
            PG8_WAIT_L(8); PG8_BAR; PG8_WAIT_L(0); PG8_MMA(0, 0, At, B0); PG8_BAR; PG8_SCHED;
            PG8_LDB(B1, 0, 1); PG8_STAGE(PG8_SB(0, 0), b2, voffB);
            PG8_BAR; PG8_WAIT_L(0); PG8_MMA(0, 1, At, B1); PG8_BAR;
            PG8_LDA(At, 0, 1); PG8_STAGE(PG8_SA(0, 0), a2, voffA);
            PG8_BAR; PG8_WAIT_L(0); PG8_MMA(1, 0, At, B0); PG8_BAR; PG8_SCHED;
            PG8_STAGE(PG8_SB(0, 1), b2 + hstepB, voffB);
            PG8_WAIT_V(6); PG8_BAR; PG8_MMA(1, 1, At, B1); PG8_BAR;
            PG8_LDB(B0, 1, 0); PG8_SCHED; PG8_LDA(At, 1, 0); PG8_STAGE(PG8_SA(0, 1), a2 + hstepA, voffA);
            PG8_WAIT_L(8); PG8_BAR; PG8_WAIT_L(0); PG8_MMA(0, 0, At, B0); PG8_BAR; PG8_SCHED;
            PG8_LDB(B1, 1, 1); PG8_STAGE(PG8_SB(1, 0), b3, voffB);
            PG8_BAR; PG8_WAIT_L(0); PG8_MMA(0, 1, At, B1); PG8_BAR;
            PG8_LDA(At, 1, 1); PG8_STAGE(PG8_SA(1, 0), a3, voffA);
            PG8_BAR; PG8_WAIT_L(0); PG8_MMA(1, 0, At, B0); PG8_BAR; PG8_SCHED;
            PG8_STAGE(PG8_SB(1, 1), b3 + hstepB, voffB);
            PG8_WAIT_V(6); PG8_BAR; PG8_MMA(1, 1, At, B1); PG8_BAR;
            }
        }
        if constexpr (ALIGN_EPI) { if (wr == 0) PG8_BAR; }
        if constexpr (Epi::SPLIT) { static_assert(SP2, "split epilogues need the SP2 loop");
            if (has_next) { E.template half<0>(acc, cur, wr, wc, fr, fq); if constexpr (Epi::PACK) E.pack1(acc, cur, wr, fr, pk); pend = cur; pending = true; }
            else { E.template half<0>(acc, cur, wr, wc, fr, fq); E.template half<1>(acc, cur, wr, wc, fr, fq); S.done(cur); } }
        else if constexpr (!Epi::AFTER_DRAIN) { E(acc, cur, wr, wc, fr, fq); S.done(cur); }
        if (!has_next) break;
#pragma unroll
        for (int a = 0; a < ((Epi::SPLIT && !Epi::PACK) ? 1 : 2); ++a)
#pragma unroll
            for (int b = 0; b < 2; ++b)
#pragma unroll
                for (int m = 0; m < 4; ++m)
#pragma unroll
                    for (int n = 0; n < 2; ++n) acc[a][b][m][n] = (f32x4){0.f, 0.f, 0.f, 0.f};
        cur = nxt; cA = nA; cB = nB; ++ui;
        if constexpr (ALIGN_EPI) { if (wr == 1) PG8_BAR; }
    }
    PG8_WAIT_V(0);
    if constexpr (!ALIGN_EPI) { if (wr == 0) PG8_BAR; }
    PG8_BAR;
    if constexpr (Epi::AFTER_DRAIN) { E.fused(acc, cur, wr, wc, fr, fq, lds, wid, lane); S.done(cur); }
#undef PG8_SA
#undef PG8_SB
#undef PG8_STAGE
#undef PG8_Q64
#undef PG8_Q64_voffA
#undef PG8_Q64_voffB
#undef PG8_LDA
#undef PG8_LDB
#undef PG8_MMA
#undef PG8_WAIT_V
#undef PG8_WAIT_L
#undef PG8_WAIT_REL
#undef PG8_BAR
#undef PG8_SCHED
}
}
#define PG8_SP2 true
#define PG8_ALIGN true
constexpr int NWAVES = 8, NTHR = 512;
constexpr int BATCH = 2, SEQ = 8192, D = 1024, M = BATCH * SEQ;
constexpr int MEMLEN = 256, MMEM = BATCH * MEMLEN;
constexpr int EV_IN = 4632, EV_INP = 4864;
constexpr int OD_IN = 5152, OD_INP = 5376;
constexpr int FF = 2816, FFE = 3584, NEXP = 8;
constexpr float MOE_W13_SCALE = 64.f;
constexpr int NQB = SEQ / 64;
constexpr int XH = 4;
constexpr float EPS = 1e-6f;
constexpr int MOE_ROWS = 2 * M + NEXP * 256;
constexpr int MOE_TILES = MOE_ROWS / 256;

constexpr size_t MiB = 1u << 20;
constexpr size_t WS_CTL = 0, CTL_ZERO_BYTES = 1 * MiB;
constexpr size_t WS_SMALL = 1 * MiB;
constexpr size_t WS_CMPB_PART = WS_SMALL;
constexpr size_t WS_CMPB = WS_SMALL + 256 * 1024;
constexpr size_t WS_OV = WS_SMALL + 512 * 1024;
constexpr size_t WS_MEMN = 2 * MiB;
constexpr size_t WS_KVM = 4 * MiB;
constexpr size_t WS_KM = 6 * MiB;
constexpr size_t WS_HID = 7 * MiB;
constexpr size_t WS_KVCMP = 9 * MiB;
constexpr size_t WS_MOEIDX = 10 * MiB;
constexpr size_t WS_SSQ = 14 * MiB;
constexpr size_t WS_W = 16 * MiB;
constexpr size_t WS_W_EVIN = WS_W, WS_W_EVOUT = WS_W_EVIN + 10 * MiB, WS_W_CK1 = WS_W_EVOUT + 4 * MiB, WS_W_CV1 = WS_W_CK1 + 2 * MiB, WS_W_ODIN = WS_W_CV1 + 2 * MiB,
                 WS_W_ODOUT = WS_W_ODIN + 11 * MiB, WS_W_XQ = WS_W_ODOUT + 4 * MiB, WS_W_XKV = WS_W_XQ + 2 * MiB, WS_W_XO = WS_W_XKV + 4 * MiB, WS_W_FF13 = WS_W_XO + 2 * MiB,
                 WS_W_FF2 = WS_W_FF13 + 11 * MiB, WS_W_M13 = WS_W_FF2 + 6 * MiB, WS_W_M2 = WS_W_M13 + 112 * MiB, WS_W_END = WS_W_M2 + 56 * MiB;
constexpr size_t WS_XN = WS_W_END;
constexpr size_t WS_QX = WS_XN + 32 * MiB, WS_OX = WS_QX + 16 * MiB, WS_R = WS_OX + 16 * MiB;
constexpr size_t WS_Y0 = WS_R, WS_KV6 = WS_R + 152 * MiB, WS_MIX = WS_R + 201 * MiB, WS_H = WS_R + 265 * MiB;
constexpr size_t WS_Y1 = WS_R, WS_YG = WS_R + 168 * MiB;
constexpr size_t WS_XP = WS_R, WS_HP = WS_R + 68 * MiB, WS_YP = WS_R + 306 * MiB, WS_END = WS_R + 442 * MiB;
static_assert(WS_W_END == 242 * MiB && WS_END == 748 * MiB, "ws map");
constexpr int CW_TMO = 0, CW_CODE = 1, CW_CHK = 2;
constexpr int CW_BAR = 4096;
constexpr int CW_MOECNT = 16384;
constexpr int CW_MOEOFF = 20480;

constexpr int LDS_BYTES = 159744;
constexpr int MISC_OFF = LDS_BYTES - 512;
constexpr int SCR_BYTES = MISC_OFF;

#define GAS __attribute__((address_space(1)))
#define LAS __attribute__((address_space(3)))
typedef unsigned short bf16;
typedef unsigned v4u __attribute__((ext_vector_type(4)));
typedef unsigned v2u __attribute__((ext_vector_type(2)));
typedef float f32x4 __attribute__((ext_vector_type(4)));
typedef float f32x16 __attribute__((ext_vector_type(16)));
typedef short bf16x8 __attribute__((ext_vector_type(8)));
typedef short s16x4 __attribute__((ext_vector_type(4)));
typedef GAS unsigned gu32;
#define RLX_AGENT __ATOMIC_RELAXED, __HIP_MEMORY_SCOPE_AGENT
#define LDS_WAIT() asm volatile("s_waitcnt lgkmcnt(0)" ::: "memory")
#define VM_WAIT() asm volatile("s_waitcnt vmcnt(0)" ::: "memory")
#define SBAR() __builtin_amdgcn_sched_barrier(0)
__device__ __forceinline__ int lane_id() { return (int)threadIdx.x & 63; }
__device__ __forceinline__ unsigned f2bf(float f) { unsigned u = __builtin_bit_cast(unsigned, f); return (u + 0x7fffu + ((u >> 16) & 1u)) >> 16; }
__device__ __forceinline__ unsigned pk2(float lo, float hi) { return f2bf(lo) | (f2bf(hi) << 16); }
__device__ __forceinline__ float bf2f(unsigned short b) { return __builtin_bit_cast(float, ((unsigned)b) << 16); }
__device__ __forceinline__ float bflo(unsigned w) { return __builtin_bit_cast(float, w << 16); }
__device__ __forceinline__ float bfhi(unsigned w) { return __builtin_bit_cast(float, w & 0xffff0000u); }
__device__ __forceinline__ unsigned cvtpk(float lo, float hi) { unsigned r; asm volatile("v_cvt_pk_bf16_f32 %0, %1, %2" : "=v"(r) : "v"(lo), "v"(hi)); return r; }
__device__ __forceinline__ float wave_sum(float v) {
#pragma unroll
    for (int o = 1; o < 64; o <<= 1) v += __shfl_xor(v, o);
    return v;
}
using pg8::fsigmoid; using pg8::gelu_tanh; using pg8::fsilu;
__device__ __forceinline__ float fsoftplus(float x) { return x > 20.f ? x : log1pf(__expf(x)); }

#define XB_TMO      128
#define XB_XCNT(j)  (256  + 64 * (j))
#define XB_XSUB(j)  (1280 + 64 * (j))
#define XB_XGEN(j)  (2304 + 64 * (j))
#define XB_TOP      3328
#define XB_TOPGEN   3392
#define XCD_BAR_WORDS 3456
#define XB_SPIN_CAP (1u << 18)

__device__ __forceinline__ unsigned xb_ld(unsigned* p)              { return __hip_atomic_load(p, __ATOMIC_RELAXED, __HIP_MEMORY_SCOPE_AGENT); }
__device__ __forceinline__ unsigned xb_add(unsigned* p, unsigned v) { return __hip_atomic_fetch_add(p, v, __ATOMIC_RELAXED, __HIP_MEMORY_SCOPE_AGENT); }
__device__ __forceinline__ unsigned xb_xcc_id() { return (unsigned)__builtin_amdgcn_s_getreg((3 << 11) | 20) & 0xFu; }
#define XB_SPIN(cond, bar) do { unsigned _sp = 0; while (cond) { __builtin_amdgcn_s_sleep(1); \
    if ((++_sp & 255u) == 0u) { if (xb_ld(&(bar)[XB_TMO])) break; if (_sp > XB_SPIN_CAP) { atomicAdd(&(bar)[XB_TMO], 1u); break; } } } } while (0)

struct XcdBarrier {
    unsigned* bar; unsigned x;
    volatile LAS unsigned* st;
};

__device__ __forceinline__ XcdBarrier xcd_barrier_post(unsigned* bar, volatile LAS unsigned* st) {
    XcdBarrier b; b.bar = bar; b.x = xb_xcc_id(); b.st = st;
    if (threadIdx.x == 0) (void)xb_add(&bar[XB_XCNT(b.x)], 1u);
    return b;
}
__device__ __forceinline__ void xcd_barrier_complete(unsigned* bar, unsigned x, unsigned& nloc, unsigned& nx) {
    const unsigned G = gridDim.x * gridDim.y * gridDim.z;
    unsigned sum, cnt, mine, sp = 0u;
    for (;;) {
        sum = 0u; cnt = 0u; mine = 0u;
#pragma unroll
        for (unsigned j = 0; j < 16; ++j) { const unsigned c = xb_ld(&bar[XB_XCNT(j)]); sum += c; cnt += (c > 0u) ? 1u : 0u; mine = (j == x) ? c : mine; }
        if (sum == G) break;
        __builtin_amdgcn_s_sleep(1);
        if ((++sp & 255u) == 0u) { if (xb_ld(&bar[XB_TMO])) break; if (sp > XB_SPIN_CAP) { atomicAdd(&bar[XB_TMO], 1u); break; } }
    }
    nloc = mine > 0u ? mine : 1u; nx = cnt > 0u ? cnt : 1u;
}

__device__ __forceinline__ void xcd_barrier(const XcdBarrier& b) {
    asm volatile("s_waitcnt vmcnt(0)" ::: "memory");
    __syncthreads();
    if (threadIdx.x == 0) {
        unsigned* bar = b.bar;
        __builtin_amdgcn_s_waitcnt(0);
        unsigned nloc = b.st[0], nx = b.st[1];
        if (nloc == 0u) { xcd_barrier_complete(bar, b.x, nloc, nx); b.st[0] = nloc; b.st[1] = nx; }
        const unsigned old = xb_add(&bar[XB_XSUB(b.x)], 1u);
        const unsigned gen = old / nloc;
        if (old + 1u == (gen + 1u) * nloc) {
            __builtin_amdgcn_fence(__ATOMIC_RELEASE, "agent");
            asm volatile("s_waitcnt vmcnt(0)" ::: "memory");
            const unsigned og = xb_add(&bar[XB_TOP], 1u);
            const unsigned tg = og / nx;
            if (og + 1u == (tg + 1u) * nx) xb_add(&bar[XB_TOPGEN], 1u);
            else XB_SPIN(xb_ld(&bar[XB_TOPGEN]) == tg, bar);
            __builtin_amdgcn_fence(__ATOMIC_ACQUIRE, "agent");
            xb_add(&bar[XB_XGEN(b.x)], 1u);
            asm volatile("s_waitcnt vmcnt(0)" ::: "memory");
        } else {
            XB_SPIN(xb_ld(&bar[XB_XGEN(b.x)]) == gen, bar);
            __builtin_amdgcn_fence(__ATOMIC_ACQUIRE, "agent");
            asm volatile("s_waitcnt vmcnt(0)" ::: "memory");
        }
    }
    __syncthreads();
}

struct Args { const float* in[41]; float* out; unsigned char* ws; int ph_lo, ph_hi, li, pad; };
struct Frame { LAS unsigned char* lds; volatile LAS unsigned* MISC; gu32* ctl; unsigned char* ws; int tid, lane, wave, G, bid; };
enum { I_X = 0, I_MEM, I_NMIX, I_NCROSS, I_NMEM, I_NFFN, I_EVWIN, I_RGCW, I_RGCB, I_RGWA, I_RGBA, I_RGWX, I_RGBX, I_RGLAM, I_GATEB, I_QNORM, I_KNORM, I_CMPPOS,
       I_CKW1, I_CKW2, I_CVW1, I_CVW2, I_EVWOUT, I_ODWIN, I_ODCW, I_ODCB, I_DTB, I_ALOG, I_DSKIP, I_ODNORM, I_ODWOUT, I_XWQ, I_XWKV, I_XQN, I_XKN, I_XWO,
       I_FFW13, I_FFW2, I_ROUTER, I_MW13, I_MW2, N_IN };
static_assert(N_IN == 41, "input count");

template <int MAP>
__device__ __forceinline__ void transpose_item(const float* W, int N, bf16* WT, int ldt, LAS float* scr, int kb, int nb, int lane, int ffs, const float* kg = nullptr) {
    const int k0 = 64 * kb, n0 = 64 * nb; const int c4 = (lane & 15) * 4, r4 = lane >> 4;
    f32x4 tv[16];
    if ((N & 3) == 0) {
#pragma unroll
        for (int i = 0; i < 16; ++i) { const int kk = 4 * i + r4; tv[i] = (n0 + c4 < N) ? *(const GAS f32x4*)(W + (size_t)(k0 + kk) * N + n0 + c4) : (f32x4){0.f, 0.f, 0.f, 0.f}; }
    } else {
#pragma unroll
        for (int i = 0; i < 16; ++i) { const int kk = 4 * i + r4; const float* src = W + (size_t)(k0 + kk) * N + n0 + c4;
#pragma unroll
            for (int j = 0; j < 4; ++j) tv[i][j] = (n0 + c4 + j < N) ? src[j] : 0.f; }
    }
#pragma unroll
    for (int i = 0; i < 16; ++i) { const int kk = 4 * i + r4; const float gk = kg ? kg[k0 + kk] : 1.f;
#pragma unroll
        for (int j = 0; j < 4; ++j) scr[kk * 65 + c4 + j] = tv[i][j] * gk; }
    LDS_WAIT(); asm volatile("" ::: "memory");
    const int c = lane & 7;
#pragma unroll
    for (int j = 0; j < 8; ++j) { const int nl = (lane >> 3) + 8 * j, n = n0 + nl; const LAS float* s = scr + (8 * c) * 65 + nl;
        v4u o; o.x = pk2(s[0 * 65], s[1 * 65]); o.y = pk2(s[2 * 65], s[3 * 65]); o.z = pk2(s[4 * 65], s[5 * 65]); o.w = pk2(s[6 * 65], s[7 * 65]);
        int row = n; if (MAP == 1) row = (n < ffs) ? pg8::swiglu_row(n, 0) : pg8::swiglu_row(n - ffs, 1);
        if (n < ((N + 31) & ~31)) *(GAS v4u*)(WT + (size_t)row * ldt + k0 + 8 * c) = o; }
    LDS_WAIT(); asm volatile("" ::: "memory");
}
__device__ __forceinline__ unsigned pk4_fp8(float a, float b, float c, float d) { int r = __builtin_amdgcn_cvt_pk_fp8_f32(a, b, 0, false); r = __builtin_amdgcn_cvt_pk_fp8_f32(c, d, r, true); return (unsigned)r; }
template <int MAP>
__device__ __forceinline__ void transpose_item_f8(const float* W, int N, unsigned char* WT8, int ldt, LAS float* scr, int kb, int nb, int lane, int ffs, float sc) {
    const int k0 = 64 * kb, n0 = 64 * nb; const int c4 = (lane & 15) * 4, r4 = lane >> 4;
    f32x4 tv[16];
#pragma unroll
    for (int i = 0; i < 16; ++i) { const int kk = 4 * i + r4; tv[i] = *(const GAS f32x4*)(W + (size_t)(k0 + kk) * N + n0 + c4); }
#pragma unroll
    for (int i = 0; i < 16; ++i) { const int kk = 4 * i + r4;
#pragma unroll
        for (int j = 0; j < 4; ++j) scr[kk * 65 + c4 + j] = tv[i][j] * sc; }
    LDS_WAIT(); asm volatile("" ::: "memory");
    const int c = lane & 7;
#pragma unroll
    for (int j = 0; j < 8; ++j) { const int nl = (lane >> 3) + 8 * j, n = n0 + nl; const LAS float* s = scr + (8 * c) * 65 + nl;
        v2u o; o.x = pk4_fp8(s[0 * 65], s[1 * 65], s[2 * 65], s[3 * 65]); o.y = pk4_fp8(s[4 * 65], s[5 * 65], s[6 * 65], s[7 * 65]);
        int row = n; if (MAP == 1) row = (n < ffs) ? pg8::swiglu_row(n, 0) : pg8::swiglu_row(n - ffs, 1);
        *(GAS v2u*)(WT8 + (size_t)row * ldt + k0 + 8 * c) = o; }
    LDS_WAIT(); asm volatile("" ::: "memory");
}
constexpr int MOE_CONV_ITEMS = NEXP * (16 * 112 + 56 * 16);

__device__ __forceinline__ void rms_row_to_bf16(const float* xrow, const float* g, bf16* orow, int lane) {
    const GAS f32x4* xr = (const GAS f32x4*)xrow + lane; const GAS f32x4* gr = (const GAS f32x4*)g + lane;
    f32x4 v[4]; float s = 0.f;
#pragma unroll
    for (int j = 0; j < 4; ++j) { v[j] = xr[64 * j]; s += (v[j].x * v[j].x + v[j].y * v[j].y) + (v[j].z * v[j].z + v[j].w * v[j].w); }
    const float rstd = 1.f / sqrtf(wave_sum(s) * (1.f / D) + EPS);
    GAS unsigned long long* o8 = (GAS unsigned long long*)orow + lane;
#pragma unroll
    for (int j = 0; j < 4; ++j) { const f32x4 gg = gr[64 * j];
        o8[64 * j] = (unsigned long long)pk2(v[j].x * rstd * gg.x, v[j].y * rstd * gg.y) | ((unsigned long long)pk2(v[j].z * rstd * gg.z, v[j].w * rstd * gg.w) << 32); }
}
__device__ __forceinline__ void phase_rmsnorm(const Frame& F, const float* x, const float* g, bf16* xn, int rows) {
    const int gw = F.bid * NWAVES + F.wave, NGW = F.G * NWAVES;
    for (int m = gw; m < rows; m += NGW) rms_row_to_bf16(x + (size_t)m * D, g, xn + (size_t)m * D, F.lane);
}
#define TR_MAT(cnt_, W_, K_, N_, WT_, ldt_, MAPK_, ffs_, kg_) \
    if (r < (cnt_)) { const int nblk_ = ((N_) + 63) / 64; transpose_item<MAPK_>((W_), (N_), (WT_), (ldt_), scr, r / nblk_, r % nblk_, F.lane, (ffs_), (kg_)); continue; } r -= (cnt_);
constexpr int C_EVIN = 16 * 73, C_EVOUT = 32 * 16, C_CW1 = 64 * 4, C_ODIN = 16 * 81, C_ODOUT = 32 * 16, C_XQ = 16 * 8, C_XKV = 16 * 16, C_XO = 8 * 16, C_FF13 = 16 * 88, C_FF2 = 44 * 16;
constexpr int CONV_A = C_EVIN + 2 * C_XKV + 2 * C_CW1, CONV_B = C_EVOUT + 2 * C_XQ + 2 * C_XO + C_FF13 + C_FF2 + C_ODIN + C_ODOUT;
constexpr int CONV_ALL = CONV_A + CONV_B + MOE_CONV_ITEMS, CONV_Q = 4480, CONV_P2_END = CONV_ALL - 2 * CONV_Q;
__device__ __forceinline__ void convert_range(const Frame& F, const Args& a, int gw, int NGW, int it_lo, int it_hi) {
    LAS float* scr = (LAS float*)(F.lds + F.wave * 16640); unsigned char* ws = F.ws;
    for (int it = it_lo + gw; it < it_hi; it += NGW) {
        int r = it;
        TR_MAT(C_EVIN, a.in[I_EVWIN], D, EV_IN, (bf16*)(ws + WS_W_EVIN), D, 0, 0, nullptr)
        TR_MAT(C_XKV, a.in[I_XWKV], D, 1024, (bf16*)(ws + WS_W_XKV), D, 0, 0, nullptr)
        TR_MAT(C_XKV, a.in[I_XWKV] + (size_t)D * 1024, D, 1024, (bf16*)(ws + WS_W_XKV) + (size_t)1024 * D, D, 0, 0, nullptr)
        TR_MAT(C_CW1, a.in[I_CKW1], 4096, 256, (bf16*)(ws + WS_W_CK1), 4096, 0, 0, nullptr)
        TR_MAT(C_CW1, a.in[I_CVW1], 4096, 256, (bf16*)(ws + WS_W_CV1), 4096, 0, 0, nullptr)
        TR_MAT(C_EVOUT, a.in[I_EVWOUT], 2048, D, (bf16*)(ws + WS_W_EVOUT), 2048, 0, 0, nullptr)
        TR_MAT(C_XQ, a.in[I_XWQ], D, 512, (bf16*)(ws + WS_W_XQ), D, 0, 0, a.in[I_NCROSS])
        TR_MAT(C_XO, a.in[I_XWO], 512, D, (bf16*)(ws + WS_W_XO), 512, 0, 0, nullptr)
        TR_MAT(C_FF13, a.in[I_FFW13], D, 2 * FF, (bf16*)(ws + WS_W_FF13), D, 1, FF, a.in[I_NFFN])
        TR_MAT(C_FF2, a.in[I_FFW2], FF, D, (bf16*)(ws + WS_W_FF2), FF, 0, 0, nullptr)
        TR_MAT(C_ODIN, a.in[I_ODWIN], D, OD_IN, (bf16*)(ws + WS_W_ODIN), D, 0, 0, a.in[I_NMIX] + D)
        TR_MAT(C_ODOUT, a.in[I_ODWOUT], 2048, D, (bf16*)(ws + WS_W_ODOUT), 2048, 0, 0, nullptr)
        TR_MAT(C_XQ, a.in[I_XWQ] + (size_t)D * 512, D, 512, (bf16*)(ws + WS_W_XQ) + (size_t)512 * D, D, 0, 0, a.in[I_NCROSS] + D)
        TR_MAT(C_XO, a.in[I_XWO] + (size_t)512 * D, 512, D, (bf16*)(ws + WS_W_XO) + (size_t)D * 512, 512, 0, 0, nullptr)
        { constexpr int C_M13 = 16 * 112, C_M2 = 56 * 16;
          if (r < NEXP * C_M13) { const int e = r / C_M13, q = r % C_M13; transpose_item_f8<1>(a.in[I_MW13] + (size_t)e * D * 2 * FFE, 2 * FFE, ws + WS_W_M13 + (size_t)e * 2 * FFE * D, D, scr, q / 112, q % 112, F.lane, FFE, MOE_W13_SCALE); continue; } r -= NEXP * C_M13;
          { const int e = r / C_M2, q = r % C_M2; transpose_item<0>(a.in[I_MW2] + (size_t)e * FFE * D, D, (bf16*)(ws + WS_W_M2) + (size_t)e * D * FFE, FFE, scr, q / 16, q % 16, F.lane, 0); } }
    }
}
__device__ __forceinline__ void p0_prologue(const Frame& F, const Args& a) {
    const int gw = F.bid * NWAVES + F.wave, NGW = F.G * NWAVES;
    unsigned char* ws = F.ws;
    convert_range(F, a, gw, NGW, 0, CONV_A);
    for (int i = F.bid * NTHR + F.tid; i < 2 * 224 * 128; i += F.G * NTHR) { const int w = i / (224 * 128), q = i % (224 * 128);
        bf16* base = w == 0 ? (bf16*)(ws + WS_W_EVIN) + (size_t)4640 * D : (bf16*)(ws + WS_W_ODIN) + (size_t)5152 * D; *(GAS v4u*)(base + (size_t)q * 8) = (v4u){0u, 0u, 0u, 0u}; }
    phase_rmsnorm(F, a.in[I_X], a.in[I_NMIX], (bf16*)(ws + WS_XN), M);
    phase_rmsnorm(F, a.in[I_MEM], a.in[I_NMEM], (bf16*)(ws + WS_MEMN), MMEM);
    phase_rmsnorm(F, a.in[I_MEM], a.in[I_NMEM] + D, (bf16*)(ws + WS_MEMN) + (size_t)MMEM * D, MMEM);
    for (int i = F.bid * NTHR + F.tid; i < 512 * 128; i += F.G * NTHR) { const int n = i >> 7, j = i & 127; ((bf16*)(ws + WS_OV))[i] = (n <= 510 && n >= 4 * j - 1 && n <= 4 * j + 3) ? (bf16)0x3F80 : (bf16)0; }
    for (int it = gw; it < 128; it += NGW) { const int mm = it >> 6, ic = it & 63; const float* w1 = a.in[mm ? I_CVW1 : I_CKW1]; const float* pos = a.in[I_CMPPOS];
        f32x4 acc = {0.f, 0.f, 0.f, 0.f};
        for (int rr = 0; rr < 64; ++rr) { const int i = ic * 64 + rr; const float p = pos[i]; const f32x4 w = *(const GAS f32x4*)(w1 + (size_t)i * 256 + 4 * F.lane); acc += w * p; }
        *(GAS f32x4*)((float*)(ws + WS_CMPB_PART) + (size_t)(mm * 64 + ic) * 256 + 4 * F.lane) = acc; }
}
#undef TR_MAT
namespace att {
constexpr float SCALE = 0.08838834764831845f;
constexpr float THR = 8.f;
constexpr int KVBLK = 64, DH = 128;
constexpr int SHM_V = KVBLK * DH * 2, SHM_K = KVBLK * DH * 2;
constexpr int NSLOT = 3;
constexpr int LDS_ATT = NSLOT * SHM_V + NSLOT * SHM_K + NWAVES * 64 * 4;
#define KSWZ(row, colB) ((row) * 256 + ((colB) ^ (((row) & 7) << 4)))
__device__ __forceinline__ int v_st(int k, int c) { const int kk = (k & ~0xC) | ((k & 4) << 1) | ((k & 8) >> 1); return ((kk >> 3) * 4 + (c >> 5)) * 512 + ((kk & 7) * 32 + (c & 31)) * 2; }
__device__ __forceinline__ int v_rd_base(int lane) { return ((lane & 3) << 3) | (((lane >> 2) & 3) << 6) | (((lane >> 4) & 1) << 5) | (((lane >> 5) & 1) << 8); }
constexpr int v_rd_off(int d0, int ks, int half) { return d0 * 512 + ks * 4096 + half * 2048; }
__device__ __forceinline__ int crow(int r, int hi) { return (r & 3) + 8 * (r >> 2) + 4 * hi; }
__device__ __forceinline__ bf16x8 pack8(f32x4 a, f32x4 b) { v4u w = {cvtpk(a[0], a[1]), cvtpk(a[2], a[3]), cvtpk(b[0], b[1]), cvtpk(b[2], b[3])}; return *reinterpret_cast<bf16x8*>(&w); }

__device__ __forceinline__ void mask_tile(f32x16& p0, f32x16& p1, int dq, unsigned W) {
    asm volatile("" : "+v"(dq));
    const float NEG = -__builtin_inff();
#pragma unroll
    for (int r = 0; r < 16; ++r) { const int c = (r & 3) + 8 * (r >> 2);
        if ((unsigned)(dq - c) >= W) p0[r] = NEG;
        if ((unsigned)(dq - c - 32) >= W) p1[r] = NEG; }
}
__device__ __forceinline__ void mask_all(f32x16& p0, f32x16& p1) { const float NEG = -__builtin_inff();
#pragma unroll
    for (int r = 0; r < 16; ++r) { p0[r] = NEG; p1[r] = NEG; } }
__device__ __forceinline__ void partialSM(f32x16& p0, f32x16& p1, float& m_reg, float& mn, float& alpha, bool keep = true) {
    float pmax = p0[0];
#pragma unroll
    for (int r = 1; r < 16; ++r) pmax = fmaxf(pmax, p0[r]);
#pragma unroll
    for (int r = 0; r < 16; ++r) pmax = fmaxf(pmax, p1[r]);
    pmax = keep ? pmax : -__builtin_inff();
    { auto rr = __builtin_amdgcn_permlane32_swap(__float_as_uint(pmax), __float_as_uint(pmax), false, false);
      pmax = fmaxf(__uint_as_float(rr[0]), __uint_as_float(rr[1])); }
    constexpr float C2 = 1.4426950408889634f * SCALE;
    if (__builtin_expect(__all((pmax - m_reg) * SCALE <= THR), 1)) { mn = m_reg; alpha = 1.f; }
    else { mn = fmaxf(m_reg, pmax); alpha = __builtin_amdgcn_exp2f((m_reg - mn) * C2); m_reg = mn; }
    const float mnL = keep ? -mn * C2 : -__builtin_inff();
#pragma unroll
    for (int r = 0; r < 16; ++r) p0[r] = fmaf(p0[r], C2, mnL);
#pragma unroll
    for (int r = 0; r < 16; ++r) p1[r] = fmaf(p1[r], C2, mnL);
#pragma unroll
    for (int r = 0; r < 16; ++r) p0[r] = __builtin_amdgcn_exp2f(p0[r]);
}
__device__ __forceinline__ void finishSM(f32x16& p0, f32x16& p1, float alpha, float& l_reg, bf16x8& pa0, bf16x8& pa1, bf16x8& pa2, bf16x8& pa3) {
#pragma unroll
    for (int r = 0; r < 16; ++r) p1[r] = __builtin_amdgcn_exp2f(p1[r]);
    float ps = 0;
#pragma unroll
    for (int r = 0; r < 16; ++r) ps += p0[r];
#pragma unroll
    for (int r = 0; r < 16; ++r) ps += p1[r];
    { auto rr = __builtin_amdgcn_permlane32_swap(__float_as_uint(ps), __float_as_uint(ps), false, false);
      ps = __uint_as_float(rr[0]) + __uint_as_float(rr[1]); }
    l_reg = l_reg * alpha + ps;
#define PK4(P, B_, OUT) do { unsigned a0 = cvtpk(P[B_+0], P[B_+1]), a1 = cvtpk(P[B_+2], P[B_+3]);                          \
        unsigned b0 = cvtpk(P[B_+4], P[B_+5]), b1 = cvtpk(P[B_+6], P[B_+7]);                                             \
        auto r0 = __builtin_amdgcn_permlane32_swap(a0, b0, false, false); auto r1 = __builtin_amdgcn_permlane32_swap(a1, b1, false, false); \
        v4u w = {r0[0], r1[0], r0[1], r1[1]}; OUT = *reinterpret_cast<bf16x8*>(&w); } while (0)
    PK4(p0, 0, pa0); PK4(p0, 8, pa1); PK4(p1, 0, pa2); PK4(p1, 8, pa3);
#undef PK4
}
__device__ __forceinline__ void qkt(f32x16& p0, f32x16& p1, const char* Kslot, int r32, int hi, const bf16x8* qr) {
    p0 = f32x16{}; p1 = f32x16{};
    const char* kb[4];
#pragma unroll
    for (int dd = 0; dd < 4; ++dd) kb[dd] = Kslot + KSWZ(r32, (dd * 16 + hi * 8) * 2);
    bf16x8 fa[4], fb[4];
#define KLD(dst, i, d0) do { const char* a_ = kb[(d0) & 3] + ((d0) >> 2) * 128; dst[i] = *reinterpret_cast<const bf16x8*>(a_); dst[i + 1] = *reinterpret_cast<const bf16x8*>(a_ + 32 * 256); } while (0)
#define KMM(src, i, d0) do { p0 = __builtin_amdgcn_mfma_f32_32x32x16_bf16(src[i], qr[d0], p0, 0, 0, 0); p1 = __builtin_amdgcn_mfma_f32_32x32x16_bf16(src[i + 1], qr[d0], p1, 0, 0, 0); } while (0)
    KLD(fa, 0, 0); KLD(fa, 2, 1); KLD(fb, 0, 2); KLD(fb, 2, 3); SBAR();
    KMM(fa, 0, 0); KMM(fa, 2, 1); SBAR(); KLD(fa, 0, 4); KLD(fa, 2, 5); SBAR();
    KMM(fb, 0, 2); KMM(fb, 2, 3); SBAR(); KLD(fb, 0, 6); KLD(fb, 2, 7); SBAR();
    KMM(fa, 0, 4); KMM(fa, 2, 5); SBAR();
    KMM(fb, 0, 6); KMM(fb, 2, 7);
#undef KLD
#undef KMM
}
__device__ __forceinline__ void pv_tile(f32x16* o, int vbs, bf16x8 pa0, bf16x8 pa1, bf16x8 pa2, bf16x8 pa3) {
#define TRRD(dst, off) asm volatile("ds_read_b64_tr_b16 %0, %1 offset:%2" : "=&v"(dst) : "v"(vbs), "i"(off) : "memory")
#define PV_D0(d0) do { s16x4 l0, l1, l2, l3, h0, h1, h2, h3; constexpr int b_ = v_rd_off(d0, 0, 0); \
        TRRD(l0, b_); TRRD(h0, b_ + 2048); TRRD(l1, b_ + 4096); TRRD(h1, b_ + 6144); TRRD(l2, b_ + 8192); TRRD(h2, b_ + 10240); TRRD(l3, b_ + 12288); TRRD(h3, b_ + 14336); \
        asm volatile("s_waitcnt lgkmcnt(0)" ::: "memory"); SBAR();   \
        o[d0] = __builtin_amdgcn_mfma_f32_32x32x16_bf16(pa0, (bf16x8){l0[0], l0[1], l0[2], l0[3], h0[0], h0[1], h0[2], h0[3]}, o[d0], 0, 0, 0);   \
        o[d0] = __builtin_amdgcn_mfma_f32_32x32x16_bf16(pa1, (bf16x8){l1[0], l1[1], l1[2], l1[3], h1[0], h1[1], h1[2], h1[3]}, o[d0], 0, 0, 0);   \
        o[d0] = __builtin_amdgcn_mfma_f32_32x32x16_bf16(pa2, (bf16x8){l2[0], l2[1], l2[2], l2[3], h2[0], h2[1], h2[2], h2[3]}, o[d0], 0, 0, 0);   \
        o[d0] = __builtin_amdgcn_mfma_f32_32x32x16_bf16(pa3, (bf16x8){l3[0], l3[1], l3[2], l3[3], h3[0], h3[1], h3[2], h3[3]}, o[d0], 0, 0, 0); } while (0)
    PV_D0(0); PV_D0(1); PV_D0(2); PV_D0(3);
#undef PV_D0
#undef TRRD
}
__device__ __forceinline__ void q_issue(const bf16* qrow, int hi, v4u (&raw)[8]) {
#pragma unroll
    for (int d0 = 0; d0 < 8; ++d0) raw[d0] = *(const GAS v4u*)(qrow + d0 * 16 + hi * 8);
}
__device__ __forceinline__ void q_finish(const v4u (&raw)[8], const float* g, int hi, bf16x8* qr) {
    float ss = 0.f;
#pragma unroll
    for (int d0 = 0; d0 < 8; ++d0)
#pragma unroll
        for (int j = 0; j < 4; ++j) { const float a = bflo(raw[d0][j]), b = bfhi(raw[d0][j]); ss += a * a + b * b; }
    ss += __shfl_xor(ss, 32);
    const float rstd = 1.f / sqrtf(ss * (1.f / 128.f) + EPS);
#pragma unroll
    for (int d0 = 0; d0 < 8; ++d0) { const f32x4 g0 = *(const GAS f32x4*)(g + d0 * 16 + hi * 8), g1 = *(const GAS f32x4*)(g + d0 * 16 + hi * 8 + 4);
        v4u w; w.x = cvtpk(bflo(raw[d0][0]) * rstd * g0[0], bfhi(raw[d0][0]) * rstd * g0[1]); w.y = cvtpk(bflo(raw[d0][1]) * rstd * g0[2], bfhi(raw[d0][1]) * rstd * g0[3]);
        w.z = cvtpk(bflo(raw[d0][2]) * rstd * g1[0], bfhi(raw[d0][2]) * rstd * g1[1]); w.w = cvtpk(bflo(raw[d0][3]) * rstd * g1[2], bfhi(raw[d0][3]) * rstd * g1[3]);
        qr[d0] = *reinterpret_cast<bf16x8*>(&w); }
}
__device__ __forceinline__ void load_q(const bf16* qrow, const float* g, int hi, bf16x8* qr) { v4u raw[8]; q_issue(qrow, hi, raw); q_finish(raw, g, hi, qr); }
struct PassIO { const bf16* Kp; int ldk; const bf16* Vp; int ldv; int t_lo, t_hi; };
__device__ __forceinline__ void dma_offsets(int wid, int lane, int ldk, int ldv, unsigned& koff, unsigned& voff) {
    const int row = 4 * wid + (lane >> 4); koff = (unsigned)(row * ldk * 2 + (((lane & 15) ^ (row & 7)) << 4));
    const int st = 2 * wid + (lane >> 5), kk = ((st >> 2) << 3) | ((lane & 31) >> 2), k = (kk & ~0xC) | ((kk & 4) << 1) | ((kk & 8) >> 1); voff = (unsigned)(k * ldv * 2 + ((st & 3) * 32 + 8 * (lane & 3)) * 2);
}
#define ATT_DMA(io_, t, slot) do { const char* kt_ = (const char*)(io_).Kp + (size_t)(t) * (KVBLK * 2) * (io_).ldk; const char* vt_ = (const char*)(io_).Vp + (size_t)(t) * (KVBLK * 2) * (io_).ldv;          \
        LAS unsigned* kd_ = (LAS unsigned*)(ldsl + NSLOT * SHM_V + (slot) * SHM_K + wid * 1024); LAS unsigned* vd_ = (LAS unsigned*)(ldsl + (slot) * SHM_V + wid * 1024);                \
        __builtin_amdgcn_global_load_lds((const unsigned*)(kt_ + koff), kd_, 16, 0, 0); __builtin_amdgcn_global_load_lds((const unsigned*)(kt_ + koff + (size_t)64 * (io_).ldk), kd_ + 2048, 16, 0, 0); \
        __builtin_amdgcn_global_load_lds((const unsigned*)(vt_ + voff), vd_, 16, 0, 0); __builtin_amdgcn_global_load_lds((const unsigned*)(vt_ + voff + (size_t)64 * (io_).ldv), vd_ + 2048, 16, 0, 0); } while (0)
__device__ __forceinline__ void attn_prefetch(char* lds, const PassIO& io) {
    int tid = threadIdx.x; asm volatile("" : "+v"(tid));
    const int wid = __builtin_amdgcn_readfirstlane(tid >> 6), lane = tid & 63;
    unsigned koff, voff; dma_offsets(wid, lane, io.ldk, io.ldv, koff, voff);
    LAS unsigned char* ldsl = (LAS unsigned char*)lds;
    ATT_DMA(io, io.t_lo, 0); if (io.t_hi - io.t_lo > 1) ATT_DMA(io, io.t_lo + 1, 1);
}
template <class MaskF>
__device__ __forceinline__ void attn_pass(char* lds, const bf16x8* qr, const PassIO& io, const MaskF& mf, f32x16 (&o)[4], float& l_out) {
    int tid = threadIdx.x; asm volatile("" : "+v"(tid));
    const int wid = __builtin_amdgcn_readfirstlane(tid >> 6), lane = tid & 63, r32 = lane & 31, hi = lane >> 5;
    char* V_lds = lds; char* K_lds = lds + NSLOT * SHM_V;
    float* wsc = (float*)(lds + NSLOT * SHM_V + NSLOT * SHM_K) + wid * 64; float* al_l = wsc + 32;
    float m_reg = -1e30f, l_reg = 0.f;
#pragma unroll
    for (int d = 0; d < 4; ++d) o[d] = f32x16{};
    const int vb0 = (int)(uintptr_t)V_lds + v_rd_base(lane);
    const int t_lo = io.t_lo, NT = io.t_hi - io.t_lo;
    unsigned koff, voff; dma_offsets(wid, lane, io.ldk, io.ldv, koff, voff);
    LAS unsigned char* ldsl = (LAS unsigned char*)lds;
    f32x16 p0, p1; float mn, alpha = 1.f; bf16x8 pa0, pa1, pa2, pa3;
#define A_RESC(a) do { if (__any((a) < 1.f)) { if (hi == 0) al_l[r32] = (a); asm volatile("s_waitcnt lgkmcnt(0)" ::: "memory"); \
        _Pragma("unroll") for (int d_ = 0; d_ < 4; ++d_) _Pragma("unroll") for (int r = 0; r < 16; ++r) o[d_][r] *= al_l[crow(r, hi)]; } } while (0)
#define A_BAR() do { asm volatile("" ::: "memory"); __builtin_amdgcn_s_barrier(); asm volatile("" ::: "memory"); } while (0)
    const bool lead = wid < 4;
    VM_WAIT();
    __syncthreads();
    if (!lead) A_BAR();
    int sK = 0, sV = 2, sW = 1;
    bool act_prev = false;
    for (int i = 0; i < NT; ++i) {
        if (lead && i >= 1 && i + 1 < NT) ATT_DMA(io, t_lo + i + 1, sW);
        const bool act = mf.active(t_lo + i);
        SBAR(); if (act) qkt(p0, p1, K_lds + sK * SHM_K, r32, hi, qr);
        if (i > 0 && act_prev) pv_tile(o, vb0 + sV * SHM_V, pa0, pa1, pa2, pa3);
        if (!lead && i + 1 < NT) VM_WAIT();
        A_BAR();
        if (!lead && i + 2 < NT) ATT_DMA(io, t_lo + i + 2, sV);
        if (act) { mf(p0, p1, t_lo + i); partialSM(p0, p1, m_reg, mn, alpha, mf.keep(t_lo + i)); A_RESC(alpha); finishSM(p0, p1, alpha, l_reg, pa0, pa1, pa2, pa3); }
        act_prev = act;
        if (lead && i + 1 < NT) VM_WAIT();
        A_BAR();
        { const int t_ = sV; sV = sK; sK = sW; sW = t_; }
    }
    if (act_prev) pv_tile(o, vb0 + sV * SHM_V, pa0, pa1, pa2, pa3);
    if (lead) A_BAR();
    __syncthreads();
#undef A_RESC
#undef A_BAR
    l_out = l_reg;
}
__device__ __forceinline__ void row_inv_l(char* lds, float l_reg, float (&rli)[16]) {
    const int tid = threadIdx.x, wid = __builtin_amdgcn_readfirstlane(tid >> 6), lane = tid & 63, r32 = lane & 31, hi = lane >> 5;
    float* wsc = (float*)(lds + NSLOT * SHM_V + NSLOT * SHM_K) + wid * 64;
    if (hi == 0) wsc[r32] = l_reg;
    asm volatile("s_waitcnt lgkmcnt(0)" ::: "memory");
#pragma unroll
    for (int r = 0; r < 16; ++r) { const float l = wsc[crow(r, hi)]; rli[r] = l > 0.f ? __builtin_amdgcn_rcpf(l) : 0.f; }
    asm volatile("s_waitcnt lgkmcnt(0)" ::: "memory");
}
struct NoMask { __device__ __forceinline__ void operator()(f32x16&, f32x16&, int) const {} __device__ __forceinline__ bool active(int) const { return true; } __device__ __forceinline__ bool keep(int) const { return true; } };
}
__device__ __forceinline__ void norm128_rows(const Frame& F, const bf16* src, size_t lds_, bf16* dst, size_t ldd, int nrows, const float* g, int gw, int NGW) {
    const int sub = F.lane >> 4, l16 = F.lane & 15;
    const f32x4 g0 = *(const GAS f32x4*)(g + l16 * 8), g1 = *(const GAS f32x4*)(g + l16 * 8 + 4);
    for (int r0 = gw * 4; r0 < nrows; r0 += NGW * 4) { const int r = r0 + sub;
        const v4u raw = *(const GAS v4u*)(src + (size_t)r * lds_ + l16 * 8);
        float ss = 0.f;
#pragma unroll
        for (int j = 0; j < 4; ++j) { const float a = bflo(raw[j]), b = bfhi(raw[j]); ss += a * a + b * b; }
        ss += __shfl_xor(ss, 1); ss += __shfl_xor(ss, 2); ss += __shfl_xor(ss, 4); ss += __shfl_xor(ss, 8);
        const float rstd = 1.f / sqrtf(ss * (1.f / 128.f) + EPS);
        v4u w; w.x = cvtpk(bflo(raw[0]) * rstd * g0[0], bfhi(raw[0]) * rstd * g0[1]); w.y = cvtpk(bflo(raw[1]) * rstd * g0[2], bfhi(raw[1]) * rstd * g0[3]);
        w.z = cvtpk(bflo(raw[2]) * rstd * g1[0], bfhi(raw[2]) * rstd * g1[1]); w.w = cvtpk(bflo(raw[3]) * rstd * g1[2], bfhi(raw[3]) * rstd * g1[3]);
        *(GAS v4u*)(dst + (size_t)r * ldd + l16 * 8) = w; }
}
__device__ __forceinline__ void phase_memk_norm(const Frame& F, const Args& a, int l, int gw, int NGW) {
    const bf16* kvm = (const bf16*)(F.ws + WS_KVM) + (size_t)l * MMEM * 1024; bf16* km = (bf16*)(F.ws + WS_KM) + (size_t)l * MMEM * 512;
    for (int bh = 0; bh < BATCH * XH; ++bh) { const int b = bh >> 2, h = bh & 3;
        norm128_rows(F, kvm + (size_t)b * MEMLEN * 1024 + h * 128, 1024, km + (size_t)bh * MEMLEN * 128, 128, MEMLEN, a.in[I_XKN] + l * 128, gw, NGW); }
}

__device__ __forceinline__ void phase_cross_attn(const Frame& F, const Args& a, int l) {
    char* lds = (char*)F.lds; const int r32 = F.lane & 31, hi = F.lane >> 5;
    const bf16* QX = (const bf16*)(F.ws + WS_QX); bf16* OX = (bf16*)(F.ws + WS_OX);
    for (int u = F.bid; u < BATCH * XH * (SEQ / 256); u += F.G) {
        const int tb = u % (SEQ / 256), bh = u / (SEQ / 256), b = bh >> 2, h = bh & 3;
        const size_t row0 = (size_t)b * SEQ + tb * 256 + F.wave * 32;
        const bf16* Kp = (const bf16*)(F.ws + WS_KM) + (size_t)l * MMEM * 512 + (size_t)bh * MEMLEN * 128;
        const bf16* Vp = (const bf16*)(F.ws + WS_KVM) + (size_t)l * MMEM * 1024 + (size_t)b * MEMLEN * 1024 + 512 + h * 128;
        const att::PassIO io{Kp, 128, Vp, 1024, 0, MEMLEN / 64}; att::attn_prefetch(lds, io);
        bf16x8 qr[8]; att::load_q(QX + (row0 + r32) * 512 + h * 128, a.in[I_XQN] + l * 128, hi, qr);
        f32x16 o[4]; float l_reg; att::attn_pass(lds, qr, io, att::NoMask{}, o, l_reg);
        float rli[16]; att::row_inv_l(lds, l_reg, rli);
#pragma unroll
        for (int r = 0; r < 16; ++r) { bf16* orow = OX + (row0 + att::crow(r, hi)) * 512 + h * 128;
#pragma unroll
            for (int d0 = 0; d0 < 4; ++d0) { const float v = o[d0][r] * rli[r]; const float vn = __shfl_xor(v, 1);
                if ((r32 & 1) == 0) *(GAS unsigned*)(orow + d0 * 32 + r32) = cvtpk(v, vn); } }
    }
}

constexpr int NSA_GSC = att::LDS_ATT, NSA_IMP = NSA_GSC + NWAVES * 32 * 3 * 4, NSA_SEL = NSA_IMP + NWAVES * 8 * 128 * 4, NSA_SELU = NSA_SEL + 64 * 4 * 4, NSA_LDS_END = NSA_SELU + NWAVES * 4 * 4;
static_assert(NSA_LDS_END <= SCR_BYTES, "nsa lds");
struct CmpMask { int nmax, hi, nmin_wave;
    __device__ __forceinline__ void operator()(f32x16& p0, f32x16& p1, int t) const { if (t * 64 + 63 <= nmin_wave) return; att::mask_tile(p0, p1, nmax - t * 64 - 4 * hi, 0x40000000u); }
    __device__ __forceinline__ bool active(int) const { return true; } __device__ __forceinline__ bool keep(int) const { return true; } };
struct WinMask { int P, hi, qb;
    __device__ __forceinline__ void operator()(f32x16& p0, f32x16& p1, int t) const { if (t == qb || t == qb - 8) att::mask_tile(p0, p1, P - t * 64 - 4 * hi, 512u); }
    __device__ __forceinline__ bool active(int) const { return true; } __device__ __forceinline__ bool keep(int) const { return true; } };
struct SlcMask { const LAS unsigned* selw; const LAS unsigned* uni; int P, hi, qb;
    __device__ __forceinline__ void operator()(f32x16& p0, f32x16& p1, int t) const { if (t == qb) att::mask_tile(p0, p1, P - t * 64 - 4 * hi, 0x40000000u); }
    __device__ __forceinline__ bool keep(int t) const { return (selw[t >> 5] >> (t & 31)) & 1u; }
    __device__ __forceinline__ bool active(int t) const { return (__builtin_amdgcn_readfirstlane(uni[t >> 5]) >> (t & 31)) & 1u; } };

__device__ __forceinline__ void nsa_unit(const Frame& F, const Args& a, int b, int g, int qb, int dry = 0) {
    char* lds = (char*)F.lds; const int w = F.wave; const int t0 = qb * 64;
#define NSA_LANE() int lane = F.lane; asm volatile("" : "+v"(lane)); const int r32 = lane & 31, hi = lane >> 5; const int tok = 8 * w + (r32 >> 2), head = 4 * g + (r32 & 3), P = t0 + tok; (void)head; (void)P; (void)tok
    unsigned char* wsl = F.ws; asm volatile("" : "+s"(wsl));
    const bf16* Y0 = (const bf16*)(wsl + WS_Y0); const bf16* KV6 = (const bf16*)(wsl + WS_KV6);
    const size_t slab = (size_t)SEQ * 128, bg = (size_t)(b * 2 + g);
    LAS float* gsc = (LAS float*)(F.lds + NSA_GSC) + w * 96; LAS float* imp = (LAS float*)(F.lds + NSA_IMP) + w * 1024; LAS unsigned* selm = (LAS unsigned*)(F.lds + NSA_SEL);
    { NSA_LANE();
      if (hi == 0) {
#pragma unroll
        for (int br = 0; br < 3; ++br) gsc[r32 * 3 + br] = fsigmoid(bf2f(Y0[((size_t)b * SEQ + P) * EV_INP + 4608 + head * 3 + br]) + a.in[I_GATEB][head * 3 + br]); }
      LDS_WAIT(); }
    f32x16 o[4]; float l_reg; float rli[16];
    const bf16* KCMP = (const bf16*)(wsl + WS_KVCMP) + bg * 512 * 128; const bf16* VCMP = (const bf16*)(wsl + WS_KVCMP) + (size_t)2048 * 128 + bg * 512 * 128;
    const int ncmp_t = ((4 * qb + 2) >> 6) + 1;
    const att::PassIO io_imp{KCMP, 128, (const bf16*)(wsl + WS_OV), 128, 0, ncmp_t}, io_cmp{KCMP, 128, VCMP, 128, 0, ncmp_t},
                      io_slc{KV6 + (2 * 4 + bg) * slab, 128, KV6 + (3 * 4 + bg) * slab, 128, 0, qb + 1}, io_win{KV6 + (4 * 4 + bg) * slab, 128, KV6 + (5 * 4 + bg) * slab, 128, qb >= 8 ? qb - 8 : 0, qb + 1};
    v4u qraw[8];
#define NSA_QISSUE() do { NSA_LANE(); att::q_issue(Y0 + ((size_t)b * SEQ + P) * EV_INP + 2048 + head * 128, hi, qraw); } while (0)
    att::attn_prefetch(lds, io_imp); NSA_QISSUE();
    { NSA_LANE(); const CmpMask cm{(P - 31) >> 4, hi, (t0 + 8 * w - 31) >> 4};
      bf16x8 qr[8]; att::q_finish(qraw, a.in[I_QNORM], hi, qr);
      if (dry < 2) att::attn_pass(lds, qr, io_imp, cm, o, l_reg); else { VM_WAIT(); __syncthreads(); l_reg = 1.f; } }
    att::attn_prefetch(lds, io_cmp); NSA_QISSUE();
    if (dry < 3) {
    att::row_inv_l(lds, l_reg, rli);
    { NSA_LANE();
#pragma unroll
    for (int q = 0; q < 4; ++q)
#pragma unroll
        for (int d = 0; d < 4; ++d) { float s = 0.f;
#pragma unroll
            for (int i = 0; i < 4; ++i) s += o[d][4 * q + i] * rli[4 * q + i];
            imp[(2 * q + hi) * 128 + d * 32 + r32] = s; }
    LDS_WAIT();
    { const unsigned long long lt = (1ull << lane) - 1ull;
#pragma unroll 1
    for (int tl = 0; tl < 8; ++tl) { unsigned k0, k1;
        { const int j0 = lane, j1 = lane + 64; const float v0 = imp[tl * 128 + j0], v1 = imp[tl * 128 + j1];
          const float s0 = v0 + (((j0 == 0) || (j0 == qb) || (j0 == qb - 1)) ? 100.f : 0.f), s1 = v1 + (((j1 == 0) || (j1 == qb) || (j1 == qb - 1)) ? 100.f : 0.f);
          k0 = (j0 <= qb) ? __float_as_uint(s0) + 1u : 0u; k1 = (j1 <= qb) ? __float_as_uint(s1) + 1u : 0u; }
        unsigned T = 0u;
#pragma unroll 1
        for (int bit = 30; bit >= 0; --bit) { const unsigned cand = T | (1u << bit);
            const int cnt = __popcll(__ballot(k0 >= cand)) + __popcll(__ballot(k1 >= cand)); if (cnt >= 16) T = cand; }
        const unsigned long long g0 = __ballot(k0 > T), g1 = __ballot(k1 > T), e0 = __ballot(k0 == T), e1 = __ballot(k1 == T);
        const int need = 16 - (__popcll(g0) + __popcll(g1));
        const bool sel0 = (k0 > T) || (k0 == T && __popcll(e0 & lt) < need), sel1 = (k1 > T) || (k1 == T && __popcll(e0) + __popcll(e1 & lt) < need);
        const unsigned long long m0 = __ballot(sel0 && lane <= qb), m1 = __ballot(sel1 && lane + 64 <= qb);
        if (lane == 0) { LAS unsigned* sw = selm + (8 * w + tl) * 4; sw[0] = (unsigned)m0; sw[1] = (unsigned)(m0 >> 32); sw[2] = (unsigned)m1; sw[3] = (unsigned)(m1 >> 32); } } }
    LDS_WAIT();
    if (lane < 4) { unsigned u = 0;
#pragma unroll
        for (int tl = 0; tl < 8; ++tl) u |= selm[(8 * w + tl) * 4 + lane];
        ((LAS unsigned*)(F.lds + NSA_SELU))[w * 4 + lane] = u; }
    LDS_WAIT(); }
    }
    { NSA_LANE(); const CmpMask cm{(P - 31) >> 4, hi, (t0 + 8 * w - 31) >> 4};
      bf16x8 qr[8]; att::q_finish(qraw, a.in[I_QNORM], hi, qr);
#if defined(MK_NSA_DUP) && MK_NSA_DUP == 2
      att::attn_pass(lds, qr, io_cmp, cm, o, l_reg); att::attn_prefetch(lds, io_cmp);
#endif
      if (dry < 2) att::attn_pass(lds, qr, io_cmp, cm, o, l_reg); else { VM_WAIT(); __syncthreads(); l_reg = 1.f; } }
    att::attn_prefetch(lds, io_slc); NSA_QISSUE();
    att::row_inv_l(lds, l_reg, rli);
    unsigned oacc[4][8];
    if (dry < 4) { NSA_LANE();
#pragma unroll
    for (int r = 0; r < 16; ++r) rli[r] *= gsc[att::crow(r, hi) * 3 + 0];
#pragma unroll
    for (int d = 0; d < 4; ++d)
#pragma unroll
        for (int r = 0; r < 16; r += 2) oacc[d][r >> 1] = cvtpk(o[d][r] * rli[r], o[d][r + 1] * rli[r + 1]); }
    { NSA_LANE(); const SlcMask sm{selm + tok * 4, (const LAS unsigned*)(F.lds + NSA_SELU) + w * 4, P, hi, qb};
      bf16x8 qr[8]; att::q_finish(qraw, a.in[I_QNORM], hi, qr);
#if defined(MK_NSA_DUP) && MK_NSA_DUP == 5
      { const size_t bg2 = (bg + 1) & 3; const att::PassIO io_cold{KV6 + (2 * 4 + bg2) * slab, 128, KV6 + (3 * 4 + bg2) * slab, 128, 0, qb + 1};
        att::attn_pass(lds, qr, io_cold, sm, o, l_reg); att::attn_prefetch(lds, io_slc); }
#endif
#if defined(MK_NSA_DUP) && MK_NSA_DUP == 3
      att::attn_pass(lds, qr, io_slc, sm, o, l_reg); att::attn_prefetch(lds, io_slc);
#endif
      if (!dry) att::attn_pass(lds, qr, io_slc, sm, o, l_reg); else { VM_WAIT(); __syncthreads(); } }
    att::attn_prefetch(lds, io_win); NSA_QISSUE();
    att::row_inv_l(lds, l_reg, rli);
    if (dry < 4) { NSA_LANE();
#pragma unroll
    for (int r = 0; r < 16; ++r) rli[r] *= gsc[att::crow(r, hi) * 3 + 1];
#pragma unroll
    for (int d = 0; d < 4; ++d)
#pragma unroll
        for (int r = 0; r < 16; r += 2) oacc[d][r >> 1] = cvtpk(bflo(oacc[d][r >> 1]) + o[d][r] * rli[r], bfhi(oacc[d][r >> 1]) + o[d][r + 1] * rli[r + 1]); }
    { NSA_LANE(); const WinMask wm{P, hi, qb};
      bf16x8 qr[8]; att::q_finish(qraw, a.in[I_QNORM], hi, qr);
#if defined(MK_NSA_DUP) && MK_NSA_DUP == 4
      att::attn_pass(lds, qr, io_win, wm, o, l_reg); att::attn_prefetch(lds, io_win);
#endif
      if (dry < 2) att::attn_pass(lds, qr, io_win, wm, o, l_reg); else { VM_WAIT(); __syncthreads(); l_reg = 1.f; } }
    att::row_inv_l(lds, l_reg, rli);
    if (dry < 4) { NSA_LANE();
    bf16* MIX = dry ? (bf16*)(wsl + WS_R + 400 * MiB) : (bf16*)(wsl + WS_MIX);
#pragma unroll
    for (int r = 0; r < 16; ++r) rli[r] *= gsc[att::crow(r, hi) * 3 + 2];
    bf16* obase = MIX + ((size_t)b * SEQ + t0 + 8 * w) * 2048 + 1024 + 4 * g * 128 + r32;
#pragma unroll
    for (int d0 = 0; d0 < 4; ++d0) {
#pragma unroll
        for (int r = 0; r < 16; ++r) { const int row = att::crow(r, hi); const float v = ((r & 1) ? bfhi(oacc[d0][r >> 1]) : bflo(oacc[d0][r >> 1])) + o[d0][r] * rli[r]; const float vn = __shfl_xor(v, 1);
            if ((r32 & 1) == 0) *(GAS unsigned*)(obase + (size_t)(row >> 2) * 2048 + (row & 3) * 128 + d0 * 32) = cvtpk(v, vn); }
        } }
    __syncthreads();
#undef NSA_QISSUE
#undef NSA_LANE
}
__device__ __forceinline__ void phase_nsa(const Frame& F, const Args& a) {
#pragma unroll 1
    for (int it = F.bid * 2; it < 512; it += F.G * 2)
#pragma unroll 1
        for (int k = 0; k < 2; ++k) { const int p = it >> 1, xcd = p & 7, bg = xcd >> 1, x = (xcd & 1) * 32 + (p >> 3);
#if defined(MK_NSA_DRY)
            nsa_unit(F, a, bg >> 1, bg & 1, k == 0 ? 127 - x : x, MK_NSA_DRY);
#endif
            nsa_unit(F, a, bg >> 1, bg & 1, k == 0 ? 127 - x : x); }
}
__device__ __forceinline__ f32x4 mma16(const LAS bf16* A, int pa, const LAS bf16* B, int pb, int K, f32x4 acc, int fr, int fq) {
    for (int k0 = 0; k0 < K; k0 += 32) { const bf16x8 af = *(const LAS bf16x8*)(A + fr * pa + k0 + 8 * fq); const bf16x8 bfv = *(const LAS bf16x8*)(B + fr * pb + k0 + 8 * fq);
        acc = __builtin_amdgcn_mfma_f32_16x16x32_bf16(af, bfv, acc, 0, 0, 0); }
    return acc;
}

__device__ __forceinline__ void phase_cmp2(const Frame& F, const Args& a, int u_lo, int u_hi, int u_step) {
    LAS bf16* hidS = (LAS bf16*)F.lds; LAS bf16* w2T = (LAS bf16*)(F.lds + 32 * 264 * 2); LAS float* outS = (LAS float*)(F.lds + 32 * 264 * 2 + 128 * 264 * 2);
    const int fr = F.lane & 15, fq = F.lane >> 4;
    for (int u = u_lo; u < u_hi; u += u_step) { const int mm = u >> 6, rb = u & 63;
        const bf16* hid = (const bf16*)(F.ws + WS_HID) + (size_t)mm * 2048 * 256 + (size_t)rb * 32 * 256; const float* w2 = a.in[mm ? I_CVW2 : I_CKW2];
        for (int i = F.tid; i < 32 * 32; i += NTHR) { const int r = i >> 5, c8 = i & 31; *(LAS v4u*)(hidS + r * 264 + c8 * 8) = *(const GAS v4u*)(hid + r * 256 + c8 * 8); }
        for (int i = F.tid; i < 256 * 128; i += NTHR) { const int k = i >> 7, c = i & 127; w2T[c * 264 + k] = (bf16)f2bf(w2[i]); }
        __syncthreads();
        const int rt = F.wave & 1;
#pragma unroll
        for (int cc = 0; cc < 2; ++cc) { const int ct = (F.wave >> 1) * 2 + cc; f32x4 acc = {0.f, 0.f, 0.f, 0.f};
            acc = mma16(hidS + rt * 16 * 264, 264, w2T + ct * 16 * 264, 264, 256, acc, fr, fq);
#pragma unroll
            for (int e = 0; e < 4; ++e) outS[(rt * 16 + 4 * fq + e) * 132 + ct * 16 + fr] = acc[e]; }
        __syncthreads();
        { const int r = F.wave * 4 + (F.lane >> 4), l16 = F.lane & 15; const int grow = rb * 32 + r, n = grow & 511;
          float v[8]; float ss = 0.f;
#pragma unroll
          for (int j = 0; j < 8; ++j) { v[j] = outS[r * 132 + l16 * 8 + j]; ss += v[j] * v[j]; }
          ss += __shfl_xor(ss, 1); ss += __shfl_xor(ss, 2); ss += __shfl_xor(ss, 4); ss += __shfl_xor(ss, 8);
          if (mm == 0) { const float rstd = 1.f / sqrtf(ss * (1.f / 128.f) + EPS); const float* g = a.in[I_KNORM];
#pragma unroll
              for (int j = 0; j < 8; ++j) v[j] = v[j] * rstd * g[l16 * 8 + j]; }
          if (n == 511) {
#pragma unroll
              for (int j = 0; j < 8; ++j) v[j] = 0.f; }
          v4u w; w.x = cvtpk(v[0], v[1]); w.y = cvtpk(v[2], v[3]); w.z = cvtpk(v[4], v[5]); w.w = cvtpk(v[6], v[7]);
          *(GAS v4u*)((bf16*)(F.ws + WS_KVCMP) + (size_t)mm * 2048 * 128 + (size_t)grow * 128 + l16 * 8) = w; }
        __syncthreads();
    }
}

__device__ __forceinline__ void rglru_unit(const Frame& F, const Args& a, int b, int h, int s) {
    const int w = F.wave, lane = F.lane, fr = lane & 15, fq = lane >> 4;
    LAS bf16* xcs = (LAS bf16*)F.lds + w * (16 * 136); LAS float* summ = (LAS float*)(F.lds + 8 * 16 * 136 * 2);
    const bf16* Y0 = (const bf16*)(F.ws + WS_Y0) + (size_t)b * SEQ * EV_INP; bf16* MIX = (bf16*)(F.ws + WS_MIX) + (size_t)b * SEQ * 2048;
    const int ch = h * 128 + s * 16 + fr;
    bf16x8 ba_f[4], bx_f[4];
    { const float* wa = a.in[I_RGWA] + (size_t)h * 128 * 128 + s * 16 + fr; const float* wx = a.in[I_RGWX] + (size_t)h * 128 * 128 + s * 16 + fr;
#pragma unroll
      for (int kk = 0; kk < 4; ++kk) { v4u ua, ux;
#pragma unroll
          for (int e2 = 0; e2 < 4; ++e2) { const int k = 32 * kk + 8 * fq + 2 * e2; ua[e2] = pk2(wa[(size_t)k * 128], wa[(size_t)(k + 1) * 128]); ux[e2] = pk2(wx[(size_t)k * 128], wx[(size_t)(k + 1) * 128]); }
          ba_f[kk] = *reinterpret_cast<bf16x8*>(&ua); bx_f[kk] = *reinterpret_cast<bf16x8*>(&ux); } }
    const float bias_a = a.in[I_RGBA][ch], bias_x = a.in[I_RGBX][ch], c8 = -8.f * fsoftplus(-a.in[I_RGLAM][ch]);
    const int cg = h * 128 + 2 * lane; float cw0[4], cw1[4];
#pragma unroll
    for (int j = 0; j < 4; ++j) { cw0[j] = a.in[I_RGCW][j * 1024 + cg]; cw1[j] = a.in[I_RGCW][j * 1024 + cg + 1]; }
    const float cb0 = a.in[I_RGCB][cg], cb1 = a.in[I_RGCB][cg + 1];
    float carry = 0.f;
    unsigned raw[19];
#define RG_LOAD(c_) do { const int T0_ = (c_) * 128 + 16 * w; _Pragma("unroll") for (int i = 0; i < 19; ++i) { const int t = T0_ - 3 + i; raw[i] = (t >= 0) ? *(const GAS unsigned*)(Y0 + (size_t)t * EV_INP + cg) : 0u; } } while (0)
    RG_LOAD(0);
#ifdef MK_DUP_RG
    for (int cc = 0; cc < 2 * (SEQ / 128); ++cc) { const int c = cc & (SEQ / 128 - 1); if (cc == SEQ / 128) { carry = 0.f; RG_LOAD(0); }
#else
    for (int c = 0; c < SEQ / 128; ++c) {
#endif
        const int T0 = c * 128 + 16 * w;
#pragma unroll
        for (int tt = 0; tt < 16; ++tt) { float y0 = cb0, y1 = cb1;
#pragma unroll
            for (int j = 0; j < 4; ++j) { y0 += cw0[j] * bflo(raw[tt + j]); y1 += cw1[j] * bfhi(raw[tt + j]); }
            *(LAS unsigned*)(xcs + tt * 136 + 2 * lane) = cvtpk(y0, y1); }
        LDS_WAIT();
        if (c + 1 < SEQ / 128) RG_LOAD(c + 1);
        unsigned short gg[4];
#pragma unroll
        for (int e = 0; e < 4; ++e) gg[e] = Y0[(size_t)(T0 + 4 * fq + e) * EV_INP + 1024 + ch];
        f32x4 acc_a = {0.f, 0.f, 0.f, 0.f}, acc_x = {0.f, 0.f, 0.f, 0.f};
#pragma unroll
        for (int kk = 0; kk < 4; ++kk) { const bf16x8 af = *(const LAS bf16x8*)(xcs + fr * 136 + 32 * kk + 8 * fq);
            acc_a = __builtin_amdgcn_mfma_f32_16x16x32_bf16(af, ba_f[kk], acc_a, 0, 0, 0); acc_x = __builtin_amdgcn_mfma_f32_16x16x32_bf16(af, bx_f[kk], acc_x, 0, 0, 0); }
        float hl[4], pl[4]; float hh = 0.f, pp = 1.f;
#pragma unroll
        for (int e = 0; e < 4; ++e) { const float xv = bf2f(xcs[(4 * fq + e) * 136 + s * 16 + fr]);
            const float r = fsigmoid(acc_a[e] + bias_a), ig = fsigmoid(acc_x[e] + bias_x); const float la = c8 * r; const float av = __expf(la);
            const float uu = __builtin_amdgcn_sqrtf((1.f - av) * (1.f + av)) * (ig * xv);
            hh = av * hh + uu; pp *= av; hl[e] = hh; pl[e] = pp; }
        float Apre = 1.f, Hpre = 0.f, Aw = 1.f, Hw = 0.f;
#pragma unroll
        for (int q = 0; q < 4; ++q) { const float Aq = __shfl(pp, fr + 16 * q), Hq = __shfl(hh, fr + 16 * q);
            if (q < fq) { Hpre = Aq * Hpre + Hq; Apre *= Aq; }
            Hw = Aq * Hw + Hq; Aw *= Aq; }
        LAS float* sm = summ + (c & 1) * 256;
        if (fq == 0) { sm[(w * 16 + fr) * 2] = Aw; sm[(w * 16 + fr) * 2 + 1] = Hw; }
        __syncthreads();
        float cin = carry, call = carry;
#pragma unroll
        for (int q = 0; q < 8; ++q) { const float Aq = sm[(q * 16 + fr) * 2], Hq = sm[(q * 16 + fr) * 2 + 1]; call = Aq * call + Hq; if (q < w) cin = call; }
        carry = call;
        const float cl = Apre * cin + Hpre;
#pragma unroll
        for (int e = 0; e < 4; ++e) { const float hv = hl[e] + pl[e] * cl; MIX[(size_t)(T0 + 4 * fq + e) * 2048 + ch] = (bf16)f2bf(gelu_tanh(bf2f(gg[e])) * hv); }
    }
#undef RG_LOAD
    __syncthreads();
}
constexpr size_t WS_M_CN = WS_R + 168 * MiB + 64 * MiB;
constexpr size_t WS_M_BN = WS_M_CN + 16 * MiB, WS_M_BT = WS_M_BN + 16 * MiB, WS_M_XT = WS_M_BT + 16 * MiB, WS_M_ACS = WS_M_XT + 64 * MiB, WS_M_DTV = WS_M_ACS + 2 * MiB,
                 WS_M_ST = WS_M_DTV + 2 * MiB, WS_M_PV = WS_M_ST + 128 * MiB, WS_M_END = WS_M_PV + 64 * MiB;
static_assert(WS_M_END <= WS_R + 560 * MiB, "mamba ws");
constexpr int MB_P = 136;
__device__ __forceinline__ void conv4_silu(const v4u (&rows)[7], const float* cw, int ldw, const float* cb, float (&out)[4][8]) {
    float wv[4][8], bv[8];
#pragma unroll
    for (int j = 0; j < 4; ++j) { const f32x4 w0 = *(const GAS f32x4*)(cw + (size_t)j * ldw), w1 = *(const GAS f32x4*)(cw + (size_t)j * ldw + 4);
#pragma unroll
        for (int i = 0; i < 4; ++i) { wv[j][i] = w0[i]; wv[j][4 + i] = w1[i]; } }
    { const f32x4 b0 = *(const GAS f32x4*)cb, b1 = *(const GAS f32x4*)(cb + 4);
#pragma unroll
      for (int i = 0; i < 4; ++i) { bv[i] = b0[i]; bv[4 + i] = b1[i]; } }
#pragma unroll
    for (int tt = 0; tt < 4; ++tt)
#pragma unroll
        for (int i2 = 0; i2 < 4; ++i2) { float y0 = bv[2 * i2], y1 = bv[2 * i2 + 1];
#pragma unroll
            for (int j = 0; j < 4; ++j) { y0 += wv[j][2 * i2] * bflo(rows[tt + j][i2]); y1 += wv[j][2 * i2 + 1] * bfhi(rows[tt + j][i2]); }
            out[tt][2 * i2] = fsilu(y0); out[tt][2 * i2 + 1] = fsilu(y1); }
}
__device__ __forceinline__ void phase_mamba_prep(const Frame& F, const Args& a) {
    LAS bf16* T = (LAS bf16*)F.lds;
    LAS float* acsS = (LAS float*)(F.lds + 128 * MB_P * 2); LAS float* dtS = acsS + 256;
    const int tid = F.tid, lane = F.lane, w = F.wave, sg = tid >> 4, cv = tid & 15;
    const float* cw = a.in[I_ODCW]; const float* cb = a.in[I_ODCB];
    v4u rows[7];
#define M0_LOAD(u_) do { const int bc_ = (u_) / 24, sl_ = (u_) % 24, T0_ = (bc_ & 63) * 128; const bf16* Y1_ = (const bf16*)(F.ws + WS_Y1) + (size_t)(bc_ >> 6) * SEQ * OD_INP; \
        _Pragma("unroll") for (int i = 0; i < 7; ++i) { const int t = T0_ + 4 * sg - 3 + i; rows[i] = (t >= 0) ? *(const GAS v4u*)(Y1_ + (size_t)t * OD_INP + 2048 + sl_ * 128 + cv * 8) : (v4u){0u, 0u, 0u, 0u}; } } while (0)
    if (F.bid < 128 * 24) M0_LOAD(F.bid);
    for (int u = F.bid; u < 128 * 24; u += F.G) { const int bc = u / 24, sl = u % 24, b = bc >> 6, c = bc & 63, T0 = c * 128;
        const bf16* Y1 = (const bf16*)(F.ws + WS_Y1) + (size_t)b * SEQ * OD_INP; const int ch0 = sl * 128;
        { float vals[4][8];
          conv4_silu(rows, cw + ch0 + cv * 8, 3072, cb + ch0 + cv * 8, vals);
          if (u + F.G < 128 * 24) M0_LOAD(u + F.G);
#pragma unroll
          for (int tt = 0; tt < 4; ++tt) { v4u o; o.x = cvtpk(vals[tt][0], vals[tt][1]); o.y = cvtpk(vals[tt][2], vals[tt][3]); o.z = cvtpk(vals[tt][4], vals[tt][5]); o.w = cvtpk(vals[tt][6], vals[tt][7]);
              *(LAS v4u*)(T + (4 * sg + tt) * MB_P + cv * 8) = o; } }
        if (sl < 16 && w < 2) { const int h = 2 * sl + w;
            const float Ah = -__expf(a.in[I_ALOG][h]), dtb = a.in[I_DTB][h];
            const float d0 = fsoftplus(bf2f(Y1[(size_t)(T0 + 2 * lane) * OD_INP + 5120 + h]) + dtb), d1 = fsoftplus(bf2f(Y1[(size_t)(T0 + 2 * lane + 1) * OD_INP + 5120 + h]) + dtb);
            const float a0 = d0 * Ah, a1 = d1 * Ah; float pr = a0 + a1;
#pragma unroll
            for (int off = 1; off < 64; off <<= 1) { const float t = __shfl_up(pr, off); if (lane >= off) pr += t; }
            const float ex = pr - (a0 + a1); const float c0 = ex + a0, c1 = ex + a0 + a1;
            acsS[w * 128 + 2 * lane] = c0; acsS[w * 128 + 2 * lane + 1] = c1; dtS[w * 128 + 2 * lane] = d0; dtS[w * 128 + 2 * lane + 1] = d1;
            float* ACS = (float*)(F.ws + WS_M_ACS) + ((size_t)bc * 32 + h) * 128; float* DTV = (float*)(F.ws + WS_M_DTV) + ((size_t)bc * 32 + h) * 128;
            typedef float f32x2v __attribute__((ext_vector_type(2))); *(GAS f32x2v*)(ACS + 2 * lane) = (f32x2v){c0, c1}; *(GAS f32x2v*)(DTV + 2 * lane) = (f32x2v){d0, d1}; }
        __syncthreads();
        if (sl < 16) {
            const int cc = tid >> 2, s0 = (tid & 3) * 32, hh = cc >> 6; bf16* XT = (bf16*)(F.ws + WS_M_XT) + (((size_t)bc * 32 + 2 * sl) * 64 + cc) * 128 + s0;
#pragma unroll
            for (int k8 = 0; k8 < 4; ++k8) { float v[8];
#pragma unroll
                for (int k = 0; k < 8; ++k) { const int s = s0 + 8 * k8 + k; v[k] = bf2f(T[s * MB_P + cc]) * dtS[hh * 128 + s]; }
                v4u o; o.x = cvtpk(v[0], v[1]); o.y = cvtpk(v[2], v[3]); o.z = cvtpk(v[4], v[5]); o.w = cvtpk(v[6], v[7]); *(GAS v4u*)(XT + 8 * k8) = o; } }
        else { const int g = (sl - 16) & 3; const bool isB = sl < 20;
            bf16* N = (bf16*)(F.ws + (isB ? WS_M_BN : WS_M_CN)) + ((size_t)b * SEQ + T0) * 512 + g * 128;
            for (int i = tid; i < 128 * 16; i += NTHR) { const int s = i >> 4, c8 = i & 15; *(GAS v4u*)(N + (size_t)s * 512 + c8 * 8) = *(const LAS v4u*)(T + s * MB_P + c8 * 8); }
            if (isB) { const int cc = tid >> 2, s0 = (tid & 3) * 32; bf16* BT = (bf16*)(F.ws + WS_M_BT) + (((size_t)bc * 4 + g) * 128 + cc) * 128 + s0;
#pragma unroll
                for (int k8 = 0; k8 < 4; ++k8) { unsigned short v[8];
#pragma unroll
                    for (int k = 0; k < 8; ++k) v[k] = T[(s0 + 8 * k8 + k) * MB_P + cc];
                    v4u o; o.x = v[0] | ((unsigned)v[1] << 16); o.y = v[2] | ((unsigned)v[3] << 16); o.z = v[4] | ((unsigned)v[5] << 16); o.w = v[6] | ((unsigned)v[7] << 16); *(GAS v4u*)(BT + 8 * k8) = o; } } }
        __syncthreads();
    }
#undef M0_LOAD
}
__device__ __forceinline__ void phase_mamba_states(const Frame& F) {
    LAS bf16* BTs = (LAS bf16*)F.lds; LAS bf16* XW = (LAS bf16*)(F.lds + 128 * MB_P * 2);
    const int tid = F.tid, lane = F.lane, w = F.wave, fr = lane & 15, fq = lane >> 4;
    for (int u = F.bid; u < 128 * 4; u += F.G) { const int bc = u >> 2, g = u & 3;
        const bf16* BT = (const bf16*)(F.ws + WS_M_BT) + ((size_t)bc * 4 + g) * 128 * 128;
        for (int i = tid; i < 128 * 16; i += NTHR) { const int n = i >> 4, c8 = i & 15; *(LAS v4u*)(BTs + n * MB_P + c8 * 8) = *(const GAS v4u*)(BT + (size_t)n * 128 + c8 * 8); }
#pragma unroll 1
        for (int hh = 0; hh < 8; ++hh) { const int h = g * 8 + hh;
            const bf16* XT = (const bf16*)(F.ws + WS_M_XT) + ((size_t)bc * 32 + h) * 64 * 128; const float* ACS = (const float*)(F.ws + WS_M_ACS) + ((size_t)bc * 32 + h) * 128;
            const float aL = ACS[127];
#pragma unroll
            for (int k = 0; k < 2; ++k) { const int i = tid + k * NTHR, p = i >> 4, c8 = i & 15; const v4u raw = *(const GAS v4u*)(XT + (size_t)p * 128 + c8 * 8);
                const f32x4 a0 = *(const GAS f32x4*)(ACS + c8 * 8), a1 = *(const GAS f32x4*)(ACS + c8 * 8 + 4);
                v4u o; o.x = cvtpk(bflo(raw[0]) * __expf(aL - a0[0]), bfhi(raw[0]) * __expf(aL - a0[1])); o.y = cvtpk(bflo(raw[1]) * __expf(aL - a0[2]), bfhi(raw[1]) * __expf(aL - a0[3]));
                o.z = cvtpk(bflo(raw[2]) * __expf(aL - a1[0]), bfhi(raw[2]) * __expf(aL - a1[1])); o.w = cvtpk(bflo(raw[3]) * __expf(aL - a1[2]), bfhi(raw[3]) * __expf(aL - a1[3]));
                *(LAS v4u*)(XW + p * MB_P + c8 * 8) = o; }
            __syncthreads();
            float* ST = (float*)(F.ws + WS_M_ST) + ((size_t)bc * 32 + h) * 64 * 128;
#pragma unroll
            for (int pt = 0; pt < 4; ++pt) { f32x4 acc = {0.f, 0.f, 0.f, 0.f}; acc = mma16(XW + pt * 16 * MB_P, MB_P, BTs + w * 16 * MB_P, MB_P, 128, acc, fr, fq);
#pragma unroll
                for (int e = 0; e < 4; ++e) ST[(size_t)(pt * 16 + 4 * fq + e) * 128 + w * 16 + fr] = acc[e]; }
            __syncthreads();
        }
    }
}
__device__ __forceinline__ void phase_mamba_scan(const Frame& F) {
    const int gt = F.bid * NTHR + F.tid;
    for (int i = gt; i < BATCH * 32 * 64 * 32; i += F.G * NTHR) { const int n4 = i & 31, p = (i >> 5) & 63, h = (i >> 11) & 31, b = i >> 16;
        f32x4 S = {0.f, 0.f, 0.f, 0.f};
#pragma unroll 4
        for (int c = 0; c < 64; ++c) { const size_t bc = (size_t)b * 64 + c; const size_t off = ((bc * 32 + h) * 64 + p) * 128 + n4 * 4;
            const f32x4 st = *(const GAS f32x4*)((const float*)(F.ws + WS_M_ST) + off); const float dec = __expf(((const float*)(F.ws + WS_M_ACS))[(bc * 32 + h) * 128 + 127]);
            v2u o; o.x = cvtpk(S[0], S[1]); o.y = cvtpk(S[2], S[3]); *(GAS v2u*)((bf16*)(F.ws + WS_M_PV) + off) = o;
            S = S * dec + st; } }
}
constexpr int M3_CS = 0, M3_BS = M3_CS + 128 * MB_P * 2, M3_MS = M3_BS + 128 * MB_P * 2, M3_XT = M3_MS + 128 * MB_P * 2, M3_PV = M3_XT + 64 * MB_P * 2, M3_ACS = M3_PV + 64 * MB_P * 2, M3_DT = M3_ACS + 512, M3_END = M3_DT + 512;
static_assert(M3_END <= SCR_BYTES, "mamba lds");
__device__ __forceinline__ void phase_mamba_out(const Frame& F, const Args& a) {
    LAS bf16* Cs = (LAS bf16*)(F.lds + M3_CS); LAS bf16* Bs = (LAS bf16*)(F.lds + M3_BS); LAS bf16* Ms = (LAS bf16*)(F.lds + M3_MS); LAS bf16* XTs = (LAS bf16*)(F.lds + M3_XT); LAS bf16* PVs = (LAS bf16*)(F.lds + M3_PV);
    LAS float* acs = (LAS float*)(F.lds + M3_ACS); LAS float* dtv = (LAS float*)(F.lds + M3_DT);
    const int tid = F.tid, lane = F.lane, w = F.wave, fr = lane & 15, fq = lane >> 4;
    for (int u = F.bid; u < 128 * 4; u += F.G) { const int bc = u >> 2, g = u & 3, b = bc >> 6, T0 = (bc & 63) * 128;
        const bf16* CN = (const bf16*)(F.ws + WS_M_CN) + ((size_t)b * SEQ + T0) * 512 + g * 128; const bf16* BN = (const bf16*)(F.ws + WS_M_BN) + ((size_t)b * SEQ + T0) * 512 + g * 128;
        for (int i = tid; i < 128 * 16; i += NTHR) { const int s = i >> 4, c8 = i & 15;
            *(LAS v4u*)(Cs + s * MB_P + c8 * 8) = *(const GAS v4u*)(CN + (size_t)s * 512 + c8 * 8); *(LAS v4u*)(Bs + s * MB_P + c8 * 8) = *(const GAS v4u*)(BN + (size_t)s * 512 + c8 * 8); }
        __syncthreads();
        f32x4 cbt[8];
#pragma unroll
        for (int st = 0; st < 8; ++st) { cbt[st] = (f32x4){0.f, 0.f, 0.f, 0.f}; if (st <= w) cbt[st] = mma16(Bs + st * 16 * MB_P, MB_P, Cs + w * 16 * MB_P, MB_P, 128, cbt[st], fr, fq); }
        const bf16* Y1 = (const bf16*)(F.ws + WS_Y1) + ((size_t)b * SEQ + T0) * OD_INP; bf16* YG = (bf16*)(F.ws + WS_YG) + ((size_t)b * SEQ + T0) * 2048;
        v4u pfx[2], pfp[2]; float pfa = 0.f, pfd = 0.f;
#define M3_PREFETCH(hh_) do { const int h_ = g * 8 + (hh_); const bf16* XT_ = (const bf16*)(F.ws + WS_M_XT) + ((size_t)bc * 32 + h_) * 64 * 128; const bf16* PV_ = (const bf16*)(F.ws + WS_M_PV) + ((size_t)bc * 32 + h_) * 64 * 128; \
            _Pragma("unroll") for (int k = 0; k < 2; ++k) { const int i = tid + k * NTHR, p = i >> 4, c8 = i & 15; pfx[k] = *(const GAS v4u*)(XT_ + (size_t)p * 128 + c8 * 8); pfp[k] = *(const GAS v4u*)(PV_ + (size_t)p * 128 + c8 * 8); } \
            if (tid < 128) { pfa = ((const float*)(F.ws + WS_M_ACS))[((size_t)bc * 32 + h_) * 128 + tid]; pfd = ((const float*)(F.ws + WS_M_DTV))[((size_t)bc * 32 + h_) * 128 + tid]; } } while (0)
        M3_PREFETCH(0);
#pragma unroll 1
        for (int hh = 0; hh < 8; ++hh) { const int h = g * 8 + hh; const float dsk = a.in[I_DSKIP][h];
#pragma unroll
            for (int k = 0; k < 2; ++k) { const int i = tid + k * NTHR, p = i >> 4, c8 = i & 15; *(LAS v4u*)(XTs + p * MB_P + c8 * 8) = pfx[k]; *(LAS v4u*)(PVs + p * MB_P + c8 * 8) = pfp[k]; }
            if (tid < 128) { acs[tid] = pfa; dtv[tid] = pfd; }
            __syncthreads();
            if (hh + 1 < 8) M3_PREFETCH(hh + 1);
            unsigned short zz[4][4];
#pragma unroll
            for (int pt = 0; pt < 4; ++pt)
#pragma unroll
                for (int e = 0; e < 4; ++e) zz[pt][e] = Y1[(size_t)(16 * w + 4 * fq + e) * OD_INP + h * 64 + pt * 16 + fr];
            const float aq = acs[16 * w + fr];
#pragma unroll
            for (int st = 0; st < 8; ++st) { if (st <= w) { float mv[4];
#pragma unroll
                for (int e = 0; e < 4; ++e) { const int s = 16 * st + 4 * fq + e; mv[e] = (s <= 16 * w + fr) ? cbt[st][e] * __expf(aq - acs[s]) : 0.f; }
                v2u o; o.x = cvtpk(mv[0], mv[1]); o.y = cvtpk(mv[2], mv[3]); *(LAS v2u*)(Ms + (16 * w + fr) * MB_P + 16 * st + 4 * fq) = o; } }
            if ((w & 1) == 0) *(LAS v2u*)(Ms + (16 * w + fr) * MB_P + 16 * (w + 1) + 4 * fq) = (v2u){0u, 0u};
            LDS_WAIT();
#pragma unroll
            for (int pt = 0; pt < 4; ++pt) { f32x4 yd = {0.f, 0.f, 0.f, 0.f}, yo = {0.f, 0.f, 0.f, 0.f};
                yd = mma16(Ms + w * 16 * MB_P, MB_P, XTs + pt * 16 * MB_P, MB_P, ((w + 2) >> 1) * 32, yd, fr, fq);
                yo = mma16(Cs + w * 16 * MB_P, MB_P, PVs + pt * 16 * MB_P, MB_P, 128, yo, fr, fq);
#pragma unroll
                for (int e = 0; e < 4; ++e) { const int q = 16 * w + 4 * fq + e, p = pt * 16 + fr;
                    const float xs = bf2f(XTs[p * MB_P + q]) * __builtin_amdgcn_rcpf(dtv[q]);
                    const float y = yd[e] + __expf(acs[q]) * yo[e] + dsk * xs;
                    YG[(size_t)q * 2048 + h * 64 + p] = (bf16)f2bf(y * fsilu(bf2f(zz[pt][e]))); } }
            __syncthreads();
        }
#undef M3_PREFETCH
        VM_WAIT(); __syncthreads();
        { const float* gn = a.in[I_ODNORM] + g * 512 + lane * 8; const f32x4 g0 = *(const GAS f32x4*)gn, g1 = *(const GAS f32x4*)(gn + 4);
#pragma unroll 4
          for (int t = 0; t < 16; ++t) { bf16* pq = YG + (size_t)(16 * w + t) * 2048 + g * 512 + lane * 8; const v4u raw = *(const GAS v4u*)pq; float ss = 0.f;
#pragma unroll
              for (int j = 0; j < 4; ++j) { const float x0 = bflo(raw[j]), x1 = bfhi(raw[j]); ss += x0 * x0 + x1 * x1; }
              const float rstd = 1.f / sqrtf(wave_sum(ss) * (1.f / 512.f) + EPS);
              v4u o; o.x = cvtpk(bflo(raw[0]) * rstd * g0[0], bfhi(raw[0]) * rstd * g0[1]); o.y = cvtpk(bflo(raw[1]) * rstd * g0[2], bfhi(raw[1]) * rstd * g0[3]);
              o.z = cvtpk(bflo(raw[2]) * rstd * g1[0], bfhi(raw[2]) * rstd * g1[1]); o.w = cvtpk(bflo(raw[3]) * rstd * g1[2], bfhi(raw[3]) * rstd * g1[3]);
              *(GAS v4u*)pq = o; } }
    }
}
__device__ __forceinline__ void phase_group_norm(const Frame& F, const Args& a) {
    const int gw = F.bid * NWAVES + F.wave, NGW = F.G * NWAVES; bf16* YG = (bf16*)(F.ws + WS_YG); const float* g = a.in[I_ODNORM];
    for (int m = gw; m < M; m += NGW) {
#pragma unroll
        for (int gi = 0; gi < 4; ++gi) { bf16* p = YG + (size_t)m * 2048 + gi * 512 + F.lane * 8; const v4u raw = *(const GAS v4u*)p; float ss = 0.f;
#pragma unroll
            for (int j = 0; j < 4; ++j) { const float x0 = bflo(raw[j]), x1 = bfhi(raw[j]); ss += x0 * x0 + x1 * x1; }
            const float rstd = 1.f / sqrtf(wave_sum(ss) * (1.f / 512.f) + EPS);
            const f32x4 g0 = *(const GAS f32x4*)(g + gi * 512 + F.lane * 8), g1 = *(const GAS f32x4*)(g + gi * 512 + F.lane * 8 + 4);
            v4u o; o.x = cvtpk(bflo(raw[0]) * rstd * g0[0], bfhi(raw[0]) * rstd * g0[1]); o.y = cvtpk(bflo(raw[1]) * rstd * g0[2], bfhi(raw[1]) * rstd * g0[3]);
            o.z = cvtpk(bflo(raw[2]) * rstd * g1[0], bfhi(raw[2]) * rstd * g1[1]); o.w = cvtpk(bflo(raw[3]) * rstd * g1[2], bfhi(raw[3]) * rstd * g1[3]);
            *(GAS v4u*)p = o; }
    }
}
constexpr int MOE_TAB = 131072;
static_assert(MOE_TAB + (32 + MOE_TILES + 24) * 4 <= SCR_BYTES, "moe lds");
__device__ __forceinline__ void phase_route(const Frame& F, const Args& a, const float* x) {
    LAS int* cntS = (LAS int*)F.lds;
    if (F.tid < 8) cntS[F.tid] = 0;
    __syncthreads();
    const float* g = a.in[I_NFFN] + D; const float* router = a.in[I_ROUTER]; bf16* XN = (bf16*)(F.ws + WS_XN);
    int* tokE = (int*)(F.ws + WS_MOEIDX); float* tokW = (float*)(F.ws + WS_MOEIDX + 1 * MiB);
    const int per = M / F.G;
    for (int i = F.wave; i < per; i += NWAVES) { const int m = F.bid * per + i;
        const GAS f32x4* xr = (const GAS f32x4*)(x + (size_t)m * D) + F.lane; const GAS f32x4* gr = (const GAS f32x4*)g + F.lane;
        f32x4 v[4]; float s = 0.f;
#pragma unroll
        for (int j = 0; j < 4; ++j) { v[j] = xr[64 * j]; s += (v[j].x * v[j].x + v[j].y * v[j].y) + (v[j].z * v[j].z + v[j].w * v[j].w); }
        const float rstd = 1.f / sqrtf(wave_sum(s) * (1.f / D) + EPS);
        float lg[8];
#pragma unroll
        for (int e = 0; e < 8; ++e) lg[e] = 0.f;
        GAS unsigned long long* o8 = (GAS unsigned long long*)(XN + (size_t)m * D) + F.lane;
#pragma unroll
        for (int j = 0; j < 4; ++j) { const f32x4 gg = gr[64 * j]; f32x4 hn = v[j] * rstd * gg;
            o8[64 * j] = (unsigned long long)pk2(hn.x, hn.y) | ((unsigned long long)pk2(hn.z, hn.w) << 32);
#pragma unroll
            for (int q = 0; q < 4; ++q) { const int k = 256 * j + 4 * F.lane + q; const f32x4 r0 = *(const GAS f32x4*)(router + (size_t)k * 8), r1 = *(const GAS f32x4*)(router + (size_t)k * 8 + 4);
#pragma unroll
                for (int e = 0; e < 4; ++e) { lg[e] += hn[q] * r0[e]; lg[4 + e] += hn[q] * r1[e]; } } }
#pragma unroll
        for (int e = 0; e < 8; ++e) lg[e] = wave_sum(lg[e]);
        int e1 = 0; float v1 = lg[0];
#pragma unroll
        for (int e = 1; e < 8; ++e) if (lg[e] > v1) { v1 = lg[e]; e1 = e; }
        int e2 = (e1 + 1) & 7; float v2 = -3.0e38f;
#pragma unroll
        for (int e = 0; e < 8; ++e) if (e != e1 && lg[e] > v2) { v2 = lg[e]; e2 = e; }
        if (F.lane == 0) { const float w1 = 1.f / (1.f + __expf(v2 - v1)); tokE[2 * m] = e1; tokE[2 * m + 1] = e2; tokW[2 * m] = w1; tokW[2 * m + 1] = 1.f - w1;
            atomicAdd((int*)cntS + e1, 1); atomicAdd((int*)cntS + e2, 1); }
    }
    __syncthreads();
    if (F.tid < 8) ((int*)(F.ctl + CW_MOECNT))[F.bid * 8 + F.tid] = cntS[F.tid];
    __syncthreads();
}
__device__ __forceinline__ void moe_layout(const Frame& F) {
    LAS int* tab = (LAS int*)(F.lds + MOE_TAB); const int* cnt = (const int*)(F.ctl + CW_MOECNT);
    if (F.tid < 16) tab[F.tid < 8 ? F.tid : 32 + MOE_TILES + F.tid] = 0;
    __syncthreads();
    { const int e = F.tid & 7; int tot = 0, pre = 0;
      for (int wg = F.tid >> 3; wg < F.G; wg += NTHR / 8) { const int c = cnt[wg * 8 + e]; tot += c; if (wg < F.bid) pre += c; }
      atomicAdd((int*)tab + e, tot); atomicAdd((int*)tab + 32 + MOE_TILES + 8 + e, pre); }
    __syncthreads();
    if (F.tid == 0) { int row = 0, tl = 0; for (int e = 0; e < 8; ++e) { const int nt = (tab[e] + 255) >> 8; tab[8 + e] = row; tab[16 + e] = nt; for (int i = 0; i < nt; ++i) tab[32 + tl + i] = e; tl += nt; row += nt * 256; } tab[24] = tl; }
    __syncthreads();
}
__device__ __forceinline__ void phase_scatter(const Frame& F) {
    moe_layout(F);
    LAS int* tab = (LAS int*)(F.lds + MOE_TAB); LAS int* slotS = (LAS int*)F.lds;
    const int per = M / F.G;
    const int* tokE = (const int*)(F.ws + WS_MOEIDX); int* tokS = (int*)(F.ws + WS_MOEIDX + 2 * MiB);
    if (F.wave == 0) { const int E0 = tokE[(size_t)F.bid * per * 2 + F.lane], E1 = tokE[(size_t)F.bid * per * 2 + 64 + F.lane]; int s0 = 0, s1 = 0;
        const unsigned long long lt = (1ull << F.lane) - 1ull;
#pragma unroll
        for (int e = 0; e < 8; ++e) { const unsigned long long m0 = __ballot(E0 == e), m1 = __ballot(E1 == e); const int base = tab[8 + e] + tab[32 + MOE_TILES + 8 + e];
            if (E0 == e) s0 = base + __popcll(m0 & lt); if (E1 == e) s1 = base + __popcll(m0) + __popcll(m1 & lt); }
        slotS[F.lane] = s0; slotS[64 + F.lane] = s1; tokS[(size_t)F.bid * per * 2 + F.lane] = s0; tokS[(size_t)F.bid * per * 2 + 64 + F.lane] = s1; }
    __syncthreads();
    const bf16* XN = (const bf16*)(F.ws + WS_XN); unsigned char* XP = F.ws + WS_XP;
    for (int i = F.wave; i < per * 2; i += NWAVES) { const int m = F.bid * per + (i >> 1); const int sl = slotS[i];
        const GAS v4u* src = (const GAS v4u*)(XN + (size_t)m * D) + F.lane; GAS v2u* dst = (GAS v2u*)(XP + (size_t)sl * D) + F.lane;
        const v4u s0 = src[0], s1 = src[64]; v2u o0, o1;
        o0.x = pk4_fp8(bflo(s0.x), bfhi(s0.x), bflo(s0.y), bfhi(s0.y)); o0.y = pk4_fp8(bflo(s0.z), bfhi(s0.z), bflo(s0.w), bfhi(s0.w));
        o1.x = pk4_fp8(bflo(s1.x), bfhi(s1.x), bflo(s1.y), bfhi(s1.y)); o1.y = pk4_fp8(bflo(s1.z), bfhi(s1.z), bflo(s1.w), bfhi(s1.w));
        dst[0] = o0; dst[64] = o1; }
    __syncthreads();
}
struct MoeOrder {
    int nN, nwg, G, c; const LAS int* texp;
    __device__ __forceinline__ bool next(int i, pg8::Unit& u) const { const long L = (long)i * G + c; if (L >= nwg) return false; u.pm = (int)(L / nN); u.pn = (int)(L % nN); u.bn = texp[u.pm] * nN + u.pn; u.idx = i; return true; }
    __device__ __forceinline__ void a_ready(const pg8::Unit&) const {}
    __device__ __forceinline__ void done(const pg8::Unit&) const {}
};
struct MoeOrderX {
    int nM, nN, nwg, G, c; const LAS int* texp;
    __device__ __forceinline__ bool next(int i, pg8::Unit& u) const { const long L = (long)i * G + c; if (L >= nwg) return false;
        int wgid = (int)L; { const int q = nwg / 8, r = nwg % 8, xcd = wgid % 8, off = wgid / 8; wgid = (xcd < r ? xcd * (q + 1) : r * (q + 1) + (xcd - r) * q) + off; }
        const int nig = 8 * nN, gid = wgid / nig, fm = gid * 8, gsz = (nM - fm) < 8 ? (nM - fm) : 8;
        u.pm = fm + ((wgid % nig) % gsz); u.pn = (wgid % nig) / gsz; u.bn = texp[u.pm] * nN + u.pn; u.idx = i; return true; }
    __device__ __forceinline__ void a_ready(const pg8::Unit&) const {}
    __device__ __forceinline__ void done(const pg8::Unit&) const {}
};
struct MoeTail { int R, Lo, pm_min; bool split; };
__device__ __forceinline__ MoeTail moe_tail(const LAS int* tab, int G) { MoeTail t; const int U = tab[24] * 4; t.R = U / G; t.Lo = U - t.R * G; t.split = (t.Lo > 0 && t.Lo <= 64 && t.R > 0); t.pm_min = t.split ? (t.R * G) / 4 : (1 << 30); return t; }
struct MoeTailOrder { int pm, pn, bn; bool has;
    __device__ __forceinline__ bool next(int i, pg8::Unit& u) const { if (i > 0 || !has) return false; u.pm = pm; u.pn = pn; u.bn = bn; u.idx = 0; return true; }
    __device__ __forceinline__ void a_ready(const pg8::Unit&) const {}
    __device__ __forceinline__ void done(const pg8::Unit&) const {} };
constexpr size_t MOE_PART_STRIDE = (size_t)16 * 256 * 1024;
__device__ __forceinline__ void phase_moe_combine(const Frame& F, const float* x, float* xo) {
    moe_layout(F); const MoeTail mt = moe_tail((const LAS int*)(F.lds + MOE_TAB), F.G); const int srow = mt.pm_min == (1 << 30) ? (1 << 30) : mt.pm_min * 256; const float* PART = (const float*)(F.ws + WS_XP);
    const int gw = F.bid * NWAVES + F.wave, NGW = F.G * NWAVES;
    const float* tokW = (const float*)(F.ws + WS_MOEIDX + 1 * MiB); const int* tokS = (const int*)(F.ws + WS_MOEIDX + 2 * MiB); const int* tokE = (const int*)(F.ws + WS_MOEIDX);
    const float* YP = (const float*)(F.ws + WS_YP);
    for (int m = gw; m < M; m += NGW) { const int s0 = tokS[2 * m], s1 = tokS[2 * m + 1]; const float w0 = tokW[2 * m], w1 = tokW[2 * m + 1]; const bool sw = tokE[2 * m] > tokE[2 * m + 1];
        const GAS f32x4* xr = (const GAS f32x4*)(x + (size_t)m * D) + F.lane; GAS f32x4* xw = (GAS f32x4*)(xo + (size_t)m * D) + F.lane; const GAS f32x4* y0 = (const GAS f32x4*)(YP + (size_t)s0 * D) + F.lane; const GAS f32x4* y1 = (const GAS f32x4*)(YP + (size_t)s1 * D) + F.lane;
#pragma unroll
        for (int j = 0; j < 4; ++j) { f32x4 v0, v1;
            if (s0 >= srow) { const GAS f32x4* q = (const GAS f32x4*)(PART + (size_t)(s0 - srow) * D) + F.lane + 64 * j; v0 = (q[0] + q[MOE_PART_STRIDE / 4]) + (q[2 * (MOE_PART_STRIDE / 4)] + q[3 * (MOE_PART_STRIDE / 4)]); } else v0 = y0[64 * j];
            if (s1 >= srow) { const GAS f32x4* q = (const GAS f32x4*)(PART + (size_t)(s1 - srow) * D) + F.lane + 64 * j; v1 = (q[0] + q[MOE_PART_STRIDE / 4]) + (q[2 * (MOE_PART_STRIDE / 4)] + q[3 * (MOE_PART_STRIDE / 4)]); } else v1 = y1[64 * j];
            const f32x4 a0 = v0 * w0, a1 = v1 * w1; xw[64 * j] = xr[64 * j] + (sw ? (a1 + a0) : (a0 + a1)); } }
}
#ifndef MK_PHMASK
#define MK_PHMASK 0xFFFFFFFFFFFFull
#endif
#ifndef MK_DUPMASK
#define MK_DUPMASK 0ull
#endif
#ifndef MK_SPLIT
#define MK_SPLIT 0
#endif
#ifndef MK_LAST_PHASE
#define MK_LAST_PHASE 29
#endif
constexpr int N_PHASES = 30;
#ifndef MK_LB
#define MK_LB 2
#endif
__global__ void __launch_bounds__(NTHR, MK_LB) mega_fwd(Args args) {
    extern __shared__ __attribute__((aligned(16))) unsigned char lds_raw[];
    Frame F;
    F.lds = (LAS unsigned char*)lds_raw; F.MISC = (volatile LAS unsigned*)(F.lds + MISC_OFF);
    F.tid = threadIdx.x; F.lane = F.tid & 63; F.wave = __builtin_amdgcn_readfirstlane(F.tid >> 6); F.G = gridDim.x; F.bid = blockIdx.x;
    F.ws = args.ws; F.ctl = (gu32*)(args.ws + WS_CTL);
    for (int u = F.tid; u < (LDS_BYTES - MISC_OFF) / 4; u += NTHR) ((LAS unsigned*)(F.lds + MISC_OFF))[u] = 0u;
    __syncthreads();
    XcdBarrier bar; bar.bar = (unsigned*)(F.ctl + CW_BAR); bar.x = 0; bar.st = nullptr;
    if (!MK_SPLIT) bar = xcd_barrier_post((unsigned*)(F.ctl + CW_BAR), F.MISC + 8);
    const int lo = args.ph_lo, hi = args.ph_hi;
#define PF() Frame Fp = F; { int t_ = threadIdx.x; asm volatile("" : "+v"(t_)); Fp.tid = t_; Fp.lane = t_ & 63; int w_ = F.wave, b_ = F.bid; asm volatile("" : "+s"(w_), "+s"(b_)); Fp.wave = w_; Fp.bid = b_; }
#define IN(k) ((((unsigned long long)MK_PHMASK >> (k)) & 1ull) && lo <= (k) && (k) < hi)
#define DUP(k) ((((unsigned long long)MK_DUPMASK >> (k)) & 1ull) ? 2 : 1)
#define SEAM(k) do { if (!MK_SPLIT && IN((k) + 1)) xcd_barrier(bar); } while (0)
    unsigned char* ws = args.ws; float* out = args.out;
    const int gw = F.bid * NWAVES + F.wave, NGW = F.G * NWAVES;
    LAS unsigned char* glds = F.lds;
    bf16* XN = (bf16*)(ws + WS_XN);

    if (IN(0)) { PF();
#pragma unroll 1
        for (int rep = 0; rep < DUP(0); ++rep) p0_prologue(Fp, args);
        SEAM(0); }
    if (IN(1)) {
        PF();
#pragma unroll 1
        for (int rep = 0; rep < DUP(1); ++rep) {
        if (F.bid == 0) { float* part = (float*)(ws + WS_CMPB_PART); float s = 0.f; for (int ic = 0; ic < 64; ++ic) s += part[(size_t)((Fp.tid >> 8) * 64 + ic) * 256 + (Fp.tid & 255)]; ((float*)(ws + WS_CMPB))[Fp.tid] = s; }
        { pg8::Gemm g{XN, (const bf16*)(ws + WS_W_EVIN), M, EV_INP, D, D, D}; pg8::StaticOrder S; S.init(M, EV_INP, F.G, F.bid);
          pg8::EpiEvIn E{(bf16*)(ws + WS_Y0), EV_INP, (bf16*)(ws + WS_KV6), SEQ};
          pg8::gemm_phase<pg8::EpiEvIn, pg8::StaticOrder, PG8_ALIGN, PG8_SP2>(glds, g, S, E); }
#pragma unroll 1
        for (int l = 0; l < 2; ++l) { pg8::Gemm g{(const bf16*)(ws + WS_MEMN) + (size_t)l * MMEM * D, (const bf16*)(ws + WS_W_XKV) + (size_t)l * 1024 * D, MMEM, 1024, D, D, D};
          pg8::ListOrder S; S.init(2, 4, 8, F.bid - 192 - 8 * l);
          pg8::EpiBf16<0> E{(bf16*)(ws + WS_KVM) + (size_t)l * MMEM * 1024, 1024, nullptr, nullptr};
          pg8::gemm_phase<pg8::EpiBf16<0>, pg8::ListOrder, PG8_ALIGN, PG8_SP2>(glds, g, S, E); }
        }
        SEAM(1);
    }
    if (IN(2)) {
        PF();
#pragma unroll 1
        for (int rep = 0; rep < DUP(2); ++rep) {
        if (F.bid < 128) { rglru_unit(Fp, args, F.bid >> 6, (F.bid >> 3) & 7, F.bid & 7);
        }
        else if (F.bid < 144) { const int mm = (F.bid - 128) >> 3;
            pg8::Gemm g{(const bf16*)(ws + WS_KV6) + (size_t)mm * 4 * SEQ * 128, (const bf16*)(ws + (mm ? WS_W_CV1 : WS_W_CK1)), 2048, 256, 4096, 2048, 4096};
            pg8::ListOrder S; S.init(8, 1, 8, (F.bid - 128) & 7);
            pg8::EpiBf16<1> E{(bf16*)(ws + WS_HID) + (size_t)mm * 2048 * 256, 256, (const float*)(ws + WS_CMPB) + mm * 256, nullptr};
            pg8::gemm_phase<pg8::EpiBf16<1>, pg8::ListOrder, PG8_ALIGN, PG8_SP2>(glds, g, S, E);
#ifdef MK_DUP_CMP1
            pg8::gemm_phase<pg8::EpiBf16<1>, pg8::ListOrder, PG8_ALIGN, PG8_SP2>(glds, g, S, E);
#endif
            VM_WAIT(); __syncthreads(); { const int u0 = mm * 64 + ((F.bid - 128) & 7) * 8; phase_cmp2(Fp, args, u0, u0 + 8, 1); }
        }
        else if (rep == 0) { const int gw2 = (F.bid - 144) * NWAVES + F.wave, NGW2 = (F.G - 144) * NWAVES;
            bf16* ks = (bf16*)(ws + WS_KV6) + (size_t)2 * 4 * SEQ * 128; bf16* kw = (bf16*)(ws + WS_KV6) + (size_t)4 * 4 * SEQ * 128;
            norm128_rows(Fp, ks, 128, ks, 128, 4 * SEQ, args.in[I_KNORM] + 128, gw2, NGW2);
            norm128_rows(Fp, kw, 128, kw, 128, 4 * SEQ, args.in[I_KNORM] + 256, gw2, NGW2);
            phase_memk_norm(Fp, args, 0, gw2, NGW2); phase_memk_norm(Fp, args, 1, gw2, NGW2); convert_range(Fp, args, gw2, NGW2, CONV_A, CONV_P2_END);
#ifdef MK_DUP_P2CONV
            convert_range(Fp, args, gw2, NGW2, CONV_A + (CONV_P2_END - CONV_A) / 2, CONV_P2_END);
#endif
        }
        }
        SEAM(2);
    }
    if (IN(4)) { PF();
#pragma unroll 1
        for (int rep = 0; rep < DUP(4); ++rep) phase_nsa(Fp, args);
        SEAM(4); }
    if (IN(5)) {
        pg8::Gemm g{(const bf16*)(ws + WS_MIX), (const bf16*)(ws + WS_W_EVOUT), M, D, 2048, 2048, 2048}; pg8::StaticOrder S; S.init(M, D, F.G, F.bid);
#pragma unroll 1
        for (int rep = 0; rep < DUP(5); ++rep) { pg8::EpiResidN E{args.in[I_X], (rep + 1 < DUP(5)) ? (float*)(ws + WS_R + 400 * MiB) : out, D, XN, (float*)(ws + WS_SSQ)};
        pg8::gemm_phase<pg8::EpiResidN, pg8::StaticOrder, PG8_ALIGN, PG8_SP2>(glds, g, S, E); }
        SEAM(5);
#ifdef MK_PROBE_BARS
#pragma unroll 1
        for (int xb = 0; xb < MK_PROBE_BARS; ++xb) xcd_barrier(bar);
#endif
    }
#pragma unroll 1
    for (int l = 0; l < 2; ++l) {
        const int pb = l == 0 ? 6 : 21;
        if (IN(pb + 1)) { pg8::Gemm g{XN, (const bf16*)(ws + WS_W_XQ) + (size_t)l * 512 * D, M, 512, D, D, D}; pg8::StaticOrder S; S.init(M, 512, F.G, F.bid);
            pg8::fill_rstd_table((LAS float*)(F.lds + MOE_TAB), S, (const float*)(ws + WS_SSQ), F.tid);
            pg8::EpiBf16<0> E{(bf16*)(ws + WS_QX), 512, nullptr, (const LAS float*)(F.lds + MOE_TAB)};
#pragma unroll 1
            for (int rep = 0; rep < DUP(7); ++rep) pg8::gemm_phase<pg8::EpiBf16<0>, pg8::StaticOrder, PG8_ALIGN, PG8_SP2>(glds, g, S, E);
            if (F.bid >= 128) { PF(); const int lo_ = CONV_ALL - (2 - l) * CONV_Q;
                convert_range(Fp, args, (F.bid - 128) * NWAVES + F.wave, (F.G - 128) * NWAVES, lo_, lo_ + CONV_Q); }
            SEAM(pb + 1); }
        if (IN(pb + 2)) { PF();
#pragma unroll 1
            for (int rep = 0; rep < DUP(8); ++rep) phase_cross_attn(Fp, args, l);
            SEAM(pb + 2); }
        if (IN(pb + 3)) { pg8::Gemm g{(const bf16*)(ws + WS_OX), (const bf16*)(ws + WS_W_XO) + (size_t)l * D * 512, M, D, 512, 512, 512}; pg8::StaticOrder S; S.init(M, D, F.G, F.bid);
#pragma unroll 1
            for (int rep = 0; rep < DUP(9); ++rep) { pg8::EpiResidN E{out, (rep + 1 < DUP(9)) ? (float*)(ws + WS_R + 400 * MiB) : out, D, l == 0 ? XN : (bf16*)nullptr, (float*)(ws + WS_SSQ)};
            pg8::gemm_phase<pg8::EpiResidN, pg8::StaticOrder, PG8_ALIGN, PG8_SP2>(glds, g, S, E); }
            SEAM(pb + 3); }
        if (l == 0) {
            if (IN(11)) { pg8::Gemm g{XN, (const bf16*)(ws + WS_W_FF13), M, 2 * FF, D, D, D}; pg8::StaticOrder S; S.init(M, 2 * FF, F.G, F.bid);
                pg8::fill_rstd_table((LAS float*)(F.lds + MOE_TAB), S, (const float*)(ws + WS_SSQ), F.tid);
                pg8::EpiSwiglu<false> E{(bf16*)(ws + WS_H), FF, (const LAS float*)(F.lds + MOE_TAB)};
#ifdef MK_PROBE_NULLEPI
                { pg8::EpiNull EN; pg8::gemm_phase<pg8::EpiNull, pg8::StaticOrder, PG8_ALIGN, PG8_SP2>(glds, g, S, EN); }
#endif
#pragma unroll 1
                for (int rep = 0; rep < DUP(11); ++rep) pg8::gemm_phase<pg8::EpiSwiglu<false>, pg8::StaticOrder, PG8_ALIGN, PG8_SP2>(glds, g, S, E);
                SEAM(11); }
            if (IN(12)) { pg8::Gemm g{(const bf16*)(ws + WS_H), (const bf16*)(ws + WS_W_FF2), M, D, FF, FF, FF}; pg8::StaticOrder S; S.init(M, D, F.G, F.bid);
#pragma unroll 1
                for (int rep = 0; rep < DUP(12); ++rep) { pg8::EpiResidN E{out, (rep + 1 < DUP(12)) ? (float*)(ws + WS_R + 400 * MiB) : out, D, XN, (float*)(ws + WS_SSQ)};
                pg8::gemm_phase<pg8::EpiResidN, pg8::StaticOrder, PG8_ALIGN, PG8_SP2>(glds, g, S, E); }
                SEAM(12); }
            if (IN(14)) { pg8::Gemm g{XN, (const bf16*)(ws + WS_W_ODIN), M, OD_INP, D, D, D}; pg8::StaticOrder S; S.init(M, OD_INP, F.G, F.bid);
                pg8::fill_rstd_table((LAS float*)(F.lds + MOE_TAB), S, (const float*)(ws + WS_SSQ), F.tid);
                pg8::EpiBf16<0> E{(bf16*)(ws + WS_Y1), OD_INP, nullptr, (const LAS float*)(F.lds + MOE_TAB)};
#pragma unroll 1
                for (int rep = 0; rep < DUP(14); ++rep) pg8::gemm_phase<pg8::EpiBf16<0>, pg8::StaticOrder, PG8_ALIGN, PG8_SP2>(glds, g, S, E);
                SEAM(14); }
            if (IN(15)) { PF();
#pragma unroll 1
                for (int rep = 0; rep < DUP(15); ++rep) phase_mamba_prep(Fp, args);
                SEAM(15); }
            if (IN(16)) { PF();
#pragma unroll 1
                for (int rep = 0; rep < DUP(16); ++rep) phase_mamba_states(Fp);
                SEAM(16); }
            if (IN(17)) { PF();
#pragma unroll 1
                for (int rep = 0; rep < DUP(17); ++rep) phase_mamba_scan(Fp);
                SEAM(17); }
            if (IN(18)) { PF();
#pragma unroll 1
                for (int rep = 0; rep < DUP(18); ++rep) phase_mamba_out(Fp, args);
                SEAM(18); }
            if (IN(20)) { pg8::Gemm g{(const bf16*)(ws + WS_YG), (const bf16*)(ws + WS_W_ODOUT), M, D, 2048, 2048, 2048}; pg8::StaticOrder S; S.init(M, D, F.G, F.bid);
#pragma unroll 1
                for (int rep = 0; rep < DUP(20); ++rep) { pg8::EpiResidN E{out, (rep + 1 < DUP(20)) ? (float*)(ws + WS_R + 400 * MiB) : out, D, XN, (float*)(ws + WS_SSQ)};
                pg8::gemm_phase<pg8::EpiResidN, pg8::StaticOrder, PG8_ALIGN, PG8_SP2>(glds, g, S, E); }
                SEAM(20); }
        }
    }
    if (IN(25)) { PF();
#pragma unroll 1
        for (int rep = 0; rep < DUP(25); ++rep) phase_route(Fp, args, out);
        SEAM(25); }
    if (IN(26)) { PF();
#pragma unroll 1
        for (int rep = 0; rep < DUP(26); ++rep) phase_scatter(Fp);
        SEAM(26); }
    if (IN(27)) { PF(); moe_layout(Fp); const LAS int* tab = (const LAS int*)(F.lds + MOE_TAB);
        pg8::Gemm g{(const bf16*)(ws + WS_XP), (const bf16*)(ws + WS_W_M13), MOE_ROWS, 2 * FFE, D / 2, D / 2, D / 2}  ; MoeOrderX S{tab[24], 2 * FFE / 256, tab[24] * (2 * FFE / 256), F.G, F.bid, tab + 32};
        pg8::EpiSwiglu<true> E{(bf16*)(ws + WS_HP), FFE, nullptr, 1.f / MOE_W13_SCALE};
#pragma unroll 1
        for (int rep = 0; rep < DUP(27); ++rep) pg8::gemm_phase<pg8::EpiSwiglu<true>, MoeOrderX, PG8_ALIGN, PG8_SP2, true>(glds, g, S, E);
        SEAM(27); }
    if (IN(28)) { PF(); moe_layout(Fp); const LAS int* tab = (const LAS int*)(F.lds + MOE_TAB);
        const MoeTail mt = moe_tail(tab, F.G);
        pg8::Gemm g{(const bf16*)(ws + WS_HP), (const bf16*)(ws + WS_W_M2), MOE_ROWS, D, FFE, FFE, FFE}; MoeOrder S{D / 256, mt.split ? mt.R * F.G : tab[24] * (D / 256), F.G, F.bid, tab + 32};
        pg8::EpiF32 E{(float*)(ws + WS_YP), D};
#pragma unroll 1
        for (int rep = 0; rep < DUP(28); ++rep) pg8::gemm_phase<pg8::EpiF32, MoeOrder, PG8_ALIGN, PG8_SP2>(glds, g, S, E);
        if (mt.split) {
            const int piece = F.bid, L = mt.R * F.G + (piece >> 2), kq = piece & 3, pm = L / 4, pn = L % 4;
            MoeTailOrder S2{pm, pn, piece < mt.Lo * 4 ? tab[32 + pm] * 4 + pn : 0, piece < mt.Lo * 4};
            pg8::Gemm g2{(const bf16*)(ws + WS_HP) + kq * (FFE / 4), (const bf16*)(ws + WS_W_M2) + kq * (FFE / 4), MOE_ROWS, D, FFE / 4, FFE, FFE};
            pg8::EpiF32 E2{(float*)(ws + WS_XP) + (size_t)kq * MOE_PART_STRIDE - (size_t)mt.pm_min * 256 * D, D};
            pg8::gemm_phase<pg8::EpiF32, MoeTailOrder, PG8_ALIGN, PG8_SP2>(glds, g2, S2, E2); }
        SEAM(28); }
    if (IN(29)) { PF();
#pragma unroll 1
        for (int rep = 0; rep < DUP(29); ++rep) phase_moe_combine(Fp, out, (rep + 1 < DUP(29)) ? (float*)(ws + WS_H) : out); }
#undef IN
#undef SEAM
}

extern "C" void kernel_launch(void* const* d_in, const int* in_sizes, int n_in, void* d_out, int out_size, void* d_ws, size_t ws_size, hipStream_t stream) {
    static int grid = 0;
    if (grid == 0) {
        if (n_in != N_IN || in_sizes[0] != M * D || out_size != M * D || ws_size < (WS_M_END > WS_END ? WS_M_END : WS_END)) { fprintf(stderr, "kernel_launch: unexpected problem (n_in %d, in0 %d, out %d, ws %zu < %zu); nothing launched\n", n_in, n_in > 0 ? in_sizes[0] : -1, out_size, ws_size, (size_t)WS_END); grid = -1; return; }
        int dev = 0, cus = 0, per_cu = 0;
        if (hipGetDevice(&dev) != hipSuccess || hipDeviceGetAttribute(&cus, hipDeviceAttributeMultiprocessorCount, dev) != hipSuccess) { fprintf(stderr, "kernel_launch: device query failed\n"); grid = -1; return; }
        if (hipFuncSetAttribute((const void*)mega_fwd, hipFuncAttributeMaxDynamicSharedMemorySize, LDS_BYTES) != hipSuccess) { fprintf(stderr, "kernel_launch: hipFuncSetAttribute(%d B LDS) failed\n", LDS_BYTES); grid = -1; return; }
        if (hipOccupancyMaxActiveBlocksPerMultiprocessor(&per_cu, (const void*)mega_fwd, NTHR, LDS_BYTES) != hipSuccess || per_cu < 1) fprintf(stderr, "kernel_launch: note: occupancy query reports %d workgroups per CU\n", per_cu);
        (void)hipGetLastError();
        if (cus < 256) { fprintf(stderr, "kernel_launch: %d CUs < 256: the persistent grid of 256 workgroups would not be resident; nothing launched\n", cus); grid = -1; return; }
        grid = 256;
    }
    if (grid < 0) return;
    if (hipMemsetAsync((char*)d_ws + WS_CTL, 0, CTL_ZERO_BYTES, stream) != hipSuccess) { fprintf(stderr, "kernel_launch: memset failed\n"); return; }
    Args a{};
    for (int i = 0; i < N_IN; ++i) a.in[i] = (const float*)d_in[i];
    a.out = (float*)d_out; a.ws = (unsigned char*)d_ws;
#if MK_SPLIT
    for (int p = 0; p <= MK_LAST_PHASE && p < N_PHASES; ++p) { a.ph_lo = p; a.ph_hi = p + 1; a.li = p; hipLaunchKernelGGL(mega_fwd, dim3(grid), dim3(NTHR), LDS_BYTES, stream, a); }
#else
    a.ph_lo = 0; a.ph_hi = MK_LAST_PHASE + 1; a.li = 0;
    hipLaunchKernelGGL(mega_fwd, dim3(grid), dim3(NTHR), LDS_BYTES, stream, a);
#endif
    const hipError_t le = hipPeekAtLastError();
    if (le != hipSuccess) fprintf(stderr, "kernel_launch: launch failed: %s\n", hipGetErrorName(le));
}
```

```cpp
#include <hip/hip_runtime.h>
#include <cstdio>
#include <cstdint>

namespace pg8 {
#define PG8_LAS __attribute__((address_space(3)))
typedef unsigned short bf16_t;
typedef short bf16x8 __attribute__((ext_vector_type(8)));
typedef float f32x4 __attribute__((ext_vector_type(4)));
typedef unsigned u32x4 __attribute__((ext_vector_type(4)));
typedef unsigned u32x2 __attribute__((ext_vector_type(2)));
constexpr int BM = 256, BK = 64, HALF = 128, HTB = HALF * BK * 2  , STAGE_BYTES = 8 * HTB, NXCD = 8, WGM = 8;

__host__ __device__ __forceinline__ int lds_byte(int r, int c) { const int st = (r >> 4) * 2 + (c >> 5), rr = r & 15, cc = c & 31, ob = rr * 64 + cc * 2; return st * 1024 + (ob ^ (((ob >> 9) & 1) << 5)); }
__host__ __device__ __forceinline__ void stage_rc(int b, int& R, int& C) { const int st = b / 1024, sb = b % 1024, swz = sb ^ (((sb >> 9) & 1) << 5); R = (st >> 1) * 16 + swz / 64; C = (st & 1) * 32 + (swz % 64) / 2; }
__host__ __device__ __forceinline__ int perm32(int rho) { const int n = rho >> 4, i = rho & 15; return 8 * (i >> 2) + 4 * n + (i & 3); }

typedef int i32x8 __attribute__((ext_vector_type(8)));
typedef int i32x4 __attribute__((ext_vector_type(4)));
__device__ __forceinline__ i32x8 cat8(bf16x8 lo, bf16x8 hi) { const i32x4 a = __builtin_bit_cast(i32x4, lo), b = __builtin_bit_cast(i32x4, hi); return __builtin_shufflevector(a, b, 0, 1, 2, 3, 4, 5, 6, 7); }
__device__ __forceinline__ void mfma_f8_inplace(f32x4& acc, i32x8 a, i32x8 b) { asm volatile("v_mfma_f32_16x16x128_f8f6f4 %0, %1, %2, %0" : "+v"(acc) : "v"(a), "v"(b)); }
struct Unit { int pm, pn, bn, idx; };
struct Gemm { const bf16_t* A; const bf16_t* Bt; int M, N, K, lda, ldb; };

struct StaticOrder {
    int nM, nN, nwg, G, c;
    __host__ __device__ void init(int M, int N, int G_, int c_) { nM = M / BM; nN = N / BM; nwg = nM * nN; G = G_; c = c_; }
    __host__ __device__ bool next(int i, Unit& u) const {
        const long L = (long)i * G + c; if (L >= nwg) return false;
        int wgid = (int)L; { const int q = nwg / NXCD, r = nwg % NXCD, xcd = wgid % NXCD, off = wgid / NXCD; wgid = (xcd < r ? xcd * (q + 1) : r * (q + 1) + (xcd - r) * q) + off; }
        const int nig = WGM * nN, gid = wgid / nig, fm = gid * WGM, gsz = (nM - fm) < WGM ? (nM - fm) : WGM;
        u.pm = fm + ((wgid % nig) % gsz); u.pn = (wgid % nig) / gsz; u.bn = u.pn; u.idx = i; return true;
    }
    __device__ __forceinline__ void a_ready(const Unit&) const {}
    __device__ __forceinline__ void done(const Unit&) const {}
};
struct ListOrder {
    int nN, nwg, G, c;
    __host__ __device__ void init(int nM_, int nN_, int G_, int c_) { nN = nN_; nwg = nM_ * nN_; G = G_; c = c_; }
    __host__ __device__ bool next(int i, Unit& u) const { const long L = (long)i * G + c; if (c < 0 || L >= nwg) return false; u.pm = (int)(L / nN); u.pn = (int)(L % nN); u.bn = u.pn; u.idx = i; return true; }
    __device__ __forceinline__ void a_ready(const Unit&) const {}
    __device__ __forceinline__ void done(const Unit&) const {}
};

__device__ __forceinline__ unsigned cvt_pk_bf16(float lo, float hi) { unsigned r; asm volatile("v_cvt_pk_bf16_f32 %0, %1, %2" : "=v"(r) : "v"(lo), "v"(hi)); return r; }
__device__ __forceinline__ unsigned cvt4_fp8(float a, float b, float c, float d) { int r = __builtin_amdgcn_cvt_pk_fp8_f32(a, b, 0, false); r = __builtin_amdgcn_cvt_pk_fp8_f32(c, d, r, true); return (unsigned)r; }
__device__ __forceinline__ float fsigmoid(float x) { return __builtin_amdgcn_rcpf(1.0f + __expf(-x)); }
__device__ __forceinline__ float gelu_tanh(float x) { const float u = 1.5957691216f * (x + 0.044715f * x * x * x); return x * fsigmoid(u); }
__device__ __forceinline__ float fsilu(float x) { return x * fsigmoid(x); }

__device__ __forceinline__ float row_rstd(const float* ssq, int row) {
    const f32x4 a = *(const f32x4*)(ssq + (size_t)row * 16), b = *(const f32x4*)(ssq + (size_t)row * 16 + 4), c = *(const f32x4*)(ssq + (size_t)row * 16 + 8), d = *(const f32x4*)(ssq + (size_t)row * 16 + 12);
    const f32x4 s = (a + b) + (c + d); return 1.0f / sqrtf(((s[0] + s[1]) + (s[2] + s[3])) * (1.0f / 1024.0f) + 1e-6f);
}
template <class Sched> __device__ __forceinline__ void fill_rstd_table(PG8_LAS float* tab, const Sched& S, const float* ssq, int tid) {
    Unit u; for (int i = 0; S.next(i, u); ++i) if (tid < 256) { const int ai = tid >> 7, wr = (tid >> 6) & 1, m = (tid >> 4) & 3, fr = tid & 15; tab[i * 256 + ((ai * 2 + wr) * 16 + fr) * 4 + m] = row_rstd(ssq, u.pm * BM + tid); }
    __syncthreads();
}
template <int ACT, bool SPLIT_ = false> struct EpiBf16 {
    static constexpr bool PERM = true, AFTER_DRAIN = false, SPLIT = SPLIT_, PACK = false; static constexpr int NST = 16; struct Pk {};
    bf16_t* O; int ldc; const float* bias; const PG8_LAS float* rsT;
    __device__ __forceinline__ void operator()(const f32x4 (&acc)[2][2][4][2], const Unit& u, int wr, int wc, int fr, int fq) const { half<0>(acc, u, wr, wc, fr, fq); half<1>(acc, u, wr, wc, fr, fq); }
    template <int AI> __device__ __forceinline__ void half(const f32x4 (&acc)[2][2][4][2], const Unit& u, int wr, int wc, int fr, int fq) const {
        const int row0 = u.pm * BM + wr * 64 + fr; const int col0 = u.pn * BM + wc * 32 + 8 * fq;
        f32x4 bv[2][2];
#pragma unroll
        for (int bj = 0; bj < 2; ++bj)
#pragma unroll
            for (int n = 0; n < 2; ++n) bv[bj][n] = bias ? *(const f32x4*)(bias + col0 + bj * HALF + 4 * n) : (f32x4){0.f, 0.f, 0.f, 0.f};
        { constexpr int ai = AI; const f32x4 rs4 = rsT ? *(const PG8_LAS f32x4*)(rsT + u.idx * 256 + ((ai * 2 + wr) * 16 + fr) * 4) : (f32x4){1.f, 1.f, 1.f, 1.f};
#pragma unroll
            for (int m = 0; m < 4; ++m) { bf16_t* rowp = O + (size_t)(row0 + ai * HALF + m * 16) * ldc + col0; const float rs = rs4[m];
#pragma unroll
                for (int bj = 0; bj < 2; ++bj) { f32x4 v0 = acc[ai][bj][m][0] * rs + bv[bj][0], v1 = acc[ai][bj][m][1] * rs + bv[bj][1];
                    if (ACT == 1) {
#pragma unroll
                        for (int j = 0; j < 4; ++j) { v0[j] = gelu_tanh(v0[j]); v1[j] = gelu_tanh(v1[j]); } }
                    u32x4 w; w.x = cvt_pk_bf16(v0[0], v0[1]); w.y = cvt_pk_bf16(v0[2], v0[3]); w.z = cvt_pk_bf16(v1[0], v1[1]); w.w = cvt_pk_bf16(v1[2], v1[3]);
                    *(u32x4*)(rowp + bj * HALF) = w; } } }
    }
};
struct EpiEvIn {
    static constexpr bool PERM = true, AFTER_DRAIN = false, SPLIT = true, PACK = false; static constexpr int NST = 16; struct Pk {};
    bf16_t* O; int ldc; bf16_t* KV6; int S;
    __device__ __forceinline__ void operator()(const f32x4 (&acc)[2][2][4][2], const Unit& u, int wr, int wc, int fr, int fq) const { half<0>(acc, u, wr, wc, fr, fq); half<1>(acc, u, wr, wc, fr, fq); }
    template <int AI> __device__ __forceinline__ void half(const f32x4 (&acc)[2][2][4][2], const Unit& u, int wr, int wc, int fr, int fq) const {
        const int row0 = u.pm * BM + wr * 64 + fr; const int col0 = u.pn * BM + wc * 32 + 8 * fq;
        const bool kv = (u.pn >= 12 && u.pn < 18);
        { constexpr int ai = AI;
#pragma unroll
            for (int m = 0; m < 4; ++m) { const int row = row0 + ai * HALF + m * 16;
#pragma unroll
                for (int bj = 0; bj < 2; ++bj) { const f32x4 v0 = acc[ai][bj][m][0], v1 = acc[ai][bj][m][1];
                    u32x4 w; w.x = cvt_pk_bf16(v0[0], v0[1]); w.y = cvt_pk_bf16(v0[2], v0[3]); w.z = cvt_pk_bf16(v1[0], v1[1]); w.w = cvt_pk_bf16(v1[2], v1[3]);
                    if (kv) { const int b = row / S, t = row - b * S;
                        bf16_t* p = KV6 + ((((size_t)(u.pn - 12) * 2 + b) * 2 + bj) * S + t) * 128 + wc * 32 + 8 * fq; *(u32x4*)p = w; }
                    else *(u32x4*)(O + (size_t)row * ldc + col0 + bj * HALF) = w; } } }
    }
};
struct EpiResid {
    static constexpr bool PERM = false, AFTER_DRAIN = false, SPLIT = false, PACK = false; static constexpr int NST = 0; struct Pk {};
    const float* base; float* out; int ldc;
    __device__ __forceinline__ void operator()(const f32x4 (&acc)[2][2][4][2], const Unit& u, int wr, int wc, int fr, int fq) const {
        const int row0 = u.pm * BM + wr * 64 + fr, col0 = u.pn * BM + wc * 32 + 4 * fq;
#pragma unroll
        for (int ai = 0; ai < 2; ++ai)
#pragma unroll
            for (int m = 0; m < 4; ++m) { const size_t off = (size_t)(row0 + ai * HALF + m * 16) * ldc + col0;
#pragma unroll
                for (int bj = 0; bj < 2; ++bj)
#pragma unroll
                    for (int n = 0; n < 2; ++n) { const f32x4 b = *(const f32x4*)(base + off + bj * HALF + n * 16); *(f32x4*)(out + off + bj * HALF + n * 16) = b + acc[ai][bj][m][n]; } }
    }
};
struct EpiResidN {
    static constexpr bool PERM = false, AFTER_DRAIN = false, SPLIT = false, PACK = false; static constexpr int NST = 0; struct Pk {};
    const float* base; float* out; int ldc; bf16_t* XB; float* SSQ;
    __device__ __forceinline__ void operator()(const f32x4 (&acc)[2][2][4][2], const Unit& u, int wr, int wc, int fr, int fq) const {
        const int row0 = u.pm * BM + wr * 64 + fr, col0 = u.pn * BM + wc * 32 + 4 * fq;
#pragma unroll
        for (int ai = 0; ai < 2; ++ai)
#pragma unroll
            for (int m = 0; m < 4; ++m) { const int row = row0 + ai * HALF + m * 16; const size_t off = (size_t)row * ldc + col0; float ss = 0.f;
#pragma unroll
                for (int bj = 0; bj < 2; ++bj)
#pragma unroll
                    for (int n = 0; n < 2; ++n) { const f32x4 b = *(const f32x4*)(base + off + bj * HALF + n * 16); const f32x4 v = b + acc[ai][bj][m][n]; *(f32x4*)(out + off + bj * HALF + n * 16) = v;
                        if (XB) { u32x2 w; w.x = cvt_pk_bf16(v[0], v[1]); w.y = cvt_pk_bf16(v[2], v[3]); *(u32x2*)(XB + off + bj * HALF + n * 16) = w; }
                        ss += (v[0] * v[0] + v[1] * v[1]) + (v[2] * v[2] + v[3] * v[3]); }
                ss += __shfl_xor(ss, 16); ss += __shfl_xor(ss, 32);
                if (XB && fq == 0) SSQ[(size_t)row * 16 + u.pn * 4 + wc] = ss; }
    }
};
struct EpiNull {
    static constexpr bool PERM = false, AFTER_DRAIN = false, SPLIT = false, PACK = false; static constexpr int NST = 0; struct Pk {};
    __device__ __forceinline__ void operator()(const f32x4 (&acc)[2][2][4][2], const Unit&, int, int, int, int) const {
#pragma unroll
        for (int ai = 0; ai < 2; ++ai)
#pragma unroll
            for (int bj = 0; bj < 2; ++bj)
#pragma unroll
                for (int m = 0; m < 4; ++m)
#pragma unroll
                    for (int n = 0; n < 2; ++n) asm volatile("" :: "v"(acc[ai][bj][m][n]));
    }
};
struct EpiF32 {
    static constexpr bool PERM = false, AFTER_DRAIN = false, SPLIT = false, PACK = false; static constexpr int NST = 0; struct Pk {};
    float* C; int ldc;
    __device__ __forceinline__ void operator()(const f32x4 (&acc)[2][2][4][2], const Unit& u, int wr, int wc, int fr, int fq) const {
        const int row0 = u.pm * BM + wr * 64 + fr, col0 = u.pn * BM + wc * 32 + 4 * fq;
#pragma unroll
        for (int ai = 0; ai < 2; ++ai)
#pragma unroll
            for (int m = 0; m < 4; ++m) { float* rowp = C + (size_t)(row0 + ai * HALF + m * 16) * ldc + col0;
#pragma unroll
                for (int bj = 0; bj < 2; ++bj)
#pragma unroll
                    for (int n = 0; n < 2; ++n) *(f32x4*)(rowp + bj * HALF + n * 16) = acc[ai][bj][m][n]; }
    }
};
template <bool SPLIT_, bool PACK_ = false, bool F8O_ = false> struct EpiSwiglu {
    static_assert(!(PACK_ && F8O_), "no packed fp8 form");
    static constexpr bool PERM = true, AFTER_DRAIN = false, SPLIT = SPLIT_, PACK = PACK_; static constexpr int NST = 8;
    bf16_t* H; int ldh; const PG8_LAS float* rsT; float sc = 1.f;
    __device__ __forceinline__ void operator()(const f32x4 (&acc)[2][2][4][2], const Unit& u, int wr, int wc, int fr, int fq) const { half<0>(acc, u, wr, wc, fr, fq); half<1>(acc, u, wr, wc, fr, fq); }
    struct Pk { u32x4 w[4]; };
    __device__ __forceinline__ void pack1(const f32x4 (&acc)[2][2][4][2], const Unit& u, int wr, int fr, Pk& pk) const {
        constexpr int ai = 1; const f32x4 rs4 = rsT ? *(const PG8_LAS f32x4*)(rsT + u.idx * 256 + ((ai * 2 + wr) * 16 + fr) * 4) : (f32x4){1.f, 1.f, 1.f, 1.f};
#pragma unroll
        for (int m = 0; m < 4; ++m) { const float rs = rs4[m] * sc;
            const f32x4 u0 = acc[ai][0][m][0] * rs, u1 = acc[ai][0][m][1] * rs, g0 = acc[ai][1][m][0] * rs, g1 = acc[ai][1][m][1] * rs;
            pk.w[m].x = cvt_pk_bf16(fsilu(g0[0]) * u0[0], fsilu(g0[1]) * u0[1]); pk.w[m].y = cvt_pk_bf16(fsilu(g0[2]) * u0[2], fsilu(g0[3]) * u0[3]);
            pk.w[m].z = cvt_pk_bf16(fsilu(g1[0]) * u1[0], fsilu(g1[1]) * u1[1]); pk.w[m].w = cvt_pk_bf16(fsilu(g1[2]) * u1[2], fsilu(g1[3]) * u1[3]); }
    }
    __device__ __forceinline__ void store1(const Pk& pk, const Unit& u, int wr, int wc, int fr, int fq) const {
        bf16_t* p = H + (size_t)(u.pm * BM + wr * 64 + fr + HALF) * ldh + u.pn * 128 + wc * 32 + 8 * fq;
#pragma unroll
        for (int m = 0; m < 4; ++m) *(u32x4*)(p + (size_t)(m * 16) * ldh) = pk.w[m];
    }
    template <int AI> __device__ __forceinline__ void half(const f32x4 (&acc)[2][2][4][2], const Unit& u, int wr, int wc, int fr, int fq) const {
        const int row0 = u.pm * BM + wr * 64 + fr, col0 = u.pn * 128 + wc * 32 + 8 * fq;
        constexpr int ai = AI; const f32x4 rs4 = rsT ? *(const PG8_LAS f32x4*)(rsT + u.idx * 256 + ((ai * 2 + wr) * 16 + fr) * 4) : (f32x4){1.f, 1.f, 1.f, 1.f};
#pragma unroll
        for (int m = 0; m < 4; ++m) { bf16_t* rowp = H + (size_t)(row0 + ai * HALF + m * 16) * ldh + col0; const float rs = rs4[m] * sc;
            const f32x4 u0 = acc[ai][0][m][0] * rs, u1 = acc[ai][0][m][1] * rs, g0 = acc[ai][1][m][0] * rs, g1 = acc[ai][1][m][1] * rs;
            if constexpr (F8O_) { u32x2 w; w.x = cvt4_fp8(fsilu(g0[0]) * u0[0], fsilu(g0[1]) * u0[1], fsilu(g0[2]) * u0[2], fsilu(g0[3]) * u0[3]);
                w.y = cvt4_fp8(fsilu(g1[0]) * u1[0], fsilu(g1[1]) * u1[1], fsilu(g1[2]) * u1[2], fsilu(g1[3]) * u1[3]);
                *(u32x2*)((unsigned char*)H + (size_t)(row0 + ai * HALF + m * 16) * ldh + col0) = w; }
            else { u32x4 w; w.x = cvt_pk_bf16(fsilu(g0[0]) * u0[0], fsilu(g0[1]) * u0[1]); w.y = cvt_pk_bf16(fsilu(g0[2]) * u0[2], fsilu(g0[3]) * u0[3]);
            w.z = cvt_pk_bf16(fsilu(g1[0]) * u1[0], fsilu(g1[1]) * u1[1]); w.w = cvt_pk_bf16(fsilu(g1[2]) * u1[2], fsilu(g1[3]) * u1[3]);
            *(u32x4*)rowp = w; } }
    }
};
__host__ __device__ __forceinline__ int swiglu_row(int h, int gate) { return (h >> 7) * 256 + gate * 128 + (h & 127); }

template <class Epi, class Sched, bool ALIGN_EPI = false, bool SP2 = false, bool F8 = false>
__device__ __forceinline__ void gemm_phase(PG8_LAS unsigned char* lds, const Gemm g, const Sched& S, const Epi& E) {
    int tid = threadIdx.x; asm volatile("" : "+v"(tid));
    const int wid = __builtin_amdgcn_readfirstlane(tid >> 6), lane = tid & 63, wr = wid >> 2, wc = wid & 3, fr = lane & 15, fq = lane >> 4;
    const int K = g.K, nt = K / BK;
    unsigned voffA, voffB;
    { int R, C; stage_rc(tid * 16, R, C); const int Rb = Epi::PERM ? ((R & ~31) + perm32(R & 31)) : R;
      voffA = (unsigned)(R * g.lda + C) * 2u; voffB = (unsigned)(Rb * g.ldb + C) * 2u; }
    const size_t q64A = (size_t)64 * g.lda * 2, q64B = (size_t)64 * g.ldb * 2;
    const size_t kstep = (size_t)(BK * 2);
    const size_t hstepA = (size_t)HALF * g.lda * 2, hstepB = (size_t)HALF * g.ldb * 2;
    const size_t tstepA = 2 * hstepA, tstepB = 2 * hstepB;
    const unsigned ldsw = (unsigned)wid * 1024u;
    const int aoff = lds_byte(wr * 64 + fr, fq * 8), boff = lds_byte(wc * 32 + fr, fq * 8);
#define PG8_SA(b, h) (((b) * 2 + (h)) * HTB)
#define PG8_SB(b, h) ((4 + (b) * 2 + (h)) * HTB)
#define PG8_STAGE(bufoff, gbase, voff) do { __builtin_amdgcn_global_load_lds((const unsigned*)((const char*)(gbase) + (voff)), (PG8_LAS unsigned*)(lds + (bufoff) + ldsw), 16, 0, 0); \
        __builtin_amdgcn_global_load_lds((const unsigned*)((const char*)(gbase) + PG8_Q64(voff) + (voff)), (PG8_LAS unsigned*)(lds + (bufoff) + ldsw + 8192), 16, 0, 0); } while (0)
#define PG8_Q64(v) PG8_Q64_##v
#define PG8_Q64_voffA q64A
#define PG8_Q64_voffB q64B
#define PG8_LDA(dst, b, h) do { _Pragma("unroll") for (int m = 0; m < 4; ++m) _Pragma("unroll") for (int k = 0; k < 2; ++k) dst[m][k] = *(const PG8_LAS bf16x8*)(lds + PG8_SA(b, h) + aoff + m * 2048 + k * 1024); } while (0)
#define PG8_LDB(dst, b, h) do { _Pragma("unroll") for (int n = 0; n < 2; ++n) _Pragma("unroll") for (int k = 0; k < 2; ++k) dst[n][k] = *(const PG8_LAS bf16x8*)(lds + PG8_SB(b, h) + boff + n * 2048 + k * 1024); } while (0)
#define PG8_MMA(ai, bj, At, Bt) do { __builtin_amdgcn_s_setprio(1); \
        if constexpr (F8) { _Pragma("unroll") for (int m = 0; m < 4; ++m) _Pragma("unroll") for (int n = 0; n < 2; ++n) \
            mfma_f8_inplace(acc[ai][bj][m][n], cat8(Bt[n][0], Bt[n][1]), cat8(At[m][0], At[m][1])); } \
        else { _Pragma("unroll") for (int m = 0; m < 4; ++m) _Pragma("unroll") for (int n = 0; n < 2; ++n) _Pragma("unroll") for (int k = 0; k < 2; ++k) \
            acc[ai][bj][m][n] = __builtin_amdgcn_mfma_f32_16x16x32_bf16(Bt[n][k], At[m][k], acc[ai][bj][m][n], 0, 0, 0); } \
        __builtin_amdgcn_s_setprio(0); } while (0)
#define PG8_WAIT_V(n) asm volatile("s_waitcnt vmcnt(" #n ")" ::: "memory")
#define PG8_WAIT_L(n) asm volatile("s_waitcnt lgkmcnt(" #n ")" ::: "memory")
#define PG8_WAIT_REL(NN) do { if (rel) asm volatile("s_waitcnt vmcnt(%0)" :: "n"(NN) : "memory"); else PG8_WAIT_V(8); } while (0)
#define PG8_BAR __builtin_amdgcn_s_barrier()
#define PG8_SCHED __builtin_amdgcn_sched_barrier(0)
    typename Epi::Pk pk; Unit cur, nxt, pend; int ui = 0; bool pending = false; pend.pm = pend.pn = pend.bn = pend.idx = 0;
    if (!S.next(0, cur)) return;
    f32x4 acc[2][2][4][2];
#pragma unroll
    for (int a = 0; a < 2; ++a)
#pragma unroll
        for (int b = 0; b < 2; ++b)
#pragma unroll
            for (int m = 0; m < 4; ++m)
#pragma unroll
                for (int n = 0; n < 2; ++n) acc[a][b][m][n] = (f32x4){0.f, 0.f, 0.f, 0.f};
    bf16x8 At[4][2], B0[2][2], B1[2][2];
    const char* cA = (const char*)g.A + (size_t)cur.pm * tstepA; const char* cB = (const char*)g.Bt + (size_t)cur.bn * tstepB;
    S.a_ready(cur);
    if constexpr (SP2) {
        PG8_STAGE(PG8_SB(0, 0), cB, voffB); PG8_STAGE(PG8_SB(0, 1), cB + hstepB, voffB); PG8_STAGE(PG8_SA(0, 0), cA, voffA); PG8_STAGE(PG8_SA(0, 1), cA + hstepA, voffA);
        if (wr == 1) PG8_BAR;
        PG8_WAIT_V(2); PG8_BAR;
        PG8_STAGE(PG8_SB(1, 0), cB + kstep, voffB); PG8_STAGE(PG8_SA(1, 0), cA + kstep, voffA); PG8_STAGE(PG8_SB(1, 1), cB + hstepB + kstep, voffB);
        PG8_WAIT_V(6); PG8_BAR;
    } else {
        PG8_STAGE(PG8_SB(0, 0), cB, voffB); PG8_STAGE(PG8_SA(0, 0), cA, voffA); PG8_STAGE(PG8_SB(0, 1), cB + hstepB, voffB); PG8_STAGE(PG8_SA(0, 1), cA + hstepA, voffA);
        if (wr == 1) PG8_BAR;
        PG8_WAIT_V(4); PG8_BAR;
        PG8_STAGE(PG8_SB(1, 0), cB + kstep, voffB); PG8_STAGE(PG8_SA(1, 0), cA + kstep, voffA); PG8_STAGE(PG8_SB(1, 1), cB + hstepB + kstep, voffB);
        PG8_WAIT_V(6); PG8_BAR;
    }
    for (;;) {
        const bool has_next = S.next(ui + 1, nxt);
        const char* nA = has_next ? (const char*)g.A + (size_t)nxt.pm * tstepA : cA; const char* nB = has_next ? (const char*)g.Bt + (size_t)nxt.bn * tstepB : cB;
        for (int t = 0; t < nt; t += 2) {
            const bool last = (t == nt - 2);
            const char* a1 = cA + (size_t)(t + 1) * kstep;
            const char* a2 = last ? nA : cA + (size_t)(t + 2) * kstep; const char* b2 = last ? nB : cB + (size_t)(t + 2) * kstep;
            const char* a3 = a2 + kstep; const char* b3 = b2 + kstep;
            if (last && has_next) S.a_ready(nxt);
            if constexpr (SP2) {
            const bool rel = Epi::SPLIT && pending && t == 0;
            if (rel) { if constexpr (Epi::SPLIT) { PG8_STAGE(PG8_SA(1, 1), a1 + hstepA, voffA); PG8_SCHED;
                if constexpr (Epi::PACK) { E.store1(pk, pend, wr, wc, fr, fq); }
                else { E.template half<1>(acc, pend, wr, wc, fr, fq);
#pragma unroll
                for (int b = 0; b < 2; ++b)
#pragma unroll
                    for (int m = 0; m < 4; ++m)
#pragma unroll
                        for (int n = 0; n < 2; ++n) acc[1][b][m][n] = (f32x4){0.f, 0.f, 0.f, 0.f}; }
                S.done(pend); pending = false;
                PG8_SCHED; PG8_LDB(B0, 0, 0); PG8_LDB(B1, 0, 1); PG8_SCHED; PG8_LDA(At, 0, 0); } }
            else { PG8_LDB(B0, 0, 0); PG8_LDB(B1, 0, 1); PG8_SCHED; PG8_LDA(At, 0, 0); PG8_STAGE(PG8_SA(1, 1), a1 + hstepA, voffA); }
            PG8_WAIT_REL(8 + Epi::NST); PG8_WAIT_L(0); PG8_BAR; PG8_MMA(0, 0, At, B0); PG8_MMA(0, 1, At, B1); PG8_BAR; PG8_SCHED;
            PG8_LDA(At, 0, 1); PG8_STAGE(PG8_SB(0, 0), b2, voffB); PG8_STAGE(PG8_SB(0, 1), b2 + hstepB, voffB); PG8_STAGE(PG8_SA(0, 0), a2, voffA);
            PG8_WAIT_REL(8 + Epi::NST); PG8_WAIT_L(0); PG8_BAR; PG8_MMA(1, 0, At, B0); PG8_MMA(1, 1, At, B1); PG8_BAR; PG8_SCHED;
            PG8_LDB(B0, 1, 0); PG8_LDB(B1, 1, 1); PG8_SCHED; PG8_LDA(At, 1, 0); PG8_STAGE(PG8_SA(0, 1), a2 + hstepA, voffA);
            PG8_WAIT_REL(8 + Epi::NST / 2); PG8_WAIT_L(0); PG8_BAR; PG8_MMA(0, 0, At, B0); PG8_MMA(0, 1, At, B1); PG8_BAR; PG8_SCHED;
            PG8_LDA(At, 1, 1); PG8_STAGE(PG8_SB(1, 0), b3, voffB); PG8_STAGE(PG8_SB(1, 1), b3 + hstepB, voffB); PG8_STAGE(PG8_SA(1, 0), a3, voffA);
            PG8_WAIT_V(8); PG8_WAIT_L(0); PG8_BAR; PG8_MMA(1, 0, At, B0); PG8_MMA(1, 1, At, B1); PG8_BAR; PG8_SCHED;
            } else {
            PG8_LDB(B0, 0, 0); PG8_SCHED; PG8_LDA(At, 0, 0); PG8_STAGE(PG8_SA(1, 1), a1 + hstepA, voffA);
            PG8_WAIT_L(8); PG8_BAR; PG8_WAIT_L(0); PG8_MMA(0, 0, At, B0); PG8_BAR; PG8_SCHED;
            PG8_LDB(B1, 0, 1); PG8_STAGE(PG8_SB(0, 0), b2, voffB);
            PG8_BAR; PG8_WAIT_L(0); PG8_MMA(0, 1, At, B1); PG8_BAR;
            PG8_LDA(At, 0, 1); PG8_STAGE(PG8_SA(0, 0), a2, voffA);
            PG8_BAR; PG8_WAIT_L(0); PG8_MMA(1, 0, At, B0); PG8_BAR; PG8_SCHED;
            PG8_STAGE(PG8_SB(0, 1), b2 + hstepB, voffB);
            PG8_WAIT_V(6); PG8_BAR; PG8_MMA(1, 1, At, B1); PG8_BAR;
            PG8_LDB(B0, 1, 0); PG8_SCHED; PG8_LDA(At, 1, 0); PG8_STAGE(PG8_SA(0, 1), a2 + hstepA, voffA);
            PG8_WAIT_L(8); PG8_BAR; PG8_WAIT_L(0); PG8_MMA(0, 0, At, B0); PG8_BAR; PG8_SCHED;
            PG8_LDB(B1, 1, 1); PG8_STAGE(PG8_SB(1, 0), b3, voffB);
            PG8_BAR; PG8_WAIT_L(0); PG8_MMA(0, 1, At, B1); PG8_BAR;
            PG8_LDA(At, 1, 1); PG8_STAGE(PG8_SA(1, 0), a3, voffA);
            PG8_BAR; PG8_WAIT_L(0); PG8_MMA(1, 0, At, B0); PG8_BAR; PG8_SCHED;
            PG8_STAGE(PG8_SB(1, 1), b3 + hstepB, voffB);
            PG8_WAIT_V(6); PG8_BAR; PG8_MMA(1, 1, At, B1); PG8_BAR;
            }
        }
        if constexpr (F8) asm volatile("s_nop 15\n\ts_nop 15\n\ts_nop 15\n\ts_nop 15" ::: "memory");
        if constexpr (ALIGN_EPI) { if (wr == 0) PG8_BAR; }
        if constexpr (Epi::SPLIT) { static_assert(SP2, "split epilogues need the SP2 loop");
            if (has_next) { E.template half<0>(acc, cur, wr, wc, fr, fq); if constexpr (Epi::PACK) E.pack1(acc, cur, wr, fr, pk); pend = cur; pending = true; }
            else { E.template half<0>(acc, cur, wr, wc, fr, fq); E.template half<1>(acc, cur, wr, wc, fr, fq); S.done(cur); } }
        else if constexpr (!Epi::AFTER_DRAIN) { E(acc, cur, wr, wc, fr, fq); S.done(cur); }
        if (!has_next) break;
#pragma unroll
        for (int a = 0; a < ((Epi::SPLIT && !Epi::PACK) ? 1 : 2); ++a)
#pragma unroll
            for (int b = 0; b < 2; ++b)
#pragma unroll
                for (int m = 0; m < 4; ++m)
#pragma unroll
                    for (int n = 0; n < 2; ++n) acc[a][b][m][n] = (f32x4){0.f, 0.f, 0.f, 0.f};
        cur = nxt; cA = nA; cB = nB; ++ui;
        if constexpr (ALIGN_EPI) { if (wr == 1) PG8_BAR; }
    }
    PG8_WAIT_V(0);
    if constexpr (!ALIGN_EPI) { if (wr == 0) PG8_BAR; }
    PG8_BAR;
    if constexpr (Epi::AFTER_DRAIN) { E.fused(acc, cur, wr, wc, fr, fq, lds, wid, lane); S.done(cur); }
#undef PG8_SA
#undef PG8_SB
#undef PG8_STAGE
#undef PG8_Q64
#undef PG8_Q64_voffA
#undef PG8_Q64_voffB
#undef PG8_LDA
#undef PG8_LDB
#undef PG8_MMA
#undef PG8_WAIT_V
#undef PG8_WAIT_L
#undef PG8_WAIT_REL
#undef PG8_BAR
#undef PG8_SCHED
}
}
#define PG8_SP2 true
#define PG8_ALIGN true
constexpr int NWAVES = 8, NTHR = 512;
constexpr int BATCH = 2, SEQ = 8192, D = 1024, M = BATCH * SEQ;
constexpr int MEMLEN = 256, MMEM = BATCH * MEMLEN;
constexpr int EV_IN = 4632, EV_INP = 4864;
constexpr int OD_IN = 5152, OD_INP = 5376;
constexpr int FF = 2816, FFE = 3584, NEXP = 8;
constexpr float MOE_W2_SCALE = 128.f;
constexpr float MOE_W13_SCALE = 64.f;
constexpr int NQB = SEQ / 64;
constexpr int XH = 4;
constexpr float EPS = 1e-6f;
constexpr int MOE_ROWS = 2 * M + NEXP * 256;
constexpr int MOE_TILES = MOE_ROWS / 256;

constexpr size_t MiB = 1u << 20;
constexpr size_t WS_CTL = 0, CTL_ZERO_BYTES = 1 * MiB;
constexpr size_t WS_SMALL = 1 * MiB;
constexpr size_t WS_CMPB_PART = WS_SMALL;
constexpr size_t WS_CMPB = WS_SMALL + 256 * 1024;
constexpr size_t WS_OV = WS_SMALL + 512 * 1024;
constexpr size_t WS_MEMN = 2 * MiB;
constexpr size_t WS_KVM = 4 * MiB;
constexpr size_t WS_KM = 6 * MiB;
constexpr size_t WS_HID = 7 * MiB;
constexpr size_t WS_KVCMP = 9 * MiB;
constexpr size_t WS_MOEIDX = 10 * MiB;
constexpr size_t WS_SSQ = 14 * MiB;
constexpr size_t WS_W = 16 * MiB;
constexpr size_t WS_W_EVIN = WS_W, WS_W_EVOUT = WS_W_EVIN + 10 * MiB, WS_W_CK1 = WS_W_EVOUT + 4 * MiB, WS_W_CV1 = WS_W_CK1 + 2 * MiB, WS_W_ODIN = WS_W_CV1 + 2 * MiB,
                 WS_W_ODOUT = WS_W_ODIN + 11 * MiB, WS_W_XQ = WS_W_ODOUT + 4 * MiB, WS_W_XKV = WS_W_XQ + 2 * MiB, WS_W_XO = WS_W_XKV + 4 * MiB, WS_W_FF13 = WS_W_XO + 2 * MiB,
                 WS_W_FF2 = WS_W_FF13 + 11 * MiB, WS_W_M13 = WS_W_FF2 + 6 * MiB, WS_W_M2 = WS_W_M13 + 112 * MiB, WS_W_END = WS_W_M2 + 56 * MiB;
constexpr size_t WS_XN = WS_W_END;
constexpr size_t WS_QX = WS_XN + 32 * MiB, WS_OX = WS_QX + 16 * MiB, WS_R = WS_OX + 16 * MiB;
constexpr size_t WS_Y0 = WS_R, WS_KV6 = WS_R + 152 * MiB, WS_MIX = WS_R + 201 * MiB, WS_H = WS_R + 265 * MiB;
constexpr size_t WS_Y1 = WS_R, WS_YG = WS_R + 168 * MiB;
constexpr size_t WS_XP = WS_R, WS_HP = WS_R + 68 * MiB, WS_YP = WS_R + 306 * MiB, WS_END = WS_R + 442 * MiB;
static_assert(WS_W_END == 242 * MiB && WS_END == 748 * MiB, "ws map");
constexpr int CW_TMO = 0, CW_CODE = 1, CW_CHK = 2;
constexpr int CW_BAR = 4096;
constexpr int CW_MOECNT = 16384;
constexpr int CW_MOEOFF = 20480;

constexpr int LDS_BYTES = 159744;
constexpr int MISC_OFF = LDS_BYTES - 512;
constexpr int SCR_BYTES = MISC_OFF;

#define GAS __attribute__((address_space(1)))
#define LAS __attribute__((address_space(3)))
typedef unsigned short bf16;
typedef unsigned v4u __attribute__((ext_vector_type(4)));
typedef unsigned v2u __attribute__((ext_vector_type(2)));
typedef float f32x4 __attribute__((ext_vector_type(4)));
typedef float f32x16 __attribute__((ext_vector_type(16)));
typedef short bf16x8 __attribute__((ext_vector_type(8)));
typedef short s16x4 __attribute__((ext_vector_type(4)));
typedef GAS unsigned gu32;
#define RLX_AGENT __ATOMIC_RELAXED, __HIP_MEMORY_SCOPE_AGENT
#define LDS_WAIT() asm volatile("s_waitcnt lgkmcnt(0)" ::: "memory")
#define VM_WAIT() asm volatile("s_waitcnt vmcnt(0)" ::: "memory")
#define SBAR() __builtin_amdgcn_sched_barrier(0)
__device__ __forceinline__ int lane_id() { return (int)threadIdx.x & 63; }
__device__ __forceinline__ unsigned f2bf(float f) { unsigned u = __builtin_bit_cast(unsigned, f); return (u + 0x7fffu + ((u >> 16) & 1u)) >> 16; }
__device__ __forceinline__ unsigned pk2(float lo, float hi) { return f2bf(lo) | (f2bf(hi) << 16); }
__device__ __forceinline__ float bf2f(unsigned short b) { return __builtin_bit_cast(float, ((unsigned)b) << 16); }
__device__ __forceinline__ float bflo(unsigned w) { return __builtin_bit_cast(float, w << 16); }
__device__ __forceinline__ float bfhi(unsigned w) { return __builtin_bit_cast(float, w & 0xffff0000u); }
__device__ __forceinline__ unsigned cvtpk(float lo, float hi) { unsigned r; asm volatile("v_cvt_pk_bf16_f32 %0, %1, %2" : "=v"(r) : "v"(lo), "v"(hi)); return r; }
__device__ __forceinline__ float wave_sum(float v) {
#pragma unroll
    for (int o = 1; o < 64; o <<= 1) v += __shfl_xor(v, o);
    return v;
}
using pg8::fsigmoid; using pg8::gelu_tanh; using pg8::fsilu;
__device__ __forceinline__ float fsoftplus(float x) { return x > 20.f ? x : log1pf(__expf(x)); }

#define XB_TMO      128
#define XB_XCNT(j)  (256  + 64 * (j))
#define XB_XSUB(j)  (1280 + 64 * (j))
#define XB_XGEN(j)  (2304 + 64 * (j))
#define XB_TOP      3328
#define XB_TOPGEN   3392
#define XCD_BAR_WORDS 3456
#define XB_SPIN_CAP (1u << 18)

__device__ __forceinline__ unsigned xb_ld(unsigned* p)              { return __hip_atomic_load(p, __ATOMIC_RELAXED, __HIP_MEMORY_SCOPE_AGENT); }
__device__ __forceinline__ unsigned xb_add(unsigned* p, unsigned v) { return __hip_atomic_fetch_add(p, v, __ATOMIC_RELAXED, __HIP_MEMORY_SCOPE_AGENT); }
__device__ __forceinline__ unsigned xb_xcc_id() { return (unsigned)__builtin_amdgcn_s_getreg((3 << 11) | 20) & 0xFu; }
#define XB_SPIN(cond, bar) do { unsigned _sp = 0; while (cond) { __builtin_amdgcn_s_sleep(1); \
    if ((++_sp & 255u) == 0u) { if (xb_ld(&(bar)[XB_TMO])) break; if (_sp > XB_SPIN_CAP) { atomicAdd(&(bar)[XB_TMO], 1u); break; } } } } while (0)

struct XcdBarrier {
    unsigned* bar; unsigned x;
    volatile LAS unsigned* st;
};

__device__ __forceinline__ XcdBarrier xcd_barrier_post(unsigned* bar, volatile LAS unsigned* st) {
    XcdBarrier b; b.bar = bar; b.x = xb_xcc_id(); b.st = st;
    if (threadIdx.x == 0) (void)xb_add(&bar[XB_XCNT(b.x)], 1u);
    return b;
}
__device__ __forceinline__ void xcd_barrier_complete(unsigned* bar, unsigned x, unsigned& nloc, unsigned& nx) {
    const unsigned G = gridDim.x * gridDim.y * gridDim.z;
    unsigned sum, cnt, mine, sp = 0u;
    for (;;) {
        sum = 0u; cnt = 0u; mine = 0u;
#pragma unroll
        for (unsigned j = 0; j < 16; ++j) { const unsigned c = xb_ld(&bar[XB_XCNT(j)]); sum += c; cnt += (c > 0u) ? 1u : 0u; mine = (j == x) ? c : mine; }
        if (sum == G) break;
        __builtin_amdgcn_s_sleep(1);
        if ((++sp & 255u) == 0u) { if (xb_ld(&bar[XB_TMO])) break; if (sp > XB_SPIN_CAP) { atomicAdd(&bar[XB_TMO], 1u); break; } }
    }
    nloc = mine > 0u ? mine : 1u; nx = cnt > 0u ? cnt : 1u;
}

__device__ __forceinline__ void xcd_barrier(const XcdBarrier& b) {
    asm volatile("s_waitcnt vmcnt(0)" ::: "memory");
    __syncthreads();
    if (threadIdx.x == 0) {
        unsigned* bar = b.bar;
        __builtin_amdgcn_s_waitcnt(0);
        unsigned nloc = b.st[0], nx = b.st[1];
        if (nloc == 0u) { xcd_barrier_complete(bar, b.x, nloc, nx); b.st[0] = nloc; b.st[1] = nx; }
        const unsigned old = xb_add(&bar[XB_XSUB(b.x)], 1u);
        const unsigned gen = old / nloc;
        if (old + 1u == (gen + 1u) * nloc) {
            __builtin_amdgcn_fence(__ATOMIC_RELEASE, "agent");
            asm volatile("s_waitcnt vmcnt(0)" ::: "memory");
            const unsigned og = xb_add(&bar[XB_TOP], 1u);
            const unsigned tg = og / nx;
            if (og + 1u == (tg + 1u) * nx) xb_add(&bar[XB_TOPGEN], 1u);
            else XB_SPIN(xb_ld(&bar[XB_TOPGEN]) == tg, bar);
            __builtin_amdgcn_fence(__ATOMIC_ACQUIRE, "agent");
            xb_add(&bar[XB_XGEN(b.x)], 1u);
            asm volatile("s_waitcnt vmcnt(0)" ::: "memory");
        } else {
            XB_SPIN(xb_ld(&bar[XB_XGEN(b.x)]) == gen, bar);
            __builtin_amdgcn_fence(__ATOMIC_ACQUIRE, "agent");
            asm volatile("s_waitcnt vmcnt(0)" ::: "memory");
        }
    }
    __syncthreads();
}

struct Args { const float* in[41]; float* out; unsigned char* ws; int ph_lo, ph_hi, li, pad; };
struct Frame { LAS unsigned char* lds; volatile LAS unsigned* MISC; gu32* ctl; unsigned char* ws; int tid, lane, wave, G, bid; };
enum { I_X = 0, I_MEM, I_NMIX, I_NCROSS, I_NMEM, I_NFFN, I_EVWIN, I_RGCW, I_RGCB, I_RGWA, I_RGBA, I_RGWX, I_RGBX, I_RGLAM, I_GATEB, I_QNORM, I_KNORM, I_CMPPOS,
       I_CKW1, I_CKW2, I_CVW1, I_CVW2, I_EVWOUT, I_ODWIN, I_ODCW, I_ODCB, I_DTB, I_ALOG, I_DSKIP, I_ODNORM, I_ODWOUT, I_XWQ, I_XWKV, I_XQN, I_XKN, I_XWO,
       I_FFW13, I_FFW2, I_ROUTER, I_MW13, I_MW2, N_IN };
static_assert(N_IN == 41, "input count");

template <int MAP>
__device__ __forceinline__ void transpose_item(const float* W, int N, bf16* WT, int ldt, LAS float* scr, int kb, int nb, int lane, int ffs, const float* kg = nullptr) {
    const int k0 = 64 * kb, n0 = 64 * nb; const int c4 = (lane & 15) * 4, r4 = lane >> 4;
    f32x4 tv[16];
    if ((N & 3) == 0) {
#pragma unroll
        for (int i = 0; i < 16; ++i) { const int kk = 4 * i + r4; tv[i] = (n0 + c4 < N) ? *(const GAS f32x4*)(W + (size_t)(k0 + kk) * N + n0 + c4) : (f32x4){0.f, 0.f, 0.f, 0.f}; }
    } else {
#pragma unroll
        for (int i = 0; i < 16; ++i) { const int kk = 4 * i + r4; const float* src = W + (size_t)(k0 + kk) * N + n0 + c4;
#pragma unroll
            for (int j = 0; j < 4; ++j) tv[i][j] = (n0 + c4 + j < N) ? src[j] : 0.f; }
    }
#pragma unroll
    for (int i = 0; i < 16; ++i) { const int kk = 4 * i + r4; const float gk = kg ? kg[k0 + kk] : 1.f;
#pragma unroll
        for (int j = 0; j < 4; ++j) scr[kk * 65 + c4 + j] = tv[i][j] * gk; }
    LDS_WAIT(); asm volatile("" ::: "memory");
    const int c = lane & 7;
#pragma unroll
    for (int j = 0; j < 8; ++j) { const int nl = (lane >> 3) + 8 * j, n = n0 + nl; const LAS float* s = scr + (8 * c) * 65 + nl;
        v4u o; o.x = pk2(s[0 * 65], s[1 * 65]); o.y = pk2(s[2 * 65], s[3 * 65]); o.z = pk2(s[4 * 65], s[5 * 65]); o.w = pk2(s[6 * 65], s[7 * 65]);
        int row = n; if (MAP == 1) row = (n < ffs) ? pg8::swiglu_row(n, 0) : pg8::swiglu_row(n - ffs, 1);
        if (n < ((N + 31) & ~31)) *(GAS v4u*)(WT + (size_t)row * ldt + k0 + 8 * c) = o; }
    LDS_WAIT(); asm volatile("" ::: "memory");
}
__device__ __forceinline__ unsigned pk4_fp8(float a, float b, float c, float d) { int r = __builtin_amdgcn_cvt_pk_fp8_f32(a, b, 0, false); r = __builtin_amdgcn_cvt_pk_fp8_f32(c, d, r, true); return (unsigned)r; }
template <int MAP>
__device__ __forceinline__ void transpose_item_f8(const float* W, int N, unsigned char* WT8, int ldt, LAS float* scr, int kb, int nb, int lane, int ffs, float sc) {
    const int k0 = 64 * kb, n0 = 64 * nb; const int c4 = (lane & 15) * 4, r4 = lane >> 4;
    f32x4 tv[16];
#pragma unroll
    for (int i = 0; i < 16; ++i) { const int kk = 4 * i + r4; tv[i] = *(const GAS f32x4*)(W + (size_t)(k0 + kk) * N + n0 + c4); }
#pragma unroll
    for (int i = 0; i < 16; ++i) { const int kk = 4 * i + r4;
#pragma unroll
        for (int j = 0; j < 4; ++j) scr[kk * 65 + c4 + j] = tv[i][j] * sc; }
    LDS_WAIT(); asm volatile("" ::: "memory");
    const int c = lane & 7;
#pragma unroll
    for (int j = 0; j < 8; ++j) { const int nl = (lane >> 3) + 8 * j, n = n0 + nl; const LAS float* s = scr + (8 * c) * 65 + nl;
        v2u o; o.x = pk4_fp8(s[0 * 65], s[1 * 65], s[2 * 65], s[3 * 65]); o.y = pk4_fp8(s[4 * 65], s[5 * 65], s[6 * 65], s[7 * 65]);
        int row = n; if (MAP == 1) row = (n < ffs) ? pg8::swiglu_row(n, 0) : pg8::swiglu_row(n - ffs, 1);
        *(GAS v2u*)(WT8 + (size_t)row * ldt + k0 + 8 * c) = o; }
    LDS_WAIT(); asm volatile("" ::: "memory");
}
constexpr int MOE_CONV_ITEMS = NEXP * (16 * 112 + 56 * 16);

__device__ __forceinline__ void rms_row_to_bf16(const float* xrow, const float* g, bf16* orow, int lane) {
    const GAS f32x4* xr = (const GAS f32x4*)xrow + lane; const GAS f32x4* gr = (const GAS f32x4*)g + lane;
    f32x4 v[4]; float s = 0.f;
#pragma unroll
    for (int j = 0; j < 4; ++j) { v[j] = xr[64 * j]; s += (v[j].x * v[j].x + v[j].y * v[j].y) + (v[j].z * v[j].z + v[j].w * v[j].w); }
    const float rstd = 1.f / sqrtf(wave_sum(s) * (1.f / D) + EPS);
    GAS unsigned long long* o8 = (GAS unsigned long long*)orow + lane;
#pragma unroll
    for (int j = 0; j < 4; ++j) { const f32x4 gg = gr[64 * j];
        o8[64 * j] = (unsigned long long)pk2(v[j].x * rstd * gg.x, v[j].y * rstd * gg.y) | ((unsigned long long)pk2(v[j].z * rstd * gg.z, v[j].w * rstd * gg.w) << 32); }
}
__device__ __forceinline__ void phase_rmsnorm(const Frame& F, const float* x, const float* g, bf16* xn, int rows) {
    const int gw = F.bid * NWAVES + F.wave, NGW = F.G * NWAVES;
    for (int m = gw; m < rows; m += NGW) rms_row_to_bf16(x + (size_t)m * D, g, xn + (size_t)m * D, F.lane);
}
#define TR_MAT(cnt_, W_, K_, N_, WT_, ldt_, MAPK_, ffs_, kg_) \
    if (r < (cnt_)) { const int nblk_ = ((N_) + 63) / 64; transpose_item<MAPK_>((W_), (N_), (WT_), (ldt_), scr, r / nblk_, r % nblk_, F.lane, (ffs_), (kg_)); continue; } r -= (cnt_);
constexpr int C_EVIN = 16 * 73, C_EVOUT = 32 * 16, C_CW1 = 64 * 4, C_ODIN = 16 * 81, C_ODOUT = 32 * 16, C_XQ = 16 * 8, C_XKV = 16 * 16, C_XO = 8 * 16, C_FF13 = 16 * 88, C_FF2 = 44 * 16;
constexpr int CONV_A = C_EVIN + 2 * C_XKV + 2 * C_CW1, CONV_B = C_EVOUT + 2 * C_XQ + 2 * C_XO + C_FF13 + C_FF2 + C_ODIN + C_ODOUT;
constexpr int CONV_ALL = CONV_A + CONV_B + MOE_CONV_ITEMS, CONV_Q = 4480, CONV_P2_END = CONV_ALL - 2 * CONV_Q;
__device__ __forceinline__ void convert_range(const Frame& F, const Args& a, int gw, int NGW, int it_lo, int it_hi) {
    LAS float* scr = (LAS float*)(F.lds + F.wave * 16640); unsigned char* ws = F.ws;
    for (int it = it_lo + gw; it < it_hi; it += NGW) {
        int r = it;
        TR_MAT(C_EVIN, a.in[I_EVWIN], D, EV_IN, (bf16*)(ws + WS_W_EVIN), D, 0, 0, nullptr)
        TR_MAT(C_XKV, a.in[I_XWKV], D, 1024, (bf16*)(ws + WS_W_XKV), D, 0, 0, nullptr)
        TR_MAT(C_XKV, a.in[I_XWKV] + (size_t)D * 1024, D, 1024, (bf16*)(ws + WS_W_XKV) + (size_t)1024 * D, D, 0, 0, nullptr)
        TR_MAT(C_CW1, a.in[I_CKW1], 4096, 256, (bf16*)(ws + WS_W_CK1), 4096, 0, 0, nullptr)
        TR_MAT(C_CW1, a.in[I_CVW1], 4096, 256, (bf16*)(ws + WS_W_CV1), 4096, 0, 0, nullptr)
        TR_MAT(C_EVOUT, a.in[I_EVWOUT], 2048, D, (bf16*)(ws + WS_W_EVOUT), 2048, 0, 0, nullptr)
        TR_MAT(C_XQ, a.in[I_XWQ], D, 512, (bf16*)(ws + WS_W_XQ), D, 0, 0, a.in[I_NCROSS])
        TR_MAT(C_XO, a.in[I_XWO], 512, D, (bf16*)(ws + WS_W_XO), 512, 0, 0, nullptr)
        TR_MAT(C_FF13, a.in[I_FFW13], D, 2 * FF, (bf16*)(ws + WS_W_FF13), D, 1, FF, a.in[I_NFFN])
        TR_MAT(C_FF2, a.in[I_FFW2], FF, D, (bf16*)(ws + WS_W_FF2), FF, 0, 0, nullptr)
        TR_MAT(C_ODIN, a.in[I_ODWIN], D, OD_IN, (bf16*)(ws + WS_W_ODIN), D, 0, 0, a.in[I_NMIX] + D)
        TR_MAT(C_ODOUT, a.in[I_ODWOUT], 2048, D, (bf16*)(ws + WS_W_ODOUT), 2048, 0, 0, nullptr)
        TR_MAT(C_XQ, a.in[I_XWQ] + (size_t)D * 512, D, 512, (bf16*)(ws + WS_W_XQ) + (size_t)512 * D, D, 0, 0, a.in[I_NCROSS] + D)
        TR_MAT(C_XO, a.in[I_XWO] + (size_t)512 * D, 512, D, (bf16*)(ws + WS_W_XO) + (size_t)D * 512, 512, 0, 0, nullptr)
        { constexpr int C_M13 = 16 * 112, C_M2 = 56 * 16;
          if (r < NEXP * C_M13) { const int e = r / C_M13, q = r % C_M13; transpose_item_f8<1>(a.in[I_MW13] + (size_t)e * D * 2 * FFE, 2 * FFE, ws + WS_W_M13 + (size_t)e * 2 * FFE * D, D, scr, q / 112, q % 112, F.lane, FFE, MOE_W13_SCALE); continue; } r -= NEXP * C_M13;
          { const int e = r / C_M2, q = r % C_M2; transpose_item_f8<0>(a.in[I_MW2] + (size_t)e * FFE * D, D, ws + WS_W_M2 + (size_t)e * D * FFE, FFE, scr, q / 16, q % 16, F.lane, 0, MOE_W2_SCALE); } }
    }
}
__device__ __forceinline__ void p0_prologue(const Frame& F, const Args& a) {
    const int gw = F.bid * NWAVES + F.wave, NGW = F.G * NWAVES;
    unsigned char* ws = F.ws;
    convert_range(F, a, gw, NGW, 0, CONV_A);
    for (int i = F.bid * NTHR + F.tid; i < 2 * 224 * 128; i += F.G * NTHR) { const int w = i / (224 * 128), q = i % (224 * 128);
        bf16* base = w == 0 ? (bf16*)(ws + WS_W_EVIN) + (size_t)4640 * D : (bf16*)(ws + WS_W_ODIN) + (size_t)5152 * D; *(GAS v4u*)(base + (size_t)q * 8) = (v4u){0u, 0u, 0u, 0u}; }
    phase_rmsnorm(F, a.in[I_X], a.in[I_NMIX], (bf16*)(ws + WS_XN), M);
    phase_rmsnorm(F, a.in[I_MEM], a.in[I_NMEM], (bf16*)(ws + WS_MEMN), MMEM);
    phase_rmsnorm(F, a.in[I_MEM], a.in[I_NMEM] + D, (bf16*)(ws + WS_MEMN) + (size_t)MMEM * D, MMEM);
    for (int i = F.bid * NTHR + F.tid; i < 512 * 128; i += F.G * NTHR) { const int n = i >> 7, j = i & 127; ((bf16*)(ws + WS_OV))[i] = (n <= 510 && n >= 4 * j - 1 && n <= 4 * j + 3) ? (bf16)0x3F80 : (bf16)0; }
    for (int it = gw; it < 128; it += NGW) { const int mm = it >> 6, ic = it & 63; const float* w1 = a.in[mm ? I_CVW1 : I_CKW1]; const float* pos = a.in[I_CMPPOS];
        f32x4 acc = {0.f, 0.f, 0.f, 0.f};
        for (int rr = 0; rr < 64; ++rr) { const int i = ic * 64 + rr; const float p = pos[i]; const f32x4 w = *(const GAS f32x4*)(w1 + (size_t)i * 256 + 4 * F.lane); acc += w * p; }
        *(GAS f32x4*)((float*)(ws + WS_CMPB_PART) + (size_t)(mm * 64 + ic) * 256 + 4 * F.lane) = acc; }
}
#undef TR_MAT
namespace att {
constexpr float SCALE = 0.08838834764831845f;
constexpr float THR = 8.f;
constexpr int KVBLK = 64, DH = 128;
constexpr int SHM_V = KVBLK * DH * 2, SHM_K = KVBLK * DH * 2;
constexpr int NSLOT = 3;
constexpr int LDS_ATT = NSLOT * SHM_V + NSLOT * SHM_K + NWAVES * 64 * 4;
#define KSWZ(row, colB) ((row) * 256 + ((colB) ^ (((row) & 7) << 4)))
__device__ __forceinline__ int v_st(int k, int c) { const int kk = (k & ~0xC) | ((k & 4) << 1) | ((k & 8) >> 1); return ((kk >> 3) * 4 + (c >> 5)) * 512 + ((kk & 7) * 32 + (c & 31)) * 2; }
__device__ __forceinline__ int v_rd_base(int lane) { return ((lane & 3) << 3) | (((lane >> 2) & 3) << 6) | (((lane >> 4) & 1) << 5) | (((lane >> 5) & 1) << 8); }
constexpr int v_rd_off(int d0, int ks, int half) { return d0 * 512 + ks * 4096 + half * 2048; }
__device__ __forceinline__ int crow(int r, int hi) { return (r & 3) + 8 * (r >> 2) + 4 * hi; }
__device__ __forceinline__ bf16x8 pack8(f32x4 a, f32x4 b) { v4u w = {cvtpk(a[0], a[1]), cvtpk(a[2], a[3]), cvtpk(b[0], b[1]), cvtpk(b[2], b[3])}; return *reinterpret_cast<bf16x8*>(&w); }

__device__ __forceinline__ void mask_tile(f32x16& p0, f32x16& p1, int dq, unsigned W) {
    asm volatile("" : "+v"(dq));
    const float NEG = -__builtin_inff();
#pragma unroll
    for (int r = 0; r < 16; ++r) { const int c = (r & 3) + 8 * (r >> 2);
        if ((unsigned)(dq - c) >= W) p0[r] = NEG;
        if ((unsigned)(dq - c - 32) >= W) p1[r] = NEG; }
}
__device__ __forceinline__ void mask_all(f32x16& p0, f32x16& p1) { const float NEG = -__builtin_inff();
#pragma unroll
    for (int r = 0; r < 16; ++r) { p0[r] = NEG; p1[r] = NEG; } }
__device__ __forceinline__ void partialSM(f32x16& p0, f32x16& p1, float& m_reg, float& mn, float& alpha, bool keep = true) {
    float pmax = p0[0];
#pragma unroll
    for (int r = 1; r < 16; ++r) pmax = fmaxf(pmax, p0[r]);
#pragma unroll
    for (int r = 0; r < 16; ++r) pmax = fmaxf(pmax, p1[r]);
    pmax = keep ? pmax : -__builtin_inff();
    { auto rr = __builtin_amdgcn_permlane32_swap(__float_as_uint(pmax), __float_as_uint(pmax), false, false);
      pmax = fmaxf(__uint_as_float(rr[0]), __uint_as_float(rr[1])); }
    constexpr float C2 = 1.4426950408889634f * SCALE;
    if (__builtin_expect(__all((pmax - m_reg) * SCALE <= THR), 1)) { mn = m_reg; alpha = 1.f; }
    else { mn = fmaxf(m_reg, pmax); alpha = __builtin_amdgcn_exp2f((m_reg - mn) * C2); m_reg = mn; }
    const float mnL = keep ? -mn * C2 : -__builtin_inff();
#pragma unroll
    for (int r = 0; r < 16; ++r) p0[r] = fmaf(p0[r], C2, mnL);
#pragma unroll
    for (int r = 0; r < 16; ++r) p1[r] = fmaf(p1[r], C2, mnL);
#pragma unroll
    for (int r = 0; r < 16; ++r) p0[r] = __builtin_amdgcn_exp2f(p0[r]);
}
__device__ __forceinline__ void finishSM(f32x16& p0, f32x16& p1, float alpha, float& l_reg, bf16x8& pa0, bf16x8& pa1, bf16x8& pa2, bf16x8& pa3) {
#pragma unroll
    for (int r = 0; r < 16; ++r) p1[r] = __builtin_amdgcn_exp2f(p1[r]);
    float ps = 0;
#pragma unroll
    for (int r = 0; r < 16; ++r) ps += p0[r];
#pragma unroll
    for (int r = 0; r < 16; ++r) ps += p1[r];
    { auto rr = __builtin_amdgcn_permlane32_swap(__float_as_uint(ps), __float_as_uint(ps), false, false);
      ps = __uint_as_float(rr[0]) + __uint_as_float(rr[1]); }
    l_reg = l_reg * alpha + ps;
#define PK4(P, B_, OUT) do { unsigned a0 = cvtpk(P[B_+0], P[B_+1]), a1 = cvtpk(P[B_+2], P[B_+3]);                          \
        unsigned b0 = cvtpk(P[B_+4], P[B_+5]), b1 = cvtpk(P[B_+6], P[B_+7]);                                             \
        auto r0 = __builtin_amdgcn_permlane32_swap(a0, b0, false, false); auto r1 = __builtin_amdgcn_permlane32_swap(a1, b1, false, false); \
        v4u w = {r0[0], r1[0], r0[1], r1[1]}; OUT = *reinterpret_cast<bf16x8*>(&w); } while (0)
    PK4(p0, 0, pa0); PK4(p0, 8, pa1); PK4(p1, 0, pa2); PK4(p1, 8, pa3);
#undef PK4
}
__device__ __forceinline__ void qkt(f32x16& p0, f32x16& p1, const char* Kslot, int r32, int hi, const bf16x8* qr) {
    p0 = f32x16{}; p1 = f32x16{};
    const char* kb[4];
#pragma unroll
    for (int dd = 0; dd < 4; ++dd) kb[dd] = Kslot + KSWZ(r32, (dd * 16 + hi * 8) * 2);
    bf16x8 fa[4], fb[4];
#define KLD(dst, i, d0) do { const char* a_ = kb[(d0) & 3] + ((d0) >> 2) * 128; dst[i] = *reinterpret_cast<const bf16x8*>(a_); dst[i + 1] = *reinterpret_cast<const bf16x8*>(a_ + 32 * 256); } while (0)
#define KMM(src, i, d0) do { p0 = __builtin_amdgcn_mfma_f32_32x32x16_bf16(src[i], qr[d0], p0, 0, 0, 0); p1 = __builtin_amdgcn_mfma_f32_32x32x16_bf16(src[i + 1], qr[d0], p1, 0, 0, 0); } while (0)
    KLD(fa, 0, 0); KLD(fa, 2, 1); KLD(fb, 0, 2); KLD(fb, 2, 3); SBAR();
    KMM(fa, 0, 0); KMM(fa, 2, 1); SBAR(); KLD(fa, 0, 4); KLD(fa, 2, 5); SBAR();
    KMM(fb, 0, 2); KMM(fb, 2, 3); SBAR(); KLD(fb, 0, 6); KLD(fb, 2, 7); SBAR();
    KMM(fa, 0, 4); KMM(fa, 2, 5); SBAR();
    KMM(fb, 0, 6); KMM(fb, 2, 7);
#undef KLD
#undef KMM
}
__device__ __forceinline__ void pv_tile(f32x16* o, int vbs, bf16x8 pa0, bf16x8 pa1, bf16x8 pa2, bf16x8 pa3) {
#define TRRD(dst, off) asm volatile("ds_read_b64_tr_b16 %0, %1 offset:%2" : "=&v"(dst) : "v"(vbs), "i"(off) : "memory")
#define PV_D0(d0) do { s16x4 l0, l1, l2, l3, h0, h1, h2, h3; constexpr int b_ = v_rd_off(d0, 0, 0); \
        TRRD(l0, b_); TRRD(h0, b_ + 2048); TRRD(l1, b_ + 4096); TRRD(h1, b_ + 6144); TRRD(l2, b_ + 8192); TRRD(h2, b_ + 10240); TRRD(l3, b_ + 12288); TRRD(h3, b_ + 14336); \
        asm volatile("s_waitcnt lgkmcnt(0)" ::: "memory"); SBAR();   \
        o[d0] = __builtin_amdgcn_mfma_f32_32x32x16_bf16(pa0, (bf16x8){l0[0], l0[1], l0[2], l0[3], h0[0], h0[1], h0[2], h0[3]}, o[d0], 0, 0, 0);   \
        o[d0] = __builtin_amdgcn_mfma_f32_32x32x16_bf16(pa1, (bf16x8){l1[0], l1[1], l1[2], l1[3], h1[0], h1[1], h1[2], h1[3]}, o[d0], 0, 0, 0);   \
        o[d0] = __builtin_amdgcn_mfma_f32_32x32x16_bf16(pa2, (bf16x8){l2[0], l2[1], l2[2], l2[3], h2[0], h2[1], h2[2], h2[3]}, o[d0], 0, 0, 0);   \
        o[d0] = __builtin_amdgcn_mfma_f32_32x32x16_bf16(pa3, (bf16x8){l3[0], l3[1], l3[2], l3[3], h3[0], h3[1], h3[2], h3[3]}, o[d0], 0, 0, 0); } while (0)
    PV_D0(0); PV_D0(1); PV_D0(2); PV_D0(3);
#undef PV_D0
#undef TRRD
}
__device__ __forceinline__ void q_issue(const bf16* qrow, int hi, v4u (&raw)[8]) {
#pragma unroll
    for (int d0 = 0; d0 < 8; ++d0) raw[d0] = *(const GAS v4u*)(qrow + d0 * 16 + hi * 8);
}
__device__ __forceinline__ void q_finish(const v4u (&raw)[8], const float* g, int hi, bf16x8* qr) {
    float ss = 0.f;
#pragma unroll
    for (int d0 = 0; d0 < 8; ++d0)
#pragma unroll
        for (int j = 0; j < 4; ++j) { const float a = bflo(raw[d0][j]), b = bfhi(raw[d0][j]); ss += a * a + b * b; }
    ss += __shfl_xor(ss, 32);
    const float rstd = 1.f / sqrtf(ss * (1.f / 128.f) + EPS);
#pragma unroll
    for (int d0 = 0; d0 < 8; ++d0) { const f32x4 g0 = *(const GAS f32x4*)(g + d0 * 16 + hi * 8), g1 = *(const GAS f32x4*)(g + d0 * 16 + hi * 8 + 4);
        v4u w; w.x = cvtpk(bflo(raw[d0][0]) * rstd * g0[0], bfhi(raw[d0][0]) * rstd * g0[1]); w.y = cvtpk(bflo(raw[d0][1]) * rstd * g0[2], bfhi(raw[d0][1]) * rstd * g0[3]);
        w.z = cvtpk(bflo(raw[d0][2]) * rstd * g1[0], bfhi(raw[d0][2]) * rstd * g1[1]); w.w = cvtpk(bflo(raw[d0][3]) * rstd * g1[2], bfhi(raw[d0][3]) * rstd * g1[3]);
        qr[d0] = *reinterpret_cast<bf16x8*>(&w); }
}
__device__ __forceinline__ void load_q(const bf16* qrow, const float* g, int hi, bf16x8* qr) { v4u raw[8]; q_issue(qrow, hi, raw); q_finish(raw, g, hi, qr); }
struct PassIO { const bf16* Kp; int ldk; const bf16* Vp; int ldv; int t_lo, t_hi; };
__device__ __forceinline__ void dma_offsets(int wid, int lane, int ldk, int ldv, unsigned& koff, unsigned& voff) {
    const int row = 4 * wid + (lane >> 4); koff = (unsigned)(row * ldk * 2 + (((lane & 15) ^ (row & 7)) << 4));
    const int st = 2 * wid + (lane >> 5), kk = ((st >> 2) << 3) | ((lane & 31) >> 2), k = (kk & ~0xC) | ((kk & 4) << 1) | ((kk & 8) >> 1); voff = (unsigned)(k * ldv * 2 + ((st & 3) * 32 + 8 * (lane & 3)) * 2);
}
#define ATT_DMA(io_, t, slot) do { const char* kt_ = (const char*)(io_).Kp + (size_t)(t) * (KVBLK * 2) * (io_).ldk; const char* vt_ = (const char*)(io_).Vp + (size_t)(t) * (KVBLK * 2) * (io_).ldv;          \
        LAS unsigned* kd_ = (LAS unsigned*)(ldsl + NSLOT * SHM_V + (slot) * SHM_K + wid * 1024); LAS unsigned* vd_ = (LAS unsigned*)(ldsl + (slot) * SHM_V + wid * 1024);                \
        __builtin_amdgcn_global_load_lds((const unsigned*)(kt_ + koff), kd_, 16, 0, 0); __builtin_amdgcn_global_load_lds((const unsigned*)(kt_ + koff + (size_t)64 * (io_).ldk), kd_ + 2048, 16, 0, 0); \
        __builtin_amdgcn_global_load_lds((const unsigned*)(vt_ + voff), vd_, 16, 0, 0); __builtin_amdgcn_global_load_lds((const unsigned*)(vt_ + voff + (size_t)64 * (io_).ldv), vd_ + 2048, 16, 0, 0); } while (0)
__device__ __forceinline__ void attn_prefetch(char* lds, const PassIO& io) {
    int tid = threadIdx.x; asm volatile("" : "+v"(tid));
    const int wid = __builtin_amdgcn_readfirstlane(tid >> 6), lane = tid & 63;
    unsigned koff, voff; dma_offsets(wid, lane, io.ldk, io.ldv, koff, voff);
    LAS unsigned char* ldsl = (LAS unsigned char*)lds;
    ATT_DMA(io, io.t_lo, 0); if (io.t_hi - io.t_lo > 1) ATT_DMA(io, io.t_lo + 1, 1);
}
template <class MaskF>
__device__ __forceinline__ void attn_pass(char* lds, const bf16x8* qr, const PassIO& io, const MaskF& mf, f32x16 (&o)[4], float& l_out) {
    int tid = threadIdx.x; asm volatile("" : "+v"(tid));
    const int wid = __builtin_amdgcn_readfirstlane(tid >> 6), lane = tid & 63, r32 = lane & 31, hi = lane >> 5;
    char* V_lds = lds; char* K_lds = lds + NSLOT * SHM_V;
    float* wsc = (float*)(lds + NSLOT * SHM_V + NSLOT * SHM_K) + wid * 64; float* al_l = wsc + 32;
    float m_reg = -1e30f, l_reg = 0.f;
#pragma unroll
    for (int d = 0; d < 4; ++d) o[d] = f32x16{};
    const int vb0 = (int)(uintptr_t)V_lds + v_rd_base(lane);
    const int t_lo = io.t_lo, NT = io.t_hi - io.t_lo;
    unsigned koff, voff; dma_offsets(wid, lane, io.ldk, io.ldv, koff, voff);
    LAS unsigned char* ldsl = (LAS unsigned char*)lds;
    f32x16 p0, p1; float mn, alpha = 1.f; bf16x8 pa0, pa1, pa2, pa3;
#define A_RESC(a) do { if (__any((a) < 1.f)) { if (hi == 0) al_l[r32] = (a); asm volatile("s_waitcnt lgkmcnt(0)" ::: "memory"); \
        _Pragma("unroll") for (int d_ = 0; d_ < 4; ++d_) _Pragma("unroll") for (int r = 0; r < 16; ++r) o[d_][r] *= al_l[crow(r, hi)]; } } while (0)
#define A_BAR() do { asm volatile("" ::: "memory"); __builtin_amdgcn_s_barrier(); asm volatile("" ::: "memory"); } while (0)
    const bool lead = wid < 4;
    VM_WAIT();
    __syncthreads();
    if (!lead) A_BAR();
    int sK = 0, sV = 2, sW = 1;
    bool act_prev = false;
    for (int i = 0; i < NT; ++i) {
        if (lead && i >= 1 && i + 1 < NT) ATT_DMA(io, t_lo + i + 1, sW);
        const bool act = mf.active(t_lo + i);
        SBAR(); if (act) qkt(p0, p1, K_lds + sK * SHM_K, r32, hi, qr);
        if (i > 0 && act_prev) pv_tile(o, vb0 + sV * SHM_V, pa0, pa1, pa2, pa3);
        if (!lead && i + 1 < NT) VM_WAIT();
        A_BAR();
        if (!lead && i + 2 < NT) ATT_DMA(io, t_lo + i + 2, sV);
        if (act) { mf(p0, p1, t_lo + i); partialSM(p0, p1, m_reg, mn, alpha, mf.keep(t_lo + i)); A_RESC(alpha); finishSM(p0, p1, alpha, l_reg, pa0, pa1, pa2, pa3); }
        act_prev = act;
        if (lead && i + 1 < NT) VM_WAIT();
        A_BAR();
        { const int t_ = sV; sV = sK; sK = sW; sW = t_; }
    }
    if (act_prev) pv_tile(o, vb0 + sV * SHM_V, pa0, pa1, pa2, pa3);
    if (lead) A_BAR();
    __syncthreads();
#undef A_RESC
#undef A_BAR
    l_out = l_reg;
}
__device__ __forceinline__ void row_inv_l(char* lds, float l_reg, float (&rli)[16]) {
    const int tid = threadIdx.x, wid = __builtin_amdgcn_readfirstlane(tid >> 6), lane = tid & 63, r32 = lane & 31, hi = lane >> 5;
    float* wsc = (float*)(lds + NSLOT * SHM_V + NSLOT * SHM_K) + wid * 64;
    if (hi == 0) wsc[r32] = l_reg;
    asm volatile("s_waitcnt lgkmcnt(0)" ::: "memory");
#pragma unroll
    for (int r = 0; r < 16; ++r) { const float l = wsc[crow(r, hi)]; rli[r] = l > 0.f ? __builtin_amdgcn_rcpf(l) : 0.f; }
    asm volatile("s_waitcnt lgkmcnt(0)" ::: "memory");
}
struct NoMask { __device__ __forceinline__ void operator()(f32x16&, f32x16&, int) const {} __device__ __forceinline__ bool active(int) const { return true; } __device__ __forceinline__ bool keep(int) const { return true; } };
}
__device__ __forceinline__ void norm128_rows(const Frame& F, const bf16* src, size_t lds_, bf16* dst, size_t ldd, int nrows, const float* g, int gw, int NGW) {
    const int sub = F.lane >> 4, l16 = F.lane & 15;
    const f32x4 g0 = *(const GAS f32x4*)(g + l16 * 8), g1 = *(const GAS f32x4*)(g + l16 * 8 + 4);
    for (int r0 = gw * 4; r0 < nrows; r0 += NGW * 4) { const int r = r0 + sub;
        const v4u raw = *(const GAS v4u*)(src + (size_t)r * lds_ + l16 * 8);
        float ss = 0.f;
#pragma unroll
        for (int j = 0; j < 4; ++j) { const float a = bflo(raw[j]), b = bfhi(raw[j]); ss += a * a + b * b; }
        ss += __shfl_xor(ss, 1); ss += __shfl_xor(ss, 2); ss += __shfl_xor(ss, 4); ss += __shfl_xor(ss, 8);
        const float rstd = 1.f / sqrtf(ss * (1.f / 128.f) + EPS);
        v4u w; w.x = cvtpk(bflo(raw[0]) * rstd * g0[0], bfhi(raw[0]) * rstd * g0[1]); w.y = cvtpk(bflo(raw[1]) * rstd * g0[2], bfhi(raw[1]) * rstd * g0[3]);
        w.z = cvtpk(bflo(raw[2]) * rstd * g1[0], bfhi(raw[2]) * rstd * g1[1]); w.w = cvtpk(bflo(raw[3]) * rstd * g1[2], bfhi(raw[3]) * rstd * g1[3]);
        *(GAS v4u*)(dst + (size_t)r * ldd + l16 * 8) = w; }
}
__device__ __forceinline__ void phase_memk_norm(const Frame& F, const Args& a, int l, int gw, int NGW) {
    const bf16* kvm = (const bf16*)(F.ws + WS_KVM) + (size_t)l * MMEM * 1024; bf16* km = (bf16*)(F.ws + WS_KM) + (size_t)l * MMEM * 512;
    for (int bh = 0; bh < BATCH * XH; ++bh) { const int b = bh >> 2, h = bh & 3;
        norm128_rows(F, kvm + (size_t)b * MEMLEN * 1024 + h * 128, 1024, km + (size_t)bh * MEMLEN * 128, 128, MEMLEN, a.in[I_XKN] + l * 128, gw, NGW); }
}

__device__ __forceinline__ void phase_cross_attn(const Frame& F, const Args& a, int l) {
    char* lds = (char*)F.lds; const int r32 = F.lane & 31, hi = F.lane >> 5;
    const bf16* QX = (const bf16*)(F.ws + WS_QX); bf16* OX = (bf16*)(F.ws + WS_OX);
    for (int u = F.bid; u < BATCH * XH * (SEQ / 256); u += F.G) {
        const int tb = u % (SEQ / 256), bh = u / (SEQ / 256), b = bh >> 2, h = bh & 3;
        const size_t row0 = (size_t)b * SEQ + tb * 256 + F.wave * 32;
        const bf16* Kp = (const bf16*)(F.ws + WS_KM) + (size_t)l * MMEM * 512 + (size_t)bh * MEMLEN * 128;
        const bf16* Vp = (const bf16*)(F.ws + WS_KVM) + (size_t)l * MMEM * 1024 + (size_t)b * MEMLEN * 1024 + 512 + h * 128;
        const att::PassIO io{Kp, 128, Vp, 1024, 0, MEMLEN / 64}; att::attn_prefetch(lds, io);
        bf16x8 qr[8]; att::load_q(QX + (row0 + r32) * 512 + h * 128, a.in[I_XQN] + l * 128, hi, qr);
        f32x16 o[4]; float l_reg; att::attn_pass(lds, qr, io, att::NoMask{}, o, l_reg);
        float rli[16]; att::row_inv_l(lds, l_reg, rli);
#pragma unroll
        for (int r = 0; r < 16; ++r) { bf16* orow = OX + (row0 + att::crow(r, hi)) * 512 + h * 128;
#pragma unroll
            for (int d0 = 0; d0 < 4; ++d0) { const float v = o[d0][r] * rli[r]; const float vn = __shfl_xor(v, 1);
                if ((r32 & 1) == 0) *(GAS unsigned*)(orow + d0 * 32 + r32) = cvtpk(v, vn); } }
    }
}

constexpr int NSA_GSC = att::LDS_ATT, NSA_IMP = NSA_GSC + NWAVES * 32 * 3 * 4, NSA_SEL = NSA_IMP + NWAVES * 8 * 128 * 4, NSA_SELU = NSA_SEL + 64 * 4 * 4, NSA_LDS_END = NSA_SELU + NWAVES * 4 * 4;
static_assert(NSA_LDS_END <= SCR_BYTES, "nsa lds");
struct CmpMask { int nmax, hi, nmin_wave;
    __device__ __forceinline__ void operator()(f32x16& p0, f32x16& p1, int t) const { if (t * 64 + 63 <= nmin_wave) return; att::mask_tile(p0, p1, nmax - t * 64 - 4 * hi, 0x40000000u); }
    __device__ __forceinline__ bool active(int) const { return true; } __device__ __forceinline__ bool keep(int) const { return true; } };
struct WinMask { int P, hi, qb;
    __device__ __forceinline__ void operator()(f32x16& p0, f32x16& p1, int t) const { if (t == qb || t == qb - 8) att::mask_tile(p0, p1, P - t * 64 - 4 * hi, 512u); }
    __device__ __forceinline__ bool active(int) const { return true; } __device__ __forceinline__ bool keep(int) const { return true; } };
struct SlcMask { const LAS unsigned* selw; const LAS unsigned* uni; int P, hi, qb;
    __device__ __forceinline__ void operator()(f32x16& p0, f32x16& p1, int t) const { if (t == qb) att::mask_tile(p0, p1, P - t * 64 - 4 * hi, 0x40000000u); }
    __device__ __forceinline__ bool keep(int t) const { return (selw[t >> 5] >> (t & 31)) & 1u; }
    __device__ __forceinline__ bool active(int t) const { return (__builtin_amdgcn_readfirstlane(uni[t >> 5]) >> (t & 31)) & 1u; } };

__device__ __forceinline__ void nsa_unit(const Frame& F, const Args& a, int b, int g, int qb, int dry = 0) {
    char* lds = (char*)F.lds; const int w = F.wave; const int t0 = qb * 64;
#define NSA_LANE() int lane = F.lane; asm volatile("" : "+v"(lane)); const int r32 = lane & 31, hi = lane >> 5; const int tok = 8 * w + (r32 >> 2), head = 4 * g + (r32 & 3), P = t0 + tok; (void)head; (void)P; (void)tok
    unsigned char* wsl = F.ws; asm volatile("" : "+s"(wsl));
    const bf16* Y0 = (const bf16*)(wsl + WS_Y0); const bf16* KV6 = (const bf16*)(wsl + WS_KV6);
    const size_t slab = (size_t)SEQ * 128, bg = (size_t)(b * 2 + g);
    LAS float* gsc = (LAS float*)(F.lds + NSA_GSC) + w * 96; LAS float* imp = (LAS float*)(F.lds + NSA_IMP) + w * 1024; LAS unsigned* selm = (LAS unsigned*)(F.lds + NSA_SEL);
    { NSA_LANE();
      if (hi == 0) {
#pragma unroll
        for (int br = 0; br < 3; ++br) gsc[r32 * 3 + br] = fsigmoid(bf2f(Y0[((size_t)b * SEQ + P) * EV_INP + 4608 + head * 3 + br]) + a.in[I_GATEB][head * 3 + br]); }
      LDS_WAIT(); }
    f32x16 o[4]; float l_reg; float rli[16];
    const bf16* KCMP = (const bf16*)(wsl + WS_KVCMP) + bg * 512 * 128; const bf16* VCMP = (const bf16*)(wsl + WS_KVCMP) + (size_t)2048 * 128 + bg * 512 * 128;
    const int ncmp_t = ((4 * qb + 2) >> 6) + 1;
    const att::PassIO io_imp{KCMP, 128, (const bf16*)(wsl + WS_OV), 128, 0, ncmp_t}, io_cmp{KCMP, 128, VCMP, 128, 0, ncmp_t},
                      io_slc{KV6 + (2 * 4 + bg) * slab, 128, KV6 + (3 * 4 + bg) * slab, 128, 0, qb + 1}, io_win{KV6 + (4 * 4 + bg) * slab, 128, KV6 + (5 * 4 + bg) * slab, 128, qb >= 8 ? qb - 8 : 0, qb + 1};
    v4u qraw[8];
#define NSA_QISSUE() do { NSA_LANE(); att::q_issue(Y0 + ((size_t)b * SEQ + P) * EV_INP + 2048 + head * 128, hi, qraw); } while (0)
    att::attn_prefetch(lds, io_imp); NSA_QISSUE();
    { NSA_LANE(); const CmpMask cm{(P - 31) >> 4, hi, (t0 + 8 * w - 31) >> 4};
      bf16x8 qr[8]; att::q_finish(qraw, a.in[I_QNORM], hi, qr);
      if (dry < 2) att::attn_pass(lds, qr, io_imp, cm, o, l_reg); else { VM_WAIT(); __syncthreads(); l_reg = 1.f; } }
    att::attn_prefetch(lds, io_cmp); NSA_QISSUE();
    if (dry < 3) {
    att::row_inv_l(lds, l_reg, rli);
    { NSA_LANE();
#pragma unroll
    for (int q = 0; q < 4; ++q)
#pragma unroll
        for (int d = 0; d < 4; ++d) { float s = 0.f;
#pragma unroll
            for (int i = 0; i < 4; ++i) s += o[d][4 * q + i] * rli[4 * q + i];
            imp[(2 * q + hi) * 128 + d * 32 + r32] = s; }
    LDS_WAIT();
    { const unsigned long long lt = (1ull << lane) - 1ull;
#pragma unroll 1
    for (int tl = 0; tl < 8; ++tl) { unsigned k0, k1;
        { const int j0 = lane, j1 = lane + 64; const float v0 = imp[tl * 128 + j0], v1 = imp[tl * 128 + j1];
          const float s0 = v0 + (((j0 == 0) || (j0 == qb) || (j0 == qb - 1)) ? 100.f : 0.f), s1 = v1 + (((j1 == 0) || (j1 == qb) || (j1 == qb - 1)) ? 100.f : 0.f);
          k0 = (j0 <= qb) ? __float_as_uint(s0) + 1u : 0u; k1 = (j1 <= qb) ? __float_as_uint(s1) + 1u : 0u; }
        unsigned T = 0u;
#pragma unroll 1
        for (int bit = 30; bit >= 0; --bit) { const unsigned cand = T | (1u << bit);
            const int cnt = __popcll(__ballot(k0 >= cand)) + __popcll(__ballot(k1 >= cand)); if (cnt >= 16) T = cand; }
        const unsigned long long g0 = __ballot(k0 > T), g1 = __ballot(k1 > T), e0 = __ballot(k0 == T), e1 = __ballot(k1 == T);
        const int need = 16 - (__popcll(g0) + __popcll(g1));
        const bool sel0 = (k0 > T) || (k0 == T && __popcll(e0 & lt) < need), sel1 = (k1 > T) || (k1 == T && __popcll(e0) + __popcll(e1 & lt) < need);
        const unsigned long long m0 = __ballot(sel0 && lane <= qb), m1 = __ballot(sel1 && lane + 64 <= qb);
        if (lane == 0) { LAS unsigned* sw = selm + (8 * w + tl) * 4; sw[0] = (unsigned)m0; sw[1] = (unsigned)(m0 >> 32); sw[2] = (unsigned)m1; sw[3] = (unsigned)(m1 >> 32); } } }
    LDS_WAIT();
    if (lane < 4) { unsigned u = 0;
#pragma unroll
        for (int tl = 0; tl < 8; ++tl) u |= selm[(8 * w + tl) * 4 + lane];
        ((LAS unsigned*)(F.lds + NSA_SELU))[w * 4 + lane] = u; }
    LDS_WAIT(); }
    }
    { NSA_LANE(); const CmpMask cm{(P - 31) >> 4, hi, (t0 + 8 * w - 31) >> 4};
      bf16x8 qr[8]; att::q_finish(qraw, a.in[I_QNORM], hi, qr);
#if defined(MK_NSA_DUP) && MK_NSA_DUP == 2
      att::attn_pass(lds, qr, io_cmp, cm, o, l_reg); att::attn_prefetch(lds, io_cmp);
#endif
      if (dry < 2) att::attn_pass(lds, qr, io_cmp, cm, o, l_reg); else { VM_WAIT(); __syncthreads(); l_reg = 1.f; } }
    att::attn_prefetch(lds, io_slc); NSA_QISSUE();
    att::row_inv_l(lds, l_reg, rli);
    unsigned oacc[4][8];
    if (dry < 4) { NSA_LANE();
#pragma unroll
    for (int r = 0; r < 16; ++r) rli[r] *= gsc[att::crow(r, hi) * 3 + 0];
#pragma unroll
    for (int d = 0; d < 4; ++d)
#pragma unroll
        for (int r = 0; r < 16; r += 2) oacc[d][r >> 1] = cvtpk(o[d][r] * rli[r], o[d][r + 1] * rli[r + 1]); }
    { NSA_LANE(); const SlcMask sm{selm + tok * 4, (const LAS unsigned*)(F.lds + NSA_SELU) + w * 4, P, hi, qb};
      bf16x8 qr[8]; att::q_finish(qraw, a.in[I_QNORM], hi, qr);
#if defined(MK_NSA_DUP) && MK_NSA_DUP == 5
      { const size_t bg2 = (bg + 1) & 3; const att::PassIO io_cold{KV6 + (2 * 4 + bg2) * slab, 128, KV6 + (3 * 4 + bg2) * slab, 128, 0, qb + 1};
        att::attn_pass(lds, qr, io_cold, sm, o, l_reg); att::attn_prefetch(lds, io_slc); }
#endif
#if defined(MK_NSA_DUP) && MK_NSA_DUP == 3
      att::attn_pass(lds, qr, io_slc, sm, o, l_reg); att::attn_prefetch(lds, io_slc);
#endif
      if (!dry) att::attn_pass(lds, qr, io_slc, sm, o, l_reg); else { VM_WAIT(); __syncthreads(); } }
    att::attn_prefetch(lds, io_win); NSA_QISSUE();
    att::row_inv_l(lds, l_reg, rli);
    if (dry < 4) { NSA_LANE();
#pragma unroll
    for (int r = 0; r < 16; ++r) rli[r] *= gsc[att::crow(r, hi) * 3 + 1];
#pragma unroll
    for (int d = 0; d < 4; ++d)
#pragma unroll
        for (int r = 0; r < 16; r += 2) oacc[d][r >> 1] = cvtpk(bflo(oacc[d][r >> 1]) + o[d][r] * rli[r], bfhi(oacc[d][r >> 1]) + o[d][r + 1] * rli[r + 1]); }
    { NSA_LANE(); const WinMask wm{P, hi, qb};
      bf16x8 qr[8]; att::q_finish(qraw, a.in[I_QNORM], hi, qr);
#if defined(MK_NSA_DUP) && MK_NSA_DUP == 4
      att::attn_pass(lds, qr, io_win, wm, o, l_reg); att::attn_prefetch(lds, io_win);
#endif
      if (dry < 2) att::attn_pass(lds, qr, io_win, wm, o, l_reg); else { VM_WAIT(); __syncthreads(); l_reg = 1.f; } }
    att::row_inv_l(lds, l_reg, rli);
    if (dry < 4) { NSA_LANE();
    bf16* MIX = dry ? (bf16*)(wsl + WS_R + 400 * MiB) : (bf16*)(wsl + WS_MIX);
#pragma unroll
    for (int r = 0; r < 16; ++r) rli[r] *= gsc[att::crow(r, hi) * 3 + 2];
    bf16* obase = MIX + ((size_t)b * SEQ + t0 + 8 * w) * 2048 + 1024 + 4 * g * 128 + r32;
#pragma unroll
    for (int d0 = 0; d0 < 4; ++d0) {
#pragma unroll
        for (int r = 0; r < 16; ++r) { const int row = att::crow(r, hi); const float v = ((r & 1) ? bfhi(oacc[d0][r >> 1]) : bflo(oacc[d0][r >> 1])) + o[d0][r] * rli[r]; const float vn = __shfl_xor(v, 1);
            if ((r32 & 1) == 0) *(GAS unsigned*)(obase + (size_t)(row >> 2) * 2048 + (row & 3) * 128 + d0 * 32) = cvtpk(v, vn); }
        } }
    __syncthreads();
#undef NSA_QISSUE
#undef NSA_LANE
}
__device__ __forceinline__ void phase_nsa(const Frame& F, const Args& a) {
#pragma unroll 1
    for (int it = F.bid * 2; it < 512; it += F.G * 2)
#pragma unroll 1
        for (int k = 0; k < 2; ++k) { const int p = it >> 1, xcd = p & 7, bg = xcd >> 1, x = (xcd & 1) * 32 + (p >> 3);
#if defined(MK_NSA_DRY)
            nsa_unit(F, a, bg >> 1, bg & 1, k == 0 ? 127 - x : x, MK_NSA_DRY);
#endif
            nsa_unit(F, a, bg >> 1, bg & 1, k == 0 ? 127 - x : x); }
}
__device__ __forceinline__ f32x4 mma16(const LAS bf16* A, int pa, const LAS bf16* B, int pb, int K, f32x4 acc, int fr, int fq) {
    for (int k0 = 0; k0 < K; k0 += 32) { const bf16x8 af = *(const LAS bf16x8*)(A + fr * pa + k0 + 8 * fq); const bf16x8 bfv = *(const LAS bf16x8*)(B + fr * pb + k0 + 8 * fq);
        acc = __builtin_amdgcn_mfma_f32_16x16x32_bf16(af, bfv, acc, 0, 0, 0); }
    return acc;
}

__device__ __forceinline__ void phase_cmp2(const Frame& F, const Args& a, int u_lo, int u_hi, int u_step) {
    LAS bf16* hidS = (LAS bf16*)F.lds; LAS bf16* w2T = (LAS bf16*)(F.lds + 32 * 264 * 2); LAS float* outS = (LAS float*)(F.lds + 32 * 264 * 2 + 128 * 264 * 2);
    const int fr = F.lane & 15, fq = F.lane >> 4;
    for (int u = u_lo; u < u_hi; u += u_step) { const int mm = u >> 6, rb = u & 63;
        const bf16* hid = (const bf16*)(F.ws + WS_HID) + (size_t)mm * 2048 * 256 + (size_t)rb * 32 * 256; const float* w2 = a.in[mm ? I_CVW2 : I_CKW2];
        for (int i = F.tid; i < 32 * 32; i += NTHR) { const int r = i >> 5, c8 = i & 31; *(LAS v4u*)(hidS + r * 264 + c8 * 8) = *(const GAS v4u*)(hid + r * 256 + c8 * 8); }
        for (int i = F.tid; i < 256 * 128; i += NTHR) { const int k = i >> 7, c = i & 127; w2T[c * 264 + k] = (bf16)f2bf(w2[i]); }
        __syncthreads();
        const int rt = F.wave & 1;
#pragma unroll
        for (int cc = 0; cc < 2; ++cc) { const int ct = (F.wave >> 1) * 2 + cc; f32x4 acc = {0.f, 0.f, 0.f, 0.f};
            acc = mma16(hidS + rt * 16 * 264, 264, w2T + ct * 16 * 264, 264, 256, acc, fr, fq);
#pragma unroll
            for (int e = 0; e < 4; ++e) outS[(rt * 16 + 4 * fq + e) * 132 + ct * 16 + fr] = acc[e]; }
        __syncthreads();
        { const int r = F.wave * 4 + (F.lane >> 4), l16 = F.lane & 15; const int grow = rb * 32 + r, n = grow & 511;
          float v[8]; float ss = 0.f;
#pragma unroll
          for (int j = 0; j < 8; ++j) { v[j] = outS[r * 132 + l16 * 8 + j]; ss += v[j] * v[j]; }
          ss += __shfl_xor(ss, 1); ss += __shfl_xor(ss, 2); ss += __shfl_xor(ss, 4); ss += __shfl_xor(ss, 8);
          if (mm == 0) { const float rstd = 1.f / sqrtf(ss * (1.f / 128.f) + EPS); const float* g = a.in[I_KNORM];
#pragma unroll
              for (int j = 0; j < 8; ++j) v[j] = v[j] * rstd * g[l16 * 8 + j]; }
          if (n == 511) {
#pragma unroll
              for (int j = 0; j < 8; ++j) v[j] = 0.f; }
          v4u w; w.x = cvtpk(v[0], v[1]); w.y = cvtpk(v[2], v[3]); w.z = cvtpk(v[4], v[5]); w.w = cvtpk(v[6], v[7]);
          *(GAS v4u*)((bf16*)(F.ws + WS_KVCMP) + (size_t)mm * 2048 * 128 + (size_t)grow * 128 + l16 * 8) = w; }
        __syncthreads();
    }
}

__device__ __forceinline__ void rglru_unit(const Frame& F, const Args& a, int b, int h, int s) {
    const int w = F.wave, lane = F.lane, fr = lane & 15, fq = lane >> 4;
    LAS bf16* xcs = (LAS bf16*)F.lds + w * (16 * 136); LAS float* summ = (LAS float*)(F.lds + 8 * 16 * 136 * 2);
    const bf16* Y0 = (const bf16*)(F.ws + WS_Y0) + (size_t)b * SEQ * EV_INP; bf16* MIX = (bf16*)(F.ws + WS_MIX) + (size_t)b * SEQ * 2048;
    const int ch = h * 128 + s * 16 + fr;
    bf16x8 ba_f[4], bx_f[4];
    { const float* wa = a.in[I_RGWA] + (size_t)h * 128 * 128 + s * 16 + fr; const float* wx = a.in[I_RGWX] + (size_t)h * 128 * 128 + s * 16 + fr;
#pragma unroll
      for (int kk = 0; kk < 4; ++kk) { v4u ua, ux;
#pragma unroll
          for (int e2 = 0; e2 < 4; ++e2) { const int k = 32 * kk + 8 * fq + 2 * e2; ua[e2] = pk2(wa[(size_t)k * 128], wa[(size_t)(k + 1) * 128]); ux[e2] = pk2(wx[(size_t)k * 128], wx[(size_t)(k + 1) * 128]); }
          ba_f[kk] = *reinterpret_cast<bf16x8*>(&ua); bx_f[kk] = *reinterpret_cast<bf16x8*>(&ux); } }
    const float bias_a = a.in[I_RGBA][ch], bias_x = a.in[I_RGBX][ch], c8 = -8.f * fsoftplus(-a.in[I_RGLAM][ch]);
    const int cg = h * 128 + 2 * lane; float cw0[4], cw1[4];
#pragma unroll
    for (int j = 0; j < 4; ++j) { cw0[j] = a.in[I_RGCW][j * 1024 + cg]; cw1[j] = a.in[I_RGCW][j * 1024 + cg + 1]; }
    const float cb0 = a.in[I_RGCB][cg], cb1 = a.in[I_RGCB][cg + 1];
    float carry = 0.f;
    unsigned raw[19];
#define RG_LOAD(c_) do { const int T0_ = (c_) * 128 + 16 * w; _Pragma("unroll") for (int i = 0; i < 19; ++i) { const int t = T0_ - 3 + i; raw[i] = (t >= 0) ? *(const GAS unsigned*)(Y0 + (size_t)t * EV_INP + cg) : 0u; } } while (0)
    RG_LOAD(0);
#ifdef MK_DUP_RG
    for (int cc = 0; cc < 2 * (SEQ / 128); ++cc) { const int c = cc & (SEQ / 128 - 1); if (cc == SEQ / 128) { carry = 0.f; RG_LOAD(0); }
#else
    for (int c = 0; c < SEQ / 128; ++c) {
#endif
        const int T0 = c * 128 + 16 * w;
#pragma unroll
        for (int tt = 0; tt < 16; ++tt) { float y0 = cb0, y1 = cb1;
#pragma unroll
            for (int j = 0; j < 4; ++j) { y0 += cw0[j] * bflo(raw[tt + j]); y1 += cw1[j] * bfhi(raw[tt + j]); }
            *(LAS unsigned*)(xcs + tt * 136 + 2 * lane) = cvtpk(y0, y1); }
        LDS_WAIT();
        if (c + 1 < SEQ / 128) RG_LOAD(c + 1);
        unsigned short gg[4];
#pragma unroll
        for (int e = 0; e < 4; ++e) gg[e] = Y0[(size_t)(T0 + 4 * fq + e) * EV_INP + 1024 + ch];
        f32x4 acc_a = {0.f, 0.f, 0.f, 0.f}, acc_x = {0.f, 0.f, 0.f, 0.f};
#pragma unroll
        for (int kk = 0; kk < 4; ++kk) { const bf16x8 af = *(const LAS bf16x8*)(xcs + fr * 136 + 32 * kk + 8 * fq);
            acc_a = __builtin_amdgcn_mfma_f32_16x16x32_bf16(af, ba_f[kk], acc_a, 0, 0, 0); acc_x = __builtin_amdgcn_mfma_f32_16x16x32_bf16(af, bx_f[kk], acc_x, 0, 0, 0); }
        float hl[4], pl[4]; float hh = 0.f, pp = 1.f;
#pragma unroll
        for (int e = 0; e < 4; ++e) { const float xv = bf2f(xcs[(4 * fq + e) * 136 + s * 16 + fr]);
            const float r = fsigmoid(acc_a[e] + bias_a), ig = fsigmoid(acc_x[e] + bias_x); const float la = c8 * r; const float av = __expf(la);
            const float uu = __builtin_amdgcn_sqrtf((1.f - av) * (1.f + av)) * (ig * xv);
            hh = av * hh + uu; pp *= av; hl[e] = hh; pl[e] = pp; }
        float Apre = 1.f, Hpre = 0.f, Aw = 1.f, Hw = 0.f;
#pragma unroll
        for (int q = 0; q < 4; ++q) { const float Aq = __shfl(pp, fr + 16 * q), Hq = __shfl(hh, fr + 16 * q);
            if (q < fq) { Hpre = Aq * Hpre + Hq; Apre *= Aq; }
            Hw = Aq * Hw + Hq; Aw *= Aq; }
        LAS float* sm = summ + (c & 1) * 256;
        if (fq == 0) { sm[(w * 16 + fr) * 2] = Aw; sm[(w * 16 + fr) * 2 + 1] = Hw; }
        __syncthreads();
        float cin = carry, call = carry;
#pragma unroll
        for (int q = 0; q < 8; ++q) { const float Aq = sm[(q * 16 + fr) * 2], Hq = sm[(q * 16 + fr) * 2 + 1]; call = Aq * call + Hq; if (q < w) cin = call; }
        carry = call;
        const float cl = Apre * cin + Hpre;
#pragma unroll
        for (int e = 0; e < 4; ++e) { const float hv = hl[e] + pl[e] * cl; MIX[(size_t)(T0 + 4 * fq + e) * 2048 + ch] = (bf16)f2bf(gelu_tanh(bf2f(gg[e])) * hv); }
    }
#undef RG_LOAD
    __syncthreads();
}
constexpr size_t WS_M_CN = WS_R + 168 * MiB + 64 * MiB;
constexpr size_t WS_M_BN = WS_M_CN + 16 * MiB, WS_M_BT = WS_M_BN + 16 * MiB, WS_M_XT = WS_M_BT + 16 * MiB, WS_M_ACS = WS_M_XT + 64 * MiB, WS_M_DTV = WS_M_ACS + 2 * MiB,
                 WS_M_ST = WS_M_DTV + 2 * MiB, WS_M_PV = WS_M_ST + 128 * MiB, WS_M_END = WS_M_PV + 64 * MiB;
static_assert(WS_M_END <= WS_R + 560 * MiB, "mamba ws");
constexpr int MB_P = 136;
__device__ __forceinline__ void conv4_silu(const v4u (&rows)[7], const float* cw, int ldw, const float* cb, float (&out)[4][8]) {
    float wv[4][8], bv[8];
#pragma unroll
    for (int j = 0; j < 4; ++j) { const f32x4 w0 = *(const GAS f32x4*)(cw + (size_t)j * ldw), w1 = *(const GAS f32x4*)(cw + (size_t)j * ldw + 4);
#pragma unroll
        for (int i = 0; i < 4; ++i) { wv[j][i] = w0[i]; wv[j][4 + i] = w1[i]; } }
    { const f32x4 b0 = *(const GAS f32x4*)cb, b1 = *(const GAS f32x4*)(cb + 4);
#pragma unroll
      for (int i = 0; i < 4; ++i) { bv[i] = b0[i]; bv[4 + i] = b1[i]; } }
#pragma unroll
    for (int tt = 0; tt < 4; ++tt)
#pragma unroll
        for (int i2 = 0; i2 < 4; ++i2) { float y0 = bv[2 * i2], y1 = bv[2 * i2 + 1];
#pragma unroll
            for (int j = 0; j < 4; ++j) { y0 += wv[j][2 * i2] * bflo(rows[tt + j][i2]); y1 += wv[j][2 * i2 + 1] * bfhi(rows[tt + j][i2]); }
            out[tt][2 * i2] = fsilu(y0); out[tt][2 * i2 + 1] = fsilu(y1); }
}
__device__ __forceinline__ void phase_mamba_prep(const Frame& F, const Args& a) {
    LAS bf16* T = (LAS bf16*)F.lds;
    LAS float* acsS = (LAS float*)(F.lds + 128 * MB_P * 2); LAS float* dtS = acsS + 256;
    const int tid = F.tid, lane = F.lane, w = F.wave, sg = tid >> 4, cv = tid & 15;
    const float* cw = a.in[I_ODCW]; const float* cb = a.in[I_ODCB];
    v4u rows[7];
#define M0_LOAD(u_) do { const int bc_ = (u_) / 24, sl_ = (u_) % 24, T0_ = (bc_ & 63) * 128; const bf16* Y1_ = (const bf16*)(F.ws + WS_Y1) + (size_t)(bc_ >> 6) * SEQ * OD_INP; \
        _Pragma("unroll") for (int i = 0; i < 7; ++i) { const int t = T0_ + 4 * sg - 3 + i; rows[i] = (t >= 0) ? *(const GAS v4u*)(Y1_ + (size_t)t * OD_INP + 2048 + sl_ * 128 + cv * 8) : (v4u){0u, 0u, 0u, 0u}; } } while (0)
    if (F.bid < 128 * 24) M0_LOAD(F.bid);
    for (int u = F.bid; u < 128 * 24; u += F.G) { const int bc = u / 24, sl = u % 24, b = bc >> 6, c = bc & 63, T0 = c * 128;
        const bf16* Y1 = (const bf16*)(F.ws + WS_Y1) + (size_t)b * SEQ * OD_INP; const int ch0 = sl * 128;
        { float vals[4][8];
          conv4_silu(rows, cw + ch0 + cv * 8, 3072, cb + ch0 + cv * 8, vals);
          if (u + F.G < 128 * 24) M0_LOAD(u + F.G);
#pragma unroll
          for (int tt = 0; tt < 4; ++tt) { v4u o; o.x = cvtpk(vals[tt][0], vals[tt][1]); o.y = cvtpk(vals[tt][2], vals[tt][3]); o.z = cvtpk(vals[tt][4], vals[tt][5]); o.w = cvtpk(vals[tt][6], vals[tt][7]);
              *(LAS v4u*)(T + (4 * sg + tt) * MB_P + cv * 8) = o; } }
        if (sl < 16 && w < 2) { const int h = 2 * sl + w;
            const float Ah = -__expf(a.in[I_ALOG][h]), dtb = a.in[I_DTB][h];
            const float d0 = fsoftplus(bf2f(Y1[(size_t)(T0 + 2 * lane) * OD_INP + 5120 + h]) + dtb), d1 = fsoftplus(bf2f(Y1[(size_t)(T0 + 2 * lane + 1) * OD_INP + 5120 + h]) + dtb);
            const float a0 = d0 * Ah, a1 = d1 * Ah; float pr = a0 + a1;
#pragma unroll
            for (int off = 1; off < 64; off <<= 1) { const float t = __shfl_up(pr, off); if (lane >= off) pr += t; }
            const float ex = pr - (a0 + a1); const float c0 = ex + a0, c1 = ex + a0 + a1;
            acsS[w * 128 + 2 * lane] = c0; acsS[w * 128 + 2 * lane + 1] = c1; dtS[w * 128 + 2 * lane] = d0; dtS[w * 128 + 2 * lane + 1] = d1;
            float* ACS = (float*)(F.ws + WS_M_ACS) + ((size_t)bc * 32 + h) * 128; float* DTV = (float*)(F.ws + WS_M_DTV) + ((size_t)bc * 32 + h) * 128;
            typedef float f32x2v __attribute__((ext_vector_type(2))); *(GAS f32x2v*)(ACS + 2 * lane) = (f32x2v){c0, c1}; *(GAS f32x2v*)(DTV + 2 * lane) = (f32x2v){d0, d1}; }
        __syncthreads();
        if (sl < 16) {
            const int cc = tid >> 2, s0 = (tid & 3) * 32, hh = cc >> 6; bf16* XT = (bf16*)(F.ws + WS_M_XT) + (((size_t)bc * 32 + 2 * sl) * 64 + cc) * 128 + s0;
#pragma unroll
            for (int k8 = 0; k8 < 4; ++k8) { float v[8];
#pragma unroll
                for (int k = 0; k < 8; ++k) { const int s = s0 + 8 * k8 + k; v[k] = bf2f(T[s * MB_P + cc]) * dtS[hh * 128 + s]; }
                v4u o; o.x = cvtpk(v[0], v[1]); o.y = cvtpk(v[2], v[3]); o.z = cvtpk(v[4], v[5]); o.w = cvtpk(v[6], v[7]); *(GAS v4u*)(XT + 8 * k8) = o; } }
        else { const int g = (sl - 16) & 3; const bool isB = sl < 20;
            bf16* N = (bf16*)(F.ws + (isB ? WS_M_BN : WS_M_CN)) + ((size_t)b * SEQ + T0) * 512 + g * 128;
            for (int i = tid; i < 128 * 16; i += NTHR) { const int s = i >> 4, c8 = i & 15; *(GAS v4u*)(N + (size_t)s * 512 + c8 * 8) = *(const LAS v4u*)(T + s * MB_P + c8 * 8); }
            if (isB) { const int cc = tid >> 2, s0 = (tid & 3) * 32; bf16* BT = (bf16*)(F.ws + WS_M_BT) + (((size_t)bc * 4 + g) * 128 + cc) * 128 + s0;
#pragma unroll
                for (int k8 = 0; k8 < 4; ++k8) { unsigned short v[8];
#pragma unroll
                    for (int k = 0; k < 8; ++k) v[k] = T[(s0 + 8 * k8 + k) * MB_P + cc];
                    v4u o; o.x = v[0] | ((unsigned)v[1] << 16); o.y = v[2] | ((unsigned)v[3] << 16); o.z = v[4] | ((unsigned)v[5] << 16); o.w = v[6] | ((unsigned)v[7] << 16); *(GAS v4u*)(BT + 8 * k8) = o; } } }
        __syncthreads();
    }
#undef M0_LOAD
}
__device__ __forceinline__ void phase_mamba_states(const Frame& F) {
    LAS bf16* BTs = (LAS bf16*)F.lds; LAS bf16* XW = (LAS bf16*)(F.lds + 128 * MB_P * 2);
    const int tid = F.tid, lane = F.lane, w = F.wave, fr = lane & 15, fq = lane >> 4;
    for (int u = F.bid; u < 128 * 4; u += F.G) { const int bc = u >> 2, g = u & 3;
        const bf16* BT = (const bf16*)(F.ws + WS_M_BT) + ((size_t)bc * 4 + g) * 128 * 128;
        for (int i = tid; i < 128 * 16; i += NTHR) { const int n = i >> 4, c8 = i & 15; *(LAS v4u*)(BTs + n * MB_P + c8 * 8) = *(const GAS v4u*)(BT + (size_t)n * 128 + c8 * 8); }
#pragma unroll 1
        for (int hh = 0; hh < 8; ++hh) { const int h = g * 8 + hh;
            const bf16* XT = (const bf16*)(F.ws + WS_M_XT) + ((size_t)bc * 32 + h) * 64 * 128; const float* ACS = (const float*)(F.ws + WS_M_ACS) + ((size_t)bc * 32 + h) * 128;
            const float aL = ACS[127];
#pragma unroll
            for (int k = 0; k < 2; ++k) { const int i = tid + k * NTHR, p = i >> 4, c8 = i & 15; const v4u raw = *(const GAS v4u*)(XT + (size_t)p * 128 + c8 * 8);
                const f32x4 a0 = *(const GAS f32x4*)(ACS + c8 * 8), a1 = *(const GAS f32x4*)(ACS + c8 * 8 + 4);
                v4u o; o.x = cvtpk(bflo(raw[0]) * __expf(aL - a0[0]), bfhi(raw[0]) * __expf(aL - a0[1])); o.y = cvtpk(bflo(raw[1]) * __expf(aL - a0[2]), bfhi(raw[1]) * __expf(aL - a0[3]));
                o.z = cvtpk(bflo(raw[2]) * __expf(aL - a1[0]), bfhi(raw[2]) * __expf(aL - a1[1])); o.w = cvtpk(bflo(raw[3]) * __expf(aL - a1[2]), bfhi(raw[3]) * __expf(aL - a1[3]));
                *(LAS v4u*)(XW + p * MB_P + c8 * 8) = o; }
            __syncthreads();
            float* ST = (float*)(F.ws + WS_M_ST) + ((size_t)bc * 32 + h) * 64 * 128;
#pragma unroll
            for (int pt = 0; pt < 4; ++pt) { f32x4 acc = {0.f, 0.f, 0.f, 0.f}; acc = mma16(XW + pt * 16 * MB_P, MB_P, BTs + w * 16 * MB_P, MB_P, 128, acc, fr, fq);
#pragma unroll
                for (int e = 0; e < 4; ++e) ST[(size_t)(pt * 16 + 4 * fq + e) * 128 + w * 16 + fr] = acc[e]; }
            __syncthreads();
        }
    }
}
__device__ __forceinline__ void phase_mamba_scan(const Frame& F) {
    const int gt = F.bid * NTHR + F.tid;
    for (int i = gt; i < BATCH * 32 * 64 * 32; i += F.G * NTHR) { const int n4 = i & 31, p = (i >> 5) & 63, h = (i >> 11) & 31, b = i >> 16;
        f32x4 S = {0.f, 0.f, 0.f, 0.f};
#pragma unroll 4
        for (int c = 0; c < 64; ++c) { const size_t bc = (size_t)b * 64 + c; const size_t off = ((bc * 32 + h) * 64 + p) * 128 + n4 * 4;
            const f32x4 st = *(const GAS f32x4*)((const float*)(F.ws + WS_M_ST) + off); const float dec = __expf(((const float*)(F.ws + WS_M_ACS))[(bc * 32 + h) * 128 + 127]);
            v2u o; o.x = cvtpk(S[0], S[1]); o.y = cvtpk(S[2], S[3]); *(GAS v2u*)((bf16*)(F.ws + WS_M_PV) + off) = o;
            S = S * dec + st; } }
}
constexpr int M3_CS = 0, M3_BS = M3_CS + 128 * MB_P * 2, M3_MS = M3_BS + 128 * MB_P * 2, M3_XT = M3_MS + 128 * MB_P * 2, M3_PV = M3_XT + 64 * MB_P * 2, M3_ACS = M3_PV + 64 * MB_P * 2, M3_DT = M3_ACS + 512, M3_END = M3_DT + 512;
static_assert(M3_END <= SCR_BYTES, "mamba lds");
__device__ __forceinline__ void phase_mamba_out(const Frame& F, const Args& a) {
    LAS bf16* Cs = (LAS bf16*)(F.lds + M3_CS); LAS bf16* Bs = (LAS bf16*)(F.lds + M3_BS); LAS bf16* Ms = (LAS bf16*)(F.lds + M3_MS); LAS bf16* XTs = (LAS bf16*)(F.lds + M3_XT); LAS bf16* PVs = (LAS bf16*)(F.lds + M3_PV);
    LAS float* acs = (LAS float*)(F.lds + M3_ACS); LAS float* dtv = (LAS float*)(F.lds + M3_DT);
    const int tid = F.tid, lane = F.lane, w = F.wave, fr = lane & 15, fq = lane >> 4;
    for (int u = F.bid; u < 128 * 4; u += F.G) { const int bc = u >> 2, g = u & 3, b = bc >> 6, T0 = (bc & 63) * 128;
        const bf16* CN = (const bf16*)(F.ws + WS_M_CN) + ((size_t)b * SEQ + T0) * 512 + g * 128; const bf16* BN = (const bf16*)(F.ws + WS_M_BN) + ((size_t)b * SEQ + T0) * 512 + g * 128;
        for (int i = tid; i < 128 * 16; i += NTHR) { const int s = i >> 4, c8 = i & 15;
            *(LAS v4u*)(Cs + s * MB_P + c8 * 8) = *(const GAS v4u*)(CN + (size_t)s * 512 + c8 * 8); *(LAS v4u*)(Bs + s * MB_P + c8 * 8) = *(const GAS v4u*)(BN + (size_t)s * 512 + c8 * 8); }
        __syncthreads();
        f32x4 cbt[8];
#pragma unroll
        for (int st = 0; st < 8; ++st) { cbt[st] = (f32x4){0.f, 0.f, 0.f, 0.f}; if (st <= w) cbt[st] = mma16(Bs + st * 16 * MB_P, MB_P, Cs + w * 16 * MB_P, MB_P, 128, cbt[st], fr, fq); }
        const bf16* Y1 = (const bf16*)(F.ws + WS_Y1) + ((size_t)b * SEQ + T0) * OD_INP; bf16* YG = (bf16*)(F.ws + WS_YG) + ((size_t)b * SEQ + T0) * 2048;
        v4u pfx[2], pfp[2]; float pfa = 0.f, pfd = 0.f;
#define M3_PREFETCH(hh_) do { const int h_ = g * 8 + (hh_); const bf16* XT_ = (const bf16*)(F.ws + WS_M_XT) + ((size_t)bc * 32 + h_) * 64 * 128; const bf16* PV_ = (const bf16*)(F.ws + WS_M_PV) + ((size_t)bc * 32 + h_) * 64 * 128; \
            _Pragma("unroll") for (int k = 0; k < 2; ++k) { const int i = tid + k * NTHR, p = i >> 4, c8 = i & 15; pfx[k] = *(const GAS v4u*)(XT_ + (size_t)p * 128 + c8 * 8); pfp[k] = *(const GAS v4u*)(PV_ + (size_t)p * 128 + c8 * 8); } \
            if (tid < 128) { pfa = ((const float*)(F.ws + WS_M_ACS))[((size_t)bc * 32 + h_) * 128 + tid]; pfd = ((const float*)(F.ws + WS_M_DTV))[((size_t)bc * 32 + h_) * 128 + tid]; } } while (0)
        M3_PREFETCH(0);
#pragma unroll 1
        for (int hh = 0; hh < 8; ++hh) { const int h = g * 8 + hh; const float dsk = a.in[I_DSKIP][h];
#pragma unroll
            for (int k = 0; k < 2; ++k) { const int i = tid + k * NTHR, p = i >> 4, c8 = i & 15; *(LAS v4u*)(XTs + p * MB_P + c8 * 8) = pfx[k]; *(LAS v4u*)(PVs + p * MB_P + c8 * 8) = pfp[k]; }
            if (tid < 128) { acs[tid] = pfa; dtv[tid] = pfd; }
            __syncthreads();
            if (hh + 1 < 8) M3_PREFETCH(hh + 1);
            unsigned short zz[4][4];
#pragma unroll
            for (int pt = 0; pt < 4; ++pt)
#pragma unroll
                for (int e = 0; e < 4; ++e) zz[pt][e] = Y1[(size_t)(16 * w + 4 * fq + e) * OD_INP + h * 64 + pt * 16 + fr];
            const float aq = acs[16 * w + fr];
#pragma unroll
            for (int st = 0; st < 8; ++st) { if (st <= w) { float mv[4];
#pragma unroll
                for (int e = 0; e < 4; ++e) { const int s = 16 * st + 4 * fq + e; mv[e] = (s <= 16 * w + fr) ? cbt[st][e] * __expf(aq - acs[s]) : 0.f; }
                v2u o; o.x = cvtpk(mv[0], mv[1]); o.y = cvtpk(mv[2], mv[3]); *(LAS v2u*)(Ms + (16 * w + fr) * MB_P + 16 * st + 4 * fq) = o; } }
            if ((w & 1) == 0) *(LAS v2u*)(Ms + (16 * w + fr) * MB_P + 16 * (w + 1) + 4 * fq) = (v2u){0u, 0u};
            LDS_WAIT();
#pragma unroll
            for (int pt = 0; pt < 4; ++pt) { f32x4 yd = {0.f, 0.f, 0.f, 0.f}, yo = {0.f, 0.f, 0.f, 0.f};
                yd = mma16(Ms + w * 16 * MB_P, MB_P, XTs + pt * 16 * MB_P, MB_P, ((w + 2) >> 1) * 32, yd, fr, fq);
                yo = mma16(Cs + w * 16 * MB_P, MB_P, PVs + pt * 16 * MB_P, MB_P, 128, yo, fr, fq);
#pragma unroll
                for (int e = 0; e < 4; ++e) { const int q = 16 * w + 4 * fq + e, p = pt * 16 + fr;
                    const float xs = bf2f(XTs[p * MB_P + q]) * __builtin_amdgcn_rcpf(dtv[q]);
                    const float y = yd[e] + __expf(acs[q]) * yo[e] + dsk * xs;
                    YG[(size_t)q * 2048 + h * 64 + p] = (bf16)f2bf(y * fsilu(bf2f(zz[pt][e]))); } }
            __syncthreads();
        }
#undef M3_PREFETCH
        VM_WAIT(); __syncthreads();
        { const float* gn = a.in[I_ODNORM] + g * 512 + lane * 8; const f32x4 g0 = *(const GAS f32x4*)gn, g1 = *(const GAS f32x4*)(gn + 4);
#pragma unroll 4
          for (int t = 0; t < 16; ++t) { bf16* pq = YG + (size_t)(16 * w + t) * 2048 + g * 512 + lane * 8; const v4u raw = *(const GAS v4u*)pq; float ss = 0.f;
#pragma unroll
              for (int j = 0; j < 4; ++j) { const float x0 = bflo(raw[j]), x1 = bfhi(raw[j]); ss += x0 * x0 + x1 * x1; }
              const float rstd = 1.f / sqrtf(wave_sum(ss) * (1.f / 512.f) + EPS);
              v4u o; o.x = cvtpk(bflo(raw[0]) * rstd * g0[0], bfhi(raw[0]) * rstd * g0[1]); o.y = cvtpk(bflo(raw[1]) * rstd * g0[2], bfhi(raw[1]) * rstd * g0[3]);
              o.z = cvtpk(bflo(raw[2]) * rstd * g1[0], bfhi(raw[2]) * rstd * g1[1]); o.w = cvtpk(bflo(raw[3]) * rstd * g1[2], bfhi(raw[3]) * rstd * g1[3]);
              *(GAS v4u*)pq = o; } }
    }
}
__device__ __forceinline__ void phase_group_norm(const Frame& F, const Args& a) {
    const int gw = F.bid * NWAVES + F.wave, NGW = F.G * NWAVES; bf16* YG = (bf16*)(F.ws + WS_YG); const float* g = a.in[I_ODNORM];
    for (int m = gw; m < M; m += NGW) {
#pragma unroll
        for (int gi = 0; gi < 4; ++gi) { bf16* p = YG + (size_t)m * 2048 + gi * 512 + F.lane * 8; const v4u raw = *(const GAS v4u*)p; float ss = 0.f;
#pragma unroll
            for (int j = 0; j < 4; ++j) { const float x0 = bflo(raw[j]), x1 = bfhi(raw[j]); ss += x0 * x0 + x1 * x1; }
            const float rstd = 1.f / sqrtf(wave_sum(ss) * (1.f / 512.f) + EPS);
            const f32x4 g0 = *(const GAS f32x4*)(g + gi * 512 + F.lane * 8), g1 = *(const GAS f32x4*)(g + gi * 512 + F.lane * 8 + 4);
            v4u o; o.x = cvtpk(bflo(raw[0]) * rstd * g0[0], bfhi(raw[0]) * rstd * g0[1]); o.y = cvtpk(bflo(raw[1]) * rstd * g0[2], bfhi(raw[1]) * rstd * g0[3]);
            o.z = cvtpk(bflo(raw[2]) * rstd * g1[0], bfhi(raw[2]) * rstd * g1[1]); o.w = cvtpk(bflo(raw[3]) * rstd * g1[2], bfhi(raw[3]) * rstd * g1[3]);
            *(GAS v4u*)p = o; }
    }
}
constexpr int MOE_TAB = 131072;
static_assert(MOE_TAB + (32 + MOE_TILES + 24) * 4 <= SCR_BYTES, "moe lds");
__device__ __forceinline__ void phase_route(const Frame& F, const Args& a, const float* x) {
    LAS int* cntS = (LAS int*)F.lds;
    if (F.tid < 8) cntS[F.tid] = 0;
    __syncthreads();
    const float* g = a.in[I_NFFN] + D; const float* router = a.in[I_ROUTER]; bf16* XN = (bf16*)(F.ws + WS_XN);
    int* tokE = (int*)(F.ws + WS_MOEIDX); float* tokW = (float*)(F.ws + WS_MOEIDX + 1 * MiB);
    const int per = M / F.G;
    for (int i = F.wave; i < per; i += NWAVES) { const int m = F.bid * per + i;
        const GAS f32x4* xr = (const GAS f32x4*)(x + (size_t)m * D) + F.lane; const GAS f32x4* gr = (const GAS f32x4*)g + F.lane;
        f32x4 v[4]; float s = 0.f;
#pragma unroll
        for (int j = 0; j < 4; ++j) { v[j] = xr[64 * j]; s += (v[j].x * v[j].x + v[j].y * v[j].y) + (v[j].z * v[j].z + v[j].w * v[j].w); }
        const float rstd = 1.f / sqrtf(wave_sum(s) * (1.f / D) + EPS);
        float lg[8];
#pragma unroll
        for (int e = 0; e < 8; ++e) lg[e] = 0.f;
        GAS unsigned long long* o8 = (GAS unsigned long long*)(XN + (size_t)m * D) + F.lane;
#pragma unroll
        for (int j = 0; j < 4; ++j) { const f32x4 gg = gr[64 * j]; f32x4 hn = v[j] * rstd * gg;
            o8[64 * j] = (unsigned long long)pk2(hn.x, hn.y) | ((unsigned long long)pk2(hn.z, hn.w) << 32);
#pragma unroll
            for (int q = 0; q < 4; ++q) { const int k = 256 * j + 4 * F.lane + q; const f32x4 r0 = *(const GAS f32x4*)(router + (size_t)k * 8), r1 = *(const GAS f32x4*)(router + (size_t)k * 8 + 4);
#pragma unroll
                for (int e = 0; e < 4; ++e) { lg[e] += hn[q] * r0[e]; lg[4 + e] += hn[q] * r1[e]; } } }
#pragma unroll
        for (int e = 0; e < 8; ++e) lg[e] = wave_sum(lg[e]);
        int e1 = 0; float v1 = lg[0];
#pragma unroll
        for (int e = 1; e < 8; ++e) if (lg[e] > v1) { v1 = lg[e]; e1 = e; }
        int e2 = (e1 + 1) & 7; float v2 = -3.0e38f;
#pragma unroll
        for (int e = 0; e < 8; ++e) if (e != e1 && lg[e] > v2) { v2 = lg[e]; e2 = e; }
        if (F.lane == 0) { const float w1 = 1.f / (1.f + __expf(v2 - v1)); tokE[2 * m] = e1; tokE[2 * m + 1] = e2; tokW[2 * m] = w1; tokW[2 * m + 1] = 1.f - w1;
            atomicAdd((int*)cntS + e1, 1); atomicAdd((int*)cntS + e2, 1); }
    }
    __syncthreads();
    if (F.tid < 8) ((int*)(F.ctl + CW_MOECNT))[F.bid * 8 + F.tid] = cntS[F.tid];
    __syncthreads();
}
__device__ __forceinline__ void moe_layout(const Frame& F) {
    LAS int* tab = (LAS int*)(F.lds + MOE_TAB); const int* cnt = (const int*)(F.ctl + CW_MOECNT);
    if (F.tid < 16) tab[F.tid < 8 ? F.tid : 32 + MOE_TILES + F.tid] = 0;
    __syncthreads();
    { const int e = F.tid & 7; int tot = 0, pre = 0;
      for (int wg = F.tid >> 3; wg < F.G; wg += NTHR / 8) { const int c = cnt[wg * 8 + e]; tot += c; if (wg < F.bid) pre += c; }
      atomicAdd((int*)tab + e, tot); atomicAdd((int*)tab + 32 + MOE_TILES + 8 + e, pre); }
    __syncthreads();
    if (F.tid == 0) { int row = 0, tl = 0; for (int e = 0; e < 8; ++e) { const int nt = (tab[e] + 255) >> 8; tab[8 + e] = row; tab[16 + e] = nt; for (int i = 0; i < nt; ++i) tab[32 + tl + i] = e; tl += nt; row += nt * 256; } tab[24] = tl; }
    __syncthreads();
}
__device__ __forceinline__ void phase_scatter(const Frame& F) {
    moe_layout(F);
    LAS int* tab = (LAS int*)(F.lds + MOE_TAB); LAS int* slotS = (LAS int*)F.lds;
    const int per = M / F.G;
    const int* tokE = (const int*)(F.ws + WS_MOEIDX); int* tokS = (int*)(F.ws + WS_MOEIDX + 2 * MiB);
    if (F.wave == 0) { const int E0 = tokE[(size_t)F.bid * per * 2 + F.lane], E1 = tokE[(size_t)F.bid * per * 2 + 64 + F.lane]; int s0 = 0, s1 = 0;
        const unsigned long long lt = (1ull << F.lane) - 1ull;
#pragma unroll
        for (int e = 0; e < 8; ++e) { const unsigned long long m0 = __ballot(E0 == e), m1 = __ballot(E1 == e); const int base = tab[8 + e] + tab[32 + MOE_TILES + 8 + e];
            if (E0 == e) s0 = base + __popcll(m0 & lt); if (E1 == e) s1 = base + __popcll(m0) + __popcll(m1 & lt); }
        slotS[F.lane] = s0; slotS[64 + F.lane] = s1; tokS[(size_t)F.bid * per * 2 + F.lane] = s0; tokS[(size_t)F.bid * per * 2 + 64 + F.lane] = s1; }
    __syncthreads();
    const bf16* XN = (const bf16*)(F.ws + WS_XN); unsigned char* XP = F.ws + WS_XP;
    for (int i = F.wave; i < per * 2; i += NWAVES) { const int m = F.bid * per + (i >> 1); const int sl = slotS[i];
        const GAS v4u* src = (const GAS v4u*)(XN + (size_t)m * D) + F.lane; GAS v2u* dst = (GAS v2u*)(XP + (size_t)sl * D) + F.lane;
        const v4u s0 = src[0], s1 = src[64]; v2u o0, o1;
        o0.x = pk4_fp8(bflo(s0.x), bfhi(s0.x), bflo(s0.y), bfhi(s0.y)); o0.y = pk4_fp8(bflo(s0.z), bfhi(s0.z), bflo(s0.w), bfhi(s0.w));
        o1.x = pk4_fp8(bflo(s1.x), bfhi(s1.x), bflo(s1.y), bfhi(s1.y)); o1.y = pk4_fp8(bflo(s1.z), bfhi(s1.z), bflo(s1.w), bfhi(s1.w));
        dst[0] = o0; dst[64] = o1; }
    __syncthreads();
}
struct MoeOrder {
    int nN, nwg, G, c; const LAS int* texp;
    __device__ __forceinline__ bool next(int i, pg8::Unit& u) const { const long L = (long)i * G + c; if (L >= nwg) return false; u.pm = (int)(L / nN); u.pn = (int)(L % nN); u.bn = texp[u.pm] * nN + u.pn; u.idx = i; return true; }
    __device__ __forceinline__ void a_ready(const pg8::Unit&) const {}
    __device__ __forceinline__ void done(const pg8::Unit&) const {}
};
struct MoeOrderX {
    int nM, nN, nwg, G, c; const LAS int* texp;
    __device__ __forceinline__ bool next(int i, pg8::Unit& u) const { const long L = (long)i * G + c; if (L >= nwg) return false;
        int wgid = (int)L; { const int q = nwg / 8, r = nwg % 8, xcd = wgid % 8, off = wgid / 8; wgid = (xcd < r ? xcd * (q + 1) : r * (q + 1) + (xcd - r) * q) + off; }
        const int nig = 8 * nN, gid = wgid / nig, fm = gid * 8, gsz = (nM - fm) < 8 ? (nM - fm) : 8;
        u.pm = fm + ((wgid % nig) % gsz); u.pn = (wgid % nig) / gsz; u.bn = texp[u.pm] * nN + u.pn; u.idx = i; return true; }
    __device__ __forceinline__ void a_ready(const pg8::Unit&) const {}
    __device__ __forceinline__ void done(const pg8::Unit&) const {}
};
struct MoeTail { int R, Lo, pm_min; bool split; };
__device__ __forceinline__ MoeTail moe_tail(const LAS int* tab, int G) { MoeTail t; const int U = tab[24] * 4; t.R = U / G; t.Lo = U - t.R * G; t.split = (t.Lo > 0 && t.Lo <= 128 && t.R > 0); t.pm_min = t.split ? (t.R * G) / 4 : (1 << 30); return t; }
struct MoeTailOrder { int pm, pn, bn; bool has;
    __device__ __forceinline__ bool next(int i, pg8::Unit& u) const { if (i > 0 || !has) return false; u.pm = pm; u.pn = pn; u.bn = bn; u.idx = 0; return true; }
    __device__ __forceinline__ void a_ready(const pg8::Unit&) const {}
    __device__ __forceinline__ void done(const pg8::Unit&) const {} };
constexpr size_t MOE_PART_STRIDE = (size_t)32 * 256 * 1024;
__device__ __forceinline__ void phase_moe_combine(const Frame& F, const float* x, float* xo) {
    moe_layout(F); const MoeTail mt = moe_tail((const LAS int*)(F.lds + MOE_TAB), F.G); const int srow = mt.pm_min == (1 << 30) ? (1 << 30) : mt.pm_min * 256; const float* PART = (const float*)(F.ws + WS_XP);
    const int gw = F.bid * NWAVES + F.wave, NGW = F.G * NWAVES;
    const float* tokW = (const float*)(F.ws + WS_MOEIDX + 1 * MiB); const int* tokS = (const int*)(F.ws + WS_MOEIDX + 2 * MiB); const int* tokE = (const int*)(F.ws + WS_MOEIDX);
    const float* YP = (const float*)(F.ws + WS_YP);
    for (int m = gw; m < M; m += NGW) { const int s0 = tokS[2 * m], s1 = tokS[2 * m + 1]; const float w0 = tokW[2 * m] * (1.f / MOE_W2_SCALE), w1 = tokW[2 * m + 1] * (1.f / MOE_W2_SCALE)  ; const bool sw = tokE[2 * m] > tokE[2 * m + 1];
        const GAS f32x4* xr = (const GAS f32x4*)(x + (size_t)m * D) + F.lane; GAS f32x4* xw = (GAS f32x4*)(xo + (size_t)m * D) + F.lane; const GAS f32x4* y0 = (const GAS f32x4*)(YP + (size_t)s0 * D) + F.lane; const GAS f32x4* y1 = (const GAS f32x4*)(YP + (size_t)s1 * D) + F.lane;
#pragma unroll
        for (int j = 0; j < 4; ++j) { f32x4 v0, v1;
            if (s0 >= srow) { const GAS f32x4* q = (const GAS f32x4*)(PART + (size_t)(s0 - srow) * D) + F.lane + 64 * j; v0 = q[0] + q[MOE_PART_STRIDE / 4]; } else v0 = y0[64 * j];
            if (s1 >= srow) { const GAS f32x4* q = (const GAS f32x4*)(PART + (size_t)(s1 - srow) * D) + F.lane + 64 * j; v1 = q[0] + q[MOE_PART_STRIDE / 4]; } else v1 = y1[64 * j];
            const f32x4 a0 = v0 * w0, a1 = v1 * w1; xw[64 * j] = xr[64 * j] + (sw ? (a1 + a0) : (a0 + a1)); } }
}
#ifndef MK_PHMASK
#define MK_PHMASK 0xFFFFFFFFFFFFull
#endif
#ifndef MK_DUPMASK
#define MK_DUPMASK 0ull
#endif
#ifndef MK_SPLIT
#define MK_SPLIT 0
#endif
#ifndef MK_LAST_PHASE
#define MK_LAST_PHASE 29
#endif
constexpr int N_PHASES = 30;
#ifndef MK_LB
#define MK_LB 2
#endif
__global__ void __launch_bounds__(NTHR, MK_LB) mega_fwd(Args args) {
    extern __shared__ __attribute__((aligned(16))) unsigned char lds_raw[];
    Frame F;
    F.lds = (LAS unsigned char*)lds_raw; F.MISC = (volatile LAS unsigned*)(F.lds + MISC_OFF);
    F.tid = threadIdx.x; F.lane = F.tid & 63; F.wave = __builtin_amdgcn_readfirstlane(F.tid >> 6); F.G = gridDim.x; F.bid = blockIdx.x;
    F.ws = args.ws; F.ctl = (gu32*)(args.ws + WS_CTL);
    for (int u = F.tid; u < (LDS_BYTES - MISC_OFF) / 4; u += NTHR) ((LAS unsigned*)(F.lds + MISC_OFF))[u] = 0u;
    __syncthreads();
    XcdBarrier bar; bar.bar = (unsigned*)(F.ctl + CW_BAR); bar.x = 0; bar.st = nullptr;
    if (!MK_SPLIT) bar = xcd_barrier_post((unsigned*)(F.ctl + CW_BAR), F.MISC + 8);
    const int lo = args.ph_lo, hi = args.ph_hi;
#define PF() Frame Fp = F; { int t_ = threadIdx.x; asm volatile("" : "+v"(t_)); Fp.tid = t_; Fp.lane = t_ & 63; int w_ = F.wave, b_ = F.bid; asm volatile("" : "+s"(w_), "+s"(b_)); Fp.wave = w_; Fp.bid = b_; }
#define IN(k) ((((unsigned long long)MK_PHMASK >> (k)) & 1ull) && lo <= (k) && (k) < hi)
#define DUP(k) ((((unsigned long long)MK_DUPMASK >> (k)) & 1ull) ? 2 : 1)
#define SEAM(k) do { if (!MK_SPLIT && IN((k) + 1)) xcd_barrier(bar); } while (0)
    unsigned char* ws = args.ws; float* out = args.out;
    const int gw = F.bid * NWAVES + F.wave, NGW = F.G * NWAVES;
    LAS unsigned char* glds = F.lds;
    bf16* XN = (bf16*)(ws + WS_XN);

    if (IN(0)) { PF();
#pragma unroll 1
        for (int rep = 0; rep < DUP(0); ++rep) p0_prologue(Fp, args);
        SEAM(0); }
    if (IN(1)) {
        PF();
#pragma unroll 1
        for (int rep = 0; rep < DUP(1); ++rep) {
        if (F.bid == 0) { float* part = (float*)(ws + WS_CMPB_PART); float s = 0.f; for (int ic = 0; ic < 64; ++ic) s += part[(size_t)((Fp.tid >> 8) * 64 + ic) * 256 + (Fp.tid & 255)]; ((float*)(ws + WS_CMPB))[Fp.tid] = s; }
        { pg8::Gemm g{XN, (const bf16*)(ws + WS_W_EVIN), M, EV_INP, D, D, D}; pg8::StaticOrder S; S.init(M, EV_INP, F.G, F.bid);
          pg8::EpiEvIn E{(bf16*)(ws + WS_Y0), EV_INP, (bf16*)(ws + WS_KV6), SEQ};
          pg8::gemm_phase<pg8::EpiEvIn, pg8::StaticOrder, PG8_ALIGN, PG8_SP2>(glds, g, S, E); }
#pragma unroll 1
        for (int l = 0; l < 2; ++l) { pg8::Gemm g{(const bf16*)(ws + WS_MEMN) + (size_t)l * MMEM * D, (const bf16*)(ws + WS_W_XKV) + (size_t)l * 1024 * D, MMEM, 1024, D, D, D};
          pg8::ListOrder S; S.init(2, 4, 8, F.bid - 192 - 8 * l);
          pg8::EpiBf16<0> E{(bf16*)(ws + WS_KVM) + (size_t)l * MMEM * 1024, 1024, nullptr, nullptr};
          pg8::gemm_phase<pg8::EpiBf16<0>, pg8::ListOrder, PG8_ALIGN, PG8_SP2>(glds, g, S, E); }
        }
        SEAM(1);
    }
    if (IN(2)) {
        PF();
#pragma unroll 1
        for (int rep = 0; rep < DUP(2); ++rep) {
        if (F.bid < 128) { rglru_unit(Fp, args, F.bid >> 6, (F.bid >> 3) & 7, F.bid & 7);
        }
        else if (F.bid < 144) { const int mm = (F.bid - 128) >> 3;
            pg8::Gemm g{(const bf16*)(ws + WS_KV6) + (size_t)mm * 4 * SEQ * 128, (const bf16*)(ws + (mm ? WS_W_CV1 : WS_W_CK1)), 2048, 256, 4096, 2048, 4096};
            pg8::ListOrder S; S.init(8, 1, 8, (F.bid - 128) & 7);
            pg8::EpiBf16<1> E{(bf16*)(ws + WS_HID) + (size_t)mm * 2048 * 256, 256, (const float*)(ws + WS_CMPB) + mm * 256, nullptr};
            pg8::gemm_phase<pg8::EpiBf16<1>, pg8::ListOrder, PG8_ALIGN, PG8_SP2>(glds, g, S, E);
#ifdef MK_DUP_CMP1
            pg8::gemm_phase<pg8::EpiBf16<1>, pg8::ListOrder, PG8_ALIGN, PG8_SP2>(glds, g, S, E);
#endif
            VM_WAIT(); __syncthreads(); { const int u0 = mm * 64 + ((F.bid - 128) & 7) * 8; phase_cmp2(Fp, args, u0, u0 + 8, 1); }
        }
        else if (rep == 0) { const int gw2 = (F.bid - 144) * NWAVES + F.wave, NGW2 = (F.G - 144) * NWAVES;
            bf16* ks = (bf16*)(ws + WS_KV6) + (size_t)2 * 4 * SEQ * 128; bf16* kw = (bf16*)(ws + WS_KV6) + (size_t)4 * 4 * SEQ * 128;
            norm128_rows(Fp, ks, 128, ks, 128, 4 * SEQ, args.in[I_KNORM] + 128, gw2, NGW2);
            norm128_rows(Fp, kw, 128, kw, 128, 4 * SEQ, args.in[I_KNORM] + 256, gw2, NGW2);
            phase_memk_norm(Fp, args, 0, gw2, NGW2); phase_memk_norm(Fp, args, 1, gw2, NGW2); convert_range(Fp, args, gw2, NGW2, CONV_A, CONV_P2_END);
#ifdef MK_DUP_P2CONV
            convert_range(Fp, args, gw2, NGW2, CONV_A + (CONV_P2_END - CONV_A) / 2, CONV_P2_END);
#endif
        }
        }
        SEAM(2);
    }
    if (IN(4)) { PF();
#pragma unroll 1
        for (int rep = 0; rep < DUP(4); ++rep) phase_nsa(Fp, args);
        SEAM(4); }
    if (IN(5)) {
        pg8::Gemm g{(const bf16*)(ws + WS_MIX), (const bf16*)(ws + WS_W_EVOUT), M, D, 2048, 2048, 2048}; pg8::StaticOrder S; S.init(M, D, F.G, F.bid);
#pragma unroll 1
        for (int rep = 0; rep < DUP(5); ++rep) { pg8::EpiResidN E{args.in[I_X], (rep + 1 < DUP(5)) ? (float*)(ws + WS_R + 400 * MiB) : out, D, XN, (float*)(ws + WS_SSQ)};
        pg8::gemm_phase<pg8::EpiResidN, pg8::StaticOrder, PG8_ALIGN, PG8_SP2>(glds, g, S, E); }
        SEAM(5);
#ifdef MK_PROBE_BARS
#pragma unroll 1
        for (int xb = 0; xb < MK_PROBE_BARS; ++xb) xcd_barrier(bar);
#endif
    }
#pragma unroll 1
    for (int l = 0; l < 2; ++l) {
        const int pb = l == 0 ? 6 : 21;
        if (IN(pb + 1)) { pg8::Gemm g{XN, (const bf16*)(ws + WS_W_XQ) + (size_t)l * 512 * D, M, 512, D, D, D}; pg8::StaticOrder S; S.init(M, 512, F.G, F.bid);
            pg8::fill_rstd_table((LAS float*)(F.lds + MOE_TAB), S, (const float*)(ws + WS_SSQ), F.tid);
            pg8::EpiBf16<0> E{(bf16*)(ws + WS_QX), 512, nullptr, (const LAS float*)(F.lds + MOE_TAB)};
#pragma unroll 1
            for (int rep = 0; rep < DUP(7); ++rep) pg8::gemm_phase<pg8::EpiBf16<0>, pg8::StaticOrder, PG8_ALIGN, PG8_SP2>(glds, g, S, E);
            if (F.bid >= 128) { PF(); const int lo_ = CONV_ALL - (2 - l) * CONV_Q;
                convert_range(Fp, args, (F.bid - 128) * NWAVES + F.wave, (F.G - 128) * NWAVES, lo_, lo_ + CONV_Q); }
            SEAM(pb + 1); }
        if (IN(pb + 2)) { PF();
#pragma unroll 1
            for (int rep = 0; rep < DUP(8); ++rep) phase_cross_attn(Fp, args, l);
            SEAM(pb + 2); }
        if (IN(pb + 3)) { pg8::Gemm g{(const bf16*)(ws + WS_OX), (const bf16*)(ws + WS_W_XO) + (size_t)l * D * 512, M, D, 512, 512, 512}; pg8::StaticOrder S; S.init(M, D, F.G, F.bid);
#pragma unroll 1
            for (int rep = 0; rep < DUP(9); ++rep) { pg8::EpiResidN E{out, (rep + 1 < DUP(9)) ? (float*)(ws + WS_R + 400 * MiB) : out, D, l == 0 ? XN : (bf16*)nullptr, (float*)(ws + WS_SSQ)};
            pg8::gemm_phase<pg8::EpiResidN, pg8::StaticOrder, PG8_ALIGN, PG8_SP2>(glds, g, S, E); }
            SEAM(pb + 3); }
        if (l == 0) {
            if (IN(11)) { pg8::Gemm g{XN, (const bf16*)(ws + WS_W_FF13), M, 2 * FF, D, D, D}; pg8::StaticOrder S; S.init(M, 2 * FF, F.G, F.bid);
                pg8::fill_rstd_table((LAS float*)(F.lds + MOE_TAB), S, (const float*)(ws + WS_SSQ), F.tid);
                pg8::EpiSwiglu<false> E{(bf16*)(ws + WS_H), FF, (const LAS float*)(F.lds + MOE_TAB)};
#ifdef MK_PROBE_NULLEPI
                { pg8::EpiNull EN; pg8::gemm_phase<pg8::EpiNull, pg8::StaticOrder, PG8_ALIGN, PG8_SP2>(glds, g, S, EN); }
#endif
#pragma unroll 1
                for (int rep = 0; rep < DUP(11); ++rep) pg8::gemm_phase<pg8::EpiSwiglu<false>, pg8::StaticOrder, PG8_ALIGN, PG8_SP2>(glds, g, S, E);
                SEAM(11); }
            if (IN(12)) { pg8::Gemm g{(const bf16*)(ws + WS_H), (const bf16*)(ws + WS_W_FF2), M, D, FF, FF, FF}; pg8::StaticOrder S; S.init(M, D, F.G, F.bid);
#pragma unroll 1
                for (int rep = 0; rep < DUP(12); ++rep) { pg8::EpiResidN E{out, (rep + 1 < DUP(12)) ? (float*)(ws + WS_R + 400 * MiB) : out, D, XN, (float*)(ws + WS_SSQ)};
                pg8::gemm_phase<pg8::EpiResidN, pg8::StaticOrder, PG8_ALIGN, PG8_SP2>(glds, g, S, E); }
                SEAM(12); }
            if (IN(14)) { pg8::Gemm g{XN, (const bf16*)(ws + WS_W_ODIN), M, OD_INP, D, D, D}; pg8::StaticOrder S; S.init(M, OD_INP, F.G, F.bid);
                pg8::fill_rstd_table((LAS float*)(F.lds + MOE_TAB), S, (const float*)(ws + WS_SSQ), F.tid);
                pg8::EpiBf16<0> E{(bf16*)(ws + WS_Y1), OD_INP, nullptr, (const LAS float*)(F.lds + MOE_TAB)};
#pragma unroll 1
                for (int rep = 0; rep < DUP(14); ++rep) pg8::gemm_phase<pg8::EpiBf16<0>, pg8::StaticOrder, PG8_ALIGN, PG8_SP2>(glds, g, S, E);
                SEAM(14); }
            if (IN(15)) { PF();
#pragma unroll 1
                for (int rep = 0; rep < DUP(15); ++rep) phase_mamba_prep(Fp, args);
                SEAM(15); }
            if (IN(16)) { PF();
#pragma unroll 1
                for (int rep = 0; rep < DUP(16); ++rep) phase_mamba_states(Fp);
                SEAM(16); }
            if (IN(17)) { PF();
#pragma unroll 1
                for (int rep = 0; rep < DUP(17); ++rep) phase_mamba_scan(Fp);
                SEAM(17); }
            if (IN(18)) { PF();
#pragma unroll 1
                for (int rep = 0; rep < DUP(18); ++rep) phase_mamba_out(Fp, args);
                SEAM(18); }
            if (IN(20)) { pg8::Gemm g{(const bf16*)(ws + WS_YG), (const bf16*)(ws + WS_W_ODOUT), M, D, 2048, 2048, 2048}; pg8::StaticOrder S; S.init(M, D, F.G, F.bid);
#pragma unroll 1
                for (int rep = 0; rep < DUP(20); ++rep) { pg8::EpiResidN E{out, (rep + 1 < DUP(20)) ? (float*)(ws + WS_R + 400 * MiB) : out, D, XN, (float*)(ws + WS_SSQ)};
                pg8::gemm_phase<pg8::EpiResidN, pg8::StaticOrder, PG8_ALIGN, PG8_SP2>(glds, g, S, E); }
                SEAM(20); }
        }
    }
    if (IN(25)) { PF();
#pragma unroll 1
        for (int rep = 0; rep < DUP(25); ++rep) phase_route(Fp, args, out);
        SEAM(25); }
    if (IN(26)) { PF();
#pragma unroll 1
        for (int rep = 0; rep < DUP(26); ++rep) phase_scatter(Fp);
        SEAM(26); }
    if (IN(27)) { PF(); moe_layout(Fp); const LAS int* tab = (const LAS int*)(F.lds + MOE_TAB);
        pg8::Gemm g{(const bf16*)(ws + WS_XP), (const bf16*)(ws + WS_W_M13), MOE_ROWS, 2 * FFE, D / 2, D / 2, D / 2}  ; MoeOrderX S{tab[24], 2 * FFE / 256, tab[24] * (2 * FFE / 256), F.G, F.bid, tab + 32};
        pg8::EpiSwiglu<true, false, true> E{(bf16*)(ws + WS_HP), FFE, nullptr, 1.f / MOE_W13_SCALE};
#pragma unroll 1
        for (int rep = 0; rep < DUP(27); ++rep) pg8::gemm_phase<pg8::EpiSwiglu<true, false, true>, MoeOrderX, PG8_ALIGN, PG8_SP2, true>(glds, g, S, E);
        SEAM(27); }
    if (IN(28)) { PF(); moe_layout(Fp); const LAS int* tab = (const LAS int*)(F.lds + MOE_TAB);
        const MoeTail mt = moe_tail(tab, F.G);
        pg8::Gemm g{(const bf16*)(ws + WS_HP), (const bf16*)(ws + WS_W_M2), MOE_ROWS, D, FFE / 2, FFE / 2, FFE / 2}  ; MoeOrder S{D / 256, mt.split ? mt.R * F.G : tab[24] * (D / 256), F.G, F.bid, tab + 32};
        pg8::EpiF32 E{(float*)(ws + WS_YP), D};
#pragma unroll 1
        for (int rep = 0; rep < DUP(28); ++rep) pg8::gemm_phase<pg8::EpiF32, MoeOrder, PG8_ALIGN, PG8_SP2, true>(glds, g, S, E);
        if (mt.split) {
            const int piece = F.bid, L = mt.R * F.G + (piece >> 1), kq = piece & 1, pm = L / 4, pn = L % 4;
            MoeTailOrder S2{pm, pn, piece < mt.Lo * 2 ? tab[32 + pm] * 4 + pn : 0, piece < mt.Lo * 2};
            pg8::Gemm g2{(const bf16*)(ws + WS_HP) + kq * (FFE / 4), (const bf16*)(ws + WS_W_M2) + kq * (FFE / 4), MOE_ROWS, D, FFE / 4, FFE / 2, FFE / 2};
            pg8::EpiF32 E2{(float*)(ws + WS_XP) + (size_t)kq * MOE_PART_STRIDE - (size_t)mt.pm_min * 256 * D, D};
            pg8::gemm_phase<pg8::EpiF32, MoeTailOrder, PG8_ALIGN, PG8_SP2, true>(glds, g2, S2, E2); }
        SEAM(28); }
    if (IN(29)) { PF();
#pragma unroll 1
        for (int rep = 0; rep < DUP(29); ++rep) phase_moe_combine(Fp, out, (rep + 1 < DUP(29)) ? (float*)(ws + WS_H) : out); }
#undef IN
#undef SEAM
}

extern "C" void kernel_launch(void* const* d_in, const int* in_sizes, int n_in, void* d_out, int out_size, void* d_ws, size_t ws_size, hipStream_t stream) {
    static int grid = 0;
    if (grid == 0) {
        if (n_in != N_IN || in_sizes[0] != M * D || out_size != M * D || ws_size < (WS_M_END > WS_END ? WS_M_END : WS_END)) { fprintf(stderr, "kernel_launch: unexpected problem (n_in %d, in0 %d, out %d, ws %zu < %zu); nothing launched\n", n_in, n_in > 0 ? in_sizes[0] : -1, out_size, ws_size, (size_t)WS_END); grid = -1; return; }
        int dev = 0, cus = 0, per_cu = 0;
        if (hipGetDevice(&dev) != hipSuccess || hipDeviceGetAttribute(&cus, hipDeviceAttributeMultiprocessorCount, dev) != hipSuccess) { fprintf(stderr, "kernel_launch: device query failed\n"); grid = -1; return; }
        if (hipFuncSetAttribute((const void*)mega_fwd, hipFuncAttributeMaxDynamicSharedMemorySize, LDS_BYTES) != hipSuccess) { fprintf(stderr, "kernel_launch: hipFuncSetAttribute(%d B LDS) failed\n", LDS_BYTES); grid = -1; return; }
        if (hipOccupancyMaxActiveBlocksPerMultiprocessor(&per_cu, (const void*)mega_fwd, NTHR, LDS_BYTES) != hipSuccess || per_cu < 1) fprintf(stderr, "kernel_launch: note: occupancy query reports %d workgroups per CU\n", per_cu);
        (void)hipGetLastError();
        if (cus < 256) { fprintf(stderr, "kernel_launch: %d CUs < 256: the persistent grid of 256 workgroups would not be resident; nothing launched\n", cus); grid = -1; return; }
        grid = 256;
    }
    if (grid < 0) return;
    if (hipMemsetAsync((char*)d_ws + WS_CTL, 0, CTL_ZERO_BYTES, stream) != hipSuccess) { fprintf(stderr, "kernel_launch: memset failed\n"); return; }
    Args a{};
    for (int i = 0; i < N_IN; ++i) a.in[i] = (const float*)d_in[i];
    a.out = (float*)d_out; a.ws = (unsigned char*)d_ws;
#if MK_SPLIT
    for (int p = 0; p <= MK_LAST_PHASE && p < N_PHASES; ++p) { a.ph_lo = p; a.ph_hi = p + 1; a.li = p; hipLaunchKernelGGL(mega_fwd, dim3(grid), dim3(NTHR), LDS_BYTES, stream, a); }
#else
    a.ph_lo = 0; a.ph_hi = MK_LAST_PHASE + 1; a.li = 0;
    hipLaunchKernelGGL(mega_fwd, dim3(grid), dim3(NTHR), LDS_BYTES, stream, a);
#endif
    const hipError_t le = hipPeekAtLastError();
    if (le != hipSuccess) fprintf(stderr, "kernel_launch: launch failed: %s\n", hipGetErrorName(le));
}
```

```cpp
#include <hip/hip_runtime.h>
#include <cstdio>
#include <cstdint>

namespace pg8 {
#define PG8_LAS __attribute__((address_space(3)))
typedef unsigned short bf16_t;
typedef short bf16x8 __attribute__((ext_vector_type(8)));
typedef float f32x4 __attribute__((ext_vector_type(4)));
typedef unsigned u32x4 __attribute__((ext_vector_type(4)));
typedef unsigned u32x2 __attribute__((ext_vector_type(2)));
constexpr int BM = 256, BK = 64, HALF = 128, HTB = HALF * BK * 2  , STAGE_BYTES = 8 * HTB, NXCD = 8, WGM = 8;

__host__ __device__ __forceinline__ int lds_byte(int r, int c) { const int st = (r >> 4) * 2 + (c >> 5), rr = r & 15, cc = c & 31, ob = rr * 64 + cc * 2; return st * 1024 + (ob ^ (((ob >> 9) & 1) << 5)); }
__host__ __device__ __forceinline__ void stage_rc(int b, int& R, int& C) { const int st = b / 1024, sb = b % 1024, swz = sb ^ (((sb >> 9) & 1) << 5); R = (st >> 1) * 16 + swz / 64; C = (st & 1) * 32 + (swz % 64) / 2; }
__host__ __device__ __forceinline__ int perm32(int rho) { const int n = rho >> 4, i = rho & 15; return 8 * (i >> 2) + 4 * n + (i & 3); }

typedef int i32x8 __attribute__((ext_vector_type(8)));
typedef int i32x4 __attribute__((ext_vector_type(4)));
__device__ __forceinline__ i32x8 cat8(bf16x8 lo, bf16x8 hi) { const i32x4 a = __builtin_bit_cast(i32x4, lo), b = __builtin_bit_cast(i32x4, hi); return __builtin_shufflevector(a, b, 0, 1, 2, 3, 4, 5, 6, 7); }
__device__ __forceinline__ void mfma_f8_inplace(f32x4& acc, i32x8 a, i32x8 b) { asm volatile("v_mfma_f32_16x16x128_f8f6f4 %0, %1, %2, %0" : "+v"(acc) : "v"(a), "v"(b)); }
struct Unit { int pm, pn, bn, idx; };
struct Gemm { const bf16_t* A; const bf16_t* Bt; int M, N, K, lda, ldb; };

struct StaticOrder {
    int nM, nN, nwg, G, c;
    __host__ __device__ void init(int M, int N, int G_, int c_) { nM = M / BM; nN = N / BM; nwg = nM * nN; G = G_; c = c_; }
    __host__ __device__ bool next(int i, Unit& u) const {
        const long L = (long)i * G + c; if (L >= nwg) return false;
        int wgid = (int)L; { const int q = nwg / NXCD, r = nwg % NXCD, xcd = wgid % NXCD, off = wgid / NXCD; wgid = (xcd < r ? xcd * (q + 1) : r * (q + 1) + (xcd - r) * q) + off; }
        const int nig = WGM * nN, gid = wgid / nig, fm = gid * WGM, gsz = (nM - fm) < WGM ? (nM - fm) : WGM;
        u.pm = fm + ((wgid % nig) % gsz); u.pn = (wgid % nig) / gsz; u.bn = u.pn; u.idx = i; return true;
    }
    __device__ __forceinline__ void a_ready(const Unit&) const {}
    __device__ __forceinline__ void done(const Unit&) const {}
};
struct ListOrder {
    int nN, nwg, G, c;
    __host__ __device__ void init(int nM_, int nN_, int G_, int c_) { nN = nN_; nwg = nM_ * nN_; G = G_; c = c_; }
    __host__ __device__ bool next(int i, Unit& u) const { const long L = (long)i * G + c; if (c < 0 || L >= nwg) return false; u.pm = (int)(L / nN); u.pn = (int)(L % nN); u.bn = u.pn; u.idx = i; return true; }
    __device__ __forceinline__ void a_ready(const Unit&) const {}
    __device__ __forceinline__ void done(const Unit&) const {}
};

__device__ __forceinline__ unsigned cvt_pk_bf16(float lo, float hi) { unsigned r; asm volatile("v_cvt_pk_bf16_f32 %0, %1, %2" : "=v"(r) : "v"(lo), "v"(hi)); return r; }
__device__ __forceinline__ unsigned cvt4_fp8(float a, float b, float c, float d) { int r = __builtin_amdgcn_cvt_pk_fp8_f32(a, b, 0, false); r = __builtin_amdgcn_cvt_pk_fp8_f32(c, d, r, true); return (unsigned)r; }
__device__ __forceinline__ float fsigmoid(float x) { return __builtin_amdgcn_rcpf(1.0f + __expf(-x)); }
__device__ __forceinline__ float gelu_tanh(float x) { const float u = 1.5957691216f * (x + 0.044715f * x * x * x); return x * fsigmoid(u); }
__device__ __forceinline__ float fsilu(float x) { return x * fsigmoid(x); }

__device__ __forceinline__ float row_rstd(const float* ssq, int row) {
    const f32x4 a = *(const f32x4*)(ssq + (size_t)row * 16), b = *(const f32x4*)(ssq + (size_t)row * 16 + 4), c = *(const f32x4*)(ssq + (size_t)row * 16 + 8), d = *(const f32x4*)(ssq + (size_t)row * 16 + 12);
    const f32x4 s = (a + b) + (c + d); return 1.0f / sqrtf(((s[0] + s[1]) + (s[2] + s[3])) * (1.0f / 1024.0f) + 1e-6f);
}
template <class Sched> __device__ __forceinline__ void fill_rstd_table(PG8_LAS float* tab, const Sched& S, const float* ssq, int tid) {
    Unit u; for (int i = 0; S.next(i, u); ++i) if (tid < 256) { const int ai = tid >> 7, wr = (tid >> 6) & 1, m = (tid >> 4) & 3, fr = tid & 15; tab[i * 256 + ((ai * 2 + wr) * 16 + fr) * 4 + m] = row_rstd(ssq, u.pm * BM + tid); }
    __syncthreads();
}
template <int ACT, bool SPLIT_ = false> struct EpiBf16 {
    static constexpr bool PERM = true, AFTER_DRAIN = false, SPLIT = SPLIT_, PACK = false; static constexpr int NST = 16; struct Pk {};
    bf16_t* O; int ldc; const float* bias; const PG8_LAS float* rsT;
    __device__ __forceinline__ void operator()(const f32x4 (&acc)[2][2][4][2], const Unit& u, int wr, int wc, int fr, int fq) const { half<0>(acc, u, wr, wc, fr, fq); half<1>(acc, u, wr, wc, fr, fq); }
    template <int AI> __device__ __forceinline__ void half(const f32x4 (&acc)[2][2][4][2], const Unit& u, int wr, int wc, int fr, int fq) const {
        const int row0 = u.pm * BM + wr * 64 + fr; const int col0 = u.pn * BM + wc * 32 + 8 * fq;
        f32x4 bv[2][2];
#pragma unroll
        for (int bj = 0; bj < 2; ++bj)
#pragma unroll
            for (int n = 0; n < 2; ++n) bv[bj][n] = bias ? *(const f32x4*)(bias + col0 + bj * HALF + 4 * n) : (f32x4){0.f, 0.f, 0.f, 0.f};
        { constexpr int ai = AI; const f32x4 rs4 = rsT ? *(const PG8_LAS f32x4*)(rsT + u.idx * 256 + ((ai * 2 + wr) * 16 + fr) * 4) : (f32x4){1.f, 1.f, 1.f, 1.f};
#pragma unroll
            for (int m = 0; m < 4; ++m) { bf16_t* rowp = O + (size_t)(row0 + ai * HALF + m * 16) * ldc + col0; const float rs = rs4[m];
#pragma unroll
                for (int bj = 0; bj < 2; ++bj) { f32x4 v0 = acc[ai][bj][m][0] * rs + bv[bj][0], v1 = acc[ai][bj][m][1] * rs + bv[bj][1];
                    if (ACT == 1) {
#pragma unroll
                        for (int j = 0; j < 4; ++j) { v0[j] = gelu_tanh(v0[j]); v1[j] = gelu_tanh(v1[j]); } }
                    u32x4 w; w.x = cvt_pk_bf16(v0[0], v0[1]); w.y = cvt_pk_bf16(v0[2], v0[3]); w.z = cvt_pk_bf16(v1[0], v1[1]); w.w = cvt_pk_bf16(v1[2], v1[3]);
                    *(u32x4*)(rowp + bj * HALF) = w; } } }
    }
};
struct EpiEvIn {
    static constexpr bool PERM = true, AFTER_DRAIN = false, SPLIT = true, PACK = false; static constexpr int NST = 16; struct Pk {};
    bf16_t* O; int ldc; bf16_t* KV6; int S;
    __device__ __forceinline__ void operator()(const f32x4 (&acc)[2][2][4][2], const Unit& u, int wr, int wc, int fr, int fq) const { half<0>(acc, u, wr, wc, fr, fq); half<1>(acc, u, wr, wc, fr, fq); }
    template <int AI> __device__ __forceinline__ void half(const f32x4 (&acc)[2][2][4][2], const Unit& u, int wr, int wc, int fr, int fq) const {
        const int row0 = u.pm * BM + wr * 64 + fr; const int col0 = u.pn * BM + wc * 32 + 8 * fq;
        const bool kv = (u.pn >= 12 && u.pn < 18);
        { constexpr int ai = AI;
#pragma unroll
            for (int m = 0; m < 4; ++m) { const int row = row0 + ai * HALF + m * 16;
#pragma unroll
                for (int bj = 0; bj < 2; ++bj) { const f32x4 v0 = acc[ai][bj][m][0], v1 = acc[ai][bj][m][1];
                    u32x4 w; w.x = cvt_pk_bf16(v0[0], v0[1]); w.y = cvt_pk_bf16(v0[2], v0[3]); w.z = cvt_pk_bf16(v1[0], v1[1]); w.w = cvt_pk_bf16(v1[2], v1[3]);
                    if (kv) { const int b = row / S, t = row - b * S;
                        bf16_t* p = KV6 + ((((size_t)(u.pn - 12) * 2 + b) * 2 + bj) * S + t) * 128 + wc * 32 + 8 * fq; *(u32x4*)p = w; }
                    else *(u32x4*)(O + (size_t)row * ldc + col0 + bj * HALF) = w; } } }
    }
};
struct EpiResid {
    static constexpr bool PERM = false, AFTER_DRAIN = false, SPLIT = false, PACK = false; static constexpr int NST = 0; struct Pk {};
    const float* base; float* out; int ldc;
    __device__ __forceinline__ void operator()(const f32x4 (&acc)[2][2][4][2], const Unit& u, int wr, int wc, int fr, int fq) const {
        const int row0 = u.pm * BM + wr * 64 + fr, col0 = u.pn * BM + wc * 32 + 4 * fq;
#pragma unroll
        for (int ai = 0; ai < 2; ++ai)
#pragma unroll
            for (int m = 0; m < 4; ++m) { const size_t off = (size_t)(row0 + ai * HALF + m * 16) * ldc + col0;
#pragma unroll
                for (int bj = 0; bj < 2; ++bj)
#pragma unroll
                    for (int n = 0; n < 2; ++n) { const f32x4 b = *(const f32x4*)(base + off + bj * HALF + n * 16); *(f32x4*)(out + off + bj * HALF + n * 16) = b + acc[ai][bj][m][n]; } }
    }
};
struct EpiResidN {
    static constexpr bool PERM = false, AFTER_DRAIN = false, SPLIT = false, PACK = false; static constexpr int NST = 0; struct Pk {};
    const float* base; float* out; int ldc; bf16_t* XB; float* SSQ;
    __device__ __forceinline__ void operator()(const f32x4 (&acc)[2][2][4][2], const Unit& u, int wr, int wc, int fr, int fq) const {
        const int row0 = u.pm * BM + wr * 64 + fr, col0 = u.pn * BM + wc * 32 + 4 * fq;
#pragma unroll
        for (int ai = 0; ai < 2; ++ai)
#pragma unroll
            for (int m = 0; m < 4; ++m) { const int row = row0 + ai * HALF + m * 16; const size_t off = (size_t)row * ldc + col0; float ss = 0.f;
#pragma unroll
                for (int bj = 0; bj < 2; ++bj)
#pragma unroll
                    for (int n = 0; n < 2; ++n) { const f32x4 b = *(const f32x4*)(base + off + bj * HALF + n * 16); const f32x4 v = b + acc[ai][bj][m][n]; *(f32x4*)(out + off + bj * HALF + n * 16) = v;
                        if (XB) { u32x2 w; w.x = cvt_pk_bf16(v[0], v[1]); w.y = cvt_pk_bf16(v[2], v[3]); *(u32x2*)(XB + off + bj * HALF + n * 16) = w; }
                        ss += (v[0] * v[0] + v[1] * v[1]) + (v[2] * v[2] + v[3] * v[3]); }
                ss += __shfl_xor(ss, 16); ss += __shfl_xor(ss, 32);
                if (XB && fq == 0) SSQ[(size_t)row * 16 + u.pn * 4 + wc] = ss; }
    }
};
struct EpiNull {
    static constexpr bool PERM = false, AFTER_DRAIN = false, SPLIT = false, PACK = false; static constexpr int NST = 0; struct Pk {};
    __device__ __forceinline__ void operator()(const f32x4 (&acc)[2][2][4][2], const Unit&, int, int, int, int) const {
#pragma unroll
        for (int ai = 0; ai < 2; ++ai)
#pragma unroll
            for (int bj = 0; bj < 2; ++bj)
#pragma unroll
                for (int m = 0; m < 4; ++m)
#pragma unroll
                    for (int n = 0; n < 2; ++n) asm volatile("" :: "v"(acc[ai][bj][m][n]));
    }
};
struct EpiF32 {
    static constexpr bool PERM = false, AFTER_DRAIN = false, SPLIT = false, PACK = false; static constexpr int NST = 0; struct Pk {};
    float* C; int ldc;
    __device__ __forceinline__ void operator()(const f32x4 (&acc)[2][2][4][2], const Unit& u, int wr, int wc, int fr, int fq) const {
        const int row0 = u.pm * BM + wr * 64 + fr, col0 = u.pn * BM + wc * 32 + 4 * fq;
#pragma unroll
        for (int ai = 0; ai < 2; ++ai)
#pragma unroll
            for (int m = 0; m < 4; ++m) { float* rowp = C + (size_t)(row0 + ai * HALF + m * 16) * ldc + col0;
#pragma unroll
                for (int bj = 0; bj < 2; ++bj)
#pragma unroll
                    for (int n = 0; n < 2; ++n) *(f32x4*)(rowp + bj * HALF + n * 16) = acc[ai][bj][m][n]; }
    }
};
template <bool SPLIT_, bool PACK_ = false, bool F8O_ = false> struct EpiSwiglu {
    static_assert(!(PACK_ && F8O_), "no packed fp8 form");
    static constexpr bool PERM = true, AFTER_DRAIN = false, SPLIT = SPLIT_, PACK = PACK_; static constexpr int NST = 8;
    bf16_t* H; int ldh; const PG8_LAS float* rsT; float sc = 1.f;
    __device__ __forceinline__ void operator()(const f32x4 (&acc)[2][2][4][2], const Unit& u, int wr, int wc, int fr, int fq) const { half<0>(acc, u, wr, wc, fr, fq); half<1>(acc, u, wr, wc, fr, fq); }
    struct Pk { u32x4 w[4]; };
    __device__ __forceinline__ void pack1(const f32x4 (&acc)[2][2][4][2], const Unit& u, int wr, int fr, Pk& pk) const {
        constexpr int ai = 1; const f32x4 rs4 = rsT ? *(const PG8_LAS f32x4*)(rsT + u.idx * 256 + ((ai * 2 + wr) * 16 + fr) * 4) : (f32x4){1.f, 1.f, 1.f, 1.f};
#pragma unroll
        for (int m = 0; m < 4; ++m) { const float rs = rs4[m] * sc;
            const f32x4 u0 = acc[ai][0][m][0] * rs, u1 = acc[ai][0][m][1] * rs, g0 = acc[ai][1][m][0] * rs, g1 = acc[ai][1][m][1] * rs;
            pk.w[m].x = cvt_pk_bf16(fsilu(g0[0]) * u0[0], fsilu(g0[1]) * u0[1]); pk.w[m].y = cvt_pk_bf16(fsilu(g0[2]) * u0[2], fsilu(g0[3]) * u0[3]);
            pk.w[m].z = cvt_pk_bf16(fsilu(g1[0]) * u1[0], fsilu(g1[1]) * u1[1]); pk.w[m].w = cvt_pk_bf16(fsilu(g1[2]) * u1[2], fsilu(g1[3]) * u1[3]); }
    }
    __device__ __forceinline__ void store1(const Pk& pk, const Unit& u, int wr, int wc, int fr, int fq) const {
        bf16_t* p = H + (size_t)(u.pm * BM + wr * 64 + fr + HALF) * ldh + u.pn * 128 + wc * 32 + 8 * fq;
#pragma unroll
        for (int m = 0; m < 4; ++m) *(u32x4*)(p + (size_t)(m * 16) * ldh) = pk.w[m];
    }
    template <int AI> __device__ __forceinline__ void half(const f32x4 (&acc)[2][2][4][2], const Unit& u, int wr, int wc, int fr, int fq) const {
        const int row0 = u.pm * BM + wr * 64 + fr, col0 = u.pn * 128 + wc * 32 + 8 * fq;
        constexpr int ai = AI; const f32x4 rs4 = rsT ? *(const PG8_LAS f32x4*)(rsT + u.idx * 256 + ((ai * 2 + wr) * 16 + fr) * 4) : (f32x4){1.f, 1.f, 1.f, 1.f};
#pragma unroll
        for (int m = 0; m < 4; ++m) { bf16_t* rowp = H + (size_t)(row0 + ai * HALF + m * 16) * ldh + col0; const float rs = rs4[m] * sc;
            const f32x4 u0 = acc[ai][0][m][0] * rs, u1 = acc[ai][0][m][1] * rs, g0 = acc[ai][1][m][0] * rs, g1 = acc[ai][1][m][1] * rs;
            if constexpr (F8O_) { u32x2 w; w.x = cvt4_fp8(fsilu(g0[0]) * u0[0], fsilu(g0[1]) * u0[1], fsilu(g0[2]) * u0[2], fsilu(g0[3]) * u0[3]);
                w.y = cvt4_fp8(fsilu(g1[0]) * u1[0], fsilu(g1[1]) * u1[1], fsilu(g1[2]) * u1[2], fsilu(g1[3]) * u1[3]);
                *(u32x2*)((unsigned char*)H + (size_t)(row0 + ai * HALF + m * 16) * ldh + col0) = w; }
            else { u32x4 w; w.x = cvt_pk_bf16(fsilu(g0[0]) * u0[0], fsilu(g0[1]) * u0[1]); w.y = cvt_pk_bf16(fsilu(g0[2]) * u0[2], fsilu(g0[3]) * u0[3]);
            w.z = cvt_pk_bf16(fsilu(g1[0]) * u1[0], fsilu(g1[1]) * u1[1]); w.w = cvt_pk_bf16(fsilu(g1[2]) * u1[2], fsilu(g1[3]) * u1[3]);
            *(u32x4*)rowp = w; } }
    }
};
__host__ __device__ __forceinline__ int swiglu_row(int h, int gate) { return (h >> 7) * 256 + gate * 128 + (h & 127); }

template <class Epi, class Sched, bool ALIGN_EPI = false, bool SP2 = false, bool F8 = false>
__device__ __forceinline__ void gemm_phase(PG8_LAS unsigned char* lds, const Gemm g, const Sched& S, const Epi& E) {
    int tid = threadIdx.x; asm volatile("" : "+v"(tid));
    const int wid = __builtin_amdgcn_readfirstlane(tid >> 6), lane = tid & 63, wr = wid >> 2, wc = wid & 3, fr = lane & 15, fq = lane >> 4;
    const int K = g.K, nt = K / BK;
    unsigned voffA, voffB;
    { int R, C; stage_rc(tid * 16, R, C); const int Rb = Epi::PERM ? ((R & ~31) + perm32(R & 31)) : R;
      voffA = (unsigned)(R * g.lda + C) * 2u; voffB = (unsigned)(Rb * g.ldb + C) * 2u; }
    const size_t q64A = (size_t)64 * g.lda * 2, q64B = (size_t)64 * g.ldb * 2;
    const size_t kstep = (size_t)(BK * 2);
    const size_t hstepA = (size_t)HALF * g.lda * 2, hstepB = (size_t)HALF * g.ldb * 2;
    const size_t tstepA = 2 * hstepA, tstepB = 2 * hstepB;
    const unsigned ldsw = (unsigned)wid * 1024u;
    const int aoff = lds_byte(wr * 64 + fr, fq * 8), boff = lds_byte(wc * 32 + fr, fq * 8);
#define PG8_SA(b, h) (((b) * 2 + (h)) * HTB)
#define PG8_SB(b, h) ((4 + (b) * 2 + (h)) * HTB)
#define PG8_STAGE(bufoff, gbase, voff) do { __builtin_amdgcn_global_load_lds((const unsigned*)((const char*)(gbase) + (voff)), (PG8_LAS unsigned*)(lds + (bufoff) + ldsw), 16, 0, 0); \
        __builtin_amdgcn_global_load_lds((const unsigned*)((const char*)(gbase) + PG8_Q64(voff) + (voff)), (PG8_LAS unsigned*)(lds + (bufoff) + ldsw + 8192), 16, 0, 0); } while (0)
#define PG8_Q64(v) PG8_Q64_##v
#define PG8_Q64_voffA q64A
#define PG8_Q64_voffB q64B
#define PG8_LDA(dst, b, h) do { _Pragma("unroll") for (int m = 0; m < 4; ++m) _Pragma("unroll") for (int k = 0; k < 2; ++k) dst[m][k] = *(const PG8_LAS bf16x8*)(lds + PG8_SA(b, h) + aoff + m * 2048 + k * 1024); } while (0)
#define PG8_LDB(dst, b, h) do { _Pragma("unroll") for (int n = 0; n < 2; ++n) _Pragma("unroll") for (int k = 0; k < 2; ++k) dst[n][k] = *(const PG8_LAS bf16x8*)(lds + PG8_SB(b, h) + boff + n * 2048 + k * 1024); } while (0)
#define PG8_MMA(ai, bj, At, Bt) do { __builtin_amdgcn_s_setprio(1); \
        if constexpr (F8) { _Pragma("unroll") for (int m = 0; m < 4; ++m) _Pragma("unroll") for (int n = 0; n < 2; ++n) \
            mfma_f8_inplace(acc[ai][bj][m][n], cat8(Bt[n][0], Bt[n][1]), cat8(At[m][0], At[m][1])); } \
        else { _Pragma("unroll") for (int m = 0; m < 4; ++m) _Pragma("unroll") for (int n = 0; n < 2; ++n) _Pragma("unroll") for (int k = 0; k < 2; ++k) \
            acc[ai][bj][m][n] = __builtin_amdgcn_mfma_f32_16x16x32_bf16(Bt[n][k], At[m][k], acc[ai][bj][m][n], 0, 0, 0); } \
        __builtin_amdgcn_s_setprio(0); } while (0)
#define PG8_WAIT_V(n) asm volatile("s_waitcnt vmcnt(" #n ")" ::: "memory")
#define PG8_WAIT_L(n) asm volatile("s_waitcnt lgkmcnt(" #n ")" ::: "memory")
#define PG8_WAIT_REL(NN) do { if (rel) asm volatile("s_waitcnt vmcnt(%0)" :: "n"(NN) : "memory"); else PG8_WAIT_V(8); } while (0)
#define PG8_BAR __builtin_amdgcn_s_barrier()
#define PG8_SCHED __builtin_amdgcn_sched_barrier(0)
    typename Epi::Pk pk; Unit cur, nxt, pend; int ui = 0; bool pending = false; pend.pm = pend.pn = pend.bn = pend.idx = 0;
    if (!S.next(0, cur)) return;
    f32x4 acc[2][2][4][2];
#pragma unroll
    for (int a = 0; a < 2; ++a)
#pragma unroll
        for (int b = 0; b < 2; ++b)
#pragma unroll
            for (int m = 0; m < 4; ++m)
#pragma unroll
                for (int n = 0; n < 2; ++n) acc[a][b][m][n] = (f32x4){0.f, 0.f, 0.f, 0.f};
    bf16x8 At[4][2], B0[2][2], B1[2][2];
    const char* cA = (const char*)g.A + (size_t)cur.pm * tstepA; const char* cB = (const char*)g.Bt + (size_t)cur.bn * tstepB;
    S.a_ready(cur);
    if constexpr (SP2) {
        PG8_STAGE(PG8_SB(0, 0), cB, voffB); PG8_STAGE(PG8_SB(0, 1), cB + hstepB, voffB); PG8_STAGE(PG8_SA(0, 0), cA, voffA); PG8_STAGE(PG8_SA(0, 1), cA + hstepA, voffA);
        if (wr == 1) PG8_BAR;
        PG8_WAIT_V(2); PG8_BAR;
        PG8_STAGE(PG8_SB(1, 0), cB + kstep, voffB); PG8_STAGE(PG8_SA(1, 0), cA + kstep, voffA); PG8_STAGE(PG8_SB(1, 1), cB + hstepB + kstep, voffB);
        PG8_WAIT_V(6); PG8_BAR;
    } else {
        PG8_STAGE(PG8_SB(0, 0), cB, voffB); PG8_STAGE(PG8_SA(0, 0), cA, voffA); PG8_STAGE(PG8_SB(0, 1), cB + hstepB, voffB); PG8_STAGE(PG8_SA(0, 1), cA + hstepA, voffA);
        if (wr == 1) PG8_BAR;
        PG8_WAIT_V(4); PG8_BAR;
        PG8_STAGE(PG8_SB(1, 0), cB + kstep, voffB); PG8_STAGE(PG8_SA(1, 0), cA + kstep, voffA); PG8_STAGE(PG8_SB(1, 1), cB + hstepB + kstep, voffB);
        PG8_WAIT_V(6); PG8_BAR;
    }
    for (;;) {
        const bool has_next = S.next(ui + 1, nxt);
        const char* nA = has_next ? (const char*)g.A + (size_t)nxt.pm * tstepA : cA; const char* nB = has_next ? (const char*)g.Bt + (size_t)nxt.bn * tstepB : cB;
        for (int t = 0; t < nt; t += 2) {
            const bool last = (t == nt - 2);
            const char* a1 = cA + (size_t)(t + 1) * kstep;
            const char* a2 = last ? nA : cA + (size_t)(t + 2) * kstep; const char* b2 = last ? nB : cB + (size_t)(t + 2) * kstep;
            const char* a3 = a2 + kstep; const char* b3 = b2 + kstep;
            if (last && has_next) S.a_ready(nxt);
            if constexpr (SP2) {
            const bool rel = Epi::SPLIT && pending && t == 0;
            if (rel) { if constexpr (Epi::SPLIT) { PG8_STAGE(PG8_SA(1, 1), a1 + hstepA, voffA); PG8_SCHED;
                if constexpr (Epi::PACK) { E.store1(pk, pend, wr, wc, fr, fq); }
                else { E.template half<1>(acc, pend, wr, wc, fr, fq);
#pragma unroll
                for (int b = 0; b < 2; ++b)
#pragma unroll
                    for (int m = 0; m < 4; ++m)
#pragma unroll
                        for (int n = 0; n < 2; ++n) acc[1][b][m][n] = (f32x4){0.f, 0.f, 0.f, 0.f}; }
                S.done(pend); pending = false;
                PG8_SCHED; PG8_LDB(B0, 0, 0); PG8_LDB(B1, 0, 1); PG8_SCHED; PG8_LDA(At, 0, 0); } }
            else { PG8_LDB(B0, 0, 0); PG8_LDB(B1, 0, 1); PG8_SCHED; PG8_LDA(At, 0, 0); PG8_STAGE(PG8_SA(1, 1), a1 + hstepA, voffA); }
            PG8_WAIT_REL(8 + Epi::NST); PG8_WAIT_L(0); PG8_BAR; PG8_MMA(0, 0, At, B0); PG8_MMA(0, 1, At, B1); PG8_BAR; PG8_SCHED;
            PG8_LDA(At, 0, 1); PG8_STAGE(PG8_SB(0, 0), b2, voffB); PG8_STAGE(PG8_SB(0, 1), b2 + hstepB, voffB); PG8_STAGE(PG8_SA(0, 0), a2, voffA);
            PG8_WAIT_REL(8 + Epi::NST); PG8_WAIT_L(0); PG8_BAR; PG8_MMA(1, 0, At, B0); PG8_MMA(1, 1, At, B1); PG8_BAR; PG8_SCHED;
            PG8_LDB(B0, 1, 0); PG8_LDB(B1, 1, 1); PG8_SCHED; PG8_LDA(At, 1, 0); PG8_STAGE(PG8_SA(0, 1), a2 + hstepA, voffA);
            PG8_WAIT_REL(8 + Epi::NST / 2); PG8_WAIT_L(0); PG8_BAR; PG8_MMA(0, 0, At, B0); PG8_MMA(0, 1, At, B1); PG8_BAR; PG8_SCHED;
            PG8_LDA(At, 1, 1); PG8_STAGE(PG8_SB(1, 0), b3, voffB); PG8_STAGE(PG8_SB(1, 1), b3 + hstepB, voffB); PG8_STAGE(PG8_SA(1, 0), a3, voffA);
            PG8_WAIT_V(8); PG8_WAIT_L(0); PG8_BAR; PG8_MMA(1, 0, At, B0); PG8_MMA(1, 1, At, B1); PG8_BAR; PG8_SCHED;
            } else {
            PG8_LDB(B0, 0, 0); PG8_SCHED; PG8_LDA(At, 0, 0); PG8_STAGE(PG8_SA(1, 1), a1 + hstepA, voffA);
            PG8_WAIT_L(8); PG8_BAR; PG8_WAIT_L(0); PG8_MMA(0, 0, At, B0); PG8_BAR; PG8_SCHED;
            PG8_LDB(B1, 0, 1); PG8_STAGE(PG8_SB(0, 0), b2, voffB);
            PG8_BAR; PG8_WAIT_L(0); PG8_MMA(0, 1, At, B1); PG8_BAR;
            PG8_LDA(At, 0, 1); PG8_STAGE(PG8_SA(0, 0), a2, voffA);
            PG8_BAR; PG8_WAIT_L(0); PG8_MMA(1, 0, At, B0); PG8_BAR; PG8_SCHED;
            PG8_STAGE(PG8_SB(0, 1), b2 + hstepB, voffB);
            PG8_WAIT_V(6); PG8_BAR; PG8_MMA(1, 1, At, B1); PG8_BAR;
            PG8_LDB(B0, 1, 0); PG8_SCHED; PG8_LDA(At, 1, 0); PG8_STAGE(PG8_SA(0, 1), a2 + hstepA, voffA);
            PG8_WAIT_L(8); PG8_BAR; PG8_WAIT_L(0); PG8_MMA(0, 0, At, B0); PG8_BAR; PG8_SCHED;
            PG8_LDB(B1, 1, 1); PG8_STAGE(PG8_SB(1, 0), b3, voffB);
            PG8_BAR; PG8_WAIT_L(0); PG8_MMA(0, 1, At, B1); PG8_BAR;
            PG8_LDA(At, 1, 1); PG8_STAGE(PG8_SA(1, 0), a3, voffA);
            PG8_BAR; PG8_WAIT_L(0); PG8_MMA(1, 0, At, B0); PG8_BAR; PG8_SCHED;
            PG8_STAGE(PG8_SB(1, 1), b3 + hstepB, voffB);
            PG8_WAIT_V(6); PG8_BAR; PG8_MMA(1, 1, At, B1); PG8_BAR;
            }
        }
        if constexpr (F8) asm volatile("s_nop 15\n\ts_nop 15\n\ts_nop 15\n\ts_nop 15" ::: "memory");
        if constexpr (ALIGN_EPI) { if (wr == 0) PG8_BAR; }
        if constexpr (Epi::SPLIT) { static_assert(SP2, "split epilogues need the SP2 loop");
            if (has_next) { E.template half<0>(acc, cur, wr, wc, fr, fq); if constexpr (Epi::PACK) E.pack1(acc, cur, wr, fr, pk); pend = cur; pending = true; }
            else { E.template half<0>(acc, cur, wr, wc, fr, fq); E.template half<1>(acc, cur, wr, wc, fr, fq); S.done(cur); } }
        else if constexpr (!Epi::AFTER_DRAIN) { E(acc, cur, wr, wc, fr, fq); S.done(cur); }
        if (!has_next) break;
#pragma unroll
        for (int a = 0; a < ((Epi::SPLIT && !Epi::PACK) ? 1 : 2); ++a)
#pragma unroll
            for (int b = 0; b < 2; ++b)
#pragma unroll
                for (int m = 0; m < 4; ++m)
#pragma unroll
                    for (int n = 0; n < 2; ++n) acc[a][b][m][n] = (f32x4){0.f, 0.f, 0.f, 0.f};
        cur = nxt; cA = nA; cB = nB; ++ui;
        if constexpr (ALIGN_EPI) { if (wr == 1) PG8_BAR; }
    }
    PG8_WAIT_V(0);
    if constexpr (!ALIGN_EPI) { if (wr == 0) PG8_BAR; }
    PG8_BAR;
    if constexpr (Epi::AFTER_DRAIN) { E.fused(acc, cur, wr, wc, fr, fq, lds, wid, lane); S.done(cur); }
#undef PG8_SA
#undef PG8_SB
#undef PG8_STAGE
#undef PG8_Q64
#undef PG8_Q64_voffA
#undef PG8_Q64_voffB
#undef PG8_LDA
#undef PG8_LDB
#undef PG8_MMA
#undef PG8_WAIT_V
#undef PG8_WAIT_L
#undef PG8_WAIT_REL
#undef PG8_BAR
#undef PG8_SCHED
}
}
#define PG8_SP2 true
#define PG8_ALIGN true
constexpr int NWAVES = 8, NTHR = 512;
constexpr int BATCH = 2, SEQ = 8192, D = 1024, M = BATCH * SEQ;
constexpr int MEMLEN = 256, MMEM = BATCH * MEMLEN;
constexpr int EV_IN = 4632, EV_INP = 4864;
constexpr int OD_IN = 5152, OD_INP = 5376;
constexpr int FF = 2816, FFE = 3584, NEXP = 8;
constexpr float MOE_W2_SCALE = 128.f;
constexpr float MOE_W13_SCALE = 64.f;
constexpr int NQB = SEQ / 64;
constexpr int XH = 4;
constexpr float EPS = 1e-6f;
constexpr int MOE_ROWS = 2 * M + NEXP * 256;
constexpr int MOE_TILES = MOE_ROWS / 256;

constexpr size_t MiB = 1u << 20;
constexpr size_t WS_CTL = 0, CTL_ZERO_BYTES = 1 * MiB;
constexpr size_t WS_SMALL = 1 * MiB;
constexpr size_t WS_CMPB_PART = WS_SMALL;
constexpr size_t WS_CMPB = WS_SMALL + 256 * 1024;
constexpr size_t WS_OV = WS_SMALL + 512 * 1024;
constexpr size_t WS_MEMN = 2 * MiB;
constexpr size_t WS_KVM = 4 * MiB;
constexpr size_t WS_KM = 6 * MiB;
constexpr size_t WS_HID = 7 * MiB;
constexpr size_t WS_KVCMP = 9 * MiB;
constexpr size_t WS_MOEIDX = 10 * MiB;
constexpr size_t WS_SSQ = 14 * MiB;
constexpr size_t WS_W = 16 * MiB;
constexpr size_t WS_W_EVIN = WS_W, WS_W_EVOUT = WS_W_EVIN + 10 * MiB, WS_W_CK1 = WS_W_EVOUT + 4 * MiB, WS_W_CV1 = WS_W_CK1 + 2 * MiB, WS_W_ODIN = WS_W_CV1 + 2 * MiB,
                 WS_W_ODOUT = WS_W_ODIN + 11 * MiB, WS_W_XQ = WS_W_ODOUT + 4 * MiB, WS_W_XKV = WS_W_XQ + 2 * MiB, WS_W_XO = WS_W_XKV + 4 * MiB, WS_W_FF13 = WS_W_XO + 2 * MiB,
                 WS_W_FF2 = WS_W_FF13 + 11 * MiB, WS_W_M13 = WS_W_FF2 + 6 * MiB, WS_W_M2 = WS_W_M13 + 112 * MiB, WS_W_END = WS_W_M2 + 56 * MiB;
constexpr size_t WS_XN = WS_W_END;
constexpr size_t WS_QX = WS_XN + 32 * MiB, WS_OX = WS_QX + 16 * MiB, WS_R = WS_OX + 16 * MiB;
constexpr size_t WS_Y0 = WS_R, WS_KV6 = WS_R + 152 * MiB, WS_MIX = WS_R + 201 * MiB, WS_H = WS_R + 265 * MiB;
constexpr size_t WS_Y1 = WS_R, WS_YG = WS_R + 168 * MiB;
constexpr size_t WS_XP = WS_R, WS_HP = WS_R + 68 * MiB, WS_YP = WS_R + 306 * MiB, WS_END = WS_R + 442 * MiB;
static_assert(WS_W_END == 242 * MiB && WS_END == 748 * MiB, "ws map");
constexpr int CW_TMO = 0, CW_CODE = 1, CW_CHK = 2;
constexpr int CW_BAR = 4096;
constexpr int CW_MOECNT = 16384;
constexpr int CW_MOEOFF = 20480;

constexpr int LDS_BYTES = 159744;
constexpr int MISC_OFF = LDS_BYTES - 512;
constexpr int SCR_BYTES = MISC_OFF;

#define GAS __attribute__((address_space(1)))
#define LAS __attribute__((address_space(3)))
typedef unsigned short bf16;
typedef unsigned v4u __attribute__((ext_vector_type(4)));
typedef unsigned v2u __attribute__((ext_vector_type(2)));
typedef float f32x4 __attribute__((ext_vector_type(4)));
typedef float f32x16 __attribute__((ext_vector_type(16)));
typedef short bf16x8 __attribute__((ext_vector_type(8)));
typedef short s16x4 __attribute__((ext_vector_type(4)));
typedef GAS unsigned gu32;
#define RLX_AGENT __ATOMIC_RELAXED, __HIP_MEMORY_SCOPE_AGENT
#define LDS_WAIT() asm volatile("s_waitcnt lgkmcnt(0)" ::: "memory")
#define VM_WAIT() asm volatile("s_waitcnt vmcnt(0)" ::: "memory")
#define SBAR() __builtin_amdgcn_sched_barrier(0)
__device__ __forceinline__ int lane_id() { return (int)threadIdx.x & 63; }
__device__ __forceinline__ unsigned f2bf(float f) { unsigned u = __builtin_bit_cast(unsigned, f); return (u + 0x7fffu + ((u >> 16) & 1u)) >> 16; }
__device__ __forceinline__ unsigned pk2(float lo, float hi) { return f2bf(lo) | (f2bf(hi) << 16); }
__device__ __forceinline__ float bf2f(unsigned short b) { return __builtin_bit_cast(float, ((unsigned)b) << 16); }
__device__ __forceinline__ float bflo(unsigned w) { return __builtin_bit_cast(float, w << 16); }
__device__ __forceinline__ float bfhi(unsigned w) { return __builtin_bit_cast(float, w & 0xffff0000u); }
__device__ __forceinline__ unsigned cvtpk(float lo, float hi) { unsigned r; asm volatile("v_cvt_pk_bf16_f32 %0, %1, %2" : "=v"(r) : "v"(lo), "v"(hi)); return r; }
__device__ __forceinline__ float wave_sum(float v) {
#pragma unroll
    for (int o = 1; o < 64; o <<= 1) v += __shfl_xor(v, o);
    return v;
}
using pg8::fsigmoid; using pg8::gelu_tanh; using pg8::fsilu;
__device__ __forceinline__ float fsoftplus(float x) { return x > 20.f ? x : log1pf(__expf(x)); }

#define XB_TMO      128
#define XB_XCNT(j)  (256  + 64 * (j))
#define XB_XSUB(j)  (1280 + 64 * (j))
#define XB_XGEN(j)  (2304 + 64 * (j))
#define XB_TOP      3328
#define XB_TOPGEN   3392
#define XCD_BAR_WORDS 3456
#define XB_SPIN_CAP (1u << 18)

__device__ __forceinline__ unsigned xb_ld(unsigned* p)              { return __hip_atomic_load(p, __ATOMIC_RELAXED, __HIP_MEMORY_SCOPE_AGENT); }
__device__ __forceinline__ unsigned xb_add(unsigned* p, unsigned v) { return __hip_atomic_fetch_add(p, v, __ATOMIC_RELAXED, __HIP_MEMORY_SCOPE_AGENT); }
__device__ __forceinline__ unsigned xb_xcc_id() { return (unsigned)__builtin_amdgcn_s_getreg((3 << 11) | 20) & 0xFu; }
#define XB_SPIN(cond, bar) do { unsigned _sp = 0; while (cond) { __builtin_amdgcn_s_sleep(1); \
    if ((++_sp & 255u) == 0u) { if (xb_ld(&(bar)[XB_TMO])) break; if (_sp > XB_SPIN_CAP) { atomicAdd(&(bar)[XB_TMO], 1u); break; } } } } while (0)

struct XcdBarrier {
    unsigned* bar; unsigned x;
    volatile LAS unsigned* st;
};

__device__ __forceinline__ XcdBarrier xcd_barrier_post(unsigned* bar, volatile LAS unsigned* st) {
    XcdBarrier b; b.bar = bar; b.x = xb_xcc_id(); b.st = st;
    if (threadIdx.x == 0) (void)xb_add(&bar[XB_XCNT(b.x)], 1u);
    return b;
}
__device__ __forceinline__ void xcd_barrier_complete(unsigned* bar, unsigned x, unsigned& nloc, unsigned& nx) {
    const unsigned G = gridDim.x * gridDim.y * gridDim.z;
    unsigned sum, cnt, mine, sp = 0u;
    for (;;) {
        sum = 0u; cnt = 0u; mine = 0u;
#pragma unroll
        for (unsigned j = 0; j < 16; ++j) { const unsigned c = xb_ld(&bar[XB_XCNT(j)]); sum += c; cnt += (c > 0u) ? 1u : 0u; mine = (j == x) ? c : mine; }
        if (sum == G) break;
        __builtin_amdgcn_s_sleep(1);
        if ((++sp & 255u) == 0u) { if (xb_ld(&bar[XB_TMO])) break; if (sp > XB_SPIN_CAP) { atomicAdd(&bar[XB_TMO], 1u); break; } }
    }
    nloc = mine > 0u ? mine : 1u; nx = cnt > 0u ? cnt : 1u;
}

__device__ __forceinline__ void xcd_barrier(const XcdBarrier& b) {
    asm volatile("s_waitcnt vmcnt(0)" ::: "memory");
    __syncthreads();
    if (threadIdx.x == 0) {
        unsigned* bar = b.bar;
        __builtin_amdgcn_s_waitcnt(0);
        unsigned nloc = b.st[0], nx = b.st[1];
        if (nloc == 0u) { xcd_barrier_complete(bar, b.x, nloc, nx); b.st[0] = nloc; b.st[1] = nx; }
        const unsigned old = xb_add(&bar[XB_XSUB(b.x)], 1u);
        const unsigned gen = old / nloc;
        if (old + 1u == (gen + 1u) * nloc) {
            __builtin_amdgcn_fence(__ATOMIC_RELEASE, "agent");
            asm volatile("s_waitcnt vmcnt(0)" ::: "memory");
            const unsigned og = xb_add(&bar[XB_TOP], 1u);
            const unsigned tg = og / nx;
            if (og + 1u == (tg + 1u) * nx) xb_add(&bar[XB_TOPGEN], 1u);
            else XB_SPIN(xb_ld(&bar[XB_TOPGEN]) == tg, bar);
            __builtin_amdgcn_fence(__ATOMIC_ACQUIRE, "agent");
            xb_add(&bar[XB_XGEN(b.x)], 1u);
            asm volatile("s_waitcnt vmcnt(0)" ::: "memory");
        } else {
            XB_SPIN(xb_ld(&bar[XB_XGEN(b.x)]) == gen, bar);
            __builtin_amdgcn_fence(__ATOMIC_ACQUIRE, "agent");
            asm volatile("s_waitcnt vmcnt(0)" ::: "memory");
        }
    }
    __syncthreads();
}

struct Args { const float* in[41]; float* out; unsigned char* ws; int ph_lo, ph_hi, li, pad; };
struct Frame { LAS unsigned char* lds; volatile LAS unsigned* MISC; gu32* ctl; unsigned char* ws; int tid, lane, wave, G, bid; };
enum { I_X = 0, I_MEM, I_NMIX, I_NCROSS, I_NMEM, I_NFFN, I_EVWIN, I_RGCW, I_RGCB, I_RGWA, I_RGBA, I_RGWX, I_RGBX, I_RGLAM, I_GATEB, I_QNORM, I_KNORM, I_CMPPOS,
       I_CKW1, I_CKW2, I_CVW1, I_CVW2, I_EVWOUT, I_ODWIN, I_ODCW, I_ODCB, I_DTB, I_ALOG, I_DSKIP, I_ODNORM, I_ODWOUT, I_XWQ, I_XWKV, I_XQN, I_XKN, I_XWO,
       I_FFW13, I_FFW2, I_ROUTER, I_MW13, I_MW2, N_IN };
static_assert(N_IN == 41, "input count");

template <int MAP>
__device__ __forceinline__ void transpose_item(const float* W, int N, bf16* WT, int ldt, LAS float* scr, int kb, int nb, int lane, int ffs, const float* kg = nullptr) {
    const int k0 = 64 * kb, n0 = 64 * nb; const int c4 = (lane & 15) * 4, r4 = lane >> 4;
    f32x4 tv[16];
    if ((N & 3) == 0) {
#pragma unroll
        for (int i = 0; i < 16; ++i) { const int kk = 4 * i + r4; tv[i] = (n0 + c4 < N) ? *(const GAS f32x4*)(W + (size_t)(k0 + kk) * N + n0 + c4) : (f32x4){0.f, 0.f, 0.f, 0.f}; }
    } else {
#pragma unroll
        for (int i = 0; i < 16; ++i) { const int kk = 4 * i + r4; const float* src = W + (size_t)(k0 + kk) * N + n0 + c4;
#pragma unroll
            for (int j = 0; j < 4; ++j) tv[i][j] = (n0 + c4 + j < N) ? src[j] : 0.f; }
    }
#pragma unroll
    for (int i = 0; i < 16; ++i) { const int kk = 4 * i + r4; const float gk = kg ? kg[k0 + kk] : 1.f;
#pragma unroll
        for (int j = 0; j < 4; ++j) scr[kk * 65 + c4 + j] = tv[i][j] * gk; }
    LDS_WAIT(); asm volatile("" ::: "memory");
    const int c = lane & 7;
#pragma unroll
    for (int j = 0; j < 8; ++j) { const int nl = (lane >> 3) + 8 * j, n = n0 + nl; const LAS float* s = scr + (8 * c) * 65 + nl;
        v4u o; o.x = pk2(s[0 * 65], s[1 * 65]); o.y = pk2(s[2 * 65], s[3 * 65]); o.z = pk2(s[4 * 65], s[5 * 65]); o.w = pk2(s[6 * 65], s[7 * 65]);
        int row = n; if (MAP == 1) row = (n < ffs) ? pg8::swiglu_row(n, 0) : pg8::swiglu_row(n - ffs, 1);
        if (n < ((N + 31) & ~31)) *(GAS v4u*)(WT + (size_t)row * ldt + k0 + 8 * c) = o; }
    LDS_WAIT(); asm volatile("" ::: "memory");
}
__device__ __forceinline__ unsigned pk4_fp8(float a, float b, float c, float d) { int r = __builtin_amdgcn_cvt_pk_fp8_f32(a, b, 0, false); r = __builtin_amdgcn_cvt_pk_fp8_f32(c, d, r, true); return (unsigned)r; }
template <int MAP>
__device__ __forceinline__ void transpose_item_f8(const float* W, int N, unsigned char* WT8, int ldt, LAS float* scr, int kb, int nb, int lane, int ffs, float sc) {
    const int k0 = 64 * kb, n0 = 64 * nb; const int c4 = (lane & 15) * 4, r4 = lane >> 4;
    f32x4 tv[16];
#pragma unroll
    for (int i = 0; i < 16; ++i) { const int kk = 4 * i + r4; tv[i] = *(const GAS f32x4*)(W + (size_t)(k0 + kk) * N + n0 + c4); }
#pragma unroll
    for (int i = 0; i < 16; ++i) { const int kk = 4 * i + r4;
#pragma unroll
        for (int j = 0; j < 4; ++j) scr[kk * 65 + c4 + j] = tv[i][j] * sc; }
    LDS_WAIT(); asm volatile("" ::: "memory");
    const int c = lane & 7;
#pragma unroll
    for (int j = 0; j < 8; ++j) { const int nl = (lane >> 3) + 8 * j, n = n0 + nl; const LAS float* s = scr + (8 * c) * 65 + nl;
        v2u o; o.x = pk4_fp8(s[0 * 65], s[1 * 65], s[2 * 65], s[3 * 65]); o.y = pk4_fp8(s[4 * 65], s[5 * 65], s[6 * 65], s[7 * 65]);
        int row = n; if (MAP == 1) row = (n < ffs) ? pg8::swiglu_row(n, 0) : pg8::swiglu_row(n - ffs, 1);
        *(GAS v2u*)(WT8 + (size_t)row * ldt + k0 + 8 * c) = o; }
    LDS_WAIT(); asm volatile("" ::: "memory");
}
constexpr int MOE_CONV_ITEMS = NEXP * (16 * 112 + 56 * 16);

__device__ __forceinline__ void rms_row_to_bf16(const float* xrow, const float* g, bf16* orow, int lane) {
    const GAS f32x4* xr = (const GAS f32x4*)xrow + lane; const GAS f32x4* gr = (const GAS f32x4*)g + lane;
    f32x4 v[4]; float s = 0.f;
#pragma unroll
    for (int j = 0; j < 4; ++j) { v[j] = xr[64 * j]; s += (v[j].x * v[j].x + v[j].y * v[j].y) + (v[j].z * v[j].z + v[j].w * v[j].w); }
    const float rstd = 1.f / sqrtf(wave_sum(s) * (1.f / D) + EPS);
    GAS unsigned long long* o8 = (GAS unsigned long long*)orow + lane;
#pragma unroll
    for (int j = 0; j < 4; ++j) { const f32x4 gg = gr[64 * j];
        o8[64 * j] = (unsigned long long)pk2(v[j].x * rstd * gg.x, v[j].y * rstd * gg.y) | ((unsigned long long)pk2(v[j].z * rstd * gg.z, v[j].w * rstd * gg.w) << 32); }
}
__device__ __forceinline__ void phase_rmsnorm(const Frame& F, const float* x, const float* g, bf16* xn, int rows) {
    const int gw = F.bid * NWAVES + F.wave, NGW = F.G * NWAVES;
    for (int m = gw; m < rows; m += NGW) rms_row_to_bf16(x + (size_t)m * D, g, xn + (size_t)m * D, F.lane);
}
#define TR_MAT(cnt_, W_, K_, N_, WT_, ldt_, MAPK_, ffs_, kg_) \
    if (r < (cnt_)) { const int nblk_ = ((N_) + 63) / 64; transpose_item<MAPK_>((W_), (N_), (WT_), (ldt_), scr, r / nblk_, r % nblk_, F.lane, (ffs_), (kg_)); continue; } r -= (cnt_);
constexpr int C_EVIN = 16 * 73, C_EVOUT = 32 * 16, C_CW1 = 64 * 4, C_ODIN = 16 * 81, C_ODOUT = 32 * 16, C_XQ = 16 * 8, C_XKV = 16 * 16, C_XO = 8 * 16, C_FF13 = 16 * 88, C_FF2 = 44 * 16;
constexpr int CONV_A = C_EVIN + 2 * C_XKV + 2 * C_CW1, CONV_B = C_EVOUT + 2 * C_XQ + 2 * C_XO + C_FF13 + C_FF2 + C_ODIN + C_ODOUT;
constexpr int CONV_ALL = CONV_A + CONV_B + MOE_CONV_ITEMS, CONV_Q = 4480, CONV_P2_END = CONV_ALL - 2 * CONV_Q;
__device__ __forceinline__ void convert_range(const Frame& F, const Args& a, int gw, int NGW, int it_lo, int it_hi) {
    LAS float* scr = (LAS float*)(F.lds + F.wave * 16640); unsigned char* ws = F.ws;
    for (int it = it_lo + gw; it < it_hi; it += NGW) {
        int r = it;
        TR_MAT(C_EVIN, a.in[I_EVWIN], D, EV_IN, (bf16*)(ws + WS_W_EVIN), D, 0, 0, nullptr)
        TR_MAT(C_XKV, a.in[I_XWKV], D, 1024, (bf16*)(ws + WS_W_XKV), D, 0, 0, nullptr)
        TR_MAT(C_XKV, a.in[I_XWKV] + (size_t)D * 1024, D, 1024, (bf16*)(ws + WS_W_XKV) + (size_t)1024 * D, D, 0, 0, nullptr)
        TR_MAT(C_CW1, a.in[I_CKW1], 4096, 256, (bf16*)(ws + WS_W_CK1), 4096, 0, 0, nullptr)
        TR_MAT(C_CW1, a.in[I_CVW1], 4096, 256, (bf16*)(ws + WS_W_CV1), 4096, 0, 0, nullptr)
        TR_MAT(C_EVOUT, a.in[I_EVWOUT], 2048, D, (bf16*)(ws + WS_W_EVOUT), 2048, 0, 0, nullptr)
        TR_MAT(C_XQ, a.in[I_XWQ], D, 512, (bf16*)(ws + WS_W_XQ), D, 0, 0, a.in[I_NCROSS])
        TR_MAT(C_XO, a.in[I_XWO], 512, D, (bf16*)(ws + WS_W_XO), 512, 0, 0, nullptr)
        TR_MAT(C_FF13, a.in[I_FFW13], D, 2 * FF, (bf16*)(ws + WS_W_FF13), D, 1, FF, a.in[I_NFFN])
        TR_MAT(C_FF2, a.in[I_FFW2], FF, D, (bf16*)(ws + WS_W_FF2), FF, 0, 0, nullptr)
        TR_MAT(C_ODIN, a.in[I_ODWIN], D, OD_IN, (bf16*)(ws + WS_W_ODIN), D, 0, 0, a.in[I_NMIX] + D)
        TR_MAT(C_ODOUT, a.in[I_ODWOUT], 2048, D, (bf16*)(ws + WS_W_ODOUT), 2048, 0, 0, nullptr)
        TR_MAT(C_XQ, a.in[I_XWQ] + (size_t)D * 512, D, 512, (bf16*)(ws + WS_W_XQ) + (size_t)512 * D, D, 0, 0, a.in[I_NCROSS] + D)
        TR_MAT(C_XO, a.in[I_XWO] + (size_t)512 * D, 512, D, (bf16*)(ws + WS_W_XO) + (size_t)D * 512, 512, 0, 0, nullptr)
        { constexpr int C_M13 = 16 * 112, C_M2 = 56 * 16;
          if (r < NEXP * C_M13) { const int e = r / C_M13, q = r % C_M13; transpose_item_f8<1>(a.in[I_MW13] + (size_t)e * D * 2 * FFE, 2 * FFE, ws + WS_W_M13 + (size_t)e * 2 * FFE * D, D, scr, q / 112, q % 112, F.lane, FFE, MOE_W13_SCALE); continue; } r -= NEXP * C_M13;
          { const int e = r / C_M2, q = r % C_M2; transpose_item_f8<0>(a.in[I_MW2] + (size_t)e * FFE * D, D, ws + WS_W_M2 + (size_t)e * D * FFE, FFE, scr, q / 16, q % 16, F.lane, 0, MOE_W2_SCALE); } }
    }
}
__device__ __forceinline__ void p0_prologue(const Frame& F, const Args& a) {
    const int gw = F.bid * NWAVES + F.wave, NGW = F.G * NWAVES;
    unsigned char* ws = F.ws;
    convert_range(F, a, gw, NGW, 0, CONV_A);
    for (int i = F.bid * NTHR + F.tid; i < 2 * 224 * 128; i += F.G * NTHR) { const int w = i / (224 * 128), q = i % (224 * 128);
        bf16* base = w == 0 ? (bf16*)(ws + WS_W_EVIN) + (size_t)4640 * D : (bf16*)(ws + WS_W_ODIN) + (size_t)5152 * D; *(GAS v4u*)(base + (size_t)q * 8) = (v4u){0u, 0u, 0u, 0u}; }
    phase_rmsnorm(F, a.in[I_X], a.in[I_NMIX], (bf16*)(ws + WS_XN), M);
    phase_rmsnorm(F, a.in[I_MEM], a.in[I_NMEM], (bf16*)(ws + WS_MEMN), MMEM);
    phase_rmsnorm(F, a.in[I_MEM], a.in[I_NMEM] + D, (bf16*)(ws + WS_MEMN) + (size_t)MMEM * D, MMEM);
    for (int i = F.bid * NTHR + F.tid; i < 512 * 128; i += F.G * NTHR) { const int n = i >> 7, j = i & 127; ((bf16*)(ws + WS_OV))[i] = (n <= 510 && n >= 4 * j - 1 && n <= 4 * j + 3) ? (bf16)0x3F80 : (bf16)0; }
    for (int it = gw; it < 128; it += NGW) { const int mm = it >> 6, ic = it & 63; const float* w1 = a.in[mm ? I_CVW1 : I_CKW1]; const float* pos = a.in[I_CMPPOS];
        f32x4 acc = {0.f, 0.f, 0.f, 0.f};
        for (int rr = 0; rr < 64; ++rr) { const int i = ic * 64 + rr; const float p = pos[i]; const f32x4 w = *(const GAS f32x4*)(w1 + (size_t)i * 256 + 4 * F.lane); acc += w * p; }
        *(GAS f32x4*)((float*)(ws + WS_CMPB_PART) + (size_t)(mm * 64 + ic) * 256 + 4 * F.lane) = acc; }
}
#undef TR_MAT
namespace att {
constexpr float SCALE = 0.08838834764831845f;
constexpr float THR = 8.f;
constexpr int KVBLK = 64, DH = 128;
constexpr int SHM_V = KVBLK * DH * 2, SHM_K = KVBLK * DH * 2;
constexpr int NSLOT = 3;
constexpr int LDS_ATT = NSLOT * SHM_V + NSLOT * SHM_K + NWAVES * 64 * 4;
#define KSWZ(row, colB) ((row) * 256 + ((colB) ^ (((row) & 7) << 4)))
__device__ __forceinline__ int v_st(int k, int c) { const int kk = (k & ~0xC) | ((k & 4) << 1) | ((k & 8) >> 1); return ((kk >> 3) * 4 + (c >> 5)) * 512 + ((kk & 7) * 32 + (c & 31)) * 2; }
__device__ __forceinline__ int v_rd_base(int lane) { return ((lane & 3) << 3) | (((lane >> 2) & 3) << 6) | (((lane >> 4) & 1) << 5) | (((lane >> 5) & 1) << 8); }
constexpr int v_rd_off(int d0, int ks, int half) { return d0 * 512 + ks * 4096 + half * 2048; }
__device__ __forceinline__ int crow(int r, int hi) { return (r & 3) + 8 * (r >> 2) + 4 * hi; }
__device__ __forceinline__ bf16x8 pack8(f32x4 a, f32x4 b) { v4u w = {cvtpk(a[0], a[1]), cvtpk(a[2], a[3]), cvtpk(b[0], b[1]), cvtpk(b[2], b[3])}; return *reinterpret_cast<bf16x8*>(&w); }

__device__ __forceinline__ void mask_tile(f32x16& p0, f32x16& p1, int dq, unsigned W) {
    asm volatile("" : "+v"(dq));
    const float NEG = -__builtin_inff();
#pragma unroll
    for (int r = 0; r < 16; ++r) { const int c = (r & 3) + 8 * (r >> 2);
        if ((unsigned)(dq - c) >= W) p0[r] = NEG;
        if ((unsigned)(dq - c - 32) >= W) p1[r] = NEG; }
}
__device__ __forceinline__ void mask_all(f32x16& p0, f32x16& p1) { const float NEG = -__builtin_inff();
#pragma unroll
    for (int r = 0; r < 16; ++r) { p0[r] = NEG; p1[r] = NEG; } }
__device__ __forceinline__ void partialSM(f32x16& p0, f32x16& p1, float& m_reg, float& mn, float& alpha, bool keep = true) {
    float pmax = p0[0];
#pragma unroll
    for (int r = 1; r < 16; ++r) pmax = fmaxf(pmax, p0[r]);
#pragma unroll
    for (int r = 0; r < 16; ++r) pmax = fmaxf(pmax, p1[r]);
    pmax = keep ? pmax : -__builtin_inff();
    { auto rr = __builtin_amdgcn_permlane32_swap(__float_as_uint(pmax), __float_as_uint(pmax), false, false);
      pmax = fmaxf(__uint_as_float(rr[0]), __uint_as_float(rr[1])); }
    constexpr float C2 = 1.4426950408889634f * SCALE;
    if (__builtin_expect(__all((pmax - m_reg) * SCALE <= THR), 1)) { mn = m_reg; alpha = 1.f; }
    else { mn = fmaxf(m_reg, pmax); alpha = __builtin_amdgcn_exp2f((m_reg - mn) * C2); m_reg = mn; }
    const float mnL = keep ? -mn * C2 : -__builtin_inff();
#pragma unroll
    for (int r = 0; r < 16; ++r) p0[r] = fmaf(p0[r], C2, mnL);
#pragma unroll
    for (int r = 0; r < 16; ++r) p1[r] = fmaf(p1[r], C2, mnL);
#pragma unroll
    for (int r = 0; r < 16; ++r) p0[r] = __builtin_amdgcn_exp2f(p0[r]);
}
__device__ __forceinline__ void finishSM(f32x16& p0, f32x16& p1, float alpha, float& l_reg, bf16x8& pa0, bf16x8& pa1, bf16x8& pa2, bf16x8& pa3) {
#pragma unroll
    for (int r = 0; r < 16; ++r) p1[r] = __builtin_amdgcn_exp2f(p1[r]);
    float ps = 0;
#pragma unroll
    for (int r = 0; r < 16; ++r) ps += p0[r];
#pragma unroll
    for (int r = 0; r < 16; ++r) ps += p1[r];
    { auto rr = __builtin_amdgcn_permlane32_swap(__float_as_uint(ps), __float_as_uint(ps), false, false);
      ps = __uint_as_float(rr[0]) + __uint_as_float(rr[1]); }
    l_reg = l_reg * alpha + ps;
#define PK4(P, B_, OUT) do { unsigned a0 = cvtpk(P[B_+0], P[B_+1]), a1 = cvtpk(P[B_+2], P[B_+3]);                          \
        unsigned b0 = cvtpk(P[B_+4], P[B_+5]), b1 = cvtpk(P[B_+6], P[B_+7]);                                             \
        auto r0 = __builtin_amdgcn_permlane32_swap(a0, b0, false, false); auto r1 = __builtin_amdgcn_permlane32_swap(a1, b1, false, false); \
        v4u w = {r0[0], r1[0], r0[1], r1[1]}; OUT = *reinterpret_cast<bf16x8*>(&w); } while (0)
    PK4(p0, 0, pa0); PK4(p0, 8, pa1); PK4(p1, 0, pa2); PK4(p1, 8, pa3);
#undef PK4
}
__device__ __forceinline__ void qkt(f32x16& p0, f32x16& p1, const char* Kslot, int r32, int hi, const bf16x8* qr) {
    p0 = f32x16{}; p1 = f32x16{};
    const char* kb[4];
#pragma unroll
    for (int dd = 0; dd < 4; ++dd) kb[dd] = Kslot + KSWZ(r32, (dd * 16 + hi * 8) * 2);
    bf16x8 fa[4], fb[4];
#define KLD(dst, i, d0) do { const char* a_ = kb[(d0) & 3] + ((d0) >> 2) * 128; dst[i] = *reinterpret_cast<const bf16x8*>(a_); dst[i + 1] = *reinterpret_cast<const bf16x8*>(a_ + 32 * 256); } while (0)
#define KMM(src, i, d0) do { p0 = __builtin_amdgcn_mfma_f32_32x32x16_bf16(src[i], qr[d0], p0, 0, 0, 0); p1 = __builtin_amdgcn_mfma_f32_32x32x16_bf16(src[i + 1], qr[d0], p1, 0, 0, 0); } while (0)
    KLD(fa, 0, 0); KLD(fa, 2, 1); KLD(fb, 0, 2); KLD(fb, 2, 3); SBAR();
    KMM(fa, 0, 0); KMM(fa, 2, 1); SBAR(); KLD(fa, 0, 4); KLD(fa, 2, 5); SBAR();
    KMM(fb, 0, 2); KMM(fb, 2, 3); SBAR(); KLD(fb, 0, 6); KLD(fb, 2, 7); SBAR();
    KMM(fa, 0, 4); KMM(fa, 2, 5); SBAR();
    KMM(fb, 0, 6); KMM(fb, 2, 7);
#undef KLD
#undef KMM
}
__device__ __forceinline__ void pv_tile(f32x16* o, int vbs, bf16x8 pa0, bf16x8 pa1, bf16x8 pa2, bf16x8 pa3) {
#define TRRD(dst, off) asm volatile("ds_read_b64_tr_b16 %0, %1 offset:%2" : "=&v"(dst) : "v"(vbs), "i"(off) : "memory")
#define PV_D0(d0) do { s16x4 l0, l1, l2, l3, h0, h1, h2, h3; constexpr int b_ = v_rd_off(d0, 0, 0); \
        TRRD(l0, b_); TRRD(h0, b_ + 2048); TRRD(l1, b_ + 4096); TRRD(h1, b_ + 6144); TRRD(l2, b_ + 8192); TRRD(h2, b_ + 10240); TRRD(l3, b_ + 12288); TRRD(h3, b_ + 14336); \
        asm volatile("s_waitcnt lgkmcnt(0)" ::: "memory"); SBAR();   \
        o[d0] = __builtin_amdgcn_mfma_f32_32x32x16_bf16(pa0, (bf16x8){l0[0], l0[1], l0[2], l0[3], h0[0], h0[1], h0[2], h0[3]}, o[d0], 0, 0, 0);   \
        o[d0] = __builtin_amdgcn_mfma_f32_32x32x16_bf16(pa1, (bf16x8){l1[0], l1[1], l1[2], l1[3], h1[0], h1[1], h1[2], h1[3]}, o[d0], 0, 0, 0);   \
        o[d0] = __builtin_amdgcn_mfma_f32_32x32x16_bf16(pa2, (bf16x8){l2[0], l2[1], l2[2], l2[3], h2[0], h2[1], h2[2], h2[3]}, o[d0], 0, 0, 0);   \
        o[d0] = __builtin_amdgcn_mfma_f32_32x32x16_bf16(pa3, (bf16x8){l3[0], l3[1], l3[2], l3[3], h3[0], h3[1], h3[2], h3[3]}, o[d0], 0, 0, 0); } while (0)
    PV_D0(0); PV_D0(1); PV_D0(2); PV_D0(3);
#undef PV_D0
#undef TRRD
}
__device__ __forceinline__ void q_issue(const bf16* qrow, int hi, v4u (&raw)[8]) {
#pragma unroll
    for (int d0 = 0; d0 < 8; ++d0) raw[d0] = *(const GAS v4u*)(qrow + d0 * 16 + hi * 8);
}
__device__ __forceinline__ void q_finish(const v4u (&raw)[8], const float* g, int hi, bf16x8* qr) {
    float ss = 0.f;
#pragma unroll
    for (int d0 = 0; d0 < 8; ++d0)
#pragma unroll
        for (int j = 0; j < 4; ++j) { const float a = bflo(raw[d0][j]), b = bfhi(raw[d0][j]); ss += a * a + b * b; }
    ss += __shfl_xor(ss, 32);
    const float rstd = 1.f / sqrtf(ss * (1.f / 128.f) + EPS);
#pragma unroll
    for (int d0 = 0; d0 < 8; ++d0) { const f32x4 g0 = *(const GAS f32x4*)(g + d0 * 16 + hi * 8), g1 = *(const GAS f32x4*)(g + d0 * 16 + hi * 8 + 4);
        v4u w; w.x = cvtpk(bflo(raw[d0][0]) * rstd * g0[0], bfhi(raw[d0][0]) * rstd * g0[1]); w.y = cvtpk(bflo(raw[d0][1]) * rstd * g0[2], bfhi(raw[d0][1]) * rstd * g0[3]);
        w.z = cvtpk(bflo(raw[d0][2]) * rstd * g1[0], bfhi(raw[d0][2]) * rstd * g1[1]); w.w = cvtpk(bflo(raw[d0][3]) * rstd * g1[2], bfhi(raw[d0][3]) * rstd * g1[3]);
        qr[d0] = *reinterpret_cast<bf16x8*>(&w); }
}
__device__ __forceinline__ void load_q(const bf16* qrow, const float* g, int hi, bf16x8* qr) { v4u raw[8]; q_issue(qrow, hi, raw); q_finish(raw, g, hi, qr); }
struct PassIO { const bf16* Kp; int ldk; const bf16* Vp; int ldv; int t_lo, t_hi; };
__device__ __forceinline__ void dma_offsets(int wid, int lane, int ldk, int ldv, unsigned& koff, unsigned& voff) {
    const int row = 4 * wid + (lane >> 4); koff = (unsigned)(row * ldk * 2 + (((lane & 15) ^ (row & 7)) << 4));
    const int st = 2 * wid + (lane >> 5), kk = ((st >> 2) << 3) | ((lane & 31) >> 2), k = (kk & ~0xC) | ((kk & 4) << 1) | ((kk & 8) >> 1); voff = (unsigned)(k * ldv * 2 + ((st & 3) * 32 + 8 * (lane & 3)) * 2);
}
#define ATT_DMA(io_, t, slot) do { const char* kt_ = (const char*)(io_).Kp + (size_t)(t) * (KVBLK * 2) * (io_).ldk; const char* vt_ = (const char*)(io_).Vp + (size_t)(t) * (KVBLK * 2) * (io_).ldv;          \
        LAS unsigned* kd_ = (LAS unsigned*)(ldsl + NSLOT * SHM_V + (slot) * SHM_K + wid * 1024); LAS unsigned* vd_ = (LAS unsigned*)(ldsl + (slot) * SHM_V + wid * 1024);                \
        __builtin_amdgcn_global_load_lds((const unsigned*)(kt_ + koff), kd_, 16, 0, 0); __builtin_amdgcn_global_load_lds((const unsigned*)(kt_ + koff + (size_t)64 * (io_).ldk), kd_ + 2048, 16, 0, 0); \
        __builtin_amdgcn_global_load_lds((const unsigned*)(vt_ + voff), vd_, 16, 0, 0); __builtin_amdgcn_global_load_lds((const unsigned*)(vt_ + voff + (size_t)64 * (io_).ldv), vd_ + 2048, 16, 0, 0); } while (0)
__device__ __forceinline__ void attn_prefetch(char* lds, const PassIO& io) {
    int tid = threadIdx.x; asm volatile("" : "+v"(tid));
    const int wid = __builtin_amdgcn_readfirstlane(tid >> 6), lane = tid & 63;
    unsigned koff, voff; dma_offsets(wid, lane, io.ldk, io.ldv, koff, voff);
    LAS unsigned char* ldsl = (LAS unsigned char*)lds;
    ATT_DMA(io, io.t_lo, 0); if (io.t_hi - io.t_lo > 1) ATT_DMA(io, io.t_lo + 1, 1);
}
template <class MaskF>
__device__ __forceinline__ void attn_pass(char* lds, const bf16x8* qr, const PassIO& io, const MaskF& mf, f32x16 (&o)[4], float& l_out) {
    int tid = threadIdx.x; asm volatile("" : "+v"(tid));
    const int wid = __builtin_amdgcn_readfirstlane(tid >> 6), lane = tid & 63, r32 = lane & 31, hi = lane >> 5;
    char* V_lds = lds; char* K_lds = lds + NSLOT * SHM_V;
    float* wsc = (float*)(lds + NSLOT * SHM_V + NSLOT * SHM_K) + wid * 64; float* al_l = wsc + 32;
    float m_reg = -1e30f, l_reg = 0.f;
#pragma unroll
    for (int d = 0; d < 4; ++d) o[d] = f32x16{};
    const int vb0 = (int)(uintptr_t)V_lds + v_rd_base(lane);
    const int t_lo = io.t_lo, NT = io.t_hi - io.t_lo;
    unsigned koff, voff; dma_offsets(wid, lane, io.ldk, io.ldv, koff, voff);
    LAS unsigned char* ldsl = (LAS unsigned char*)lds;
    f32x16 p0, p1; float mn, alpha = 1.f; bf16x8 pa0, pa1, pa2, pa3;
#define A_RESC(a) do { if (__any((a) < 1.f)) { if (hi == 0) al_l[r32] = (a); asm volatile("s_waitcnt lgkmcnt(0)" ::: "memory"); \
        _Pragma("unroll") for (int d_ = 0; d_ < 4; ++d_) _Pragma("unroll") for (int r = 0; r < 16; ++r) o[d_][r] *= al_l[crow(r, hi)]; } } while (0)
#define A_BAR() do { asm volatile("" ::: "memory"); __builtin_amdgcn_s_barrier(); asm volatile("" ::: "memory"); } while (0)
    const bool lead = wid < 4;
    VM_WAIT();
    __syncthreads();
    if (!lead) A_BAR();
    int sK = 0, sV = 2, sW = 1;
    bool act_prev = false;
    for (int i = 0; i < NT; ++i) {
        if (lead && i >= 1 && i + 1 < NT) ATT_DMA(io, t_lo + i + 1, sW);
        const bool act = mf.active(t_lo + i);
        SBAR(); if (act) qkt(p0, p1, K_lds + sK * SHM_K, r32, hi, qr);
        if (i > 0 && act_prev) pv_tile(o, vb0 + sV * SHM_V, pa0, pa1, pa2, pa3);
        if (!lead && i + 1 < NT) VM_WAIT();
        A_BAR();
        if (!lead && i + 2 < NT) ATT_DMA(io, t_lo + i + 2, sV);
        if (act) { mf(p0, p1, t_lo + i); partialSM(p0, p1, m_reg, mn, alpha, mf.keep(t_lo + i)); A_RESC(alpha); finishSM(p0, p1, alpha, l_reg, pa0, pa1, pa2, pa3); }
        act_prev = act;
        if (lead && i + 1 < NT) VM_WAIT();
        A_BAR();
        { const int t_ = sV; sV = sK; sK = sW; sW = t_; }
    }
    if (act_prev) pv_tile(o, vb0 + sV * SHM_V, pa0, pa1, pa2, pa3);
    if (lead) A_BAR();
    __syncthreads();
#undef A_RESC
#undef A_BAR
    l_out = l_reg;
}
__device__ __forceinline__ void row_inv_l(char* lds, float l_reg, float (&rli)[16]) {
    const int tid = threadIdx.x, wid = __builtin_amdgcn_readfirstlane(tid >> 6), lane = tid & 63, r32 = lane & 31, hi = lane >> 5;
    float* wsc = (float*)(lds + NSLOT * SHM_V + NSLOT * SHM_K) + wid * 64;
    if (hi == 0) wsc[r32] = l_reg;
    asm volatile("s_waitcnt lgkmcnt(0)" ::: "memory");
#pragma unroll
    for (int r = 0; r < 16; ++r) { const float l = wsc[crow(r, hi)]; rli[r] = l > 0.f ? __builtin_amdgcn_rcpf(l) : 0.f; }
    asm volatile("s_waitcnt lgkmcnt(0)" ::: "memory");
}
struct NoMask { __device__ __forceinline__ void operator()(f32x16&, f32x16&, int) const {} __device__ __forceinline__ bool active(int) const { return true; } __device__ __forceinline__ bool keep(int) const { return true; } };
}
__device__ __forceinline__ void norm128_rows(const Frame& F, const bf16* src, size_t lds_, bf16* dst, size_t ldd, int nrows, const float* g, int gw, int NGW) {
    const int sub = F.lane >> 4, l16 = F.lane & 15;
    const f32x4 g0 = *(const GAS f32x4*)(g + l16 * 8), g1 = *(const GAS f32x4*)(g + l16 * 8 + 4);
    for (int r0 = gw * 4; r0 < nrows; r0 += NGW * 4) { const int r = r0 + sub;
        const v4u raw = *(const GAS v4u*)(src + (size_t)r * lds_ + l16 * 8);
        float ss = 0.f;
#pragma unroll
        for (int j = 0; j < 4; ++j) { const float a = bflo(raw[j]), b = bfhi(raw[j]); ss += a * a + b * b; }
        ss += __shfl_xor(ss, 1); ss += __shfl_xor(ss, 2); ss += __shfl_xor(ss, 4); ss += __shfl_xor(ss, 8);
        const float rstd = 1.f / sqrtf(ss * (1.f / 128.f) + EPS);
        v4u w; w.x = cvtpk(bflo(raw[0]) * rstd * g0[0], bfhi(raw[0]) * rstd * g0[1]); w.y = cvtpk(bflo(raw[1]) * rstd * g0[2], bfhi(raw[1]) * rstd * g0[3]);
        w.z = cvtpk(bflo(raw[2]) * rstd * g1[0], bfhi(raw[2]) * rstd * g1[1]); w.w = cvtpk(bflo(raw[3]) * rstd * g1[2], bfhi(raw[3]) * rstd * g1[3]);
        *(GAS v4u*)(dst + (size_t)r * ldd + l16 * 8) = w; }
}
__device__ __forceinline__ void phase_memk_norm(const Frame& F, const Args& a, int l, int gw, int NGW) {
    const bf16* kvm = (const bf16*)(F.ws + WS_KVM) + (size_t)l * MMEM * 1024; bf16* km = (bf16*)(F.ws + WS_KM) + (size_t)l * MMEM * 512;
    for (int bh = 0; bh < BATCH * XH; ++bh) { const int b = bh >> 2, h = bh & 3;
        norm128_rows(F, kvm + (size_t)b * MEMLEN * 1024 + h * 128, 1024, km + (size_t)bh * MEMLEN * 128, 128, MEMLEN, a.in[I_XKN] + l * 128, gw, NGW); }
}

__device__ __forceinline__ void phase_cross_attn(const Frame& F, const Args& a, int l) {
    char* lds = (char*)F.lds; const int r32 = F.lane & 31, hi = F.lane >> 5;
    const bf16* QX = (const bf16*)(F.ws + WS_QX); bf16* OX = (bf16*)(F.ws + WS_OX);
    for (int u = F.bid; u < BATCH * XH * (SEQ / 256); u += F.G) {
        const int tb = u % (SEQ / 256), bh = u / (SEQ / 256), b = bh >> 2, h = bh & 3;
        const size_t row0 = (size_t)b * SEQ + tb * 256 + F.wave * 32;
        const bf16* Kp = (const bf16*)(F.ws + WS_KM) + (size_t)l * MMEM * 512 + (size_t)bh * MEMLEN * 128;
        const bf16* Vp = (const bf16*)(F.ws + WS_KVM) + (size_t)l * MMEM * 1024 + (size_t)b * MEMLEN * 1024 + 512 + h * 128;
        const att::PassIO io{Kp, 128, Vp, 1024, 0, MEMLEN / 64}; att::attn_prefetch(lds, io);
        bf16x8 qr[8]; att::load_q(QX + (row0 + r32) * 512 + h * 128, a.in[I_XQN] + l * 128, hi, qr);
        f32x16 o[4]; float l_reg; att::attn_pass(lds, qr, io, att::NoMask{}, o, l_reg);
        float rli[16]; att::row_inv_l(lds, l_reg, rli);
#pragma unroll
        for (int r = 0; r < 16; ++r) { bf16* orow = OX + (row0 + att::crow(r, hi)) * 512 + h * 128;
#pragma unroll
            for (int d0 = 0; d0 < 4; ++d0) { const float v = o[d0][r] * rli[r]; const float vn = __shfl_xor(v, 1);
                if ((r32 & 1) == 0) *(GAS unsigned*)(orow + d0 * 32 + r32) = cvtpk(v, vn); } }
    }
}

constexpr int NSA_GSC = att::LDS_ATT, NSA_IMP = NSA_GSC + NWAVES * 32 * 3 * 4, NSA_SEL = NSA_IMP + NWAVES * 8 * 128 * 4, NSA_SELU = NSA_SEL + 64 * 4 * 4, NSA_LDS_END = NSA_SELU + NWAVES * 4 * 4;
static_assert(NSA_LDS_END <= SCR_BYTES, "nsa lds");
struct CmpMask { int nmax, hi, nmin_wave;
    __device__ __forceinline__ void operator()(f32x16& p0, f32x16& p1, int t) const { if (t * 64 + 63 <= nmin_wave) return; att::mask_tile(p0, p1, nmax - t * 64 - 4 * hi, 0x40000000u); }
    __device__ __forceinline__ bool active(int) const { return true; } __device__ __forceinline__ bool keep(int) const { return true; } };
struct WinMask { int P, hi, qb;
    __device__ __forceinline__ void operator()(f32x16& p0, f32x16& p1, int t) const { if (t == qb || t == qb - 8) att::mask_tile(p0, p1, P - t * 64 - 4 * hi, 512u); }
    __device__ __forceinline__ bool active(int) const { return true; } __device__ __forceinline__ bool keep(int) const { return true; } };
struct SlcMask { const LAS unsigned* selw; const LAS unsigned* uni; int P, hi, qb;
    __device__ __forceinline__ void operator()(f32x16& p0, f32x16& p1, int t) const { if (t == qb) att::mask_tile(p0, p1, P - t * 64 - 4 * hi, 0x40000000u); }
    __device__ __forceinline__ bool keep(int t) const { return (selw[t >> 5] >> (t & 31)) & 1u; }
    __device__ __forceinline__ bool active(int t) const { return (__builtin_amdgcn_readfirstlane(uni[t >> 5]) >> (t & 31)) & 1u; } };

__device__ __forceinline__ void nsa_unit(const Frame& F, const Args& a, int b, int g, int qb, int dry = 0) {
    char* lds = (char*)F.lds; const int w = F.wave; const int t0 = qb * 64;
#define NSA_LANE() int lane = F.lane; asm volatile("" : "+v"(lane)); const int r32 = lane & 31, hi = lane >> 5; const int tok = 8 * w + (r32 >> 2), head = 4 * g + (r32 & 3), P = t0 + tok; (void)head; (void)P; (void)tok
    unsigned char* wsl = F.ws; asm volatile("" : "+s"(wsl));
    const bf16* Y0 = (const bf16*)(wsl + WS_Y0); const bf16* KV6 = (const bf16*)(wsl + WS_KV6);
    const size_t slab = (size_t)SEQ * 128, bg = (size_t)(b * 2 + g);
    LAS float* gsc = (LAS float*)(F.lds + NSA_GSC) + w * 96; LAS float* imp = (LAS float*)(F.lds + NSA_IMP) + w * 1024; LAS unsigned* selm = (LAS unsigned*)(F.lds + NSA_SEL);
    { NSA_LANE();
      if (hi == 0) {
#pragma unroll
        for (int br = 0; br < 3; ++br) gsc[r32 * 3 + br] = fsigmoid(bf2f(Y0[((size_t)b * SEQ + P) * EV_INP + 4608 + head * 3 + br]) + a.in[I_GATEB][head * 3 + br]); }
      LDS_WAIT(); }
    f32x16 o[4]; float l_reg; float rli[16];
    const bf16* KCMP = (const bf16*)(wsl + WS_KVCMP) + bg * 512 * 128; const bf16* VCMP = (const bf16*)(wsl + WS_KVCMP) + (size_t)2048 * 128 + bg * 512 * 128;
    const int ncmp_t = ((4 * qb + 2) >> 6) + 1;
    const att::PassIO io_imp{KCMP, 128, (const bf16*)(wsl + WS_OV), 128, 0, ncmp_t}, io_cmp{KCMP, 128, VCMP, 128, 0, ncmp_t},
                      io_slc{KV6 + (2 * 4 + bg) * slab, 128, KV6 + (3 * 4 + bg) * slab, 128, 0, qb + 1}, io_win{KV6 + (4 * 4 + bg) * slab, 128, KV6 + (5 * 4 + bg) * slab, 128, qb >= 8 ? qb - 8 : 0, qb + 1};
    v4u qraw[8];
#define NSA_QISSUE() do { NSA_LANE(); att::q_issue(Y0 + ((size_t)b * SEQ + P) * EV_INP + 2048 + head * 128, hi, qraw); } while (0)
    att::attn_prefetch(lds, io_imp); NSA_QISSUE();
    { NSA_LANE(); const CmpMask cm{(P - 31) >> 4, hi, (t0 + 8 * w - 31) >> 4};
      bf16x8 qr[8]; att::q_finish(qraw, a.in[I_QNORM], hi, qr);
      if (dry < 2) att::attn_pass(lds, qr, io_imp, cm, o, l_reg); else { VM_WAIT(); __syncthreads(); l_reg = 1.f; } }
    att::attn_prefetch(lds, io_cmp); NSA_QISSUE();
    if (dry < 3) {
    att::row_inv_l(lds, l_reg, rli);
    { NSA_LANE();
#pragma unroll
    for (int q = 0; q < 4; ++q)
#pragma unroll
        for (int d = 0; d < 4; ++d) { float s = 0.f;
#pragma unroll
            for (int i = 0; i < 4; ++i) s += o[d][4 * q + i] * rli[4 * q + i];
            imp[(2 * q + hi) * 128 + d * 32 + r32] = s; }
    LDS_WAIT();
    { const unsigned long long lt = (1ull << lane) - 1ull;
#pragma unroll 1
    for (int tl = 0; tl < 8; ++tl) { unsigned k0, k1;
        { const int j0 = lane, j1 = lane + 64; const float v0 = imp[tl * 128 + j0], v1 = imp[tl * 128 + j1];
          const float s0 = v0 + (((j0 == 0) || (j0 == qb) || (j0 == qb - 1)) ? 100.f : 0.f), s1 = v1 + (((j1 == 0) || (j1 == qb) || (j1 == qb - 1)) ? 100.f : 0.f);
          k0 = (j0 <= qb) ? __float_as_uint(s0) + 1u : 0u; k1 = (j1 <= qb) ? __float_as_uint(s1) + 1u : 0u; }
        unsigned T = 0u;
#pragma unroll 1
        for (int bit = 30; bit >= 0; --bit) { const unsigned cand = T | (1u << bit);
            const int cnt = __popcll(__ballot(k0 >= cand)) + __popcll(__ballot(k1 >= cand)); if (cnt >= 16) T = cand; }
        const unsigned long long g0 = __ballot(k0 > T), g1 = __ballot(k1 > T), e0 = __ballot(k0 == T), e1 = __ballot(k1 == T);
        const int need = 16 - (__popcll(g0) + __popcll(g1));
        const bool sel0 = (k0 > T) || (k0 == T && __popcll(e0 & lt) < need), sel1 = (k1 > T) || (k1 == T && __popcll(e0) + __popcll(e1 & lt) < need);
        const unsigned long long m0 = __ballot(sel0 && lane <= qb), m1 = __ballot(sel1 && lane + 64 <= qb);
        if (lane == 0) { LAS unsigned* sw = selm + (8 * w + tl) * 4; sw[0] = (unsigned)m0; sw[1] = (unsigned)(m0 >> 32); sw[2] = (unsigned)m1; sw[3] = (unsigned)(m1 >> 32); } } }
    LDS_WAIT();
    if (lane < 4) { unsigned u = 0;
#pragma unroll
        for (int tl = 0; tl < 8; ++tl) u |= selm[(8 * w + tl) * 4 + lane];
        ((LAS unsigned*)(F.lds + NSA_SELU))[w * 4 + lane] = u; }
    LDS_WAIT(); }
    }
    { NSA_LANE(); const CmpMask cm{(P - 31) >> 4, hi, (t0 + 8 * w - 31) >> 4};
      bf16x8 qr[8]; att::q_finish(qraw, a.in[I_QNORM], hi, qr);
#if defined(MK_NSA_DUP) && MK_NSA_DUP == 2
      att::attn_pass(lds, qr, io_cmp, cm, o, l_reg); att::attn_prefetch(lds, io_cmp);
#endif
      if (dry < 2) att::attn_pass(lds, qr, io_cmp, cm, o, l_reg); else { VM_WAIT(); __syncthreads(); l_reg = 1.f; } }
    att::attn_prefetch(lds, io_slc); NSA_QISSUE();
    att::row_inv_l(lds, l_reg, rli);
    unsigned oacc[4][8];
    if (dry < 4) { NSA_LANE();
#pragma unroll
    for (int r = 0; r < 16; ++r) rli[r] *= gsc[att::crow(r, hi) * 3 + 0];
#pragma unroll
    for (int d = 0; d < 4; ++d)
#pragma unroll
        for (int r = 0; r < 16; r += 2) oacc[d][r >> 1] = cvtpk(o[d][r] * rli[r], o[d][r + 1] * rli[r + 1]); }
    { NSA_LANE(); const SlcMask sm{selm + tok * 4, (const LAS unsigned*)(F.lds + NSA_SELU) + w * 4, P, hi, qb};
      bf16x8 qr[8]; att::q_finish(qraw, a.in[I_QNORM], hi, qr);
#if defined(MK_NSA_DUP) && MK_NSA_DUP == 5
      { const size_t bg2 = (bg + 1) & 3; const att::PassIO io_cold{KV6 + (2 * 4 + bg2) * slab, 128, KV6 + (3 * 4 + bg2) * slab, 128, 0, qb + 1};
        att::attn_pass(lds, qr, io_cold, sm, o, l_reg); att::attn_prefetch(lds, io_slc); }
#endif
#if defined(MK_NSA_DUP) && MK_NSA_DUP == 3
      att::attn_pass(lds, qr, io_slc, sm, o, l_reg); att::attn_prefetch(lds, io_slc);
#endif
      if (!dry) att::attn_pass(lds, qr, io_slc, sm, o, l_reg); else { VM_WAIT(); __syncthreads(); } }
    att::attn_prefetch(lds, io_win); NSA_QISSUE();
    att::row_inv_l(lds, l_reg, rli);
    if (dry < 4) { NSA_LANE();
#pragma unroll
    for (int r = 0; r < 16; ++r) rli[r] *= gsc[att::crow(r, hi) * 3 + 1];
#pragma unroll
    for (int d = 0; d < 4; ++d)
#pragma unroll
        for (int r = 0; r < 16; r += 2) oacc[d][r >> 1] = cvtpk(bflo(oacc[d][r >> 1]) + o[d][r] * rli[r], bfhi(oacc[d][r >> 1]) + o[d][r + 1] * rli[r + 1]); }
    { NSA_LANE(); const WinMask wm{P, hi, qb};
      bf16x8 qr[8]; att::q_finish(qraw, a.in[I_QNORM], hi, qr);
#if defined(MK_NSA_DUP) && MK_NSA_DUP == 4
      att::attn_pass(lds, qr, io_win, wm, o, l_reg); att::attn_prefetch(lds, io_win);
#endif
      if (dry < 2) att::attn_pass(lds, qr, io_win, wm, o, l_reg); else { VM_WAIT(); __syncthreads(); l_reg = 1.f; } }
    att::row_inv_l(lds, l_reg, rli);
    if (dry < 4) { NSA_LANE();
    bf16* MIX = dry ? (bf16*)(wsl + WS_R + 400 * MiB) : (bf16*)(wsl + WS_MIX);
#pragma unroll
    for (int r = 0; r < 16; ++r) rli[r] *= gsc[att::crow(r, hi) * 3 + 2];
    bf16* obase = MIX + ((size_t)b * SEQ + t0 + 8 * w) * 2048 + 1024 + 4 * g * 128 + r32;
#pragma unroll
    for (int d0 = 0; d0 < 4; ++d0) {
#pragma unroll
        for (int r = 0; r < 16; ++r) { const int row = att::crow(r, hi); const float v = ((r & 1) ? bfhi(oacc[d0][r >> 1]) : bflo(oacc[d0][r >> 1])) + o[d0][r] * rli[r]; const float vn = __shfl_xor(v, 1);
            if ((r32 & 1) == 0) *(GAS unsigned*)(obase + (size_t)(row >> 2) * 2048 + (row & 3) * 128 + d0 * 32) = cvtpk(v, vn); }
        } }
    __syncthreads();
#undef NSA_QISSUE
#undef NSA_LANE
}
__device__ __forceinline__ void phase_nsa(const Frame& F, const Args& a) {
#pragma unroll 1
    for (int it = F.bid * 2; it < 512; it += F.G * 2)
#pragma unroll 1
        for (int k = 0; k < 2; ++k) { const int p = it >> 1, xcd = p & 7, bg = xcd >> 1, x = (xcd & 1) * 32 + (p >> 3);
#if defined(MK_NSA_DRY)
            nsa_unit(F, a, bg >> 1, bg & 1, k == 0 ? 127 - x : x, MK_NSA_DRY);
#endif
            nsa_unit(F, a, bg >> 1, bg & 1, k == 0 ? 127 - x : x); }
}
__device__ __forceinline__ f32x4 mma16(const LAS bf16* A, int pa, const LAS bf16* B, int pb, int K, f32x4 acc, int fr, int fq) {
    for (int k0 = 0; k0 < K; k0 += 32) { const bf16x8 af = *(const LAS bf16x8*)(A + fr * pa + k0 + 8 * fq); const bf16x8 bfv = *(const LAS bf16x8*)(B + fr * pb + k0 + 8 * fq);
        acc = __builtin_amdgcn_mfma_f32_16x16x32_bf16(af, bfv, acc, 0, 0, 0); }
    return acc;
}

__device__ __forceinline__ void phase_cmp2(const Frame& F, const Args& a, int u_lo, int u_hi, int u_step) {
    LAS bf16* hidS = (LAS bf16*)F.lds; LAS bf16* w2T = (LAS bf16*)(F.lds + 32 * 264 * 2); LAS float* outS = (LAS float*)(F.lds + 32 * 264 * 2 + 128 * 264 * 2);
    const int fr = F.lane & 15, fq = F.lane >> 4;
    for (int u = u_lo; u < u_hi; u += u_step) { const int mm = u >> 6, rb = u & 63;
        const bf16* hid = (const bf16*)(F.ws + WS_HID) + (size_t)mm * 2048 * 256 + (size_t)rb * 32 * 256; const float* w2 = a.in[mm ? I_CVW2 : I_CKW2];
        for (int i = F.tid; i < 32 * 32; i += NTHR) { const int r = i >> 5, c8 = i & 31; *(LAS v4u*)(hidS + r * 264 + c8 * 8) = *(const GAS v4u*)(hid + r * 256 + c8 * 8); }
        for (int i = F.tid; i < 256 * 128; i += NTHR) { const int k = i >> 7, c = i & 127; w2T[c * 264 + k] = (bf16)f2bf(w2[i]); }
        __syncthreads();
        const int rt = F.wave & 1;
#pragma unroll
        for (int cc = 0; cc < 2; ++cc) { const int ct = (F.wave >> 1) * 2 + cc; f32x4 acc = {0.f, 0.f, 0.f, 0.f};
            acc = mma16(hidS + rt * 16 * 264, 264, w2T + ct * 16 * 264, 264, 256, acc, fr, fq);
#pragma unroll
            for (int e = 0; e < 4; ++e) outS[(rt * 16 + 4 * fq + e) * 132 + ct * 16 + fr] = acc[e]; }
        __syncthreads();
        { const int r = F.wave * 4 + (F.lane >> 4), l16 = F.lane & 15; const int grow = rb * 32 + r, n = grow & 511;
          float v[8]; float ss = 0.f;
#pragma unroll
          for (int j = 0; j < 8; ++j) { v[j] = outS[r * 132 + l16 * 8 + j]; ss += v[j] * v[j]; }
          ss += __shfl_xor(ss, 1); ss += __shfl_xor(ss, 2); ss += __shfl_xor(ss, 4); ss += __shfl_xor(ss, 8);
          if (mm == 0) { const float rstd = 1.f / sqrtf(ss * (1.f / 128.f) + EPS); const float* g = a.in[I_KNORM];
#pragma unroll
              for (int j = 0; j < 8; ++j) v[j] = v[j] * rstd * g[l16 * 8 + j]; }
          if (n == 511) {
#pragma unroll
              for (int j = 0; j < 8; ++j) v[j] = 0.f; }
          v4u w; w.x = cvtpk(v[0], v[1]); w.y = cvtpk(v[2], v[3]); w.z = cvtpk(v[4], v[5]); w.w = cvtpk(v[6], v[7]);
          *(GAS v4u*)((bf16*)(F.ws + WS_KVCMP) + (size_t)mm * 2048 * 128 + (size_t)grow * 128 + l16 * 8) = w; }
        __syncthreads();
    }
}

__device__ __forceinline__ void rglru_unit(const Frame& F, const Args& a, int b, int h, int s) {
    const int w = F.wave, lane = F.lane, fr = lane & 15, fq = lane >> 4;
    LAS bf16* xcs = (LAS bf16*)F.lds + w * (16 * 136); LAS float* summ = (LAS float*)(F.lds + 8 * 16 * 136 * 2);
    const bf16* Y0 = (const bf16*)(F.ws + WS_Y0) + (size_t)b * SEQ * EV_INP; bf16* MIX = (bf16*)(F.ws + WS_MIX) + (size_t)b * SEQ * 2048;
    const int ch = h * 128 + s * 16 + fr;
    bf16x8 ba_f[4], bx_f[4];
    { const float* wa = a.in[I_RGWA] + (size_t)h * 128 * 128 + s * 16 + fr; const float* wx = a.in[I_RGWX] + (size_t)h * 128 * 128 + s * 16 + fr;
#pragma unroll
      for (int kk = 0; kk < 4; ++kk) { v4u ua, ux;
#pragma unroll
          for (int e2 = 0; e2 < 4; ++e2) { const int k = 32 * kk + 8 * fq + 2 * e2; ua[e2] = pk2(wa[(size_t)k * 128], wa[(size_t)(k + 1) * 128]); ux[e2] = pk2(wx[(size_t)k * 128], wx[(size_t)(k + 1) * 128]); }
          ba_f[kk] = *reinterpret_cast<bf16x8*>(&ua); bx_f[kk] = *reinterpret_cast<bf16x8*>(&ux); } }
    const float bias_a = a.in[I_RGBA][ch], bias_x = a.in[I_RGBX][ch], c8 = -8.f * fsoftplus(-a.in[I_RGLAM][ch]);
    const int cg = h * 128 + 2 * lane; float cw0[4], cw1[4];
#pragma unroll
    for (int j = 0; j < 4; ++j) { cw0[j] = a.in[I_RGCW][j * 1024 + cg]; cw1[j] = a.in[I_RGCW][j * 1024 + cg + 1]; }
    const float cb0 = a.in[I_RGCB][cg], cb1 = a.in[I_RGCB][cg + 1];
    float carry = 0.f;
    unsigned raw[19];
#define RG_LOAD(c_) do { const int T0_ = (c_) * 128 + 16 * w; _Pragma("unroll") for (int i = 0; i < 19; ++i) { const int t = T0_ - 3 + i; raw[i] = (t >= 0) ? *(const GAS unsigned*)(Y0 + (size_t)t * EV_INP + cg) : 0u; } } while (0)
    RG_LOAD(0);
#ifdef MK_DUP_RG
    for (int cc = 0; cc < 2 * (SEQ / 128); ++cc) { const int c = cc & (SEQ / 128 - 1); if (cc == SEQ / 128) { carry = 0.f; RG_LOAD(0); }
#else
    for (int c = 0; c < SEQ / 128; ++c) {
#endif
        const int T0 = c * 128 + 16 * w;
#pragma unroll
        for (int tt = 0; tt < 16; ++tt) { float y0 = cb0, y1 = cb1;
#pragma unroll
            for (int j = 0; j < 4; ++j) { y0 += cw0[j] * bflo(raw[tt + j]); y1 += cw1[j] * bfhi(raw[tt + j]); }
            *(LAS unsigned*)(xcs + tt * 136 + 2 * lane) = cvtpk(y0, y1); }
        LDS_WAIT();
        if (c + 1 < SEQ / 128) RG_LOAD(c + 1);
        unsigned short gg[4];
#pragma unroll
        for (int e = 0; e < 4; ++e) gg[e] = Y0[(size_t)(T0 + 4 * fq + e) * EV_INP + 1024 + ch];
        f32x4 acc_a = {0.f, 0.f, 0.f, 0.f}, acc_x = {0.f, 0.f, 0.f, 0.f};
#pragma unroll
        for (int kk = 0; kk < 4; ++kk) { const bf16x8 af = *(const LAS bf16x8*)(xcs + fr * 136 + 32 * kk + 8 * fq);
            acc_a = __builtin_amdgcn_mfma_f32_16x16x32_bf16(af, ba_f[kk], acc_a, 0, 0, 0); acc_x = __builtin_amdgcn_mfma_f32_16x16x32_bf16(af, bx_f[kk], acc_x, 0, 0, 0); }
        float hl[4], pl[4]; float hh = 0.f, pp = 1.f;
#pragma unroll
        for (int e = 0; e < 4; ++e) { const float xv = bf2f(xcs[(4 * fq + e) * 136 + s * 16 + fr]);
            const float r = fsigmoid(acc_a[e] + bias_a), ig = fsigmoid(acc_x[e] + bias_x); const float la = c8 * r; const float av = __expf(la);
            const float uu = __builtin_amdgcn_sqrtf((1.f - av) * (1.f + av)) * (ig * xv);
            hh = av * hh + uu; pp *= av; hl[e] = hh; pl[e] = pp; }
        float Apre = 1.f, Hpre = 0.f, Aw = 1.f, Hw = 0.f;
#pragma unroll
        for (int q = 0; q < 4; ++q) { const float Aq = __shfl(pp, fr + 16 * q), Hq = __shfl(hh, fr + 16 * q);
            if (q < fq) { Hpre = Aq * Hpre + Hq; Apre *= Aq; }
            Hw = Aq * Hw + Hq; Aw *= Aq; }
        LAS float* sm = summ + (c & 1) * 256;
        if (fq == 0) { sm[(w * 16 + fr) * 2] = Aw; sm[(w * 16 + fr) * 2 + 1] = Hw; }
        __syncthreads();
        float cin = carry, call = carry;
#pragma unroll
        for (int q = 0; q < 8; ++q) { const float Aq = sm[(q * 16 + fr) * 2], Hq = sm[(q * 16 + fr) * 2 + 1]; call = Aq * call + Hq; if (q < w) cin = call; }
        carry = call;
        const float cl = Apre * cin + Hpre;
#pragma unroll
        for (int e = 0; e < 4; ++e) { const float hv = hl[e] + pl[e] * cl; MIX[(size_t)(T0 + 4 * fq + e) * 2048 + ch] = (bf16)f2bf(gelu_tanh(bf2f(gg[e])) * hv); }
    }
#undef RG_LOAD
    __syncthreads();
}
constexpr size_t WS_M_CN = WS_R + 168 * MiB + 64 * MiB;
constexpr size_t WS_M_BN = WS_M_CN + 16 * MiB, WS_M_BT = WS_M_BN + 16 * MiB, WS_M_XT = WS_M_BT + 16 * MiB, WS_M_ACS = WS_M_XT + 64 * MiB, WS_M_DTV = WS_M_ACS + 2 * MiB,
                 WS_M_ST = WS_M_DTV + 2 * MiB, WS_M_PV = WS_M_ST + 128 * MiB, WS_M_END = WS_M_PV + 64 * MiB;
static_assert(WS_M_END <= WS_R + 560 * MiB, "mamba ws");
constexpr int MB_P = 136;
__device__ __forceinline__ void conv4_silu(const v4u (&rows)[7], const float* cw, int ldw, const float* cb, float (&out)[4][8]) {
    float wv[4][8], bv[8];
#pragma unroll
    for (int j = 0; j < 4; ++j) { const f32x4 w0 = *(const GAS f32x4*)(cw + (size_t)j * ldw), w1 = *(const GAS f32x4*)(cw + (size_t)j * ldw + 4);
#pragma unroll
        for (int i = 0; i < 4; ++i) { wv[j][i] = w0[i]; wv[j][4 + i] = w1[i]; } }
    { const f32x4 b0 = *(const GAS f32x4*)cb, b1 = *(const GAS f32x4*)(cb + 4);
#pragma unroll
      for (int i = 0; i < 4; ++i) { bv[i] = b0[i]; bv[4 + i] = b1[i]; } }
#pragma unroll
    for (int tt = 0; tt < 4; ++tt)
#pragma unroll
        for (int i2 = 0; i2 < 4; ++i2) { float y0 = bv[2 * i2], y1 = bv[2 * i2 + 1];
#pragma unroll
            for (int j = 0; j < 4; ++j) { y0 += wv[j][2 * i2] * bflo(rows[tt + j][i2]); y1 += wv[j][2 * i2 + 1] * bfhi(rows[tt + j][i2]); }
            out[tt][2 * i2] = fsilu(y0); out[tt][2 * i2 + 1] = fsilu(y1); }
}
__device__ __forceinline__ void od_dt_cols(const Frame& F, const bf16* X, const bf16* Wt, const float* ssq, bf16* Y1) {
    typedef float f32x16_t __attribute__((ext_vector_type(16)));
    int t_ = threadIdx.x; asm volatile("" : "+v"(t_));
    const int wave = __builtin_amdgcn_readfirstlane(t_ >> 6), lane = t_ & 63;
    const int r32 = lane & 31, hi = lane >> 5, kq = wave & 3;
    LAS float* red = (LAS float*)F.lds;
    for (int t0 = F.bid * 2; t0 < M / 32; t0 += F.G * 2) { const int r0 = (t0 + (wave >> 2)) * 32;
        const bf16* xa = X + (size_t)(r0 + r32) * D + 256 * kq + 8 * hi; const bf16* wb = Wt + (size_t)(5120 + r32) * D + 256 * kq + 8 * hi;
        f32x16_t acc;
#pragma unroll
        for (int r = 0; r < 16; ++r) acc[r] = 0.f;
        pg8::bf16x8 av[16], bv[16];
#pragma unroll
        for (int u = 0; u < 16; ++u) { av[u] = *(const GAS pg8::bf16x8*)(xa + 16 * u); bv[u] = *(const GAS pg8::bf16x8*)(wb + 16 * u); }
#pragma unroll
        for (int u = 0; u < 16; ++u) acc = __builtin_amdgcn_mfma_f32_32x32x16_bf16(av[u], bv[u], acc, 0, 0, 0);
        if (kq != 0) {
#pragma unroll
            for (int r = 0; r < 16; ++r) red[(wave * 16 + r) * 64 + lane] = acc[r]; }
        __syncthreads();
        if (kq == 0) { const float rs_l = pg8::row_rstd(ssq, r0 + r32);
#pragma unroll
            for (int r = 0; r < 16; ++r) { const int row = (r & 3) + 8 * (r >> 2) + 4 * hi; const float rs = __shfl(rs_l, row);
                const float v = (acc[r] + red[((wave + 1) * 16 + r) * 64 + lane]) + (red[((wave + 2) * 16 + r) * 64 + lane] + red[((wave + 3) * 16 + r) * 64 + lane]);
                Y1[(size_t)(r0 + row) * OD_INP + 5120 + r32] = (bf16)f2bf(v * rs); } }
        __syncthreads();
    }
}
__device__ __forceinline__ void phase_mamba_prep(const Frame& F, const Args& a) {
    LAS bf16* T = (LAS bf16*)F.lds;
    LAS float* acsS = (LAS float*)(F.lds + 128 * MB_P * 2); LAS float* dtS = acsS + 256;
    const int tid = F.tid, lane = F.lane, w = F.wave, sg = tid >> 4, cv = tid & 15;
    const float* cw = a.in[I_ODCW]; const float* cb = a.in[I_ODCB];
    v4u rows[7];
#define M0_LOAD(u_) do { const int bc_ = (u_) / 24, sl_ = (u_) % 24, T0_ = (bc_ & 63) * 128; const bf16* Y1_ = (const bf16*)(F.ws + WS_Y1) + (size_t)(bc_ >> 6) * SEQ * OD_INP; \
        _Pragma("unroll") for (int i = 0; i < 7; ++i) { const int t = T0_ + 4 * sg - 3 + i; rows[i] = (t >= 0) ? *(const GAS v4u*)(Y1_ + (size_t)t * OD_INP + 2048 + sl_ * 128 + cv * 8) : (v4u){0u, 0u, 0u, 0u}; } } while (0)
    if (F.bid < 128 * 24) M0_LOAD(F.bid);
    for (int u = F.bid; u < 128 * 24; u += F.G) { const int bc = u / 24, sl = u % 24, b = bc >> 6, c = bc & 63, T0 = c * 128;
        const bf16* Y1 = (const bf16*)(F.ws + WS_Y1) + (size_t)b * SEQ * OD_INP; const int ch0 = sl * 128;
        { float vals[4][8];
          conv4_silu(rows, cw + ch0 + cv * 8, 3072, cb + ch0 + cv * 8, vals);
          if (u + F.G < 128 * 24) M0_LOAD(u + F.G);
#pragma unroll
          for (int tt = 0; tt < 4; ++tt) { v4u o; o.x = cvtpk(vals[tt][0], vals[tt][1]); o.y = cvtpk(vals[tt][2], vals[tt][3]); o.z = cvtpk(vals[tt][4], vals[tt][5]); o.w = cvtpk(vals[tt][6], vals[tt][7]);
              *(LAS v4u*)(T + (4 * sg + tt) * MB_P + cv * 8) = o; } }
        if (sl < 16 && w < 2) { const int h = 2 * sl + w;
            const float Ah = -__expf(a.in[I_ALOG][h]), dtb = a.in[I_DTB][h];
            const float d0 = fsoftplus(bf2f(Y1[(size_t)(T0 + 2 * lane) * OD_INP + 5120 + h]) + dtb), d1 = fsoftplus(bf2f(Y1[(size_t)(T0 + 2 * lane + 1) * OD_INP + 5120 + h]) + dtb);
            const float a0 = d0 * Ah, a1 = d1 * Ah; float pr = a0 + a1;
#pragma unroll
            for (int off = 1; off < 64; off <<= 1) { const float t = __shfl_up(pr, off); if (lane >= off) pr += t; }
            const float ex = pr - (a0 + a1); const float c0 = ex + a0, c1 = ex + a0 + a1;
            acsS[w * 128 + 2 * lane] = c0; acsS[w * 128 + 2 * lane + 1] = c1; dtS[w * 128 + 2 * lane] = d0; dtS[w * 128 + 2 * lane + 1] = d1;
            float* ACS = (float*)(F.ws + WS_M_ACS) + ((size_t)bc * 32 + h) * 128; float* DTV = (float*)(F.ws + WS_M_DTV) + ((size_t)bc * 32 + h) * 128;
            typedef float f32x2v __attribute__((ext_vector_type(2))); *(GAS f32x2v*)(ACS + 2 * lane) = (f32x2v){c0, c1}; *(GAS f32x2v*)(DTV + 2 * lane) = (f32x2v){d0, d1}; }
        __syncthreads();
        if (sl < 16) {
            const int cc = tid >> 2, s0 = (tid & 3) * 32, hh = cc >> 6; bf16* XT = (bf16*)(F.ws + WS_M_XT) + (((size_t)bc * 32 + 2 * sl) * 64 + cc) * 128 + s0;
#pragma unroll
            for (int k8 = 0; k8 < 4; ++k8) { float v[8];
#pragma unroll
                for (int k = 0; k < 8; ++k) { const int s = s0 + 8 * k8 + k; v[k] = bf2f(T[s * MB_P + cc]) * dtS[hh * 128 + s]; }
                v4u o; o.x = cvtpk(v[0], v[1]); o.y = cvtpk(v[2], v[3]); o.z = cvtpk(v[4], v[5]); o.w = cvtpk(v[6], v[7]); *(GAS v4u*)(XT + 8 * k8) = o; } }
        else { const int g = (sl - 16) & 3; const bool isB = sl < 20;
            bf16* N = (bf16*)(F.ws + (isB ? WS_M_BN : WS_M_CN)) + ((size_t)b * SEQ + T0) * 512 + g * 128;
            for (int i = tid; i < 128 * 16; i += NTHR) { const int s = i >> 4, c8 = i & 15; *(GAS v4u*)(N + (size_t)s * 512 + c8 * 8) = *(const LAS v4u*)(T + s * MB_P + c8 * 8); }
            if (isB) { const int cc = tid >> 2, s0 = (tid & 3) * 32; bf16* BT = (bf16*)(F.ws + WS_M_BT) + (((size_t)bc * 4 + g) * 128 + cc) * 128 + s0;
#pragma unroll
                for (int k8 = 0; k8 < 4; ++k8) { unsigned short v[8];
#pragma unroll
                    for (int k = 0; k < 8; ++k) v[k] = T[(s0 + 8 * k8 + k) * MB_P + cc];
                    v4u o; o.x = v[0] | ((unsigned)v[1] << 16); o.y = v[2] | ((unsigned)v[3] << 16); o.z = v[4] | ((unsigned)v[5] << 16); o.w = v[6] | ((unsigned)v[7] << 16); *(GAS v4u*)(BT + 8 * k8) = o; } } }
        __syncthreads();
    }
#undef M0_LOAD
}
__device__ __forceinline__ void phase_mamba_states(const Frame& F) {
    LAS bf16* BTs = (LAS bf16*)F.lds; LAS bf16* XW = (LAS bf16*)(F.lds + 128 * MB_P * 2);
    const int tid = F.tid, lane = F.lane, w = F.wave, fr = lane & 15, fq = lane >> 4;
    for (int u = F.bid; u < 128 * 4; u += F.G) { const int bc = u >> 2, g = u & 3;
        const bf16* BT = (const bf16*)(F.ws + WS_M_BT) + ((size_t)bc * 4 + g) * 128 * 128;
        for (int i = tid; i < 128 * 16; i += NTHR) { const int n = i >> 4, c8 = i & 15; *(LAS v4u*)(BTs + n * MB_P + c8 * 8) = *(const GAS v4u*)(BT + (size_t)n * 128 + c8 * 8); }
#pragma unroll 1
        for (int hh = 0; hh < 8; ++hh) { const int h = g * 8 + hh;
            const bf16* XT = (const bf16*)(F.ws + WS_M_XT) + ((size_t)bc * 32 + h) * 64 * 128; const float* ACS = (const float*)(F.ws + WS_M_ACS) + ((size_t)bc * 32 + h) * 128;
            const float aL = ACS[127];
#pragma unroll
            for (int k = 0; k < 2; ++k) { const int i = tid + k * NTHR, p = i >> 4, c8 = i & 15; const v4u raw = *(const GAS v4u*)(XT + (size_t)p * 128 + c8 * 8);
                const f32x4 a0 = *(const GAS f32x4*)(ACS + c8 * 8), a1 = *(const GAS f32x4*)(ACS + c8 * 8 + 4);
                v4u o; o.x = cvtpk(bflo(raw[0]) * __expf(aL - a0[0]), bfhi(raw[0]) * __expf(aL - a0[1])); o.y = cvtpk(bflo(raw[1]) * __expf(aL - a0[2]), bfhi(raw[1]) * __expf(aL - a0[3]));
                o.z = cvtpk(bflo(raw[2]) * __expf(aL - a1[0]), bfhi(raw[2]) * __expf(aL - a1[1])); o.w = cvtpk(bflo(raw[3]) * __expf(aL - a1[2]), bfhi(raw[3]) * __expf(aL - a1[3]));
                *(LAS v4u*)(XW + p * MB_P + c8 * 8) = o; }
            __syncthreads();
            float* ST = (float*)(F.ws + WS_M_ST) + ((size_t)bc * 32 + h) * 64 * 128;
#pragma unroll
            for (int pt = 0; pt < 4; ++pt) { f32x4 acc = {0.f, 0.f, 0.f, 0.f}; acc = mma16(XW + pt * 16 * MB_P, MB_P, BTs + w * 16 * MB_P, MB_P, 128, acc, fr, fq);
#pragma unroll
                for (int e = 0; e < 4; ++e) ST[(size_t)(pt * 16 + 4 * fq + e) * 128 + w * 16 + fr] = acc[e]; }
            __syncthreads();
        }
    }
}
__device__ __forceinline__ void phase_mamba_scan(const Frame& F) {
    const int gt = F.bid * NTHR + F.tid;
    for (int i = gt; i < BATCH * 32 * 64 * 32; i += F.G * NTHR) { const int n4 = i & 31, p = (i >> 5) & 63, h = (i >> 11) & 31, b = i >> 16;
        f32x4 S = {0.f, 0.f, 0.f, 0.f};
#pragma unroll 4
        for (int c = 0; c < 64; ++c) { const size_t bc = (size_t)b * 64 + c; const size_t off = ((bc * 32 + h) * 64 + p) * 128 + n4 * 4;
            const f32x4 st = *(const GAS f32x4*)((const float*)(F.ws + WS_M_ST) + off); const float dec = __expf(((const float*)(F.ws + WS_M_ACS))[(bc * 32 + h) * 128 + 127]);
            v2u o; o.x = cvtpk(S[0], S[1]); o.y = cvtpk(S[2], S[3]); *(GAS v2u*)((bf16*)(F.ws + WS_M_PV) + off) = o;
            S = S * dec + st; } }
}
constexpr int M3_CS = 0, M3_BS = M3_CS + 128 * MB_P * 2, M3_MS = M3_BS + 128 * MB_P * 2, M3_XT = M3_MS + 128 * MB_P * 2, M3_PV = M3_XT + 64 * MB_P * 2, M3_ACS = M3_PV + 64 * MB_P * 2, M3_DT = M3_ACS + 512, M3_END = M3_DT + 512;
static_assert(M3_END <= SCR_BYTES, "mamba lds");
__device__ __forceinline__ void phase_mamba_out(const Frame& F, const Args& a) {
    LAS bf16* Cs = (LAS bf16*)(F.lds + M3_CS); LAS bf16* Bs = (LAS bf16*)(F.lds + M3_BS); LAS bf16* Ms = (LAS bf16*)(F.lds + M3_MS); LAS bf16* XTs = (LAS bf16*)(F.lds + M3_XT); LAS bf16* PVs = (LAS bf16*)(F.lds + M3_PV);
    LAS float* acs = (LAS float*)(F.lds + M3_ACS); LAS float* dtv = (LAS float*)(F.lds + M3_DT);
    const int tid = F.tid, lane = F.lane, w = F.wave, fr = lane & 15, fq = lane >> 4;
    for (int u = F.bid; u < 128 * 4; u += F.G) { const int bc = u >> 2, g = u & 3, b = bc >> 6, T0 = (bc & 63) * 128;
        const bf16* CN = (const bf16*)(F.ws + WS_M_CN) + ((size_t)b * SEQ + T0) * 512 + g * 128; const bf16* BN = (const bf16*)(F.ws + WS_M_BN) + ((size_t)b * SEQ + T0) * 512 + g * 128;
        for (int i = tid; i < 128 * 16; i += NTHR) { const int s = i >> 4, c8 = i & 15;
            *(LAS v4u*)(Cs + s * MB_P + c8 * 8) = *(const GAS v4u*)(CN + (size_t)s * 512 + c8 * 8); *(LAS v4u*)(Bs + s * MB_P + c8 * 8) = *(const GAS v4u*)(BN + (size_t)s * 512 + c8 * 8); }
        __syncthreads();
        f32x4 cbt[8];
#pragma unroll
        for (int st = 0; st < 8; ++st) { cbt[st] = (f32x4){0.f, 0.f, 0.f, 0.f}; if (st <= w) cbt[st] = mma16(Bs + st * 16 * MB_P, MB_P, Cs + w * 16 * MB_P, MB_P, 128, cbt[st], fr, fq); }
        const bf16* Y1 = (const bf16*)(F.ws + WS_Y1) + ((size_t)b * SEQ + T0) * OD_INP; bf16* YG = (bf16*)(F.ws + WS_YG) + ((size_t)b * SEQ + T0) * 2048;
        v4u pfx[2], pfp[2]; float pfa = 0.f, pfd = 0.f;
#define M3_PREFETCH(hh_) do { const int h_ = g * 8 + (hh_); const bf16* XT_ = (const bf16*)(F.ws + WS_M_XT) + ((size_t)bc * 32 + h_) * 64 * 128; const bf16* PV_ = (const bf16*)(F.ws + WS_M_PV) + ((size_t)bc * 32 + h_) * 64 * 128; \
            _Pragma("unroll") for (int k = 0; k < 2; ++k) { const int i = tid + k * NTHR, p = i >> 4, c8 = i & 15; pfx[k] = *(const GAS v4u*)(XT_ + (size_t)p * 128 + c8 * 8); pfp[k] = *(const GAS v4u*)(PV_ + (size_t)p * 128 + c8 * 8); } \
            if (tid < 128) { pfa = ((const float*)(F.ws + WS_M_ACS))[((size_t)bc * 32 + h_) * 128 + tid]; pfd = ((const float*)(F.ws + WS_M_DTV))[((size_t)bc * 32 + h_) * 128 + tid]; } } while (0)
        M3_PREFETCH(0);
#pragma unroll 1
        for (int hh = 0; hh < 8; ++hh) { const int h = g * 8 + hh; const float dsk = a.in[I_DSKIP][h];
#pragma unroll
            for (int k = 0; k < 2; ++k) { const int i = tid + k * NTHR, p = i >> 4, c8 = i & 15; *(LAS v4u*)(XTs + p * MB_P + c8 * 8) = pfx[k]; *(LAS v4u*)(PVs + p * MB_P + c8 * 8) = pfp[k]; }
            if (tid < 128) { acs[tid] = pfa; dtv[tid] = pfd; }
            __syncthreads();
            if (hh + 1 < 8) M3_PREFETCH(hh + 1);
            unsigned short zz[4][4];
#pragma unroll
            for (int pt = 0; pt < 4; ++pt)
#pragma unroll
                for (int e = 0; e < 4; ++e) zz[pt][e] = Y1[(size_t)(16 * w + 4 * fq + e) * OD_INP + h * 64 + pt * 16 + fr];
            const float aq = acs[16 * w + fr];
#pragma unroll
            for (int st = 0; st < 8; ++st) { if (st <= w) { float mv[4];
#pragma unroll
                for (int e = 0; e < 4; ++e) { const int s = 16 * st + 4 * fq + e; mv[e] = (s <= 16 * w + fr) ? cbt[st][e] * __expf(aq - acs[s]) : 0.f; }
                v2u o; o.x = cvtpk(mv[0], mv[1]); o.y = cvtpk(mv[2], mv[3]); *(LAS v2u*)(Ms + (16 * w + fr) * MB_P + 16 * st + 4 * fq) = o; } }
            if ((w & 1) == 0) *(LAS v2u*)(Ms + (16 * w + fr) * MB_P + 16 * (w + 1) + 4 * fq) = (v2u){0u, 0u};
            LDS_WAIT();
#pragma unroll
            for (int pt = 0; pt < 4; ++pt) { f32x4 yd = {0.f, 0.f, 0.f, 0.f}, yo = {0.f, 0.f, 0.f, 0.f};
                yd = mma16(Ms + w * 16 * MB_P, MB_P, XTs + pt * 16 * MB_P, MB_P, ((w + 2) >> 1) * 32, yd, fr, fq);
                yo = mma16(Cs + w * 16 * MB_P, MB_P, PVs + pt * 16 * MB_P, MB_P, 128, yo, fr, fq);
#pragma unroll
                for (int e = 0; e < 4; ++e) { const int q = 16 * w + 4 * fq + e, p = pt * 16 + fr;
                    const float xs = bf2f(XTs[p * MB_P + q]) * __builtin_amdgcn_rcpf(dtv[q]);
                    const float y = yd[e] + __expf(acs[q]) * yo[e] + dsk * xs;
                    YG[(size_t)q * 2048 + h * 64 + p] = (bf16)f2bf(y * fsilu(bf2f(zz[pt][e]))); } }
            __syncthreads();
        }
#undef M3_PREFETCH
        VM_WAIT(); __syncthreads();
        { const float* gn = a.in[I_ODNORM] + g * 512 + lane * 8; const f32x4 g0 = *(const GAS f32x4*)gn, g1 = *(const GAS f32x4*)(gn + 4);
#pragma unroll 4
          for (int t = 0; t < 16; ++t) { bf16* pq = YG + (size_t)(16 * w + t) * 2048 + g * 512 + lane * 8; const v4u raw = *(const GAS v4u*)pq; float ss = 0.f;
#pragma unroll
              for (int j = 0; j < 4; ++j) { const float x0 = bflo(raw[j]), x1 = bfhi(raw[j]); ss += x0 * x0 + x1 * x1; }
              const float rstd = 1.f / sqrtf(wave_sum(ss) * (1.f / 512.f) + EPS);
              v4u o; o.x = cvtpk(bflo(raw[0]) * rstd * g0[0], bfhi(raw[0]) * rstd * g0[1]); o.y = cvtpk(bflo(raw[1]) * rstd * g0[2], bfhi(raw[1]) * rstd * g0[3]);
              o.z = cvtpk(bflo(raw[2]) * rstd * g1[0], bfhi(raw[2]) * rstd * g1[1]); o.w = cvtpk(bflo(raw[3]) * rstd * g1[2], bfhi(raw[3]) * rstd * g1[3]);
              *(GAS v4u*)pq = o; } }
    }
}
__device__ __forceinline__ void phase_group_norm(const Frame& F, const Args& a) {
    const int gw = F.bid * NWAVES + F.wave, NGW = F.G * NWAVES; bf16* YG = (bf16*)(F.ws + WS_YG); const float* g = a.in[I_ODNORM];
    for (int m = gw; m < M; m += NGW) {
#pragma unroll
        for (int gi = 0; gi < 4; ++gi) { bf16* p = YG + (size_t)m * 2048 + gi * 512 + F.lane * 8; const v4u raw = *(const GAS v4u*)p; float ss = 0.f;
#pragma unroll
            for (int j = 0; j < 4; ++j) { const float x0 = bflo(raw[j]), x1 = bfhi(raw[j]); ss += x0 * x0 + x1 * x1; }
            const float rstd = 1.f / sqrtf(wave_sum(ss) * (1.f / 512.f) + EPS);
            const f32x4 g0 = *(const GAS f32x4*)(g + gi * 512 + F.lane * 8), g1 = *(const GAS f32x4*)(g + gi * 512 + F.lane * 8 + 4);
            v4u o; o.x = cvtpk(bflo(raw[0]) * rstd * g0[0], bfhi(raw[0]) * rstd * g0[1]); o.y = cvtpk(bflo(raw[1]) * rstd * g0[2], bfhi(raw[1]) * rstd * g0[3]);
            o.z = cvtpk(bflo(raw[2]) * rstd * g1[0], bfhi(raw[2]) * rstd * g1[1]); o.w = cvtpk(bflo(raw[3]) * rstd * g1[2], bfhi(raw[3]) * rstd * g1[3]);
            *(GAS v4u*)p = o; }
    }
}
constexpr int MOE_TAB = 131072;
static_assert(MOE_TAB + (32 + MOE_TILES + 24) * 4 <= SCR_BYTES, "moe lds");
__device__ __forceinline__ void phase_route(const Frame& F, const Args& a, const float* x) {
    LAS int* cntS = (LAS int*)F.lds;
    if (F.tid < 8) cntS[F.tid] = 0;
    __syncthreads();
    const float* g = a.in[I_NFFN] + D; const float* router = a.in[I_ROUTER]; bf16* XN = (bf16*)(F.ws + WS_XN);
    int* tokE = (int*)(F.ws + WS_MOEIDX); float* tokW = (float*)(F.ws + WS_MOEIDX + 1 * MiB);
    const int per = M / F.G;
    for (int i = F.wave; i < per; i += NWAVES) { const int m = F.bid * per + i;
        const GAS f32x4* xr = (const GAS f32x4*)(x + (size_t)m * D) + F.lane; const GAS f32x4* gr = (const GAS f32x4*)g + F.lane;
        f32x4 v[4]; float s = 0.f;
#pragma unroll
        for (int j = 0; j < 4; ++j) { v[j] = xr[64 * j]; s += (v[j].x * v[j].x + v[j].y * v[j].y) + (v[j].z * v[j].z + v[j].w * v[j].w); }
        const float rstd = 1.f / sqrtf(wave_sum(s) * (1.f / D) + EPS);
        float lg[8];
#pragma unroll
        for (int e = 0; e < 8; ++e) lg[e] = 0.f;
        GAS unsigned long long* o8 = (GAS unsigned long long*)(XN + (size_t)m * D) + F.lane;
#pragma unroll
        for (int j = 0; j < 4; ++j) { const f32x4 gg = gr[64 * j]; f32x4 hn = v[j] * rstd * gg;
            o8[64 * j] = (unsigned long long)pk2(hn.x, hn.y) | ((unsigned long long)pk2(hn.z, hn.w) << 32);
#pragma unroll
            for (int q = 0; q < 4; ++q) { const int k = 256 * j + 4 * F.lane + q; const f32x4 r0 = *(const GAS f32x4*)(router + (size_t)k * 8), r1 = *(const GAS f32x4*)(router + (size_t)k * 8 + 4);
#pragma unroll
                for (int e = 0; e < 4; ++e) { lg[e] += hn[q] * r0[e]; lg[4 + e] += hn[q] * r1[e]; } } }
#pragma unroll
        for (int e = 0; e < 8; ++e) lg[e] = wave_sum(lg[e]);
        int e1 = 0; float v1 = lg[0];
#pragma unroll
        for (int e = 1; e < 8; ++e) if (lg[e] > v1) { v1 = lg[e]; e1 = e; }
        int e2 = (e1 + 1) & 7; float v2 = -3.0e38f;
#pragma unroll
        for (int e = 0; e < 8; ++e) if (e != e1 && lg[e] > v2) { v2 = lg[e]; e2 = e; }
        if (F.lane == 0) { const float w1 = 1.f / (1.f + __expf(v2 - v1)); tokE[2 * m] = e1; tokE[2 * m + 1] = e2; tokW[2 * m] = w1; tokW[2 * m + 1] = 1.f - w1;
            atomicAdd((int*)cntS + e1, 1); atomicAdd((int*)cntS + e2, 1); }
    }
    __syncthreads();
    if (F.tid < 8) ((int*)(F.ctl + CW_MOECNT))[F.bid * 8 + F.tid] = cntS[F.tid];
    __syncthreads();
}
__device__ __forceinline__ void moe_layout(const Frame& F) {
    LAS int* tab = (LAS int*)(F.lds + MOE_TAB); const int* cnt = (const int*)(F.ctl + CW_MOECNT);
    if (F.tid < 16) tab[F.tid < 8 ? F.tid : 32 + MOE_TILES + F.tid] = 0;
    __syncthreads();
    { const int e = F.tid & 7; int tot = 0, pre = 0;
      for (int wg = F.tid >> 3; wg < F.G; wg += NTHR / 8) { const int c = cnt[wg * 8 + e]; tot += c; if (wg < F.bid) pre += c; }
      atomicAdd((int*)tab + e, tot); atomicAdd((int*)tab + 32 + MOE_TILES + 8 + e, pre); }
    __syncthreads();
    if (F.tid == 0) { int row = 0, tl = 0; for (int e = 0; e < 8; ++e) { const int nt = (tab[e] + 255) >> 8; tab[8 + e] = row; tab[16 + e] = nt; for (int i = 0; i < nt; ++i) tab[32 + tl + i] = e; tl += nt; row += nt * 256; } tab[24] = tl; }
    __syncthreads();
}
__device__ __forceinline__ void phase_scatter(const Frame& F) {
    moe_layout(F);
    LAS int* tab = (LAS int*)(F.lds + MOE_TAB); LAS int* slotS = (LAS int*)F.lds;
    const int per = M / F.G;
    const int* tokE = (const int*)(F.ws + WS_MOEIDX); int* tokS = (int*)(F.ws + WS_MOEIDX + 2 * MiB);
    if (F.wave == 0) { const int E0 = tokE[(size_t)F.bid * per * 2 + F.lane], E1 = tokE[(size_t)F.bid * per * 2 + 64 + F.lane]; int s0 = 0, s1 = 0;
        const unsigned long long lt = (1ull << F.lane) - 1ull;
#pragma unroll
        for (int e = 0; e < 8; ++e) { const unsigned long long m0 = __ballot(E0 == e), m1 = __ballot(E1 == e); const int base = tab[8 + e] + tab[32 + MOE_TILES + 8 + e];
            if (E0 == e) s0 = base + __popcll(m0 & lt); if (E1 == e) s1 = base + __popcll(m0) + __popcll(m1 & lt); }
        slotS[F.lane] = s0; slotS[64 + F.lane] = s1; tokS[(size_t)F.bid * per * 2 + F.lane] = s0; tokS[(size_t)F.bid * per * 2 + 64 + F.lane] = s1; }
    __syncthreads();
    const bf16* XN = (const bf16*)(F.ws + WS_XN); unsigned char* XP = F.ws + WS_XP;
    for (int i = F.wave; i < per * 2; i += NWAVES) { const int m = F.bid * per + (i >> 1); const int sl = slotS[i];
        const GAS v4u* src = (const GAS v4u*)(XN + (size_t)m * D) + F.lane; GAS v2u* dst = (GAS v2u*)(XP + (size_t)sl * D) + F.lane;
        const v4u s0 = src[0], s1 = src[64]; v2u o0, o1;
        o0.x = pk4_fp8(bflo(s0.x), bfhi(s0.x), bflo(s0.y), bfhi(s0.y)); o0.y = pk4_fp8(bflo(s0.z), bfhi(s0.z), bflo(s0.w), bfhi(s0.w));
        o1.x = pk4_fp8(bflo(s1.x), bfhi(s1.x), bflo(s1.y), bfhi(s1.y)); o1.y = pk4_fp8(bflo(s1.z), bfhi(s1.z), bflo(s1.w), bfhi(s1.w));
        dst[0] = o0; dst[64] = o1; }
    __syncthreads();
}
struct MoeOrder {
    int nN, nwg, G, c; const LAS int* texp;
    __device__ __forceinline__ bool next(int i, pg8::Unit& u) const { const long L = (long)i * G + c; if (L >= nwg) return false; u.pm = (int)(L / nN); u.pn = (int)(L % nN); u.bn = texp[u.pm] * nN + u.pn; u.idx = i; return true; }
    __device__ __forceinline__ void a_ready(const pg8::Unit&) const {}
    __device__ __forceinline__ void done(const pg8::Unit&) const {}
};
struct MoeOrderX {
    int nM, nN, nwg, G, c; const LAS int* texp;
    __device__ __forceinline__ bool next(int i, pg8::Unit& u) const { const long L = (long)i * G + c; if (L >= nwg) return false;
        int wgid = (int)L; { const int q = nwg / 8, r = nwg % 8, xcd = wgid % 8, off = wgid / 8; wgid = (xcd < r ? xcd * (q + 1) : r * (q + 1) + (xcd - r) * q) + off; }
        const int nig = 8 * nN, gid = wgid / nig, fm = gid * 8, gsz = (nM - fm) < 8 ? (nM - fm) : 8;
        u.pm = fm + ((wgid % nig) % gsz); u.pn = (wgid % nig) / gsz; u.bn = texp[u.pm] * nN + u.pn; u.idx = i; return true; }
    __device__ __forceinline__ void a_ready(const pg8::Unit&) const {}
    __device__ __forceinline__ void done(const pg8::Unit&) const {}
};
struct MoeTail { int R, Lo, pm_min; bool split; };
__device__ __forceinline__ MoeTail moe_tail(const LAS int* tab, int G) { MoeTail t; const int U = tab[24] * 4; t.R = U / G; t.Lo = U - t.R * G; t.split = (t.Lo > 0 && t.Lo <= 128 && t.R > 0); t.pm_min = t.split ? (t.R * G) / 4 : (1 << 30); return t; }
struct MoeTailOrder { int pm, pn, bn; bool has;
    __device__ __forceinline__ bool next(int i, pg8::Unit& u) const { if (i > 0 || !has) return false; u.pm = pm; u.pn = pn; u.bn = bn; u.idx = 0; return true; }
    __device__ __forceinline__ void a_ready(const pg8::Unit&) const {}
    __device__ __forceinline__ void done(const pg8::Unit&) const {} };
constexpr size_t MOE_PART_STRIDE = (size_t)32 * 256 * 1024;
__device__ __forceinline__ void phase_moe_combine(const Frame& F, const float* x, float* xo) {
    moe_layout(F); const MoeTail mt = moe_tail((const LAS int*)(F.lds + MOE_TAB), F.G); const int srow = mt.pm_min == (1 << 30) ? (1 << 30) : mt.pm_min * 256; const float* PART = (const float*)(F.ws + WS_XP);
    const int gw = F.bid * NWAVES + F.wave, NGW = F.G * NWAVES;
    const float* tokW = (const float*)(F.ws + WS_MOEIDX + 1 * MiB); const int* tokS = (const int*)(F.ws + WS_MOEIDX + 2 * MiB); const int* tokE = (const int*)(F.ws + WS_MOEIDX);
    const float* YP = (const float*)(F.ws + WS_YP);
    for (int m = gw; m < M; m += NGW) { const int s0 = tokS[2 * m], s1 = tokS[2 * m + 1]; const float w0 = tokW[2 * m] * (1.f / MOE_W2_SCALE), w1 = tokW[2 * m + 1] * (1.f / MOE_W2_SCALE)  ; const bool sw = tokE[2 * m] > tokE[2 * m + 1];
        const GAS f32x4* xr = (const GAS f32x4*)(x + (size_t)m * D) + F.lane; GAS f32x4* xw = (GAS f32x4*)(xo + (size_t)m * D) + F.lane; const GAS f32x4* y0 = (const GAS f32x4*)(YP + (size_t)s0 * D) + F.lane; const GAS f32x4* y1 = (const GAS f32x4*)(YP + (size_t)s1 * D) + F.lane;
#pragma unroll
        for (int j = 0; j < 4; ++j) { f32x4 v0, v1;
            if (s0 >= srow) { const GAS f32x4* q = (const GAS f32x4*)(PART + (size_t)(s0 - srow) * D) + F.lane + 64 * j; v0 = q[0] + q[MOE_PART_STRIDE / 4]; } else v0 = y0[64 * j];
            if (s1 >= srow) { const GAS f32x4* q = (const GAS f32x4*)(PART + (size_t)(s1 - srow) * D) + F.lane + 64 * j; v1 = q[0] + q[MOE_PART_STRIDE / 4]; } else v1 = y1[64 * j];
            const f32x4 a0 = v0 * w0, a1 = v1 * w1; xw[64 * j] = xr[64 * j] + (sw ? (a1 + a0) : (a0 + a1)); } }
}
#ifndef MK_PHMASK
#define MK_PHMASK 0xFFFFFFFFFFFFull
#endif
#ifndef MK_DUPMASK
#define MK_DUPMASK 0ull
#endif
#ifndef MK_SPLIT
#define MK_SPLIT 0
#endif
#ifndef MK_LAST_PHASE
#define MK_LAST_PHASE 29
#endif
constexpr int N_PHASES = 30;
#ifndef MK_LB
#define MK_LB 2
#endif
__global__ void __launch_bounds__(NTHR, MK_LB) mega_fwd(Args args) {
    extern __shared__ __attribute__((aligned(16))) unsigned char lds_raw[];
    Frame F;
    F.lds = (LAS unsigned char*)lds_raw; F.MISC = (volatile LAS unsigned*)(F.lds + MISC_OFF);
    F.tid = threadIdx.x; F.lane = F.tid & 63; F.wave = __builtin_amdgcn_readfirstlane(F.tid >> 6); F.G = gridDim.x; F.bid = blockIdx.x;
    F.ws = args.ws; F.ctl = (gu32*)(args.ws + WS_CTL);
    for (int u = F.tid; u < (LDS_BYTES - MISC_OFF) / 4; u += NTHR) ((LAS unsigned*)(F.lds + MISC_OFF))[u] = 0u;
    __syncthreads();
    XcdBarrier bar; bar.bar = (unsigned*)(F.ctl + CW_BAR); bar.x = 0; bar.st = nullptr;
    if (!MK_SPLIT) bar = xcd_barrier_post((unsigned*)(F.ctl + CW_BAR), F.MISC + 8);
    const int lo = args.ph_lo, hi = args.ph_hi;
#define PF() Frame Fp = F; { int t_ = threadIdx.x; asm volatile("" : "+v"(t_)); Fp.tid = t_; Fp.lane = t_ & 63; int w_ = F.wave, b_ = F.bid; asm volatile("" : "+s"(w_), "+s"(b_)); Fp.wave = w_; Fp.bid = b_; }
#define IN(k) ((((unsigned long long)MK_PHMASK >> (k)) & 1ull) && lo <= (k) && (k) < hi)
#define DUP(k) ((((unsigned long long)MK_DUPMASK >> (k)) & 1ull) ? 2 : 1)
#define SEAM(k) do { if (!MK_SPLIT && IN((k) + 1)) xcd_barrier(bar); } while (0)
    unsigned char* ws = args.ws; float* out = args.out;
    const int gw = F.bid * NWAVES + F.wave, NGW = F.G * NWAVES;
    LAS unsigned char* glds = F.lds;
    bf16* XN = (bf16*)(ws + WS_XN);

    if (IN(0)) { PF();
#pragma unroll 1
        for (int rep = 0; rep < DUP(0); ++rep) p0_prologue(Fp, args);
        SEAM(0); }
    if (IN(1)) {
        PF();
#pragma unroll 1
        for (int rep = 0; rep < DUP(1); ++rep) {
        if (F.bid == 0) { float* part = (float*)(ws + WS_CMPB_PART); float s = 0.f; for (int ic = 0; ic < 64; ++ic) s += part[(size_t)((Fp.tid >> 8) * 64 + ic) * 256 + (Fp.tid & 255)]; ((float*)(ws + WS_CMPB))[Fp.tid] = s; }
        { pg8::Gemm g{XN, (const bf16*)(ws + WS_W_EVIN), M, EV_INP, D, D, D}; pg8::StaticOrder S; S.init(M, EV_INP, F.G, F.bid);
          pg8::EpiEvIn E{(bf16*)(ws + WS_Y0), EV_INP, (bf16*)(ws + WS_KV6), SEQ};
          pg8::gemm_phase<pg8::EpiEvIn, pg8::StaticOrder, PG8_ALIGN, PG8_SP2>(glds, g, S, E); }
#pragma unroll 1
        for (int l = 0; l < 2; ++l) { pg8::Gemm g{(const bf16*)(ws + WS_MEMN) + (size_t)l * MMEM * D, (const bf16*)(ws + WS_W_XKV) + (size_t)l * 1024 * D, MMEM, 1024, D, D, D};
          pg8::ListOrder S; S.init(2, 4, 8, F.bid - 192 - 8 * l);
          pg8::EpiBf16<0> E{(bf16*)(ws + WS_KVM) + (size_t)l * MMEM * 1024, 1024, nullptr, nullptr};
          pg8::gemm_phase<pg8::EpiBf16<0>, pg8::ListOrder, PG8_ALIGN, PG8_SP2>(glds, g, S, E); }
        }
        SEAM(1);
    }
    if (IN(2)) {
        PF();
#pragma unroll 1
        for (int rep = 0; rep < DUP(2); ++rep) {
        if (F.bid < 128) { rglru_unit(Fp, args, F.bid >> 6, (F.bid >> 3) & 7, F.bid & 7);
        }
        else if (F.bid < 144) { const int mm = (F.bid - 128) >> 3;
            pg8::Gemm g{(const bf16*)(ws + WS_KV6) + (size_t)mm * 4 * SEQ * 128, (const bf16*)(ws + (mm ? WS_W_CV1 : WS_W_CK1)), 2048, 256, 4096, 2048, 4096};
            pg8::ListOrder S; S.init(8, 1, 8, (F.bid - 128) & 7);
            pg8::EpiBf16<1> E{(bf16*)(ws + WS_HID) + (size_t)mm * 2048 * 256, 256, (const float*)(ws + WS_CMPB) + mm * 256, nullptr};
            pg8::gemm_phase<pg8::EpiBf16<1>, pg8::ListOrder, PG8_ALIGN, PG8_SP2>(glds, g, S, E);
#ifdef MK_DUP_CMP1
            pg8::gemm_phase<pg8::EpiBf16<1>, pg8::ListOrder, PG8_ALIGN, PG8_SP2>(glds, g, S, E);
#endif
            VM_WAIT(); __syncthreads(); { const int u0 = mm * 64 + ((F.bid - 128) & 7) * 8; phase_cmp2(Fp, args, u0, u0 + 8, 1); }
        }
        else if (rep == 0) { const int gw2 = (F.bid - 144) * NWAVES + F.wave, NGW2 = (F.G - 144) * NWAVES;
            bf16* ks = (bf16*)(ws + WS_KV6) + (size_t)2 * 4 * SEQ * 128; bf16* kw = (bf16*)(ws + WS_KV6) + (size_t)4 * 4 * SEQ * 128;
            norm128_rows(Fp, ks, 128, ks, 128, 4 * SEQ, args.in[I_KNORM] + 128, gw2, NGW2);
            norm128_rows(Fp, kw, 128, kw, 128, 4 * SEQ, args.in[I_KNORM] + 256, gw2, NGW2);
            phase_memk_norm(Fp, args, 0, gw2, NGW2); phase_memk_norm(Fp, args, 1, gw2, NGW2); convert_range(Fp, args, gw2, NGW2, CONV_A, CONV_P2_END);
#ifdef MK_DUP_P2CONV
            convert_range(Fp, args, gw2, NGW2, CONV_A + (CONV_P2_END - CONV_A) / 2, CONV_P2_END);
#endif
        }
        }
        SEAM(2);
    }
    if (IN(4)) { PF();
#pragma unroll 1
        for (int rep = 0; rep < DUP(4); ++rep) phase_nsa(Fp, args);
        SEAM(4); }
    if (IN(5)) {
        pg8::Gemm g{(const bf16*)(ws + WS_MIX), (const bf16*)(ws + WS_W_EVOUT), M, D, 2048, 2048, 2048}; pg8::StaticOrder S; S.init(M, D, F.G, F.bid);
#pragma unroll 1
        for (int rep = 0; rep < DUP(5); ++rep) { pg8::EpiResidN E{args.in[I_X], (rep + 1 < DUP(5)) ? (float*)(ws + WS_R + 400 * MiB) : out, D, XN, (float*)(ws + WS_SSQ)};
        pg8::gemm_phase<pg8::EpiResidN, pg8::StaticOrder, PG8_ALIGN, PG8_SP2>(glds, g, S, E); }
        SEAM(5);
#ifdef MK_PROBE_BARS
#pragma unroll 1
        for (int xb = 0; xb < MK_PROBE_BARS; ++xb) xcd_barrier(bar);
#endif
    }
#pragma unroll 1
    for (int l = 0; l < 2; ++l) {
        const int pb = l == 0 ? 6 : 21;
        if (IN(pb + 1)) { pg8::Gemm g{XN, (const bf16*)(ws + WS_W_XQ) + (size_t)l * 512 * D, M, 512, D, D, D}; pg8::StaticOrder S; S.init(M, 512, F.G, F.bid);
            pg8::fill_rstd_table((LAS float*)(F.lds + MOE_TAB), S, (const float*)(ws + WS_SSQ), F.tid);
            pg8::EpiBf16<0> E{(bf16*)(ws + WS_QX), 512, nullptr, (const LAS float*)(F.lds + MOE_TAB)};
#pragma unroll 1
            for (int rep = 0; rep < DUP(7); ++rep) pg8::gemm_phase<pg8::EpiBf16<0>, pg8::StaticOrder, PG8_ALIGN, PG8_SP2>(glds, g, S, E);
            if (F.bid >= 128) { PF(); const int lo_ = CONV_ALL - (2 - l) * CONV_Q;
                convert_range(Fp, args, (F.bid - 128) * NWAVES + F.wave, (F.G - 128) * NWAVES, lo_, lo_ + CONV_Q); }
            SEAM(pb + 1); }
        if (IN(pb + 2)) { PF();
#pragma unroll 1
            for (int rep = 0; rep < DUP(8); ++rep) phase_cross_attn(Fp, args, l);
            SEAM(pb + 2); }
        if (IN(pb + 3)) { pg8::Gemm g{(const bf16*)(ws + WS_OX), (const bf16*)(ws + WS_W_XO) + (size_t)l * D * 512, M, D, 512, 512, 512}; pg8::StaticOrder S; S.init(M, D, F.G, F.bid);
#pragma unroll 1
            for (int rep = 0; rep < DUP(9); ++rep) { pg8::EpiResidN E{out, (rep + 1 < DUP(9)) ? (float*)(ws + WS_R + 400 * MiB) : out, D, l == 0 ? XN : (bf16*)nullptr, (float*)(ws + WS_SSQ)};
            pg8::gemm_phase<pg8::EpiResidN, pg8::StaticOrder, PG8_ALIGN, PG8_SP2>(glds, g, S, E); }
            SEAM(pb + 3); }
        if (l == 0) {
            if (IN(11)) { pg8::Gemm g{XN, (const bf16*)(ws + WS_W_FF13), M, 2 * FF, D, D, D}; pg8::StaticOrder S; S.init(M, 2 * FF, F.G, F.bid);
                pg8::fill_rstd_table((LAS float*)(F.lds + MOE_TAB), S, (const float*)(ws + WS_SSQ), F.tid);
                pg8::EpiSwiglu<false> E{(bf16*)(ws + WS_H), FF, (const LAS float*)(F.lds + MOE_TAB)};
#ifdef MK_PROBE_NULLEPI
                { pg8::EpiNull EN; pg8::gemm_phase<pg8::EpiNull, pg8::StaticOrder, PG8_ALIGN, PG8_SP2>(glds, g, S, EN); }
#endif
#pragma unroll 1
                for (int rep = 0; rep < DUP(11); ++rep) pg8::gemm_phase<pg8::EpiSwiglu<false>, pg8::StaticOrder, PG8_ALIGN, PG8_SP2>(glds, g, S, E);
                SEAM(11); }
            if (IN(12)) { pg8::Gemm g{(const bf16*)(ws + WS_H), (const bf16*)(ws + WS_W_FF2), M, D, FF, FF, FF}; pg8::StaticOrder S; S.init(M, D, F.G, F.bid);
#pragma unroll 1
                for (int rep = 0; rep < DUP(12); ++rep) { pg8::EpiResidN E{out, (rep + 1 < DUP(12)) ? (float*)(ws + WS_R + 400 * MiB) : out, D, XN, (float*)(ws + WS_SSQ)};
                pg8::gemm_phase<pg8::EpiResidN, pg8::StaticOrder, PG8_ALIGN, PG8_SP2>(glds, g, S, E); }
                SEAM(12); }
            if (IN(14)) { pg8::Gemm g{XN, (const bf16*)(ws + WS_W_ODIN), M, 5120, D, D, D}; pg8::StaticOrder S; S.init(M, 5120, F.G, F.bid);
                pg8::fill_rstd_table((LAS float*)(F.lds + MOE_TAB), S, (const float*)(ws + WS_SSQ), F.tid);
                pg8::EpiBf16<0> E{(bf16*)(ws + WS_Y1), OD_INP, nullptr, (const LAS float*)(F.lds + MOE_TAB)};
#pragma unroll 1
                for (int rep = 0; rep < DUP(14); ++rep) pg8::gemm_phase<pg8::EpiBf16<0>, pg8::StaticOrder, PG8_ALIGN, PG8_SP2>(glds, g, S, E);
                od_dt_cols(F, XN, (const bf16*)(ws + WS_W_ODIN), (const float*)(ws + WS_SSQ), (bf16*)(ws + WS_Y1));
                SEAM(14); }
            if (IN(15)) { PF();
#pragma unroll 1
                for (int rep = 0; rep < DUP(15); ++rep) phase_mamba_prep(Fp, args);
                SEAM(15); }
            if (IN(16)) { PF();
#pragma unroll 1
                for (int rep = 0; rep < DUP(16); ++rep) phase_mamba_states(Fp);
                SEAM(16); }
            if (IN(17)) { PF();
#pragma unroll 1
                for (int rep = 0; rep < DUP(17); ++rep) phase_mamba_scan(Fp);
                SEAM(17); }
            if (IN(18)) { PF();
#pragma unroll 1
                for (int rep = 0; rep < DUP(18); ++rep) phase_mamba_out(Fp, args);
                SEAM(18); }
            if (IN(20)) { pg8::Gemm g{(const bf16*)(ws + WS_YG), (const bf16*)(ws + WS_W_ODOUT), M, D, 2048, 2048, 2048}; pg8::StaticOrder S; S.init(M, D, F.G, F.bid);
#pragma unroll 1
                for (int rep = 0; rep < DUP(20); ++rep) { pg8::EpiResidN E{out, (rep + 1 < DUP(20)) ? (float*)(ws + WS_R + 400 * MiB) : out, D, XN, (float*)(ws + WS_SSQ)};
                pg8::gemm_phase<pg8::EpiResidN, pg8::StaticOrder, PG8_ALIGN, PG8_SP2>(glds, g, S, E); }
                SEAM(20); }
        }
    }
    if (IN(25)) { PF();
#pragma unroll 1
        for (int rep = 0; rep < DUP(25); ++rep) phase_route(Fp, args, out);
        SEAM(25); }
    if (IN(26)) { PF();
#pragma unroll 1
        for (int rep = 0; rep < DUP(26); ++rep) phase_scatter(Fp);
        SEAM(26); }
    if (IN(27)) { PF(); moe_layout(Fp); const LAS int* tab = (const LAS int*)(F.lds + MOE_TAB);
        pg8::Gemm g{(const bf16*)(ws + WS_XP), (const bf16*)(ws + WS_W_M13), MOE_ROWS, 2 * FFE, D / 2, D / 2, D / 2}  ; MoeOrderX S{tab[24], 2 * FFE / 256, tab[24] * (2 * FFE / 256), F.G, F.bid, tab + 32};
        pg8::EpiSwiglu<true, false, true> E{(bf16*)(ws + WS_HP), FFE, nullptr, 1.f / MOE_W13_SCALE};
#pragma unroll 1
        for (int rep = 0; rep < DUP(27); ++rep) pg8::gemm_phase<pg8::EpiSwiglu<true, false, true>, MoeOrderX, PG8_ALIGN, PG8_SP2, true>(glds, g, S, E);
        SEAM(27); }
    if (IN(28)) { PF(); moe_layout(Fp); const LAS int* tab = (const LAS int*)(F.lds + MOE_TAB);
        const MoeTail mt = moe_tail(tab, F.G);
        pg8::Gemm g{(const bf16*)(ws + WS_HP), (const bf16*)(ws + WS_W_M2), MOE_ROWS, D, FFE / 2, FFE / 2, FFE / 2}  ; MoeOrder S{D / 256, mt.split ? mt.R * F.G : tab[24] * (D / 256), F.G, F.bid, tab + 32};
        pg8::EpiF32 E{(float*)(ws + WS_YP), D};
#pragma unroll 1
        for (int rep = 0; rep < DUP(28); ++rep) pg8::gemm_phase<pg8::EpiF32, MoeOrder, PG8_ALIGN, PG8_SP2, true>(glds, g, S, E);
        if (mt.split) {
            const int piece = F.bid, L = mt.R * F.G + (piece >> 1), kq = piece & 1, pm = L / 4, pn = L % 4;
            MoeTailOrder S2{pm, pn, piece < mt.Lo * 2 ? tab[32 + pm] * 4 + pn : 0, piece < mt.Lo * 2};
            pg8::Gemm g2{(const bf16*)(ws + WS_HP) + kq * (FFE / 4), (const bf16*)(ws + WS_W_M2) + kq * (FFE / 4), MOE_ROWS, D, FFE / 4, FFE / 2, FFE / 2};
            pg8::EpiF32 E2{(float*)(ws + WS_XP) + (size_t)kq * MOE_PART_STRIDE - (size_t)mt.pm_min * 256 * D, D};
            pg8::gemm_phase<pg8::EpiF32, MoeTailOrder, PG8_ALIGN, PG8_SP2, true>(glds, g2, S2, E2); }
        SEAM(28); }
    if (IN(29)) { PF();
#pragma unroll 1
        for (int rep = 0; rep < DUP(29); ++rep) phase_moe_combine(Fp, out, (rep + 1 < DUP(29)) ? (float*)(ws + WS_H) : out); }
#undef IN
#undef SEAM
}

extern "C" void kernel_launch(void* const* d_in, const int* in_sizes, int n_in, void* d_out, int out_size, void* d_ws, size_t ws_size, hipStream_t stream) {
    static int grid = 0;
    if (grid == 0) {
        if (n_in != N_IN || in_sizes[0] != M * D || out_size != M * D || ws_size < (WS_M_END > WS_END ? WS_M_END : WS_END)) { fprintf(stderr, "kernel_launch: unexpected problem (n_in %d, in0 %d, out %d, ws %zu < %zu); nothing launched\n", n_in, n_in > 0 ? in_sizes[0] : -1, out_size, ws_size, (size_t)WS_END); grid = -1; return; }
        int dev = 0, cus = 0, per_cu = 0;
        if (hipGetDevice(&dev) != hipSuccess || hipDeviceGetAttribute(&cus, hipDeviceAttributeMultiprocessorCount, dev) != hipSuccess) { fprintf(stderr, "kernel_launch: device query failed\n"); grid = -1; return; }
        if (hipFuncSetAttribute((const void*)mega_fwd, hipFuncAttributeMaxDynamicSharedMemorySize, LDS_BYTES) != hipSuccess) { fprintf(stderr, "kernel_launch: hipFuncSetAttribute(%d B LDS) failed\n", LDS_BYTES); grid = -1; return; }
        if (hipOccupancyMaxActiveBlocksPerMultiprocessor(&per_cu, (const void*)mega_fwd, NTHR, LDS_BYTES) != hipSuccess || per_cu < 1) fprintf(stderr, "kernel_launch: note: occupancy query reports %d workgroups per CU\n", per_cu);
        (void)hipGetLastError();
        if (cus < 256) { fprintf(stderr, "kernel_launch: %d CUs < 256: the persistent grid of 256 workgroups would not be resident; nothing launched\n", cus); grid = -1; return; }
        grid = 256;
    }
    if (grid < 0) return;
    if (hipMemsetAsync((char*)d_ws + WS_CTL, 0, CTL_ZERO_BYTES, stream) != hipSuccess) { fprintf(stderr, "kernel_launch: memset failed\n"); return; }
    Args a{};
    for (int i = 0; i < N_IN; ++i) a.in[i] = (const float*)d_in[i];
    a.out = (float*)d_out; a.ws = (unsigned char*)d_ws;
#if MK_SPLIT
    for (int p = 0; p <= MK_LAST_PHASE && p < N_PHASES; ++p) { a.ph_lo = p; a.ph_hi = p + 1; a.li = p; hipLaunchKernelGGL(mega_fwd, dim3(grid), dim3(NTHR), LDS_BYTES, stream, a); }
#else
    a.ph_lo = 0; a.ph_hi = MK_LAST_PHASE + 1; a.li = 0;
    hipLaunchKernelGGL(mega_fwd, dim3(grid), dim3(NTHR), LDS_BYTES, stream, a);
#endif
    const hipError_t le = hipPeekAtLastError();
    if (le != hipSuccess) fprintf(stderr, "kernel_launch: launch failed: %s\n", hipGetErrorName(le));
}
```

```cpp
#include <hip/hip_runtime.h>
#include <cstdio>
#include <cstdint>

namespace pg8 {
#define PG8_LAS __attribute__((address_space(3)))
typedef unsigned short bf16_t;
typedef short bf16x8 __attribute__((ext_vector_type(8)));
typedef float f32x4 __attribute__((ext_vector_type(4)));
typedef unsigned u32x4 __attribute__((ext_vector_type(4)));
typedef unsigned u32x2 __attribute__((ext_vector_type(2)));
constexpr int BM = 256, BK = 64, HALF = 128, HTB = HALF * BK * 2  , STAGE_BYTES = 8 * HTB, NXCD = 8, WGM = 8;

__host__ __device__ __forceinline__ int lds_byte(int r, int c) { const int st = (r >> 4) * 2 + (c >> 5), rr = r & 15, cc = c & 31, ob = rr * 64 + cc * 2; return st * 1024 + (ob ^ (((ob >> 9) & 1) << 5)); }
__host__ __device__ __forceinline__ void stage_rc(int b, int& R, int& C) { const int st = b / 1024, sb = b % 1024, swz = sb ^ (((sb >> 9) & 1) << 5); R = (st >> 1) * 16 + swz / 64; C = (st & 1) * 32 + (swz % 64) / 2; }
__host__ __device__ __forceinline__ int perm32(int rho) { const int n = rho >> 4, i = rho & 15; return 8 * (i >> 2) + 4 * n + (i & 3); }

typedef int i32x8 __attribute__((ext_vector_type(8)));
typedef int i32x4 __attribute__((ext_vector_type(4)));
__device__ __forceinline__ i32x8 cat8(bf16x8 lo, bf16x8 hi) { const i32x4 a = __builtin_bit_cast(i32x4, lo), b = __builtin_bit_cast(i32x4, hi); return __builtin_shufflevector(a, b, 0, 1, 2, 3, 4, 5, 6, 7); }
__device__ __forceinline__ void mfma_f8_inplace(f32x4& acc, i32x8 a, i32x8 b) { asm volatile("v_mfma_f32_16x16x128_f8f6f4 %0, %1, %2, %0" : "+v"(acc) : "v"(a), "v"(b)); }
struct Unit { int pm, pn, bn, idx; };
struct Gemm { const bf16_t* A; const bf16_t* Bt; int M, N, K, lda, ldb; };

struct StaticOrder {
    int nM, nN, nwg, G, c;
    __host__ __device__ void init(int M, int N, int G_, int c_) { nM = M / BM; nN = N / BM; nwg = nM * nN; G = G_; c = c_; }
    __host__ __device__ bool next(int i, Unit& u) const {
        const long L = (long)i * G + c; if (L >= nwg) return false;
        int wgid = (int)L; { const int q = nwg / NXCD, r = nwg % NXCD, xcd = wgid % NXCD, off = wgid / NXCD; wgid = (xcd < r ? xcd * (q + 1) : r * (q + 1) + (xcd - r) * q) + off; }
        const int nig = WGM * nN, gid = wgid / nig, fm = gid * WGM, gsz = (nM - fm) < WGM ? (nM - fm) : WGM;
        u.pm = fm + ((wgid % nig) % gsz); u.pn = (wgid % nig) / gsz; u.bn = u.pn; u.idx = i; return true;
    }
    __device__ __forceinline__ void a_ready(const Unit&) const {}
    __device__ __forceinline__ void done(const Unit&) const {}
};
struct ListOrder {
    int nN, nwg, G, c;
    __host__ __device__ void init(int nM_, int nN_, int G_, int c_) { nN = nN_; nwg = nM_ * nN_; G = G_; c = c_; }
    __host__ __device__ bool next(int i, Unit& u) const { const long L = (long)i * G + c; if (c < 0 || L >= nwg) return false; u.pm = (int)(L / nN); u.pn = (int)(L % nN); u.bn = u.pn; u.idx = i; return true; }
    __device__ __forceinline__ void a_ready(const Unit&) const {}
    __device__ __forceinline__ void done(const Unit&) const {}
};

__device__ __forceinline__ unsigned cvt_pk_bf16(float lo, float hi) { unsigned r; asm volatile("v_cvt_pk_bf16_f32 %0, %1, %2" : "=v"(r) : "v"(lo), "v"(hi)); return r; }
__device__ __forceinline__ unsigned cvt4_fp8(float a, float b, float c, float d) { int r = __builtin_amdgcn_cvt_pk_fp8_f32(a, b, 0, false); r = __builtin_amdgcn_cvt_pk_fp8_f32(c, d, r, true); return (unsigned)r; }
__device__ __forceinline__ float fsigmoid(float x) { return __builtin_amdgcn_rcpf(1.0f + __expf(-x)); }
__device__ __forceinline__ float gelu_tanh(float x) { const float u = 1.5957691216f * (x + 0.044715f * x * x * x); return x * fsigmoid(u); }
__device__ __forceinline__ float fsilu(float x) { return x * fsigmoid(x); }

__device__ __forceinline__ float row_rstd(const float* ssq, int row) {
    const f32x4 a = *(const f32x4*)(ssq + (size_t)row * 16), b = *(const f32x4*)(ssq + (size_t)row * 16 + 4), c = *(const f32x4*)(ssq + (size_t)row * 16 + 8), d = *(const f32x4*)(ssq + (size_t)row * 16 + 12);
    const f32x4 s = (a + b) + (c + d); return 1.0f / sqrtf(((s[0] + s[1]) + (s[2] + s[3])) * (1.0f / 1024.0f) + 1e-6f);
}
template <class Sched> __device__ __forceinline__ void fill_rstd_table(PG8_LAS float* tab, const Sched& S, const float* ssq, int tid) {
    Unit u; for (int i = 0; S.next(i, u); ++i) if (tid < 256) { const int ai = tid >> 7, wr = (tid >> 6) & 1, m = (tid >> 4) & 3, fr = tid & 15; tab[i * 256 + ((ai * 2 + wr) * 16 + fr) * 4 + m] = row_rstd(ssq, u.pm * BM + tid); }
    __syncthreads();
}
template <int ACT, bool SPLIT_ = false> struct EpiBf16 {
    static constexpr bool PERM = true, AFTER_DRAIN = false, SPLIT = SPLIT_, PACK = false; static constexpr int NST = 16; struct Pk {};
    bf16_t* O; int ldc; const float* bias; const PG8_LAS float* rsT;
    __device__ __forceinline__ void operator()(const f32x4 (&acc)[2][2][4][2], const Unit& u, int wr, int wc, int fr, int fq) const { half<0>(acc, u, wr, wc, fr, fq); half<1>(acc, u, wr, wc, fr, fq); }
    template <int AI> __device__ __forceinline__ void half(const f32x4 (&acc)[2][2][4][2], const Unit& u, int wr, int wc, int fr, int fq) const {
        const int row0 = u.pm * BM + wr * 64 + fr; const int col0 = u.pn * BM + wc * 32 + 8 * fq;
        f32x4 bv[2][2];
#pragma unroll
        for (int bj = 0; bj < 2; ++bj)
#pragma unroll
            for (int n = 0; n < 2; ++n) bv[bj][n] = bias ? *(const f32x4*)(bias + col0 + bj * HALF + 4 * n) : (f32x4){0.f, 0.f, 0.f, 0.f};
        { constexpr int ai = AI; const f32x4 rs4 = rsT ? *(const PG8_LAS f32x4*)(rsT + u.idx * 256 + ((ai * 2 + wr) * 16 + fr) * 4) : (f32x4){1.f, 1.f, 1.f, 1.f};
#pragma unroll
            for (int m = 0; m < 4; ++m) { bf16_t* rowp = O + (size_t)(row0 + ai * HALF + m * 16) * ldc + col0; const float rs = rs4[m];
#pragma unroll
                for (int bj = 0; bj < 2; ++bj) { f32x4 v0 = acc[ai][bj][m][0] * rs + bv[bj][0], v1 = acc[ai][bj][m][1] * rs + bv[bj][1];
                    if (ACT == 1) {
#pragma unroll
                        for (int j = 0; j < 4; ++j) { v0[j] = gelu_tanh(v0[j]); v1[j] = gelu_tanh(v1[j]); } }
                    u32x4 w; w.x = cvt_pk_bf16(v0[0], v0[1]); w.y = cvt_pk_bf16(v0[2], v0[3]); w.z = cvt_pk_bf16(v1[0], v1[1]); w.w = cvt_pk_bf16(v1[2], v1[3]);
                    *(u32x4*)(rowp + bj * HALF) = w; } } }
    }
};
struct EpiEvIn {
    static constexpr bool PERM = true, AFTER_DRAIN = false, SPLIT = true, PACK = false; static constexpr int NST = 16; struct Pk {};
    bf16_t* O; int ldc; bf16_t* KV6; int S;
    __device__ __forceinline__ void operator()(const f32x4 (&acc)[2][2][4][2], const Unit& u, int wr, int wc, int fr, int fq) const { half<0>(acc, u, wr, wc, fr, fq); half<1>(acc, u, wr, wc, fr, fq); }
    template <int AI> __device__ __forceinline__ void half(const f32x4 (&acc)[2][2][4][2], const Unit& u, int wr, int wc, int fr, int fq) const {
        const int row0 = u.pm * BM + wr * 64 + fr; const int col0 = u.pn * BM + wc * 32 + 8 * fq;
        const bool kv = (u.pn >= 12 && u.pn < 18);
        { constexpr int ai = AI;
#pragma unroll
            for (int m = 0; m < 4; ++m) { const int row = row0 + ai * HALF + m * 16;
#pragma unroll
                for (int bj = 0; bj < 2; ++bj) { const f32x4 v0 = acc[ai][bj][m][0], v1 = acc[ai][bj][m][1];
                    u32x4 w; w.x = cvt_pk_bf16(v0[0], v0[1]); w.y = cvt_pk_bf16(v0[2], v0[3]); w.z = cvt_pk_bf16(v1[0], v1[1]); w.w = cvt_pk_bf16(v1[2], v1[3]);
                    if (kv) { const int b = row / S, t = row - b * S;
                        bf16_t* p = KV6 + ((((size_t)(u.pn - 12) * 2 + b) * 2 + bj) * S + t) * 128 + wc * 32 + 8 * fq; *(u32x4*)p = w; }
                    else *(u32x4*)(O + (size_t)row * ldc + col0 + bj * HALF) = w; } } }
    }
};
struct EpiResid {
    static constexpr bool PERM = false, AFTER_DRAIN = false, SPLIT = false, PACK = false; static constexpr int NST = 0; struct Pk {};
    const float* base; float* out; int ldc;
    __device__ __forceinline__ void operator()(const f32x4 (&acc)[2][2][4][2], const Unit& u, int wr, int wc, int fr, int fq) const {
        const int row0 = u.pm * BM + wr * 64 + fr, col0 = u.pn * BM + wc * 32 + 4 * fq;
#pragma unroll
        for (int ai = 0; ai < 2; ++ai)
#pragma unroll
            for (int m = 0; m < 4; ++m) { const size_t off = (size_t)(row0 + ai * HALF + m * 16) * ldc + col0;
#pragma unroll
                for (int bj = 0; bj < 2; ++bj)
#pragma unroll
                    for (int n = 0; n < 2; ++n) { const f32x4 b = *(const f32x4*)(base + off + bj * HALF + n * 16); *(f32x4*)(out + off + bj * HALF + n * 16) = b + acc[ai][bj][m][n]; } }
    }
};
struct EpiResidN {
    static constexpr bool PERM = false, AFTER_DRAIN = false, SPLIT = false, PACK = false; static constexpr int NST = 0; struct Pk {};
    const float* base; float* out; int ldc; bf16_t* XB; float* SSQ;
    __device__ __forceinline__ void operator()(const f32x4 (&acc)[2][2][4][2], const Unit& u, int wr, int wc, int fr, int fq) const {
        const int row0 = u.pm * BM + wr * 64 + fr, col0 = u.pn * BM + wc * 32 + 4 * fq;
#pragma unroll
        for (int ai = 0; ai < 2; ++ai)
#pragma unroll
            for (int m = 0; m < 4; ++m) { const int row = row0 + ai * HALF + m * 16; const size_t off = (size_t)row * ldc + col0; float ss = 0.f;
#pragma unroll
                for (int bj = 0; bj < 2; ++bj)
#pragma unroll
                    for (int n = 0; n < 2; ++n) { const f32x4 b = *(const f32x4*)(base + off + bj * HALF + n * 16); const f32x4 v = b + acc[ai][bj][m][n]; *(f32x4*)(out + off + bj * HALF + n * 16) = v;
                        if (XB) { u32x2 w; w.x = cvt_pk_bf16(v[0], v[1]); w.y = cvt_pk_bf16(v[2], v[3]); *(u32x2*)(XB + off + bj * HALF + n * 16) = w; }
                        ss += (v[0] * v[0] + v[1] * v[1]) + (v[2] * v[2] + v[3] * v[3]); }
                ss += __shfl_xor(ss, 16); ss += __shfl_xor(ss, 32);
                if (XB && fq == 0) SSQ[(size_t)row * 16 + u.pn * 4 + wc] = ss; }
    }
};
struct EpiNull {
    static constexpr bool PERM = false, AFTER_DRAIN = false, SPLIT = false, PACK = false; static constexpr int NST = 0; struct Pk {};
    __device__ __forceinline__ void operator()(const f32x4 (&acc)[2][2][4][2], const Unit&, int, int, int, int) const {
#pragma unroll
        for (int ai = 0; ai < 2; ++ai)
#pragma unroll
            for (int bj = 0; bj < 2; ++bj)
#pragma unroll
                for (int m = 0; m < 4; ++m)
#pragma unroll
                    for (int n = 0; n < 2; ++n) asm volatile("" :: "v"(acc[ai][bj][m][n]));
    }
};
struct EpiF32 {
    static constexpr bool PERM = false, AFTER_DRAIN = false, SPLIT = false, PACK = false; static constexpr int NST = 0; struct Pk {};
    float* C; int ldc;
    __device__ __forceinline__ void operator()(const f32x4 (&acc)[2][2][4][2], const Unit& u, int wr, int wc, int fr, int fq) const {
        const int row0 = u.pm * BM + wr * 64 + fr, col0 = u.pn * BM + wc * 32 + 4 * fq;
#pragma unroll
        for (int ai = 0; ai < 2; ++ai)
#pragma unroll
            for (int m = 0; m < 4; ++m) { float* rowp = C + (size_t)(row0 + ai * HALF + m * 16) * ldc + col0;
#pragma unroll
                for (int bj = 0; bj < 2; ++bj)
#pragma unroll
                    for (int n = 0; n < 2; ++n) *(f32x4*)(rowp + bj * HALF + n * 16) = acc[ai][bj][m][n]; }
    }
};
template <bool SPLIT_, bool PACK_ = false, bool F8O_ = false> struct EpiSwiglu {
    static_assert(!(PACK_ && F8O_), "no packed fp8 form");
    static constexpr bool PERM = true, AFTER_DRAIN = false, SPLIT = SPLIT_, PACK = PACK_; static constexpr int NST = 8;
    bf16_t* H; int ldh; const PG8_LAS float* rsT; float sc = 1.f;
    __device__ __forceinline__ void operator()(const f32x4 (&acc)[2][2][4][2], const Unit& u, int wr, int wc, int fr, int fq) const { half<0>(acc, u, wr, wc, fr, fq); half<1>(acc, u, wr, wc, fr, fq); }
    struct Pk { u32x4 w[4]; };
    __device__ __forceinline__ void pack1(const f32x4 (&acc)[2][2][4][2], const Unit& u, int wr, int fr, Pk& pk) const {
        constexpr int ai = 1; const f32x4 rs4 = rsT ? *(const PG8_LAS f32x4*)(rsT + u.idx * 256 + ((ai * 2 + wr) * 16 + fr) * 4) : (f32x4){1.f, 1.f, 1.f, 1.f};
#pragma unroll
        for (int m = 0; m < 4; ++m) { const float rs = rs4[m] * sc;
            const f32x4 u0 = acc[ai][0][m][0] * rs, u1 = acc[ai][0][m][1] * rs, g0 = acc[ai][1][m][0] * rs, g1 = acc[ai][1][m][1] * rs;
            pk.w[m].x = cvt_pk_bf16(fsilu(g0[0]) * u0[0], fsilu(g0[1]) * u0[1]); pk.w[m].y = cvt_pk_bf16(fsilu(g0[2]) * u0[2], fsilu(g0[3]) * u0[3]);
            pk.w[m].z = cvt_pk_bf16(fsilu(g1[0]) * u1[0], fsilu(g1[1]) * u1[1]); pk.w[m].w = cvt_pk_bf16(fsilu(g1[2]) * u1[2], fsilu(g1[3]) * u1[3]); }
    }
    __device__ __forceinline__ void store1(const Pk& pk, const Unit& u, int wr, int wc, int fr, int fq) const {
        bf16_t* p = H + (size_t)(u.pm * BM + wr * 64 + fr + HALF) * ldh + u.pn * 128 + wc * 32 + 8 * fq;
#pragma unroll
        for (int m = 0; m < 4; ++m) *(u32x4*)(p + (size_t)(m * 16) * ldh) = pk.w[m];
    }
    template <int AI> __device__ __forceinline__ void half(const f32x4 (&acc)[2][2][4][2], const Unit& u, int wr, int wc, int fr, int fq) const {
        const int row0 = u.pm * BM + wr * 64 + fr, col0 = u.pn * 128 + wc * 32 + 8 * fq;
        constexpr int ai = AI; const f32x4 rs4 = rsT ? *(const PG8_LAS f32x4*)(rsT + u.idx * 256 + ((ai * 2 + wr) * 16 + fr) * 4) : (f32x4){1.f, 1.f, 1.f, 1.f};
#pragma unroll
        for (int m = 0; m < 4; ++m) { bf16_t* rowp = H + (size_t)(row0 + ai * HALF + m * 16) * ldh + col0; const float rs = rs4[m] * sc;
            const f32x4 u0 = acc[ai][0][m][0] * rs, u1 = acc[ai][0][m][1] * rs, g0 = acc[ai][1][m][0] * rs, g1 = acc[ai][1][m][1] * rs;
            if constexpr (F8O_) { u32x2 w; w.x = cvt4_fp8(fsilu(g0[0]) * u0[0], fsilu(g0[1]) * u0[1], fsilu(g0[2]) * u0[2], fsilu(g0[3]) * u0[3]);
                w.y = cvt4_fp8(fsilu(g1[0]) * u1[0], fsilu(g1[1]) * u1[1], fsilu(g1[2]) * u1[2], fsilu(g1[3]) * u1[3]);
                *(u32x2*)((unsigned char*)H + (size_t)(row0 + ai * HALF + m * 16) * ldh + col0) = w; }
            else { u32x4 w; w.x = cvt_pk_bf16(fsilu(g0[0]) * u0[0], fsilu(g0[1]) * u0[1]); w.y = cvt_pk_bf16(fsilu(g0[2]) * u0[2], fsilu(g0[3]) * u0[3]);
            w.z = cvt_pk_bf16(fsilu(g1[0]) * u1[0], fsilu(g1[1]) * u1[1]); w.w = cvt_pk_bf16(fsilu(g1[2]) * u1[2], fsilu(g1[3]) * u1[3]);
            *(u32x4*)rowp = w; } }
    }
};
__host__ __device__ __forceinline__ int swiglu_row(int h, int gate) { return (h >> 7) * 256 + gate * 128 + (h & 127); }

template <class Epi, class Sched, bool ALIGN_EPI = false, bool SP2 = false, bool F8 = false>
__device__ __forceinline__ void gemm_phase(PG8_LAS unsigned char* lds, const Gemm g, const Sched& S, const Epi& E) {
    int tid = threadIdx.x; asm volatile("" : "+v"(tid));
    const int wid = __builtin_amdgcn_readfirstlane(tid >> 6), lane = tid & 63, wr = wid >> 2, wc = wid & 3, fr = lane & 15, fq = lane >> 4;
    const int K = g.K, nt = K / BK;
    unsigned voffA, voffB;
    { int R, C; stage_rc(tid * 16, R, C); const int Rb = Epi::PERM ? ((R & ~31) + perm32(R & 31)) : R;
      voffA = (unsigned)(R * g.lda + C) * 2u; voffB = (unsigned)(Rb * g.ldb + C) * 2u; }
    const size_t q64A = (size_t)64 * g.lda * 2, q64B = (size_t)64 * g.ldb * 2;
    const size_t kstep = (size_t)(BK * 2);
    const size_t hstepA = (size_t)HALF * g.lda * 2, hstepB = (size_t)HALF * g.ldb * 2;
    const size_t tstepA = 2 * hstepA, tstepB = 2 * hstepB;
    const unsigned ldsw = (unsigned)wid * 1024u;
    const int aoff = lds_byte(wr * 64 + fr, fq * 8), boff = lds_byte(wc * 32 + fr, fq * 8);
#define PG8_SA(b, h) (((b) * 2 + (h)) * HTB)
#define PG8_SB(b, h) ((4 + (b) * 2 + (h)) * HTB)
#define PG8_STAGE(bufoff, gbase, voff) do { __builtin_amdgcn_global_load_lds((const unsigned*)((const char*)(gbase) + (voff)), (PG8_LAS unsigned*)(lds + (bufoff) + ldsw), 16, 0, 0); \
        __builtin_amdgcn_global_load_lds((const unsigned*)((const char*)(gbase) + PG8_Q64(voff) + (voff)), (PG8_LAS unsigned*)(lds + (bufoff) + ldsw + 8192), 16, 0, 0); } while (0)
#define PG8_Q64(v) PG8_Q64_##v
#define PG8_Q64_voffA q64A
#define PG8_Q64_voffB q64B
#define PG8_LDA(dst, b, h) do { _Pragma("unroll") for (int m = 0; m < 4; ++m) _Pragma("unroll") for (int k = 0; k < 2; ++k) dst[m][k] = *(const PG8_LAS bf16x8*)(lds + PG8_SA(b, h) + aoff + m * 2048 + k * 1024); } while (0)
#define PG8_LDB(dst, b, h) do { _Pragma("unroll") for (int n = 0; n < 2; ++n) _Pragma("unroll") for (int k = 0; k < 2; ++k) dst[n][k] = *(const PG8_LAS bf16x8*)(lds + PG8_SB(b, h) + boff + n * 2048 + k * 1024); } while (0)
#define PG8_MMA(ai, bj, At, Bt) do { __builtin_amdgcn_s_setprio(1); \
        if constexpr (F8) { _Pragma("unroll") for (int m = 0; m < 4; ++m) _Pragma("unroll") for (int n = 0; n < 2; ++n) \
            mfma_f8_inplace(acc[ai][bj][m][n], cat8(Bt[n][0], Bt[n][1]), cat8(At[m][0], At[m][1])); } \
        else { _Pragma("unroll") for (int m = 0; m < 4; ++m) _Pragma("unroll") for (int n = 0; n < 2; ++n) _Pragma("unroll") for (int k = 0; k < 2; ++k) \
            acc[ai][bj][m][n] = __builtin_amdgcn_mfma_f32_16x16x32_bf16(Bt[n][k], At[m][k], acc[ai][bj][m][n], 0, 0, 0); } \
        __builtin_amdgcn_s_setprio(0); } while (0)
#define PG8_WAIT_V(n) asm volatile("s_waitcnt vmcnt(" #n ")" ::: "memory")
#define PG8_WAIT_L(n) asm volatile("s_waitcnt lgkmcnt(" #n ")" ::: "memory")
#define PG8_WAIT_REL(NN) do { if (rel) asm volatile("s_waitcnt vmcnt(%0)" :: "n"(NN) : "memory"); else PG8_WAIT_V(8); } while (0)
#define PG8_BAR __builtin_amdgcn_s_barrier()
#define PG8_SCHED __builtin_amdgcn_sched_barrier(0)
    typename Epi::Pk pk; Unit cur, nxt, pend; int ui = 0; bool pending = false; pend.pm = pend.pn = pend.bn = pend.idx = 0;
    if (!S.next(0, cur)) return;
    f32x4 acc[2][2][4][2];
#pragma unroll
    for (int a = 0; a < 2; ++a)
#pragma unroll
        for (int b = 0; b < 2; ++b)
#pragma unroll
            for (int m = 0; m < 4; ++m)
#pragma unroll
                for (int n = 0; n < 2; ++n) acc[a][b][m][n] = (f32x4){0.f, 0.f, 0.f, 0.f};
    bf16x8 At[4][2], B0[2][2], B1[2][2];
    const char* cA = (const char*)g.A + (size_t)cur.pm * tstepA; const char* cB = (const char*)g.Bt + (size_t)cur.bn * tstepB;
    S.a_ready(cur);
    if constexpr (SP2) {
        PG8_STAGE(PG8_SB(0, 0), cB, voffB); PG8_STAGE(PG8_SB(0, 1), cB + hstepB, voffB); PG8_STAGE(PG8_SA(0, 0), cA, voffA); PG8_STAGE(PG8_SA(0, 1), cA + hstepA, voffA);
        if (wr == 1) PG8_BAR;
        PG8_WAIT_V(2); PG8_BAR;
        PG8_STAGE(PG8_SB(1, 0), cB + kstep, voffB); PG8_STAGE(PG8_SA(1, 0), cA + kstep, voffA); PG8_STAGE(PG8_SB(1, 1), cB + hstepB + kstep, voffB);
        PG8_WAIT_V(6); PG8_BAR;
    } else {
        PG8_STAGE(PG8_SB(0, 0), cB, voffB); PG8_STAGE(PG8_SA(0, 0), cA, voffA); PG8_STAGE(PG8_SB(0, 1), cB + hstepB, voffB); PG8_STAGE(PG8_SA(0, 1), cA + hstepA, voffA);
        if (wr == 1) PG8_BAR;
        PG8_WAIT_V(4); PG8_BAR;
        PG8_STAGE(PG8_SB(1, 0), cB + kstep, voffB); PG8_STAGE(PG8_SA(1, 0), cA + kstep, voffA); PG8_STAGE(PG8_SB(1, 1), cB + hstepB + kstep, voffB);
        PG8_WAIT_V(6); PG8_BAR;
    }
    for (;;) {
        const bool has_next = S.next(ui + 1, nxt);
        const char* nA = has_next ? (const char*)g.A + (size_t)nxt.pm * tstepA : cA; const char* nB = has_next ? (const char*)g.Bt + (size_t)nxt.bn * tstepB : cB;
        for (int t = 0; t < nt; t += 2) {
            const bool last = (t == nt - 2);
            const char* a1 = cA + (size_t)(t + 1) * kstep;
            const char* a2 = last ? nA : cA + (size_t)(t + 2) * kstep; const char* b2 = last ? nB : cB + (size_t)(t + 2) * kstep;
            const char* a3 = a2 + kstep; const char* b3 = b2 + kstep;
            if (last && has_next) S.a_ready(nxt);
            if constexpr (SP2) {
            const bool rel = Epi::SPLIT && pending && t == 0;
            if (rel) { if constexpr (Epi::SPLIT) { PG8_STAGE(PG8_SA(1, 1), a1 + hstepA, voffA); PG8_SCHED;
                if constexpr (Epi::PACK) { E.store1(pk, pend, wr, wc, fr, fq); }
                else { E.template half<1>(acc, pend, wr, wc, fr, fq);
#pragma unroll
                for (int b = 0; b < 2; ++b)
#pragma unroll
                    for (int m = 0; m < 4; ++m)
#pragma unroll
                        for (int n = 0; n < 2; ++n) acc[1][b][m][n] = (f32x4){0.f, 0.f, 0.f, 0.f}; }
                S.done(pend); pending = false;
                PG8_SCHED; PG8_LDB(B0, 0, 0); PG8_LDB(B1, 0, 1); PG8_SCHED; PG8_LDA(At, 0, 0); } }
            else { PG8_LDB(B0, 0, 0); PG8_LDB(B1, 0, 1); PG8_SCHED; PG8_LDA(At, 0, 0); PG8_STAGE(PG8_SA(1, 1), a1 + hstepA, voffA); }
            PG8_WAIT_REL(8 + Epi::NST); PG8_WAIT_L(0); PG8_BAR; PG8_MMA(0, 0, At, B0); PG8_MMA(0, 1, At, B1); PG8_BAR; PG8_SCHED;
            PG8_LDA(At, 0, 1); PG8_STAGE(PG8_SB(0, 0), b2, voffB); PG8_STAGE(PG8_SB(0, 1), b2 + hstepB, voffB); PG8_STAGE(PG8_SA(0, 0), a2, voffA);
            PG8_WAIT_REL(8 + Epi::NST); PG8_WAIT_L(0); PG8_BAR; PG8_MMA(1, 0, At, B0); PG8_MMA(1, 1, At, B1); PG8_BAR; PG8_SCHED;
            PG8_LDB(B0, 1, 0); PG8_LDB(B1, 1, 1); PG8_SCHED; PG8_LDA(At, 1, 0); PG8_STAGE(PG8_SA(0, 1), a2 + hstepA, voffA);
            PG8_WAIT_REL(8 + Epi::NST / 2); PG8_WAIT_L(0); PG8_BAR; PG8_MMA(0, 0, At, B0); PG8_MMA(0, 1, At, B1); PG8_BAR; PG8_SCHED;
            PG8_LDA(At, 1, 1); PG8_STAGE(PG8_SB(1, 0), b3, voffB); PG8_STAGE(PG8_SB(1, 1), b3 + hstepB, voffB); PG8_STAGE(PG8_SA(1, 0), a3, voffA);
            PG8_WAIT_V(8); PG8_WAIT_L(0); PG8_BAR; PG8_MMA(1, 0, At, B0); PG8_MMA(1, 1, At, B1); PG8_BAR; PG8_SCHED;
            } else {
            PG8_LDB(B0, 0, 0); PG8_SCHED; PG8_LDA(At, 0, 0); PG8_STAGE(PG8_SA(1, 1), a1 + hstepA, voffA);
            PG8_WAIT_L(8); PG8_BAR; PG8_WAIT_L(0); PG8_MMA(0, 0, At, B0); PG8_BAR; PG8_SCHED;
            PG8_LDB(B1, 0, 1); PG8_STAGE(PG8_SB(0, 0), b2, voffB);
            PG8_BAR; PG8_WAIT_L(0); PG8_MMA(0, 1, At, B1); PG8_BAR;
            PG8_LDA(At, 0, 1); PG8_STAGE(PG8_SA(0, 0), a2, voffA);
            PG8_BAR; PG8_WAIT_L(0); PG8_MMA(1, 0, At, B0); PG8_BAR; PG8_SCHED;
            PG8_STAGE(PG8_SB(0, 1), b2 + hstepB, voffB);
            PG8_WAIT_V(6); PG8_BAR; PG8_MMA(1, 1, At, B1); PG8_BAR;
            PG8_LDB(B0, 1, 0); PG8_SCHED; PG8_LDA(At, 1, 0); PG8_STAGE(PG8_SA(0, 1), a2 + hstepA, voffA);
            PG8_WAIT_L(8); PG8_BAR; PG8_WAIT_L(0); PG8_MMA(0, 0, At, B0); PG8_BAR; PG8_SCHED;
            PG8_LDB(B1, 1, 1); PG8_STAGE(PG8_SB(1, 0), b3, voffB);
            PG8_BAR; PG8_WAIT_L(0); PG8_MMA(0, 1, At, B1); PG8_BAR;
            PG8_LDA(At, 1, 1); PG8_STAGE(PG8_SA(1, 0), a3, voffA);
            PG8_BAR; PG8_WAIT_L(0); PG8_MMA(1, 0, At, B0); PG8_BAR; PG8_SCHED;
            PG8_STAGE(PG8_SB(1, 1), b3 + hstepB, voffB);
            PG8_WAIT_V(6); PG8_BAR; PG8_MMA(1, 1, At, B1); PG8_BAR;
            }
        }
        if constexpr (F8) asm volatile("s_nop 15\n\ts_nop 15\n\ts_nop 15\n\ts_nop 15" ::: "memory");
        if constexpr (ALIGN_EPI) { if (wr == 0) PG8_BAR; }
        if constexpr (Epi::SPLIT) { static_assert(SP2, "split epilogues need the SP2 loop");
            if (has_next) { E.template half<0>(acc, cur, wr, wc, fr, fq); if constexpr (Epi::PACK) E.pack1(acc, cur, wr, fr, pk); pend = cur; pending = true; }
            else { E.template half<0>(acc, cur, wr, wc, fr, fq); E.template half<1>(acc, cur, wr, wc, fr, fq); S.done(cur); } }
        else if constexpr (!Epi::AFTER_DRAIN) { E(acc, cur, wr, wc, fr, fq); S.done(cur); }
        if (!has_next) break;
#pragma unroll
        for (int a = 0; a < ((Epi::SPLIT && !Epi::PACK) ? 1 : 2); ++a)
#pragma unroll
            for (int b = 0; b < 2; ++b)
#pragma unroll
                for (int m = 0; m < 4; ++m)
#pragma unroll
                    for (int n = 0; n < 2; ++n) acc[a][b][m][n] = (f32x4){0.f, 0.f, 0.f, 0.f};
        cur = nxt; cA = nA; cB = nB; ++ui;
        if constexpr (ALIGN_EPI) { if (wr == 1) PG8_BAR; }
    }
    PG8_WAIT_V(0);
    if constexpr (!ALIGN_EPI) { if (wr == 0) PG8_BAR; }
    PG8_BAR;
    if constexpr (Epi::AFTER_DRAIN) { E.fused(acc, cur, wr, wc, fr, fq, lds, wid, lane); S.done(cur); }
#undef PG8_SA
#undef PG8_SB
#undef PG8_STAGE
#undef PG8_Q64
#undef PG8_Q64_voffA
#undef PG8_Q64_voffB
#undef PG8_LDA
#undef PG8_LDB
#undef PG8_MMA
#undef PG8_WAIT_V
#undef PG8_WAIT_L
#undef PG8_WAIT_REL
#undef PG8_BAR
#undef PG8_SCHED
}
}
#define PG8_SP2 true
#define PG8_ALIGN true
constexpr int NWAVES = 8, NTHR = 512;
constexpr int BATCH = 2, SEQ = 8192, D = 1024, M = BATCH * SEQ;
constexpr int MEMLEN = 256, MMEM = BATCH * MEMLEN;
constexpr int EV_IN = 4632, EV_INP = 4864;
constexpr int OD_IN = 5152, OD_INP = 5376;
constexpr int FF = 2816, FFE = 3584, NEXP = 8;
constexpr float MOE_W2_SCALE = 128.f;
constexpr float MOE_W13_SCALE = 64.f;
constexpr int NQB = SEQ / 64;
constexpr int XH = 4;
constexpr float EPS = 1e-6f;
constexpr int MOE_ROWS = 2 * M + NEXP * 256;
constexpr int MOE_TILES = MOE_ROWS / 256;

constexpr size_t MiB = 1u << 20;
constexpr size_t WS_CTL = 0, CTL_ZERO_BYTES = 1 * MiB;
constexpr size_t WS_SMALL = 1 * MiB;
constexpr size_t WS_CMPB_PART = WS_SMALL;
constexpr size_t WS_CMPB = WS_SMALL + 256 * 1024;
constexpr size_t WS_OV = WS_SMALL + 512 * 1024;
constexpr size_t WS_MEMN = 2 * MiB;
constexpr size_t WS_KVM = 4 * MiB;
constexpr size_t WS_KM = 6 * MiB;
constexpr size_t WS_HID = 7 * MiB;
constexpr size_t WS_KVCMP = 9 * MiB;
constexpr size_t WS_MOEIDX = 10 * MiB;
constexpr size_t WS_SSQ = 14 * MiB;
constexpr size_t WS_W = 16 * MiB;
constexpr size_t WS_W_EVIN = WS_W, WS_W_EVOUT = WS_W_EVIN + 10 * MiB, WS_W_CK1 = WS_W_EVOUT + 4 * MiB, WS_W_CV1 = WS_W_CK1 + 2 * MiB, WS_W_ODIN = WS_W_CV1 + 2 * MiB,
                 WS_W_ODOUT = WS_W_ODIN + 11 * MiB, WS_W_XQ = WS_W_ODOUT + 4 * MiB, WS_W_XKV = WS_W_XQ + 2 * MiB, WS_W_XO = WS_W_XKV + 4 * MiB, WS_W_FF13 = WS_W_XO + 2 * MiB,
                 WS_W_FF2 = WS_W_FF13 + 11 * MiB, WS_W_M13 = WS_W_FF2 + 6 * MiB, WS_W_M2 = WS_W_M13 + 112 * MiB, WS_W_END = WS_W_M2 + 56 * MiB;
constexpr size_t WS_XN = WS_W_END;
constexpr size_t WS_QX = WS_XN + 32 * MiB, WS_OX = WS_QX + 16 * MiB, WS_R = WS_OX + 16 * MiB;
constexpr size_t WS_Y0 = WS_R, WS_KV6 = WS_R + 152 * MiB, WS_MIX = WS_R + 201 * MiB, WS_H = WS_R + 265 * MiB;
constexpr size_t WS_Y1 = WS_R, WS_YG = WS_R + 168 * MiB;
constexpr size_t WS_XP = WS_R, WS_HP = WS_R + 68 * MiB, WS_YP = WS_R + 306 * MiB, WS_END = WS_R + 442 * MiB;
static_assert(WS_W_END == 242 * MiB && WS_END == 748 * MiB, "ws map");
constexpr int CW_TMO = 0, CW_CODE = 1, CW_CHK = 2;
constexpr int CW_BAR = 4096;
constexpr int CW_MOECNT = 16384;
constexpr int CW_MOEOFF = 20480;

constexpr int LDS_BYTES = 159744;
constexpr int MISC_OFF = LDS_BYTES - 512;
constexpr int SCR_BYTES = MISC_OFF;

#define GAS __attribute__((address_space(1)))
#define LAS __attribute__((address_space(3)))
typedef unsigned short bf16;
typedef unsigned v4u __attribute__((ext_vector_type(4)));
typedef unsigned v2u __attribute__((ext_vector_type(2)));
typedef float f32x4 __attribute__((ext_vector_type(4)));
typedef float f32x16 __attribute__((ext_vector_type(16)));
typedef short bf16x8 __attribute__((ext_vector_type(8)));
typedef short s16x4 __attribute__((ext_vector_type(4)));
typedef GAS unsigned gu32;
#define RLX_AGENT __ATOMIC_RELAXED, __HIP_MEMORY_SCOPE_AGENT
#define LDS_WAIT() asm volatile("s_waitcnt lgkmcnt(0)" ::: "memory")
#define VM_WAIT() asm volatile("s_waitcnt vmcnt(0)" ::: "memory")
#define SBAR() __builtin_amdgcn_sched_barrier(0)
__device__ __forceinline__ int lane_id() { return (int)threadIdx.x & 63; }
__device__ __forceinline__ unsigned f2bf(float f) { unsigned u = __builtin_bit_cast(unsigned, f); return (u + 0x7fffu + ((u >> 16) & 1u)) >> 16; }
__device__ __forceinline__ unsigned pk2(float lo, float hi) { return f2bf(lo) | (f2bf(hi) << 16); }
__device__ __forceinline__ float bf2f(unsigned short b) { return __builtin_bit_cast(float, ((unsigned)b) << 16); }
__device__ __forceinline__ float bflo(unsigned w) { return __builtin_bit_cast(float, w << 16); }
__device__ __forceinline__ float bfhi(unsigned w) { return __builtin_bit_cast(float, w & 0xffff0000u); }
__device__ __forceinline__ unsigned cvtpk(float lo, float hi) { unsigned r; asm volatile("v_cvt_pk_bf16_f32 %0, %1, %2" : "=v"(r) : "v"(lo), "v"(hi)); return r; }
__device__ __forceinline__ float wave_sum(float v) {
#pragma unroll
    for (int o = 1; o < 64; o <<= 1) v += __shfl_xor(v, o);
    return v;
}
using pg8::fsigmoid; using pg8::gelu_tanh; using pg8::fsilu;
__device__ __forceinline__ float fsoftplus(float x) { return x > 20.f ? x : log1pf(__expf(x)); }

#define XB_TMO      128
#define XB_XCNT(j)  (256  + 64 * (j))
#define XB_XSUB(j)  (1280 + 64 * (j))
#define XB_XGEN(j)  (2304 + 64 * (j))
#define XB_TOP      3328
#define XB_TOPGEN   3392
#define XCD_BAR_WORDS 3456
#define XB_SPIN_CAP (1u << 18)

__device__ __forceinline__ unsigned xb_ld(unsigned* p)              { return __hip_atomic_load(p, __ATOMIC_RELAXED, __HIP_MEMORY_SCOPE_AGENT); }
__device__ __forceinline__ unsigned xb_add(unsigned* p, unsigned v) { return __hip_atomic_fetch_add(p, v, __ATOMIC_RELAXED, __HIP_MEMORY_SCOPE_AGENT); }
__device__ __forceinline__ unsigned xb_xcc_id() { return (unsigned)__builtin_amdgcn_s_getreg((3 << 11) | 20) & 0xFu; }
#define XB_SPIN(cond, bar) do { unsigned _sp = 0; while (cond) { __builtin_amdgcn_s_sleep(1); \
    if ((++_sp & 255u) == 0u) { if (xb_ld(&(bar)[XB_TMO])) break; if (_sp > XB_SPIN_CAP) { atomicAdd(&(bar)[XB_TMO], 1u); break; } } } } while (0)

struct XcdBarrier {
    unsigned* bar; unsigned x;
    volatile LAS unsigned* st;
};

__device__ __forceinline__ XcdBarrier xcd_barrier_post(unsigned* bar, volatile LAS unsigned* st) {
    XcdBarrier b; b.bar = bar; b.x = xb_xcc_id(); b.st = st;
    if (threadIdx.x == 0) (void)xb_add(&bar[XB_XCNT(b.x)], 1u);
    return b;
}
__device__ __forceinline__ void xcd_barrier_complete(unsigned* bar, unsigned x, unsigned& nloc, unsigned& nx) {
    const unsigned G = gridDim.x * gridDim.y * gridDim.z;
    unsigned sum, cnt, mine, sp = 0u;
    for (;;) {
        sum = 0u; cnt = 0u; mine = 0u;
#pragma unroll
        for (unsigned j = 0; j < 16; ++j) { const unsigned c = xb_ld(&bar[XB_XCNT(j)]); sum += c; cnt += (c > 0u) ? 1u : 0u; mine = (j == x) ? c : mine; }
        if (sum == G) break;
        __builtin_amdgcn_s_sleep(1);
        if ((++sp & 255u) == 0u) { if (xb_ld(&bar[XB_TMO])) break; if (sp > XB_SPIN_CAP) { atomicAdd(&bar[XB_TMO], 1u); break; } }
    }
    nloc = mine > 0u ? mine : 1u; nx = cnt > 0u ? cnt : 1u;
}

__device__ __forceinline__ void xcd_barrier(const XcdBarrier& b) {
    asm volatile("s_waitcnt vmcnt(0)" ::: "memory");
    __syncthreads();
    if (threadIdx.x == 0) {
        unsigned* bar = b.bar;
        __builtin_amdgcn_s_waitcnt(0);
        unsigned nloc = b.st[0], nx = b.st[1];
        if (nloc == 0u) { xcd_barrier_complete(bar, b.x, nloc, nx); b.st[0] = nloc; b.st[1] = nx; }
        const unsigned old = xb_add(&bar[XB_XSUB(b.x)], 1u);
        const unsigned gen = old / nloc;
        if (old + 1u == (gen + 1u) * nloc) {
            __builtin_amdgcn_fence(__ATOMIC_RELEASE, "agent");
            asm volatile("s_waitcnt vmcnt(0)" ::: "memory");
            const unsigned og = xb_add(&bar[XB_TOP], 1u);
            const unsigned tg = og / nx;
            if (og + 1u == (tg + 1u) * nx) xb_add(&bar[XB_TOPGEN], 1u);
            else XB_SPIN(xb_ld(&bar[XB_TOPGEN]) == tg, bar);
            __builtin_amdgcn_fence(__ATOMIC_ACQUIRE, "agent");
            xb_add(&bar[XB_XGEN(b.x)], 1u);
            asm volatile("s_waitcnt vmcnt(0)" ::: "memory");
        } else {
            XB_SPIN(xb_ld(&bar[XB_XGEN(b.x)]) == gen, bar);
            __builtin_amdgcn_fence(__ATOMIC_ACQUIRE, "agent");
            asm volatile("s_waitcnt vmcnt(0)" ::: "memory");
        }
    }
    __syncthreads();
}

struct Args { const float* in[41]; float* out; unsigned char* ws; int ph_lo, ph_hi, li, pad; };
struct Frame { LAS unsigned char* lds; volatile LAS unsigned* MISC; gu32* ctl; unsigned char* ws; int tid, lane, wave, G, bid; };
enum { I_X = 0, I_MEM, I_NMIX, I_NCROSS, I_NMEM, I_NFFN, I_EVWIN, I_RGCW, I_RGCB, I_RGWA, I_RGBA, I_RGWX, I_RGBX, I_RGLAM, I_GATEB, I_QNORM, I_KNORM, I_CMPPOS,
       I_CKW1, I_CKW2, I_CVW1, I_CVW2, I_EVWOUT, I_ODWIN, I_ODCW, I_ODCB, I_DTB, I_ALOG, I_DSKIP, I_ODNORM, I_ODWOUT, I_XWQ, I_XWKV, I_XQN, I_XKN, I_XWO,
       I_FFW13, I_FFW2, I_ROUTER, I_MW13, I_MW2, N_IN };
static_assert(N_IN == 41, "input count");

template <int MAP>
__device__ __forceinline__ void transpose_item(const float* W, int N, bf16* WT, int ldt, LAS float* scr, int kb, int nb, int lane, int ffs, const float* kg = nullptr) {
    const int k0 = 64 * kb, n0 = 64 * nb; const int c4 = (lane & 15) * 4, r4 = lane >> 4;
    f32x4 tv[16];
    if ((N & 3) == 0) {
#pragma unroll
        for (int i = 0; i < 16; ++i) { const int kk = 4 * i + r4; tv[i] = (n0 + c4 < N) ? *(const GAS f32x4*)(W + (size_t)(k0 + kk) * N + n0 + c4) : (f32x4){0.f, 0.f, 0.f, 0.f}; }
    } else {
#pragma unroll
        for (int i = 0; i < 16; ++i) { const int kk = 4 * i + r4; const float* src = W + (size_t)(k0 + kk) * N + n0 + c4;
#pragma unroll
            for (int j = 0; j < 4; ++j) tv[i][j] = (n0 + c4 + j < N) ? src[j] : 0.f; }
    }
#pragma unroll
    for (int i = 0; i < 16; ++i) { const int kk = 4 * i + r4; const float gk = kg ? kg[k0 + kk] : 1.f;
#pragma unroll
        for (int j = 0; j < 4; ++j) scr[kk * 65 + c4 + j] = tv[i][j] * gk; }
    LDS_WAIT(); asm volatile("" ::: "memory");
    const int c = lane & 7;
#pragma unroll
    for (int j = 0; j < 8; ++j) { const int nl = (lane >> 3) + 8 * j, n = n0 + nl; const LAS float* s = scr + (8 * c) * 65 + nl;
        v4u o; o.x = pk2(s[0 * 65], s[1 * 65]); o.y = pk2(s[2 * 65], s[3 * 65]); o.z = pk2(s[4 * 65], s[5 * 65]); o.w = pk2(s[6 * 65], s[7 * 65]);
        int row = n; if (MAP == 1) row = (n < ffs) ? pg8::swiglu_row(n, 0) : pg8::swiglu_row(n - ffs, 1);
        if (n < ((N + 31) & ~31)) *(GAS v4u*)(WT + (size_t)row * ldt + k0 + 8 * c) = o; }
    LDS_WAIT(); asm volatile("" ::: "memory");
}
__device__ __forceinline__ unsigned pk4_fp8(float a, float b, float c, float d) { int r = __builtin_amdgcn_cvt_pk_fp8_f32(a, b, 0, false); r = __builtin_amdgcn_cvt_pk_fp8_f32(c, d, r, true); return (unsigned)r; }
template <int MAP>
__device__ __forceinline__ void transpose_item_f8(const float* W, int N, unsigned char* WT8, int ldt, LAS float* scr, int kb, int nb, int lane, int ffs, float sc) {
    const int k0 = 64 * kb, n0 = 64 * nb; const int c4 = (lane & 15) * 4, r4 = lane >> 4;
    f32x4 tv[16];
#pragma unroll
    for (int i = 0; i < 16; ++i) { const int kk = 4 * i + r4; tv[i] = *(const GAS f32x4*)(W + (size_t)(k0 + kk) * N + n0 + c4); }
#pragma unroll
    for (int i = 0; i < 16; ++i) { const int kk = 4 * i + r4;
#pragma unroll
        for (int j = 0; j < 4; ++j) scr[kk * 65 + c4 + j] = tv[i][j] * sc; }
    LDS_WAIT(); asm volatile("" ::: "memory");
    const int c = lane & 7;
#pragma unroll
    for (int j = 0; j < 8; ++j) { const int nl = (lane >> 3) + 8 * j, n = n0 + nl; const LAS float* s = scr + (8 * c) * 65 + nl;
        v2u o; o.x = pk4_fp8(s[0 * 65], s[1 * 65], s[2 * 65], s[3 * 65]); o.y = pk4_fp8(s[4 * 65], s[5 * 65], s[6 * 65], s[7 * 65]);
        int row = n; if (MAP == 1) row = (n < ffs) ? pg8::swiglu_row(n, 0) : pg8::swiglu_row(n - ffs, 1);
        *(GAS v2u*)(WT8 + (size_t)row * ldt + k0 + 8 * c) = o; }
    LDS_WAIT(); asm volatile("" ::: "memory");
}
constexpr int MOE_CONV_ITEMS = NEXP * (16 * 112 + 56 * 16);

__device__ __forceinline__ void rms_row_to_bf16(const float* xrow, const float* g, bf16* orow, int lane) {
    const GAS f32x4* xr = (const GAS f32x4*)xrow + lane; const GAS f32x4* gr = (const GAS f32x4*)g + lane;
    f32x4 v[4]; float s = 0.f;
#pragma unroll
    for (int j = 0; j < 4; ++j) { v[j] = xr[64 * j]; s += (v[j].x * v[j].x + v[j].y * v[j].y) + (v[j].z * v[j].z + v[j].w * v[j].w); }
    const float rstd = 1.f / sqrtf(wave_sum(s) * (1.f / D) + EPS);
    GAS unsigned long long* o8 = (GAS unsigned long long*)orow + lane;
#pragma unroll
    for (int j = 0; j < 4; ++j) { const f32x4 gg = gr[64 * j];
        o8[64 * j] = (unsigned long long)pk2(v[j].x * rstd * gg.x, v[j].y * rstd * gg.y) | ((unsigned long long)pk2(v[j].z * rstd * gg.z, v[j].w * rstd * gg.w) << 32); }
}
__device__ __forceinline__ void phase_rmsnorm(const Frame& F, const float* x, const float* g, bf16* xn, int rows) {
    const int gw = F.bid * NWAVES + F.wave, NGW = F.G * NWAVES;
    for (int m = gw; m < rows; m += NGW) rms_row_to_bf16(x + (size_t)m * D, g, xn + (size_t)m * D, F.lane);
}
#define TR_MAT(cnt_, W_, K_, N_, WT_, ldt_, MAPK_, ffs_, kg_) \
    if (r < (cnt_)) { const int nblk_ = ((N_) + 63) / 64; transpose_item<MAPK_>((W_), (N_), (WT_), (ldt_), scr, r / nblk_, r % nblk_, F.lane, (ffs_), (kg_)); continue; } r -= (cnt_);
constexpr int C_EVIN = 16 * 73, C_EVOUT = 32 * 16, C_CW1 = 64 * 4, C_ODIN = 16 * 81, C_ODOUT = 32 * 16, C_XQ = 16 * 8, C_XKV = 16 * 16, C_XO = 8 * 16, C_FF13 = 16 * 88, C_FF2 = 44 * 16;
constexpr int CONV_A = C_EVIN + 2 * C_XKV + 2 * C_CW1, CONV_B = C_EVOUT + 2 * C_XQ + 2 * C_XO + C_FF13 + C_FF2 + C_ODIN + C_ODOUT;
constexpr int CONV_ALL = CONV_A + CONV_B + MOE_CONV_ITEMS, CONV_Q = 4480, CONV_P2_END = CONV_ALL - 2 * CONV_Q;
__device__ __forceinline__ void convert_range(const Frame& F, const Args& a, int gw, int NGW, int it_lo, int it_hi) {
    LAS float* scr = (LAS float*)(F.lds + F.wave * 16640); unsigned char* ws = F.ws;
    for (int it = it_lo + gw; it < it_hi; it += NGW) {
        int r = it;
        TR_MAT(C_EVIN, a.in[I_EVWIN], D, EV_IN, (bf16*)(ws + WS_W_EVIN), D, 0, 0, nullptr)
        TR_MAT(C_XKV, a.in[I_XWKV], D, 1024, (bf16*)(ws + WS_W_XKV), D, 0, 0, nullptr)
        TR_MAT(C_XKV, a.in[I_XWKV] + (size_t)D * 1024, D, 1024, (bf16*)(ws + WS_W_XKV) + (size_t)1024 * D, D, 0, 0, nullptr)
        TR_MAT(C_CW1, a.in[I_CKW1], 4096, 256, (bf16*)(ws + WS_W_CK1), 4096, 0, 0, nullptr)
        TR_MAT(C_CW1, a.in[I_CVW1], 4096, 256, (bf16*)(ws + WS_W_CV1), 4096, 0, 0, nullptr)
        TR_MAT(C_EVOUT, a.in[I_EVWOUT], 2048, D, (bf16*)(ws + WS_W_EVOUT), 2048, 0, 0, nullptr)
        TR_MAT(C_XQ, a.in[I_XWQ], D, 512, (bf16*)(ws + WS_W_XQ), D, 0, 0, a.in[I_NCROSS])
        TR_MAT(C_XO, a.in[I_XWO], 512, D, (bf16*)(ws + WS_W_XO), 512, 0, 0, nullptr)
        TR_MAT(C_FF13, a.in[I_FFW13], D, 2 * FF, (bf16*)(ws + WS_W_FF13), D, 1, FF, a.in[I_NFFN])
        TR_MAT(C_FF2, a.in[I_FFW2], FF, D, (bf16*)(ws + WS_W_FF2), FF, 0, 0, nullptr)
        TR_MAT(C_ODIN, a.in[I_ODWIN], D, OD_IN, (bf16*)(ws + WS_W_ODIN), D, 0, 0, a.in[I_NMIX] + D)
        TR_MAT(C_ODOUT, a.in[I_ODWOUT], 2048, D, (bf16*)(ws + WS_W_ODOUT), 2048, 0, 0, nullptr)
        TR_MAT(C_XQ, a.in[I_XWQ] + (size_t)D * 512, D, 512, (bf16*)(ws + WS_W_XQ) + (size_t)512 * D, D, 0, 0, a.in[I_NCROSS] + D)
        TR_MAT(C_XO, a.in[I_XWO] + (size_t)512 * D, 512, D, (bf16*)(ws + WS_W_XO) + (size_t)D * 512, 512, 0, 0, nullptr)
        { constexpr int C_M13 = 16 * 112, C_M2 = 56 * 16;
          if (r < NEXP * C_M13) { const int e = r / C_M13, q = r % C_M13; transpose_item_f8<1>(a.in[I_MW13] + (size_t)e * D * 2 * FFE, 2 * FFE, ws + WS_W_M13 + (size_t)e * 2 * FFE * D, D, scr, q / 112, q % 112, F.lane, FFE, MOE_W13_SCALE); continue; } r -= NEXP * C_M13;
          { const int e = r / C_M2, q = r % C_M2; transpose_item_f8<0>(a.in[I_MW2] + (size_t)e * FFE * D, D, ws + WS_W_M2 + (size_t)e * D * FFE, FFE, scr, q / 16, q % 16, F.lane, 0, MOE_W2_SCALE); } }
    }
}
__device__ __forceinline__ void p0_prologue(const Frame& F, const Args& a) {
    const int gw = F.bid * NWAVES + F.wave, NGW = F.G * NWAVES;
    unsigned char* ws = F.ws;
    convert_range(F, a, gw, NGW, 0, CONV_A);
    for (int i = F.bid * NTHR + F.tid; i < 2 * 224 * 128; i += F.G * NTHR) { const int w = i / (224 * 128), q = i % (224 * 128);
        bf16* base = w == 0 ? (bf16*)(ws + WS_W_EVIN) + (size_t)4640 * D : (bf16*)(ws + WS_W_ODIN) + (size_t)5152 * D; *(GAS v4u*)(base + (size_t)q * 8) = (v4u){0u, 0u, 0u, 0u}; }
    phase_rmsnorm(F, a.in[I_X], a.in[I_NMIX], (bf16*)(ws + WS_XN), M);
    phase_rmsnorm(F, a.in[I_MEM], a.in[I_NMEM], (bf16*)(ws + WS_MEMN), MMEM);
    phase_rmsnorm(F, a.in[I_MEM], a.in[I_NMEM] + D, (bf16*)(ws + WS_MEMN) + (size_t)MMEM * D, MMEM);
    for (int i = F.bid * NTHR + F.tid; i < 512 * 128; i += F.G * NTHR) { const int n = i >> 7, j = i & 127; ((bf16*)(ws + WS_OV))[i] = (n <= 510 && n >= 4 * j - 1 && n <= 4 * j + 3) ? (bf16)0x3F80 : (bf16)0; }
    for (int it = gw; it < 128; it += NGW) { const int mm = it >> 6, ic = it & 63; const float* w1 = a.in[mm ? I_CVW1 : I_CKW1]; const float* pos = a.in[I_CMPPOS];
        f32x4 acc = {0.f, 0.f, 0.f, 0.f};
        for (int rr = 0; rr < 64; ++rr) { const int i = ic * 64 + rr; const float p = pos[i]; const f32x4 w = *(const GAS f32x4*)(w1 + (size_t)i * 256 + 4 * F.lane); acc += w * p; }
        *(GAS f32x4*)((float*)(ws + WS_CMPB_PART) + (size_t)(mm * 64 + ic) * 256 + 4 * F.lane) = acc; }
}
#undef TR_MAT
namespace att {
constexpr float SCALE = 0.08838834764831845f;
constexpr float THR = 8.f;
constexpr int KVBLK = 64, DH = 128;
constexpr int SHM_V = KVBLK * DH * 2, SHM_K = KVBLK * DH * 2;
constexpr int NSLOT = 3;
constexpr int LDS_ATT = NSLOT * SHM_V + NSLOT * SHM_K + NWAVES * 64 * 4;
#define KSWZ(row, colB) ((row) * 256 + ((colB) ^ (((row) & 7) << 4)))
__device__ __forceinline__ int v_st(int k, int c) { const int kk = (k & ~0xC) | ((k & 4) << 1) | ((k & 8) >> 1); return ((kk >> 3) * 4 + (c >> 5)) * 512 + ((kk & 7) * 32 + (c & 31)) * 2; }
__device__ __forceinline__ int v_rd_base(int lane) { return ((lane & 3) << 3) | (((lane >> 2) & 3) << 6) | (((lane >> 4) & 1) << 5) | (((lane >> 5) & 1) << 8); }
constexpr int v_rd_off(int d0, int ks, int half) { return d0 * 512 + ks * 4096 + half * 2048; }
__device__ __forceinline__ int crow(int r, int hi) { return (r & 3) + 8 * (r >> 2) + 4 * hi; }
__device__ __forceinline__ bf16x8 pack8(f32x4 a, f32x4 b) { v4u w = {cvtpk(a[0], a[1]), cvtpk(a[2], a[3]), cvtpk(b[0], b[1]), cvtpk(b[2], b[3])}; return *reinterpret_cast<bf16x8*>(&w); }

__device__ __forceinline__ void mask_tile(f32x16& p0, f32x16& p1, int dq, unsigned W) {
    asm volatile("" : "+v"(dq));
    const float NEG = -__builtin_inff();
#pragma unroll
    for (int r = 0; r < 16; ++r) { const int c = (r & 3) + 8 * (r >> 2);
        if ((unsigned)(dq - c) >= W) p0[r] = NEG;
        if ((unsigned)(dq - c - 32) >= W) p1[r] = NEG; }
}
__device__ __forceinline__ void mask_all(f32x16& p0, f32x16& p1) { const float NEG = -__builtin_inff();
#pragma unroll
    for (int r = 0; r < 16; ++r) { p0[r] = NEG; p1[r] = NEG; } }
__device__ __forceinline__ void partialSM(f32x16& p0, f32x16& p1, float& m_reg, float& mn, float& alpha, bool keep = true) {
    float pmax = p0[0];
#pragma unroll
    for (int r = 1; r < 16; ++r) pmax = fmaxf(pmax, p0[r]);
#pragma unroll
    for (int r = 0; r < 16; ++r) pmax = fmaxf(pmax, p1[r]);
    pmax = keep ? pmax : -__builtin_inff();
    { auto rr = __builtin_amdgcn_permlane32_swap(__float_as_uint(pmax), __float_as_uint(pmax), false, false);
      pmax = fmaxf(__uint_as_float(rr[0]), __uint_as_float(rr[1])); }
    constexpr float C2 = 1.4426950408889634f * SCALE;
    if (__builtin_expect(__all((pmax - m_reg) * SCALE <= THR), 1)) { mn = m_reg; alpha = 1.f; }
    else { mn = fmaxf(m_reg, pmax); alpha = __builtin_amdgcn_exp2f((m_reg - mn) * C2); m_reg = mn; }
    const float mnL = keep ? -mn * C2 : -__builtin_inff();
#pragma unroll
    for (int r = 0; r < 16; ++r) p0[r] = fmaf(p0[r], C2, mnL);
#pragma unroll
    for (int r = 0; r < 16; ++r) p1[r] = fmaf(p1[r], C2, mnL);
#pragma unroll
    for (int r = 0; r < 16; ++r) p0[r] = __builtin_amdgcn_exp2f(p0[r]);
}
__device__ __forceinline__ void finishSM(f32x16& p0, f32x16& p1, float alpha, float& l_reg, bf16x8& pa0, bf16x8& pa1, bf16x8& pa2, bf16x8& pa3) {
#pragma unroll
    for (int r = 0; r < 16; ++r) p1[r] = __builtin_amdgcn_exp2f(p1[r]);
    float ps = 0;
#pragma unroll
    for (int r = 0; r < 16; ++r) ps += p0[r];
#pragma unroll
    for (int r = 0; r < 16; ++r) ps += p1[r];
    { auto rr = __builtin_amdgcn_permlane32_swap(__float_as_uint(ps), __float_as_uint(ps), false, false);
      ps = __uint_as_float(rr[0]) + __uint_as_float(rr[1]); }
    l_reg = l_reg * alpha + ps;
#define PK4(P, B_, OUT) do { unsigned a0 = cvtpk(P[B_+0], P[B_+1]), a1 = cvtpk(P[B_+2], P[B_+3]);                          \
        unsigned b0 = cvtpk(P[B_+4], P[B_+5]), b1 = cvtpk(P[B_+6], P[B_+7]);                                             \
        auto r0 = __builtin_amdgcn_permlane32_swap(a0, b0, false, false); auto r1 = __builtin_amdgcn_permlane32_swap(a1, b1, false, false); \
        v4u w = {r0[0], r1[0], r0[1], r1[1]}; OUT = *reinterpret_cast<bf16x8*>(&w); } while (0)
    PK4(p0, 0, pa0); PK4(p0, 8, pa1); PK4(p1, 0, pa2); PK4(p1, 8, pa3);
#undef PK4
}
__device__ __forceinline__ void qkt(f32x16& p0, f32x16& p1, const char* Kslot, int r32, int hi, const bf16x8* qr) {
    p0 = f32x16{}; p1 = f32x16{};
    const char* kb[4];
#pragma unroll
    for (int dd = 0; dd < 4; ++dd) kb[dd] = Kslot + KSWZ(r32, (dd * 16 + hi * 8) * 2);
    bf16x8 fa[4], fb[4];
#define KLD(dst, i, d0) do { const char* a_ = kb[(d0) & 3] + ((d0) >> 2) * 128; dst[i] = *reinterpret_cast<const bf16x8*>(a_); dst[i + 1] = *reinterpret_cast<const bf16x8*>(a_ + 32 * 256); } while (0)
#define KMM(src, i, d0) do { p0 = __builtin_amdgcn_mfma_f32_32x32x16_bf16(src[i], qr[d0], p0, 0, 0, 0); p1 = __builtin_amdgcn_mfma_f32_32x32x16_bf16(src[i + 1], qr[d0], p1, 0, 0, 0); } while (0)
    KLD(fa, 0, 0); KLD(fa, 2, 1); KLD(fb, 0, 2); KLD(fb, 2, 3); SBAR();
    KMM(fa, 0, 0); KMM(fa, 2, 1); SBAR(); KLD(fa, 0, 4); KLD(fa, 2, 5); SBAR();
    KMM(fb, 0, 2); KMM(fb, 2, 3); SBAR(); KLD(fb, 0, 6); KLD(fb, 2, 7); SBAR();
    KMM(fa, 0, 4); KMM(fa, 2, 5); SBAR();
    KMM(fb, 0, 6); KMM(fb, 2, 7);
#undef KLD
#undef KMM
}
__device__ __forceinline__ void pv_tile(f32x16* o, int vbs, bf16x8 pa0, bf16x8 pa1, bf16x8 pa2, bf16x8 pa3) {
#define TRRD(dst, off) asm volatile("ds_read_b64_tr_b16 %0, %1 offset:%2" : "=&v"(dst) : "v"(vbs), "i"(off) : "memory")
#define PV_D0(d0) do { s16x4 l0, l1, l2, l3, h0, h1, h2, h3; constexpr int b_ = v_rd_off(d0, 0, 0); \
        TRRD(l0, b_); TRRD(h0, b_ + 2048); TRRD(l1, b_ + 4096); TRRD(h1, b_ + 6144); TRRD(l2, b_ + 8192); TRRD(h2, b_ + 10240); TRRD(l3, b_ + 12288); TRRD(h3, b_ + 14336); \
        asm volatile("s_waitcnt lgkmcnt(0)" ::: "memory"); SBAR();   \
        o[d0] = __builtin_amdgcn_mfma_f32_32x32x16_bf16(pa0, (bf16x8){l0[0], l0[1], l0[2], l0[3], h0[0], h0[1], h0[2], h0[3]}, o[d0], 0, 0, 0);   \
        o[d0] = __builtin_amdgcn_mfma_f32_32x32x16_bf16(pa1, (bf16x8){l1[0], l1[1], l1[2], l1[3], h1[0], h1[1], h1[2], h1[3]}, o[d0], 0, 0, 0);   \
        o[d0] = __builtin_amdgcn_mfma_f32_32x32x16_bf16(pa2, (bf16x8){l2[0], l2[1], l2[2], l2[3], h2[0], h2[1], h2[2], h2[3]}, o[d0], 0, 0, 0);   \
        o[d0] = __builtin_amdgcn_mfma_f32_32x32x16_bf16(pa3, (bf16x8){l3[0], l3[1], l3[2], l3[3], h3[0], h3[1], h3[2], h3[3]}, o[d0], 0, 0, 0); } while (0)
    PV_D0(0); PV_D0(1); PV_D0(2); PV_D0(3);
#undef PV_D0
#undef TRRD
}
__device__ __forceinline__ void q_issue(const bf16* qrow, int hi, v4u (&raw)[8]) {
#pragma unroll
    for (int d0 = 0; d0 < 8; ++d0) raw[d0] = *(const GAS v4u*)(qrow + d0 * 16 + hi * 8);
}
__device__ __forceinline__ void q_finish(const v4u (&raw)[8], const float* g, int hi, bf16x8* qr) {
    float ss = 0.f;
#pragma unroll
    for (int d0 = 0; d0 < 8; ++d0)
#pragma unroll
        for (int j = 0; j < 4; ++j) { const float a = bflo(raw[d0][j]), b = bfhi(raw[d0][j]); ss += a * a + b * b; }
    ss += __shfl_xor(ss, 32);
    const float rstd = 1.f / sqrtf(ss * (1.f / 128.f) + EPS);
#pragma unroll
    for (int d0 = 0; d0 < 8; ++d0) { const f32x4 g0 = *(const GAS f32x4*)(g + d0 * 16 + hi * 8), g1 = *(const GAS f32x4*)(g + d0 * 16 + hi * 8 + 4);
        v4u w; w.x = cvtpk(bflo(raw[d0][0]) * rstd * g0[0], bfhi(raw[d0][0]) * rstd * g0[1]); w.y = cvtpk(bflo(raw[d0][1]) * rstd * g0[2], bfhi(raw[d0][1]) * rstd * g0[3]);
        w.z = cvtpk(bflo(raw[d0][2]) * rstd * g1[0], bfhi(raw[d0][2]) * rstd * g1[1]); w.w = cvtpk(bflo(raw[d0][3]) * rstd * g1[2], bfhi(raw[d0][3]) * rstd * g1[3]);
        qr[d0] = *reinterpret_cast<bf16x8*>(&w); }
}
__device__ __forceinline__ void load_q(const bf16* qrow, const float* g, int hi, bf16x8* qr) { v4u raw[8]; q_issue(qrow, hi, raw); q_finish(raw, g, hi, qr); }
struct PassIO { const bf16* Kp; int ldk; const bf16* Vp; int ldv; int t_lo, t_hi; };
__device__ __forceinline__ void dma_offsets(int wid, int lane, int ldk, int ldv, unsigned& koff, unsigned& voff) {
    const int row = 4 * wid + (lane >> 4); koff = (unsigned)(row * ldk * 2 + (((lane & 15) ^ (row & 7)) << 4));
    const int st = 2 * wid + (lane >> 5), kk = ((st >> 2) << 3) | ((lane & 31) >> 2), k = (kk & ~0xC) | ((kk & 4) << 1) | ((kk & 8) >> 1); voff = (unsigned)(k * ldv * 2 + ((st & 3) * 32 + 8 * (lane & 3)) * 2);
}
#define ATT_DMA(io_, t, slot) do { const char* kt_ = (const char*)(io_).Kp + (size_t)(t) * (KVBLK * 2) * (io_).ldk; const char* vt_ = (const char*)(io_).Vp + (size_t)(t) * (KVBLK * 2) * (io_).ldv;          \
        LAS unsigned* kd_ = (LAS unsigned*)(ldsl + NSLOT * SHM_V + (slot) * SHM_K + wid * 1024); LAS unsigned* vd_ = (LAS unsigned*)(ldsl + (slot) * SHM_V + wid * 1024);                \
        __builtin_amdgcn_global_load_lds((const unsigned*)(kt_ + koff), kd_, 16, 0, 0); __builtin_amdgcn_global_load_lds((const unsigned*)(kt_ + koff + (size_t)64 * (io_).ldk), kd_ + 2048, 16, 0, 0); \
        __builtin_amdgcn_global_load_lds((const unsigned*)(vt_ + voff), vd_, 16, 0, 0); __builtin_amdgcn_global_load_lds((const unsigned*)(vt_ + voff + (size_t)64 * (io_).ldv), vd_ + 2048, 16, 0, 0); } while (0)
__device__ __forceinline__ void attn_prefetch(char* lds, const PassIO& io) {
    int tid = threadIdx.x; asm volatile("" : "+v"(tid));
    const int wid = __builtin_amdgcn_readfirstlane(tid >> 6), lane = tid & 63;
    unsigned koff, voff; dma_offsets(wid, lane, io.ldk, io.ldv, koff, voff);
    LAS unsigned char* ldsl = (LAS unsigned char*)lds;
    ATT_DMA(io, io.t_lo, 0); if (io.t_hi - io.t_lo > 1) ATT_DMA(io, io.t_lo + 1, 1);
}
template <class MaskF>
__device__ __forceinline__ void attn_pass(char* lds, const bf16x8* qr, const PassIO& io, const MaskF& mf, f32x16 (&o)[4], float& l_out) {
    int tid = threadIdx.x; asm volatile("" : "+v"(tid));
    const int wid = __builtin_amdgcn_readfirstlane(tid >> 6), lane = tid & 63, r32 = lane & 31, hi = lane >> 5;
    char* V_lds = lds; char* K_lds = lds + NSLOT * SHM_V;
    float* wsc = (float*)(lds + NSLOT * SHM_V + NSLOT * SHM_K) + wid * 64; float* al_l = wsc + 32;
    float m_reg = -1e30f, l_reg = 0.f;
#pragma unroll
    for (int d = 0; d < 4; ++d) o[d] = f32x16{};
    const int vb0 = (int)(uintptr_t)V_lds + v_rd_base(lane);
    const int t_lo = io.t_lo, NT = io.t_hi - io.t_lo;
    unsigned koff, voff; dma_offsets(wid, lane, io.ldk, io.ldv, koff, voff);
    LAS unsigned char* ldsl = (LAS unsigned char*)lds;
    f32x16 p0, p1; float mn, alpha = 1.f; bf16x8 pa0, pa1, pa2, pa3;
#define A_RESC(a) do { if (__any((a) < 1.f)) { if (hi == 0) al_l[r32] = (a); asm volatile("s_waitcnt lgkmcnt(0)" ::: "memory"); \
        _Pragma("unroll") for (int d_ = 0; d_ < 4; ++d_) _Pragma("unroll") for (int r = 0; r < 16; ++r) o[d_][r] *= al_l[crow(r, hi)]; } } while (0)
#define A_BAR() do { asm volatile("" ::: "memory"); __builtin_amdgcn_s_barrier(); asm volatile("" ::: "memory"); } while (0)
    const bool lead = wid < 4;
    VM_WAIT();
    __syncthreads();
    if (!lead) A_BAR();
    int sK = 0, sV = 2, sW = 1;
    bool act_prev = false;
    for (int i = 0; i < NT; ++i) {
        if (lead && i >= 1 && i + 1 < NT) ATT_DMA(io, t_lo + i + 1, sW);
        const bool act = mf.active(t_lo + i);
        SBAR(); if (act) qkt(p0, p1, K_lds + sK * SHM_K, r32, hi, qr);
        if (i > 0 && act_prev) pv_tile(o, vb0 + sV * SHM_V, pa0, pa1, pa2, pa3);
        if (!lead && i + 1 < NT) VM_WAIT();
        A_BAR();
        if (!lead && i + 2 < NT) ATT_DMA(io, t_lo + i + 2, sV);
        if (act) { mf(p0, p1, t_lo + i); partialSM(p0, p1, m_reg, mn, alpha, mf.keep(t_lo + i)); A_RESC(alpha); finishSM(p0, p1, alpha, l_reg, pa0, pa1, pa2, pa3); }
        act_prev = act;
        if (lead && i + 1 < NT) VM_WAIT();
        A_BAR();
        { const int t_ = sV; sV = sK; sK = sW; sW = t_; }
    }
    if (act_prev) pv_tile(o, vb0 + sV * SHM_V, pa0, pa1, pa2, pa3);
    if (lead) A_BAR();
    __syncthreads();
#undef A_RESC
#undef A_BAR
    l_out = l_reg;
}
__device__ __forceinline__ void row_inv_l(char* lds, float l_reg, float (&rli)[16]) {
    const int tid = threadIdx.x, wid = __builtin_amdgcn_readfirstlane(tid >> 6), lane = tid & 63, r32 = lane & 31, hi = lane >> 5;
    float* wsc = (float*)(lds + NSLOT * SHM_V + NSLOT * SHM_K) + wid * 64;
    if (hi == 0) wsc[r32] = l_reg;
    asm volatile("s_waitcnt lgkmcnt(0)" ::: "memory");
#pragma unroll
    for (int r = 0; r < 16; ++r) { const float l = wsc[crow(r, hi)]; rli[r] = l > 0.f ? __builtin_amdgcn_rcpf(l) : 0.f; }
    asm volatile("s_waitcnt lgkmcnt(0)" ::: "memory");
}
struct NoMask { __device__ __forceinline__ void operator()(f32x16&, f32x16&, int) const {} __device__ __forceinline__ bool active(int) const { return true; } __device__ __forceinline__ bool keep(int) const { return true; } };
}
__device__ __forceinline__ void norm128_rows(const Frame& F, const bf16* src, size_t lds_, bf16* dst, size_t ldd, int nrows, const float* g, int gw, int NGW) {
    const int sub = F.lane >> 4, l16 = F.lane & 15;
    const f32x4 g0 = *(const GAS f32x4*)(g + l16 * 8), g1 = *(const GAS f32x4*)(g + l16 * 8 + 4);
    for (int r0 = gw * 4; r0 < nrows; r0 += NGW * 4) { const int r = r0 + sub;
        const v4u raw = *(const GAS v4u*)(src + (size_t)r * lds_ + l16 * 8);
        float ss = 0.f;
#pragma unroll
        for (int j = 0; j < 4; ++j) { const float a = bflo(raw[j]), b = bfhi(raw[j]); ss += a * a + b * b; }
        ss += __shfl_xor(ss, 1); ss += __shfl_xor(ss, 2); ss += __shfl_xor(ss, 4); ss += __shfl_xor(ss, 8);
        const float rstd = 1.f / sqrtf(ss * (1.f / 128.f) + EPS);
        v4u w; w.x = cvtpk(bflo(raw[0]) * rstd * g0[0], bfhi(raw[0]) * rstd * g0[1]); w.y = cvtpk(bflo(raw[1]) * rstd * g0[2], bfhi(raw[1]) * rstd * g0[3]);
        w.z = cvtpk(bflo(raw[2]) * rstd * g1[0], bfhi(raw[2]) * rstd * g1[1]); w.w = cvtpk(bflo(raw[3]) * rstd * g1[2], bfhi(raw[3]) * rstd * g1[3]);
        *(GAS v4u*)(dst + (size_t)r * ldd + l16 * 8) = w; }
}
__device__ __forceinline__ void phase_memk_norm(const Frame& F, const Args& a, int l, int gw, int NGW) {
    const bf16* kvm = (const bf16*)(F.ws + WS_KVM) + (size_t)l * MMEM * 1024; bf16* km = (bf16*)(F.ws + WS_KM) + (size_t)l * MMEM * 512;
    for (int bh = 0; bh < BATCH * XH; ++bh) { const int b = bh >> 2, h = bh & 3;
        norm128_rows(F, kvm + (size_t)b * MEMLEN * 1024 + h * 128, 1024, km + (size_t)bh * MEMLEN * 128, 128, MEMLEN, a.in[I_XKN] + l * 128, gw, NGW); }
}

__device__ __forceinline__ void phase_cross_attn(const Frame& F, const Args& a, int l) {
    char* lds = (char*)F.lds; const int r32 = F.lane & 31, hi = F.lane >> 5;
    const bf16* QX = (const bf16*)(F.ws + WS_QX); bf16* OX = (bf16*)(F.ws + WS_OX);
    for (int u = F.bid; u < BATCH * XH * (SEQ / 256); u += F.G) {
        const int tb = u % (SEQ / 256), bh = u / (SEQ / 256), b = bh >> 2, h = bh & 3;
        const size_t row0 = (size_t)b * SEQ + tb * 256 + F.wave * 32;
        const bf16* Kp = (const bf16*)(F.ws + WS_KM) + (size_t)l * MMEM * 512 + (size_t)bh * MEMLEN * 128;
        const bf16* Vp = (const bf16*)(F.ws + WS_KVM) + (size_t)l * MMEM * 1024 + (size_t)b * MEMLEN * 1024 + 512 + h * 128;
        const att::PassIO io{Kp, 128, Vp, 1024, 0, MEMLEN / 64}; att::attn_prefetch(lds, io);
        bf16x8 qr[8]; att::load_q(QX + (row0 + r32) * 512 + h * 128, a.in[I_XQN] + l * 128, hi, qr);
        f32x16 o[4]; float l_reg; att::attn_pass(lds, qr, io, att::NoMask{}, o, l_reg);
        float rli[16]; att::row_inv_l(lds, l_reg, rli);
#pragma unroll
        for (int r = 0; r < 16; ++r) { bf16* orow = OX + (row0 + att::crow(r, hi)) * 512 + h * 128;
#pragma unroll
            for (int d0 = 0; d0 < 4; ++d0) { const float v = o[d0][r] * rli[r]; const float vn = __shfl_xor(v, 1);
                if ((r32 & 1) == 0) *(GAS unsigned*)(orow + d0 * 32 + r32) = cvtpk(v, vn); } }
    }
}

constexpr int NSA_GSC = att::LDS_ATT, NSA_IMP = NSA_GSC + NWAVES * 32 * 3 * 4, NSA_SEL = NSA_IMP + NWAVES * 8 * 128 * 4, NSA_SELU = NSA_SEL + 64 * 4 * 4, NSA_LDS_END = NSA_SELU + NWAVES * 4 * 4;
static_assert(NSA_LDS_END <= SCR_BYTES, "nsa lds");
struct CmpMask { int nmax, hi, nmin_wave;
    __device__ __forceinline__ void operator()(f32x16& p0, f32x16& p1, int t) const { if (t * 64 + 63 <= nmin_wave) return; att::mask_tile(p0, p1, nmax - t * 64 - 4 * hi, 0x40000000u); }
    __device__ __forceinline__ bool active(int) const { return true; } __device__ __forceinline__ bool keep(int) const { return true; } };
struct WinMask { int P, hi, qb;
    __device__ __forceinline__ void operator()(f32x16& p0, f32x16& p1, int t) const { if (t == qb || t == qb - 8) att::mask_tile(p0, p1, P - t * 64 - 4 * hi, 512u); }
    __device__ __forceinline__ bool active(int) const { return true; } __device__ __forceinline__ bool keep(int) const { return true; } };
struct SlcMask { const LAS unsigned* selw; const LAS unsigned* uni; int P, hi, qb;
    __device__ __forceinline__ void operator()(f32x16& p0, f32x16& p1, int t) const { if (t == qb) att::mask_tile(p0, p1, P - t * 64 - 4 * hi, 0x40000000u); }
    __device__ __forceinline__ bool keep(int t) const { return (selw[t >> 5] >> (t & 31)) & 1u; }
    __device__ __forceinline__ bool active(int t) const { return (__builtin_amdgcn_readfirstlane(uni[t >> 5]) >> (t & 31)) & 1u; } };

__device__ __forceinline__ void nsa_unit(const Frame& F, const Args& a, int b, int g, int qb, int dry = 0) {
    char* lds = (char*)F.lds; const int w = F.wave; const int t0 = qb * 64;
#define NSA_LANE() int lane = F.lane; asm volatile("" : "+v"(lane)); const int r32 = lane & 31, hi = lane >> 5; const int tok = 8 * w + (r32 >> 2), head = 4 * g + (r32 & 3), P = t0 + tok; (void)head; (void)P; (void)tok
    unsigned char* wsl = F.ws; asm volatile("" : "+s"(wsl));
    const bf16* Y0 = (const bf16*)(wsl + WS_Y0); const bf16* KV6 = (const bf16*)(wsl + WS_KV6);
    const size_t slab = (size_t)SEQ * 128, bg = (size_t)(b * 2 + g);
    LAS float* gsc = (LAS float*)(F.lds + NSA_GSC) + w * 96; LAS float* imp = (LAS float*)(F.lds + NSA_IMP) + w * 1024; LAS unsigned* selm = (LAS unsigned*)(F.lds + NSA_SEL);
    { NSA_LANE();
      if (hi == 0) {
#pragma unroll
        for (int br = 0; br < 3; ++br) gsc[r32 * 3 + br] = fsigmoid(bf2f(Y0[((size_t)b * SEQ + P) * EV_INP + 4608 + head * 3 + br]) + a.in[I_GATEB][head * 3 + br]); }
      LDS_WAIT(); }
    f32x16 o[4]; float l_reg; float rli[16];
    const bf16* KCMP = (const bf16*)(wsl + WS_KVCMP) + bg * 512 * 128; const bf16* VCMP = (const bf16*)(wsl + WS_KVCMP) + (size_t)2048 * 128 + bg * 512 * 128;
    const int ncmp_t = ((4 * qb + 2) >> 6) + 1;
    const att::PassIO io_imp{KCMP, 128, (const bf16*)(wsl + WS_OV), 128, 0, ncmp_t}, io_cmp{KCMP, 128, VCMP, 128, 0, ncmp_t},
                      io_slc{KV6 + (2 * 4 + bg) * slab, 128, KV6 + (3 * 4 + bg) * slab, 128, 0, qb + 1}, io_win{KV6 + (4 * 4 + bg) * slab, 128, KV6 + (5 * 4 + bg) * slab, 128, qb >= 8 ? qb - 8 : 0, qb + 1};
    v4u qraw[8];
#define NSA_QISSUE() do { NSA_LANE(); att::q_issue(Y0 + ((size_t)b * SEQ + P) * EV_INP + 2048 + head * 128, hi, qraw); } while (0)
    att::attn_prefetch(lds, io_imp); NSA_QISSUE();
    { NSA_LANE(); const CmpMask cm{(P - 31) >> 4, hi, (t0 + 8 * w - 31) >> 4};
      bf16x8 qr[8]; att::q_finish(qraw, a.in[I_QNORM], hi, qr);
      if (dry < 2) att::attn_pass(lds, qr, io_imp, cm, o, l_reg); else { VM_WAIT(); __syncthreads(); l_reg = 1.f; } }
    att::attn_prefetch(lds, io_cmp); NSA_QISSUE();
    if (dry < 3) {
    att::row_inv_l(lds, l_reg, rli);
    { NSA_LANE();
#pragma unroll
    for (int q = 0; q < 4; ++q)
#pragma unroll
        for (int d = 0; d < 4; ++d) { float s = 0.f;
#pragma unroll
            for (int i = 0; i < 4; ++i) s += o[d][4 * q + i] * rli[4 * q + i];
            imp[(2 * q + hi) * 128 + d * 32 + r32] = s; }
    LDS_WAIT();
    { const unsigned long long lt = (1ull << lane) - 1ull;
#pragma unroll 1
    for (int tl = 0; tl < 8; ++tl) { unsigned k0, k1;
        { const int j0 = lane, j1 = lane + 64; const float v0 = imp[tl * 128 + j0], v1 = imp[tl * 128 + j1];
          const float s0 = v0 + (((j0 == 0) || (j0 == qb) || (j0 == qb - 1)) ? 100.f : 0.f), s1 = v1 + (((j1 == 0) || (j1 == qb) || (j1 == qb - 1)) ? 100.f : 0.f);
          k0 = (j0 <= qb) ? __float_as_uint(s0) + 1u : 0u; k1 = (j1 <= qb) ? __float_as_uint(s1) + 1u : 0u; }
        unsigned T = 0u;
#pragma unroll 1
        for (int bit = 30; bit >= 0; --bit) { const unsigned cand = T | (1u << bit);
            const int cnt = __popcll(__ballot(k0 >= cand)) + __popcll(__ballot(k1 >= cand)); if (cnt >= 16) T = cand; }
        const unsigned long long g0 = __ballot(k0 > T), g1 = __ballot(k1 > T), e0 = __ballot(k0 == T), e1 = __ballot(k1 == T);
        const int need = 16 - (__popcll(g0) + __popcll(g1));
        const bool sel0 = (k0 > T) || (k0 == T && __popcll(e0 & lt) < need), sel1 = (k1 > T) || (k1 == T && __popcll(e0) + __popcll(e1 & lt) < need);
        const unsigned long long m0 = __ballot(sel0 && lane <= qb), m1 = __ballot(sel1 && lane + 64 <= qb);
        if (lane == 0) { LAS unsigned* sw = selm + (8 * w + tl) * 4; sw[0] = (unsigned)m0; sw[1] = (unsigned)(m0 >> 32); sw[2] = (unsigned)m1; sw[3] = (unsigned)(m1 >> 32); } } }
    LDS_WAIT();
    if (lane < 4) { unsigned u = 0;
#pragma unroll
        for (int tl = 0; tl < 8; ++tl) u |= selm[(8 * w + tl) * 4 + lane];
        ((LAS unsigned*)(F.lds + NSA_SELU))[w * 4 + lane] = u; }
    LDS_WAIT(); }
    }
    { NSA_LANE(); const CmpMask cm{(P - 31) >> 4, hi, (t0 + 8 * w - 31) >> 4};
      bf16x8 qr[8]; att::q_finish(qraw, a.in[I_QNORM], hi, qr);
#if defined(MK_NSA_DUP) && MK_NSA_DUP == 2
      att::attn_pass(lds, qr, io_cmp, cm, o, l_reg); att::attn_prefetch(lds, io_cmp);
#endif
      if (dry < 2) att::attn_pass(lds, qr, io_cmp, cm, o, l_reg); else { VM_WAIT(); __syncthreads(); l_reg = 1.f; } }
    att::attn_prefetch(lds, io_slc); NSA_QISSUE();
    att::row_inv_l(lds, l_reg, rli);
    unsigned oacc[4][8];
    if (dry < 4) { NSA_LANE();
#pragma unroll
    for (int r = 0; r < 16; ++r) rli[r] *= gsc[att::crow(r, hi) * 3 + 0];
#pragma unroll
    for (int d = 0; d < 4; ++d)
#pragma unroll
        for (int r = 0; r < 16; r += 2) oacc[d][r >> 1] = cvtpk(o[d][r] * rli[r], o[d][r + 1] * rli[r + 1]); }
    { NSA_LANE(); const SlcMask sm{selm + tok * 4, (const LAS unsigned*)(F.lds + NSA_SELU) + w * 4, P, hi, qb};
      bf16x8 qr[8]; att::q_finish(qraw, a.in[I_QNORM], hi, qr);
#if defined(MK_NSA_DUP) && MK_NSA_DUP == 5
      { const size_t bg2 = (bg + 1) & 3; const att::PassIO io_cold{KV6 + (2 * 4 + bg2) * slab, 128, KV6 + (3 * 4 + bg2) * slab, 128, 0, qb + 1};
        att::attn_pass(lds, qr, io_cold, sm, o, l_reg); att::attn_prefetch(lds, io_slc); }
#endif
#if defined(MK_NSA_DUP) && MK_NSA_DUP == 3
      att::attn_pass(lds, qr, io_slc, sm, o, l_reg); att::attn_prefetch(lds, io_slc);
#endif
      if (!dry) att::attn_pass(lds, qr, io_slc, sm, o, l_reg); else { VM_WAIT(); __syncthreads(); } }
    att::attn_prefetch(lds, io_win); NSA_QISSUE();
    att::row_inv_l(lds, l_reg, rli);
    if (dry < 4) { NSA_LANE();
#pragma unroll
    for (int r = 0; r < 16; ++r) rli[r] *= gsc[att::crow(r, hi) * 3 + 1];
#pragma unroll
    for (int d = 0; d < 4; ++d)
#pragma unroll
        for (int r = 0; r < 16; r += 2) oacc[d][r >> 1] = cvtpk(bflo(oacc[d][r >> 1]) + o[d][r] * rli[r], bfhi(oacc[d][r >> 1]) + o[d][r + 1] * rli[r + 1]); }
    { NSA_LANE(); const WinMask wm{P, hi, qb};
      bf16x8 qr[8]; att::q_finish(qraw, a.in[I_QNORM], hi, qr);
#if defined(MK_NSA_DUP) && MK_NSA_DUP == 4
      att::attn_pass(lds, qr, io_win, wm, o, l_reg); att::attn_prefetch(lds, io_win);
#endif
      if (dry < 2) att::attn_pass(lds, qr, io_win, wm, o, l_reg); else { VM_WAIT(); __syncthreads(); l_reg = 1.f; } }
    att::row_inv_l(lds, l_reg, rli);
    if (dry < 4) { NSA_LANE();
    bf16* MIX = dry ? (bf16*)(wsl + WS_R + 400 * MiB) : (bf16*)(wsl + WS_MIX);
#pragma unroll
    for (int r = 0; r < 16; ++r) rli[r] *= gsc[att::crow(r, hi) * 3 + 2];
    bf16* obase = MIX + ((size_t)b * SEQ + t0 + 8 * w) * 2048 + 1024 + 4 * g * 128 + r32;
#pragma unroll
    for (int d0 = 0; d0 < 4; ++d0) {
#pragma unroll
        for (int r = 0; r < 16; ++r) { const int row = att::crow(r, hi); const float v = ((r & 1) ? bfhi(oacc[d0][r >> 1]) : bflo(oacc[d0][r >> 1])) + o[d0][r] * rli[r]; const float vn = __shfl_xor(v, 1);
            if ((r32 & 1) == 0) *(GAS unsigned*)(obase + (size_t)(row >> 2) * 2048 + (row & 3) * 128 + d0 * 32) = cvtpk(v, vn); }
        } }
    __syncthreads();
#undef NSA_QISSUE
#undef NSA_LANE
}
__device__ __forceinline__ void phase_nsa(const Frame& F, const Args& a) {
#pragma unroll 1
    for (int it = F.bid * 2; it < 512; it += F.G * 2)
#pragma unroll 1
        for (int k = 0; k < 2; ++k) { const int p = it >> 1, xcd = p & 7, bg = xcd >> 1, x = (xcd & 1) * 32 + (p >> 3);
#if defined(MK_NSA_DRY)
            nsa_unit(F, a, bg >> 1, bg & 1, k == 0 ? 127 - x : x, MK_NSA_DRY);
#endif
            nsa_unit(F, a, bg >> 1, bg & 1, k == 0 ? 127 - x : x); }
}
__device__ __forceinline__ f32x4 mma16(const LAS bf16* A, int pa, const LAS bf16* B, int pb, int K, f32x4 acc, int fr, int fq) {
    for (int k0 = 0; k0 < K; k0 += 32) { const bf16x8 af = *(const LAS bf16x8*)(A + fr * pa + k0 + 8 * fq); const bf16x8 bfv = *(const LAS bf16x8*)(B + fr * pb + k0 + 8 * fq);
        acc = __builtin_amdgcn_mfma_f32_16x16x32_bf16(af, bfv, acc, 0, 0, 0); }
    return acc;
}

__device__ __forceinline__ f32x4 mma16r(const LAS bf16* Arow, const LAS bf16* Brow, int K, f32x4 acc, int fq) {
    for (int k0 = 0; k0 < K; k0 += 32) { const bf16x8 af = *(const LAS bf16x8*)(Arow + k0 + 8 * fq); const bf16x8 bfv = *(const LAS bf16x8*)(Brow + k0 + 8 * fq);
        acc = __builtin_amdgcn_mfma_f32_16x16x32_bf16(af, bfv, acc, 0, 0, 0); }
    return acc;
}

__device__ __forceinline__ void phase_cmp2(const Frame& F, const Args& a, int u_lo, int u_hi, int u_step) {
    LAS bf16* hidS = (LAS bf16*)F.lds; LAS bf16* w2T = (LAS bf16*)(F.lds + 32 * 264 * 2); LAS float* outS = (LAS float*)(F.lds + 32 * 264 * 2 + 128 * 264 * 2);
    const int fr = F.lane & 15, fq = F.lane >> 4;
    for (int u = u_lo; u < u_hi; u += u_step) { const int mm = u >> 6, rb = u & 63;
        const bf16* hid = (const bf16*)(F.ws + WS_HID) + (size_t)mm * 2048 * 256 + (size_t)rb * 32 * 256; const float* w2 = a.in[mm ? I_CVW2 : I_CKW2];
        for (int i = F.tid; i < 32 * 32; i += NTHR) { const int r = i >> 5, c8 = i & 31; *(LAS v4u*)(hidS + r * 264 + c8 * 8) = *(const GAS v4u*)(hid + r * 256 + c8 * 8); }
        for (int i = F.tid; i < 256 * 128; i += NTHR) { const int k = i >> 7, c = i & 127; w2T[c * 264 + k] = (bf16)f2bf(w2[i]); }
        __syncthreads();
        const int rt = F.wave & 1;
#pragma unroll
        for (int cc = 0; cc < 2; ++cc) { const int ct = (F.wave >> 1) * 2 + cc; f32x4 acc = {0.f, 0.f, 0.f, 0.f};
            acc = mma16(hidS + rt * 16 * 264, 264, w2T + ct * 16 * 264, 264, 256, acc, fr, fq);
#pragma unroll
            for (int e = 0; e < 4; ++e) outS[(rt * 16 + 4 * fq + e) * 132 + ct * 16 + fr] = acc[e]; }
        __syncthreads();
        { const int r = F.wave * 4 + (F.lane >> 4), l16 = F.lane & 15; const int grow = rb * 32 + r, n = grow & 511;
          float v[8]; float ss = 0.f;
#pragma unroll
          for (int j = 0; j < 8; ++j) { v[j] = outS[r * 132 + l16 * 8 + j]; ss += v[j] * v[j]; }
          ss += __shfl_xor(ss, 1); ss += __shfl_xor(ss, 2); ss += __shfl_xor(ss, 4); ss += __shfl_xor(ss, 8);
          if (mm == 0) { const float rstd = 1.f / sqrtf(ss * (1.f / 128.f) + EPS); const float* g = a.in[I_KNORM];
#pragma unroll
              for (int j = 0; j < 8; ++j) v[j] = v[j] * rstd * g[l16 * 8 + j]; }
          if (n == 511) {
#pragma unroll
              for (int j = 0; j < 8; ++j) v[j] = 0.f; }
          v4u w; w.x = cvtpk(v[0], v[1]); w.y = cvtpk(v[2], v[3]); w.z = cvtpk(v[4], v[5]); w.w = cvtpk(v[6], v[7]);
          *(GAS v4u*)((bf16*)(F.ws + WS_KVCMP) + (size_t)mm * 2048 * 128 + (size_t)grow * 128 + l16 * 8) = w; }
        __syncthreads();
    }
}

__device__ __forceinline__ void rglru_unit(const Frame& F, const Args& a, int b, int h, int s) {
    const int w = F.wave, lane = F.lane, fr = lane & 15, fq = lane >> 4;
    LAS bf16* xcs = (LAS bf16*)F.lds + w * (16 * 136); LAS float* summ = (LAS float*)(F.lds + 8 * 16 * 136 * 2);
    const bf16* Y0 = (const bf16*)(F.ws + WS_Y0) + (size_t)b * SEQ * EV_INP; bf16* MIX = (bf16*)(F.ws + WS_MIX) + (size_t)b * SEQ * 2048;
    const int ch = h * 128 + s * 16 + fr;
    bf16x8 ba_f[4], bx_f[4];
    { const float* wa = a.in[I_RGWA] + (size_t)h * 128 * 128 + s * 16 + fr; const float* wx = a.in[I_RGWX] + (size_t)h * 128 * 128 + s * 16 + fr;
#pragma unroll
      for (int kk = 0; kk < 4; ++kk) { v4u ua, ux;
#pragma unroll
          for (int e2 = 0; e2 < 4; ++e2) { const int k = 32 * kk + 8 * fq + 2 * e2; ua[e2] = pk2(wa[(size_t)k * 128], wa[(size_t)(k + 1) * 128]); ux[e2] = pk2(wx[(size_t)k * 128], wx[(size_t)(k + 1) * 128]); }
          ba_f[kk] = *reinterpret_cast<bf16x8*>(&ua); bx_f[kk] = *reinterpret_cast<bf16x8*>(&ux); } }
    const float bias_a = a.in[I_RGBA][ch], bias_x = a.in[I_RGBX][ch], c8 = -8.f * fsoftplus(-a.in[I_RGLAM][ch]);
    const int cg = h * 128 + 2 * lane; float cw0[4], cw1[4];
#pragma unroll
    for (int j = 0; j < 4; ++j) { cw0[j] = a.in[I_RGCW][j * 1024 + cg]; cw1[j] = a.in[I_RGCW][j * 1024 + cg + 1]; }
    const float cb0 = a.in[I_RGCB][cg], cb1 = a.in[I_RGCB][cg + 1];
    float carry = 0.f;
    unsigned raw[19];
#define RG_LOAD(c_) do { const int T0_ = (c_) * 128 + 16 * w; _Pragma("unroll") for (int i = 0; i < 19; ++i) { const int t = T0_ - 3 + i; raw[i] = (t >= 0) ? *(const GAS unsigned*)(Y0 + (size_t)t * EV_INP + cg) : 0u; } } while (0)
    RG_LOAD(0);
#ifdef MK_DUP_RG
    for (int cc = 0; cc < 2 * (SEQ / 128); ++cc) { const int c = cc & (SEQ / 128 - 1); if (cc == SEQ / 128) { carry = 0.f; RG_LOAD(0); }
#else
    for (int c = 0; c < SEQ / 128; ++c) {
#endif
        const int T0 = c * 128 + 16 * w;
#pragma unroll
        for (int tt = 0; tt < 16; ++tt) { float y0 = cb0, y1 = cb1;
#pragma unroll
            for (int j = 0; j < 4; ++j) { y0 += cw0[j] * bflo(raw[tt + j]); y1 += cw1[j] * bfhi(raw[tt + j]); }
            *(LAS unsigned*)(xcs + tt * 136 + 2 * lane) = cvtpk(y0, y1); }
        LDS_WAIT();
        if (c + 1 < SEQ / 128) RG_LOAD(c + 1);
        unsigned short gg[4];
#pragma unroll
        for (int e = 0; e < 4; ++e) gg[e] = Y0[(size_t)(T0 + 4 * fq + e) * EV_INP + 1024 + ch];
        f32x4 acc_a = {0.f, 0.f, 0.f, 0.f}, acc_x = {0.f, 0.f, 0.f, 0.f};
#pragma unroll
        for (int kk = 0; kk < 4; ++kk) { const bf16x8 af = *(const LAS bf16x8*)(xcs + fr * 136 + 32 * kk + 8 * fq);
            acc_a = __builtin_amdgcn_mfma_f32_16x16x32_bf16(af, ba_f[kk], acc_a, 0, 0, 0); acc_x = __builtin_amdgcn_mfma_f32_16x16x32_bf16(af, bx_f[kk], acc_x, 0, 0, 0); }
        float hl[4], pl[4]; float hh = 0.f, pp = 1.f;
#pragma unroll
        for (int e = 0; e < 4; ++e) { const float xv = bf2f(xcs[(4 * fq + e) * 136 + s * 16 + fr]);
            const float r = fsigmoid(acc_a[e] + bias_a), ig = fsigmoid(acc_x[e] + bias_x); const float la = c8 * r; const float av = __expf(la);
            const float uu = __builtin_amdgcn_sqrtf((1.f - av) * (1.f + av)) * (ig * xv);
            hh = av * hh + uu; pp *= av; hl[e] = hh; pl[e] = pp; }
        float Apre = 1.f, Hpre = 0.f, Aw = 1.f, Hw = 0.f;
#pragma unroll
        for (int q = 0; q < 4; ++q) { const float Aq = __shfl(pp, fr + 16 * q), Hq = __shfl(hh, fr + 16 * q);
            if (q < fq) { Hpre = Aq * Hpre + Hq; Apre *= Aq; }
            Hw = Aq * Hw + Hq; Aw *= Aq; }
        LAS float* sm = summ + (c & 1) * 256;
        if (fq == 0) { sm[(w * 16 + fr) * 2] = Aw; sm[(w * 16 + fr) * 2 + 1] = Hw; }
        __syncthreads();
        float cin = carry, call = carry;
#pragma unroll
        for (int q = 0; q < 8; ++q) { const float Aq = sm[(q * 16 + fr) * 2], Hq = sm[(q * 16 + fr) * 2 + 1]; call = Aq * call + Hq; if (q < w) cin = call; }
        carry = call;
        const float cl = Apre * cin + Hpre;
#pragma unroll
        for (int e = 0; e < 4; ++e) { const float hv = hl[e] + pl[e] * cl; MIX[(size_t)(T0 + 4 * fq + e) * 2048 + ch] = (bf16)f2bf(gelu_tanh(bf2f(gg[e])) * hv); }
    }
#undef RG_LOAD
    __syncthreads();
}
constexpr size_t WS_M_CN = WS_R + 168 * MiB + 64 * MiB;
constexpr size_t WS_M_BN = WS_M_CN + 16 * MiB, WS_M_BT = WS_M_BN + 16 * MiB, WS_M_XT = WS_M_BT + 16 * MiB, WS_M_ACS = WS_M_XT + 64 * MiB, WS_M_DTV = WS_M_ACS + 2 * MiB,
                 WS_M_ST = WS_M_DTV + 2 * MiB, WS_M_PV = WS_M_ST + 128 * MiB, WS_M_END = WS_M_PV + 64 * MiB;
static_assert(WS_M_END <= WS_R + 560 * MiB, "mamba ws");
constexpr int MB_P = 136;
__device__ __forceinline__ void conv4_silu(const v4u (&rows)[7], const float* cw, int ldw, const float* cb, float (&out)[4][8]) {
    float wv[4][8], bv[8];
#pragma unroll
    for (int j = 0; j < 4; ++j) { const f32x4 w0 = *(const GAS f32x4*)(cw + (size_t)j * ldw), w1 = *(const GAS f32x4*)(cw + (size_t)j * ldw + 4);
#pragma unroll
        for (int i = 0; i < 4; ++i) { wv[j][i] = w0[i]; wv[j][4 + i] = w1[i]; } }
    { const f32x4 b0 = *(const GAS f32x4*)cb, b1 = *(const GAS f32x4*)(cb + 4);
#pragma unroll
      for (int i = 0; i < 4; ++i) { bv[i] = b0[i]; bv[4 + i] = b1[i]; } }
#pragma unroll
    for (int tt = 0; tt < 4; ++tt)
#pragma unroll
        for (int i2 = 0; i2 < 4; ++i2) { float y0 = bv[2 * i2], y1 = bv[2 * i2 + 1];
#pragma unroll
            for (int j = 0; j < 4; ++j) { y0 += wv[j][2 * i2] * bflo(rows[tt + j][i2]); y1 += wv[j][2 * i2 + 1] * bfhi(rows[tt + j][i2]); }
            out[tt][2 * i2] = fsilu(y0); out[tt][2 * i2 + 1] = fsilu(y1); }
}
__device__ __forceinline__ void od_dt_cols(const Frame& F, const bf16* X, const bf16* Wt, const float* ssq, bf16* Y1) {
    typedef float f32x16_t __attribute__((ext_vector_type(16)));
    int t_ = threadIdx.x; asm volatile("" : "+v"(t_));
    const int wave = __builtin_amdgcn_readfirstlane(t_ >> 6), lane = t_ & 63;
    const int r32 = lane & 31, hi = lane >> 5, kq = wave & 3;
    LAS float* red = (LAS float*)F.lds;
    for (int t0 = F.bid * 2; t0 < M / 32; t0 += F.G * 2) { const int r0 = (t0 + (wave >> 2)) * 32;
        const bf16* xa = X + (size_t)(r0 + r32) * D + 256 * kq + 8 * hi; const bf16* wb = Wt + (size_t)(5120 + r32) * D + 256 * kq + 8 * hi;
        f32x16_t acc;
#pragma unroll
        for (int r = 0; r < 16; ++r) acc[r] = 0.f;
        pg8::bf16x8 av[16], bv[16];
#pragma unroll
        for (int u = 0; u < 16; ++u) { av[u] = *(const GAS pg8::bf16x8*)(xa + 16 * u); bv[u] = *(const GAS pg8::bf16x8*)(wb + 16 * u); }
#pragma unroll
        for (int u = 0; u < 16; ++u) acc = __builtin_amdgcn_mfma_f32_32x32x16_bf16(av[u], bv[u], acc, 0, 0, 0);
        if (kq != 0) {
#pragma unroll
            for (int r = 0; r < 16; ++r) red[(wave * 16 + r) * 64 + lane] = acc[r]; }
        __syncthreads();
        if (kq == 0) { const float rs_l = pg8::row_rstd(ssq, r0 + r32);
#pragma unroll
            for (int r = 0; r < 16; ++r) { const int row = (r & 3) + 8 * (r >> 2) + 4 * hi; const float rs = __shfl(rs_l, row);
                const float v = (acc[r] + red[((wave + 1) * 16 + r) * 64 + lane]) + (red[((wave + 2) * 16 + r) * 64 + lane] + red[((wave + 3) * 16 + r) * 64 + lane]);
                Y1[(size_t)(r0 + row) * OD_INP + 5120 + r32] = (bf16)f2bf(v * rs); } }
        __syncthreads();
    }
}
__device__ __forceinline__ void phase_mamba_prep(const Frame& F, const Args& a) {
    LAS bf16* T = (LAS bf16*)F.lds;
    LAS float* acsS = (LAS float*)(F.lds + 128 * MB_P * 2); LAS float* dtS = acsS + 256;
    const int tid = F.tid, lane = F.lane, w = F.wave, sg = tid >> 4, cv = tid & 15;
    const float* cw = a.in[I_ODCW]; const float* cb = a.in[I_ODCB];
    v4u rows[7];
#define M0_LOAD(u_) do { const int bc_ = (u_) / 24, sl_ = (u_) % 24, T0_ = (bc_ & 63) * 128; const bf16* Y1_ = (const bf16*)(F.ws + WS_Y1) + (size_t)(bc_ >> 6) * SEQ * OD_INP; \
        _Pragma("unroll") for (int i = 0; i < 7; ++i) { const int t = T0_ + 4 * sg - 3 + i; rows[i] = (t >= 0) ? *(const GAS v4u*)(Y1_ + (size_t)t * OD_INP + 2048 + sl_ * 128 + cv * 8) : (v4u){0u, 0u, 0u, 0u}; } } while (0)
    if (F.bid < 128 * 24) M0_LOAD(F.bid);
    for (int u = F.bid; u < 128 * 24; u += F.G) { const int bc = u / 24, sl = u % 24, b = bc >> 6, c = bc & 63, T0 = c * 128;
        const bf16* Y1 = (const bf16*)(F.ws + WS_Y1) + (size_t)b * SEQ * OD_INP; const int ch0 = sl * 128;
        { float vals[4][8];
          conv4_silu(rows, cw + ch0 + cv * 8, 3072, cb + ch0 + cv * 8, vals);
          if (u + F.G < 128 * 24) M0_LOAD(u + F.G);
#pragma unroll
          for (int tt = 0; tt < 4; ++tt) { v4u o; o.x = cvtpk(vals[tt][0], vals[tt][1]); o.y = cvtpk(vals[tt][2], vals[tt][3]); o.z = cvtpk(vals[tt][4], vals[tt][5]); o.w = cvtpk(vals[tt][6], vals[tt][7]);
              *(LAS v4u*)(T + (4 * sg + tt) * MB_P + cv * 8) = o; } }
        if (sl < 16 && w < 2) { const int h = 2 * sl + w;
            const float Ah = -__expf(a.in[I_ALOG][h]), dtb = a.in[I_DTB][h];
            const float d0 = fsoftplus(bf2f(Y1[(size_t)(T0 + 2 * lane) * OD_INP + 5120 + h]) + dtb), d1 = fsoftplus(bf2f(Y1[(size_t)(T0 + 2 * lane + 1) * OD_INP + 5120 + h]) + dtb);
            const float a0 = d0 * Ah, a1 = d1 * Ah; float pr = a0 + a1;
#pragma unroll
            for (int off = 1; off < 64; off <<= 1) { const float t = __shfl_up(pr, off); if (lane >= off) pr += t; }
            const float ex = pr - (a0 + a1); const float c0 = ex + a0, c1 = ex + a0 + a1;
            acsS[w * 128 + 2 * lane] = c0; acsS[w * 128 + 2 * lane + 1] = c1; dtS[w * 128 + 2 * lane] = d0; dtS[w * 128 + 2 * lane + 1] = d1;
            float* ACS = (float*)(F.ws + WS_M_ACS) + ((size_t)bc * 32 + h) * 128; float* DTV = (float*)(F.ws + WS_M_DTV) + ((size_t)bc * 32 + h) * 128;
            typedef float f32x2v __attribute__((ext_vector_type(2))); *(GAS f32x2v*)(ACS + 2 * lane) = (f32x2v){c0, c1}; *(GAS f32x2v*)(DTV + 2 * lane) = (f32x2v){d0, d1}; }
        __syncthreads();
        if (sl < 16) {
            const int cc = tid >> 2, s0 = (tid & 3) * 32, hh = cc >> 6; bf16* XT = (bf16*)(F.ws + WS_M_XT) + (((size_t)bc * 32 + 2 * sl) * 64 + cc) * 128 + s0;
#pragma unroll
            for (int k8 = 0; k8 < 4; ++k8) { float v[8];
#pragma unroll
                for (int k = 0; k < 8; ++k) { const int s = s0 + 8 * k8 + k; v[k] = bf2f(T[s * MB_P + cc]) * dtS[hh * 128 + s]; }
                v4u o; o.x = cvtpk(v[0], v[1]); o.y = cvtpk(v[2], v[3]); o.z = cvtpk(v[4], v[5]); o.w = cvtpk(v[6], v[7]); *(GAS v4u*)(XT + 8 * k8) = o; } }
        else { const int g = (sl - 16) & 3; const bool isB = sl < 20;
            bf16* N = (bf16*)(F.ws + (isB ? WS_M_BN : WS_M_CN)) + ((size_t)b * SEQ + T0) * 512 + g * 128;
            for (int i = tid; i < 128 * 16; i += NTHR) { const int s = i >> 4, c8 = i & 15; *(GAS v4u*)(N + (size_t)s * 512 + c8 * 8) = *(const LAS v4u*)(T + s * MB_P + c8 * 8); }
            if (isB) { const int cc = tid >> 2, s0 = (tid & 3) * 32; bf16* BT = (bf16*)(F.ws + WS_M_BT) + (((size_t)bc * 4 + g) * 128 + cc) * 128 + s0;
#pragma unroll
                for (int k8 = 0; k8 < 4; ++k8) { unsigned short v[8];
#pragma unroll
                    for (int k = 0; k < 8; ++k) v[k] = T[(s0 + 8 * k8 + k) * MB_P + cc];
                    v4u o; o.x = v[0] | ((unsigned)v[1] << 16); o.y = v[2] | ((unsigned)v[3] << 16); o.z = v[4] | ((unsigned)v[5] << 16); o.w = v[6] | ((unsigned)v[7] << 16); *(GAS v4u*)(BT + 8 * k8) = o; } } }
        __syncthreads();
    }
#undef M0_LOAD
}
__device__ __forceinline__ void phase_mamba_states(const Frame& F) {
    LAS bf16* BTs = (LAS bf16*)F.lds; LAS bf16* XW = (LAS bf16*)(F.lds + 128 * MB_P * 2); LAS bf16* STs = (LAS bf16*)(F.lds + 192 * MB_P * 2);
    const int tid = F.tid, lane = F.lane, w = F.wave, fr = lane & 15, fq = lane >> 4;
    for (int u = F.bid; u < 128 * 4; u += F.G) { const int bc = u >> 2, g = u & 3;
        const bf16* BT = (const bf16*)(F.ws + WS_M_BT) + ((size_t)bc * 4 + g) * 128 * 128;
        for (int i = tid; i < 128 * 16; i += NTHR) { const int n = i >> 4, c8 = i & 15; *(LAS v4u*)(BTs + n * MB_P + c8 * 8) = *(const GAS v4u*)(BT + (size_t)n * 128 + c8 * 8); }
#pragma unroll 1
        for (int hh = 0; hh < 8; ++hh) { const int h = g * 8 + hh;
            const bf16* XT = (const bf16*)(F.ws + WS_M_XT) + ((size_t)bc * 32 + h) * 64 * 128; const float* ACS = (const float*)(F.ws + WS_M_ACS) + ((size_t)bc * 32 + h) * 128;
            const float aL = ACS[127];
#pragma unroll
            for (int k = 0; k < 2; ++k) { const int i = tid + k * NTHR, p = i >> 4, c8 = i & 15; const v4u raw = *(const GAS v4u*)(XT + (size_t)p * 128 + c8 * 8);
                const f32x4 a0 = *(const GAS f32x4*)(ACS + c8 * 8), a1 = *(const GAS f32x4*)(ACS + c8 * 8 + 4);
                v4u o; o.x = cvtpk(bflo(raw[0]) * __expf(aL - a0[0]), bfhi(raw[0]) * __expf(aL - a0[1])); o.y = cvtpk(bflo(raw[1]) * __expf(aL - a0[2]), bfhi(raw[1]) * __expf(aL - a0[3]));
                o.z = cvtpk(bflo(raw[2]) * __expf(aL - a1[0]), bfhi(raw[2]) * __expf(aL - a1[1])); o.w = cvtpk(bflo(raw[3]) * __expf(aL - a1[2]), bfhi(raw[3]) * __expf(aL - a1[3]));
                *(LAS v4u*)(XW + p * MB_P + c8 * 8) = o; }
            __syncthreads();
            bf16* ST = (bf16*)(F.ws + WS_M_ST) + ((size_t)bc * 32 + h) * 64 * 128;
#pragma unroll
            for (int pt = 0; pt < 4; ++pt) { f32x4 acc = {0.f, 0.f, 0.f, 0.f}; acc = mma16(XW + pt * 16 * MB_P, MB_P, BTs + w * 16 * MB_P, MB_P, 128, acc, fr, fq);
#pragma unroll
                for (int e = 0; e < 4; ++e) STs[(pt * 16 + 4 * fq + e) * MB_P + w * 16 + fr] = (bf16)f2bf(acc[e]); }
            __syncthreads();
#pragma unroll
            for (int k = 0; k < 2; ++k) { const int i = tid + k * NTHR, pp = i >> 4, c8 = i & 15; *(GAS v4u*)(ST + (size_t)pp * 128 + c8 * 8) = *(const LAS v4u*)(STs + pp * MB_P + c8 * 8); }
        }
    }
}
__device__ __forceinline__ void phase_mamba_scan(const Frame& F) {
    const int gt = F.bid * NTHR + F.tid;
    const bf16* STg = (const bf16*)(F.ws + WS_M_ST); bf16* PVg = (bf16*)(F.ws + WS_M_PV); const float* ACSg = (const float*)(F.ws + WS_M_ACS);
    for (int i = gt; i < BATCH * 32 * 64 * 32; i += F.G * NTHR) { const int n4 = i & 31, p = (i >> 5) & 63, h = (i >> 11) & 31, b = i >> 16;
        f32x4 S = {0.f, 0.f, 0.f, 0.f};
        const size_t off0 = (((size_t)b * 64 * 32 + h) * 64 + p) * 128 + n4 * 4, cstep = (size_t)32 * 64 * 128;
        const float* al = ACSg + ((size_t)b * 64 * 32 + h) * 128 + 127;
#pragma unroll 1
        for (int c0 = 0; c0 < 64; c0 += 16) {
            v2u sr[16]; float dl[16];
#pragma unroll
            for (int j = 0; j < 16; ++j) { sr[j] = *(const GAS v2u*)(STg + off0 + (size_t)(c0 + j) * cstep); dl[j] = al[(size_t)(c0 + j) * 32 * 128]; }
#pragma unroll
            for (int j = 0; j < 16; ++j) { const float dec = __expf(dl[j]); const f32x4 st = {bflo(sr[j].x), bfhi(sr[j].x), bflo(sr[j].y), bfhi(sr[j].y)};
                v2u o; o.x = cvtpk(S[0], S[1]); o.y = cvtpk(S[2], S[3]); *(GAS v2u*)(PVg + off0 + (size_t)(c0 + j) * cstep) = o;
                S = S * dec + st; } } }
}
constexpr int M3_CS = 0, M3_BS = M3_CS + 128 * MB_P * 2, M3_MS = M3_BS + 128 * MB_P * 2, M3_XT = M3_MS + 128 * MB_P * 2, M3_PV = M3_XT + 64 * MB_P * 2, M3_ACS = M3_PV + 64 * MB_P * 2, M3_DT = M3_ACS + 512, M3_END = M3_DT + 512;
static_assert(M3_END <= SCR_BYTES, "mamba lds");
__device__ __forceinline__ void phase_mamba_out(const Frame& F, const Args& a) {
    LAS bf16* Cs = (LAS bf16*)(F.lds + M3_CS); LAS bf16* Bs = (LAS bf16*)(F.lds + M3_BS); LAS bf16* Ms = (LAS bf16*)(F.lds + M3_MS); LAS bf16* XTs = (LAS bf16*)(F.lds + M3_XT); LAS bf16* PVs = (LAS bf16*)(F.lds + M3_PV);
    LAS float* acs = (LAS float*)(F.lds + M3_ACS); LAS float* dtv = (LAS float*)(F.lds + M3_DT);
    const int tid = F.tid, lane = F.lane, w = F.wave, fr = lane & 15, fq = lane >> 4;
    for (int u = F.bid; u < 128 * 4; u += F.G) { const int bc = u >> 2, g = u & 3, b = bc >> 6, T0 = (bc & 63) * 128;
        const bf16* CN = (const bf16*)(F.ws + WS_M_CN) + ((size_t)b * SEQ + T0) * 512 + g * 128; const bf16* BN = (const bf16*)(F.ws + WS_M_BN) + ((size_t)b * SEQ + T0) * 512 + g * 128;
        for (int i = tid; i < 128 * 16; i += NTHR) { const int s = i >> 4, c8 = i & 15;
            *(LAS v4u*)(Cs + s * MB_P + c8 * 8) = *(const GAS v4u*)(CN + (size_t)s * 512 + c8 * 8); *(LAS v4u*)(Bs + s * MB_P + c8 * 8) = *(const GAS v4u*)(BN + (size_t)s * 512 + c8 * 8); }
        __syncthreads();
        f32x4 cbt[8];
#pragma unroll
        for (int st = 0; st < 8; ++st) { cbt[st] = (f32x4){0.f, 0.f, 0.f, 0.f}; if (st <= w) cbt[st] = mma16(Bs + st * 16 * MB_P, MB_P, Cs + w * 16 * MB_P, MB_P, 128, cbt[st], fr, fq); }
        const bf16* Y1 = (const bf16*)(F.ws + WS_Y1) + ((size_t)b * SEQ + T0) * OD_INP; bf16* YG = (bf16*)(F.ws + WS_YG) + ((size_t)b * SEQ + T0) * 2048;
        v4u pfx[2], pfp[2]; float pfa = 0.f, pfd = 0.f;
#define M3_PREFETCH(hh_) do { const int h_ = g * 8 + (hh_); const bf16* XT_ = (const bf16*)(F.ws + WS_M_XT) + ((size_t)bc * 32 + h_) * 64 * 128; const bf16* PV_ = (const bf16*)(F.ws + WS_M_PV) + ((size_t)bc * 32 + h_) * 64 * 128; \
            _Pragma("unroll") for (int k = 0; k < 2; ++k) { const int i = tid + k * NTHR, p = i >> 4, c8 = i & 15; pfx[k] = *(const GAS v4u*)(XT_ + (size_t)p * 128 + c8 * 8); pfp[k] = *(const GAS v4u*)(PV_ + (size_t)p * 128 + c8 * 8); } \
            if (tid < 128) { pfa = ((const float*)(F.ws + WS_M_ACS))[((size_t)bc * 32 + h_) * 128 + tid]; pfd = ((const float*)(F.ws + WS_M_DTV))[((size_t)bc * 32 + h_) * 128 + tid]; } } while (0)
        M3_PREFETCH(0);
#pragma unroll 1
        for (int hh = 0; hh < 8; ++hh) { const int h = g * 8 + hh; const float dsk = a.in[I_DSKIP][h];
#pragma unroll
            for (int k = 0; k < 2; ++k) { const int i = tid + k * NTHR, p = i >> 4, c8 = i & 15; *(LAS v4u*)(XTs + p * MB_P + c8 * 8) = pfx[k]; *(LAS v4u*)(PVs + p * MB_P + c8 * 8) = pfp[k]; }
            if (tid < 128) { acs[tid] = pfa; dtv[tid] = pfd; }
            __syncthreads();
            if (hh + 1 < 8) M3_PREFETCH(hh + 1);
            v4u zz[2];
#pragma unroll
            for (int k = 0; k < 2; ++k) zz[k] = *(const GAS v4u*)(Y1 + (size_t)(16 * w + fr) * OD_INP + h * 64 + 16 * fq + 8 * k);
            const float aq = acs[16 * w + fr];
#pragma unroll
            for (int st = 0; st < 8; ++st) { if (st <= w) { float mv[4];
#pragma unroll
                for (int e = 0; e < 4; ++e) { const int s = 16 * st + 4 * fq + e; mv[e] = (s <= 16 * w + fr) ? cbt[st][e] * __expf(aq - acs[s]) : 0.f; }
                v2u o; o.x = cvtpk(mv[0], mv[1]); o.y = cvtpk(mv[2], mv[3]); *(LAS v2u*)(Ms + (16 * w + fr) * MB_P + 16 * st + 4 * fq) = o; } }
            if ((w & 1) == 0) *(LAS v2u*)(Ms + (16 * w + fr) * MB_P + 16 * (w + 1) + 4 * fq) = (v2u){0u, 0u};
            LDS_WAIT();
            float yv[16]; { const int q = 16 * w + fr; const float eq = __expf(acs[q]), rdt = dsk * __builtin_amdgcn_rcpf(dtv[q]); const int prow = 16 * (fr >> 2) + (fr & 3);
#pragma unroll
            for (int pt = 0; pt < 4; ++pt) { f32x4 yd = {0.f, 0.f, 0.f, 0.f}, yo = {0.f, 0.f, 0.f, 0.f};
                yd = mma16r(XTs + (prow + 4 * pt) * MB_P, Ms + q * MB_P, ((w + 2) >> 1) * 32, yd, fq);
                yo = mma16r(PVs + (prow + 4 * pt) * MB_P, Cs + q * MB_P, 128, yo, fq);
#pragma unroll
                for (int e = 0; e < 4; ++e) { const int pp = 16 * fq + 4 * pt + e; yv[4 * pt + e] = yd[e] + eq * yo[e] + rdt * bf2f(XTs[pp * MB_P + q]); } } }
#pragma unroll
            for (int k = 0; k < 2; ++k) { v4u o;
#pragma unroll
                for (int j = 0; j < 4; ++j) o[j] = cvtpk(yv[8 * k + 2 * j] * fsilu(bflo(zz[k][j])), yv[8 * k + 2 * j + 1] * fsilu(bfhi(zz[k][j])));
                *(GAS v4u*)(YG + (size_t)(16 * w + fr) * 2048 + h * 64 + 16 * fq + 8 * k) = o; }
            __syncthreads();
        }
#undef M3_PREFETCH
        VM_WAIT(); __syncthreads();
        { const float* gn = a.in[I_ODNORM] + g * 512 + lane * 8; const f32x4 g0 = *(const GAS f32x4*)gn, g1 = *(const GAS f32x4*)(gn + 4);
#pragma unroll 4
          for (int t = 0; t < 16; ++t) { bf16* pq = YG + (size_t)(16 * w + t) * 2048 + g * 512 + lane * 8; const v4u raw = *(const GAS v4u*)pq; float ss = 0.f;
#pragma unroll
              for (int j = 0; j < 4; ++j) { const float x0 = bflo(raw[j]), x1 = bfhi(raw[j]); ss += x0 * x0 + x1 * x1; }
              const float rstd = 1.f / sqrtf(wave_sum(ss) * (1.f / 512.f) + EPS);
              v4u o; o.x = cvtpk(bflo(raw[0]) * rstd * g0[0], bfhi(raw[0]) * rstd * g0[1]); o.y = cvtpk(bflo(raw[1]) * rstd * g0[2], bfhi(raw[1]) * rstd * g0[3]);
              o.z = cvtpk(bflo(raw[2]) * rstd * g1[0], bfhi(raw[2]) * rstd * g1[1]); o.w = cvtpk(bflo(raw[3]) * rstd * g1[2], bfhi(raw[3]) * rstd * g1[3]);
              *(GAS v4u*)pq = o; } }
    }
}
__device__ __forceinline__ void phase_group_norm(const Frame& F, const Args& a) {
    const int gw = F.bid * NWAVES + F.wave, NGW = F.G * NWAVES; bf16* YG = (bf16*)(F.ws + WS_YG); const float* g = a.in[I_ODNORM];
    for (int m = gw; m < M; m += NGW) {
#pragma unroll
        for (int gi = 0; gi < 4; ++gi) { bf16* p = YG + (size_t)m * 2048 + gi * 512 + F.lane * 8; const v4u raw = *(const GAS v4u*)p; float ss = 0.f;
#pragma unroll
            for (int j = 0; j < 4; ++j) { const float x0 = bflo(raw[j]), x1 = bfhi(raw[j]); ss += x0 * x0 + x1 * x1; }
            const float rstd = 1.f / sqrtf(wave_sum(ss) * (1.f / 512.f) + EPS);
            const f32x4 g0 = *(const GAS f32x4*)(g + gi * 512 + F.lane * 8), g1 = *(const GAS f32x4*)(g + gi * 512 + F.lane * 8 + 4);
            v4u o; o.x = cvtpk(bflo(raw[0]) * rstd * g0[0], bfhi(raw[0]) * rstd * g0[1]); o.y = cvtpk(bflo(raw[1]) * rstd * g0[2], bfhi(raw[1]) * rstd * g0[3]);
            o.z = cvtpk(bflo(raw[2]) * rstd * g1[0], bfhi(raw[2]) * rstd * g1[1]); o.w = cvtpk(bflo(raw[3]) * rstd * g1[2], bfhi(raw[3]) * rstd * g1[3]);
            *(GAS v4u*)p = o; }
    }
}
constexpr int MOE_TAB = 131072;
static_assert(MOE_TAB + (32 + MOE_TILES + 24) * 4 <= SCR_BYTES, "moe lds");
__device__ __forceinline__ void phase_route(const Frame& F, const Args& a, const float* x) {
    LAS int* cntS = (LAS int*)F.lds;
    if (F.tid < 8) cntS[F.tid] = 0;
    __syncthreads();
    const float* g = a.in[I_NFFN] + D; const float* router = a.in[I_ROUTER]; bf16* XN = (bf16*)(F.ws + WS_XN);
    int* tokE = (int*)(F.ws + WS_MOEIDX); float* tokW = (float*)(F.ws + WS_MOEIDX + 1 * MiB);
    const int per = M / F.G;
    for (int i = F.wave; i < per; i += NWAVES) { const int m = F.bid * per + i;
        const GAS f32x4* xr = (const GAS f32x4*)(x + (size_t)m * D) + F.lane; const GAS f32x4* gr = (const GAS f32x4*)g + F.lane;
        f32x4 v[4]; float s = 0.f;
#pragma unroll
        for (int j = 0; j < 4; ++j) { v[j] = xr[64 * j]; s += (v[j].x * v[j].x + v[j].y * v[j].y) + (v[j].z * v[j].z + v[j].w * v[j].w); }
        const float rstd = 1.f / sqrtf(wave_sum(s) * (1.f / D) + EPS);
        float lg[8];
#pragma unroll
        for (int e = 0; e < 8; ++e) lg[e] = 0.f;
        GAS unsigned long long* o8 = (GAS unsigned long long*)(XN + (size_t)m * D) + F.lane;
#pragma unroll
        for (int j = 0; j < 4; ++j) { const f32x4 gg = gr[64 * j]; f32x4 hn = v[j] * rstd * gg;
            o8[64 * j] = (unsigned long long)pk2(hn.x, hn.y) | ((unsigned long long)pk2(hn.z, hn.w) << 32);
#pragma unroll
            for (int q = 0; q < 4; ++q) { const int k = 256 * j + 4 * F.lane + q; const f32x4 r0 = *(const GAS f32x4*)(router + (size_t)k * 8), r1 = *(const GAS f32x4*)(router + (size_t)k * 8 + 4);
#pragma unroll
                for (int e = 0; e < 4; ++e) { lg[e] += hn[q] * r0[e]; lg[4 + e] += hn[q] * r1[e]; } } }
#pragma unroll
        for (int e = 0; e < 8; ++e) lg[e] = wave_sum(lg[e]);
        int e1 = 0; float v1 = lg[0];
#pragma unroll
        for (int e = 1; e < 8; ++e) if (lg[e] > v1) { v1 = lg[e]; e1 = e; }
        int e2 = (e1 + 1) & 7; float v2 = -3.0e38f;
#pragma unroll
        for (int e = 0; e < 8; ++e) if (e != e1 && lg[e] > v2) { v2 = lg[e]; e2 = e; }
        if (F.lane == 0) { const float w1 = 1.f / (1.f + __expf(v2 - v1)); tokE[2 * m] = e1; tokE[2 * m + 1] = e2; tokW[2 * m] = w1; tokW[2 * m + 1] = 1.f - w1;
            atomicAdd((int*)cntS + e1, 1); atomicAdd((int*)cntS + e2, 1); }
    }
    __syncthreads();
    if (F.tid < 8) ((int*)(F.ctl + CW_MOECNT))[F.bid * 8 + F.tid] = cntS[F.tid];
    __syncthreads();
}
__device__ __forceinline__ void moe_layout(const Frame& F) {
    LAS int* tab = (LAS int*)(F.lds + MOE_TAB); const int* cnt = (const int*)(F.ctl + CW_MOECNT);
    if (F.tid < 16) tab[F.tid < 8 ? F.tid : 32 + MOE_TILES + F.tid] = 0;
    __syncthreads();
    { const int e = F.tid & 7; int tot = 0, pre = 0;
      for (int wg = F.tid >> 3; wg < F.G; wg += NTHR / 8) { const int c = cnt[wg * 8 + e]; tot += c; if (wg < F.bid) pre += c; }
      atomicAdd((int*)tab + e, tot); atomicAdd((int*)tab + 32 + MOE_TILES + 8 + e, pre); }
    __syncthreads();
    if (F.tid == 0) { int row = 0, tl = 0; for (int e = 0; e < 8; ++e) { const int nt = (tab[e] + 255) >> 8; tab[8 + e] = row; tab[16 + e] = nt; for (int i = 0; i < nt; ++i) tab[32 + tl + i] = e; tl += nt; row += nt * 256; } tab[24] = tl; }
    __syncthreads();
}
__device__ __forceinline__ void phase_scatter(const Frame& F) {
    moe_layout(F);
    LAS int* tab = (LAS int*)(F.lds + MOE_TAB); LAS int* slotS = (LAS int*)F.lds;
    const int per = M / F.G;
    const int* tokE = (const int*)(F.ws + WS_MOEIDX); int* tokS = (int*)(F.ws + WS_MOEIDX + 2 * MiB);
    if (F.wave == 0) { const int E0 = tokE[(size_t)F.bid * per * 2 + F.lane], E1 = tokE[(size_t)F.bid * per * 2 + 64 + F.lane]; int s0 = 0, s1 = 0;
        const unsigned long long lt = (1ull << F.lane) - 1ull;
#pragma unroll
        for (int e = 0; e < 8; ++e) { const unsigned long long m0 = __ballot(E0 == e), m1 = __ballot(E1 == e); const int base = tab[8 + e] + tab[32 + MOE_TILES + 8 + e];
            if (E0 == e) s0 = base + __popcll(m0 & lt); if (E1 == e) s1 = base + __popcll(m0) + __popcll(m1 & lt); }
        slotS[F.lane] = s0; slotS[64 + F.lane] = s1; tokS[(size_t)F.bid * per * 2 + F.lane] = s0; tokS[(size_t)F.bid * per * 2 + 64 + F.lane] = s1; }
    __syncthreads();
    const bf16* XN = (const bf16*)(F.ws + WS_XN); unsigned char* XP = F.ws + WS_XP;
    for (int i = F.wave; i < per * 2; i += NWAVES) { const int m = F.bid * per + (i >> 1); const int sl = slotS[i];
        const GAS v4u* src = (const GAS v4u*)(XN + (size_t)m * D) + F.lane; GAS v2u* dst = (GAS v2u*)(XP + (size_t)sl * D) + F.lane;
        const v4u s0 = src[0], s1 = src[64]; v2u o0, o1;
        o0.x = pk4_fp8(bflo(s0.x), bfhi(s0.x), bflo(s0.y), bfhi(s0.y)); o0.y = pk4_fp8(bflo(s0.z), bfhi(s0.z), bflo(s0.w), bfhi(s0.w));
        o1.x = pk4_fp8(bflo(s1.x), bfhi(s1.x), bflo(s1.y), bfhi(s1.y)); o1.y = pk4_fp8(bflo(s1.z), bfhi(s1.z), bflo(s1.w), bfhi(s1.w));
        dst[0] = o0; dst[64] = o1; }
    __syncthreads();
}
struct MoeOrder {
    int nN, nwg, G, c; const LAS int* texp;
    __device__ __forceinline__ bool next(int i, pg8::Unit& u) const { const long L = (long)i * G + c; if (L >= nwg) return false; u.pm = (int)(L / nN); u.pn = (int)(L % nN); u.bn = texp[u.pm] * nN + u.pn; u.idx = i; return true; }
    __device__ __forceinline__ void a_ready(const pg8::Unit&) const {}
    __device__ __forceinline__ void done(const pg8::Unit&) const {}
};
struct MoeOrderX {
    int nM, nN, nwg, G, c; const LAS int* texp;
    __device__ __forceinline__ bool next(int i, pg8::Unit& u) const { const long L = (long)i * G + c; if (L >= nwg) return false;
        int wgid = (int)L; { const int q = nwg / 8, r = nwg % 8, xcd = wgid % 8, off = wgid / 8; wgid = (xcd < r ? xcd * (q + 1) : r * (q + 1) + (xcd - r) * q) + off; }
        const int nig = 8 * nN, gid = wgid / nig, fm = gid * 8, gsz = (nM - fm) < 8 ? (nM - fm) : 8;
        u.pm = fm + ((wgid % nig) % gsz); u.pn = (wgid % nig) / gsz; u.bn = texp[u.pm] * nN + u.pn; u.idx = i; return true; }
    __device__ __forceinline__ void a_ready(const pg8::Unit&) const {}
    __device__ __forceinline__ void done(const pg8::Unit&) const {}
};
struct MoeTail { int R, Lo, pm_min; bool split; };
__device__ __forceinline__ MoeTail moe_tail(const LAS int* tab, int G) { MoeTail t; const int U = tab[24] * 4; t.R = U / G; t.Lo = U - t.R * G; t.split = (t.Lo > 0 && t.Lo <= 128 && t.R > 0); t.pm_min = t.split ? (t.R * G) / 4 : (1 << 30); return t; }
struct MoeTailOrder { int pm, pn, bn; bool has;
    __device__ __forceinline__ bool next(int i, pg8::Unit& u) const { if (i > 0 || !has) return false; u.pm = pm; u.pn = pn; u.bn = bn; u.idx = 0; return true; }
    __device__ __forceinline__ void a_ready(const pg8::Unit&) const {}
    __device__ __forceinline__ void done(const pg8::Unit&) const {} };
constexpr size_t MOE_PART_STRIDE = (size_t)32 * 256 * 1024;
__device__ __forceinline__ void phase_moe_combine(const Frame& F, const float* x, float* xo) {
    moe_layout(F); const MoeTail mt = moe_tail((const LAS int*)(F.lds + MOE_TAB), F.G); const int srow = mt.pm_min == (1 << 30) ? (1 << 30) : mt.pm_min * 256; const float* PART = (const float*)(F.ws + WS_XP);
    const int gw = F.bid * NWAVES + F.wave, NGW = F.G * NWAVES;
    const float* tokW = (const float*)(F.ws + WS_MOEIDX + 1 * MiB); const int* tokS = (const int*)(F.ws + WS_MOEIDX + 2 * MiB); const int* tokE = (const int*)(F.ws + WS_MOEIDX);
    const float* YP = (const float*)(F.ws + WS_YP);
    for (int m = gw; m < M; m += NGW) { const int s0 = tokS[2 * m], s1 = tokS[2 * m + 1]; const float w0 = tokW[2 * m] * (1.f / MOE_W2_SCALE), w1 = tokW[2 * m + 1] * (1.f / MOE_W2_SCALE)  ; const bool sw = tokE[2 * m] > tokE[2 * m + 1];
        const GAS f32x4* xr = (const GAS f32x4*)(x + (size_t)m * D) + F.lane; GAS f32x4* xw = (GAS f32x4*)(xo + (size_t)m * D) + F.lane; const GAS f32x4* y0 = (const GAS f32x4*)(YP + (size_t)s0 * D) + F.lane; const GAS f32x4* y1 = (const GAS f32x4*)(YP + (size_t)s1 * D) + F.lane;
#pragma unroll
        for (int j = 0; j < 4; ++j) { f32x4 v0, v1;
            if (s0 >= srow) { const GAS f32x4* q = (const GAS f32x4*)(PART + (size_t)(s0 - srow) * D) + F.lane + 64 * j; v0 = q[0] + q[MOE_PART_STRIDE / 4]; } else v0 = y0[64 * j];
            if (s1 >= srow) { const GAS f32x4* q = (const GAS f32x4*)(PART + (size_t)(s1 - srow) * D) + F.lane + 64 * j; v1 = q[0] + q[MOE_PART_STRIDE / 4]; } else v1 = y1[64 * j];
            const f32x4 a0 = v0 * w0, a1 = v1 * w1; xw[64 * j] = xr[64 * j] + (sw ? (a1 + a0) : (a0 + a1)); } }
}
#ifndef MK_PHMASK
#define MK_PHMASK 0xFFFFFFFFFFFFull
#endif
#ifndef MK_DUPMASK
#define MK_DUPMASK 0ull
#endif
#ifndef MK_SPLIT
#define MK_SPLIT 0
#endif
#ifndef MK_LAST_PHASE
#define MK_LAST_PHASE 29
#endif
constexpr int N_PHASES = 30;
#ifndef MK_LB
#define MK_LB 2
#endif
__global__ void __launch_bounds__(NTHR, MK_LB) mega_fwd(Args args) {
    extern __shared__ __attribute__((aligned(16))) unsigned char lds_raw[];
    Frame F;
    F.lds = (LAS unsigned char*)lds_raw; F.MISC = (volatile LAS unsigned*)(F.lds + MISC_OFF);
    F.tid = threadIdx.x; F.lane = F.tid & 63; F.wave = __builtin_amdgcn_readfirstlane(F.tid >> 6); F.G = gridDim.x; F.bid = blockIdx.x;
    F.ws = args.ws; F.ctl = (gu32*)(args.ws + WS_CTL);
    for (int u = F.tid; u < (LDS_BYTES - MISC_OFF) / 4; u += NTHR) ((LAS unsigned*)(F.lds + MISC_OFF))[u] = 0u;
    __syncthreads();
    XcdBarrier bar; bar.bar = (unsigned*)(F.ctl + CW_BAR); bar.x = 0; bar.st = nullptr;
    if (!MK_SPLIT) bar = xcd_barrier_post((unsigned*)(F.ctl + CW_BAR), F.MISC + 8);
    const int lo = args.ph_lo, hi = args.ph_hi;
#define PF() Frame Fp = F; { int t_ = threadIdx.x; asm volatile("" : "+v"(t_)); Fp.tid = t_; Fp.lane = t_ & 63; int w_ = F.wave, b_ = F.bid; asm volatile("" : "+s"(w_), "+s"(b_)); Fp.wave = w_; Fp.bid = b_; }
#define IN(k) ((((unsigned long long)MK_PHMASK >> (k)) & 1ull) && lo <= (k) && (k) < hi)
#define DUP(k) ((((unsigned long long)MK_DUPMASK >> (k)) & 1ull) ? 2 : 1)
#define SEAM(k) do { if (!MK_SPLIT && IN((k) + 1)) xcd_barrier(bar); } while (0)
    unsigned char* ws = args.ws; float* out = args.out;
    const int gw = F.bid * NWAVES + F.wave, NGW = F.G * NWAVES;
    LAS unsigned char* glds = F.lds;
    bf16* XN = (bf16*)(ws + WS_XN);

    if (IN(0)) { PF();
#pragma unroll 1
        for (int rep = 0; rep < DUP(0); ++rep) p0_prologue(Fp, args);
        SEAM(0); }
    if (IN(1)) {
        PF();
#pragma unroll 1
        for (int rep = 0; rep < DUP(1); ++rep) {
        if (F.bid == 0) { float* part = (float*)(ws + WS_CMPB_PART); float s = 0.f; for (int ic = 0; ic < 64; ++ic) s += part[(size_t)((Fp.tid >> 8) * 64 + ic) * 256 + (Fp.tid & 255)]; ((float*)(ws + WS_CMPB))[Fp.tid] = s; }
        { pg8::Gemm g{XN, (const bf16*)(ws + WS_W_EVIN), M, EV_INP, D, D, D}; pg8::StaticOrder S; S.init(M, EV_INP, F.G, F.bid);
          pg8::EpiEvIn E{(bf16*)(ws + WS_Y0), EV_INP, (bf16*)(ws + WS_KV6), SEQ};
          pg8::gemm_phase<pg8::EpiEvIn, pg8::StaticOrder, PG8_ALIGN, PG8_SP2>(glds, g, S, E); }
#pragma unroll 1
        for (int l = 0; l < 2; ++l) { pg8::Gemm g{(const bf16*)(ws + WS_MEMN) + (size_t)l * MMEM * D, (const bf16*)(ws + WS_W_XKV) + (size_t)l * 1024 * D, MMEM, 1024, D, D, D};
          pg8::ListOrder S; S.init(2, 4, 8, F.bid - 192 - 8 * l);
          pg8::EpiBf16<0> E{(bf16*)(ws + WS_KVM) + (size_t)l * MMEM * 1024, 1024, nullptr, nullptr};
          pg8::gemm_phase<pg8::EpiBf16<0>, pg8::ListOrder, PG8_ALIGN, PG8_SP2>(glds, g, S, E); }
        }
        SEAM(1);
    }
    if (IN(2)) {
        PF();
#pragma unroll 1
        for (int rep = 0; rep < DUP(2); ++rep) {
        if (F.bid < 128) { rglru_unit(Fp, args, F.bid >> 6, (F.bid >> 3) & 7, F.bid & 7);
        }
        else if (F.bid < 144) { const int mm = (F.bid - 128) >> 3;
            pg8::Gemm g{(const bf16*)(ws + WS_KV6) + (size_t)mm * 4 * SEQ * 128, (const bf16*)(ws + (mm ? WS_W_CV1 : WS_W_CK1)), 2048, 256, 4096, 2048, 4096};
            pg8::ListOrder S; S.init(8, 1, 8, (F.bid - 128) & 7);
            pg8::EpiBf16<1> E{(bf16*)(ws + WS_HID) + (size_t)mm * 2048 * 256, 256, (const float*)(ws + WS_CMPB) + mm * 256, nullptr};
            pg8::gemm_phase<pg8::EpiBf16<1>, pg8::ListOrder, PG8_ALIGN, PG8_SP2>(glds, g, S, E);
#ifdef MK_DUP_CMP1
            pg8::gemm_phase<pg8::EpiBf16<1>, pg8::ListOrder, PG8_ALIGN, PG8_SP2>(glds, g, S, E);
#endif
            VM_WAIT(); __syncthreads(); { const int u0 = mm * 64 + ((F.bid - 128) & 7) * 8; phase_cmp2(Fp, args, u0, u0 + 8, 1); }
        }
        else if (rep == 0) { const int gw2 = (F.bid - 144) * NWAVES + F.wave, NGW2 = (F.G - 144) * NWAVES;
            bf16* ks = (bf16*)(ws + WS_KV6) + (size_t)2 * 4 * SEQ * 128; bf16* kw = (bf16*)(ws + WS_KV6) + (size_t)4 * 4 * SEQ * 128;
            norm128_rows(Fp, ks, 128, ks, 128, 4 * SEQ, args.in[I_KNORM] + 128, gw2, NGW2);
            norm128_rows(Fp, kw, 128, kw, 128, 4 * SEQ, args.in[I_KNORM] + 256, gw2, NGW2);
            phase_memk_norm(Fp, args, 0, gw2, NGW2); phase_memk_norm(Fp, args, 1, gw2, NGW2); convert_range(Fp, args, gw2, NGW2, CONV_A, CONV_P2_END);
#ifdef MK_DUP_P2CONV
            convert_range(Fp, args, gw2, NGW2, CONV_A + (CONV_P2_END - CONV_A) / 2, CONV_P2_END);
#endif
        }
        }
        SEAM(2);
    }
    if (IN(4)) { PF();
#pragma unroll 1
        for (int rep = 0; rep < DUP(4); ++rep) phase_nsa(Fp, args);
        SEAM(4); }
    if (IN(5)) {
        pg8::Gemm g{(const bf16*)(ws + WS_MIX), (const bf16*)(ws + WS_W_EVOUT), M, D, 2048, 2048, 2048}; pg8::StaticOrder S; S.init(M, D, F.G, F.bid);
#pragma unroll 1
        for (int rep = 0; rep < DUP(5); ++rep) { pg8::EpiResidN E{args.in[I_X], (rep + 1 < DUP(5)) ? (float*)(ws + WS_R + 400 * MiB) : out, D, XN, (float*)(ws + WS_SSQ)};
        pg8::gemm_phase<pg8::EpiResidN, pg8::StaticOrder, PG8_ALIGN, PG8_SP2>(glds, g, S, E); }
        SEAM(5);
#ifdef MK_PROBE_BARS
#pragma unroll 1
        for (int xb = 0; xb < MK_PROBE_BARS; ++xb) xcd_barrier(bar);
#endif
    }
#pragma unroll 1
    for (int l = 0; l < 2; ++l) {
        const int pb = l == 0 ? 6 : 21;
        if (IN(pb + 1)) { pg8::Gemm g{XN, (const bf16*)(ws + WS_W_XQ) + (size_t)l * 512 * D, M, 512, D, D, D}; pg8::StaticOrder S; S.init(M, 512, F.G, F.bid);
            pg8::fill_rstd_table((LAS float*)(F.lds + MOE_TAB), S, (const float*)(ws + WS_SSQ), F.tid);
            pg8::EpiBf16<0> E{(bf16*)(ws + WS_QX), 512, nullptr, (const LAS float*)(F.lds + MOE_TAB)};
#pragma unroll 1
            for (int rep = 0; rep < DUP(7); ++rep) pg8::gemm_phase<pg8::EpiBf16<0>, pg8::StaticOrder, PG8_ALIGN, PG8_SP2>(glds, g, S, E);
            if (F.bid >= 128) { PF(); const int lo_ = CONV_ALL - (2 - l) * CONV_Q;
                convert_range(Fp, args, (F.bid - 128) * NWAVES + F.wave, (F.G - 128) * NWAVES, lo_, lo_ + CONV_Q); }
            SEAM(pb + 1); }
        if (IN(pb + 2)) { PF();
#pragma unroll 1
            for (int rep = 0; rep < DUP(8); ++rep) phase_cross_attn(Fp, args, l);
            SEAM(pb + 2); }
        if (IN(pb + 3)) { pg8::Gemm g{(const bf16*)(ws + WS_OX), (const bf16*)(ws + WS_W_XO) + (size_t)l * D * 512, M, D, 512, 512, 512}; pg8::StaticOrder S; S.init(M, D, F.G, F.bid);
#pragma unroll 1
            for (int rep = 0; rep < DUP(9); ++rep) { pg8::EpiResidN E{out, (rep + 1 < DUP(9)) ? (float*)(ws + WS_R + 400 * MiB) : out, D, l == 0 ? XN : (bf16*)nullptr, (float*)(ws + WS_SSQ)};
            pg8::gemm_phase<pg8::EpiResidN, pg8::StaticOrder, PG8_ALIGN, PG8_SP2>(glds, g, S, E); }
            SEAM(pb + 3); }
        if (l == 0) {
            if (IN(11)) { pg8::Gemm g{XN, (const bf16*)(ws + WS_W_FF13), M, 2 * FF, D, D, D}; pg8::StaticOrder S; S.init(M, 2 * FF, F.G, F.bid);
                pg8::fill_rstd_table((LAS float*)(F.lds + MOE_TAB), S, (const float*)(ws + WS_SSQ), F.tid);
                pg8::EpiSwiglu<false> E{(bf16*)(ws + WS_H), FF, (const LAS float*)(F.lds + MOE_TAB)};
#ifdef MK_PROBE_NULLEPI
                { pg8::EpiNull EN; pg8::gemm_phase<pg8::EpiNull, pg8::StaticOrder, PG8_ALIGN, PG8_SP2>(glds, g, S, EN); }
#endif
#pragma unroll 1
                for (int rep = 0; rep < DUP(11); ++rep) pg8::gemm_phase<pg8::EpiSwiglu<false>, pg8::StaticOrder, PG8_ALIGN, PG8_SP2>(glds, g, S, E);
                SEAM(11); }
            if (IN(12)) { pg8::Gemm g{(const bf16*)(ws + WS_H), (const bf16*)(ws + WS_W_FF2), M, D, FF, FF, FF}; pg8::StaticOrder S; S.init(M, D, F.G, F.bid);
#pragma unroll 1
                for (int rep = 0; rep < DUP(12); ++rep) { pg8::EpiResidN E{out, (rep + 1 < DUP(12)) ? (float*)(ws + WS_R + 400 * MiB) : out, D, XN, (float*)(ws + WS_SSQ)};
                pg8::gemm_phase<pg8::EpiResidN, pg8::StaticOrder, PG8_ALIGN, PG8_SP2>(glds, g, S, E); }
                SEAM(12); }
            if (IN(14)) { pg8::Gemm g{XN, (const bf16*)(ws + WS_W_ODIN), M, 5120, D, D, D}; pg8::StaticOrder S; S.init(M, 5120, F.G, F.bid);
                pg8::fill_rstd_table((LAS float*)(F.lds + MOE_TAB), S, (const float*)(ws + WS_SSQ), F.tid);
                pg8::EpiBf16<0> E{(bf16*)(ws + WS_Y1), OD_INP, nullptr, (const LAS float*)(F.lds + MOE_TAB)};
#pragma unroll 1
                for (int rep = 0; rep < DUP(14); ++rep) pg8::gemm_phase<pg8::EpiBf16<0>, pg8::StaticOrder, PG8_ALIGN, PG8_SP2>(glds, g, S, E);
                od_dt_cols(F, XN, (const bf16*)(ws + WS_W_ODIN), (const float*)(ws + WS_SSQ), (bf16*)(ws + WS_Y1));
                SEAM(14); }
            if (IN(15)) { PF();
#pragma unroll 1
                for (int rep = 0; rep < DUP(15); ++rep) phase_mamba_prep(Fp, args);
                SEAM(15); }
            if (IN(16)) { PF();
#pragma unroll 1
                for (int rep = 0; rep < DUP(16); ++rep) phase_mamba_states(Fp);
                SEAM(16); }
            if (IN(17)) { PF();
#pragma unroll 1
                for (int rep = 0; rep < DUP(17); ++rep) phase_mamba_scan(Fp);
                SEAM(17); }
            if (IN(18)) { PF();
#pragma unroll 1
                for (int rep = 0; rep < DUP(18); ++rep) phase_mamba_out(Fp, args);
                SEAM(18); }
            if (IN(20)) { pg8::Gemm g{(const bf16*)(ws + WS_YG), (const bf16*)(ws + WS_W_ODOUT), M, D, 2048, 2048, 2048}; pg8::StaticOrder S; S.init(M, D, F.G, F.bid);
#pragma unroll 1
                for (int rep = 0; rep < DUP(20); ++rep) { pg8::EpiResidN E{out, (rep + 1 < DUP(20)) ? (float*)(ws + WS_R + 400 * MiB) : out, D, XN, (float*)(ws + WS_SSQ)};
                pg8::gemm_phase<pg8::EpiResidN, pg8::StaticOrder, PG8_ALIGN, PG8_SP2>(glds, g, S, E); }
                SEAM(20); }
        }
    }
    if (IN(25)) { PF();
#pragma unroll 1
        for (int rep = 0; rep < DUP(25); ++rep) phase_route(Fp, args, out);
        SEAM(25); }
    if (IN(26)) { PF();
#pragma unroll 1
        for (int rep = 0; rep < DUP(26); ++rep) phase_scatter(Fp);
        SEAM(26); }
    if (IN(27)) { PF(); moe_layout(Fp); const LAS int* tab = (const LAS int*)(F.lds + MOE_TAB);
        pg8::Gemm g{(const bf16*)(ws + WS_XP), (const bf16*)(ws + WS_W_M13), MOE_ROWS, 2 * FFE, D / 2, D / 2, D / 2}  ; MoeOrderX S{tab[24], 2 * FFE / 256, tab[24] * (2 * FFE / 256), F.G, F.bid, tab + 32};
        pg8::EpiSwiglu<true, false, true> E{(bf16*)(ws + WS_HP), FFE, nullptr, 1.f / MOE_W13_SCALE};
#pragma unroll 1
        for (int rep = 0; rep < DUP(27); ++rep) pg8::gemm_phase<pg8::EpiSwiglu<true, false, true>, MoeOrderX, PG8_ALIGN, PG8_SP2, true>(glds, g, S, E);
        SEAM(27); }
    if (IN(28)) { PF(); moe_layout(Fp); const LAS int* tab = (const LAS int*)(F.lds + MOE_TAB);
        const MoeTail mt = moe_tail(tab, F.G);
        pg8::Gemm g{(const bf16*)(ws + WS_HP), (const bf16*)(ws + WS_W_M2), MOE_ROWS, D, FFE / 2, FFE / 2, FFE / 2}  ; MoeOrder S{D / 256, mt.split ? mt.R * F.G : tab[24] * (D / 256), F.G, F.bid, tab + 32};
        pg8::EpiF32 E{(float*)(ws + WS_YP), D};
#pragma unroll 1
        for (int rep = 0; rep < DUP(28); ++rep) pg8::gemm_phase<pg8::EpiF32, MoeOrder, PG8_ALIGN, PG8_SP2, true>(glds, g, S, E);
        if (mt.split) {
            const int piece = F.bid, L = mt.R * F.G + (piece >> 1), kq = piece & 1, pm = L / 4, pn = L % 4;
            MoeTailOrder S2{pm, pn, piece < mt.Lo * 2 ? tab[32 + pm] * 4 + pn : 0, piece < mt.Lo * 2};
            pg8::Gemm g2{(const bf16*)(ws + WS_HP) + kq * (FFE / 4), (const bf16*)(ws + WS_W_M2) + kq * (FFE / 4), MOE_ROWS, D, FFE / 4, FFE / 2, FFE / 2};
            pg8::EpiF32 E2{(float*)(ws + WS_XP) + (size_t)kq * MOE_PART_STRIDE - (size_t)mt.pm_min * 256 * D, D};
            pg8::gemm_phase<pg8::EpiF32, MoeTailOrder, PG8_ALIGN, PG8_SP2, true>(glds, g2, S2, E2); }
        SEAM(28); }
    if (IN(29)) { PF();
#pragma unroll 1
        for (int rep = 0; rep < DUP(29); ++rep) phase_moe_combine(Fp, out, (rep + 1 < DUP(29)) ? (float*)(ws + WS_H) : out); }
#undef IN
#undef SEAM
}

extern "C" void kernel_launch(void* const* d_in, const int* in_sizes, int n_in, void* d_out, int out_size, void* d_ws, size_t ws_size, hipStream_t stream) {
    static int grid = 0;
    if (grid == 0) {
        if (n_in != N_IN || in_sizes[0] != M * D || out_size != M * D || ws_size < (WS_M_END > WS_END ? WS_M_END : WS_END)) { fprintf(stderr, "kernel_launch: unexpected problem (n_in %d, in0 %d, out %d, ws %zu < %zu); nothing launched\n", n_in, n_in > 0 ? in_sizes[0] : -1, out_size, ws_size, (size_t)WS_END); grid = -1; return; }
        int dev = 0, cus = 0, per_cu = 0;
        if (hipGetDevice(&dev) != hipSuccess || hipDeviceGetAttribute(&cus, hipDeviceAttributeMultiprocessorCount, dev) != hipSuccess) { fprintf(stderr, "kernel_launch: device query failed\n"); grid = -1; return; }
        if (hipFuncSetAttribute((const void*)mega_fwd, hipFuncAttributeMaxDynamicSharedMemorySize, LDS_BYTES) != hipSuccess) { fprintf(stderr, "kernel_launch: hipFuncSetAttribute(%d B LDS) failed\n", LDS_BYTES); grid = -1; return; }
        if (hipOccupancyMaxActiveBlocksPerMultiprocessor(&per_cu, (const void*)mega_fwd, NTHR, LDS_BYTES) != hipSuccess || per_cu < 1) fprintf(stderr, "kernel_launch: note: occupancy query reports %d workgroups per CU\n", per_cu);
        (void)hipGetLastError();
        if (cus < 256) { fprintf(stderr, "kernel_launch: %d CUs < 256: the persistent grid of 256 workgroups would not be resident; nothing launched\n", cus); grid = -1; return; }
        grid = 256;
    }
    if (grid < 0) return;
    if (hipMemsetAsync((char*)d_ws + WS_CTL, 0, CTL_ZERO_BYTES, stream) != hipSuccess) { fprintf(stderr, "kernel_launch: memset failed\n"); return; }
    Args a{};
    for (int i = 0; i < N_IN; ++i) a.in[i] = (const float*)d_in[i];
    a.out = (float*)d_out; a.ws = (unsigned char*)d_ws;
#if MK_SPLIT
    for (int p = 0; p <= MK_LAST_PHASE && p < N_PHASES; ++p) { a.ph_lo = p; a.ph_hi = p + 1; a.li = p; hipLaunchKernelGGL(mega_fwd, dim3(grid), dim3(NTHR), LDS_BYTES, stream, a); }
#else
    a.ph_lo = 0; a.ph_hi = MK_LAST_PHASE + 1; a.li = 0;
    hipLaunchKernelGGL(mega_fwd, dim3(grid), dim3(NTHR), LDS_BYTES, stream, a);
#endif
    const hipError_t le = hipPeekAtLastError();
    if (le != hipSuccess) fprintf(stderr, "kernel_launch: launch failed: %s\n", hipGetErrorName(le));
}
```

```cpp
#include <hip/hip_runtime.h>
#include <cstdio>
#include <cstdint>

namespace pg8 {
#define PG8_LAS __attribute__((address_space(3)))
typedef unsigned short bf16_t;
typedef short bf16x8 __attribute__((ext_vector_type(8)));
typedef float f32x4 __attribute__((ext_vector_type(4)));
typedef unsigned u32x4 __attribute__((ext_vector_type(4)));
typedef unsigned u32x2 __attribute__((ext_vector_type(2)));
constexpr int BM = 256, BK = 64, HALF = 128, HTB = HALF * BK * 2  , STAGE_BYTES = 8 * HTB, NXCD = 8, WGM = 8;

__host__ __device__ __forceinline__ int lds_byte(int r, int c) { const int st = (r >> 4) * 2 + (c >> 5), rr = r & 15, cc = c & 31, ob = rr * 64 + cc * 2; return st * 1024 + (ob ^ (((ob >> 9) & 1) << 5)); }
__host__ __device__ __forceinline__ void stage_rc(int b, int& R, int& C) { const int st = b / 1024, sb = b % 1024, swz = sb ^ (((sb >> 9) & 1) << 5); R = (st >> 1) * 16 + swz / 64; C = (st & 1) * 32 + (swz % 64) / 2; }
__host__ __device__ __forceinline__ int perm32(int rho) { const int n = rho >> 4, i = rho & 15; return 8 * (i >> 2) + 4 * n + (i & 3); }

typedef int i32x8 __attribute__((ext_vector_type(8)));
typedef int i32x4 __attribute__((ext_vector_type(4)));
__device__ __forceinline__ i32x8 cat8(bf16x8 lo, bf16x8 hi) { const i32x4 a = __builtin_bit_cast(i32x4, lo), b = __builtin_bit_cast(i32x4, hi); return __builtin_shufflevector(a, b, 0, 1, 2, 3, 4, 5, 6, 7); }
__device__ __forceinline__ void mfma_f8_inplace(f32x4& acc, i32x8 a, i32x8 b) { asm volatile("v_mfma_f32_16x16x128_f8f6f4 %0, %1, %2, %0" : "+v"(acc) : "v"(a), "v"(b)); }
struct Unit { int pm, pn, bn, idx; };
struct Gemm { const bf16_t* A; const bf16_t* Bt; int M, N, K, lda, ldb; };

struct StaticOrder {
    int nM, nN, nwg, G, c;
    __host__ __device__ void init(int M, int N, int G_, int c_) { nM = M / BM; nN = N / BM; nwg = nM * nN; G = G_; c = c_; }
    __host__ __device__ bool next(int i, Unit& u) const {
        const long L = (long)i * G + c; if (L >= nwg) return false;
        int wgid = (int)L; { const int q = nwg / NXCD, r = nwg % NXCD, xcd = wgid % NXCD, off = wgid / NXCD; wgid = (xcd < r ? xcd * (q + 1) : r * (q + 1) + (xcd - r) * q) + off; }
        const int nig = WGM * nN, gid = wgid / nig, fm = gid * WGM, gsz = (nM - fm) < WGM ? (nM - fm) : WGM;
        u.pm = fm + ((wgid % nig) % gsz); u.pn = (wgid % nig) / gsz; u.bn = u.pn; u.idx = i; return true;
    }
    __device__ __forceinline__ void a_ready(const Unit&) const {}
    __device__ __forceinline__ void done(const Unit&) const {}
};
struct ListOrder {
    int nN, nwg, G, c;
    __host__ __device__ void init(int nM_, int nN_, int G_, int c_) { nN = nN_; nwg = nM_ * nN_; G = G_; c = c_; }
    __host__ __device__ bool next(int i, Unit& u) const { const long L = (long)i * G + c; if (c < 0 || L >= nwg) return false; u.pm = (int)(L / nN); u.pn = (int)(L % nN); u.bn = u.pn; u.idx = i; return true; }
    __device__ __forceinline__ void a_ready(const Unit&) const {}
    __device__ __forceinline__ void done(const Unit&) const {}
};

__device__ __forceinline__ unsigned cvt_pk_bf16(float lo, float hi) { unsigned r; asm volatile("v_cvt_pk_bf16_f32 %0, %1, %2" : "=v"(r) : "v"(lo), "v"(hi)); return r; }
__device__ __forceinline__ unsigned cvt4_fp8(float a, float b, float c, float d) { int r = __builtin_amdgcn_cvt_pk_fp8_f32(a, b, 0, false); r = __builtin_amdgcn_cvt_pk_fp8_f32(c, d, r, true); return (unsigned)r; }
__device__ __forceinline__ float fsigmoid(float x) { return __builtin_amdgcn_rcpf(1.0f + __expf(-x)); }
__device__ __forceinline__ float gelu_tanh(float x) { const float u = 1.5957691216f * (x + 0.044715f * x * x * x); return x * fsigmoid(u); }
__device__ __forceinline__ float fsilu(float x) { return x * fsigmoid(x); }

__device__ __forceinline__ float row_rstd(const float* ssq, int row) {
    const f32x4 a = *(const f32x4*)(ssq + (size_t)row * 16), b = *(const f32x4*)(ssq + (size_t)row * 16 + 4), c = *(const f32x4*)(ssq + (size_t)row * 16 + 8), d = *(const f32x4*)(ssq + (size_t)row * 16 + 12);
    const f32x4 s = (a + b) + (c + d); return 1.0f / sqrtf(((s[0] + s[1]) + (s[2] + s[3])) * (1.0f / 1024.0f) + 1e-6f);
}
template <class Sched> __device__ __forceinline__ void fill_rstd_table(PG8_LAS float* tab, const Sched& S, const float* ssq, int tid) {
    Unit u; for (int i = 0; S.next(i, u); ++i) if (tid < 256) { const int ai = tid >> 7, wr = (tid >> 6) & 1, m = (tid >> 4) & 3, fr = tid & 15; tab[i * 256 + ((ai * 2 + wr) * 16 + fr) * 4 + m] = row_rstd(ssq, u.pm * BM + tid); }
    __syncthreads();
}
template <int ACT, bool SPLIT_ = false> struct EpiBf16 {
    static constexpr bool PERM = true, AFTER_DRAIN = false, SPLIT = SPLIT_, PACK = false; static constexpr int NST = 16; struct Pk {};
    bf16_t* O; int ldc; const float* bias; const PG8_LAS float* rsT;
    __device__ __forceinline__ void operator()(const f32x4 (&acc)[2][2][4][2], const Unit& u, int wr, int wc, int fr, int fq) const { half<0>(acc, u, wr, wc, fr, fq); half<1>(acc, u, wr, wc, fr, fq); }
    template <int AI> __device__ __forceinline__ void half(const f32x4 (&acc)[2][2][4][2], const Unit& u, int wr, int wc, int fr, int fq) const {
        const int row0 = u.pm * BM + wr * 64 + fr; const int col0 = u.pn * BM + wc * 32 + 8 * fq;
        f32x4 bv[2][2];
#pragma unroll
        for (int bj = 0; bj < 2; ++bj)
#pragma unroll
            for (int n = 0; n < 2; ++n) bv[bj][n] = bias ? *(const f32x4*)(bias + col0 + bj * HALF + 4 * n) : (f32x4){0.f, 0.f, 0.f, 0.f};
        { constexpr int ai = AI; const f32x4 rs4 = rsT ? *(const PG8_LAS f32x4*)(rsT + u.idx * 256 + ((ai * 2 + wr) * 16 + fr) * 4) : (f32x4){1.f, 1.f, 1.f, 1.f};
#pragma unroll
            for (int m = 0; m < 4; ++m) { bf16_t* rowp = O + (size_t)(row0 + ai * HALF + m * 16) * ldc + col0; const float rs = rs4[m];
#pragma unroll
                for (int bj = 0; bj < 2; ++bj) { f32x4 v0 = acc[ai][bj][m][0] * rs + bv[bj][0], v1 = acc[ai][bj][m][1] * rs + bv[bj][1];
                    if (ACT == 1) {
#pragma unroll
                        for (int j = 0; j < 4; ++j) { v0[j] = gelu_tanh(v0[j]); v1[j] = gelu_tanh(v1[j]); } }
                    u32x4 w; w.x = cvt_pk_bf16(v0[0], v0[1]); w.y = cvt_pk_bf16(v0[2], v0[3]); w.z = cvt_pk_bf16(v1[0], v1[1]); w.w = cvt_pk_bf16(v1[2], v1[3]);
                    *(u32x4*)(rowp + bj * HALF) = w; } } }
    }
};
struct EpiEvIn {
    static constexpr bool PERM = true, AFTER_DRAIN = false, SPLIT = true, PACK = false; static constexpr int NST = 16; struct Pk {};
    bf16_t* O; int ldc; bf16_t* KV6; int S;
    __device__ __forceinline__ void operator()(const f32x4 (&acc)[2][2][4][2], const Unit& u, int wr, int wc, int fr, int fq) const { half<0>(acc, u, wr, wc, fr, fq); half<1>(acc, u, wr, wc, fr, fq); }
    template <int AI> __device__ __forceinline__ void half(const f32x4 (&acc)[2][2][4][2], const Unit& u, int wr, int wc, int fr, int fq) const {
        const int row0 = u.pm * BM + wr * 64 + fr; const int col0 = u.pn * BM + wc * 32 + 8 * fq;
        const bool kv = (u.pn >= 12 && u.pn < 18);
        { constexpr int ai = AI;
#pragma unroll
            for (int m = 0; m < 4; ++m) { const int row = row0 + ai * HALF + m * 16;
#pragma unroll
                for (int bj = 0; bj < 2; ++bj) { const f32x4 v0 = acc[ai][bj][m][0], v1 = acc[ai][bj][m][1];
                    u32x4 w; w.x = cvt_pk_bf16(v0[0], v0[1]); w.y = cvt_pk_bf16(v0[2], v0[3]); w.z = cvt_pk_bf16(v1[0], v1[1]); w.w = cvt_pk_bf16(v1[2], v1[3]);
                    if (kv) { const int b = row / S, t = row - b * S;
                        bf16_t* p = KV6 + ((((size_t)(u.pn - 12) * 2 + b) * 2 + bj) * S + t) * 128 + wc * 32 + 8 * fq; *(u32x4*)p = w; }
                    else *(u32x4*)(O + (size_t)row * ldc + col0 + bj * HALF) = w; } } }
    }
};
struct EpiResid {
    static constexpr bool PERM = false, AFTER_DRAIN = false, SPLIT = false, PACK = false; static constexpr int NST = 0; struct Pk {};
    const float* base; float* out; int ldc;
    __device__ __forceinline__ void operator()(const f32x4 (&acc)[2][2][4][2], const Unit& u, int wr, int wc, int fr, int fq) const {
        const int row0 = u.pm * BM + wr * 64 + fr, col0 = u.pn * BM + wc * 32 + 4 * fq;
#pragma unroll
        for (int ai = 0; ai < 2; ++ai)
#pragma unroll
            for (int m = 0; m < 4; ++m) { const size_t off = (size_t)(row0 + ai * HALF + m * 16) * ldc + col0;
#pragma unroll
                for (int bj = 0; bj < 2; ++bj)
#pragma unroll
                    for (int n = 0; n < 2; ++n) { const f32x4 b = *(const f32x4*)(base + off + bj * HALF + n * 16); *(f32x4*)(out + off + bj * HALF + n * 16) = b + acc[ai][bj][m][n]; } }
    }
};
struct EpiResidN {
    static constexpr bool PERM = false, AFTER_DRAIN = false, SPLIT = false, PACK = false; static constexpr int NST = 0; struct Pk {};
    const float* base; float* out; int ldc; bf16_t* XB; float* SSQ;
    __device__ __forceinline__ void operator()(const f32x4 (&acc)[2][2][4][2], const Unit& u, int wr, int wc, int fr, int fq) const {
        const int row0 = u.pm * BM + wr * 64 + fr, col0 = u.pn * BM + wc * 32 + 4 * fq;
#pragma unroll
        for (int ai = 0; ai < 2; ++ai)
#pragma unroll
            for (int m = 0; m < 4; ++m) { const int row = row0 + ai * HALF + m * 16; const size_t off = (size_t)row * ldc + col0; float ss = 0.f;
#pragma unroll
                for (int bj = 0; bj < 2; ++bj)
#pragma unroll
                    for (int n = 0; n < 2; ++n) { const f32x4 b = *(const f32x4*)(base + off + bj * HALF + n * 16); const f32x4 v = b + acc[ai][bj][m][n]; *(f32x4*)(out + off + bj * HALF + n * 16) = v;
                        if (XB) { u32x2 w; w.x = cvt_pk_bf16(v[0], v[1]); w.y = cvt_pk_bf16(v[2], v[3]); *(u32x2*)(XB + off + bj * HALF + n * 16) = w; }
                        ss += (v[0] * v[0] + v[1] * v[1]) + (v[2] * v[2] + v[3] * v[3]); }
                ss += __shfl_xor(ss, 16); ss += __shfl_xor(ss, 32);
                if (XB && fq == 0) SSQ[(size_t)row * 16 + u.pn * 4 + wc] = ss; }
    }
};
template <bool BASE_F32> struct EpiResidB {
    static constexpr bool PERM = true, AFTER_DRAIN = false, SPLIT = false, PACK = false; static constexpr int NST = 0; struct Pk {};
    const void* base; bf16_t* X; int ldc; float* SSQ;
    __device__ __forceinline__ void operator()(const f32x4 (&acc)[2][2][4][2], const Unit& u, int wr, int wc, int fr, int fq) const {
        const int row0 = u.pm * BM + wr * 64 + fr, col0 = u.pn * BM + wc * 32 + 8 * fq;
#pragma unroll
        for (int ai = 0; ai < 2; ++ai)
#pragma unroll
            for (int m = 0; m < 4; ++m) { const int row = row0 + ai * HALF + m * 16; const size_t off = (size_t)row * ldc + col0; float ss = 0.f;
#pragma unroll
                for (int bj = 0; bj < 2; ++bj) { f32x4 b0, b1;
                    if constexpr (BASE_F32) { b0 = *(const f32x4*)((const float*)base + off + bj * HALF); b1 = *(const f32x4*)((const float*)base + off + bj * HALF + 4); }
                    else { const u32x4 r = *(const u32x4*)((const bf16_t*)base + off + bj * HALF);
                        b0 = (f32x4){__builtin_bit_cast(float, r.x << 16), __builtin_bit_cast(float, r.x & 0xffff0000u), __builtin_bit_cast(float, r.y << 16), __builtin_bit_cast(float, r.y & 0xffff0000u)};
                        b1 = (f32x4){__builtin_bit_cast(float, r.z << 16), __builtin_bit_cast(float, r.z & 0xffff0000u), __builtin_bit_cast(float, r.w << 16), __builtin_bit_cast(float, r.w & 0xffff0000u)}; }
                    const f32x4 v0 = b0 + acc[ai][bj][m][0], v1 = b1 + acc[ai][bj][m][1];
                    u32x4 w; w.x = cvt_pk_bf16(v0[0], v0[1]); w.y = cvt_pk_bf16(v0[2], v0[3]); w.z = cvt_pk_bf16(v1[0], v1[1]); w.w = cvt_pk_bf16(v1[2], v1[3]);
                    *(u32x4*)(X + off + bj * HALF) = w;
                    ss += ((v0[0] * v0[0] + v0[1] * v0[1]) + (v0[2] * v0[2] + v0[3] * v0[3])) + ((v1[0] * v1[0] + v1[1] * v1[1]) + (v1[2] * v1[2] + v1[3] * v1[3])); }
                ss += __shfl_xor(ss, 16); ss += __shfl_xor(ss, 32);
                if (fq == 0) SSQ[(size_t)row * 16 + u.pn * 4 + wc] = ss; }
    }
};
struct EpiNull {
    static constexpr bool PERM = false, AFTER_DRAIN = false, SPLIT = false, PACK = false; static constexpr int NST = 0; struct Pk {};
    __device__ __forceinline__ void operator()(const f32x4 (&acc)[2][2][4][2], const Unit&, int, int, int, int) const {
#pragma unroll
        for (int ai = 0; ai < 2; ++ai)
#pragma unroll
            for (int bj = 0; bj < 2; ++bj)
#pragma unroll
                for (int m = 0; m < 4; ++m)
#pragma unroll
                    for (int n = 0; n < 2; ++n) asm volatile("" :: "v"(acc[ai][bj][m][n]));
    }
};
struct EpiF32 {
    static constexpr bool PERM = false, AFTER_DRAIN = false, SPLIT = false, PACK = false; static constexpr int NST = 0; struct Pk {};
    float* C; int ldc;
    __device__ __forceinline__ void operator()(const f32x4 (&acc)[2][2][4][2], const Unit& u, int wr, int wc, int fr, int fq) const {
        const int row0 = u.pm * BM + wr * 64 + fr, col0 = u.pn * BM + wc * 32 + 4 * fq;
#pragma unroll
        for (int ai = 0; ai < 2; ++ai)
#pragma unroll
            for (int m = 0; m < 4; ++m) { float* rowp = C + (size_t)(row0 + ai * HALF + m * 16) * ldc + col0;
#pragma unroll
                for (int bj = 0; bj < 2; ++bj)
#pragma unroll
                    for (int n = 0; n < 2; ++n) *(f32x4*)(rowp + bj * HALF + n * 16) = acc[ai][bj][m][n]; }
    }
};
template <bool SPLIT_, bool PACK_ = false, bool F8O_ = false> struct EpiSwiglu {
    static_assert(!(PACK_ && F8O_), "no packed fp8 form");
    static constexpr bool PERM = true, AFTER_DRAIN = false, SPLIT = SPLIT_, PACK = PACK_; static constexpr int NST = 8;
    bf16_t* H; int ldh; const PG8_LAS float* rsT; float sc = 1.f;
    __device__ __forceinline__ void operator()(const f32x4 (&acc)[2][2][4][2], const Unit& u, int wr, int wc, int fr, int fq) const { half<0>(acc, u, wr, wc, fr, fq); half<1>(acc, u, wr, wc, fr, fq); }
    struct Pk { u32x4 w[4]; };
    __device__ __forceinline__ void pack1(const f32x4 (&acc)[2][2][4][2], const Unit& u, int wr, int fr, Pk& pk) const {
        constexpr int ai = 1; const f32x4 rs4 = rsT ? *(const PG8_LAS f32x4*)(rsT + u.idx * 256 + ((ai * 2 + wr) * 16 + fr) * 4) : (f32x4){1.f, 1.f, 1.f, 1.f};
#pragma unroll
        for (int m = 0; m < 4; ++m) { const float rs = rs4[m] * sc;
            const f32x4 u0 = acc[ai][0][m][0] * rs, u1 = acc[ai][0][m][1] * rs, g0 = acc[ai][1][m][0] * rs, g1 = acc[ai][1][m][1] * rs;
            pk.w[m].x = cvt_pk_bf16(fsilu(g0[0]) * u0[0], fsilu(g0[1]) * u0[1]); pk.w[m].y = cvt_pk_bf16(fsilu(g0[2]) * u0[2], fsilu(g0[3]) * u0[3]);
            pk.w[m].z = cvt_pk_bf16(fsilu(g1[0]) * u1[0], fsilu(g1[1]) * u1[1]); pk.w[m].w = cvt_pk_bf16(fsilu(g1[2]) * u1[2], fsilu(g1[3]) * u1[3]); }
    }
    __device__ __forceinline__ void store1(const Pk& pk, const Unit& u, int wr, int wc, int fr, int fq) const {
        bf16_t* p = H + (size_t)(u.pm * BM + wr * 64 + fr + HALF) * ldh + u.pn * 128 + wc * 32 + 8 * fq;
#pragma unroll
        for (int m = 0; m < 4; ++m) *(u32x4*)(p + (size_t)(m * 16) * ldh) = pk.w[m];
    }
    template <int AI> __device__ __forceinline__ void half(const f32x4 (&acc)[2][2][4][2], const Unit& u, int wr, int wc, int fr, int fq) const {
        const int row0 = u.pm * BM + wr * 64 + fr, col0 = u.pn * 128 + wc * 32 + 8 * fq;
        constexpr int ai = AI; const f32x4 rs4 = rsT ? *(const PG8_LAS f32x4*)(rsT + u.idx * 256 + ((ai * 2 + wr) * 16 + fr) * 4) : (f32x4){1.f, 1.f, 1.f, 1.f};
#pragma unroll
        for (int m = 0; m < 4; ++m) { bf16_t* rowp = H + (size_t)(row0 + ai * HALF + m * 16) * ldh + col0; const float rs = rs4[m] * sc;
            const f32x4 u0 = acc[ai][0][m][0] * rs, u1 = acc[ai][0][m][1] * rs, g0 = acc[ai][1][m][0] * rs, g1 = acc[ai][1][m][1] * rs;
            if constexpr (F8O_) { u32x2 w; w.x = cvt4_fp8(fsilu(g0[0]) * u0[0], fsilu(g0[1]) * u0[1], fsilu(g0[2]) * u0[2], fsilu(g0[3]) * u0[3]);
                w.y = cvt4_fp8(fsilu(g1[0]) * u1[0], fsilu(g1[1]) * u1[1], fsilu(g1[2]) * u1[2], fsilu(g1[3]) * u1[3]);
                *(u32x2*)((unsigned char*)H + (size_t)(row0 + ai * HALF + m * 16) * ldh + col0) = w; }
            else { u32x4 w; w.x = cvt_pk_bf16(fsilu(g0[0]) * u0[0], fsilu(g0[1]) * u0[1]); w.y = cvt_pk_bf16(fsilu(g0[2]) * u0[2], fsilu(g0[3]) * u0[3]);
            w.z = cvt_pk_bf16(fsilu(g1[0]) * u1[0], fsilu(g1[1]) * u1[1]); w.w = cvt_pk_bf16(fsilu(g1[2]) * u1[2], fsilu(g1[3]) * u1[3]);
            *(u32x4*)rowp = w; } }
    }
};
__host__ __device__ __forceinline__ int swiglu_row(int h, int gate) { return (h >> 7) * 256 + gate * 128 + (h & 127); }

template <class Epi, class Sched, bool ALIGN_EPI = false, bool SP2 = false, bool F8 = false>
__device__ __forceinline__ void gemm_phase(PG8_LAS unsigned char* lds, const Gemm g, const Sched& S, const Epi& E) {
    int tid = threadIdx.x; asm volatile("" : "+v"(tid));
    const int wid = __builtin_amdgcn_readfirstlane(tid >> 6), lane = tid & 63, wr = wid >> 2, wc = wid & 3, fr = lane & 15, fq = lane >> 4;
    const int K = g.K, nt = K / BK;
    unsigned voffA, voffB;
    { int R, C; stage_rc(tid * 16, R, C); const int Rb = Epi::PERM ? ((R & ~31) + perm32(R & 31)) : R;
      voffA = (unsigned)(R * g.lda + C) * 2u; voffB = (unsigned)(Rb * g.ldb + C) * 2u; }
    const size_t q64A = (size_t)64 * g.lda * 2, q64B = (size_t)64 * g.ldb * 2;
    const size_t kstep = (size_t)(BK * 2);
    const size_t hstepA = (size_t)HALF * g.lda * 2, hstepB = (size_t)HALF * g.ldb * 2;
    const size_t tstepA = 2 * hstepA, tstepB = 2 * hstepB;
    const unsigned ldsw = (unsigned)wid * 1024u;
    const int aoff = lds_byte(wr * 64 + fr, fq * 8), boff = lds_byte(wc * 32 + fr, fq * 8);
#define PG8_SA(b, h) (((b) * 2 + (h)) * HTB)
#define PG8_SB(b, h) ((4 + (b) * 2 + (h)) * HTB)
#define PG8_STAGE(bufoff, gbase, voff) do { __builtin_amdgcn_global_load_lds((const unsigned*)((const char*)(gbase) + (voff)), (PG8_LAS unsigned*)(lds + (bufoff) + ldsw), 16, 0, 0); \
        __builtin_amdgcn_global_load_lds((const unsigned*)((const char*)(gbase) + PG8_Q64(voff) + (voff)), (PG8_LAS unsigned*)(lds + (bufoff) + ldsw + 8192), 16, 0, 0); } while (0)
#define PG8_Q64(v) PG8_Q64_##v
#define PG8_Q64_voffA q64A
#define PG8_Q64_voffB q64B
#define PG8_LDA(dst, b, h) do { _Pragma("unroll") for (int m = 0; m < 4; ++m) _Pragma("unroll") for (int k = 0; k < 2; ++k) dst[m][k] = *(const PG8_LAS bf16x8*)(lds + PG8_SA(b, h) + aoff + m * 2048 + k * 1024); } while (0)
#define PG8_LDB(dst, b, h) do { _Pragma("unroll") for (int n = 0; n < 2; ++n) _Pragma("unroll") for (int k = 0; k < 2; ++k) dst[n][k] = *(const PG8_LAS bf16x8*)(lds + PG8_SB(b, h) + boff + n * 2048 + k * 1024); } while (0)
#define PG8_MMA(ai, bj, At, Bt) do { __builtin_amdgcn_s_setprio(1); \
        if constexpr (F8) { _Pragma("unroll") for (int m = 0; m < 4; ++m) _Pragma("unroll") for (int n = 0; n < 2; ++n) \
            mfma_f8_inplace(acc[ai][bj][m][n], cat8(Bt[n][0], Bt[n][1]), cat8(At[m][0], At[m][1])); } \
        else { _Pragma("unroll") for (int m = 0; m < 4; ++m) _Pragma("unroll") for (int n = 0; n < 2; ++n) _Pragma("unroll") for (int k = 0; k < 2; ++k) \
            acc[ai][bj][m][n] = __builtin_amdgcn_mfma_f32_16x16x32_bf16(Bt[n][k], At[m][k], acc[ai][bj][m][n], 0, 0, 0); } \
        __builtin_amdgcn_s_setprio(0); } while (0)
#define PG8_WAIT_V(n) asm volatile("s_waitcnt vmcnt(" #n ")" ::: "memory")
#define PG8_WAIT_L(n) asm volatile("s_waitcnt lgkmcnt(" #n ")" ::: "memory")
#define PG8_WAIT_REL(NN) do { if (rel) asm volatile("s_waitcnt vmcnt(%0)" :: "n"(NN) : "memory"); else PG8_WAIT_V(8); } while (0)
#define PG8_BAR __builtin_amdgcn_s_barrier()
#define PG8_SCHED __builtin_amdgcn_sched_barrier(0)
    typename Epi::Pk pk; Unit cur, nxt, pend; int ui = 0; bool pending = false; pend.pm = pend.pn = pend.bn = pend.idx = 0;
    if (!S.next(0, cur)) return;
    f32x4 acc[2][2][4][2];
#pragma unroll
    for (int a = 0; a < 2; ++a)
#pragma unroll
        for (int b = 0; b < 2; ++b)
#pragma unroll
            for (int m = 0; m < 4; ++m)
#pragma unroll
                for (int n = 0; n < 2; ++n) acc[a][b][m][n] = (f32x4){0.f, 0.f, 0.f, 0.f};
    bf16x8 At[4][2], B0[2][2], B1[2][2];
    const char* cA = (const char*)g.A + (size_t)cur.pm * tstepA; const char* cB = (const char*)g.Bt + (size_t)cur.bn * tstepB;
    S.a_ready(cur);
    if constexpr (SP2) {
        PG8_STAGE(PG8_SB(0, 0), cB, voffB); PG8_STAGE(PG8_SB(0, 1), cB + hstepB, voffB); PG8_STAGE(PG8_SA(0, 0), cA, voffA); PG8_STAGE(PG8_SA(0, 1), cA + hstepA, voffA);
        if (wr == 1) PG8_BAR;
        PG8_WAIT_V(2); PG8_BAR;
        PG8_STAGE(PG8_SB(1, 0), cB + kstep, voffB); PG8_STAGE(PG8_SA(1, 0), cA + kstep, voffA); PG8_STAGE(PG8_SB(1, 1), cB + hstepB + kstep, voffB);
        PG8_WAIT_V(6); PG8_BAR;
    } else {
        PG8_STAGE(PG8_SB(0, 0), cB, voffB); PG8_STAGE(PG8_SA(0, 0), cA, voffA); PG8_STAGE(PG8_SB(0, 1), cB + hstepB, voffB); PG8_STAGE(PG8_SA(0, 1), cA + hstepA, voffA);
        if (wr == 1) PG8_BAR;
        PG8_WAIT_V(4); PG8_BAR;
        PG8_STAGE(PG8_SB(1, 0), cB + kstep, voffB); PG8_STAGE(PG8_SA(1, 0), cA + kstep, voffA); PG8_STAGE(PG8_SB(1, 1), cB + hstepB + kstep, voffB);
        PG8_WAIT_V(6); PG8_BAR;
    }
    for (;;) {
        const bool has_next = S.next(ui + 1, nxt);
        const char* nA = has_next ? (const char*)g.A + (size_t)nxt.pm * tstepA : cA; const char* nB = has_next ? (const char*)g.Bt + (size_t)nxt.bn * tstepB : cB;
        for (int t = 0; t < nt; t += 2) {
            const bool last = (t == nt - 2);
            const char* a1 = cA + (size_t)(t + 1) * kstep;
            const char* a2 = last ? nA : cA + (size_t)(t + 2) * kstep; const char* b2 = last ? nB : cB + (size_t)(t + 2) * kstep;
            const char* a3 = a2 + kstep; const char* b3 = b2 + kstep;
            if (last && has_next) S.a_ready(nxt);
            if constexpr (SP2) {
            const bool rel = Epi::SPLIT && pending && t == 0;
            if (rel) { if constexpr (Epi::SPLIT) { PG8_STAGE(PG8_SA(1, 1), a1 + hstepA, voffA); PG8_SCHED;
                if constexpr (Epi::PACK) { E.store1(pk, pend, wr, wc, fr, fq); }
                else { E.template half<1>(acc, pend, wr, wc, fr, fq);
#pragma unroll
                for (int b = 0; b < 2; ++b)
#pragma unroll
                    for (int m = 0; m < 4; ++m)
#pragma unroll
                        for (int n = 0; n < 2; ++n) acc[1][b][m][n] = (f32x4){0.f, 0.f, 0.f, 0.f}; }
                S.done(pend); pending = false;
                PG8_SCHED; PG8_LDB(B0, 0, 0); PG8_LDB(B1, 0, 1); PG8_SCHED; PG8_LDA(At, 0, 0); } }
            else { PG8_LDB(B0, 0, 0); PG8_LDB(B1, 0, 1); PG8_SCHED; PG8_LDA(At, 0, 0); PG8_STAGE(PG8_SA(1, 1), a1 + hstepA, voffA); }
            PG8_WAIT_REL(8 + Epi::NST); PG8_WAIT_L(0); PG8_BAR; PG8_MMA(0, 0, At, B0); PG8_MMA(0, 1, At, B1); PG8_BAR; PG8_SCHED;
            PG8_LDA(At, 0, 1); PG8_STAGE(PG8_SB(0, 0), b2, voffB); PG8_STAGE(PG8_SB(0, 1), b2 + hstepB, voffB); PG8_STAGE(PG8_SA(0, 0), a2, voffA);
            PG8_WAIT_REL(8 + Epi::NST); PG8_WAIT_L(0); PG8_BAR; PG8_MMA(1, 0, At, B0); PG8_MMA(1, 1, At, B1); PG8_BAR; PG8_SCHED;
            PG8_LDB(B0, 1, 0); PG8_LDB(B1, 1, 1); PG8_SCHED; PG8_LDA(At, 1, 0); PG8_STAGE(PG8_SA(0, 1), a2 + hstepA, voffA);
            PG8_WAIT_REL(8 + Epi::NST / 2); PG8_WAIT_L(0); PG8_BAR; PG8_MMA(0, 0, At, B0); PG8_MMA(0, 1, At, B1); PG8_BAR; PG8_SCHED;
            PG8_LDA(At, 1, 1); PG8_STAGE(PG8_SB(1, 0), b3, voffB); PG8_STAGE(PG8_SB(1, 1), b3 + hstepB, voffB); PG8_STAGE(PG8_SA(1, 0), a3, voffA);
            PG8_WAIT_V(8); PG8_WAIT_L(0); PG8_BAR; PG8_MMA(1, 0, At, B0); PG8_MMA(1, 1, At, B1); PG8_BAR; PG8_SCHED;
            } else {
            PG8_LDB(B0, 0, 0); PG8_SCHED; PG8_LDA(At, 0, 0); PG8_STAGE(PG8_SA(1, 1), a1 + hstepA, voffA);
            PG8_WAIT_L(8); PG8_BAR; PG8_WAIT_L(0); PG8_MMA(0, 0, At, B0); PG8_BAR; PG8_SCHED;
            PG8_LDB(B1, 0, 1); PG8_STAGE(PG8_SB(0, 0), b2, voffB);
            PG8_BAR; PG8_WAIT_L(0); PG8_MMA(0, 1, At, B1); PG8_BAR;
            PG8_LDA(At, 0, 1); PG8_STAGE(PG8_SA(0, 0), a2, voffA);
            PG8_BAR; PG8_WAIT_L(0); PG8_MMA(1, 0, At, B0); PG8_BAR; PG8_SCHED;
            PG8_STAGE(PG8_SB(0, 1), b2 + hstepB, voffB);
            PG8_WAIT_V(6); PG8_BAR; PG8_MMA(1, 1, At, B1); PG8_BAR;
            PG8_LDB(B0, 1, 0); PG8_SCHED; PG8_LDA(At, 1, 0); PG8_STAGE(PG8_SA(0, 1), a2 + hstepA, voffA);
            PG8_WAIT_L(8); PG8_BAR; PG8_WAIT_L(0); PG8_MMA(0, 0, At, B0); PG8_BAR; PG8_SCHED;
            PG8_LDB(B1, 1, 1); PG8_STAGE(PG8_SB(1, 0), b3, voffB);
            PG8_BAR; PG8_WAIT_L(0); PG8_MMA(0, 1, At, B1); PG8_BAR;
            PG8_LDA(At, 1, 1); PG8_STAGE(PG8_SA(1, 0), a3, voffA);
            PG8_BAR; PG8_WAIT_L(0); PG8_MMA(1, 0, At, B0); PG8_BAR; PG8_SCHED;
            PG8_STAGE(PG8_SB(1, 1), b3 + hstepB, voffB);
            PG8_WAIT_V(6); PG8_BAR; PG8_MMA(1, 1, At, B1); PG8_BAR;
            }
        }
        if constexpr (F8) asm volatile("s_nop 15\n\ts_nop 15\n\ts_nop 15\n\ts_nop 15" ::: "memory");
        if constexpr (ALIGN_EPI) { if (wr == 0) PG8_BAR; }
        if constexpr (Epi::SPLIT) { static_assert(SP2, "split epilogues need the SP2 loop");
            if (has_next) { E.template half<0>(acc, cur, wr, wc, fr, fq); if constexpr (Epi::PACK) E.pack1(acc, cur, wr, fr, pk); pend = cur; pending = true; }
            else { E.template half<0>(acc, cur, wr, wc, fr, fq); E.template half<1>(acc, cur, wr, wc, fr, fq); S.done(cur); } }
        else if constexpr (!Epi::AFTER_DRAIN) { E(acc, cur, wr, wc, fr, fq); S.done(cur); }
        if (!has_next) break;
#pragma unroll
        for (int a = 0; a < ((Epi::SPLIT && !Epi::PACK) ? 1 : 2); ++a)
#pragma unroll
            for (int b = 0; b < 2; ++b)
#pragma unroll
                for (int m = 0; m < 4; ++m)
#pragma unroll
                    for (int n = 0; n < 2; ++n) acc[a][b][m][n] = (f32x4){0.f, 0.f, 0.f, 0.f};
        cur = nxt; cA = nA; cB = nB; ++ui;
        if constexpr (ALIGN_EPI) { if (wr == 1) PG8_BAR; }
    }
    PG8_WAIT_V(0);
    if constexpr (!ALIGN_EPI) { if (wr == 0) PG8_BAR; }
    PG8_BAR;
    if constexpr (Epi::AFTER_DRAIN) { E.fused(acc, cur, wr, wc, fr, fq, lds, wid, lane); S.done(cur); }
#undef PG8_SA
#undef PG8_SB
#undef PG8_STAGE
#undef PG8_Q64
#undef PG8_Q64_voffA
#undef PG8_Q64_voffB
#undef PG8_LDA
#undef PG8_LDB
#undef PG8_MMA
#undef PG8_WAIT_V
#undef PG8_WAIT_L
#undef PG8_WAIT_REL
#undef PG8_BAR
#undef PG8_SCHED
}
}
#define PG8_SP2 true
#define PG8_ALIGN true
constexpr int NWAVES = 8, NTHR = 512;
constexpr int BATCH = 2, SEQ = 8192, D = 1024, M = BATCH * SEQ;
constexpr int MEMLEN = 256, MMEM = BATCH * MEMLEN;
constexpr int EV_IN = 4632, EV_INP = 4864;
constexpr int OD_IN = 5152, OD_INP = 5376;
constexpr int FF = 2816, FFE = 3584, NEXP = 8;
constexpr float MOE_W2_SCALE = 128.f;
constexpr float MOE_W13_SCALE = 64.f;
constexpr int NQB = SEQ / 64;
constexpr int XH = 4;
constexpr float EPS = 1e-6f;
constexpr int MOE_ROWS = 2 * M + NEXP * 256;
constexpr int MOE_TILES = MOE_ROWS / 256;

constexpr size_t MiB = 1u << 20;
constexpr size_t WS_CTL = 0, CTL_ZERO_BYTES = 1 * MiB;
constexpr size_t WS_SMALL = 1 * MiB;
constexpr size_t WS_CMPB_PART = WS_SMALL;
constexpr size_t WS_CMPB = WS_SMALL + 256 * 1024;
constexpr size_t WS_OV = WS_SMALL + 512 * 1024;
constexpr size_t WS_MEMN = 2 * MiB;
constexpr size_t WS_KVM = 4 * MiB;
constexpr size_t WS_KM = 6 * MiB;
constexpr size_t WS_HID = 7 * MiB;
constexpr size_t WS_KVCMP = 9 * MiB;
constexpr size_t WS_MOEIDX = 10 * MiB;
constexpr size_t WS_SSQ = 14 * MiB;
constexpr size_t WS_W = 16 * MiB;
constexpr size_t WS_W_EVIN = WS_W, WS_W_EVOUT = WS_W_EVIN + 10 * MiB, WS_W_CK1 = WS_W_EVOUT + 4 * MiB, WS_W_CV1 = WS_W_CK1 + 2 * MiB, WS_W_ODIN = WS_W_CV1 + 2 * MiB,
                 WS_W_ODOUT = WS_W_ODIN + 11 * MiB, WS_W_XQ = WS_W_ODOUT + 4 * MiB, WS_W_XKV = WS_W_XQ + 2 * MiB, WS_W_XO = WS_W_XKV + 4 * MiB, WS_W_FF13 = WS_W_XO + 2 * MiB,
                 WS_W_FF2 = WS_W_FF13 + 11 * MiB, WS_W_M13 = WS_W_FF2 + 6 * MiB, WS_W_M2 = WS_W_M13 + 112 * MiB, WS_W_END = WS_W_M2 + 56 * MiB;
constexpr size_t WS_XN = WS_W_END;
constexpr size_t WS_QX = WS_XN + 32 * MiB, WS_OX = WS_QX + 16 * MiB, WS_R = WS_OX + 16 * MiB;
constexpr size_t WS_Y0 = WS_R, WS_KV6 = WS_R + 152 * MiB, WS_MIX = WS_R + 201 * MiB, WS_H = WS_R + 265 * MiB;
constexpr size_t WS_Y1 = WS_R, WS_YG = WS_R + 168 * MiB;
constexpr size_t WS_XN8 = WS_QX;
constexpr size_t WS_XP = WS_R, WS_HP = WS_R + 68 * MiB, WS_YP = WS_R + 306 * MiB, WS_END = WS_R + 442 * MiB;
static_assert(WS_W_END == 242 * MiB && WS_END == 748 * MiB, "ws map");
constexpr int CW_TMO = 0, CW_CODE = 1, CW_CHK = 2;
constexpr int CW_BAR = 4096;
constexpr int CW_MOECNT = 16384;
constexpr int CW_MOEOFF = 20480;

constexpr int LDS_BYTES = 159744;
constexpr int MISC_OFF = LDS_BYTES - 512;
constexpr int SCR_BYTES = MISC_OFF;

#define GAS __attribute__((address_space(1)))
#define LAS __attribute__((address_space(3)))
typedef unsigned short bf16;
typedef unsigned v4u __attribute__((ext_vector_type(4)));
typedef unsigned v2u __attribute__((ext_vector_type(2)));
typedef float f32x4 __attribute__((ext_vector_type(4)));
typedef float f32x16 __attribute__((ext_vector_type(16)));
typedef short bf16x8 __attribute__((ext_vector_type(8)));
typedef short s16x4 __attribute__((ext_vector_type(4)));
typedef GAS unsigned gu32;
#define RLX_AGENT __ATOMIC_RELAXED, __HIP_MEMORY_SCOPE_AGENT
#define LDS_WAIT() asm volatile("s_waitcnt lgkmcnt(0)" ::: "memory")
#define VM_WAIT() asm volatile("s_waitcnt vmcnt(0)" ::: "memory")
#define SBAR() __builtin_amdgcn_sched_barrier(0)
__device__ __forceinline__ int lane_id() { return (int)threadIdx.x & 63; }
__device__ __forceinline__ unsigned f2bf(float f) { unsigned u = __builtin_bit_cast(unsigned, f); return (u + 0x7fffu + ((u >> 16) & 1u)) >> 16; }
__device__ __forceinline__ unsigned pk2(float lo, float hi) { return f2bf(lo) | (f2bf(hi) << 16); }
__device__ __forceinline__ float bf2f(unsigned short b) { return __builtin_bit_cast(float, ((unsigned)b) << 16); }
__device__ __forceinline__ float bflo(unsigned w) { return __builtin_bit_cast(float, w << 16); }
__device__ __forceinline__ float bfhi(unsigned w) { return __builtin_bit_cast(float, w & 0xffff0000u); }
__device__ __forceinline__ unsigned cvtpk(float lo, float hi) { unsigned r; asm volatile("v_cvt_pk_bf16_f32 %0, %1, %2" : "=v"(r) : "v"(lo), "v"(hi)); return r; }
__device__ __forceinline__ float wave_sum(float v) {
#pragma unroll
    for (int o = 1; o < 64; o <<= 1) v += __shfl_xor(v, o);
    return v;
}
using pg8::fsigmoid; using pg8::gelu_tanh; using pg8::fsilu;
__device__ __forceinline__ float fsoftplus(float x) { return x > 20.f ? x : log1pf(__expf(x)); }

#define XB_TMO      128
#define XB_XCNT(j)  (256  + 64 * (j))
#define XB_XSUB(j)  (1280 + 64 * (j))
#define XB_XGEN(j)  (2304 + 64 * (j))
#define XB_TOP      3328
#define XB_TOPGEN   3392
#define XCD_BAR_WORDS 3456
#define XB_SPIN_CAP (1u << 18)

__device__ __forceinline__ unsigned xb_ld(unsigned* p)              { return __hip_atomic_load(p, __ATOMIC_RELAXED, __HIP_MEMORY_SCOPE_AGENT); }
__device__ __forceinline__ unsigned xb_add(unsigned* p, unsigned v) { return __hip_atomic_fetch_add(p, v, __ATOMIC_RELAXED, __HIP_MEMORY_SCOPE_AGENT); }
__device__ __forceinline__ unsigned xb_xcc_id() { return (unsigned)__builtin_amdgcn_s_getreg((3 << 11) | 20) & 0xFu; }
#define XB_SPIN(cond, bar) do { unsigned _sp = 0; while (cond) { __builtin_amdgcn_s_sleep(1); \
    if ((++_sp & 255u) == 0u) { if (xb_ld(&(bar)[XB_TMO])) break; if (_sp > XB_SPIN_CAP) { atomicAdd(&(bar)[XB_TMO], 1u); break; } } } } while (0)

struct XcdBarrier {
    unsigned* bar; unsigned x;
    volatile LAS unsigned* st;
};

__device__ __forceinline__ XcdBarrier xcd_barrier_post(unsigned* bar, volatile LAS unsigned* st) {
    XcdBarrier b; b.bar = bar; b.x = xb_xcc_id(); b.st = st;
    if (threadIdx.x == 0) (void)xb_add(&bar[XB_XCNT(b.x)], 1u);
    return b;
}
__device__ __forceinline__ void xcd_barrier_complete(unsigned* bar, unsigned x, unsigned& nloc, unsigned& nx) {
    const unsigned G = gridDim.x * gridDim.y * gridDim.z;
    unsigned sum, cnt, mine, sp = 0u;
    for (;;) {
        sum = 0u; cnt = 0u; mine = 0u;
#pragma unroll
        for (unsigned j = 0; j < 16; ++j) { const unsigned c = xb_ld(&bar[XB_XCNT(j)]); sum += c; cnt += (c > 0u) ? 1u : 0u; mine = (j == x) ? c : mine; }
        if (sum == G) break;
        __builtin_amdgcn_s_sleep(1);
        if ((++sp & 255u) == 0u) { if (xb_ld(&bar[XB_TMO])) break; if (sp > XB_SPIN_CAP) { atomicAdd(&bar[XB_TMO], 1u); break; } }
    }
    nloc = mine > 0u ? mine : 1u; nx = cnt > 0u ? cnt : 1u;
}

__device__ __forceinline__ void xcd_barrier(const XcdBarrier& b) {
    asm volatile("s_waitcnt vmcnt(0)" ::: "memory");
    __syncthreads();
    if (threadIdx.x == 0) {
        unsigned* bar = b.bar;
        __builtin_amdgcn_s_waitcnt(0);
        unsigned nloc = b.st[0], nx = b.st[1];
        if (nloc == 0u) { xcd_barrier_complete(bar, b.x, nloc, nx); b.st[0] = nloc; b.st[1] = nx; }
        const unsigned old = xb_add(&bar[XB_XSUB(b.x)], 1u);
        const unsigned gen = old / nloc;
        if (old + 1u == (gen + 1u) * nloc) {
            __builtin_amdgcn_fence(__ATOMIC_RELEASE, "agent");
            asm volatile("s_waitcnt vmcnt(0)" ::: "memory");
            const unsigned og = xb_add(&bar[XB_TOP], 1u);
            const unsigned tg = og / nx;
            if (og + 1u == (tg + 1u) * nx) xb_add(&bar[XB_TOPGEN], 1u);
            else XB_SPIN(xb_ld(&bar[XB_TOPGEN]) == tg, bar);
            __builtin_amdgcn_fence(__ATOMIC_ACQUIRE, "agent");
            xb_add(&bar[XB_XGEN(b.x)], 1u);
            asm volatile("s_waitcnt vmcnt(0)" ::: "memory");
        } else {
            XB_SPIN(xb_ld(&bar[XB_XGEN(b.x)]) == gen, bar);
            __builtin_amdgcn_fence(__ATOMIC_ACQUIRE, "agent");
            asm volatile("s_waitcnt vmcnt(0)" ::: "memory");
        }
    }
    __syncthreads();
}

struct Args { const float* in[41]; float* out; unsigned char* ws; int ph_lo, ph_hi, li, pad; };
struct Frame { LAS unsigned char* lds; volatile LAS unsigned* MISC; gu32* ctl; unsigned char* ws; int tid, lane, wave, G, bid; };
enum { I_X = 0, I_MEM, I_NMIX, I_NCROSS, I_NMEM, I_NFFN, I_EVWIN, I_RGCW, I_RGCB, I_RGWA, I_RGBA, I_RGWX, I_RGBX, I_RGLAM, I_GATEB, I_QNORM, I_KNORM, I_CMPPOS,
       I_CKW1, I_CKW2, I_CVW1, I_CVW2, I_EVWOUT, I_ODWIN, I_ODCW, I_ODCB, I_DTB, I_ALOG, I_DSKIP, I_ODNORM, I_ODWOUT, I_XWQ, I_XWKV, I_XQN, I_XKN, I_XWO,
       I_FFW13, I_FFW2, I_ROUTER, I_MW13, I_MW2, N_IN };
static_assert(N_IN == 41, "input count");

template <int MAP>
__device__ __forceinline__ void transpose_item(const float* W, int N, bf16* WT, int ldt, LAS float* scr, int kb, int nb, int lane, int ffs, const float* kg = nullptr) {
    const int k0 = 64 * kb, n0 = 64 * nb; const int c4 = (lane & 15) * 4, r4 = lane >> 4;
    f32x4 tv[16];
    if ((N & 3) == 0) {
#pragma unroll
        for (int i = 0; i < 16; ++i) { const int kk = 4 * i + r4; tv[i] = (n0 + c4 < N) ? *(const GAS f32x4*)(W + (size_t)(k0 + kk) * N + n0 + c4) : (f32x4){0.f, 0.f, 0.f, 0.f}; }
    } else {
#pragma unroll
        for (int i = 0; i < 16; ++i) { const int kk = 4 * i + r4; const float* src = W + (size_t)(k0 + kk) * N + n0 + c4;
#pragma unroll
            for (int j = 0; j < 4; ++j) tv[i][j] = (n0 + c4 + j < N) ? src[j] : 0.f; }
    }
#pragma unroll
    for (int i = 0; i < 16; ++i) { const int kk = 4 * i + r4; const float gk = kg ? kg[k0 + kk] : 1.f;
#pragma unroll
        for (int j = 0; j < 4; ++j) scr[kk * 65 + c4 + j] = tv[i][j] * gk; }
    LDS_WAIT(); asm volatile("" ::: "memory");
    const int c = lane & 7;
#pragma unroll
    for (int j = 0; j < 8; ++j) { const int nl = (lane >> 3) + 8 * j, n = n0 + nl; const LAS float* s = scr + (8 * c) * 65 + nl;
        v4u o; o.x = pk2(s[0 * 65], s[1 * 65]); o.y = pk2(s[2 * 65], s[3 * 65]); o.z = pk2(s[4 * 65], s[5 * 65]); o.w = pk2(s[6 * 65], s[7 * 65]);
        int row = n; if (MAP == 1) row = (n < ffs) ? pg8::swiglu_row(n, 0) : pg8::swiglu_row(n - ffs, 1);
        if (n < ((N + 31) & ~31)) *(GAS v4u*)(WT + (size_t)row * ldt + k0 + 8 * c) = o; }
    LDS_WAIT(); asm volatile("" ::: "memory");
}
__device__ __forceinline__ unsigned pk4_fp8(float a, float b, float c, float d) { int r = __builtin_amdgcn_cvt_pk_fp8_f32(a, b, 0, false); r = __builtin_amdgcn_cvt_pk_fp8_f32(c, d, r, true); return (unsigned)r; }
template <int MAP>
__device__ __forceinline__ void transpose_item_f8(const float* W, int N, unsigned char* WT8, int ldt, LAS float* scr, int kb, int nb, int lane, int ffs, float sc) {
    const int k0 = 64 * kb, n0 = 64 * nb; const int c4 = (lane & 15) * 4, r4 = lane >> 4;
    f32x4 tv[16];
#pragma unroll
    for (int i = 0; i < 16; ++i) { const int kk = 4 * i + r4; tv[i] = *(const GAS f32x4*)(W + (size_t)(k0 + kk) * N + n0 + c4); }
#pragma unroll
    for (int i = 0; i < 16; ++i) { const int kk = 4 * i + r4;
#pragma unroll
        for (int j = 0; j < 4; ++j) scr[kk * 65 + c4 + j] = tv[i][j] * sc; }
    LDS_WAIT(); asm volatile("" ::: "memory");
    const int c = lane & 7;
#pragma unroll
    for (int j = 0; j < 8; ++j) { const int nl = (lane >> 3) + 8 * j, n = n0 + nl; const LAS float* s = scr + (8 * c) * 65 + nl;
        v2u o; o.x = pk4_fp8(s[0 * 65], s[1 * 65], s[2 * 65], s[3 * 65]); o.y = pk4_fp8(s[4 * 65], s[5 * 65], s[6 * 65], s[7 * 65]);
        int row = n; if (MAP == 1) row = (n < ffs) ? pg8::swiglu_row(n, 0) : pg8::swiglu_row(n - ffs, 1);
        *(GAS v2u*)(WT8 + (size_t)row * ldt + k0 + 8 * c) = o; }
    LDS_WAIT(); asm volatile("" ::: "memory");
}
constexpr int MOE_CONV_ITEMS = NEXP * (16 * 112 + 56 * 16);

__device__ __forceinline__ void rms_row_to_bf16(const float* xrow, const float* g, bf16* orow, int lane) {
    const GAS f32x4* xr = (const GAS f32x4*)xrow + lane; const GAS f32x4* gr = (const GAS f32x4*)g + lane;
    f32x4 v[4]; float s = 0.f;
#pragma unroll
    for (int j = 0; j < 4; ++j) { v[j] = xr[64 * j]; s += (v[j].x * v[j].x + v[j].y * v[j].y) + (v[j].z * v[j].z + v[j].w * v[j].w); }
    const float rstd = 1.f / sqrtf(wave_sum(s) * (1.f / D) + EPS);
    GAS unsigned long long* o8 = (GAS unsigned long long*)orow + lane;
#pragma unroll
    for (int j = 0; j < 4; ++j) { const f32x4 gg = gr[64 * j];
        o8[64 * j] = (unsigned long long)pk2(v[j].x * rstd * gg.x, v[j].y * rstd * gg.y) | ((unsigned long long)pk2(v[j].z * rstd * gg.z, v[j].w * rstd * gg.w) << 32); }
}
__device__ __forceinline__ void phase_rmsnorm(const Frame& F, const float* x, const float* g, bf16* xn, int rows) {
    const int gw = F.bid * NWAVES + F.wave, NGW = F.G * NWAVES;
    for (int m = gw; m < rows; m += NGW) rms_row_to_bf16(x + (size_t)m * D, g, xn + (size_t)m * D, F.lane);
}
#define TR_MAT(cnt_, W_, K_, N_, WT_, ldt_, MAPK_, ffs_, kg_) \
    if (r < (cnt_)) { const int nblk_ = ((N_) + 63) / 64; transpose_item<MAPK_>((W_), (N_), (WT_), (ldt_), scr, r / nblk_, r % nblk_, F.lane, (ffs_), (kg_)); continue; } r -= (cnt_);
constexpr int C_EVIN = 16 * 73, C_EVOUT = 32 * 16, C_CW1 = 64 * 4, C_ODIN = 16 * 81, C_ODOUT = 32 * 16, C_XQ = 16 * 8, C_XKV = 16 * 16, C_XO = 8 * 16, C_FF13 = 16 * 88, C_FF2 = 44 * 16;
constexpr int CONV_A = C_EVIN + 2 * C_XKV + 2 * C_CW1, CONV_B = C_EVOUT + 2 * C_XQ + 2 * C_XO + C_FF13 + C_FF2 + C_ODIN + C_ODOUT;
constexpr int CONV_ALL = CONV_A + CONV_B + MOE_CONV_ITEMS, CONV_Q = 4480, CONV_P2_END = CONV_ALL - 2 * CONV_Q;
__device__ __forceinline__ void convert_range(const Frame& F, const Args& a, int gw, int NGW, int it_lo, int it_hi) {
    LAS float* scr = (LAS float*)(F.lds + F.wave * 16640); unsigned char* ws = F.ws;
    for (int it = it_lo + gw; it < it_hi; it += NGW) {
        int r = it;
        TR_MAT(C_EVIN, a.in[I_EVWIN], D, EV_IN, (bf16*)(ws + WS_W_EVIN), D, 0, 0, nullptr)
        TR_MAT(C_XKV, a.in[I_XWKV], D, 1024, (bf16*)(ws + WS_W_XKV), D, 0, 0, nullptr)
        TR_MAT(C_XKV, a.in[I_XWKV] + (size_t)D * 1024, D, 1024, (bf16*)(ws + WS_W_XKV) + (size_t)1024 * D, D, 0, 0, nullptr)
        TR_MAT(C_CW1, a.in[I_CKW1], 4096, 256, (bf16*)(ws + WS_W_CK1), 4096, 0, 0, nullptr)
        TR_MAT(C_CW1, a.in[I_CVW1], 4096, 256, (bf16*)(ws + WS_W_CV1), 4096, 0, 0, nullptr)
        TR_MAT(C_EVOUT, a.in[I_EVWOUT], 2048, D, (bf16*)(ws + WS_W_EVOUT), 2048, 0, 0, nullptr)
        TR_MAT(C_XQ, a.in[I_XWQ], D, 512, (bf16*)(ws + WS_W_XQ), D, 0, 0, a.in[I_NCROSS])
        TR_MAT(C_XO, a.in[I_XWO], 512, D, (bf16*)(ws + WS_W_XO), 512, 0, 0, nullptr)
        TR_MAT(C_FF13, a.in[I_FFW13], D, 2 * FF, (bf16*)(ws + WS_W_FF13), D, 1, FF, a.in[I_NFFN])
        TR_MAT(C_FF2, a.in[I_FFW2], FF, D, (bf16*)(ws + WS_W_FF2), FF, 0, 0, nullptr)
        TR_MAT(C_ODIN, a.in[I_ODWIN], D, OD_IN, (bf16*)(ws + WS_W_ODIN), D, 0, 0, a.in[I_NMIX] + D)
        TR_MAT(C_ODOUT, a.in[I_ODWOUT], 2048, D, (bf16*)(ws + WS_W_ODOUT), 2048, 0, 0, nullptr)
        TR_MAT(C_XQ, a.in[I_XWQ] + (size_t)D * 512, D, 512, (bf16*)(ws + WS_W_XQ) + (size_t)512 * D, D, 0, 0, a.in[I_NCROSS] + D)
        TR_MAT(C_XO, a.in[I_XWO] + (size_t)512 * D, 512, D, (bf16*)(ws + WS_W_XO) + (size_t)D * 512, 512, 0, 0, nullptr)
        { constexpr int C_M13 = 16 * 112, C_M2 = 56 * 16;
          if (r < NEXP * C_M13) { const int e = r / C_M13, q = r % C_M13; transpose_item_f8<1>(a.in[I_MW13] + (size_t)e * D * 2 * FFE, 2 * FFE, ws + WS_W_M13 + (size_t)e * 2 * FFE * D, D, scr, q / 112, q % 112, F.lane, FFE, MOE_W13_SCALE); continue; } r -= NEXP * C_M13;
          { const int e = r / C_M2, q = r % C_M2; transpose_item_f8<0>(a.in[I_MW2] + (size_t)e * FFE * D, D, ws + WS_W_M2 + (size_t)e * D * FFE, FFE, scr, q / 16, q % 16, F.lane, 0, MOE_W2_SCALE); } }
    }
}
__device__ __forceinline__ void p0_prologue(const Frame& F, const Args& a) {
    const int gw = F.bid * NWAVES + F.wave, NGW = F.G * NWAVES;
    unsigned char* ws = F.ws;
    convert_range(F, a, gw, NGW, 0, CONV_A);
    for (int i = F.bid * NTHR + F.tid; i < 2 * 224 * 128; i += F.G * NTHR) { const int w = i / (224 * 128), q = i % (224 * 128);
        bf16* base = w == 0 ? (bf16*)(ws + WS_W_EVIN) + (size_t)4640 * D : (bf16*)(ws + WS_W_ODIN) + (size_t)5152 * D; *(GAS v4u*)(base + (size_t)q * 8) = (v4u){0u, 0u, 0u, 0u}; }
    phase_rmsnorm(F, a.in[I_X], a.in[I_NMIX], (bf16*)(ws + WS_XN), M);
    phase_rmsnorm(F, a.in[I_MEM], a.in[I_NMEM], (bf16*)(ws + WS_MEMN), MMEM);
    phase_rmsnorm(F, a.in[I_MEM], a.in[I_NMEM] + D, (bf16*)(ws + WS_MEMN) + (size_t)MMEM * D, MMEM);
    for (int i = F.bid * NTHR + F.tid; i < 512 * 128; i += F.G * NTHR) { const int n = i >> 7, j = i & 127; ((bf16*)(ws + WS_OV))[i] = (n <= 510 && n >= 4 * j - 1 && n <= 4 * j + 3) ? (bf16)0x3F80 : (bf16)0; }
    for (int it = gw; it < 128; it += NGW) { const int mm = it >> 6, ic = it & 63; const float* w1 = a.in[mm ? I_CVW1 : I_CKW1]; const float* pos = a.in[I_CMPPOS];
        f32x4 acc = {0.f, 0.f, 0.f, 0.f};
        for (int rr = 0; rr < 64; ++rr) { const int i = ic * 64 + rr; const float p = pos[i]; const f32x4 w = *(const GAS f32x4*)(w1 + (size_t)i * 256 + 4 * F.lane); acc += w * p; }
        *(GAS f32x4*)((float*)(ws + WS_CMPB_PART) + (size_t)(mm * 64 + ic) * 256 + 4 * F.lane) = acc; }
}
#undef TR_MAT
namespace att {
constexpr float SCALE = 0.08838834764831845f;
constexpr float THR = 8.f;
constexpr int KVBLK = 64, DH = 128;
constexpr int SHM_V = KVBLK * DH * 2, SHM_K = KVBLK * DH * 2;
constexpr int NSLOT = 3;
constexpr int LDS_ATT = NSLOT * SHM_V + NSLOT * SHM_K + NWAVES * 64 * 4;
#define KSWZ(row, colB) ((row) * 256 + ((colB) ^ (((row) & 7) << 4)))
__device__ __forceinline__ int v_st(int k, int c) { const int kk = (k & ~0xC) | ((k & 4) << 1) | ((k & 8) >> 1); return ((kk >> 3) * 4 + (c >> 5)) * 512 + ((kk & 7) * 32 + (c & 31)) * 2; }
__device__ __forceinline__ int v_rd_base(int lane) { return ((lane & 3) << 3) | (((lane >> 2) & 3) << 6) | (((lane >> 4) & 1) << 5) | (((lane >> 5) & 1) << 8); }
constexpr int v_rd_off(int d0, int ks, int half) { return d0 * 512 + ks * 4096 + half * 2048; }
__device__ __forceinline__ int crow(int r, int hi) { return (r & 3) + 8 * (r >> 2) + 4 * hi; }
__device__ __forceinline__ bf16x8 pack8(f32x4 a, f32x4 b) { v4u w = {cvtpk(a[0], a[1]), cvtpk(a[2], a[3]), cvtpk(b[0], b[1]), cvtpk(b[2], b[3])}; return *reinterpret_cast<bf16x8*>(&w); }

__device__ __forceinline__ void mask_tile(f32x16& p0, f32x16& p1, int dq, unsigned W) {
    asm volatile("" : "+v"(dq));
    const float NEG = -__builtin_inff();
#pragma unroll
    for (int r = 0; r < 16; ++r) { const int c = (r & 3) + 8 * (r >> 2);
        if ((unsigned)(dq - c) >= W) p0[r] = NEG;
        if ((unsigned)(dq - c - 32) >= W) p1[r] = NEG; }
}
__device__ __forceinline__ void mask_all(f32x16& p0, f32x16& p1) { const float NEG = -__builtin_inff();
#pragma unroll
    for (int r = 0; r < 16; ++r) { p0[r] = NEG; p1[r] = NEG; } }
__device__ __forceinline__ void partialSM(f32x16& p0, f32x16& p1, float& m_reg, float& mn, float& alpha, bool keep = true) {
    float pmax = p0[0];
#pragma unroll
    for (int r = 1; r < 16; ++r) pmax = fmaxf(pmax, p0[r]);
#pragma unroll
    for (int r = 0; r < 16; ++r) pmax = fmaxf(pmax, p1[r]);
    pmax = keep ? pmax : -__builtin_inff();
    { auto rr = __builtin_amdgcn_permlane32_swap(__float_as_uint(pmax), __float_as_uint(pmax), false, false);
      pmax = fmaxf(__uint_as_float(rr[0]), __uint_as_float(rr[1])); }
    constexpr float C2 = 1.4426950408889634f * SCALE;
    if (__builtin_expect(__all((pmax - m_reg) * SCALE <= THR), 1)) { mn = m_reg; alpha = 1.f; }
    else { mn = fmaxf(m_reg, pmax); alpha = __builtin_amdgcn_exp2f((m_reg - mn) * C2); m_reg = mn; }
    const float mnL = keep ? -mn * C2 : -__builtin_inff();
#pragma unroll
    for (int r = 0; r < 16; ++r) p0[r] = fmaf(p0[r], C2, mnL);
#pragma unroll
    for (int r = 0; r < 16; ++r) p1[r] = fmaf(p1[r], C2, mnL);
#pragma unroll
    for (int r = 0; r < 16; ++r) p0[r] = __builtin_amdgcn_exp2f(p0[r]);
}
__device__ __forceinline__ void finishSM(f32x16& p0, f32x16& p1, float alpha, float& l_reg, bf16x8& pa0, bf16x8& pa1, bf16x8& pa2, bf16x8& pa3) {
#pragma unroll
    for (int r = 0; r < 16; ++r) p1[r] = __builtin_amdgcn_exp2f(p1[r]);
    float ps = 0;
#pragma unroll
    for (int r = 0; r < 16; ++r) ps += p0[r];
#pragma unroll
    for (int r = 0; r < 16; ++r) ps += p1[r];
    { auto rr = __builtin_amdgcn_permlane32_swap(__float_as_uint(ps), __float_as_uint(ps), false, false);
      ps = __uint_as_float(rr[0]) + __uint_as_float(rr[1]); }
    l_reg = l_reg * alpha + ps;
#define PK4(P, B_, OUT) do { unsigned a0 = cvtpk(P[B_+0], P[B_+1]), a1 = cvtpk(P[B_+2], P[B_+3]);                          \
        unsigned b0 = cvtpk(P[B_+4], P[B_+5]), b1 = cvtpk(P[B_+6], P[B_+7]);                                             \
        auto r0 = __builtin_amdgcn_permlane32_swap(a0, b0, false, false); auto r1 = __builtin_amdgcn_permlane32_swap(a1, b1, false, false); \
        v4u w = {r0[0], r1[0], r0[1], r1[1]}; OUT = *reinterpret_cast<bf16x8*>(&w); } while (0)
    PK4(p0, 0, pa0); PK4(p0, 8, pa1); PK4(p1, 0, pa2); PK4(p1, 8, pa3);
#undef PK4
}
__device__ __forceinline__ void qkt(f32x16& p0, f32x16& p1, const char* Kslot, int r32, int hi, const bf16x8* qr) {
    p0 = f32x16{}; p1 = f32x16{};
    const char* kb[4];
#pragma unroll
    for (int dd = 0; dd < 4; ++dd) kb[dd] = Kslot + KSWZ(r32, (dd * 16 + hi * 8) * 2);
    bf16x8 fa[4], fb[4];
#define KLD(dst, i, d0) do { const char* a_ = kb[(d0) & 3] + ((d0) >> 2) * 128; dst[i] = *reinterpret_cast<const bf16x8*>(a_); dst[i + 1] = *reinterpret_cast<const bf16x8*>(a_ + 32 * 256); } while (0)
#define KMM(src, i, d0) do { p0 = __builtin_amdgcn_mfma_f32_32x32x16_bf16(src[i], qr[d0], p0, 0, 0, 0); p1 = __builtin_amdgcn_mfma_f32_32x32x16_bf16(src[i + 1], qr[d0], p1, 0, 0, 0); } while (0)
    KLD(fa, 0, 0); KLD(fa, 2, 1); KLD(fb, 0, 2); KLD(fb, 2, 3); SBAR();
    KMM(fa, 0, 0); KMM(fa, 2, 1); SBAR(); KLD(fa, 0, 4); KLD(fa, 2, 5); SBAR();
    KMM(fb, 0, 2); KMM(fb, 2, 3); SBAR(); KLD(fb, 0, 6); KLD(fb, 2, 7); SBAR();
    KMM(fa, 0, 4); KMM(fa, 2, 5); SBAR();
    KMM(fb, 0, 6); KMM(fb, 2, 7);
#undef KLD
#undef KMM
}
__device__ __forceinline__ void pv_tile(f32x16* o, int vbs, bf16x8 pa0, bf16x8 pa1, bf16x8 pa2, bf16x8 pa3) {
#define TRRD(dst, off) asm volatile("ds_read_b64_tr_b16 %0, %1 offset:%2" : "=&v"(dst) : "v"(vbs), "i"(off) : "memory")
#define PV_D0(d0) do { s16x4 l0, l1, l2, l3, h0, h1, h2, h3; constexpr int b_ = v_rd_off(d0, 0, 0); \
        TRRD(l0, b_); TRRD(h0, b_ + 2048); TRRD(l1, b_ + 4096); TRRD(h1, b_ + 6144); TRRD(l2, b_ + 8192); TRRD(h2, b_ + 10240); TRRD(l3, b_ + 12288); TRRD(h3, b_ + 14336); \
        asm volatile("s_waitcnt lgkmcnt(0)" ::: "memory"); SBAR();   \
        o[d0] = __builtin_amdgcn_mfma_f32_32x32x16_bf16(pa0, (bf16x8){l0[0], l0[1], l0[2], l0[3], h0[0], h0[1], h0[2], h0[3]}, o[d0], 0, 0, 0);   \
        o[d0] = __builtin_amdgcn_mfma_f32_32x32x16_bf16(pa1, (bf16x8){l1[0], l1[1], l1[2], l1[3], h1[0], h1[1], h1[2], h1[3]}, o[d0], 0, 0, 0);   \
        o[d0] = __builtin_amdgcn_mfma_f32_32x32x16_bf16(pa2, (bf16x8){l2[0], l2[1], l2[2], l2[3], h2[0], h2[1], h2[2], h2[3]}, o[d0], 0, 0, 0);   \
        o[d0] = __builtin_amdgcn_mfma_f32_32x32x16_bf16(pa3, (bf16x8){l3[0], l3[1], l3[2], l3[3], h3[0], h3[1], h3[2], h3[3]}, o[d0], 0, 0, 0); } while (0)
    PV_D0(0); PV_D0(1); PV_D0(2); PV_D0(3);
#undef PV_D0
#undef TRRD
}
__device__ __forceinline__ void q_issue(const bf16* qrow, int hi, v4u (&raw)[8]) {
#pragma unroll
    for (int d0 = 0; d0 < 8; ++d0) raw[d0] = *(const GAS v4u*)(qrow + d0 * 16 + hi * 8);
}
__device__ __forceinline__ void q_finish(const v4u (&raw)[8], const float* g, int hi, bf16x8* qr) {
    float ss = 0.f;
#pragma unroll
    for (int d0 = 0; d0 < 8; ++d0)
#pragma unroll
        for (int j = 0; j < 4; ++j) { const float a = bflo(raw[d0][j]), b = bfhi(raw[d0][j]); ss += a * a + b * b; }
    ss += __shfl_xor(ss, 32);
    const float rstd = 1.f / sqrtf(ss * (1.f / 128.f) + EPS);
#pragma unroll
    for (int d0 = 0; d0 < 8; ++d0) { const f32x4 g0 = *(const GAS f32x4*)(g + d0 * 16 + hi * 8), g1 = *(const GAS f32x4*)(g + d0 * 16 + hi * 8 + 4);
        v4u w; w.x = cvtpk(bflo(raw[d0][0]) * rstd * g0[0], bfhi(raw[d0][0]) * rstd * g0[1]); w.y = cvtpk(bflo(raw[d0][1]) * rstd * g0[2], bfhi(raw[d0][1]) * rstd * g0[3]);
        w.z = cvtpk(bflo(raw[d0][2]) * rstd * g1[0], bfhi(raw[d0][2]) * rstd * g1[1]); w.w = cvtpk(bflo(raw[d0][3]) * rstd * g1[2], bfhi(raw[d0][3]) * rstd * g1[3]);
        qr[d0] = *reinterpret_cast<bf16x8*>(&w); }
}
__device__ __forceinline__ void load_q(const bf16* qrow, const float* g, int hi, bf16x8* qr) { v4u raw[8]; q_issue(qrow, hi, raw); q_finish(raw, g, hi, qr); }
struct PassIO { const bf16* Kp; int ldk; const bf16* Vp; int ldv; int t_lo, t_hi; };
__device__ __forceinline__ void dma_offsets(int wid, int lane, int ldk, int ldv, unsigned& koff, unsigned& voff) {
    const int row = 4 * wid + (lane >> 4); koff = (unsigned)(row * ldk * 2 + (((lane & 15) ^ (row & 7)) << 4));
    const int st = 2 * wid + (lane >> 5), kk = ((st >> 2) << 3) | ((lane & 31) >> 2), k = (kk & ~0xC) | ((kk & 4) << 1) | ((kk & 8) >> 1); voff = (unsigned)(k * ldv * 2 + ((st & 3) * 32 + 8 * (lane & 3)) * 2);
}
#define ATT_DMA(io_, t, slot) do { const char* kt_ = (const char*)(io_).Kp + (size_t)(t) * (KVBLK * 2) * (io_).ldk; const char* vt_ = (const char*)(io_).Vp + (size_t)(t) * (KVBLK * 2) * (io_).ldv;          \
        LAS unsigned* kd_ = (LAS unsigned*)(ldsl + NSLOT * SHM_V + (slot) * SHM_K + wid * 1024); LAS unsigned* vd_ = (LAS unsigned*)(ldsl + (slot) * SHM_V + wid * 1024);                \
        __builtin_amdgcn_global_load_lds((const unsigned*)(kt_ + koff), kd_, 16, 0, 0); __builtin_amdgcn_global_load_lds((const unsigned*)(kt_ + koff + (size_t)64 * (io_).ldk), kd_ + 2048, 16, 0, 0); \
        __builtin_amdgcn_global_load_lds((const unsigned*)(vt_ + voff), vd_, 16, 0, 0); __builtin_amdgcn_global_load_lds((const unsigned*)(vt_ + voff + (size_t)64 * (io_).ldv), vd_ + 2048, 16, 0, 0); } while (0)
__device__ __forceinline__ void attn_prefetch(char* lds, const PassIO& io) {
    int tid = threadIdx.x; asm volatile("" : "+v"(tid));
    const int wid = __builtin_amdgcn_readfirstlane(tid >> 6), lane = tid & 63;
    unsigned koff, voff; dma_offsets(wid, lane, io.ldk, io.ldv, koff, voff);
    LAS unsigned char* ldsl = (LAS unsigned char*)lds;
    ATT_DMA(io, io.t_lo, 0); if (io.t_hi - io.t_lo > 1) ATT_DMA(io, io.t_lo + 1, 1);
}
template <class MaskF>
__device__ __forceinline__ void attn_pass(char* lds, const bf16x8* qr, const PassIO& io, const MaskF& mf, f32x16 (&o)[4], float& l_out) {
    int tid = threadIdx.x; asm volatile("" : "+v"(tid));
    const int wid = __builtin_amdgcn_readfirstlane(tid >> 6), lane = tid & 63, r32 = lane & 31, hi = lane >> 5;
    char* V_lds = lds; char* K_lds = lds + NSLOT * SHM_V;
    float* wsc = (float*)(lds + NSLOT * SHM_V + NSLOT * SHM_K) + wid * 64; float* al_l = wsc + 32;
    float m_reg = -1e30f, l_reg = 0.f;
#pragma unroll
    for (int d = 0; d < 4; ++d) o[d] = f32x16{};
    const int vb0 = (int)(uintptr_t)V_lds + v_rd_base(lane);
    const int t_lo = io.t_lo, NT = io.t_hi - io.t_lo;
    unsigned koff, voff; dma_offsets(wid, lane, io.ldk, io.ldv, koff, voff);
    LAS unsigned char* ldsl = (LAS unsigned char*)lds;
    f32x16 p0, p1; float mn, alpha = 1.f; bf16x8 pa0, pa1, pa2, pa3;
#define A_RESC(a) do { if (__any((a) < 1.f)) { if (hi == 0) al_l[r32] = (a); asm volatile("s_waitcnt lgkmcnt(0)" ::: "memory"); \
        _Pragma("unroll") for (int d_ = 0; d_ < 4; ++d_) _Pragma("unroll") for (int r = 0; r < 16; ++r) o[d_][r] *= al_l[crow(r, hi)]; } } while (0)
#define A_BAR() do { asm volatile("" ::: "memory"); __builtin_amdgcn_s_barrier(); asm volatile("" ::: "memory"); } while (0)
    const bool lead = wid < 4;
    VM_WAIT();
    __syncthreads();
    if (!lead) A_BAR();
    int sK = 0, sV = 2, sW = 1;
    bool act_prev = false;
    for (int i = 0; i < NT; ++i) {
        if (lead && i >= 1 && i + 1 < NT) ATT_DMA(io, t_lo + i + 1, sW);
        const bool act = mf.active(t_lo + i);
        SBAR(); if (act) qkt(p0, p1, K_lds + sK * SHM_K, r32, hi, qr);
        if (i > 0 && act_prev) pv_tile(o, vb0 + sV * SHM_V, pa0, pa1, pa2, pa3);
        if (!lead && i + 1 < NT) VM_WAIT();
        A_BAR();
        if (!lead && i + 2 < NT) ATT_DMA(io, t_lo + i + 2, sV);
        if (act) { mf(p0, p1, t_lo + i); partialSM(p0, p1, m_reg, mn, alpha, mf.keep(t_lo + i)); A_RESC(alpha); finishSM(p0, p1, alpha, l_reg, pa0, pa1, pa2, pa3); }
        act_prev = act;
        if (lead && i + 1 < NT) VM_WAIT();
        A_BAR();
        { const int t_ = sV; sV = sK; sK = sW; sW = t_; }
    }
    if (act_prev) pv_tile(o, vb0 + sV * SHM_V, pa0, pa1, pa2, pa3);
    if (lead) A_BAR();
    __syncthreads();
#undef A_RESC
#undef A_BAR
    l_out = l_reg;
}
__device__ __forceinline__ void row_inv_l(char* lds, float l_reg, float (&rli)[16]) {
    const int tid = threadIdx.x, wid = __builtin_amdgcn_readfirstlane(tid >> 6), lane = tid & 63, r32 = lane & 31, hi = lane >> 5;
    float* wsc = (float*)(lds + NSLOT * SHM_V + NSLOT * SHM_K) + wid * 64;
    if (hi == 0) wsc[r32] = l_reg;
    asm volatile("s_waitcnt lgkmcnt(0)" ::: "memory");
#pragma unroll
    for (int r = 0; r < 16; ++r) { const float l = wsc[crow(r, hi)]; rli[r] = l > 0.f ? __builtin_amdgcn_rcpf(l) : 0.f; }
    asm volatile("s_waitcnt lgkmcnt(0)" ::: "memory");
}
struct NoMask { __device__ __forceinline__ void operator()(f32x16&, f32x16&, int) const {} __device__ __forceinline__ bool active(int) const { return true; } __device__ __forceinline__ bool keep(int) const { return true; } };
}
__device__ __forceinline__ void norm128_rows(const Frame& F, const bf16* src, size_t lds_, bf16* dst, size_t ldd, int nrows, const float* g, int gw, int NGW) {
    const int sub = F.lane >> 4, l16 = F.lane & 15;
    const f32x4 g0 = *(const GAS f32x4*)(g + l16 * 8), g1 = *(const GAS f32x4*)(g + l16 * 8 + 4);
    for (int r0 = gw * 4; r0 < nrows; r0 += NGW * 4) { const int r = r0 + sub;
        const v4u raw = *(const GAS v4u*)(src + (size_t)r * lds_ + l16 * 8);
        float ss = 0.f;
#pragma unroll
        for (int j = 0; j < 4; ++j) { const float a = bflo(raw[j]), b = bfhi(raw[j]); ss += a * a + b * b; }
        ss += __shfl_xor(ss, 1); ss += __shfl_xor(ss, 2); ss += __shfl_xor(ss, 4); ss += __shfl_xor(ss, 8);
        const float rstd = 1.f / sqrtf(ss * (1.f / 128.f) + EPS);
        v4u w; w.x = cvtpk(bflo(raw[0]) * rstd * g0[0], bfhi(raw[0]) * rstd * g0[1]); w.y = cvtpk(bflo(raw[1]) * rstd * g0[2], bfhi(raw[1]) * rstd * g0[3]);
        w.z = cvtpk(bflo(raw[2]) * rstd * g1[0], bfhi(raw[2]) * rstd * g1[1]); w.w = cvtpk(bflo(raw[3]) * rstd * g1[2], bfhi(raw[3]) * rstd * g1[3]);
        *(GAS v4u*)(dst + (size_t)r * ldd + l16 * 8) = w; }
}
__device__ __forceinline__ void phase_memk_norm(const Frame& F, const Args& a, int l, int gw, int NGW) {
    const bf16* kvm = (const bf16*)(F.ws + WS_KVM) + (size_t)l * MMEM * 1024; bf16* km = (bf16*)(F.ws + WS_KM) + (size_t)l * MMEM * 512;
    for (int bh = 0; bh < BATCH * XH; ++bh) { const int b = bh >> 2, h = bh & 3;
        norm128_rows(F, kvm + (size_t)b * MEMLEN * 1024 + h * 128, 1024, km + (size_t)bh * MEMLEN * 128, 128, MEMLEN, a.in[I_XKN] + l * 128, gw, NGW); }
}

__device__ __forceinline__ void phase_cross_attn(const Frame& F, const Args& a, int l) {
    char* lds = (char*)F.lds; const int r32 = F.lane & 31, hi = F.lane >> 5;
    const bf16* QX = (const bf16*)(F.ws + WS_QX); bf16* OX = (bf16*)(F.ws + WS_OX);
    for (int u = F.bid; u < BATCH * XH * (SEQ / 256); u += F.G) {
        const int tb = u % (SEQ / 256), bh = u / (SEQ / 256), b = bh >> 2, h = bh & 3;
        const size_t row0 = (size_t)b * SEQ + tb * 256 + F.wave * 32;
        const bf16* Kp = (const bf16*)(F.ws + WS_KM) + (size_t)l * MMEM * 512 + (size_t)bh * MEMLEN * 128;
        const bf16* Vp = (const bf16*)(F.ws + WS_KVM) + (size_t)l * MMEM * 1024 + (size_t)b * MEMLEN * 1024 + 512 + h * 128;
        const att::PassIO io{Kp, 128, Vp, 1024, 0, MEMLEN / 64}; att::attn_prefetch(lds, io);
        bf16x8 qr[8]; att::load_q(QX + (row0 + r32) * 512 + h * 128, a.in[I_XQN] + l * 128, hi, qr);
        f32x16 o[4]; float l_reg; att::attn_pass(lds, qr, io, att::NoMask{}, o, l_reg);
        float rli[16]; att::row_inv_l(lds, l_reg, rli);
#pragma unroll
        for (int r = 0; r < 16; ++r) { bf16* orow = OX + (row0 + att::crow(r, hi)) * 512 + h * 128;
#pragma unroll
            for (int d0 = 0; d0 < 4; ++d0) { const float v = o[d0][r] * rli[r]; const float vn = __shfl_xor(v, 1);
                if ((r32 & 1) == 0) *(GAS unsigned*)(orow + d0 * 32 + r32) = cvtpk(v, vn); } }
    }
}

constexpr int NSA_GSC = att::LDS_ATT, NSA_IMP = NSA_GSC + NWAVES * 32 * 3 * 4, NSA_SEL = NSA_IMP + NWAVES * 8 * 128 * 4, NSA_SELU = NSA_SEL + 64 * 4 * 4, NSA_LDS_END = NSA_SELU + NWAVES * 4 * 4;
static_assert(NSA_LDS_END <= SCR_BYTES, "nsa lds");
struct CmpMask { int nmax, hi, nmin_wave;
    __device__ __forceinline__ void operator()(f32x16& p0, f32x16& p1, int t) const { if (t * 64 + 63 <= nmin_wave) return; att::mask_tile(p0, p1, nmax - t * 64 - 4 * hi, 0x40000000u); }
    __device__ __forceinline__ bool active(int) const { return true; } __device__ __forceinline__ bool keep(int) const { return true; } };
struct WinMask { int P, hi, qb;
    __device__ __forceinline__ void operator()(f32x16& p0, f32x16& p1, int t) const { if (t == qb || t == qb - 8) att::mask_tile(p0, p1, P - t * 64 - 4 * hi, 512u); }
    __device__ __forceinline__ bool active(int) const { return true; } __device__ __forceinline__ bool keep(int) const { return true; } };
struct SlcMask { const LAS unsigned* selw; const LAS unsigned* uni; int P, hi, qb;
    __device__ __forceinline__ void operator()(f32x16& p0, f32x16& p1, int t) const { if (t == qb) att::mask_tile(p0, p1, P - t * 64 - 4 * hi, 0x40000000u); }
    __device__ __forceinline__ bool keep(int t) const { return (selw[t >> 5] >> (t & 31)) & 1u; }
    __device__ __forceinline__ bool active(int t) const { return (__builtin_amdgcn_readfirstlane(uni[t >> 5]) >> (t & 31)) & 1u; } };

__device__ __forceinline__ void nsa_unit(const Frame& F, const Args& a, int b, int g, int qb, int dry = 0) {
    char* lds = (char*)F.lds; const int w = F.wave; const int t0 = qb * 64;
#define NSA_LANE() int lane = F.lane; asm volatile("" : "+v"(lane)); const int r32 = lane & 31, hi = lane >> 5; const int tok = 8 * w + (r32 >> 2), head = 4 * g + (r32 & 3), P = t0 + tok; (void)head; (void)P; (void)tok
    unsigned char* wsl = F.ws; asm volatile("" : "+s"(wsl));
    const bf16* Y0 = (const bf16*)(wsl + WS_Y0); const bf16* KV6 = (const bf16*)(wsl + WS_KV6);
    const size_t slab = (size_t)SEQ * 128, bg = (size_t)(b * 2 + g);
    LAS float* gsc = (LAS float*)(F.lds + NSA_GSC) + w * 96; LAS float* imp = (LAS float*)(F.lds + NSA_IMP) + w * 1024; LAS unsigned* selm = (LAS unsigned*)(F.lds + NSA_SEL);
    { NSA_LANE();
      if (hi == 0) {
#pragma unroll
        for (int br = 0; br < 3; ++br) gsc[r32 * 3 + br] = fsigmoid(bf2f(Y0[((size_t)b * SEQ + P) * EV_INP + 4608 + head * 3 + br]) + a.in[I_GATEB][head * 3 + br]); }
      LDS_WAIT(); }
    f32x16 o[4]; float l_reg; float rli[16];
    const bf16* KCMP = (const bf16*)(wsl + WS_KVCMP) + bg * 512 * 128; const bf16* VCMP = (const bf16*)(wsl + WS_KVCMP) + (size_t)2048 * 128 + bg * 512 * 128;
    const int ncmp_t = ((4 * qb + 2) >> 6) + 1;
    const att::PassIO io_imp{KCMP, 128, (const bf16*)(wsl + WS_OV), 128, 0, ncmp_t}, io_cmp{KCMP, 128, VCMP, 128, 0, ncmp_t},
                      io_slc{KV6 + (2 * 4 + bg) * slab, 128, KV6 + (3 * 4 + bg) * slab, 128, 0, qb + 1}, io_win{KV6 + (4 * 4 + bg) * slab, 128, KV6 + (5 * 4 + bg) * slab, 128, qb >= 8 ? qb - 8 : 0, qb + 1};
    v4u qraw[8];
#define NSA_QISSUE() do { NSA_LANE(); att::q_issue(Y0 + ((size_t)b * SEQ + P) * EV_INP + 2048 + head * 128, hi, qraw); } while (0)
    att::attn_prefetch(lds, io_imp); NSA_QISSUE();
    { NSA_LANE(); const CmpMask cm{(P - 31) >> 4, hi, (t0 + 8 * w - 31) >> 4};
      bf16x8 qr[8]; att::q_finish(qraw, a.in[I_QNORM], hi, qr);
      if (dry < 2) att::attn_pass(lds, qr, io_imp, cm, o, l_reg); else { VM_WAIT(); __syncthreads(); l_reg = 1.f; } }
    att::attn_prefetch(lds, io_cmp); NSA_QISSUE();
    if (dry < 3) {
    att::row_inv_l(lds, l_reg, rli);
    { NSA_LANE();
#pragma unroll
    for (int q = 0; q < 4; ++q)
#pragma unroll
        for (int d = 0; d < 4; ++d) { float s = 0.f;
#pragma unroll
            for (int i = 0; i < 4; ++i) s += o[d][4 * q + i] * rli[4 * q + i];
            imp[(2 * q + hi) * 128 + d * 32 + r32] = s; }
    LDS_WAIT();
    { const unsigned long long lt = (1ull << lane) - 1ull;
#pragma unroll 1
    for (int tl = 0; tl < 8; ++tl) { unsigned k0, k1;
        { const int j0 = lane, j1 = lane + 64; const float v0 = imp[tl * 128 + j0], v1 = imp[tl * 128 + j1];
          const float s0 = v0 + (((j0 == 0) || (j0 == qb) || (j0 == qb - 1)) ? 100.f : 0.f), s1 = v1 + (((j1 == 0) || (j1 == qb) || (j1 == qb - 1)) ? 100.f : 0.f);
          k0 = (j0 <= qb) ? __float_as_uint(s0) + 1u : 0u; k1 = (j1 <= qb) ? __float_as_uint(s1) + 1u : 0u; }
        unsigned T = 0u;
#pragma unroll 1
        for (int bit = 30; bit >= 0; --bit) { const unsigned cand = T | (1u << bit);
            const int cnt = __popcll(__ballot(k0 >= cand)) + __popcll(__ballot(k1 >= cand)); if (cnt >= 16) T = cand; }
        const unsigned long long g0 = __ballot(k0 > T), g1 = __ballot(k1 > T), e0 = __ballot(k0 == T), e1 = __ballot(k1 == T);
        const int need = 16 - (__popcll(g0) + __popcll(g1));
        const bool sel0 = (k0 > T) || (k0 == T && __popcll(e0 & lt) < need), sel1 = (k1 > T) || (k1 == T && __popcll(e0) + __popcll(e1 & lt) < need);
        const unsigned long long m0 = __ballot(sel0 && lane <= qb), m1 = __ballot(sel1 && lane + 64 <= qb);
        if (lane == 0) { LAS unsigned* sw = selm + (8 * w + tl) * 4; sw[0] = (unsigned)m0; sw[1] = (unsigned)(m0 >> 32); sw[2] = (unsigned)m1; sw[3] = (unsigned)(m1 >> 32); } } }
    LDS_WAIT();
    if (lane < 4) { unsigned u = 0;
#pragma unroll
        for (int tl = 0; tl < 8; ++tl) u |= selm[(8 * w + tl) * 4 + lane];
        ((LAS unsigned*)(F.lds + NSA_SELU))[w * 4 + lane] = u; }
    LDS_WAIT(); }
    }
    { NSA_LANE(); const CmpMask cm{(P - 31) >> 4, hi, (t0 + 8 * w - 31) >> 4};
      bf16x8 qr[8]; att::q_finish(qraw, a.in[I_QNORM], hi, qr);
#if defined(MK_NSA_DUP) && MK_NSA_DUP == 2
      att::attn_pass(lds, qr, io_cmp, cm, o, l_reg); att::attn_prefetch(lds, io_cmp);
#endif
      if (dry < 2) att::attn_pass(lds, qr, io_cmp, cm, o, l_reg); else { VM_WAIT(); __syncthreads(); l_reg = 1.f; } }
    att::attn_prefetch(lds, io_slc); NSA_QISSUE();
    att::row_inv_l(lds, l_reg, rli);
    unsigned oacc[4][8];
    if (dry < 4) { NSA_LANE();
#pragma unroll
    for (int r = 0; r < 16; ++r) rli[r] *= gsc[att::crow(r, hi) * 3 + 0];
#pragma unroll
    for (int d = 0; d < 4; ++d)
#pragma unroll
        for (int r = 0; r < 16; r += 2) oacc[d][r >> 1] = cvtpk(o[d][r] * rli[r], o[d][r + 1] * rli[r + 1]); }
    { NSA_LANE(); const SlcMask sm{selm + tok * 4, (const LAS unsigned*)(F.lds + NSA_SELU) + w * 4, P, hi, qb};
      bf16x8 qr[8]; att::q_finish(qraw, a.in[I_QNORM], hi, qr);
#if defined(MK_NSA_DUP) && MK_NSA_DUP == 5
      { const size_t bg2 = (bg + 1) & 3; const att::PassIO io_cold{KV6 + (2 * 4 + bg2) * slab, 128, KV6 + (3 * 4 + bg2) * slab, 128, 0, qb + 1};
        att::attn_pass(lds, qr, io_cold, sm, o, l_reg); att::attn_prefetch(lds, io_slc); }
#endif
#if defined(MK_NSA_DUP) && MK_NSA_DUP == 3
      att::attn_pass(lds, qr, io_slc, sm, o, l_reg); att::attn_prefetch(lds, io_slc);
#endif
      if (!dry) att::attn_pass(lds, qr, io_slc, sm, o, l_reg); else { VM_WAIT(); __syncthreads(); } }
    att::attn_prefetch(lds, io_win); NSA_QISSUE();
    att::row_inv_l(lds, l_reg, rli);
    if (dry < 4) { NSA_LANE();
#pragma unroll
    for (int r = 0; r < 16; ++r) rli[r] *= gsc[att::crow(r, hi) * 3 + 1];
#pragma unroll
    for (int d = 0; d < 4; ++d)
#pragma unroll
        for (int r = 0; r < 16; r += 2) oacc[d][r >> 1] = cvtpk(bflo(oacc[d][r >> 1]) + o[d][r] * rli[r], bfhi(oacc[d][r >> 1]) + o[d][r + 1] * rli[r + 1]); }
    { NSA_LANE(); const WinMask wm{P, hi, qb};
      bf16x8 qr[8]; att::q_finish(qraw, a.in[I_QNORM], hi, qr);
#if defined(MK_NSA_DUP) && MK_NSA_DUP == 4
      att::attn_pass(lds, qr, io_win, wm, o, l_reg); att::attn_prefetch(lds, io_win);
#endif
      if (dry < 2) att::attn_pass(lds, qr, io_win, wm, o, l_reg); else { VM_WAIT(); __syncthreads(); l_reg = 1.f; } }
    att::row_inv_l(lds, l_reg, rli);
    if (dry < 4) { NSA_LANE();
    bf16* MIX = dry ? (bf16*)(wsl + WS_R + 400 * MiB) : (bf16*)(wsl + WS_MIX);
#pragma unroll
    for (int r = 0; r < 16; ++r) rli[r] *= gsc[att::crow(r, hi) * 3 + 2];
    bf16* obase = MIX + ((size_t)b * SEQ + t0 + 8 * w) * 2048 + 1024 + 4 * g * 128 + r32;
#pragma unroll
    for (int d0 = 0; d0 < 4; ++d0) {
#pragma unroll
        for (int r = 0; r < 16; ++r) { const int row = att::crow(r, hi); const float v = ((r & 1) ? bfhi(oacc[d0][r >> 1]) : bflo(oacc[d0][r >> 1])) + o[d0][r] * rli[r]; const float vn = __shfl_xor(v, 1);
            if ((r32 & 1) == 0) *(GAS unsigned*)(obase + (size_t)(row >> 2) * 2048 + (row & 3) * 128 + d0 * 32) = cvtpk(v, vn); }
        } }
    __syncthreads();
#undef NSA_QISSUE
#undef NSA_LANE
}
__device__ __forceinline__ void phase_nsa(const Frame& F, const Args& a) {
#pragma unroll 1
    for (int it = F.bid * 2; it < 512; it += F.G * 2)
#pragma unroll 1
        for (int k = 0; k < 2; ++k) { const int p = it >> 1, xcd = p & 7, bg = xcd >> 1, x = (xcd & 1) * 32 + (p >> 3);
#if defined(MK_NSA_DRY)
            nsa_unit(F, a, bg >> 1, bg & 1, k == 0 ? 127 - x : x, MK_NSA_DRY);
#endif
            nsa_unit(F, a, bg >> 1, bg & 1, k == 0 ? 127 - x : x); }
}
__device__ __forceinline__ f32x4 mma16(const LAS bf16* A, int pa, const LAS bf16* B, int pb, int K, f32x4 acc, int fr, int fq) {
    for (int k0 = 0; k0 < K; k0 += 32) { const bf16x8 af = *(const LAS bf16x8*)(A + fr * pa + k0 + 8 * fq); const bf16x8 bfv = *(const LAS bf16x8*)(B + fr * pb + k0 + 8 * fq);
        acc = __builtin_amdgcn_mfma_f32_16x16x32_bf16(af, bfv, acc, 0, 0, 0); }
    return acc;
}

__device__ __forceinline__ f32x4 mma16r(const LAS bf16* Arow, const LAS bf16* Brow, int K, f32x4 acc, int fq) {
    for (int k0 = 0; k0 < K; k0 += 32) { const bf16x8 af = *(const LAS bf16x8*)(Arow + k0 + 8 * fq); const bf16x8 bfv = *(const LAS bf16x8*)(Brow + k0 + 8 * fq);
        acc = __builtin_amdgcn_mfma_f32_16x16x32_bf16(af, bfv, acc, 0, 0, 0); }
    return acc;
}

__device__ __forceinline__ void phase_cmp2(const Frame& F, const Args& a, int u_lo, int u_hi, int u_step) {
    LAS bf16* hidS = (LAS bf16*)F.lds; LAS bf16* w2T = (LAS bf16*)(F.lds + 32 * 264 * 2); LAS float* outS = (LAS float*)(F.lds + 32 * 264 * 2 + 128 * 264 * 2);
    const int fr = F.lane & 15, fq = F.lane >> 4;
    for (int u = u_lo; u < u_hi; u += u_step) { const int mm = u >> 6, rb = u & 63;
        const bf16* hid = (const bf16*)(F.ws + WS_HID) + (size_t)mm * 2048 * 256 + (size_t)rb * 32 * 256; const float* w2 = a.in[mm ? I_CVW2 : I_CKW2];
        for (int i = F.tid; i < 32 * 32; i += NTHR) { const int r = i >> 5, c8 = i & 31; *(LAS v4u*)(hidS + r * 264 + c8 * 8) = *(const GAS v4u*)(hid + r * 256 + c8 * 8); }
        for (int i = F.tid; i < 256 * 128; i += NTHR) { const int k = i >> 7, c = i & 127; w2T[c * 264 + k] = (bf16)f2bf(w2[i]); }
        __syncthreads();
        const int rt = F.wave & 1;
#pragma unroll
        for (int cc = 0; cc < 2; ++cc) { const int ct = (F.wave >> 1) * 2 + cc; f32x4 acc = {0.f, 0.f, 0.f, 0.f};
            acc = mma16(hidS + rt * 16 * 264, 264, w2T + ct * 16 * 264, 264, 256, acc, fr, fq);
#pragma unroll
            for (int e = 0; e < 4; ++e) outS[(rt * 16 + 4 * fq + e) * 132 + ct * 16 + fr] = acc[e]; }
        __syncthreads();
        { const int r = F.wave * 4 + (F.lane >> 4), l16 = F.lane & 15; const int grow = rb * 32 + r, n = grow & 511;
          float v[8]; float ss = 0.f;
#pragma unroll
          for (int j = 0; j < 8; ++j) { v[j] = outS[r * 132 + l16 * 8 + j]; ss += v[j] * v[j]; }
          ss += __shfl_xor(ss, 1); ss += __shfl_xor(ss, 2); ss += __shfl_xor(ss, 4); ss += __shfl_xor(ss, 8);
          if (mm == 0) { const float rstd = 1.f / sqrtf(ss * (1.f / 128.f) + EPS); const float* g = a.in[I_KNORM];
#pragma unroll
              for (int j = 0; j < 8; ++j) v[j] = v[j] * rstd * g[l16 * 8 + j]; }
          if (n == 511) {
#pragma unroll
              for (int j = 0; j < 8; ++j) v[j] = 0.f; }
          v4u w; w.x = cvtpk(v[0], v[1]); w.y = cvtpk(v[2], v[3]); w.z = cvtpk(v[4], v[5]); w.w = cvtpk(v[6], v[7]);
          *(GAS v4u*)((bf16*)(F.ws + WS_KVCMP) + (size_t)mm * 2048 * 128 + (size_t)grow * 128 + l16 * 8) = w; }
        __syncthreads();
    }
}

__device__ __forceinline__ void rglru_unit(const Frame& F, const Args& a, int b, int h, int s) {
    const int w = F.wave, lane = F.lane, fr = lane & 15, fq = lane >> 4;
    LAS bf16* xcs = (LAS bf16*)F.lds + w * (16 * 136); LAS float* summ = (LAS float*)(F.lds + 8 * 16 * 136 * 2);
    const bf16* Y0 = (const bf16*)(F.ws + WS_Y0) + (size_t)b * SEQ * EV_INP; bf16* MIX = (bf16*)(F.ws + WS_MIX) + (size_t)b * SEQ * 2048;
    const int ch = h * 128 + s * 16 + fr;
    bf16x8 ba_f[4], bx_f[4];
    { const float* wa = a.in[I_RGWA] + (size_t)h * 128 * 128 + s * 16 + fr; const float* wx = a.in[I_RGWX] + (size_t)h * 128 * 128 + s * 16 + fr;
#pragma unroll
      for (int kk = 0; kk < 4; ++kk) { v4u ua, ux;
#pragma unroll
          for (int e2 = 0; e2 < 4; ++e2) { const int k = 32 * kk + 8 * fq + 2 * e2; ua[e2] = pk2(wa[(size_t)k * 128], wa[(size_t)(k + 1) * 128]); ux[e2] = pk2(wx[(size_t)k * 128], wx[(size_t)(k + 1) * 128]); }
          ba_f[kk] = *reinterpret_cast<bf16x8*>(&ua); bx_f[kk] = *reinterpret_cast<bf16x8*>(&ux); } }
    const float bias_a = a.in[I_RGBA][ch], bias_x = a.in[I_RGBX][ch], c8 = -8.f * fsoftplus(-a.in[I_RGLAM][ch]);
    const int cg = h * 128 + 2 * lane; float cw0[4], cw1[4];
#pragma unroll
    for (int j = 0; j < 4; ++j) { cw0[j] = a.in[I_RGCW][j * 1024 + cg]; cw1[j] = a.in[I_RGCW][j * 1024 + cg + 1]; }
    const float cb0 = a.in[I_RGCB][cg], cb1 = a.in[I_RGCB][cg + 1];
    float carry = 0.f;
    unsigned raw[19];
#define RG_LOAD(c_) do { const int T0_ = (c_) * 128 + 16 * w; _Pragma("unroll") for (int i = 0; i < 19; ++i) { const int t = T0_ - 3 + i; raw[i] = (t >= 0) ? *(const GAS unsigned*)(Y0 + (size_t)t * EV_INP + cg) : 0u; } } while (0)
    RG_LOAD(0);
#ifdef MK_DUP_RG
    for (int cc = 0; cc < 2 * (SEQ / 128); ++cc) { const int c = cc & (SEQ / 128 - 1); if (cc == SEQ / 128) { carry = 0.f; RG_LOAD(0); }
#else
    for (int c = 0; c < SEQ / 128; ++c) {
#endif
        const int T0 = c * 128 + 16 * w;
#pragma unroll
        for (int tt = 0; tt < 16; ++tt) { float y0 = cb0, y1 = cb1;
#pragma unroll
            for (int j = 0; j < 4; ++j) { y0 += cw0[j] * bflo(raw[tt + j]); y1 += cw1[j] * bfhi(raw[tt + j]); }
            *(LAS unsigned*)(xcs + tt * 136 + 2 * lane) = cvtpk(y0, y1); }
        LDS_WAIT();
        if (c + 1 < SEQ / 128) RG_LOAD(c + 1);
        unsigned short gg[4];
#pragma unroll
        for (int e = 0; e < 4; ++e) gg[e] = Y0[(size_t)(T0 + 4 * fq + e) * EV_INP + 1024 + ch];
        f32x4 acc_a = {0.f, 0.f, 0.f, 0.f}, acc_x = {0.f, 0.f, 0.f, 0.f};
#pragma unroll
        for (int kk = 0; kk < 4; ++kk) { const bf16x8 af = *(const LAS bf16x8*)(xcs + fr * 136 + 32 * kk + 8 * fq);
            acc_a = __builtin_amdgcn_mfma_f32_16x16x32_bf16(af, ba_f[kk], acc_a, 0, 0, 0); acc_x = __builtin_amdgcn_mfma_f32_16x16x32_bf16(af, bx_f[kk], acc_x, 0, 0, 0); }
        float hl[4], pl[4]; float hh = 0.f, pp = 1.f;
#pragma unroll
        for (int e = 0; e < 4; ++e) { const float xv = bf2f(xcs[(4 * fq + e) * 136 + s * 16 + fr]);
            const float r = fsigmoid(acc_a[e] + bias_a), ig = fsigmoid(acc_x[e] + bias_x); const float la = c8 * r; const float av = __expf(la);
            const float uu = __builtin_amdgcn_sqrtf((1.f - av) * (1.f + av)) * (ig * xv);
            hh = av * hh + uu; pp *= av; hl[e] = hh; pl[e] = pp; }
        float Apre = 1.f, Hpre = 0.f, Aw = 1.f, Hw = 0.f;
#pragma unroll
        for (int q = 0; q < 4; ++q) { const float Aq = __shfl(pp, fr + 16 * q), Hq = __shfl(hh, fr + 16 * q);
            if (q < fq) { Hpre = Aq * Hpre + Hq; Apre *= Aq; }
            Hw = Aq * Hw + Hq; Aw *= Aq; }
        LAS float* sm = summ + (c & 1) * 256;
        if (fq == 0) { sm[(w * 16 + fr) * 2] = Aw; sm[(w * 16 + fr) * 2 + 1] = Hw; }
        __syncthreads();
        float cin = carry, call = carry;
#pragma unroll
        for (int q = 0; q < 8; ++q) { const float Aq = sm[(q * 16 + fr) * 2], Hq = sm[(q * 16 + fr) * 2 + 1]; call = Aq * call + Hq; if (q < w) cin = call; }
        carry = call;
        const float cl = Apre * cin + Hpre;
#pragma unroll
        for (int e = 0; e < 4; ++e) { const float hv = hl[e] + pl[e] * cl; MIX[(size_t)(T0 + 4 * fq + e) * 2048 + ch] = (bf16)f2bf(gelu_tanh(bf2f(gg[e])) * hv); }
    }
#undef RG_LOAD
    __syncthreads();
}
constexpr size_t WS_M_CN = WS_R + 168 * MiB + 64 * MiB;
constexpr size_t WS_M_BN = WS_M_CN + 16 * MiB, WS_M_BT = WS_M_BN + 16 * MiB, WS_M_XT = WS_M_BT + 16 * MiB, WS_M_ACS = WS_M_XT + 64 * MiB, WS_M_DTV = WS_M_ACS + 2 * MiB,
                 WS_M_ST = WS_M_DTV + 2 * MiB, WS_M_PV = WS_M_ST + 128 * MiB, WS_M_END = WS_M_PV + 64 * MiB;
static_assert(WS_M_END <= WS_R + 560 * MiB, "mamba ws");
constexpr int MB_P = 136;
__device__ __forceinline__ void conv4_silu(const v4u (&rows)[7], const float* cw, int ldw, const float* cb, float (&out)[4][8]) {
    float wv[4][8], bv[8];
#pragma unroll
    for (int j = 0; j < 4; ++j) { const f32x4 w0 = *(const GAS f32x4*)(cw + (size_t)j * ldw), w1 = *(const GAS f32x4*)(cw + (size_t)j * ldw + 4);
#pragma unroll
        for (int i = 0; i < 4; ++i) { wv[j][i] = w0[i]; wv[j][4 + i] = w1[i]; } }
    { const f32x4 b0 = *(const GAS f32x4*)cb, b1 = *(const GAS f32x4*)(cb + 4);
#pragma unroll
      for (int i = 0; i < 4; ++i) { bv[i] = b0[i]; bv[4 + i] = b1[i]; } }
#pragma unroll
    for (int tt = 0; tt < 4; ++tt)
#pragma unroll
        for (int i2 = 0; i2 < 4; ++i2) { float y0 = bv[2 * i2], y1 = bv[2 * i2 + 1];
#pragma unroll
            for (int j = 0; j < 4; ++j) { y0 += wv[j][2 * i2] * bflo(rows[tt + j][i2]); y1 += wv[j][2 * i2 + 1] * bfhi(rows[tt + j][i2]); }
            out[tt][2 * i2] = fsilu(y0); out[tt][2 * i2 + 1] = fsilu(y1); }
}
__device__ __forceinline__ void od_dt_cols(const Frame& F, const bf16* X, const bf16* Wt, const float* ssq, bf16* Y1) {
    typedef float f32x16_t __attribute__((ext_vector_type(16)));
    int t_ = threadIdx.x; asm volatile("" : "+v"(t_));
    const int wave = __builtin_amdgcn_readfirstlane(t_ >> 6), lane = t_ & 63;
    const int r32 = lane & 31, hi = lane >> 5, kq = wave & 3;
    LAS float* red = (LAS float*)F.lds;
    for (int t0 = F.bid * 2; t0 < M / 32; t0 += F.G * 2) { const int r0 = (t0 + (wave >> 2)) * 32;
        const bf16* xa = X + (size_t)(r0 + r32) * D + 256 * kq + 8 * hi; const bf16* wb = Wt + (size_t)(5120 + r32) * D + 256 * kq + 8 * hi;
        f32x16_t acc;
#pragma unroll
        for (int r = 0; r < 16; ++r) acc[r] = 0.f;
        pg8::bf16x8 av[16], bv[16];
#pragma unroll
        for (int u = 0; u < 16; ++u) { av[u] = *(const GAS pg8::bf16x8*)(xa + 16 * u); bv[u] = *(const GAS pg8::bf16x8*)(wb + 16 * u); }
#pragma unroll
        for (int u = 0; u < 16; ++u) acc = __builtin_amdgcn_mfma_f32_32x32x16_bf16(av[u], bv[u], acc, 0, 0, 0);
        if (kq != 0) {
#pragma unroll
            for (int r = 0; r < 16; ++r) red[(wave * 16 + r) * 64 + lane] = acc[r]; }
        __syncthreads();
        if (kq == 0) { const float rs_l = pg8::row_rstd(ssq, r0 + r32);
#pragma unroll
            for (int r = 0; r < 16; ++r) { const int row = (r & 3) + 8 * (r >> 2) + 4 * hi; const float rs = __shfl(rs_l, row);
                const float v = (acc[r] + red[((wave + 1) * 16 + r) * 64 + lane]) + (red[((wave + 2) * 16 + r) * 64 + lane] + red[((wave + 3) * 16 + r) * 64 + lane]);
                Y1[(size_t)(r0 + row) * OD_INP + 5120 + r32] = (bf16)f2bf(v * rs); } }
        __syncthreads();
    }
}
__device__ __forceinline__ void phase_mamba_prep(const Frame& F, const Args& a) {
    LAS bf16* T = (LAS bf16*)F.lds;
    LAS float* acsS = (LAS float*)(F.lds + 128 * MB_P * 2); LAS float* dtS = acsS + 256;
    const int tid = F.tid, lane = F.lane, w = F.wave, sg = tid >> 4, cv = tid & 15;
    const float* cw = a.in[I_ODCW]; const float* cb = a.in[I_ODCB];
    v4u rows[7];
#define M0_LOAD(u_) do { const int bc_ = (u_) / 24, sl_ = (u_) % 24, T0_ = (bc_ & 63) * 128; const bf16* Y1_ = (const bf16*)(F.ws + WS_Y1) + (size_t)(bc_ >> 6) * SEQ * OD_INP; \
        _Pragma("unroll") for (int i = 0; i < 7; ++i) { const int t = T0_ + 4 * sg - 3 + i; rows[i] = (t >= 0) ? *(const GAS v4u*)(Y1_ + (size_t)t * OD_INP + 2048 + sl_ * 128 + cv * 8) : (v4u){0u, 0u, 0u, 0u}; } } while (0)
    if (F.bid < 128 * 24) M0_LOAD(F.bid);
    for (int u = F.bid; u < 128 * 24; u += F.G) { const int bc = u / 24, sl = u % 24, b = bc >> 6, c = bc & 63, T0 = c * 128;
        const bf16* Y1 = (const bf16*)(F.ws + WS_Y1) + (size_t)b * SEQ * OD_INP; const int ch0 = sl * 128;
        { float vals[4][8];
          conv4_silu(rows, cw + ch0 + cv * 8, 3072, cb + ch0 + cv * 8, vals);
          if (u + F.G < 128 * 24) M0_LOAD(u + F.G);
#pragma unroll
          for (int tt = 0; tt < 4; ++tt) { v4u o; o.x = cvtpk(vals[tt][0], vals[tt][1]); o.y = cvtpk(vals[tt][2], vals[tt][3]); o.z = cvtpk(vals[tt][4], vals[tt][5]); o.w = cvtpk(vals[tt][6], vals[tt][7]);
              *(LAS v4u*)(T + (4 * sg + tt) * MB_P + cv * 8) = o; } }
        if (sl < 16 && w < 2) { const int h = 2 * sl + w;
            const float Ah = -__expf(a.in[I_ALOG][h]), dtb = a.in[I_DTB][h];
            const float d0 = fsoftplus(bf2f(Y1[(size_t)(T0 + 2 * lane) * OD_INP + 5120 + h]) + dtb), d1 = fsoftplus(bf2f(Y1[(size_t)(T0 + 2 * lane + 1) * OD_INP + 5120 + h]) + dtb);
            const float a0 = d0 * Ah, a1 = d1 * Ah; float pr = a0 + a1;
#pragma unroll
            for (int off = 1; off < 64; off <<= 1) { const float t = __shfl_up(pr, off); if (lane >= off) pr += t; }
            const float ex = pr - (a0 + a1); const float c0 = ex + a0, c1 = ex + a0 + a1;
            acsS[w * 128 + 2 * lane] = c0; acsS[w * 128 + 2 * lane + 1] = c1; dtS[w * 128 + 2 * lane] = d0; dtS[w * 128 + 2 * lane + 1] = d1;
            float* ACS = (float*)(F.ws + WS_M_ACS) + ((size_t)bc * 32 + h) * 128; float* DTV = (float*)(F.ws + WS_M_DTV) + ((size_t)bc * 32 + h) * 128;
            typedef float f32x2v __attribute__((ext_vector_type(2))); *(GAS f32x2v*)(ACS + 2 * lane) = (f32x2v){c0, c1}; *(GAS f32x2v*)(DTV + 2 * lane) = (f32x2v){d0, d1}; }
        __syncthreads();
        if (sl < 16) {
            const int cc = tid >> 2, s0 = (tid & 3) * 32, hh = cc >> 6; bf16* XT = (bf16*)(F.ws + WS_M_XT) + (((size_t)bc * 32 + 2 * sl) * 64 + cc) * 128 + s0;
#pragma unroll
            for (int k8 = 0; k8 < 4; ++k8) { float v[8];
#pragma unroll
                for (int k = 0; k < 8; ++k) { const int s = s0 + 8 * k8 + k; v[k] = bf2f(T[s * MB_P + cc]) * dtS[hh * 128 + s]; }
                v4u o; o.x = cvtpk(v[0], v[1]); o.y = cvtpk(v[2], v[3]); o.z = cvtpk(v[4], v[5]); o.w = cvtpk(v[6], v[7]); *(GAS v4u*)(XT + 8 * k8) = o; } }
        else { const int g = (sl - 16) & 3; const bool isB = sl < 20;
            bf16* N = (bf16*)(F.ws + (isB ? WS_M_BN : WS_M_CN)) + ((size_t)b * SEQ + T0) * 512 + g * 128;
            for (int i = tid; i < 128 * 16; i += NTHR) { const int s = i >> 4, c8 = i & 15; *(GAS v4u*)(N + (size_t)s * 512 + c8 * 8) = *(const LAS v4u*)(T + s * MB_P + c8 * 8); }
            if (isB) { const int cc = tid >> 2, s0 = (tid & 3) * 32; bf16* BT = (bf16*)(F.ws + WS_M_BT) + (((size_t)bc * 4 + g) * 128 + cc) * 128 + s0;
#pragma unroll
                for (int k8 = 0; k8 < 4; ++k8) { unsigned short v[8];
#pragma unroll
                    for (int k = 0; k < 8; ++k) v[k] = T[(s0 + 8 * k8 + k) * MB_P + cc];
                    v4u o; o.x = v[0] | ((unsigned)v[1] << 16); o.y = v[2] | ((unsigned)v[3] << 16); o.z = v[4] | ((unsigned)v[5] << 16); o.w = v[6] | ((unsigned)v[7] << 16); *(GAS v4u*)(BT + 8 * k8) = o; } } }
        __syncthreads();
    }
#undef M0_LOAD
}
__device__ __forceinline__ void phase_mamba_states(const Frame& F) {
    LAS bf16* BTs = (LAS bf16*)F.lds; LAS bf16* XW = (LAS bf16*)(F.lds + 128 * MB_P * 2); LAS bf16* STs = (LAS bf16*)(F.lds + 192 * MB_P * 2);
    const int tid = F.tid, lane = F.lane, w = F.wave, fr = lane & 15, fq = lane >> 4;
    for (int u = F.bid; u < 128 * 4; u += F.G) { const int bc = u >> 2, g = u & 3;
        const bf16* BT = (const bf16*)(F.ws + WS_M_BT) + ((size_t)bc * 4 + g) * 128 * 128;
        for (int i = tid; i < 128 * 16; i += NTHR) { const int n = i >> 4, c8 = i & 15; *(LAS v4u*)(BTs + n * MB_P + c8 * 8) = *(const GAS v4u*)(BT + (size_t)n * 128 + c8 * 8); }
#pragma unroll 1
        for (int hh = 0; hh < 8; ++hh) { const int h = g * 8 + hh;
            const bf16* XT = (const bf16*)(F.ws + WS_M_XT) + ((size_t)bc * 32 + h) * 64 * 128; const float* ACS = (const float*)(F.ws + WS_M_ACS) + ((size_t)bc * 32 + h) * 128;
            const float aL = ACS[127];
#pragma unroll
            for (int k = 0; k < 2; ++k) { const int i = tid + k * NTHR, p = i >> 4, c8 = i & 15; const v4u raw = *(const GAS v4u*)(XT + (size_t)p * 128 + c8 * 8);
                const f32x4 a0 = *(const GAS f32x4*)(ACS + c8 * 8), a1 = *(const GAS f32x4*)(ACS + c8 * 8 + 4);
                v4u o; o.x = cvtpk(bflo(raw[0]) * __expf(aL - a0[0]), bfhi(raw[0]) * __expf(aL - a0[1])); o.y = cvtpk(bflo(raw[1]) * __expf(aL - a0[2]), bfhi(raw[1]) * __expf(aL - a0[3]));
                o.z = cvtpk(bflo(raw[2]) * __expf(aL - a1[0]), bfhi(raw[2]) * __expf(aL - a1[1])); o.w = cvtpk(bflo(raw[3]) * __expf(aL - a1[2]), bfhi(raw[3]) * __expf(aL - a1[3]));
                *(LAS v4u*)(XW + p * MB_P + c8 * 8) = o; }
            __syncthreads();
            bf16* ST = (bf16*)(F.ws + WS_M_ST) + ((size_t)bc * 32 + h) * 64 * 128;
#pragma unroll
            for (int pt = 0; pt < 4; ++pt) { f32x4 acc = {0.f, 0.f, 0.f, 0.f}; acc = mma16(XW + pt * 16 * MB_P, MB_P, BTs + w * 16 * MB_P, MB_P, 128, acc, fr, fq);
#pragma unroll
                for (int e = 0; e < 4; ++e) STs[(pt * 16 + 4 * fq + e) * MB_P + w * 16 + fr] = (bf16)f2bf(acc[e]); }
            __syncthreads();
#pragma unroll
            for (int k = 0; k < 2; ++k) { const int i = tid + k * NTHR, pp = i >> 4, c8 = i & 15; *(GAS v4u*)(ST + (size_t)pp * 128 + c8 * 8) = *(const LAS v4u*)(STs + pp * MB_P + c8 * 8); }
        }
    }
}
__device__ __forceinline__ void phase_mamba_scan(const Frame& F) {
    const int gt = F.bid * NTHR + F.tid;
    const bf16* STg = (const bf16*)(F.ws + WS_M_ST); bf16* PVg = (bf16*)(F.ws + WS_M_PV); const float* ACSg = (const float*)(F.ws + WS_M_ACS);
    for (int i = gt; i < BATCH * 32 * 64 * 32; i += F.G * NTHR) { const int n4 = i & 31, p = (i >> 5) & 63, h = (i >> 11) & 31, b = i >> 16;
        f32x4 S = {0.f, 0.f, 0.f, 0.f};
        const size_t off0 = (((size_t)b * 64 * 32 + h) * 64 + p) * 128 + n4 * 4, cstep = (size_t)32 * 64 * 128;
        const float* al = ACSg + ((size_t)b * 64 * 32 + h) * 128 + 127;
#pragma unroll 1
        for (int c0 = 0; c0 < 64; c0 += 16) {
            v2u sr[16]; float dl[16];
#pragma unroll
            for (int j = 0; j < 16; ++j) { sr[j] = *(const GAS v2u*)(STg + off0 + (size_t)(c0 + j) * cstep); dl[j] = al[(size_t)(c0 + j) * 32 * 128]; }
#pragma unroll
            for (int j = 0; j < 16; ++j) { const float dec = __expf(dl[j]); const f32x4 st = {bflo(sr[j].x), bfhi(sr[j].x), bflo(sr[j].y), bfhi(sr[j].y)};
                v2u o; o.x = cvtpk(S[0], S[1]); o.y = cvtpk(S[2], S[3]); *(GAS v2u*)(PVg + off0 + (size_t)(c0 + j) * cstep) = o;
                S = S * dec + st; } } }
}
constexpr int M3_CS = 0, M3_BS = M3_CS + 128 * MB_P * 2, M3_MS = M3_BS + 128 * MB_P * 2, M3_XT = M3_MS + 128 * MB_P * 2, M3_PV = M3_XT + 64 * MB_P * 2, M3_ACS = M3_PV + 64 * MB_P * 2, M3_DT = M3_ACS + 512, M3_END = M3_DT + 512;
static_assert(M3_END <= SCR_BYTES, "mamba lds");
__device__ __forceinline__ void phase_mamba_out(const Frame& F, const Args& a) {
    LAS bf16* Cs = (LAS bf16*)(F.lds + M3_CS); LAS bf16* Bs = (LAS bf16*)(F.lds + M3_BS); LAS bf16* Ms = (LAS bf16*)(F.lds + M3_MS); LAS bf16* XTs = (LAS bf16*)(F.lds + M3_XT); LAS bf16* PVs = (LAS bf16*)(F.lds + M3_PV);
    LAS float* acs = (LAS float*)(F.lds + M3_ACS); LAS float* dtv = (LAS float*)(F.lds + M3_DT);
    const int tid = F.tid, lane = F.lane, w = F.wave, fr = lane & 15, fq = lane >> 4;
    for (int u = F.bid; u < 128 * 4; u += F.G) { const int bc = u >> 2, g = u & 3, b = bc >> 6, T0 = (bc & 63) * 128;
        const bf16* CN = (const bf16*)(F.ws + WS_M_CN) + ((size_t)b * SEQ + T0) * 512 + g * 128; const bf16* BN = (const bf16*)(F.ws + WS_M_BN) + ((size_t)b * SEQ + T0) * 512 + g * 128;
        for (int i = tid; i < 128 * 16; i += NTHR) { const int s = i >> 4, c8 = i & 15;
            *(LAS v4u*)(Cs + s * MB_P + c8 * 8) = *(const GAS v4u*)(CN + (size_t)s * 512 + c8 * 8); *(LAS v4u*)(Bs + s * MB_P + c8 * 8) = *(const GAS v4u*)(BN + (size_t)s * 512 + c8 * 8); }
        __syncthreads();
        f32x4 cbt[8];
#pragma unroll
        for (int st = 0; st < 8; ++st) { cbt[st] = (f32x4){0.f, 0.f, 0.f, 0.f}; if (st <= w) cbt[st] = mma16(Bs + st * 16 * MB_P, MB_P, Cs + w * 16 * MB_P, MB_P, 128, cbt[st], fr, fq); }
        const bf16* Y1 = (const bf16*)(F.ws + WS_Y1) + ((size_t)b * SEQ + T0) * OD_INP; bf16* YG = (bf16*)(F.ws + WS_YG) + ((size_t)b * SEQ + T0) * 2048;
        v4u pfx[2], pfp[2]; float pfa = 0.f, pfd = 0.f;
#define M3_PREFETCH(hh_) do { const int h_ = g * 8 + (hh_); const bf16* XT_ = (const bf16*)(F.ws + WS_M_XT) + ((size_t)bc * 32 + h_) * 64 * 128; const bf16* PV_ = (const bf16*)(F.ws + WS_M_PV) + ((size_t)bc * 32 + h_) * 64 * 128; \
            _Pragma("unroll") for (int k = 0; k < 2; ++k) { const int i = tid + k * NTHR, p = i >> 4, c8 = i & 15; pfx[k] = *(const GAS v4u*)(XT_ + (size_t)p * 128 + c8 * 8); pfp[k] = *(const GAS v4u*)(PV_ + (size_t)p * 128 + c8 * 8); } \
            if (tid < 128) { pfa = ((const float*)(F.ws + WS_M_ACS))[((size_t)bc * 32 + h_) * 128 + tid]; pfd = ((const float*)(F.ws + WS_M_DTV))[((size_t)bc * 32 + h_) * 128 + tid]; } } while (0)
        M3_PREFETCH(0);
#pragma unroll 1
        for (int hh = 0; hh < 8; ++hh) { const int h = g * 8 + hh; const float dsk = a.in[I_DSKIP][h];
#pragma unroll
            for (int k = 0; k < 2; ++k) { const int i = tid + k * NTHR, p = i >> 4, c8 = i & 15; *(LAS v4u*)(XTs + p * MB_P + c8 * 8) = pfx[k]; *(LAS v4u*)(PVs + p * MB_P + c8 * 8) = pfp[k]; }
            if (tid < 128) { acs[tid] = pfa; dtv[tid] = pfd; }
            __syncthreads();
            if (hh + 1 < 8) M3_PREFETCH(hh + 1);
            v4u zz[2];
#pragma unroll
            for (int k = 0; k < 2; ++k) zz[k] = *(const GAS v4u*)(Y1 + (size_t)(16 * w + fr) * OD_INP + h * 64 + 16 * fq + 8 * k);
            const float aq = acs[16 * w + fr];
#pragma unroll
            for (int st = 0; st < 8; ++st) { if (st <= w) { float mv[4];
#pragma unroll
                for (int e = 0; e < 4; ++e) { const int s = 16 * st + 4 * fq + e; mv[e] = (s <= 16 * w + fr) ? cbt[st][e] * __expf(aq - acs[s]) : 0.f; }
                v2u o; o.x = cvtpk(mv[0], mv[1]); o.y = cvtpk(mv[2], mv[3]); *(LAS v2u*)(Ms + (16 * w + fr) * MB_P + 16 * st + 4 * fq) = o; } }
            if ((w & 1) == 0) *(LAS v2u*)(Ms + (16 * w + fr) * MB_P + 16 * (w + 1) + 4 * fq) = (v2u){0u, 0u};
            LDS_WAIT();
            float yv[16]; { const int q = 16 * w + fr; const float eq = __expf(acs[q]), rdt = dsk * __builtin_amdgcn_rcpf(dtv[q]); const int prow = 16 * (fr >> 2) + (fr & 3);
#pragma unroll
            for (int pt = 0; pt < 4; ++pt) { f32x4 yd = {0.f, 0.f, 0.f, 0.f}, yo = {0.f, 0.f, 0.f, 0.f};
                yd = mma16r(XTs + (prow + 4 * pt) * MB_P, Ms + q * MB_P, ((w + 2) >> 1) * 32, yd, fq);
                yo = mma16r(PVs + (prow + 4 * pt) * MB_P, Cs + q * MB_P, 128, yo, fq);
#pragma unroll
                for (int e = 0; e < 4; ++e) { const int pp = 16 * fq + 4 * pt + e; yv[4 * pt + e] = yd[e] + eq * yo[e] + rdt * bf2f(XTs[pp * MB_P + q]); } } }
#pragma unroll
            for (int k = 0; k < 2; ++k) { v4u o;
#pragma unroll
                for (int j = 0; j < 4; ++j) o[j] = cvtpk(yv[8 * k + 2 * j] * fsilu(bflo(zz[k][j])), yv[8 * k + 2 * j + 1] * fsilu(bfhi(zz[k][j])));
                *(GAS v4u*)(YG + (size_t)(16 * w + fr) * 2048 + h * 64 + 16 * fq + 8 * k) = o; }
            __syncthreads();
        }
#undef M3_PREFETCH
        VM_WAIT(); __syncthreads();
        { const float* gn = a.in[I_ODNORM] + g * 512 + lane * 8; const f32x4 g0 = *(const GAS f32x4*)gn, g1 = *(const GAS f32x4*)(gn + 4);
#pragma unroll 4
          for (int t = 0; t < 16; ++t) { bf16* pq = YG + (size_t)(16 * w + t) * 2048 + g * 512 + lane * 8; const v4u raw = *(const GAS v4u*)pq; float ss = 0.f;
#pragma unroll
              for (int j = 0; j < 4; ++j) { const float x0 = bflo(raw[j]), x1 = bfhi(raw[j]); ss += x0 * x0 + x1 * x1; }
              const float rstd = 1.f / sqrtf(wave_sum(ss) * (1.f / 512.f) + EPS);
              v4u o; o.x = cvtpk(bflo(raw[0]) * rstd * g0[0], bfhi(raw[0]) * rstd * g0[1]); o.y = cvtpk(bflo(raw[1]) * rstd * g0[2], bfhi(raw[1]) * rstd * g0[3]);
              o.z = cvtpk(bflo(raw[2]) * rstd * g1[0], bfhi(raw[2]) * rstd * g1[1]); o.w = cvtpk(bflo(raw[3]) * rstd * g1[2], bfhi(raw[3]) * rstd * g1[3]);
              *(GAS v4u*)pq = o; } }
    }
}
__device__ __forceinline__ void phase_group_norm(const Frame& F, const Args& a) {
    const int gw = F.bid * NWAVES + F.wave, NGW = F.G * NWAVES; bf16* YG = (bf16*)(F.ws + WS_YG); const float* g = a.in[I_ODNORM];
    for (int m = gw; m < M; m += NGW) {
#pragma unroll
        for (int gi = 0; gi < 4; ++gi) { bf16* p = YG + (size_t)m * 2048 + gi * 512 + F.lane * 8; const v4u raw = *(const GAS v4u*)p; float ss = 0.f;
#pragma unroll
            for (int j = 0; j < 4; ++j) { const float x0 = bflo(raw[j]), x1 = bfhi(raw[j]); ss += x0 * x0 + x1 * x1; }
            const float rstd = 1.f / sqrtf(wave_sum(ss) * (1.f / 512.f) + EPS);
            const f32x4 g0 = *(const GAS f32x4*)(g + gi * 512 + F.lane * 8), g1 = *(const GAS f32x4*)(g + gi * 512 + F.lane * 8 + 4);
            v4u o; o.x = cvtpk(bflo(raw[0]) * rstd * g0[0], bfhi(raw[0]) * rstd * g0[1]); o.y = cvtpk(bflo(raw[1]) * rstd * g0[2], bfhi(raw[1]) * rstd * g0[3]);
            o.z = cvtpk(bflo(raw[2]) * rstd * g1[0], bfhi(raw[2]) * rstd * g1[1]); o.w = cvtpk(bflo(raw[3]) * rstd * g1[2], bfhi(raw[3]) * rstd * g1[3]);
            *(GAS v4u*)p = o; }
    }
}
constexpr int MOE_TAB = 131072;
static_assert(MOE_TAB + (32 + MOE_TILES + 24) * 4 <= SCR_BYTES, "moe lds");
__device__ __forceinline__ void phase_route(const Frame& F, const Args& a, const bf16* X) {
    LAS int* cntS = (LAS int*)F.lds;
    if (F.tid < 8) cntS[F.tid] = 0;
    __syncthreads();
    const float* g = a.in[I_NFFN] + D; const float* router = a.in[I_ROUTER]; unsigned char* XN8 = F.ws + WS_XN8;
    int* tokE = (int*)(F.ws + WS_MOEIDX); float* tokW = (float*)(F.ws + WS_MOEIDX + 1 * MiB);
    const int per = M / F.G;
    for (int i = F.wave; i < per; i += NWAVES) { const int m = F.bid * per + i;
        const GAS v4u* xr = (const GAS v4u*)(X + (size_t)m * D) + F.lane;
        float v[2][8]; float s = 0.f;
#pragma unroll
        for (int k = 0; k < 2; ++k) { const v4u r = xr[64 * k];
#pragma unroll
            for (int j = 0; j < 4; ++j) { v[k][2 * j] = bflo(r[j]); v[k][2 * j + 1] = bfhi(r[j]); s += v[k][2 * j] * v[k][2 * j] + v[k][2 * j + 1] * v[k][2 * j + 1]; } }
        const float rstd = 1.f / sqrtf(wave_sum(s) * (1.f / D) + EPS);
        float lg[8];
#pragma unroll
        for (int e = 0; e < 8; ++e) lg[e] = 0.f;
#pragma unroll
        for (int k = 0; k < 2; ++k) { const int c0 = 512 * k + 8 * F.lane; const f32x4 g0 = *(const GAS f32x4*)(g + c0), g1 = *(const GAS f32x4*)(g + c0 + 4); float hn[8];
#pragma unroll
            for (int q = 0; q < 8; ++q) hn[q] = v[k][q] * rstd * (q < 4 ? g0[q & 3] : g1[q & 3]);
            v2u o; o.x = pk4_fp8(hn[0], hn[1], hn[2], hn[3]); o.y = pk4_fp8(hn[4], hn[5], hn[6], hn[7]);
            *(GAS v2u*)(XN8 + (size_t)m * D + c0) = o;
#pragma unroll
            for (int q = 0; q < 8; ++q) { const f32x4 r0 = *(const GAS f32x4*)(router + (size_t)(c0 + q) * 8), r1 = *(const GAS f32x4*)(router + (size_t)(c0 + q) * 8 + 4);
#pragma unroll
                for (int e = 0; e < 4; ++e) { lg[e] += hn[q] * r0[e]; lg[4 + e] += hn[q] * r1[e]; } } }
#pragma unroll
        for (int e = 0; e < 8; ++e) lg[e] = wave_sum(lg[e]);
        int e1 = 0; float v1 = lg[0];
#pragma unroll
        for (int e = 1; e < 8; ++e) if (lg[e] > v1) { v1 = lg[e]; e1 = e; }
        int e2 = (e1 + 1) & 7; float v2 = -3.0e38f;
#pragma unroll
        for (int e = 0; e < 8; ++e) if (e != e1 && lg[e] > v2) { v2 = lg[e]; e2 = e; }
        if (F.lane == 0) { const float w1 = 1.f / (1.f + __expf(v2 - v1)); tokE[2 * m] = e1; tokE[2 * m + 1] = e2; tokW[2 * m] = w1; tokW[2 * m + 1] = 1.f - w1;
            atomicAdd((int*)cntS + e1, 1); atomicAdd((int*)cntS + e2, 1); }
    }
    __syncthreads();
    if (F.tid < 8) ((int*)(F.ctl + CW_MOECNT))[F.bid * 8 + F.tid] = cntS[F.tid];
    __syncthreads();
}
__device__ __forceinline__ void moe_layout(const Frame& F) {
    LAS int* tab = (LAS int*)(F.lds + MOE_TAB); const int* cnt = (const int*)(F.ctl + CW_MOECNT);
    if (F.tid < 16) tab[F.tid < 8 ? F.tid : 32 + MOE_TILES + F.tid] = 0;
    __syncthreads();
    { const int e = F.tid & 7; int tot = 0, pre = 0;
      for (int wg = F.tid >> 3; wg < F.G; wg += NTHR / 8) { const int c = cnt[wg * 8 + e]; tot += c; if (wg < F.bid) pre += c; }
      atomicAdd((int*)tab + e, tot); atomicAdd((int*)tab + 32 + MOE_TILES + 8 + e, pre); }
    __syncthreads();
    if (F.tid == 0) { int row = 0, tl = 0; for (int e = 0; e < 8; ++e) { const int nt = (tab[e] + 255) >> 8; tab[8 + e] = row; tab[16 + e] = nt; for (int i = 0; i < nt; ++i) tab[32 + tl + i] = e; tl += nt; row += nt * 256; } tab[24] = tl; }
    __syncthreads();
}
__device__ __forceinline__ void phase_scatter(const Frame& F) {
    moe_layout(F);
    LAS int* tab = (LAS int*)(F.lds + MOE_TAB); LAS int* slotS = (LAS int*)F.lds;
    const int per = M / F.G;
    const int* tokE = (const int*)(F.ws + WS_MOEIDX); int* tokS = (int*)(F.ws + WS_MOEIDX + 2 * MiB);
    if (F.wave == 0) { const int E0 = tokE[(size_t)F.bid * per * 2 + F.lane], E1 = tokE[(size_t)F.bid * per * 2 + 64 + F.lane]; int s0 = 0, s1 = 0;
        const unsigned long long lt = (1ull << F.lane) - 1ull;
#pragma unroll
        for (int e = 0; e < 8; ++e) { const unsigned long long m0 = __ballot(E0 == e), m1 = __ballot(E1 == e); const int base = tab[8 + e] + tab[32 + MOE_TILES + 8 + e];
            if (E0 == e) s0 = base + __popcll(m0 & lt); if (E1 == e) s1 = base + __popcll(m0) + __popcll(m1 & lt); }
        slotS[F.lane] = s0; slotS[64 + F.lane] = s1; tokS[(size_t)F.bid * per * 2 + F.lane] = s0; tokS[(size_t)F.bid * per * 2 + 64 + F.lane] = s1; }
    __syncthreads();
    const unsigned char* XN8 = F.ws + WS_XN8; unsigned char* XP = F.ws + WS_XP;
    for (int i = F.wave; i < per * 2; i += NWAVES) { const int m = F.bid * per + (i >> 1); const int sl = slotS[i];
        ((GAS v4u*)(XP + (size_t)sl * D))[F.lane] = ((const GAS v4u*)(XN8 + (size_t)m * D))[F.lane]; }
    __syncthreads();
}
struct MoeOrder {
    int nN, nwg, G, c; const LAS int* texp;
    __device__ __forceinline__ bool next(int i, pg8::Unit& u) const { const long L = (long)i * G + c; if (L >= nwg) return false; u.pm = (int)(L / nN); u.pn = (int)(L % nN); u.bn = texp[u.pm] * nN + u.pn; u.idx = i; return true; }
    __device__ __forceinline__ void a_ready(const pg8::Unit&) const {}
    __device__ __forceinline__ void done(const pg8::Unit&) const {}
};
struct MoeOrderX {
    int nM, nN, nwg, G, c; const LAS int* texp;
    __device__ __forceinline__ bool next(int i, pg8::Unit& u) const { const long L = (long)i * G + c; if (L >= nwg) return false;
        int wgid = (int)L; { const int q = nwg / 8, r = nwg % 8, xcd = wgid % 8, off = wgid / 8; wgid = (xcd < r ? xcd * (q + 1) : r * (q + 1) + (xcd - r) * q) + off; }
        const int nig = 8 * nN, gid = wgid / nig, fm = gid * 8, gsz = (nM - fm) < 8 ? (nM - fm) : 8;
        u.pm = fm + ((wgid % nig) % gsz); u.pn = (wgid % nig) / gsz; u.bn = texp[u.pm] * nN + u.pn; u.idx = i; return true; }
    __device__ __forceinline__ void a_ready(const pg8::Unit&) const {}
    __device__ __forceinline__ void done(const pg8::Unit&) const {}
};
struct MoeTail { int R, Lo, pm_min; bool split; };
__device__ __forceinline__ MoeTail moe_tail(const LAS int* tab, int G) { MoeTail t; const int U = tab[24] * 4; t.R = U / G; t.Lo = U - t.R * G; t.split = (t.Lo > 0 && t.Lo <= 128 && t.R > 0); t.pm_min = t.split ? (t.R * G) / 4 : (1 << 30); return t; }
struct MoeTailOrder { int pm, pn, bn; bool has;
    __device__ __forceinline__ bool next(int i, pg8::Unit& u) const { if (i > 0 || !has) return false; u.pm = pm; u.pn = pn; u.bn = bn; u.idx = 0; return true; }
    __device__ __forceinline__ void a_ready(const pg8::Unit&) const {}
    __device__ __forceinline__ void done(const pg8::Unit&) const {} };
constexpr size_t MOE_PART_STRIDE = (size_t)32 * 256 * 1024;
__device__ __forceinline__ void phase_moe_combine(const Frame& F, const bf16* x, float* xo) {
    moe_layout(F); const MoeTail mt = moe_tail((const LAS int*)(F.lds + MOE_TAB), F.G); const int srow = mt.pm_min == (1 << 30) ? (1 << 30) : mt.pm_min * 256; const float* PART = (const float*)(F.ws + WS_XP);
    const int gw = F.bid * NWAVES + F.wave, NGW = F.G * NWAVES;
    const float* tokW = (const float*)(F.ws + WS_MOEIDX + 1 * MiB); const int* tokS = (const int*)(F.ws + WS_MOEIDX + 2 * MiB); const int* tokE = (const int*)(F.ws + WS_MOEIDX);
    const float* YP = (const float*)(F.ws + WS_YP);
    for (int m = gw; m < M; m += NGW) { const int s0 = tokS[2 * m], s1 = tokS[2 * m + 1]; const float w0 = tokW[2 * m] * (1.f / MOE_W2_SCALE), w1 = tokW[2 * m + 1] * (1.f / MOE_W2_SCALE)  ; const bool sw = tokE[2 * m] > tokE[2 * m + 1];
        const GAS v2u* xr = (const GAS v2u*)(x + (size_t)m * D) + F.lane; GAS f32x4* xw = (GAS f32x4*)(xo + (size_t)m * D) + F.lane; const GAS f32x4* y0 = (const GAS f32x4*)(YP + (size_t)s0 * D) + F.lane; const GAS f32x4* y1 = (const GAS f32x4*)(YP + (size_t)s1 * D) + F.lane;
#pragma unroll
        for (int j = 0; j < 4; ++j) { f32x4 v0, v1;
            if (s0 >= srow) { const GAS f32x4* q = (const GAS f32x4*)(PART + (size_t)(s0 - srow) * D) + F.lane + 64 * j; v0 = q[0] + q[MOE_PART_STRIDE / 4]; } else v0 = y0[64 * j];
            if (s1 >= srow) { const GAS f32x4* q = (const GAS f32x4*)(PART + (size_t)(s1 - srow) * D) + F.lane + 64 * j; v1 = q[0] + q[MOE_PART_STRIDE / 4]; } else v1 = y1[64 * j];
            const f32x4 a0 = v0 * w0, a1 = v1 * w1; const v2u xb = xr[64 * j]; const f32x4 xv = {bflo(xb.x), bfhi(xb.x), bflo(xb.y), bfhi(xb.y)}; xw[64 * j] = xv + (sw ? (a1 + a0) : (a0 + a1)); } }
}
#ifndef MK_PHMASK
#define MK_PHMASK 0xFFFFFFFFFFFFull
#endif
#ifndef MK_DUPMASK
#define MK_DUPMASK 0ull
#endif
#ifndef MK_SPLIT
#define MK_SPLIT 0
#endif
#ifndef MK_LAST_PHASE
#define MK_LAST_PHASE 29
#endif
constexpr int N_PHASES = 30;
#ifndef MK_LB
#define MK_LB 2
#endif
__global__ void __launch_bounds__(NTHR, MK_LB) mega_fwd(Args args) {
    extern __shared__ __attribute__((aligned(16))) unsigned char lds_raw[];
    Frame F;
    F.lds = (LAS unsigned char*)lds_raw; F.MISC = (volatile LAS unsigned*)(F.lds + MISC_OFF);
    F.tid = threadIdx.x; F.lane = F.tid & 63; F.wave = __builtin_amdgcn_readfirstlane(F.tid >> 6); F.G = gridDim.x; F.bid = blockIdx.x;
    F.ws = args.ws; F.ctl = (gu32*)(args.ws + WS_CTL);
    for (int u = F.tid; u < (LDS_BYTES - MISC_OFF) / 4; u += NTHR) ((LAS unsigned*)(F.lds + MISC_OFF))[u] = 0u;
    __syncthreads();
    XcdBarrier bar; bar.bar = (unsigned*)(F.ctl + CW_BAR); bar.x = 0; bar.st = nullptr;
    if (!MK_SPLIT) bar = xcd_barrier_post((unsigned*)(F.ctl + CW_BAR), F.MISC + 8);
    const int lo = args.ph_lo, hi = args.ph_hi;
#define PF() Frame Fp = F; { int t_ = threadIdx.x; asm volatile("" : "+v"(t_)); Fp.tid = t_; Fp.lane = t_ & 63; int w_ = F.wave, b_ = F.bid; asm volatile("" : "+s"(w_), "+s"(b_)); Fp.wave = w_; Fp.bid = b_; }
#define IN(k) ((((unsigned long long)MK_PHMASK >> (k)) & 1ull) && lo <= (k) && (k) < hi)
#define DUP(k) ((((unsigned long long)MK_DUPMASK >> (k)) & 1ull) ? 2 : 1)
#define SEAM(k) do { if (!MK_SPLIT && IN((k) + 1)) xcd_barrier(bar); } while (0)
    unsigned char* ws = args.ws; float* out = args.out;
    const int gw = F.bid * NWAVES + F.wave, NGW = F.G * NWAVES;
    LAS unsigned char* glds = F.lds;
    bf16* XN = (bf16*)(ws + WS_XN);

    if (IN(0)) { PF();
#pragma unroll 1
        for (int rep = 0; rep < DUP(0); ++rep) p0_prologue(Fp, args);
        SEAM(0); }
    if (IN(1)) {
        PF();
#pragma unroll 1
        for (int rep = 0; rep < DUP(1); ++rep) {
        if (F.bid == 0) { float* part = (float*)(ws + WS_CMPB_PART); float s = 0.f; for (int ic = 0; ic < 64; ++ic) s += part[(size_t)((Fp.tid >> 8) * 64 + ic) * 256 + (Fp.tid & 255)]; ((float*)(ws + WS_CMPB))[Fp.tid] = s; }
        { pg8::Gemm g{XN, (const bf16*)(ws + WS_W_EVIN), M, EV_INP, D, D, D}; pg8::StaticOrder S; S.init(M, EV_INP, F.G, F.bid);
          pg8::EpiEvIn E{(bf16*)(ws + WS_Y0), EV_INP, (bf16*)(ws + WS_KV6), SEQ};
          pg8::gemm_phase<pg8::EpiEvIn, pg8::StaticOrder, PG8_ALIGN, PG8_SP2>(glds, g, S, E); }
#pragma unroll 1
        for (int l = 0; l < 2; ++l) { pg8::Gemm g{(const bf16*)(ws + WS_MEMN) + (size_t)l * MMEM * D, (const bf16*)(ws + WS_W_XKV) + (size_t)l * 1024 * D, MMEM, 1024, D, D, D};
          pg8::ListOrder S; S.init(2, 4, 8, F.bid - 192 - 8 * l);
          pg8::EpiBf16<0> E{(bf16*)(ws + WS_KVM) + (size_t)l * MMEM * 1024, 1024, nullptr, nullptr};
          pg8::gemm_phase<pg8::EpiBf16<0>, pg8::ListOrder, PG8_ALIGN, PG8_SP2>(glds, g, S, E); }
        }
        SEAM(1);
    }
    if (IN(2)) {
        PF();
#pragma unroll 1
        for (int rep = 0; rep < DUP(2); ++rep) {
        if (F.bid < 128) { rglru_unit(Fp, args, F.bid >> 6, (F.bid >> 3) & 7, F.bid & 7);
        }
        else if (F.bid < 144) { const int mm = (F.bid - 128) >> 3;
            pg8::Gemm g{(const bf16*)(ws + WS_KV6) + (size_t)mm * 4 * SEQ * 128, (const bf16*)(ws + (mm ? WS_W_CV1 : WS_W_CK1)), 2048, 256, 4096, 2048, 4096};
            pg8::ListOrder S; S.init(8, 1, 8, (F.bid - 128) & 7);
            pg8::EpiBf16<1> E{(bf16*)(ws + WS_HID) + (size_t)mm * 2048 * 256, 256, (const float*)(ws + WS_CMPB) + mm * 256, nullptr};
            pg8::gemm_phase<pg8::EpiBf16<1>, pg8::ListOrder, PG8_ALIGN, PG8_SP2>(glds, g, S, E);
#ifdef MK_DUP_CMP1
            pg8::gemm_phase<pg8::EpiBf16<1>, pg8::ListOrder, PG8_ALIGN, PG8_SP2>(glds, g, S, E);
#endif
            VM_WAIT(); __syncthreads(); { const int u0 = mm * 64 + ((F.bid - 128) & 7) * 8; phase_cmp2(Fp, args, u0, u0 + 8, 1); }
        }
        else if (rep == 0) { const int gw2 = (F.bid - 144) * NWAVES + F.wave, NGW2 = (F.G - 144) * NWAVES;
            bf16* ks = (bf16*)(ws + WS_KV6) + (size_t)2 * 4 * SEQ * 128; bf16* kw = (bf16*)(ws + WS_KV6) + (size_t)4 * 4 * SEQ * 128;
            norm128_rows(Fp, ks, 128, ks, 128, 4 * SEQ, args.in[I_KNORM] + 128, gw2, NGW2);
            norm128_rows(Fp, kw, 128, kw, 128, 4 * SEQ, args.in[I_KNORM] + 256, gw2, NGW2);
            phase_memk_norm(Fp, args, 0, gw2, NGW2); phase_memk_norm(Fp, args, 1, gw2, NGW2); convert_range(Fp, args, gw2, NGW2, CONV_A, CONV_P2_END);
#ifdef MK_DUP_P2CONV
            convert_range(Fp, args, gw2, NGW2, CONV_A + (CONV_P2_END - CONV_A) / 2, CONV_P2_END);
#endif
        }
        }
        SEAM(2);
    }
    if (IN(4)) { PF();
#pragma unroll 1
        for (int rep = 0; rep < DUP(4); ++rep) phase_nsa(Fp, args);
        SEAM(4); }
    if (IN(5)) {
        pg8::Gemm g{(const bf16*)(ws + WS_MIX), (const bf16*)(ws + WS_W_EVOUT), M, D, 2048, 2048, 2048}; pg8::StaticOrder S; S.init(M, D, F.G, F.bid);
#pragma unroll 1
        for (int rep = 0; rep < DUP(5); ++rep) { pg8::EpiResidB<true> E{args.in[I_X], (rep + 1 < DUP(5)) ? (bf16*)(ws + WS_R + 400 * MiB) : XN, D, (float*)(ws + WS_SSQ)};
        pg8::gemm_phase<pg8::EpiResidB<true>, pg8::StaticOrder, PG8_ALIGN, PG8_SP2>(glds, g, S, E); }
        SEAM(5);
#ifdef MK_PROBE_BARS
#pragma unroll 1
        for (int xb = 0; xb < MK_PROBE_BARS; ++xb) xcd_barrier(bar);
#endif
    }
#pragma unroll 1
    for (int l = 0; l < 2; ++l) {
        const int pb = l == 0 ? 6 : 21;
        if (IN(pb + 1)) { pg8::Gemm g{XN, (const bf16*)(ws + WS_W_XQ) + (size_t)l * 512 * D, M, 512, D, D, D}; pg8::StaticOrder S; S.init(M, 512, F.G, F.bid);
            pg8::fill_rstd_table((LAS float*)(F.lds + MOE_TAB), S, (const float*)(ws + WS_SSQ), F.tid);
            pg8::EpiBf16<0> E{(bf16*)(ws + WS_QX), 512, nullptr, (const LAS float*)(F.lds + MOE_TAB)};
#pragma unroll 1
            for (int rep = 0; rep < DUP(7); ++rep) pg8::gemm_phase<pg8::EpiBf16<0>, pg8::StaticOrder, PG8_ALIGN, PG8_SP2>(glds, g, S, E);
            if (F.bid >= 128) { PF(); const int lo_ = CONV_ALL - (2 - l) * CONV_Q;
                convert_range(Fp, args, (F.bid - 128) * NWAVES + F.wave, (F.G - 128) * NWAVES, lo_, lo_ + CONV_Q); }
            SEAM(pb + 1); }
        if (IN(pb + 2)) { PF();
#pragma unroll 1
            for (int rep = 0; rep < DUP(8); ++rep) phase_cross_attn(Fp, args, l);
            SEAM(pb + 2); }
        if (IN(pb + 3)) { pg8::Gemm g{(const bf16*)(ws + WS_OX), (const bf16*)(ws + WS_W_XO) + (size_t)l * D * 512, M, D, 512, 512, 512}; pg8::StaticOrder S; S.init(M, D, F.G, F.bid);
#pragma unroll 1
            for (int rep = 0; rep < DUP(9); ++rep) { pg8::EpiResidB<false> E{XN, (rep + 1 < DUP(9)) ? (bf16*)(ws + WS_R + 400 * MiB) : XN, D, (float*)(ws + WS_SSQ)};
            pg8::gemm_phase<pg8::EpiResidB<false>, pg8::StaticOrder, PG8_ALIGN, PG8_SP2>(glds, g, S, E); }
            SEAM(pb + 3); }
        if (l == 0) {
            if (IN(11)) { pg8::Gemm g{XN, (const bf16*)(ws + WS_W_FF13), M, 2 * FF, D, D, D}; pg8::StaticOrder S; S.init(M, 2 * FF, F.G, F.bid);
                pg8::fill_rstd_table((LAS float*)(F.lds + MOE_TAB), S, (const float*)(ws + WS_SSQ), F.tid);
                pg8::EpiSwiglu<false> E{(bf16*)(ws + WS_H), FF, (const LAS float*)(F.lds + MOE_TAB)};
#ifdef MK_PROBE_NULLEPI
                { pg8::EpiNull EN; pg8::gemm_phase<pg8::EpiNull, pg8::StaticOrder, PG8_ALIGN, PG8_SP2>(glds, g, S, EN); }
#endif
#pragma unroll 1
                for (int rep = 0; rep < DUP(11); ++rep) pg8::gemm_phase<pg8::EpiSwiglu<false>, pg8::StaticOrder, PG8_ALIGN, PG8_SP2>(glds, g, S, E);
                SEAM(11); }
            if (IN(12)) { pg8::Gemm g{(const bf16*)(ws + WS_H), (const bf16*)(ws + WS_W_FF2), M, D, FF, FF, FF}; pg8::StaticOrder S; S.init(M, D, F.G, F.bid);
#pragma unroll 1
                for (int rep = 0; rep < DUP(12); ++rep) { pg8::EpiResidB<false> E{XN, (rep + 1 < DUP(12)) ? (bf16*)(ws + WS_R + 400 * MiB) : XN, D, (float*)(ws + WS_SSQ)};
                pg8::gemm_phase<pg8::EpiResidB<false>, pg8::StaticOrder, PG8_ALIGN, PG8_SP2>(glds, g, S, E); }
                SEAM(12); }
            if (IN(14)) { pg8::Gemm g{XN, (const bf16*)(ws + WS_W_ODIN), M, 5120, D, D, D}; pg8::StaticOrder S; S.init(M, 5120, F.G, F.bid);
                pg8::fill_rstd_table((LAS float*)(F.lds + MOE_TAB), S, (const float*)(ws + WS_SSQ), F.tid);
                pg8::EpiBf16<0> E{(bf16*)(ws + WS_Y1), OD_INP, nullptr, (const LAS float*)(F.lds + MOE_TAB)};
#pragma unroll 1
                for (int rep = 0; rep < DUP(14); ++rep) pg8::gemm_phase<pg8::EpiBf16<0>, pg8::StaticOrder, PG8_ALIGN, PG8_SP2>(glds, g, S, E);
                od_dt_cols(F, XN, (const bf16*)(ws + WS_W_ODIN), (const float*)(ws + WS_SSQ), (bf16*)(ws + WS_Y1));
                SEAM(14); }
            if (IN(15)) { PF();
#pragma unroll 1
                for (int rep = 0; rep < DUP(15); ++rep) phase_mamba_prep(Fp, args);
                SEAM(15); }
            if (IN(16)) { PF();
#pragma unroll 1
                for (int rep = 0; rep < DUP(16); ++rep) phase_mamba_states(Fp);
                SEAM(16); }
            if (IN(17)) { PF();
#pragma unroll 1
                for (int rep = 0; rep < DUP(17); ++rep) phase_mamba_scan(Fp);
                SEAM(17); }
            if (IN(18)) { PF();
#pragma unroll 1
                for (int rep = 0; rep < DUP(18); ++rep) phase_mamba_out(Fp, args);
                SEAM(18); }
            if (IN(20)) { pg8::Gemm g{(const bf16*)(ws + WS_YG), (const bf16*)(ws + WS_W_ODOUT), M, D, 2048, 2048, 2048}; pg8::StaticOrder S; S.init(M, D, F.G, F.bid);
#pragma unroll 1
                for (int rep = 0; rep < DUP(20); ++rep) { pg8::EpiResidB<false> E{XN, (rep + 1 < DUP(20)) ? (bf16*)(ws + WS_R + 400 * MiB) : XN, D, (float*)(ws + WS_SSQ)};
                pg8::gemm_phase<pg8::EpiResidB<false>, pg8::StaticOrder, PG8_ALIGN, PG8_SP2>(glds, g, S, E); }
                SEAM(20); }
        }
    }
    if (IN(25)) { PF();
#pragma unroll 1
        for (int rep = 0; rep < DUP(25); ++rep) phase_route(Fp, args, XN);
        SEAM(25); }
    if (IN(26)) { PF();
#pragma unroll 1
        for (int rep = 0; rep < DUP(26); ++rep) phase_scatter(Fp);
        SEAM(26); }
    if (IN(27)) { PF(); moe_layout(Fp); const LAS int* tab = (const LAS int*)(F.lds + MOE_TAB);
        pg8::Gemm g{(const bf16*)(ws + WS_XP), (const bf16*)(ws + WS_W_M13), MOE_ROWS, 2 * FFE, D / 2, D / 2, D / 2}  ; MoeOrderX S{tab[24], 2 * FFE / 256, tab[24] * (2 * FFE / 256), F.G, F.bid, tab + 32};
        pg8::EpiSwiglu<true, false, true> E{(bf16*)(ws + WS_HP), FFE, nullptr, 1.f / MOE_W13_SCALE};
#pragma unroll 1
        for (int rep = 0; rep < DUP(27); ++rep) pg8::gemm_phase<pg8::EpiSwiglu<true, false, true>, MoeOrderX, PG8_ALIGN, PG8_SP2, true>(glds, g, S, E);
        SEAM(27); }
    if (IN(28)) { PF(); moe_layout(Fp); const LAS int* tab = (const LAS int*)(F.lds + MOE_TAB);
        const MoeTail mt = moe_tail(tab, F.G);
        pg8::Gemm g{(const bf16*)(ws + WS_HP), (const bf16*)(ws + WS_W_M2), MOE_ROWS, D, FFE / 2, FFE / 2, FFE / 2}  ; MoeOrder S{D / 256, mt.split ? mt.R * F.G : tab[24] * (D / 256), F.G, F.bid, tab + 32};
        pg8::EpiF32 E{(float*)(ws + WS_YP), D};
#pragma unroll 1
        for (int rep = 0; rep < DUP(28); ++rep) pg8::gemm_phase<pg8::EpiF32, MoeOrder, PG8_ALIGN, PG8_SP2, true>(glds, g, S, E);
        if (mt.split) {
            const int piece = F.bid, L = mt.R * F.G + (piece >> 1), kq = piece & 1, pm = L / 4, pn = L % 4;
            MoeTailOrder S2{pm, pn, piece < mt.Lo * 2 ? tab[32 + pm] * 4 + pn : 0, piece < mt.Lo * 2};
            pg8::Gemm g2{(const bf16*)(ws + WS_HP) + kq * (FFE / 4), (const bf16*)(ws + WS_W_M2) + kq * (FFE / 4), MOE_ROWS, D, FFE / 4, FFE / 2, FFE / 2};
            pg8::EpiF32 E2{(float*)(ws + WS_XP) + (size_t)kq * MOE_PART_STRIDE - (size_t)mt.pm_min * 256 * D, D};
            pg8::gemm_phase<pg8::EpiF32, MoeTailOrder, PG8_ALIGN, PG8_SP2, true>(glds, g2, S2, E2); }
        SEAM(28); }
    if (IN(29)) { PF();
#pragma unroll 1
        for (int rep = 0; rep < DUP(29); ++rep) phase_moe_combine(Fp, XN, (rep + 1 < DUP(29)) ? (float*)(ws + WS_H) : out); }
#undef IN
#undef SEAM
}

extern "C" void kernel_launch(void* const* d_in, const int* in_sizes, int n_in, void* d_out, int out_size, void* d_ws, size_t ws_size, hipStream_t stream) {
    static int grid = 0;
    if (grid == 0) {
        if (n_in != N_IN || in_sizes[0] != M * D || out_size != M * D || ws_size < (WS_M_END > WS_END ? WS_M_END : WS_END)) { fprintf(stderr, "kernel_launch: unexpected problem (n_in %d, in0 %d, out %d, ws %zu < %zu); nothing launched\n", n_in, n_in > 0 ? in_sizes[0] : -1, out_size, ws_size, (size_t)WS_END); grid = -1; return; }
        int dev = 0, cus = 0, per_cu = 0;
        if (hipGetDevice(&dev) != hipSuccess || hipDeviceGetAttribute(&cus, hipDeviceAttributeMultiprocessorCount, dev) != hipSuccess) { fprintf(stderr, "kernel_launch: device query failed\n"); grid = -1; return; }
        if (hipFuncSetAttribute((const void*)mega_fwd, hipFuncAttributeMaxDynamicSharedMemorySize, LDS_BYTES) != hipSuccess) { fprintf(stderr, "kernel_launch: hipFuncSetAttribute(%d B LDS) failed\n", LDS_BYTES); grid = -1; return; }
        if (hipOccupancyMaxActiveBlocksPerMultiprocessor(&per_cu, (const void*)mega_fwd, NTHR, LDS_BYTES) != hipSuccess || per_cu < 1) fprintf(stderr, "kernel_launch: note: occupancy query reports %d workgroups per CU\n", per_cu);
        (void)hipGetLastError();
        if (cus < 256) { fprintf(stderr, "kernel_launch: %d CUs < 256: the persistent grid of 256 workgroups would not be resident; nothing launched\n", cus); grid = -1; return; }
        grid = 256;
    }
    if (grid < 0) return;
    if (hipMemsetAsync((char*)d_ws + WS_CTL, 0, CTL_ZERO_BYTES, stream) != hipSuccess) { fprintf(stderr, "kernel_launch: memset failed\n"); return; }
    Args a{};
    for (int i = 0; i < N_IN; ++i) a.in[i] = (const float*)d_in[i];
    a.out = (float*)d_out; a.ws = (unsigned char*)d_ws;
#if MK_SPLIT
    for (int p = 0; p <= MK_LAST_PHASE && p < N_PHASES; ++p) { a.ph_lo = p; a.ph_hi = p + 1; a.li = p; hipLaunchKernelGGL(mega_fwd, dim3(grid), dim3(NTHR), LDS_BYTES, stream, a); }
#else
    a.ph_lo = 0; a.ph_hi = MK_LAST_PHASE + 1; a.li = 0;
    hipLaunchKernelGGL(mega_fwd, dim3(grid), dim3(NTHR), LDS_BYTES, stream, a);
#endif
    const hipError_t le = hipPeekAtLastError();
    if (le != hipSuccess) fprintf(stderr, "kernel_launch: launch failed: %s\n", hipGetErrorName(le));
}
```

```cpp
#include <hip/hip_runtime.h>
#include <cstdio>
#include <cstdint>

namespace pg8 {
#define PG8_LAS __attribute__((address_space(3)))
typedef unsigned short bf16_t;
typedef short bf16x8 __attribute__((ext_vector_type(8)));
typedef float f32x4 __attribute__((ext_vector_type(4)));
typedef unsigned u32x4 __attribute__((ext_vector_type(4)));
typedef unsigned u32x2 __attribute__((ext_vector_type(2)));
constexpr int BM = 256, BK = 64, HALF = 128, HTB = HALF * BK * 2  , STAGE_BYTES = 8 * HTB, NXCD = 8, WGM = 8;

__host__ __device__ __forceinline__ int lds_byte(int r, int c) { const int st = (r >> 4) * 2 + (c >> 5), rr = r & 15, cc = c & 31, ob = rr * 64 + cc * 2; return st * 1024 + (ob ^ (((ob >> 9) & 1) << 5)); }
__host__ __device__ __forceinline__ void stage_rc(int b, int& R, int& C) { const int st = b / 1024, sb = b % 1024, swz = sb ^ (((sb >> 9) & 1) << 5); R = (st >> 1) * 16 + swz / 64; C = (st & 1) * 32 + (swz % 64) / 2; }
__host__ __device__ __forceinline__ int perm32(int rho) { const int n = rho >> 4, i = rho & 15; return 8 * (i >> 2) + 4 * n + (i & 3); }

typedef int i32x8 __attribute__((ext_vector_type(8)));
typedef int i32x4 __attribute__((ext_vector_type(4)));
__device__ __forceinline__ i32x8 cat8(bf16x8 lo, bf16x8 hi) { const i32x4 a = __builtin_bit_cast(i32x4, lo), b = __builtin_bit_cast(i32x4, hi); return __builtin_shufflevector(a, b, 0, 1, 2, 3, 4, 5, 6, 7); }
__device__ __forceinline__ void mfma_f8_inplace(f32x4& acc, i32x8 a, i32x8 b) { asm volatile("v_mfma_f32_16x16x128_f8f6f4 %0, %1, %2, %0" : "+v"(acc) : "v"(a), "v"(b)); }
struct Unit { int pm, pn, bn, idx; };
struct Gemm { const bf16_t* A; const bf16_t* Bt; int M, N, K, lda, ldb; };

struct StaticOrder {
    int nM, nN, nwg, G, c;
    __host__ __device__ void init(int M, int N, int G_, int c_) { nM = M / BM; nN = N / BM; nwg = nM * nN; G = G_; c = c_; }
    __host__ __device__ bool next(int i, Unit& u) const {
        const long L = (long)i * G + c; if (L >= nwg) return false;
        int wgid = (int)L; { const int q = nwg / NXCD, r = nwg % NXCD, xcd = wgid % NXCD, off = wgid / NXCD; wgid = (xcd < r ? xcd * (q + 1) : r * (q + 1) + (xcd - r) * q) + off; }
        const int nig = WGM * nN, gid = wgid / nig, fm = gid * WGM, gsz = (nM - fm) < WGM ? (nM - fm) : WGM;
        u.pm = fm + ((wgid % nig) % gsz); u.pn = (wgid % nig) / gsz; u.bn = u.pn; u.idx = i; return true;
    }
    __device__ __forceinline__ void a_ready(const Unit&) const {}
    __device__ __forceinline__ void done(const Unit&) const {}
};
struct ListOrder {
    int nN, nwg, G, c;
    __host__ __device__ void init(int nM_, int nN_, int G_, int c_) { nN = nN_; nwg = nM_ * nN_; G = G_; c = c_; }
    __host__ __device__ bool next(int i, Unit& u) const { const long L = (long)i * G + c; if (c < 0 || L >= nwg) return false; u.pm = (int)(L / nN); u.pn = (int)(L % nN); u.bn = u.pn; u.idx = i; return true; }
    __device__ __forceinline__ void a_ready(const Unit&) const {}
    __device__ __forceinline__ void done(const Unit&) const {}
};

__device__ __forceinline__ unsigned cvt_pk_bf16(float lo, float hi) { unsigned r; asm volatile("v_cvt_pk_bf16_f32 %0, %1, %2" : "=v"(r) : "v"(lo), "v"(hi)); return r; }
__device__ __forceinline__ unsigned cvt4_fp8(float a, float b, float c, float d) { int r = __builtin_amdgcn_cvt_pk_fp8_f32(a, b, 0, false); r = __builtin_amdgcn_cvt_pk_fp8_f32(c, d, r, true); return (unsigned)r; }
__device__ __forceinline__ float fsigmoid(float x) { return __builtin_amdgcn_rcpf(1.0f + __expf(-x)); }
__device__ __forceinline__ float gelu_tanh(float x) { const float u = 1.5957691216f * (x + 0.044715f * x * x * x); return x * fsigmoid(u); }
__device__ __forceinline__ float fsilu(float x) { return x * fsigmoid(x); }

__device__ __forceinline__ float row_rstd(const float* ssq, int row) {
    const f32x4 a = *(const f32x4*)(ssq + (size_t)row * 16), b = *(const f32x4*)(ssq + (size_t)row * 16 + 4), c = *(const f32x4*)(ssq + (size_t)row * 16 + 8), d = *(const f32x4*)(ssq + (size_t)row * 16 + 12);
    const f32x4 s = (a + b) + (c + d); return 1.0f / sqrtf(((s[0] + s[1]) + (s[2] + s[3])) * (1.0f / 1024.0f) + 1e-6f);
}
template <class Sched> __device__ __forceinline__ void fill_rstd_table(PG8_LAS float* tab, const Sched& S, const float* ssq, int tid) {
    Unit u; for (int i = 0; S.next(i, u); ++i) if (tid < 256) { const int ai = tid >> 7, wr = (tid >> 6) & 1, m = (tid >> 4) & 3, fr = tid & 15; tab[i * 256 + ((ai * 2 + wr) * 16 + fr) * 4 + m] = row_rstd(ssq, u.pm * BM + tid); }
    __syncthreads();
}
template <int ACT, bool SPLIT_ = false> struct EpiBf16 {
    static constexpr bool PERM = true, AFTER_DRAIN = false, SPLIT = SPLIT_, PACK = false; static constexpr int NST = 16; struct Pk {};
    bf16_t* O; int ldc; const float* bias; const PG8_LAS float* rsT;
    __device__ __forceinline__ void operator()(const f32x4 (&acc)[2][2][4][2], const Unit& u, int wr, int wc, int fr, int fq) const { half<0>(acc, u, wr, wc, fr, fq); half<1>(acc, u, wr, wc, fr, fq); }
    template <int AI> __device__ __forceinline__ void half(const f32x4 (&acc)[2][2][4][2], const Unit& u, int wr, int wc, int fr, int fq) const {
        const int row0 = u.pm * BM + wr * 64 + fr; const int col0 = u.pn * BM + wc * 32 + 8 * fq;
        f32x4 bv[2][2];
#pragma unroll
        for (int bj = 0; bj < 2; ++bj)
#pragma unroll
            for (int n = 0; n < 2; ++n) bv[bj][n] = bias ? *(const f32x4*)(bias + col0 + bj * HALF + 4 * n) : (f32x4){0.f, 0.f, 0.f, 0.f};
        { constexpr int ai = AI; const f32x4 rs4 = rsT ? *(const PG8_LAS f32x4*)(rsT + u.idx * 256 + ((ai * 2 + wr) * 16 + fr) * 4) : (f32x4){1.f, 1.f, 1.f, 1.f};
#pragma unroll
            for (int m = 0; m < 4; ++m) { bf16_t* rowp = O + (size_t)(row0 + ai * HALF + m * 16) * ldc + col0; const float rs = rs4[m];
#pragma unroll
                for (int bj = 0; bj < 2; ++bj) { f32x4 v0 = acc[ai][bj][m][0] * rs + bv[bj][0], v1 = acc[ai][bj][m][1] * rs + bv[bj][1];
                    if (ACT == 1) {
#pragma unroll
                        for (int j = 0; j < 4; ++j) { v0[j] = gelu_tanh(v0[j]); v1[j] = gelu_tanh(v1[j]); } }
                    u32x4 w; w.x = cvt_pk_bf16(v0[0], v0[1]); w.y = cvt_pk_bf16(v0[2], v0[3]); w.z = cvt_pk_bf16(v1[0], v1[1]); w.w = cvt_pk_bf16(v1[2], v1[3]);
                    *(u32x4*)(rowp + bj * HALF) = w; } } }
    }
};
struct EpiEvIn {
    static constexpr bool PERM = true, AFTER_DRAIN = false, SPLIT = true, PACK = false; static constexpr int NST = 16; struct Pk {};
    bf16_t* O; int ldc; bf16_t* KV6; int S;
    __device__ __forceinline__ void operator()(const f32x4 (&acc)[2][2][4][2], const Unit& u, int wr, int wc, int fr, int fq) const { half<0>(acc, u, wr, wc, fr, fq); half<1>(acc, u, wr, wc, fr, fq); }
    template <int AI> __device__ __forceinline__ void half(const f32x4 (&acc)[2][2][4][2], const Unit& u, int wr, int wc, int fr, int fq) const {
        const int row0 = u.pm * BM + wr * 64 + fr; const int col0 = u.pn * BM + wc * 32 + 8 * fq;
        const bool kv = (u.pn >= 12 && u.pn < 18);
        { constexpr int ai = AI;
#pragma unroll
            for (int m = 0; m < 4; ++m) { const int row = row0 + ai * HALF + m * 16;
#pragma unroll
                for (int bj = 0; bj < 2; ++bj) { const f32x4 v0 = acc[ai][bj][m][0], v1 = acc[ai][bj][m][1];
                    u32x4 w; w.x = cvt_pk_bf16(v0[0], v0[1]); w.y = cvt_pk_bf16(v0[2], v0[3]); w.z = cvt_pk_bf16(v1[0], v1[1]); w.w = cvt_pk_bf16(v1[2], v1[3]);
                    if (kv) { const int b = row / S, t = row - b * S;
                        bf16_t* p = KV6 + ((((size_t)(u.pn - 12) * 2 + b) * 2 + bj) * S + t) * 128 + wc * 32 + 8 * fq; *(u32x4*)p = w; }
                    else *(u32x4*)(O + (size_t)row * ldc + col0 + bj * HALF) = w; } } }
    }
};
struct EpiResid {
    static constexpr bool PERM = false, AFTER_DRAIN = false, SPLIT = false, PACK = false; static constexpr int NST = 0; struct Pk {};
    const float* base; float* out; int ldc;
    __device__ __forceinline__ void operator()(const f32x4 (&acc)[2][2][4][2], const Unit& u, int wr, int wc, int fr, int fq) const {
        const int row0 = u.pm * BM + wr * 64 + fr, col0 = u.pn * BM + wc * 32 + 4 * fq;
#pragma unroll
        for (int ai = 0; ai < 2; ++ai)
#pragma unroll
            for (int m = 0; m < 4; ++m) { const size_t off = (size_t)(row0 + ai * HALF + m * 16) * ldc + col0;
#pragma unroll
                for (int bj = 0; bj < 2; ++bj)
#pragma unroll
                    for (int n = 0; n < 2; ++n) { const f32x4 b = *(const f32x4*)(base + off + bj * HALF + n * 16); *(f32x4*)(out + off + bj * HALF + n * 16) = b + acc[ai][bj][m][n]; } }
    }
};
struct EpiResidN {
    static constexpr bool PERM = false, AFTER_DRAIN = false, SPLIT = false, PACK = false; static constexpr int NST = 0; struct Pk {};
    const float* base; float* out; int ldc; bf16_t* XB; float* SSQ;
    __device__ __forceinline__ void operator()(const f32x4 (&acc)[2][2][4][2], const Unit& u, int wr, int wc, int fr, int fq) const {
        const int row0 = u.pm * BM + wr * 64 + fr, col0 = u.pn * BM + wc * 32 + 4 * fq;
#pragma unroll
        for (int ai = 0; ai < 2; ++ai)
#pragma unroll
            for (int m = 0; m < 4; ++m) { const int row = row0 + ai * HALF + m * 16; const size_t off = (size_t)row * ldc + col0; float ss = 0.f;
#pragma unroll
                for (int bj = 0; bj < 2; ++bj)
#pragma unroll
                    for (int n = 0; n < 2; ++n) { const f32x4 b = *(const f32x4*)(base + off + bj * HALF + n * 16); const f32x4 v = b + acc[ai][bj][m][n]; *(f32x4*)(out + off + bj * HALF + n * 16) = v;
                        if (XB) { u32x2 w; w.x = cvt_pk_bf16(v[0], v[1]); w.y = cvt_pk_bf16(v[2], v[3]); *(u32x2*)(XB + off + bj * HALF + n * 16) = w; }
                        ss += (v[0] * v[0] + v[1] * v[1]) + (v[2] * v[2] + v[3] * v[3]); }
                ss += __shfl_xor(ss, 16); ss += __shfl_xor(ss, 32);
                if (XB && fq == 0) SSQ[(size_t)row * 16 + u.pn * 4 + wc] = ss; }
    }
};
template <bool BASE_F32> struct EpiResidB {
    static constexpr bool PERM = true, AFTER_DRAIN = false, SPLIT = false, PACK = false; static constexpr int NST = 0; struct Pk {};
    const void* base; bf16_t* X; int ldc; float* SSQ;
    __device__ __forceinline__ void operator()(const f32x4 (&acc)[2][2][4][2], const Unit& u, int wr, int wc, int fr, int fq) const {
        const int row0 = u.pm * BM + wr * 64 + fr, col0 = u.pn * BM + wc * 32 + 8 * fq;
#pragma unroll
        for (int ai = 0; ai < 2; ++ai)
#pragma unroll
            for (int m = 0; m < 4; ++m) { const int row = row0 + ai * HALF + m * 16; const size_t off = (size_t)row * ldc + col0; float ss = 0.f;
#pragma unroll
                for (int bj = 0; bj < 2; ++bj) { f32x4 b0, b1;
                    if constexpr (BASE_F32) { b0 = *(const f32x4*)((const float*)base + off + bj * HALF); b1 = *(const f32x4*)((const float*)base + off + bj * HALF + 4); }
                    else { const u32x4 r = *(const u32x4*)((const bf16_t*)base + off + bj * HALF);
                        b0 = (f32x4){__builtin_bit_cast(float, r.x << 16), __builtin_bit_cast(float, r.x & 0xffff0000u), __builtin_bit_cast(float, r.y << 16), __builtin_bit_cast(float, r.y & 0xffff0000u)};
                        b1 = (f32x4){__builtin_bit_cast(float, r.z << 16), __builtin_bit_cast(float, r.z & 0xffff0000u), __builtin_bit_cast(float, r.w << 16), __builtin_bit_cast(float, r.w & 0xffff0000u)}; }
                    const f32x4 v0 = b0 + acc[ai][bj][m][0], v1 = b1 + acc[ai][bj][m][1];
                    u32x4 w; w.x = cvt_pk_bf16(v0[0], v0[1]); w.y = cvt_pk_bf16(v0[2], v0[3]); w.z = cvt_pk_bf16(v1[0], v1[1]); w.w = cvt_pk_bf16(v1[2], v1[3]);
                    *(u32x4*)(X + off + bj * HALF) = w;
                    ss += ((v0[0] * v0[0] + v0[1] * v0[1]) + (v0[2] * v0[2] + v0[3] * v0[3])) + ((v1[0] * v1[0] + v1[1] * v1[1]) + (v1[2] * v1[2] + v1[3] * v1[3])); }
                ss += __shfl_xor(ss, 16); ss += __shfl_xor(ss, 32);
                if (fq == 0) SSQ[(size_t)row * 16 + u.pn * 4 + wc] = ss; }
    }
};
struct EpiNull {
    static constexpr bool PERM = false, AFTER_DRAIN = false, SPLIT = false, PACK = false; static constexpr int NST = 0; struct Pk {};
    __device__ __forceinline__ void operator()(const f32x4 (&acc)[2][2][4][2], const Unit&, int, int, int, int) const {
#pragma unroll
        for (int ai = 0; ai < 2; ++ai)
#pragma unroll
            for (int bj = 0; bj < 2; ++bj)
#pragma unroll
                for (int m = 0; m < 4; ++m)
#pragma unroll
                    for (int n = 0; n < 2; ++n) asm volatile("" :: "v"(acc[ai][bj][m][n]));
    }
};
struct EpiF32 {
    static constexpr bool PERM = false, AFTER_DRAIN = false, SPLIT = false, PACK = false; static constexpr int NST = 0; struct Pk {};
    float* C; int ldc;
    __device__ __forceinline__ void operator()(const f32x4 (&acc)[2][2][4][2], const Unit& u, int wr, int wc, int fr, int fq) const {
        const int row0 = u.pm * BM + wr * 64 + fr, col0 = u.pn * BM + wc * 32 + 4 * fq;
#pragma unroll
        for (int ai = 0; ai < 2; ++ai)
#pragma unroll
            for (int m = 0; m < 4; ++m) { float* rowp = C + (size_t)(row0 + ai * HALF + m * 16) * ldc + col0;
#pragma unroll
                for (int bj = 0; bj < 2; ++bj)
#pragma unroll
                    for (int n = 0; n < 2; ++n) *(f32x4*)(rowp + bj * HALF + n * 16) = acc[ai][bj][m][n]; }
    }
};
template <bool SPLIT_, bool PACK_ = false, bool F8O_ = false> struct EpiSwiglu {
    static_assert(!(PACK_ && F8O_), "no packed fp8 form");
    static constexpr bool PERM = true, AFTER_DRAIN = false, SPLIT = SPLIT_, PACK = PACK_; static constexpr int NST = 8;
    bf16_t* H; int ldh; const PG8_LAS float* rsT; float sc = 1.f;
    __device__ __forceinline__ void operator()(const f32x4 (&acc)[2][2][4][2], const Unit& u, int wr, int wc, int fr, int fq) const { half<0>(acc, u, wr, wc, fr, fq); half<1>(acc, u, wr, wc, fr, fq); }
    struct Pk { u32x4 w[4]; };
    __device__ __forceinline__ void pack1(const f32x4 (&acc)[2][2][4][2], const Unit& u, int wr, int fr, Pk& pk) const {
        constexpr int ai = 1; const f32x4 rs4 = rsT ? *(const PG8_LAS f32x4*)(rsT + u.idx * 256 + ((ai * 2 + wr) * 16 + fr) * 4) : (f32x4){1.f, 1.f, 1.f, 1.f};
#pragma unroll
        for (int m = 0; m < 4; ++m) { const float rs = rs4[m] * sc;
            const f32x4 u0 = acc[ai][0][m][0] * rs, u1 = acc[ai][0][m][1] * rs, g0 = acc[ai][1][m][0] * rs, g1 = acc[ai][1][m][1] * rs;
            pk.w[m].x = cvt_pk_bf16(fsilu(g0[0]) * u0[0], fsilu(g0[1]) * u0[1]); pk.w[m].y = cvt_pk_bf16(fsilu(g0[2]) * u0[2], fsilu(g0[3]) * u0[3]);
            pk.w[m].z = cvt_pk_bf16(fsilu(g1[0]) * u1[0], fsilu(g1[1]) * u1[1]); pk.w[m].w = cvt_pk_bf16(fsilu(g1[2]) * u1[2], fsilu(g1[3]) * u1[3]); }
    }
    __device__ __forceinline__ void store1(const Pk& pk, const Unit& u, int wr, int wc, int fr, int fq) const {
        bf16_t* p = H + (size_t)(u.pm * BM + wr * 64 + fr + HALF) * ldh + u.pn * 128 + wc * 32 + 8 * fq;
#pragma unroll
        for (int m = 0; m < 4; ++m) *(u32x4*)(p + (size_t)(m * 16) * ldh) = pk.w[m];
    }
    template <int AI> __device__ __forceinline__ void half(const f32x4 (&acc)[2][2][4][2], const Unit& u, int wr, int wc, int fr, int fq) const {
        const int row0 = u.pm * BM + wr * 64 + fr, col0 = u.pn * 128 + wc * 32 + 8 * fq;
        constexpr int ai = AI; const f32x4 rs4 = rsT ? *(const PG8_LAS f32x4*)(rsT + u.idx * 256 + ((ai * 2 + wr) * 16 + fr) * 4) : (f32x4){1.f, 1.f, 1.f, 1.f};
#pragma unroll
        for (int m = 0; m < 4; ++m) { bf16_t* rowp = H + (size_t)(row0 + ai * HALF + m * 16) * ldh + col0; const float rs = rs4[m] * sc;
            const f32x4 u0 = acc[ai][0][m][0] * rs, u1 = acc[ai][0][m][1] * rs, g0 = acc[ai][1][m][0] * rs, g1 = acc[ai][1][m][1] * rs;
            if constexpr (F8O_) { u32x2 w; w.x = cvt4_fp8(fsilu(g0[0]) * u0[0], fsilu(g0[1]) * u0[1], fsilu(g0[2]) * u0[2], fsilu(g0[3]) * u0[3]);
                w.y = cvt4_fp8(fsilu(g1[0]) * u1[0], fsilu(g1[1]) * u1[1], fsilu(g1[2]) * u1[2], fsilu(g1[3]) * u1[3]);
                *(u32x2*)((unsigned char*)H + (size_t)(row0 + ai * HALF + m * 16) * ldh + col0) = w; }
            else { u32x4 w; w.x = cvt_pk_bf16(fsilu(g0[0]) * u0[0], fsilu(g0[1]) * u0[1]); w.y = cvt_pk_bf16(fsilu(g0[2]) * u0[2], fsilu(g0[3]) * u0[3]);
            w.z = cvt_pk_bf16(fsilu(g1[0]) * u1[0], fsilu(g1[1]) * u1[1]); w.w = cvt_pk_bf16(fsilu(g1[2]) * u1[2], fsilu(g1[3]) * u1[3]);
            *(u32x4*)rowp = w; } }
    }
};
__host__ __device__ __forceinline__ int swiglu_row(int h, int gate) { return (h >> 7) * 256 + gate * 128 + (h & 127); }

template <class Epi, class Sched, bool ALIGN_EPI = false, bool SP2 = false, bool F8 = false>
__device__ __forceinline__ void gemm_phase(PG8_LAS unsigned char* lds, const Gemm g, const Sched& S, const Epi& E) {
    int tid = threadIdx.x; asm volatile("" : "+v"(tid));
    const int wid = __builtin_amdgcn_readfirstlane(tid >> 6), lane = tid & 63, wr = wid >> 2, wc = wid & 3, fr = lane & 15, fq = lane >> 4;
    const int K = g.K, nt = K / BK;
    unsigned voffA, voffB;
    { int R, C; stage_rc(tid * 16, R, C); const int Rb = Epi::PERM ? ((R & ~31) + perm32(R & 31)) : R;
      voffA = (unsigned)(R * g.lda + C) * 2u; voffB = (unsigned)(Rb * g.ldb + C) * 2u; }
    const size_t q64A = (size_t)64 * g.lda * 2, q64B = (size_t)64 * g.ldb * 2;
    const size_t kstep = (size_t)(BK * 2);
    const size_t hstepA = (size_t)HALF * g.lda * 2, hstepB = (size_t)HALF * g.ldb * 2;
    const size_t tstepA = 2 * hstepA, tstepB = 2 * hstepB;
    const unsigned ldsw = (unsigned)wid * 1024u;
    const int aoff = lds_byte(wr * 64 + fr, fq * 8), boff = lds_byte(wc * 32 + fr, fq * 8);
#define PG8_SA(b, h) (((b) * 2 + (h)) * HTB)
#define PG8_SB(b, h) ((4 + (b) * 2 + (h)) * HTB)
#define PG8_STAGE(bufoff, gbase, voff) do { __builtin_amdgcn_global_load_lds((const unsigned*)((const char*)(gbase) + (voff)), (PG8_LAS unsigned*)(lds + (bufoff) + ldsw), 16, 0, 0); \
        __builtin_amdgcn_global_load_lds((const unsigned*)((const char*)(gbase) + PG8_Q64(voff) + (voff)), (PG8_LAS unsigned*)(lds + (bufoff) + ldsw + 8192), 16, 0, 0); } while (0)
#define PG8_Q64(v) PG8_Q64_##v
#define PG8_Q64_voffA q64A
#define PG8_Q64_voffB q64B
#define PG8_LDA(dst, b, h) do { _Pragma("unroll") for (int m = 0; m < 4; ++m) _Pragma("unroll") for (int k = 0; k < 2; ++k) dst[m][k] = *(const PG8_LAS bf16x8*)(lds + PG8_SA(b, h) + aoff + m * 2048 + k * 1024); } while (0)
#define PG8_LDB(dst, b, h) do { _Pragma("unroll") for (int n = 0; n < 2; ++n) _Pragma("unroll") for (int k = 0; k < 2; ++k) dst[n][k] = *(const PG8_LAS bf16x8*)(lds + PG8_SB(b, h) + boff + n * 2048 + k * 1024); } while (0)
#define PG8_MMA(ai, bj, At, Bt) do { __builtin_amdgcn_s_setprio(1); \
        if constexpr (F8) { _Pragma("unroll") for (int m = 0; m < 4; ++m) _Pragma("unroll") for (int n = 0; n < 2; ++n) \
            mfma_f8_inplace(acc[ai][bj][m][n], cat8(Bt[n][0], Bt[n][1]), cat8(At[m][0], At[m][1])); } \
        else { _Pragma("unroll") for (int m = 0; m < 4; ++m) _Pragma("unroll") for (int n = 0; n < 2; ++n) _Pragma("unroll") for (int k = 0; k < 2; ++k) \
            acc[ai][bj][m][n] = __builtin_amdgcn_mfma_f32_16x16x32_bf16(Bt[n][k], At[m][k], acc[ai][bj][m][n], 0, 0, 0); } \
        __builtin_amdgcn_s_setprio(0); } while (0)
#define PG8_WAIT_V(n) asm volatile("s_waitcnt vmcnt(" #n ")" ::: "memory")
#define PG8_WAIT_L(n) asm volatile("s_waitcnt lgkmcnt(" #n ")" ::: "memory")
#define PG8_WAIT_REL(NN) do { if (rel) asm volatile("s_waitcnt vmcnt(%0)" :: "n"(NN) : "memory"); else PG8_WAIT_V(8); } while (0)
#define PG8_BAR __builtin_amdgcn_s_barrier()
#define PG8_SCHED __builtin_amdgcn_sched_barrier(0)
    typename Epi::Pk pk; Unit cur, nxt, pend; int ui = 0; bool pending = false; pend.pm = pend.pn = pend.bn = pend.idx = 0;
    if (!S.next(0, cur)) return;
    f32x4 acc[2][2][4][2];
#pragma unroll
    for (int a = 0; a < 2; ++a)
#pragma unroll
        for (int b = 0; b < 2; ++b)
#pragma unroll
            for (int m = 0; m < 4; ++m)
#pragma unroll
                for (int n = 0; n < 2; ++n) acc[a][b][m][n] = (f32x4){0.f, 0.f, 0.f, 0.f};
    bf16x8 At[4][2], B0[2][2], B1[2][2];
    const char* cA = (const char*)g.A + (size_t)cur.pm * tstepA; const char* cB = (const char*)g.Bt + (size_t)cur.bn * tstepB;
    S.a_ready(cur);
    if constexpr (SP2) {
        PG8_STAGE(PG8_SB(0, 0), cB, voffB); PG8_STAGE(PG8_SB(0, 1), cB + hstepB, voffB); PG8_STAGE(PG8_SA(0, 0), cA, voffA); PG8_STAGE(PG8_SA(0, 1), cA + hstepA, voffA);
        if (wr == 1) PG8_BAR;
        PG8_WAIT_V(2); PG8_BAR;
        PG8_STAGE(PG8_SB(1, 0), cB + kstep, voffB); PG8_STAGE(PG8_SA(1, 0), cA + kstep, voffA); PG8_STAGE(PG8_SB(1, 1), cB + hstepB + kstep, voffB);
        PG8_WAIT_V(6); PG8_BAR;
    } else {
        PG8_STAGE(PG8_SB(0, 0), cB, voffB); PG8_STAGE(PG8_SA(0, 0), cA, voffA); PG8_STAGE(PG8_SB(0, 1), cB + hstepB, voffB); PG8_STAGE(PG8_SA(0, 1), cA + hstepA, voffA);
        if (wr == 1) PG8_BAR;
        PG8_WAIT_V(4); PG8_BAR;
        PG8_STAGE(PG8_SB(1, 0), cB + kstep, voffB); PG8_STAGE(PG8_SA(1, 0), cA + kstep, voffA); PG8_STAGE(PG8_SB(1, 1), cB + hstepB + kstep, voffB);
        PG8_WAIT_V(6); PG8_BAR;
    }
    for (;;) {
        const bool has_next = S.next(ui + 1, nxt);
        const char* nA = has_next ? (const char*)g.A + (size_t)nxt.pm * tstepA : cA; const char* nB = has_next ? (const char*)g.Bt + (size_t)nxt.bn * tstepB : cB;
        for (int t = 0; t < nt; t += 2) {
            const bool last = (t == nt - 2);
            const char* a1 = cA + (size_t)(t + 1) * kstep;
            const char* a2 = last ? nA : cA + (size_t)(t + 2) * kstep; const char* b2 = last ? nB : cB + (size_t)(t + 2) * kstep;
            const char* a3 = a2 + kstep; const char* b3 = b2 + kstep;
            if (last && has_next) S.a_ready(nxt);
            if constexpr (SP2) {
            const bool rel = Epi::SPLIT && pending && t == 0;
            if (rel) { if constexpr (Epi::SPLIT) { PG8_STAGE(PG8_SA(1, 1), a1 + hstepA, voffA); PG8_SCHED;
                if constexpr (Epi::PACK) { E.store1(pk, pend, wr, wc, fr, fq); }
                else { E.template half<1>(acc, pend, wr, wc, fr, fq);
#pragma unroll
                for (int b = 0; b < 2; ++b)
#pragma unroll
                    for (int m = 0; m < 4; ++m)
#pragma unroll
                        for (int n = 0; n < 2; ++n) acc[1][b][m][n] = (f32x4){0.f, 0.f, 0.f, 0.f}; }
                S.done(pend); pending = false;
                PG8_SCHED; PG8_LDB(B0, 0, 0); PG8_LDB(B1, 0, 1); PG8_SCHED; PG8_LDA(At, 0, 0); } }
            else { PG8_LDB(B0, 0, 0); PG8_LDB(B1, 0, 1); PG8_SCHED; PG8_LDA(At, 0, 0); PG8_STAGE(PG8_SA(1, 1), a1 + hstepA, voffA); }
            PG8_WAIT_REL(8 + Epi::NST); PG8_WAIT_L(0); PG8_BAR; PG8_MMA(0, 0, At, B0); PG8_MMA(0, 1, At, B1); PG8_BAR; PG8_SCHED;
            PG8_LDA(At, 0, 1); PG8_STAGE(PG8_SB(0, 0), b2, voffB); PG8_STAGE(PG8_SB(0, 1), b2 + hstepB, voffB); PG8_STAGE(PG8_SA(0, 0), a2, voffA);
            PG8_WAIT_REL(8 + Epi::NST); PG8_WAIT_L(0); PG8_BAR; PG8_MMA(1, 0, At, B0); PG8_MMA(1, 1, At, B1); PG8_BAR; PG8_SCHED;
            PG8_LDB(B0, 1, 0); PG8_LDB(B1, 1, 1); PG8_SCHED; PG8_LDA(At, 1, 0); PG8_STAGE(PG8_SA(0, 1), a2 + hstepA, voffA);
            PG8_WAIT_REL(8 + Epi::NST / 2); PG8_WAIT_L(0); PG8_BAR; PG8_MMA(0, 0, At, B0); PG8_MMA(0, 1, At, B1); PG8_BAR; PG8_SCHED;
            PG8_LDA(At, 1, 1); PG8_STAGE(PG8_SB(1, 0), b3, voffB); PG8_STAGE(PG8_SB(1, 1), b3 + hstepB, voffB); PG8_STAGE(PG8_SA(1, 0), a3, voffA);
            PG8_WAIT_V(8); PG8_WAIT_L(0); PG8_BAR; PG8_MMA(1, 0, At, B0); PG8_MMA(1, 1, At, B1); PG8_BAR; PG8_SCHED;
            } else {
            PG8_LDB(B0, 0, 0); PG8_SCHED; PG8_LDA(At, 0, 0); PG8_STAGE(PG8_SA(1, 1), a1 + hstepA, voffA);
            PG8_WAIT_L(8); PG8_BAR; PG8_WAIT_L(0); PG8_MMA(0, 0, At, B0); PG8_BAR; PG8_SCHED;
            PG8_LDB(B1, 0, 1); PG8_STAGE(PG8_SB(0, 0), b2, voffB);
            PG8_BAR; PG8_WAIT_L(0); PG8_MMA(0, 1, At, B1); PG8_BAR;
            PG8_LDA(At, 0, 1); PG8_STAGE(PG8_SA(0, 0), a2, voffA);
            PG8_BAR; PG8_WAIT_L(0); PG8_MMA(1, 0, At, B0); PG8_BAR; PG8_SCHED;
            PG8_STAGE(PG8_SB(0, 1), b2 + hstepB, voffB);
            PG8_WAIT_V(6); PG8_BAR; PG8_MMA(1, 1, At, B1); PG8_BAR;
            PG8_LDB(B0, 1, 0); PG8_SCHED; PG8_LDA(At, 1, 0); PG8_STAGE(PG8_SA(0, 1), a2 + hstepA, voffA);
            PG8_WAIT_L(8); PG8_BAR; PG8_WAIT_L(0); PG8_MMA(0, 0, At, B0); PG8_BAR; PG8_SCHED;
            PG8_LDB(B1, 1, 1); PG8_STAGE(PG8_SB(1, 0), b3, voffB);
            PG8_BAR; PG8_WAIT_L(0); PG8_MMA(0, 1, At, B1); PG8_BAR;
            PG8_LDA(At, 1, 1); PG8_STAGE(PG8_SA(1, 0), a3, voffA);
            PG8_BAR; PG8_WAIT_L(0); PG8_MMA(1, 0, At, B0); PG8_BAR; PG8_SCHED;
            PG8_STAGE(PG8_SB(1, 1), b3 + hstepB, voffB);
            PG8_WAIT_V(6); PG8_BAR; PG8_MMA(1, 1, At, B1); PG8_BAR;
            }
        }
        if constexpr (F8) asm volatile("s_nop 15\n\ts_nop 15\n\ts_nop 15\n\ts_nop 15" ::: "memory");
        if constexpr (ALIGN_EPI) { if (wr == 0) PG8_BAR; }
        if constexpr (Epi::SPLIT) { static_assert(SP2, "split epilogues need the SP2 loop");
            if (has_next) { E.template half<0>(acc, cur, wr, wc, fr, fq); if constexpr (Epi::PACK) E.pack1(acc, cur, wr, fr, pk); pend = cur; pending = true; }
            else { E.template half<0>(acc, cur, wr, wc, fr, fq); E.template half<1>(acc, cur, wr, wc, fr, fq); S.done(cur); } }
        else if constexpr (!Epi::AFTER_DRAIN) { E(acc, cur, wr, wc, fr, fq); S.done(cur); }
        if (!has_next) break;
#pragma unroll
        for (int a = 0; a < ((Epi::SPLIT && !Epi::PACK) ? 1 : 2); ++a)
#pragma unroll
            for (int b = 0; b < 2; ++b)
#pragma unroll
                for (int m = 0; m < 4; ++m)
#pragma unroll
                    for (int n = 0; n < 2; ++n) acc[a][b][m][n] = (f32x4){0.f, 0.f, 0.f, 0.f};
        cur = nxt; cA = nA; cB = nB; ++ui;
        if constexpr (ALIGN_EPI) { if (wr == 1) PG8_BAR; }
    }
    PG8_WAIT_V(0);
    if constexpr (!ALIGN_EPI) { if (wr == 0) PG8_BAR; }
    PG8_BAR;
    if constexpr (Epi::AFTER_DRAIN) { E.fused(acc, cur, wr, wc, fr, fq, lds, wid, lane); S.done(cur); }
#undef PG8_SA
#undef PG8_SB
#undef PG8_STAGE
#undef PG8_Q64
#undef PG8_Q64_voffA
#undef PG8_Q64_voffB
#undef PG8_LDA
#undef PG8_LDB
#undef PG8_MMA
#undef PG8_WAIT_V
#undef PG8_WAIT_L
#undef PG8_WAIT_REL
#undef PG8_BAR
#undef PG8_SCHED
}
}
#define PG8_SP2 true
#define PG8_ALIGN true
constexpr int NWAVES = 8, NTHR = 512;
constexpr int BATCH = 2, SEQ = 8192, D = 1024, M = BATCH * SEQ;
constexpr int MEMLEN = 256, MMEM = BATCH * MEMLEN;
constexpr int EV_IN = 4632, EV_INP = 4864;
constexpr int OD_IN = 5152, OD_INP = 5376;
constexpr int FF = 2816, FFE = 3584, NEXP = 8;
constexpr float MOE_W2_SCALE = 128.f;
constexpr float MOE_W13_SCALE = 64.f;
constexpr int NQB = SEQ / 64;
constexpr int XH = 4;
constexpr float EPS = 1e-6f;
constexpr int MOE_ROWS = 2 * M + NEXP * 256;
constexpr int MOE_TILES = MOE_ROWS / 256;

constexpr size_t MiB = 1u << 20;
constexpr size_t WS_CTL = 0, CTL_ZERO_BYTES = 1 * MiB;
constexpr size_t WS_SMALL = 1 * MiB;
constexpr size_t WS_CMPB_PART = WS_SMALL;
constexpr size_t WS_CMPB = WS_SMALL + 256 * 1024;
constexpr size_t WS_OV = WS_SMALL + 512 * 1024;
constexpr size_t WS_MEMN = 2 * MiB;
constexpr size_t WS_KVM = 4 * MiB;
constexpr size_t WS_KM = 6 * MiB;
constexpr size_t WS_HID = 7 * MiB;
constexpr size_t WS_KVCMP = 9 * MiB;
constexpr size_t WS_MOEIDX = 10 * MiB;
constexpr size_t WS_SSQ = 14 * MiB;
constexpr size_t WS_W = 16 * MiB;
constexpr size_t WS_W_EVIN = WS_W, WS_W_EVOUT = WS_W_EVIN + 10 * MiB, WS_W_CK1 = WS_W_EVOUT + 4 * MiB, WS_W_CV1 = WS_W_CK1 + 2 * MiB, WS_W_ODIN = WS_W_CV1 + 2 * MiB,
                 WS_W_ODOUT = WS_W_ODIN + 11 * MiB, WS_W_XQ = WS_W_ODOUT + 4 * MiB, WS_W_XKV = WS_W_XQ + 2 * MiB, WS_W_XO = WS_W_XKV + 4 * MiB, WS_W_FF13 = WS_W_XO + 2 * MiB,
                 WS_W_FF2 = WS_W_FF13 + 11 * MiB, WS_W_M13 = WS_W_FF2 + 6 * MiB, WS_W_M2 = WS_W_M13 + 112 * MiB, WS_W_END = WS_W_M2 + 56 * MiB;
constexpr size_t WS_XN = WS_W_END;
constexpr size_t WS_QX = WS_XN + 32 * MiB, WS_OX = WS_QX + 16 * MiB, WS_R = WS_OX + 16 * MiB;
constexpr size_t WS_Y0 = WS_R, WS_KV6 = WS_R + 152 * MiB, WS_MIX = WS_R + 201 * MiB, WS_H = WS_R + 265 * MiB;
constexpr size_t WS_Y1 = WS_R, WS_YG = WS_R + 168 * MiB;
constexpr size_t WS_XN8 = WS_QX;
constexpr size_t WS_XP = WS_R, WS_HP = WS_R + 68 * MiB, WS_YP = WS_R + 306 * MiB, WS_END = WS_R + 442 * MiB;
static_assert(WS_W_END == 242 * MiB && WS_END == 748 * MiB, "ws map");
constexpr int CW_TMO = 0, CW_CODE = 1, CW_CHK = 2;
constexpr int CW_BAR = 4096;
constexpr int CW_MOECNT = 16384;
constexpr int CW_MOEOFF = 20480;

constexpr int LDS_BYTES = 159744;
constexpr int MISC_OFF = LDS_BYTES - 512;
constexpr int SCR_BYTES = MISC_OFF;

#define GAS __attribute__((address_space(1)))
#define LAS __attribute__((address_space(3)))
typedef unsigned short bf16;
typedef unsigned v4u __attribute__((ext_vector_type(4)));
typedef unsigned v2u __attribute__((ext_vector_type(2)));
typedef float f32x4 __attribute__((ext_vector_type(4)));
typedef float f32x16 __attribute__((ext_vector_type(16)));
typedef short bf16x8 __attribute__((ext_vector_type(8)));
typedef short s16x4 __attribute__((ext_vector_type(4)));
typedef GAS unsigned gu32;
#define RLX_AGENT __ATOMIC_RELAXED, __HIP_MEMORY_SCOPE_AGENT
#define LDS_WAIT() asm volatile("s_waitcnt lgkmcnt(0)" ::: "memory")
#define VM_WAIT() asm volatile("s_waitcnt vmcnt(0)" ::: "memory")
#define SBAR() __builtin_amdgcn_sched_barrier(0)
__device__ __forceinline__ int lane_id() { return (int)threadIdx.x & 63; }
__device__ __forceinline__ unsigned f2bf(float f) { unsigned u = __builtin_bit_cast(unsigned, f); return (u + 0x7fffu + ((u >> 16) & 1u)) >> 16; }
__device__ __forceinline__ unsigned pk2(float lo, float hi) { return f2bf(lo) | (f2bf(hi) << 16); }
__device__ __forceinline__ float bf2f(unsigned short b) { return __builtin_bit_cast(float, ((unsigned)b) << 16); }
__device__ __forceinline__ float bflo(unsigned w) { return __builtin_bit_cast(float, w << 16); }
__device__ __forceinline__ float bfhi(unsigned w) { return __builtin_bit_cast(float, w & 0xffff0000u); }
__device__ __forceinline__ unsigned cvtpk(float lo, float hi) { unsigned r; asm volatile("v_cvt_pk_bf16_f32 %0, %1, %2" : "=v"(r) : "v"(lo), "v"(hi)); return r; }
__device__ __forceinline__ float wave_sum(float v) {
#pragma unroll
    for (int o = 1; o < 64; o <<= 1) v += __shfl_xor(v, o);
    return v;
}
using pg8::fsigmoid; using pg8::gelu_tanh; using pg8::fsilu;
__device__ __forceinline__ float fsoftplus(float x) { return x > 20.f ? x : log1pf(__expf(x)); }

#define XB_TMO      128
#define XB_XCNT(j)  (256  + 64 * (j))
#define XB_XSUB(j)  (1280 + 64 * (j))
#define XB_XGEN(j)  (2304 + 64 * (j))
#define XB_TOP      3328
#define XB_TOPGEN   3392
#define XCD_BAR_WORDS 3456
#define XB_SPIN_CAP (1u << 18)

__device__ __forceinline__ unsigned xb_ld(unsigned* p)              { return __hip_atomic_load(p, __ATOMIC_RELAXED, __HIP_MEMORY_SCOPE_AGENT); }
__device__ __forceinline__ unsigned xb_add(unsigned* p, unsigned v) { return __hip_atomic_fetch_add(p, v, __ATOMIC_RELAXED, __HIP_MEMORY_SCOPE_AGENT); }
__device__ __forceinline__ unsigned xb_xcc_id() { return (unsigned)__builtin_amdgcn_s_getreg((3 << 11) | 20) & 0xFu; }
#define XB_SPIN(cond, bar) do { unsigned _sp = 0; while (cond) { __builtin_amdgcn_s_sleep(1); \
    if ((++_sp & 255u) == 0u) { if (xb_ld(&(bar)[XB_TMO])) break; if (_sp > XB_SPIN_CAP) { atomicAdd(&(bar)[XB_TMO], 1u); break; } } } } while (0)

struct XcdBarrier {
    unsigned* bar; unsigned x;
    volatile LAS unsigned* st;
};

__device__ __forceinline__ XcdBarrier xcd_barrier_post(unsigned* bar, volatile LAS unsigned* st) {
    XcdBarrier b; b.bar = bar; b.x = xb_xcc_id(); b.st = st;
    if (threadIdx.x == 0) (void)xb_add(&bar[XB_XCNT(b.x)], 1u);
    return b;
}
__device__ __forceinline__ void xcd_barrier_complete(unsigned* bar, unsigned x, unsigned& nloc, unsigned& nx) {
    const unsigned G = gridDim.x * gridDim.y * gridDim.z;
    unsigned sum, cnt, mine, sp = 0u;
    for (;;) {
        sum = 0u; cnt = 0u; mine = 0u;
#pragma unroll
        for (unsigned j = 0; j < 16; ++j) { const unsigned c = xb_ld(&bar[XB_XCNT(j)]); sum += c; cnt += (c > 0u) ? 1u : 0u; mine = (j == x) ? c : mine; }
        if (sum == G) break;
        __builtin_amdgcn_s_sleep(1);
        if ((++sp & 255u) == 0u) { if (xb_ld(&bar[XB_TMO])) break; if (sp > XB_SPIN_CAP) { atomicAdd(&bar[XB_TMO], 1u); break; } }
    }
    nloc = mine > 0u ? mine : 1u; nx = cnt > 0u ? cnt : 1u;
}

__device__ __forceinline__ void xcd_barrier(const XcdBarrier& b) {
    asm volatile("s_waitcnt vmcnt(0)" ::: "memory");
    __syncthreads();
    if (threadIdx.x == 0) {
        unsigned* bar = b.bar;
        __builtin_amdgcn_s_waitcnt(0);
        unsigned nloc = b.st[0], nx = b.st[1];
        if (nloc == 0u) { xcd_barrier_complete(bar, b.x, nloc, nx); b.st[0] = nloc; b.st[1] = nx; }
        const unsigned old = xb_add(&bar[XB_XSUB(b.x)], 1u);
        const unsigned gen = old / nloc;
        if (old + 1u == (gen + 1u) * nloc) {
            __builtin_amdgcn_fence(__ATOMIC_RELEASE, "agent");
            asm volatile("s_waitcnt vmcnt(0)" ::: "memory");
            const unsigned og = xb_add(&bar[XB_TOP], 1u);
            const unsigned tg = og / nx;
            if (og + 1u == (tg + 1u) * nx) xb_add(&bar[XB_TOPGEN], 1u);
            else XB_SPIN(xb_ld(&bar[XB_TOPGEN]) == tg, bar);
            __builtin_amdgcn_fence(__ATOMIC_ACQUIRE, "agent");
            xb_add(&bar[XB_XGEN(b.x)], 1u);
            asm volatile("s_waitcnt vmcnt(0)" ::: "memory");
        } else {
            XB_SPIN(xb_ld(&bar[XB_XGEN(b.x)]) == gen, bar);
            __builtin_amdgcn_fence(__ATOMIC_ACQUIRE, "agent");
            asm volatile("s_waitcnt vmcnt(0)" ::: "memory");
        }
    }
    __syncthreads();
}

struct Args { const float* in[41]; float* out; unsigned char* ws; int ph_lo, ph_hi, li, pad; };
struct Frame { LAS unsigned char* lds; volatile LAS unsigned* MISC; gu32* ctl; unsigned char* ws; int tid, lane, wave, G, bid; };
enum { I_X = 0, I_MEM, I_NMIX, I_NCROSS, I_NMEM, I_NFFN, I_EVWIN, I_RGCW, I_RGCB, I_RGWA, I_RGBA, I_RGWX, I_RGBX, I_RGLAM, I_GATEB, I_QNORM, I_KNORM, I_CMPPOS,
       I_CKW1, I_CKW2, I_CVW1, I_CVW2, I_EVWOUT, I_ODWIN, I_ODCW, I_ODCB, I_DTB, I_ALOG, I_DSKIP, I_ODNORM, I_ODWOUT, I_XWQ, I_XWKV, I_XQN, I_XKN, I_XWO,
       I_FFW13, I_FFW2, I_ROUTER, I_MW13, I_MW2, N_IN };
static_assert(N_IN == 41, "input count");

template <int MAP>
__device__ __forceinline__ void transpose_item(const float* W, int N, bf16* WT, int ldt, LAS float* scr, int kb, int nb, int lane, int ffs, const float* kg = nullptr) {
    const int k0 = 64 * kb, n0 = 64 * nb; const int c4 = (lane & 15) * 4, r4 = lane >> 4;
    f32x4 tv[16];
    if ((N & 3) == 0) {
#pragma unroll
        for (int i = 0; i < 16; ++i) { const int kk = 4 * i + r4; tv[i] = (n0 + c4 < N) ? *(const GAS f32x4*)(W + (size_t)(k0 + kk) * N + n0 + c4) : (f32x4){0.f, 0.f, 0.f, 0.f}; }
    } else {
#pragma unroll
        for (int i = 0; i < 16; ++i) { const int kk = 4 * i + r4; const float* src = W + (size_t)(k0 + kk) * N + n0 + c4;
#pragma unroll
            for (int j = 0; j < 4; ++j) tv[i][j] = (n0 + c4 + j < N) ? src[j] : 0.f; }
    }
#pragma unroll
    for (int i = 0; i < 16; ++i) { const int kk = 4 * i + r4; const float gk = kg ? kg[k0 + kk] : 1.f;
#pragma unroll
        for (int j = 0; j < 4; ++j) scr[kk * 65 + c4 + j] = tv[i][j] * gk; }
    LDS_WAIT(); asm volatile("" ::: "memory");
    const int c = lane & 7;
#pragma unroll
    for (int j = 0; j < 8; ++j) { const int nl = (lane >> 3) + 8 * j, n = n0 + nl; const LAS float* s = scr + (8 * c) * 65 + nl;
        v4u o; o.x = pk2(s[0 * 65], s[1 * 65]); o.y = pk2(s[2 * 65], s[3 * 65]); o.z = pk2(s[4 * 65], s[5 * 65]); o.w = pk2(s[6 * 65], s[7 * 65]);
        int row = n; if (MAP == 1) row = (n < ffs) ? pg8::swiglu_row(n, 0) : pg8::swiglu_row(n - ffs, 1);
        if (n < ((N + 31) & ~31)) *(GAS v4u*)(WT + (size_t)row * ldt + k0 + 8 * c) = o; }
    LDS_WAIT(); asm volatile("" ::: "memory");
}
__device__ __forceinline__ unsigned pk4_fp8(float a, float b, float c, float d) { int r = __builtin_amdgcn_cvt_pk_fp8_f32(a, b, 0, false); r = __builtin_amdgcn_cvt_pk_fp8_f32(c, d, r, true); return (unsigned)r; }
template <int MAP>
__device__ __forceinline__ void transpose_item_f8(const float* W, int N, unsigned char* WT8, int ldt, LAS float* scr, int kb, int nb, int lane, int ffs, float sc) {
    const int k0 = 64 * kb, n0 = 64 * nb; const int c4 = (lane & 15) * 4, r4 = lane >> 4;
    f32x4 tv[16];
#pragma unroll
    for (int i = 0; i < 16; ++i) { const int kk = 4 * i + r4; tv[i] = *(const GAS f32x4*)(W + (size_t)(k0 + kk) * N + n0 + c4); }
#pragma unroll
    for (int i = 0; i < 16; ++i) { const int kk = 4 * i + r4;
#pragma unroll
        for (int j = 0; j < 4; ++j) scr[kk * 65 + c4 + j] = tv[i][j] * sc; }
    LDS_WAIT(); asm volatile("" ::: "memory");
    const int c = lane & 7;
#pragma unroll
    for (int j = 0; j < 8; ++j) { const int nl = (lane >> 3) + 8 * j, n = n0 + nl; const LAS float* s = scr + (8 * c) * 65 + nl;
        v2u o; o.x = pk4_fp8(s[0 * 65], s[1 * 65], s[2 * 65], s[3 * 65]); o.y = pk4_fp8(s[4 * 65], s[5 * 65], s[6 * 65], s[7 * 65]);
        int row = n; if (MAP == 1) row = (n < ffs) ? pg8::swiglu_row(n, 0) : pg8::swiglu_row(n - ffs, 1);
        *(GAS v2u*)(WT8 + (size_t)row * ldt + k0 + 8 * c) = o; }
    LDS_WAIT(); asm volatile("" ::: "memory");
}
constexpr int MOE_CONV_ITEMS = NEXP * (16 * 112 + 56 * 16);

__device__ __forceinline__ void rms_row_to_bf16(const float* xrow, const float* g, bf16* orow, int lane) {
    const GAS f32x4* xr = (const GAS f32x4*)xrow + lane; const GAS f32x4* gr = (const GAS f32x4*)g + lane;
    f32x4 v[4]; float s = 0.f;
#pragma unroll
    for (int j = 0; j < 4; ++j) { v[j] = xr[64 * j]; s += (v[j].x * v[j].x + v[j].y * v[j].y) + (v[j].z * v[j].z + v[j].w * v[j].w); }
    const float rstd = 1.f / sqrtf(wave_sum(s) * (1.f / D) + EPS);
    GAS unsigned long long* o8 = (GAS unsigned long long*)orow + lane;
#pragma unroll
    for (int j = 0; j < 4; ++j) { const f32x4 gg = gr[64 * j];
        o8[64 * j] = (unsigned long long)pk2(v[j].x * rstd * gg.x, v[j].y * rstd * gg.y) | ((unsigned long long)pk2(v[j].z * rstd * gg.z, v[j].w * rstd * gg.w) << 32); }
}
__device__ __forceinline__ void phase_rmsnorm(const Frame& F, const float* x, const float* g, bf16* xn, int rows) {
    const int gw = F.bid * NWAVES + F.wave, NGW = F.G * NWAVES;
    for (int m = gw; m < rows; m += NGW) rms_row_to_bf16(x + (size_t)m * D, g, xn + (size_t)m * D, F.lane);
}
#define TR_MAT(cnt_, W_, K_, N_, WT_, ldt_, MAPK_, ffs_, kg_) \
    if (r < (cnt_)) { const int nblk_ = ((N_) + 63) / 64; transpose_item<MAPK_>((W_), (N_), (WT_), (ldt_), scr, r / nblk_, r % nblk_, F.lane, (ffs_), (kg_)); continue; } r -= (cnt_);
constexpr int C_EVIN = 16 * 73, C_EVOUT = 32 * 16, C_CW1 = 64 * 4, C_ODIN = 16 * 81, C_ODOUT = 32 * 16, C_XQ = 16 * 8, C_XKV = 16 * 16, C_XO = 8 * 16, C_FF13 = 16 * 88, C_FF2 = 44 * 16;
constexpr int CONV_A = C_EVIN + 2 * C_XKV + 2 * C_CW1, CONV_B = C_EVOUT + 2 * C_XQ + 2 * C_XO + C_FF13 + C_FF2 + C_ODIN + C_ODOUT;
constexpr int CONV_ALL = CONV_A + CONV_B + MOE_CONV_ITEMS, CONV_Q = 4480, CONV_P2_END = CONV_ALL - 2 * CONV_Q;
__device__ __forceinline__ void convert_range(const Frame& F, const Args& a, int gw, int NGW, int it_lo, int it_hi) {
    LAS float* scr = (LAS float*)(F.lds + F.wave * 16640); unsigned char* ws = F.ws;
    for (int it = it_lo + gw; it < it_hi; it += NGW) {
        int r = it;
        TR_MAT(C_EVIN, a.in[I_EVWIN], D, EV_IN, (bf16*)(ws + WS_W_EVIN), D, 0, 0, nullptr)
        TR_MAT(C_XKV, a.in[I_XWKV], D, 1024, (bf16*)(ws + WS_W_XKV), D, 0, 0, nullptr)
        TR_MAT(C_XKV, a.in[I_XWKV] + (size_t)D * 1024, D, 1024, (bf16*)(ws + WS_W_XKV) + (size_t)1024 * D, D, 0, 0, nullptr)
        TR_MAT(C_CW1, a.in[I_CKW1], 4096, 256, (bf16*)(ws + WS_W_CK1), 4096, 0, 0, nullptr)
        TR_MAT(C_CW1, a.in[I_CVW1], 4096, 256, (bf16*)(ws + WS_W_CV1), 4096, 0, 0, nullptr)
        TR_MAT(C_EVOUT, a.in[I_EVWOUT], 2048, D, (bf16*)(ws + WS_W_EVOUT), 2048, 0, 0, nullptr)
        TR_MAT(C_XQ, a.in[I_XWQ], D, 512, (bf16*)(ws + WS_W_XQ), D, 0, 0, a.in[I_NCROSS])
        TR_MAT(C_XO, a.in[I_XWO], 512, D, (bf16*)(ws + WS_W_XO), 512, 0, 0, nullptr)
        TR_MAT(C_FF13, a.in[I_FFW13], D, 2 * FF, (bf16*)(ws + WS_W_FF13), D, 1, FF, a.in[I_NFFN])
        TR_MAT(C_FF2, a.in[I_FFW2], FF, D, (bf16*)(ws + WS_W_FF2), FF, 0, 0, nullptr)
        TR_MAT(C_ODIN, a.in[I_ODWIN], D, OD_IN, (bf16*)(ws + WS_W_ODIN), D, 0, 0, a.in[I_NMIX] + D)
        TR_MAT(C_ODOUT, a.in[I_ODWOUT], 2048, D, (bf16*)(ws + WS_W_ODOUT), 2048, 0, 0, nullptr)
        TR_MAT(C_XQ, a.in[I_XWQ] + (size_t)D * 512, D, 512, (bf16*)(ws + WS_W_XQ) + (size_t)512 * D, D, 0, 0, a.in[I_NCROSS] + D)
        TR_MAT(C_XO, a.in[I_XWO] + (size_t)512 * D, 512, D, (bf16*)(ws + WS_W_XO) + (size_t)D * 512, 512, 0, 0, nullptr)
        { constexpr int C_M13 = 16 * 112, C_M2 = 56 * 16;
          if (r < NEXP * C_M13) { const int e = r / C_M13, q = r % C_M13; transpose_item_f8<1>(a.in[I_MW13] + (size_t)e * D * 2 * FFE, 2 * FFE, ws + WS_W_M13 + (size_t)e * 2 * FFE * D, D, scr, q / 112, q % 112, F.lane, FFE, MOE_W13_SCALE); continue; } r -= NEXP * C_M13;
          { const int e = r / C_M2, q = r % C_M2; transpose_item_f8<0>(a.in[I_MW2] + (size_t)e * FFE * D, D, ws + WS_W_M2 + (size_t)e * D * FFE, FFE, scr, q / 16, q % 16, F.lane, 0, MOE_W2_SCALE); } }
    }
}
__device__ __forceinline__ void p0_prologue(const Frame& F, const Args& a) {
    const int gw = F.bid * NWAVES + F.wave, NGW = F.G * NWAVES;
    unsigned char* ws = F.ws;
    convert_range(F, a, gw, NGW, 0, CONV_A);
    for (int i = F.bid * NTHR + F.tid; i < 2 * 224 * 128; i += F.G * NTHR) { const int w = i / (224 * 128), q = i % (224 * 128);
        bf16* base = w == 0 ? (bf16*)(ws + WS_W_EVIN) + (size_t)4640 * D : (bf16*)(ws + WS_W_ODIN) + (size_t)5152 * D; *(GAS v4u*)(base + (size_t)q * 8) = (v4u){0u, 0u, 0u, 0u}; }
    phase_rmsnorm(F, a.in[I_X], a.in[I_NMIX], (bf16*)(ws + WS_XN), M);
    phase_rmsnorm(F, a.in[I_MEM], a.in[I_NMEM], (bf16*)(ws + WS_MEMN), MMEM);
    phase_rmsnorm(F, a.in[I_MEM], a.in[I_NMEM] + D, (bf16*)(ws + WS_MEMN) + (size_t)MMEM * D, MMEM);
    for (int i = F.bid * NTHR + F.tid; i < 512 * 128; i += F.G * NTHR) { const int n = i >> 7, j = i & 127; ((bf16*)(ws + WS_OV))[i] = (n <= 510 && n >= 4 * j - 1 && n <= 4 * j + 3) ? (bf16)0x3F80 : (bf16)0; }
    for (int it = gw; it < 128; it += NGW) { const int mm = it >> 6, ic = it & 63; const float* w1 = a.in[mm ? I_CVW1 : I_CKW1]; const float* pos = a.in[I_CMPPOS];
        f32x4 acc = {0.f, 0.f, 0.f, 0.f};
        for (int rr = 0; rr < 64; ++rr) { const int i = ic * 64 + rr; const float p = pos[i]; const f32x4 w = *(const GAS f32x4*)(w1 + (size_t)i * 256 + 4 * F.lane); acc += w * p; }
        *(GAS f32x4*)((float*)(ws + WS_CMPB_PART) + (size_t)(mm * 64 + ic) * 256 + 4 * F.lane) = acc; }
}
#undef TR_MAT
namespace att {
constexpr float SCALE = 0.08838834764831845f;
constexpr float THR = 8.f;
constexpr int KVBLK = 64, DH = 128;
constexpr int SHM_V = KVBLK * DH * 2, SHM_K = KVBLK * DH * 2;
constexpr int NSLOT = 3;
constexpr int LDS_ATT = NSLOT * SHM_V + NSLOT * SHM_K + NWAVES * 64 * 4;
#define KSWZ(row, colB) ((row) * 256 + ((colB) ^ (((row) & 7) << 4)))
__device__ __forceinline__ int v_st(int k, int c) { const int kk = (k & ~0xC) | ((k & 4) << 1) | ((k & 8) >> 1); return ((kk >> 3) * 4 + (c >> 5)) * 512 + ((kk & 7) * 32 + (c & 31)) * 2; }
__device__ __forceinline__ int v_rd_base(int lane) { return ((lane & 3) << 3) | (((lane >> 2) & 3) << 6) | (((lane >> 4) & 1) << 5) | (((lane >> 5) & 1) << 8); }
constexpr int v_rd_off(int d0, int ks, int half) { return d0 * 512 + ks * 4096 + half * 2048; }
__device__ __forceinline__ int crow(int r, int hi) { return (r & 3) + 8 * (r >> 2) + 4 * hi; }
__device__ __forceinline__ bf16x8 pack8(f32x4 a, f32x4 b) { v4u w = {cvtpk(a[0], a[1]), cvtpk(a[2], a[3]), cvtpk(b[0], b[1]), cvtpk(b[2], b[3])}; return *reinterpret_cast<bf16x8*>(&w); }

__device__ __forceinline__ void mask_tile(f32x16& p0, f32x16& p1, int dq, unsigned W) {
    asm volatile("" : "+v"(dq));
    const float NEG = -__builtin_inff();
#pragma unroll
    for (int r = 0; r < 16; ++r) { const int c = (r & 3) + 8 * (r >> 2);
        if ((unsigned)(dq - c) >= W) p0[r] = NEG;
        if ((unsigned)(dq - c - 32) >= W) p1[r] = NEG; }
}
__device__ __forceinline__ void mask_all(f32x16& p0, f32x16& p1) { const float NEG = -__builtin_inff();
#pragma unroll
    for (int r = 0; r < 16; ++r) { p0[r] = NEG; p1[r] = NEG; } }
__device__ __forceinline__ void partialSM(f32x16& p0, f32x16& p1, float& m_reg, float& mn, float& alpha, bool keep = true) {
    float pmax = p0[0];
#pragma unroll
    for (int r = 1; r < 16; ++r) pmax = fmaxf(pmax, p0[r]);
#pragma unroll
    for (int r = 0; r < 16; ++r) pmax = fmaxf(pmax, p1[r]);
    pmax = keep ? pmax : -__builtin_inff();
    { auto rr = __builtin_amdgcn_permlane32_swap(__float_as_uint(pmax), __float_as_uint(pmax), false, false);
      pmax = fmaxf(__uint_as_float(rr[0]), __uint_as_float(rr[1])); }
    constexpr float C2 = 1.4426950408889634f * SCALE;
    if (__builtin_expect(__all((pmax - m_reg) * SCALE <= THR), 1)) { mn = m_reg; alpha = 1.f; }
    else { mn = fmaxf(m_reg, pmax); alpha = __builtin_amdgcn_exp2f((m_reg - mn) * C2); m_reg = mn; }
    const float mnL = keep ? -mn * C2 : -__builtin_inff();
#pragma unroll
    for (int r = 0; r < 16; ++r) p0[r] = fmaf(p0[r], C2, mnL);
#pragma unroll
    for (int r = 0; r < 16; ++r) p1[r] = fmaf(p1[r], C2, mnL);
#pragma unroll
    for (int r = 0; r < 16; ++r) p0[r] = __builtin_amdgcn_exp2f(p0[r]);
}
__device__ __forceinline__ void finishSM(f32x16& p0, f32x16& p1, float alpha, float& l_reg, bf16x8& pa0, bf16x8& pa1, bf16x8& pa2, bf16x8& pa3) {
#pragma unroll
    for (int r = 0; r < 16; ++r) p1[r] = __builtin_amdgcn_exp2f(p1[r]);
    float ps = 0;
#pragma unroll
    for (int r = 0; r < 16; ++r) ps += p0[r];
#pragma unroll
    for (int r = 0; r < 16; ++r) ps += p1[r];
    { auto rr = __builtin_amdgcn_permlane32_swap(__float_as_uint(ps), __float_as_uint(ps), false, false);
      ps = __uint_as_float(rr[0]) + __uint_as_float(rr[1]); }
    l_reg = l_reg * alpha + ps;
#define PK4(P, B_, OUT) do { unsigned a0 = cvtpk(P[B_+0], P[B_+1]), a1 = cvtpk(P[B_+2], P[B_+3]);                          \
        unsigned b0 = cvtpk(P[B_+4], P[B_+5]), b1 = cvtpk(P[B_+6], P[B_+7]);                                             \
        auto r0 = __builtin_amdgcn_permlane32_swap(a0, b0, false, false); auto r1 = __builtin_amdgcn_permlane32_swap(a1, b1, false, false); \
        v4u w = {r0[0], r1[0], r0[1], r1[1]}; OUT = *reinterpret_cast<bf16x8*>(&w); } while (0)
    PK4(p0, 0, pa0); PK4(p0, 8, pa1); PK4(p1, 0, pa2); PK4(p1, 8, pa3);
#undef PK4
}
__device__ __forceinline__ void qkt(f32x16& p0, f32x16& p1, const char* Kslot, int r32, int hi, const bf16x8* qr) {
    p0 = f32x16{}; p1 = f32x16{};
    const char* kb[4];
#pragma unroll
    for (int dd = 0; dd < 4; ++dd) kb[dd] = Kslot + KSWZ(r32, (dd * 16 + hi * 8) * 2);
    bf16x8 fa[4], fb[4];
#define KLD(dst, i, d0) do { const char* a_ = kb[(d0) & 3] + ((d0) >> 2) * 128; dst[i] = *reinterpret_cast<const bf16x8*>(a_); dst[i + 1] = *reinterpret_cast<const bf16x8*>(a_ + 32 * 256); } while (0)
#define KMM(src, i, d0) do { p0 = __builtin_amdgcn_mfma_f32_32x32x16_bf16(src[i], qr[d0], p0, 0, 0, 0); p1 = __builtin_amdgcn_mfma_f32_32x32x16_bf16(src[i + 1], qr[d0], p1, 0, 0, 0); } while (0)
    KLD(fa, 0, 0); KLD(fa, 2, 1); KLD(fb, 0, 2); KLD(fb, 2, 3); SBAR();
    KMM(fa, 0, 0); KMM(fa, 2, 1); SBAR(); KLD(fa, 0, 4); KLD(fa, 2, 5); SBAR();
    KMM(fb, 0, 2); KMM(fb, 2, 3); SBAR(); KLD(fb, 0, 6); KLD(fb, 2, 7); SBAR();
    KMM(fa, 0, 4); KMM(fa, 2, 5); SBAR();
    KMM(fb, 0, 6); KMM(fb, 2, 7);
#undef KLD
#undef KMM
}
__device__ __forceinline__ void pv_tile(f32x16* o, int vbs, bf16x8 pa0, bf16x8 pa1, bf16x8 pa2, bf16x8 pa3) {
#define TRRD(dst, off) asm volatile("ds_read_b64_tr_b16 %0, %1 offset:%2" : "=&v"(dst) : "v"(vbs), "i"(off) : "memory")
#define PV_D0(d0) do { s16x4 l0, l1, l2, l3, h0, h1, h2, h3; constexpr int b_ = v_rd_off(d0, 0, 0); \
        TRRD(l0, b_); TRRD(h0, b_ + 2048); TRRD(l1, b_ + 4096); TRRD(h1, b_ + 6144); TRRD(l2, b_ + 8192); TRRD(h2, b_ + 10240); TRRD(l3, b_ + 12288); TRRD(h3, b_ + 14336); \
        asm volatile("s_waitcnt lgkmcnt(0)" ::: "memory"); SBAR();   \
        o[d0] = __builtin_amdgcn_mfma_f32_32x32x16_bf16(pa0, (bf16x8){l0[0], l0[1], l0[2], l0[3], h0[0], h0[1], h0[2], h0[3]}, o[d0], 0, 0, 0);   \
        o[d0] = __builtin_amdgcn_mfma_f32_32x32x16_bf16(pa1, (bf16x8){l1[0], l1[1], l1[2], l1[3], h1[0], h1[1], h1[2], h1[3]}, o[d0], 0, 0, 0);   \
        o[d0] = __builtin_amdgcn_mfma_f32_32x32x16_bf16(pa2, (bf16x8){l2[0], l2[1], l2[2], l2[3], h2[0], h2[1], h2[2], h2[3]}, o[d0], 0, 0, 0);   \
        o[d0] = __builtin_amdgcn_mfma_f32_32x32x16_bf16(pa3, (bf16x8){l3[0], l3[1], l3[2], l3[3], h3[0], h3[1], h3[2], h3[3]}, o[d0], 0, 0, 0); } while (0)
    PV_D0(0); PV_D0(1); PV_D0(2); PV_D0(3);
#undef PV_D0
#undef TRRD
}
__device__ __forceinline__ void q_issue(const bf16* qrow, int hi, v4u (&raw)[8]) {
#pragma unroll
    for (int d0 = 0; d0 < 8; ++d0) raw[d0] = *(const GAS v4u*)(qrow + d0 * 16 + hi * 8);
}
__device__ __forceinline__ void q_finish(const v4u (&raw)[8], const float* g, int hi, bf16x8* qr) {
    float ss = 0.f;
#pragma unroll
    for (int d0 = 0; d0 < 8; ++d0)
#pragma unroll
        for (int j = 0; j < 4; ++j) { const float a = bflo(raw[d0][j]), b = bfhi(raw[d0][j]); ss += a * a + b * b; }
    ss += __shfl_xor(ss, 32);
    const float rstd = 1.f / sqrtf(ss * (1.f / 128.f) + EPS);
#pragma unroll
    for (int d0 = 0; d0 < 8; ++d0) { const f32x4 g0 = *(const GAS f32x4*)(g + d0 * 16 + hi * 8), g1 = *(const GAS f32x4*)(g + d0 * 16 + hi * 8 + 4);
        v4u w; w.x = cvtpk(bflo(raw[d0][0]) * rstd * g0[0], bfhi(raw[d0][0]) * rstd * g0[1]); w.y = cvtpk(bflo(raw[d0][1]) * rstd * g0[2], bfhi(raw[d0][1]) * rstd * g0[3]);
        w.z = cvtpk(bflo(raw[d0][2]) * rstd * g1[0], bfhi(raw[d0][2]) * rstd * g1[1]); w.w = cvtpk(bflo(raw[d0][3]) * rstd * g1[2], bfhi(raw[d0][3]) * rstd * g1[3]);
        qr[d0] = *reinterpret_cast<bf16x8*>(&w); }
}
__device__ __forceinline__ void load_q(const bf16* qrow, const float* g, int hi, bf16x8* qr) { v4u raw[8]; q_issue(qrow, hi, raw); q_finish(raw, g, hi, qr); }
struct PassIO { const bf16* Kp; int ldk; const bf16* Vp; int ldv; int t_lo, t_hi; };
__device__ __forceinline__ void dma_offsets(int wid, int lane, int ldk, int ldv, unsigned& koff, unsigned& voff) {
    const int row = 4 * wid + (lane >> 4); koff = (unsigned)(row * ldk * 2 + (((lane & 15) ^ (row & 7)) << 4));
    const int st = 2 * wid + (lane >> 5), kk = ((st >> 2) << 3) | ((lane & 31) >> 2), k = (kk & ~0xC) | ((kk & 4) << 1) | ((kk & 8) >> 1); voff = (unsigned)(k * ldv * 2 + ((st & 3) * 32 + 8 * (lane & 3)) * 2);
}
#define ATT_DMA(io_, t, slot) do { const char* kt_ = (const char*)(io_).Kp + (size_t)(t) * (KVBLK * 2) * (io_).ldk; const char* vt_ = (const char*)(io_).Vp + (size_t)(t) * (KVBLK * 2) * (io_).ldv;          \
        LAS unsigned* kd_ = (LAS unsigned*)(ldsl + NSLOT * SHM_V + (slot) * SHM_K + wid * 1024); LAS unsigned* vd_ = (LAS unsigned*)(ldsl + (slot) * SHM_V + wid * 1024);                \
        __builtin_amdgcn_global_load_lds((const unsigned*)(kt_ + koff), kd_, 16, 0, 0); __builtin_amdgcn_global_load_lds((const unsigned*)(kt_ + koff + (size_t)64 * (io_).ldk), kd_ + 2048, 16, 0, 0); \
        __builtin_amdgcn_global_load_lds((const unsigned*)(vt_ + voff), vd_, 16, 0, 0); __builtin_amdgcn_global_load_lds((const unsigned*)(vt_ + voff + (size_t)64 * (io_).ldv), vd_ + 2048, 16, 0, 0); } while (0)
__device__ __forceinline__ void attn_prefetch(char* lds, const PassIO& io) {
    int tid = threadIdx.x; asm volatile("" : "+v"(tid));
    const int wid = __builtin_amdgcn_readfirstlane(tid >> 6), lane = tid & 63;
    unsigned koff, voff; dma_offsets(wid, lane, io.ldk, io.ldv, koff, voff);
    LAS unsigned char* ldsl = (LAS unsigned char*)lds;
    ATT_DMA(io, io.t_lo, 0); if (io.t_hi - io.t_lo > 1) ATT_DMA(io, io.t_lo + 1, 1);
}
template <class MaskF>
__device__ __forceinline__ void attn_pass(char* lds, const bf16x8* qr, const PassIO& io, const MaskF& mf, f32x16 (&o)[4], float& l_out) {
    int tid = threadIdx.x; asm volatile("" : "+v"(tid));
    const int wid = __builtin_amdgcn_readfirstlane(tid >> 6), lane = tid & 63, r32 = lane & 31, hi = lane >> 5;
    char* V_lds = lds; char* K_lds = lds + NSLOT * SHM_V;
    float* wsc = (float*)(lds + NSLOT * SHM_V + NSLOT * SHM_K) + wid * 64; float* al_l = wsc + 32;
    float m_reg = -1e30f, l_reg = 0.f;
#pragma unroll
    for (int d = 0; d < 4; ++d) o[d] = f32x16{};
    const int vb0 = (int)(uintptr_t)V_lds + v_rd_base(lane);
    const int t_lo = io.t_lo, NT = io.t_hi - io.t_lo;
    unsigned koff, voff; dma_offsets(wid, lane, io.ldk, io.ldv, koff, voff);
    LAS unsigned char* ldsl = (LAS unsigned char*)lds;
    f32x16 p0, p1; float mn, alpha = 1.f; bf16x8 pa0, pa1, pa2, pa3;
#define A_RESC(a) do { if (__any((a) < 1.f)) { if (hi == 0) al_l[r32] = (a); asm volatile("s_waitcnt lgkmcnt(0)" ::: "memory"); \
        _Pragma("unroll") for (int d_ = 0; d_ < 4; ++d_) _Pragma("unroll") for (int r = 0; r < 16; ++r) o[d_][r] *= al_l[crow(r, hi)]; } } while (0)
#define A_BAR() do { asm volatile("" ::: "memory"); __builtin_amdgcn_s_barrier(); asm volatile("" ::: "memory"); } while (0)
    const bool lead = wid < 4;
    VM_WAIT();
    __syncthreads();
    if (!lead) A_BAR();
    int sK = 0, sV = 2, sW = 1;
    bool act_prev = false;
    for (int i = 0; i < NT; ++i) {
        if (lead && i >= 1 && i + 1 < NT) ATT_DMA(io, t_lo + i + 1, sW);
        const bool act = mf.active(t_lo + i);
        SBAR(); if (act) qkt(p0, p1, K_lds + sK * SHM_K, r32, hi, qr);
        if (i > 0 && act_prev) pv_tile(o, vb0 + sV * SHM_V, pa0, pa1, pa2, pa3);
        if (!lead && i + 1 < NT) VM_WAIT();
        A_BAR();
        if (!lead && i + 2 < NT) ATT_DMA(io, t_lo + i + 2, sV);
        if (act) { mf(p0, p1, t_lo + i); partialSM(p0, p1, m_reg, mn, alpha, mf.keep(t_lo + i)); A_RESC(alpha); finishSM(p0, p1, alpha, l_reg, pa0, pa1, pa2, pa3); }
        act_prev = act;
        if (lead && i + 1 < NT) VM_WAIT();
        A_BAR();
        { const int t_ = sV; sV = sK; sK = sW; sW = t_; }
    }
    if (act_prev) pv_tile(o, vb0 + sV * SHM_V, pa0, pa1, pa2, pa3);
    if (lead) A_BAR();
    __syncthreads();
#undef A_RESC
#undef A_BAR
    l_out = l_reg;
}
__device__ __forceinline__ void row_inv_l(char* lds, float l_reg, float (&rli)[16]) {
    const int tid = threadIdx.x, wid = __builtin_amdgcn_readfirstlane(tid >> 6), lane = tid & 63, r32 = lane & 31, hi = lane >> 5;
    float* wsc = (float*)(lds + NSLOT * SHM_V + NSLOT * SHM_K) + wid * 64;
    if (hi == 0) wsc[r32] = l_reg;
    asm volatile("s_waitcnt lgkmcnt(0)" ::: "memory");
#pragma unroll
    for (int r = 0; r < 16; ++r) { const float l = wsc[crow(r, hi)]; rli[r] = l > 0.f ? __builtin_amdgcn_rcpf(l) : 0.f; }
    asm volatile("s_waitcnt lgkmcnt(0)" ::: "memory");
}
struct NoMask { __device__ __forceinline__ void operator()(f32x16&, f32x16&, int) const {} __device__ __forceinline__ bool active(int) const { return true; } __device__ __forceinline__ bool keep(int) const { return true; } };
}
__device__ __forceinline__ void norm128_rows(const Frame& F, const bf16* src, size_t lds_, bf16* dst, size_t ldd, int nrows, const float* g, int gw, int NGW) {
    const int sub = F.lane >> 4, l16 = F.lane & 15;
    const f32x4 g0 = *(const GAS f32x4*)(g + l16 * 8), g1 = *(const GAS f32x4*)(g + l16 * 8 + 4);
    for (int r0 = gw * 4; r0 < nrows; r0 += NGW * 4) { const int r = r0 + sub;
        const v4u raw = *(const GAS v4u*)(src + (size_t)r * lds_ + l16 * 8);
        float ss = 0.f;
#pragma unroll
        for (int j = 0; j < 4; ++j) { const float a = bflo(raw[j]), b = bfhi(raw[j]); ss += a * a + b * b; }
        ss += __shfl_xor(ss, 1); ss += __shfl_xor(ss, 2); ss += __shfl_xor(ss, 4); ss += __shfl_xor(ss, 8);
        const float rstd = 1.f / sqrtf(ss * (1.f / 128.f) + EPS);
        v4u w; w.x = cvtpk(bflo(raw[0]) * rstd * g0[0], bfhi(raw[0]) * rstd * g0[1]); w.y = cvtpk(bflo(raw[1]) * rstd * g0[2], bfhi(raw[1]) * rstd * g0[3]);
        w.z = cvtpk(bflo(raw[2]) * rstd * g1[0], bfhi(raw[2]) * rstd * g1[1]); w.w = cvtpk(bflo(raw[3]) * rstd * g1[2], bfhi(raw[3]) * rstd * g1[3]);
        *(GAS v4u*)(dst + (size_t)r * ldd + l16 * 8) = w; }
}
__device__ __forceinline__ void phase_memk_norm(const Frame& F, const Args& a, int l, int gw, int NGW) {
    const bf16* kvm = (const bf16*)(F.ws + WS_KVM) + (size_t)l * MMEM * 1024; bf16* km = (bf16*)(F.ws + WS_KM) + (size_t)l * MMEM * 512;
    for (int bh = 0; bh < BATCH * XH; ++bh) { const int b = bh >> 2, h = bh & 3;
        norm128_rows(F, kvm + (size_t)b * MEMLEN * 1024 + h * 128, 1024, km + (size_t)bh * MEMLEN * 128, 128, MEMLEN, a.in[I_XKN] + l * 128, gw, NGW); }
}

__device__ __forceinline__ void phase_cross_attn(const Frame& F, const Args& a, int l) {
    char* lds = (char*)F.lds; const int r32 = F.lane & 31, hi = F.lane >> 5;
    const bf16* QX = (const bf16*)(F.ws + WS_QX); bf16* OX = (bf16*)(F.ws + WS_OX);
    for (int u = F.bid; u < BATCH * XH * (SEQ / 256); u += F.G) {
        const int tb = u % (SEQ / 256), bh = u / (SEQ / 256), b = bh >> 2, h = bh & 3;
        const size_t row0 = (size_t)b * SEQ + tb * 256 + F.wave * 32;
        const bf16* Kp = (const bf16*)(F.ws + WS_KM) + (size_t)l * MMEM * 512 + (size_t)bh * MEMLEN * 128;
        const bf16* Vp = (const bf16*)(F.ws + WS_KVM) + (size_t)l * MMEM * 1024 + (size_t)b * MEMLEN * 1024 + 512 + h * 128;
        const att::PassIO io{Kp, 128, Vp, 1024, 0, MEMLEN / 64}; att::attn_prefetch(lds, io);
        bf16x8 qr[8]; att::load_q(QX + (row0 + r32) * 512 + h * 128, a.in[I_XQN] + l * 128, hi, qr);
        f32x16 o[4]; float l_reg; att::attn_pass(lds, qr, io, att::NoMask{}, o, l_reg);
        float rli[16]; att::row_inv_l(lds, l_reg, rli);
#pragma unroll
        for (int r = 0; r < 16; ++r) { bf16* orow = OX + (row0 + att::crow(r, hi)) * 512 + h * 128;
#pragma unroll
            for (int d0 = 0; d0 < 4; ++d0) { const float v = o[d0][r] * rli[r]; const float vn = __shfl_xor(v, 1);
                if ((r32 & 1) == 0) *(GAS unsigned*)(orow + d0 * 32 + r32) = cvtpk(v, vn); } }
    }
}

constexpr int NSA_GSC = att::LDS_ATT, NSA_IMP = NSA_GSC + NWAVES * 32 * 3 * 4, NSA_SEL = NSA_IMP + NWAVES * 8 * 128 * 4, NSA_SELU = NSA_SEL + 64 * 4 * 4, NSA_LDS_END = NSA_SELU + NWAVES * 4 * 4;
static_assert(NSA_LDS_END <= SCR_BYTES, "nsa lds");
struct CmpMask { int nmax, hi, nmin_wave;
    __device__ __forceinline__ void operator()(f32x16& p0, f32x16& p1, int t) const { if (t * 64 + 63 <= nmin_wave) return; att::mask_tile(p0, p1, nmax - t * 64 - 4 * hi, 0x40000000u); }
    __device__ __forceinline__ bool active(int) const { return true; } __device__ __forceinline__ bool keep(int) const { return true; } };
struct WinMask { int P, hi, qb;
    __device__ __forceinline__ void operator()(f32x16& p0, f32x16& p1, int t) const { if (t == qb || t == qb - 8) att::mask_tile(p0, p1, P - t * 64 - 4 * hi, 512u); }
    __device__ __forceinline__ bool active(int) const { return true; } __device__ __forceinline__ bool keep(int) const { return true; } };
struct SlcMask { const LAS unsigned* selw; const LAS unsigned* uni; int P, hi, qb;
    __device__ __forceinline__ void operator()(f32x16& p0, f32x16& p1, int t) const { if (t == qb) att::mask_tile(p0, p1, P - t * 64 - 4 * hi, 0x40000000u); }
    __device__ __forceinline__ bool keep(int t) const { return (selw[t >> 5] >> (t & 31)) & 1u; }
    __device__ __forceinline__ bool active(int t) const { return (__builtin_amdgcn_readfirstlane(uni[t >> 5]) >> (t & 31)) & 1u; } };

__device__ __forceinline__ void nsa_unit(const Frame& F, const Args& a, int b, int g, int qb, int dry = 0) {
    char* lds = (char*)F.lds; const int w = F.wave; const int t0 = qb * 64;
#define NSA_LANE() int lane = F.lane; asm volatile("" : "+v"(lane)); const int r32 = lane & 31, hi = lane >> 5; const int tok = 8 * w + (r32 >> 2), head = 4 * g + (r32 & 3), P = t0 + tok; (void)head; (void)P; (void)tok
    unsigned char* wsl = F.ws; asm volatile("" : "+s"(wsl));
    const bf16* Y0 = (const bf16*)(wsl + WS_Y0); const bf16* KV6 = (const bf16*)(wsl + WS_KV6);
    const size_t slab = (size_t)SEQ * 128, bg = (size_t)(b * 2 + g);
    LAS float* gsc = (LAS float*)(F.lds + NSA_GSC) + w * 96; LAS float* imp = (LAS float*)(F.lds + NSA_IMP) + w * 1024; LAS unsigned* selm = (LAS unsigned*)(F.lds + NSA_SEL);
    { NSA_LANE();
      if (hi == 0) {
#pragma unroll
        for (int br = 0; br < 3; ++br) gsc[r32 * 3 + br] = fsigmoid(bf2f(Y0[((size_t)b * SEQ + P) * EV_INP + 4608 + head * 3 + br]) + a.in[I_GATEB][head * 3 + br]); }
      LDS_WAIT(); }
    f32x16 o[4]; float l_reg; float rli[16];
    const bf16* KCMP = (const bf16*)(wsl + WS_KVCMP) + bg * 512 * 128; const bf16* VCMP = (const bf16*)(wsl + WS_KVCMP) + (size_t)2048 * 128 + bg * 512 * 128;
    const int ncmp_t = ((4 * qb + 2) >> 6) + 1;
    const att::PassIO io_imp{KCMP, 128, (const bf16*)(wsl + WS_OV), 128, 0, ncmp_t}, io_cmp{KCMP, 128, VCMP, 128, 0, ncmp_t},
                      io_slc{KV6 + (2 * 4 + bg) * slab, 128, KV6 + (3 * 4 + bg) * slab, 128, 0, qb + 1}, io_win{KV6 + (4 * 4 + bg) * slab, 128, KV6 + (5 * 4 + bg) * slab, 128, qb >= 8 ? qb - 8 : 0, qb + 1};
    v4u qraw[8];
#define NSA_QISSUE() do { NSA_LANE(); att::q_issue(Y0 + ((size_t)b * SEQ + P) * EV_INP + 2048 + head * 128, hi, qraw); } while (0)
    att::attn_prefetch(lds, io_imp); NSA_QISSUE();
    { NSA_LANE(); const CmpMask cm{(P - 31) >> 4, hi, (t0 + 8 * w - 31) >> 4};
      bf16x8 qr[8]; att::q_finish(qraw, a.in[I_QNORM], hi, qr);
      if (dry < 2) att::attn_pass(lds, qr, io_imp, cm, o, l_reg); else { VM_WAIT(); __syncthreads(); l_reg = 1.f; } }
    att::attn_prefetch(lds, io_cmp); NSA_QISSUE();
    if (dry < 3) {
    att::row_inv_l(lds, l_reg, rli);
    { NSA_LANE();
#pragma unroll
    for (int q = 0; q < 4; ++q)
#pragma unroll
        for (int d = 0; d < 4; ++d) { float s = 0.f;
#pragma unroll
            for (int i = 0; i < 4; ++i) s += o[d][4 * q + i] * rli[4 * q + i];
            imp[(2 * q + hi) * 128 + d * 32 + r32] = s; }
    LDS_WAIT();
    { const unsigned long long lt = (1ull << lane) - 1ull;
#pragma unroll 1
    for (int tg = 0; tg < 8; tg += 4) { unsigned k0[4], k1[4], T[4];
#pragma unroll
        for (int u = 0; u < 4; ++u) { const int tl = tg + u; const int j0 = lane, j1 = lane + 64; const float v0 = imp[tl * 128 + j0], v1 = imp[tl * 128 + j1];
          const float s0 = v0 + (((j0 == 0) || (j0 == qb) || (j0 == qb - 1)) ? 100.f : 0.f), s1 = v1 + (((j1 == 0) || (j1 == qb) || (j1 == qb - 1)) ? 100.f : 0.f);
          k0[u] = (j0 <= qb) ? __float_as_uint(s0) + 1u : 0u; k1[u] = (j1 <= qb) ? __float_as_uint(s1) + 1u : 0u; T[u] = 0u; }
#pragma unroll 1
        for (int bit = 30; bit >= 0; --bit) {
#pragma unroll
            for (int u = 0; u < 4; ++u) { const unsigned cand = T[u] | (1u << bit);
                const int cnt = __popcll(__ballot(k0[u] >= cand)) + __popcll(__ballot(k1[u] >= cand)); if (cnt >= 16) T[u] = cand; } }
#pragma unroll
        for (int u = 0; u < 4; ++u) { const int tl = tg + u;
        const unsigned long long g0 = __ballot(k0[u] > T[u]), g1 = __ballot(k1[u] > T[u]), e0 = __ballot(k0[u] == T[u]), e1 = __ballot(k1[u] == T[u]);
        const int need = 16 - (__popcll(g0) + __popcll(g1));
        const bool sel0 = (k0[u] > T[u]) || (k0[u] == T[u] && __popcll(e0 & lt) < need), sel1 = (k1[u] > T[u]) || (k1[u] == T[u] && __popcll(e0) + __popcll(e1 & lt) < need);
        const unsigned long long m0 = __ballot(sel0 && lane <= qb), m1 = __ballot(sel1 && lane + 64 <= qb);
        if (lane == 0) { LAS unsigned* sw = selm + (8 * w + tl) * 4; sw[0] = (unsigned)m0; sw[1] = (unsigned)(m0 >> 32); sw[2] = (unsigned)m1; sw[3] = (unsigned)(m1 >> 32); } } } }
    LDS_WAIT();
    if (lane < 4) { unsigned u = 0;
#pragma unroll
        for (int tl = 0; tl < 8; ++tl) u |= selm[(8 * w + tl) * 4 + lane];
        ((LAS unsigned*)(F.lds + NSA_SELU))[w * 4 + lane] = u; }
    LDS_WAIT(); }
    }
    { NSA_LANE(); const CmpMask cm{(P - 31) >> 4, hi, (t0 + 8 * w - 31) >> 4};
      bf16x8 qr[8]; att::q_finish(qraw, a.in[I_QNORM], hi, qr);
#if defined(MK_NSA_DUP) && MK_NSA_DUP == 2
      att::attn_pass(lds, qr, io_cmp, cm, o, l_reg); att::attn_prefetch(lds, io_cmp);
#endif
      if (dry < 2) att::attn_pass(lds, qr, io_cmp, cm, o, l_reg); else { VM_WAIT(); __syncthreads(); l_reg = 1.f; } }
    att::attn_prefetch(lds, io_slc); NSA_QISSUE();
    att::row_inv_l(lds, l_reg, rli);
    unsigned oacc[4][8];
    if (dry < 4) { NSA_LANE();
#pragma unroll
    for (int r = 0; r < 16; ++r) rli[r] *= gsc[att::crow(r, hi) * 3 + 0];
#pragma unroll
    for (int d = 0; d < 4; ++d)
#pragma unroll
        for (int r = 0; r < 16; r += 2) oacc[d][r >> 1] = cvtpk(o[d][r] * rli[r], o[d][r + 1] * rli[r + 1]); }
    { NSA_LANE(); const SlcMask sm{selm + tok * 4, (const LAS unsigned*)(F.lds + NSA_SELU) + w * 4, P, hi, qb};
      bf16x8 qr[8]; att::q_finish(qraw, a.in[I_QNORM], hi, qr);
#if defined(MK_NSA_DUP) && MK_NSA_DUP == 5
      { const size_t bg2 = (bg + 1) & 3; const att::PassIO io_cold{KV6 + (2 * 4 + bg2) * slab, 128, KV6 + (3 * 4 + bg2) * slab, 128, 0, qb + 1};
        att::attn_pass(lds, qr, io_cold, sm, o, l_reg); att::attn_prefetch(lds, io_slc); }
#endif
#if defined(MK_NSA_DUP) && MK_NSA_DUP == 3
      att::attn_pass(lds, qr, io_slc, sm, o, l_reg); att::attn_prefetch(lds, io_slc);
#endif
      if (!dry) att::attn_pass(lds, qr, io_slc, sm, o, l_reg); else { VM_WAIT(); __syncthreads(); } }
    att::attn_prefetch(lds, io_win); NSA_QISSUE();
    att::row_inv_l(lds, l_reg, rli);
    if (dry < 4) { NSA_LANE();
#pragma unroll
    for (int r = 0; r < 16; ++r) rli[r] *= gsc[att::crow(r, hi) * 3 + 1];
#pragma unroll
    for (int d = 0; d < 4; ++d)
#pragma unroll
        for (int r = 0; r < 16; r += 2) oacc[d][r >> 1] = cvtpk(bflo(oacc[d][r >> 1]) + o[d][r] * rli[r], bfhi(oacc[d][r >> 1]) + o[d][r + 1] * rli[r + 1]); }
    { NSA_LANE(); const WinMask wm{P, hi, qb};
      bf16x8 qr[8]; att::q_finish(qraw, a.in[I_QNORM], hi, qr);
#if defined(MK_NSA_DUP) && MK_NSA_DUP == 4
      att::attn_pass(lds, qr, io_win, wm, o, l_reg); att::attn_prefetch(lds, io_win);
#endif
      if (dry < 2) att::attn_pass(lds, qr, io_win, wm, o, l_reg); else { VM_WAIT(); __syncthreads(); l_reg = 1.f; } }
    att::row_inv_l(lds, l_reg, rli);
    if (dry < 4) { NSA_LANE();
    bf16* MIX = dry ? (bf16*)(wsl + WS_R + 400 * MiB) : (bf16*)(wsl + WS_MIX);
#pragma unroll
    for (int r = 0; r < 16; ++r) rli[r] *= gsc[att::crow(r, hi) * 3 + 2];
    bf16* obase = MIX + ((size_t)b * SEQ + t0 + 8 * w) * 2048 + 1024 + 4 * g * 128 + r32;
#pragma unroll
    for (int d0 = 0; d0 < 4; ++d0) {
#pragma unroll
        for (int r = 0; r < 16; ++r) { const int row = att::crow(r, hi); const float v = ((r & 1) ? bfhi(oacc[d0][r >> 1]) : bflo(oacc[d0][r >> 1])) + o[d0][r] * rli[r]; const float vn = __shfl_xor(v, 1);
            if ((r32 & 1) == 0) *(GAS unsigned*)(obase + (size_t)(row >> 2) * 2048 + (row & 3) * 128 + d0 * 32) = cvtpk(v, vn); }
        } }
    __syncthreads();
#undef NSA_QISSUE
#undef NSA_LANE
}
__device__ __forceinline__ void phase_nsa(const Frame& F, const Args& a) {
#pragma unroll 1
    for (int it = F.bid * 2; it < 512; it += F.G * 2)
#pragma unroll 1
        for (int k = 0; k < 2; ++k) { const int p = it >> 1, xcd = p & 7, bg = xcd >> 1, x = (xcd & 1) * 32 + (p >> 3);
#if defined(MK_NSA_DRY)
            nsa_unit(F, a, bg >> 1, bg & 1, k == 0 ? 127 - x : x, MK_NSA_DRY);
#endif
            nsa_unit(F, a, bg >> 1, bg & 1, k == 0 ? 127 - x : x); }
}
__device__ __forceinline__ f32x4 mma16(const LAS bf16* A, int pa, const LAS bf16* B, int pb, int K, f32x4 acc, int fr, int fq) {
    for (int k0 = 0; k0 < K; k0 += 32) { const bf16x8 af = *(const LAS bf16x8*)(A + fr * pa + k0 + 8 * fq); const bf16x8 bfv = *(const LAS bf16x8*)(B + fr * pb + k0 + 8 * fq);
        acc = __builtin_amdgcn_mfma_f32_16x16x32_bf16(af, bfv, acc, 0, 0, 0); }
    return acc;
}

__device__ __forceinline__ f32x4 mma16r(const LAS bf16* Arow, const LAS bf16* Brow, int K, f32x4 acc, int fq) {
    for (int k0 = 0; k0 < K; k0 += 32) { const bf16x8 af = *(const LAS bf16x8*)(Arow + k0 + 8 * fq); const bf16x8 bfv = *(const LAS bf16x8*)(Brow + k0 + 8 * fq);
        acc = __builtin_amdgcn_mfma_f32_16x16x32_bf16(af, bfv, acc, 0, 0, 0); }
    return acc;
}

__device__ __forceinline__ void phase_cmp2(const Frame& F, const Args& a, int u_lo, int u_hi, int u_step) {
    LAS bf16* hidS = (LAS bf16*)F.lds; LAS bf16* w2T = (LAS bf16*)(F.lds + 32 * 264 * 2); LAS float* outS = (LAS float*)(F.lds + 32 * 264 * 2 + 128 * 264 * 2);
    const int fr = F.lane & 15, fq = F.lane >> 4;
    for (int u = u_lo; u < u_hi; u += u_step) { const int mm = u >> 6, rb = u & 63;
        const bf16* hid = (const bf16*)(F.ws + WS_HID) + (size_t)mm * 2048 * 256 + (size_t)rb * 32 * 256; const float* w2 = a.in[mm ? I_CVW2 : I_CKW2];
        for (int i = F.tid; i < 32 * 32; i += NTHR) { const int r = i >> 5, c8 = i & 31; *(LAS v4u*)(hidS + r * 264 + c8 * 8) = *(const GAS v4u*)(hid + r * 256 + c8 * 8); }
        for (int i = F.tid; i < 256 * 128; i += NTHR) { const int k = i >> 7, c = i & 127; w2T[c * 264 + k] = (bf16)f2bf(w2[i]); }
        __syncthreads();
        const int rt = F.wave & 1;
#pragma unroll
        for (int cc = 0; cc < 2; ++cc) { const int ct = (F.wave >> 1) * 2 + cc; f32x4 acc = {0.f, 0.f, 0.f, 0.f};
            acc = mma16(hidS + rt * 16 * 264, 264, w2T + ct * 16 * 264, 264, 256, acc, fr, fq);
#pragma unroll
            for (int e = 0; e < 4; ++e) outS[(rt * 16 + 4 * fq + e) * 132 + ct * 16 + fr] = acc[e]; }
        __syncthreads();
        { const int r = F.wave * 4 + (F.lane >> 4), l16 = F.lane & 15; const int grow = rb * 32 + r, n = grow & 511;
          float v[8]; float ss = 0.f;
#pragma unroll
          for (int j = 0; j < 8; ++j) { v[j] = outS[r * 132 + l16 * 8 + j]; ss += v[j] * v[j]; }
          ss += __shfl_xor(ss, 1); ss += __shfl_xor(ss, 2); ss += __shfl_xor(ss, 4); ss += __shfl_xor(ss, 8);
          if (mm == 0) { const float rstd = 1.f / sqrtf(ss * (1.f / 128.f) + EPS); const float* g = a.in[I_KNORM];
#pragma unroll
              for (int j = 0; j < 8; ++j) v[j] = v[j] * rstd * g[l16 * 8 + j]; }
          if (n == 511) {
#pragma unroll
              for (int j = 0; j < 8; ++j) v[j] = 0.f; }
          v4u w; w.x = cvtpk(v[0], v[1]); w.y = cvtpk(v[2], v[3]); w.z = cvtpk(v[4], v[5]); w.w = cvtpk(v[6], v[7]);
          *(GAS v4u*)((bf16*)(F.ws + WS_KVCMP) + (size_t)mm * 2048 * 128 + (size_t)grow * 128 + l16 * 8) = w; }
        __syncthreads();
    }
}

__device__ __forceinline__ void rglru_unit(const Frame& F, const Args& a, int b, int h, int s) {
    const int w = F.wave, lane = F.lane, fr = lane & 15, fq = lane >> 4;
    LAS bf16* xcs = (LAS bf16*)F.lds + w * (16 * 136); LAS float* summ = (LAS float*)(F.lds + 8 * 16 * 136 * 2);
    const bf16* Y0 = (const bf16*)(F.ws + WS_Y0) + (size_t)b * SEQ * EV_INP; bf16* MIX = (bf16*)(F.ws + WS_MIX) + (size_t)b * SEQ * 2048;
    const int ch = h * 128 + s * 16 + fr;
    bf16x8 ba_f[4], bx_f[4];
    { const float* wa = a.in[I_RGWA] + (size_t)h * 128 * 128 + s * 16 + fr; const float* wx = a.in[I_RGWX] + (size_t)h * 128 * 128 + s * 16 + fr;
#pragma unroll
      for (int kk = 0; kk < 4; ++kk) { v4u ua, ux;
#pragma unroll
          for (int e2 = 0; e2 < 4; ++e2) { const int k = 32 * kk + 8 * fq + 2 * e2; ua[e2] = pk2(wa[(size_t)k * 128], wa[(size_t)(k + 1) * 128]); ux[e2] = pk2(wx[(size_t)k * 128], wx[(size_t)(k + 1) * 128]); }
          ba_f[kk] = *reinterpret_cast<bf16x8*>(&ua); bx_f[kk] = *reinterpret_cast<bf16x8*>(&ux); } }
    const float bias_a = a.in[I_RGBA][ch], bias_x = a.in[I_RGBX][ch], c8 = -8.f * fsoftplus(-a.in[I_RGLAM][ch]);
    const int cg = h * 128 + 2 * lane; float cw0[4], cw1[4];
#pragma unroll
    for (int j = 0; j < 4; ++j) { cw0[j] = a.in[I_RGCW][j * 1024 + cg]; cw1[j] = a.in[I_RGCW][j * 1024 + cg + 1]; }
    const float cb0 = a.in[I_RGCB][cg], cb1 = a.in[I_RGCB][cg + 1];
    float carry = 0.f;
    unsigned raw[19];
#define RG_LOAD(c_) do { const int T0_ = (c_) * 128 + 16 * w; _Pragma("unroll") for (int i = 0; i < 19; ++i) { const int t = T0_ - 3 + i; raw[i] = (t >= 0) ? *(const GAS unsigned*)(Y0 + (size_t)t * EV_INP + cg) : 0u; } } while (0)
    RG_LOAD(0);
#ifdef MK_DUP_RG
    for (int cc = 0; cc < 2 * (SEQ / 128); ++cc) { const int c = cc & (SEQ / 128 - 1); if (cc == SEQ / 128) { carry = 0.f; RG_LOAD(0); }
#else
    for (int c = 0; c < SEQ / 128; ++c) {
#endif
        const int T0 = c * 128 + 16 * w;
#pragma unroll
        for (int tt = 0; tt < 16; ++tt) { float y0 = cb0, y1 = cb1;
#pragma unroll
            for (int j = 0; j < 4; ++j) { y0 += cw0[j] * bflo(raw[tt + j]); y1 += cw1[j] * bfhi(raw[tt + j]); }
            *(LAS unsigned*)(xcs + tt * 136 + 2 * lane) = cvtpk(y0, y1); }
        LDS_WAIT();
        if (c + 1 < SEQ / 128) RG_LOAD(c + 1);
        unsigned short gg[4];
#pragma unroll
        for (int e = 0; e < 4; ++e) gg[e] = Y0[(size_t)(T0 + 4 * fq + e) * EV_INP + 1024 + ch];
        f32x4 acc_a = {0.f, 0.f, 0.f, 0.f}, acc_x = {0.f, 0.f, 0.f, 0.f};
#pragma unroll
        for (int kk = 0; kk < 4; ++kk) { const bf16x8 af = *(const LAS bf16x8*)(xcs + fr * 136 + 32 * kk + 8 * fq);
            acc_a = __builtin_amdgcn_mfma_f32_16x16x32_bf16(af, ba_f[kk], acc_a, 0, 0, 0); acc_x = __builtin_amdgcn_mfma_f32_16x16x32_bf16(af, bx_f[kk], acc_x, 0, 0, 0); }
        float hl[4], pl[4]; float hh = 0.f, pp = 1.f;
#pragma unroll
        for (int e = 0; e < 4; ++e) { const float xv = bf2f(xcs[(4 * fq + e) * 136 + s * 16 + fr]);
            const float r = fsigmoid(acc_a[e] + bias_a), ig = fsigmoid(acc_x[e] + bias_x); const float la = c8 * r; const float av = __expf(la);
            const float uu = __builtin_amdgcn_sqrtf((1.f - av) * (1.f + av)) * (ig * xv);
            hh = av * hh + uu; pp *= av; hl[e] = hh; pl[e] = pp; }
        float Apre = 1.f, Hpre = 0.f, Aw = 1.f, Hw = 0.f;
#pragma unroll
        for (int q = 0; q < 4; ++q) { const float Aq = __shfl(pp, fr + 16 * q), Hq = __shfl(hh, fr + 16 * q);
            if (q < fq) { Hpre = Aq * Hpre + Hq; Apre *= Aq; }
            Hw = Aq * Hw + Hq; Aw *= Aq; }
        LAS float* sm = summ + (c & 1) * 256;
        if (fq == 0) { sm[(w * 16 + fr) * 2] = Aw; sm[(w * 16 + fr) * 2 + 1] = Hw; }
        __syncthreads();
        float cin = carry, call = carry;
#pragma unroll
        for (int q = 0; q < 8; ++q) { const float Aq = sm[(q * 16 + fr) * 2], Hq = sm[(q * 16 + fr) * 2 + 1]; call = Aq * call + Hq; if (q < w) cin = call; }
        carry = call;
        const float cl = Apre * cin + Hpre;
#pragma unroll
        for (int e = 0; e < 4; ++e) { const float hv = hl[e] + pl[e] * cl; MIX[(size_t)(T0 + 4 * fq + e) * 2048 + ch] = (bf16)f2bf(gelu_tanh(bf2f(gg[e])) * hv); }
    }
#undef RG_LOAD
    __syncthreads();
}
constexpr size_t WS_M_CN = WS_R + 168 * MiB + 64 * MiB;
constexpr size_t WS_M_BN = WS_M_CN + 16 * MiB, WS_M_BT = WS_M_BN + 16 * MiB, WS_M_XT = WS_M_BT + 16 * MiB, WS_M_ACS = WS_M_XT + 64 * MiB, WS_M_DTV = WS_M_ACS + 2 * MiB,
                 WS_M_ST = WS_M_DTV + 2 * MiB, WS_M_PV = WS_M_ST + 128 * MiB, WS_M_END = WS_M_PV + 64 * MiB;
static_assert(WS_M_END <= WS_R + 560 * MiB, "mamba ws");
constexpr int MB_P = 136;
__device__ __forceinline__ void conv4_silu(const v4u (&rows)[7], const float* cw, int ldw, const float* cb, float (&out)[4][8]) {
    float wv[4][8], bv[8];
#pragma unroll
    for (int j = 0; j < 4; ++j) { const f32x4 w0 = *(const GAS f32x4*)(cw + (size_t)j * ldw), w1 = *(const GAS f32x4*)(cw + (size_t)j * ldw + 4);
#pragma unroll
        for (int i = 0; i < 4; ++i) { wv[j][i] = w0[i]; wv[j][4 + i] = w1[i]; } }
    { const f32x4 b0 = *(const GAS f32x4*)cb, b1 = *(const GAS f32x4*)(cb + 4);
#pragma unroll
      for (int i = 0; i < 4; ++i) { bv[i] = b0[i]; bv[4 + i] = b1[i]; } }
#pragma unroll
    for (int tt = 0; tt < 4; ++tt)
#pragma unroll
        for (int i2 = 0; i2 < 4; ++i2) { float y0 = bv[2 * i2], y1 = bv[2 * i2 + 1];
#pragma unroll
            for (int j = 0; j < 4; ++j) { y0 += wv[j][2 * i2] * bflo(rows[tt + j][i2]); y1 += wv[j][2 * i2 + 1] * bfhi(rows[tt + j][i2]); }
            out[tt][2 * i2] = fsilu(y0); out[tt][2 * i2 + 1] = fsilu(y1); }
}
__device__ __forceinline__ void od_dt_cols(const Frame& F, const bf16* X, const bf16* Wt, const float* ssq, bf16* Y1) {
    typedef float f32x16_t __attribute__((ext_vector_type(16)));
    int t_ = threadIdx.x; asm volatile("" : "+v"(t_));
    const int wave = __builtin_amdgcn_readfirstlane(t_ >> 6), lane = t_ & 63;
    const int r32 = lane & 31, hi = lane >> 5, kq = wave & 3;
    LAS float* red = (LAS float*)F.lds;
    for (int t0 = F.bid * 2; t0 < M / 32; t0 += F.G * 2) { const int r0 = (t0 + (wave >> 2)) * 32;
        const bf16* xa = X + (size_t)(r0 + r32) * D + 256 * kq + 8 * hi; const bf16* wb = Wt + (size_t)(5120 + r32) * D + 256 * kq + 8 * hi;
        f32x16_t acc;
#pragma unroll
        for (int r = 0; r < 16; ++r) acc[r] = 0.f;
        pg8::bf16x8 av[16], bv[16];
#pragma unroll
        for (int u = 0; u < 16; ++u) { av[u] = *(const GAS pg8::bf16x8*)(xa + 16 * u); bv[u] = *(const GAS pg8::bf16x8*)(wb + 16 * u); }
#pragma unroll
        for (int u = 0; u < 16; ++u) acc = __builtin_amdgcn_mfma_f32_32x32x16_bf16(av[u], bv[u], acc, 0, 0, 0);
        if (kq != 0) {
#pragma unroll
            for (int r = 0; r < 16; ++r) red[(wave * 16 + r) * 64 + lane] = acc[r]; }
        __syncthreads();
        if (kq == 0) { const float rs_l = pg8::row_rstd(ssq, r0 + r32);
#pragma unroll
            for (int r = 0; r < 16; ++r) { const int row = (r & 3) + 8 * (r >> 2) + 4 * hi; const float rs = __shfl(rs_l, row);
                const float v = (acc[r] + red[((wave + 1) * 16 + r) * 64 + lane]) + (red[((wave + 2) * 16 + r) * 64 + lane] + red[((wave + 3) * 16 + r) * 64 + lane]);
                Y1[(size_t)(r0 + row) * OD_INP + 5120 + r32] = (bf16)f2bf(v * rs); } }
        __syncthreads();
    }
}
__device__ __forceinline__ void phase_mamba_prep(const Frame& F, const Args& a) {
    LAS bf16* T = (LAS bf16*)F.lds;
    LAS float* acsS = (LAS float*)(F.lds + 128 * MB_P * 2); LAS float* dtS = acsS + 256;
    const int tid = F.tid, lane = F.lane, w = F.wave, sg = tid >> 4, cv = tid & 15;
    const float* cw = a.in[I_ODCW]; const float* cb = a.in[I_ODCB];
    v4u rows[7];
#define M0_LOAD(u_) do { const int bc_ = (u_) / 24, sl_ = (u_) % 24, T0_ = (bc_ & 63) * 128; const bf16* Y1_ = (const bf16*)(F.ws + WS_Y1) + (size_t)(bc_ >> 6) * SEQ * OD_INP; \
        _Pragma("unroll") for (int i = 0; i < 7; ++i) { const int t = T0_ + 4 * sg - 3 + i; rows[i] = (t >= 0) ? *(const GAS v4u*)(Y1_ + (size_t)t * OD_INP + 2048 + sl_ * 128 + cv * 8) : (v4u){0u, 0u, 0u, 0u}; } } while (0)
    if (F.bid < 128 * 24) M0_LOAD(F.bid);
    for (int u = F.bid; u < 128 * 24; u += F.G) { const int bc = u / 24, sl = u % 24, b = bc >> 6, c = bc & 63, T0 = c * 128;
        const bf16* Y1 = (const bf16*)(F.ws + WS_Y1) + (size_t)b * SEQ * OD_INP; const int ch0 = sl * 128;
        { float vals[4][8];
          conv4_silu(rows, cw + ch0 + cv * 8, 3072, cb + ch0 + cv * 8, vals);
          if (u + F.G < 128 * 24) M0_LOAD(u + F.G);
#pragma unroll
          for (int tt = 0; tt < 4; ++tt) { v4u o; o.x = cvtpk(vals[tt][0], vals[tt][1]); o.y = cvtpk(vals[tt][2], vals[tt][3]); o.z = cvtpk(vals[tt][4], vals[tt][5]); o.w = cvtpk(vals[tt][6], vals[tt][7]);
              *(LAS v4u*)(T + (4 * sg + tt) * MB_P + cv * 8) = o; } }
        if (sl < 16 && w < 2) { const int h = 2 * sl + w;
            const float Ah = -__expf(a.in[I_ALOG][h]), dtb = a.in[I_DTB][h];
            const float d0 = fsoftplus(bf2f(Y1[(size_t)(T0 + 2 * lane) * OD_INP + 5120 + h]) + dtb), d1 = fsoftplus(bf2f(Y1[(size_t)(T0 + 2 * lane + 1) * OD_INP + 5120 + h]) + dtb);
            const float a0 = d0 * Ah, a1 = d1 * Ah; float pr = a0 + a1;
#pragma unroll
            for (int off = 1; off < 64; off <<= 1) { const float t = __shfl_up(pr, off); if (lane >= off) pr += t; }
            const float ex = pr - (a0 + a1); const float c0 = ex + a0, c1 = ex + a0 + a1;
            acsS[w * 128 + 2 * lane] = c0; acsS[w * 128 + 2 * lane + 1] = c1; dtS[w * 128 + 2 * lane] = d0; dtS[w * 128 + 2 * lane + 1] = d1;
            float* ACS = (float*)(F.ws + WS_M_ACS) + ((size_t)bc * 32 + h) * 128; float* DTV = (float*)(F.ws + WS_M_DTV) + ((size_t)bc * 32 + h) * 128;
            typedef float f32x2v __attribute__((ext_vector_type(2))); *(GAS f32x2v*)(ACS + 2 * lane) = (f32x2v){c0, c1}; *(GAS f32x2v*)(DTV + 2 * lane) = (f32x2v){d0, d1}; }
        __syncthreads();
        if (sl < 16) {
            const int cc = tid >> 2, s0 = (tid & 3) * 32, hh = cc >> 6; bf16* XT = (bf16*)(F.ws + WS_M_XT) + (((size_t)bc * 32 + 2 * sl) * 64 + cc) * 128 + s0;
#pragma unroll
            for (int k8 = 0; k8 < 4; ++k8) { float v[8];
#pragma unroll
                for (int k = 0; k < 8; ++k) { const int s = s0 + 8 * k8 + k; v[k] = bf2f(T[s * MB_P + cc]) * dtS[hh * 128 + s]; }
                v4u o; o.x = cvtpk(v[0], v[1]); o.y = cvtpk(v[2], v[3]); o.z = cvtpk(v[4], v[5]); o.w = cvtpk(v[6], v[7]); *(GAS v4u*)(XT + 8 * k8) = o; } }
        else { const int g = (sl - 16) & 3; const bool isB = sl < 20;
            bf16* N = (bf16*)(F.ws + (isB ? WS_M_BN : WS_M_CN)) + ((size_t)b * SEQ + T0) * 512 + g * 128;
            for (int i = tid; i < 128 * 16; i += NTHR) { const int s = i >> 4, c8 = i & 15; *(GAS v4u*)(N + (size_t)s * 512 + c8 * 8) = *(const LAS v4u*)(T + s * MB_P + c8 * 8); }
            if (isB) { const int cc = tid >> 2, s0 = (tid & 3) * 32; bf16* BT = (bf16*)(F.ws + WS_M_BT) + (((size_t)bc * 4 + g) * 128 + cc) * 128 + s0;
#pragma unroll
                for (int k8 = 0; k8 < 4; ++k8) { unsigned short v[8];
#pragma unroll
                    for (int k = 0; k < 8; ++k) v[k] = T[(s0 + 8 * k8 + k) * MB_P + cc];
                    v4u o; o.x = v[0] | ((unsigned)v[1] << 16); o.y = v[2] | ((unsigned)v[3] << 16); o.z = v[4] | ((unsigned)v[5] << 16); o.w = v[6] | ((unsigned)v[7] << 16); *(GAS v4u*)(BT + 8 * k8) = o; } } }
        __syncthreads();
    }
#undef M0_LOAD
}
__device__ __forceinline__ void phase_mamba_states(const Frame& F) {
    LAS bf16* BTs = (LAS bf16*)F.lds; LAS bf16* XW = (LAS bf16*)(F.lds + 128 * MB_P * 2); LAS bf16* STs = (LAS bf16*)(F.lds + 192 * MB_P * 2);
    const int tid = F.tid, lane = F.lane, w = F.wave, fr = lane & 15, fq = lane >> 4;
    for (int u = F.bid; u < 128 * 4; u += F.G) { const int bc = u >> 2, g = u & 3;
        const bf16* BT = (const bf16*)(F.ws + WS_M_BT) + ((size_t)bc * 4 + g) * 128 * 128;
        for (int i = tid; i < 128 * 16; i += NTHR) { const int n = i >> 4, c8 = i & 15; *(LAS v4u*)(BTs + n * MB_P + c8 * 8) = *(const GAS v4u*)(BT + (size_t)n * 128 + c8 * 8); }
#pragma unroll 1
        for (int hh = 0; hh < 8; ++hh) { const int h = g * 8 + hh;
            const bf16* XT = (const bf16*)(F.ws + WS_M_XT) + ((size_t)bc * 32 + h) * 64 * 128; const float* ACS = (const float*)(F.ws + WS_M_ACS) + ((size_t)bc * 32 + h) * 128;
            const float aL = ACS[127];
#pragma unroll
            for (int k = 0; k < 2; ++k) { const int i = tid + k * NTHR, p = i >> 4, c8 = i & 15; const v4u raw = *(const GAS v4u*)(XT + (size_t)p * 128 + c8 * 8);
                const f32x4 a0 = *(const GAS f32x4*)(ACS + c8 * 8), a1 = *(const GAS f32x4*)(ACS + c8 * 8 + 4);
                v4u o; o.x = cvtpk(bflo(raw[0]) * __expf(aL - a0[0]), bfhi(raw[0]) * __expf(aL - a0[1])); o.y = cvtpk(bflo(raw[1]) * __expf(aL - a0[2]), bfhi(raw[1]) * __expf(aL - a0[3]));
                o.z = cvtpk(bflo(raw[2]) * __expf(aL - a1[0]), bfhi(raw[2]) * __expf(aL - a1[1])); o.w = cvtpk(bflo(raw[3]) * __expf(aL - a1[2]), bfhi(raw[3]) * __expf(aL - a1[3]));
                *(LAS v4u*)(XW + p * MB_P + c8 * 8) = o; }
            __syncthreads();
            bf16* ST = (bf16*)(F.ws + WS_M_ST) + ((size_t)bc * 32 + h) * 64 * 128;
#pragma unroll
            for (int pt = 0; pt < 4; ++pt) { f32x4 acc = {0.f, 0.f, 0.f, 0.f}; acc = mma16(XW + pt * 16 * MB_P, MB_P, BTs + w * 16 * MB_P, MB_P, 128, acc, fr, fq);
#pragma unroll
                for (int e = 0; e < 4; ++e) STs[(pt * 16 + 4 * fq + e) * MB_P + w * 16 + fr] = (bf16)f2bf(acc[e]); }
            __syncthreads();
#pragma unroll
            for (int k = 0; k < 2; ++k) { const int i = tid + k * NTHR, pp = i >> 4, c8 = i & 15; *(GAS v4u*)(ST + (size_t)pp * 128 + c8 * 8) = *(const LAS v4u*)(STs + pp * MB_P + c8 * 8); }
        }
    }
}
__device__ __forceinline__ void phase_mamba_scan(const Frame& F) {
    const int gt = F.bid * NTHR + F.tid;
    const bf16* STg = (const bf16*)(F.ws + WS_M_ST); bf16* PVg = (bf16*)(F.ws + WS_M_PV); const float* ACSg = (const float*)(F.ws + WS_M_ACS);
    for (int i = gt; i < BATCH * 32 * 64 * 32; i += F.G * NTHR) { const int n4 = i & 31, p = (i >> 5) & 63, h = (i >> 11) & 31, b = i >> 16;
        f32x4 S = {0.f, 0.f, 0.f, 0.f};
        const size_t off0 = (((size_t)b * 64 * 32 + h) * 64 + p) * 128 + n4 * 4, cstep = (size_t)32 * 64 * 128;
        const float* al = ACSg + ((size_t)b * 64 * 32 + h) * 128 + 127;
#pragma unroll 1
        for (int c0 = 0; c0 < 64; c0 += 16) {
            v2u sr[16]; float dl[16];
#pragma unroll
            for (int j = 0; j < 16; ++j) { sr[j] = *(const GAS v2u*)(STg + off0 + (size_t)(c0 + j) * cstep); dl[j] = al[(size_t)(c0 + j) * 32 * 128]; }
#pragma unroll
            for (int j = 0; j < 16; ++j) { const float dec = __expf(dl[j]); const f32x4 st = {bflo(sr[j].x), bfhi(sr[j].x), bflo(sr[j].y), bfhi(sr[j].y)};
                v2u o; o.x = cvtpk(S[0], S[1]); o.y = cvtpk(S[2], S[3]); *(GAS v2u*)(PVg + off0 + (size_t)(c0 + j) * cstep) = o;
                S = S * dec + st; } } }
}
constexpr int M3_CS = 0, M3_BS = M3_CS + 128 * MB_P * 2, M3_MS = M3_BS + 128 * MB_P * 2, M3_XT = M3_MS + 128 * MB_P * 2, M3_PV = M3_XT + 64 * MB_P * 2, M3_ACS = M3_PV + 64 * MB_P * 2, M3_DT = M3_ACS + 512, M3_END = M3_DT + 512;
static_assert(M3_END <= SCR_BYTES, "mamba lds");
__device__ __forceinline__ void phase_mamba_out(const Frame& F, const Args& a) {
    LAS bf16* Cs = (LAS bf16*)(F.lds + M3_CS); LAS bf16* Bs = (LAS bf16*)(F.lds + M3_BS); LAS bf16* Ms = (LAS bf16*)(F.lds + M3_MS); LAS bf16* XTs = (LAS bf16*)(F.lds + M3_XT); LAS bf16* PVs = (LAS bf16*)(F.lds + M3_PV);
    LAS float* acs = (LAS float*)(F.lds + M3_ACS); LAS float* dtv = (LAS float*)(F.lds + M3_DT);
    const int tid = F.tid, lane = F.lane, w = F.wave, fr = lane & 15, fq = lane >> 4;
    for (int u = F.bid; u < 128 * 4; u += F.G) { const int bc = u >> 2, g = u & 3, b = bc >> 6, T0 = (bc & 63) * 128;
        const bf16* CN = (const bf16*)(F.ws + WS_M_CN) + ((size_t)b * SEQ + T0) * 512 + g * 128; const bf16* BN = (const bf16*)(F.ws + WS_M_BN) + ((size_t)b * SEQ + T0) * 512 + g * 128;
        for (int i = tid; i < 128 * 16; i += NTHR) { const int s = i >> 4, c8 = i & 15;
            *(LAS v4u*)(Cs + s * MB_P + c8 * 8) = *(const GAS v4u*)(CN + (size_t)s * 512 + c8 * 8); *(LAS v4u*)(Bs + s * MB_P + c8 * 8) = *(const GAS v4u*)(BN + (size_t)s * 512 + c8 * 8); }
        __syncthreads();
        f32x4 cbt[8];
#pragma unroll
        for (int st = 0; st < 8; ++st) { cbt[st] = (f32x4){0.f, 0.f, 0.f, 0.f}; if (st <= w) cbt[st] = mma16(Bs + st * 16 * MB_P, MB_P, Cs + w * 16 * MB_P, MB_P, 128, cbt[st], fr, fq); }
        const bf16* Y1 = (const bf16*)(F.ws + WS_Y1) + ((size_t)b * SEQ + T0) * OD_INP; bf16* YG = (bf16*)(F.ws + WS_YG) + ((size_t)b * SEQ + T0) * 2048;
        v4u pfx[2], pfp[2]; float pfa = 0.f, pfd = 0.f;
#define M3_PREFETCH(hh_) do { const int h_ = g * 8 + (hh_); const bf16* XT_ = (const bf16*)(F.ws + WS_M_XT) + ((size_t)bc * 32 + h_) * 64 * 128; const bf16* PV_ = (const bf16*)(F.ws + WS_M_PV) + ((size_t)bc * 32 + h_) * 64 * 128; \
            _Pragma("unroll") for (int k = 0; k < 2; ++k) { const int i = tid + k * NTHR, p = i >> 4, c8 = i & 15; pfx[k] = *(const GAS v4u*)(XT_ + (size_t)p * 128 + c8 * 8); pfp[k] = *(const GAS v4u*)(PV_ + (size_t)p * 128 + c8 * 8); } \
            if (tid < 128) { pfa = ((const float*)(F.ws + WS_M_ACS))[((size_t)bc * 32 + h_) * 128 + tid]; pfd = ((const float*)(F.ws + WS_M_DTV))[((size_t)bc * 32 + h_) * 128 + tid]; } } while (0)
        M3_PREFETCH(0);
#pragma unroll 1
        for (int hh = 0; hh < 8; ++hh) { const int h = g * 8 + hh; const float dsk = a.in[I_DSKIP][h];
#pragma unroll
            for (int k = 0; k < 2; ++k) { const int i = tid + k * NTHR, p = i >> 4, c8 = i & 15; *(LAS v4u*)(XTs + p * MB_P + c8 * 8) = pfx[k]; *(LAS v4u*)(PVs + p * MB_P + c8 * 8) = pfp[k]; }
            if (tid < 128) { acs[tid] = pfa; dtv[tid] = pfd; }
            __syncthreads();
            if (hh + 1 < 8) M3_PREFETCH(hh + 1);
            v4u zz[2];
#pragma unroll
            for (int k = 0; k < 2; ++k) zz[k] = *(const GAS v4u*)(Y1 + (size_t)(16 * w + fr) * OD_INP + h * 64 + 16 * fq + 8 * k);
            const float aq = acs[16 * w + fr];
#pragma unroll
            for (int st = 0; st < 8; ++st) { if (st <= w) { float mv[4];
#pragma unroll
                for (int e = 0; e < 4; ++e) { const int s = 16 * st + 4 * fq + e; mv[e] = (s <= 16 * w + fr) ? cbt[st][e] * __expf(aq - acs[s]) : 0.f; }
                v2u o; o.x = cvtpk(mv[0], mv[1]); o.y = cvtpk(mv[2], mv[3]); *(LAS v2u*)(Ms + (16 * w + fr) * MB_P + 16 * st + 4 * fq) = o; } }
            if ((w & 1) == 0) *(LAS v2u*)(Ms + (16 * w + fr) * MB_P + 16 * (w + 1) + 4 * fq) = (v2u){0u, 0u};
            LDS_WAIT();
            float yv[16]; { const int q = 16 * w + fr; const float eq = __expf(acs[q]), rdt = dsk * __builtin_amdgcn_rcpf(dtv[q]); const int prow = 16 * (fr >> 2) + (fr & 3);
#pragma unroll
            for (int pt = 0; pt < 4; ++pt) { f32x4 yd = {0.f, 0.f, 0.f, 0.f}, yo = {0.f, 0.f, 0.f, 0.f};
                yd = mma16r(XTs + (prow + 4 * pt) * MB_P, Ms + q * MB_P, ((w + 2) >> 1) * 32, yd, fq);
                yo = mma16r(PVs + (prow + 4 * pt) * MB_P, Cs + q * MB_P, 128, yo, fq);
#pragma unroll
                for (int e = 0; e < 4; ++e) { const int pp = 16 * fq + 4 * pt + e; yv[4 * pt + e] = yd[e] + eq * yo[e] + rdt * bf2f(XTs[pp * MB_P + q]); } } }
#pragma unroll
            for (int k = 0; k < 2; ++k) { v4u o;
#pragma unroll
                for (int j = 0; j < 4; ++j) o[j] = cvtpk(yv[8 * k + 2 * j] * fsilu(bflo(zz[k][j])), yv[8 * k + 2 * j + 1] * fsilu(bfhi(zz[k][j])));
                *(GAS v4u*)(YG + (size_t)(16 * w + fr) * 2048 + h * 64 + 16 * fq + 8 * k) = o; }
            __syncthreads();
        }
#undef M3_PREFETCH
        VM_WAIT(); __syncthreads();
        { const float* gn = a.in[I_ODNORM] + g * 512 + lane * 8; const f32x4 g0 = *(const GAS f32x4*)gn, g1 = *(const GAS f32x4*)(gn + 4);
#pragma unroll 4
          for (int t = 0; t < 16; ++t) { bf16* pq = YG + (size_t)(16 * w + t) * 2048 + g * 512 + lane * 8; const v4u raw = *(const GAS v4u*)pq; float ss = 0.f;
#pragma unroll
              for (int j = 0; j < 4; ++j) { const float x0 = bflo(raw[j]), x1 = bfhi(raw[j]); ss += x0 * x0 + x1 * x1; }
              const float rstd = 1.f / sqrtf(wave_sum(ss) * (1.f / 512.f) + EPS);
              v4u o; o.x = cvtpk(bflo(raw[0]) * rstd * g0[0], bfhi(raw[0]) * rstd * g0[1]); o.y = cvtpk(bflo(raw[1]) * rstd * g0[2], bfhi(raw[1]) * rstd * g0[3]);
              o.z = cvtpk(bflo(raw[2]) * rstd * g1[0], bfhi(raw[2]) * rstd * g1[1]); o.w = cvtpk(bflo(raw[3]) * rstd * g1[2], bfhi(raw[3]) * rstd * g1[3]);
              *(GAS v4u*)pq = o; } }
    }
}
__device__ __forceinline__ void phase_group_norm(const Frame& F, const Args& a) {
    const int gw = F.bid * NWAVES + F.wave, NGW = F.G * NWAVES; bf16* YG = (bf16*)(F.ws + WS_YG); const float* g = a.in[I_ODNORM];
    for (int m = gw; m < M; m += NGW) {
#pragma unroll
        for (int gi = 0; gi < 4; ++gi) { bf16* p = YG + (size_t)m * 2048 + gi * 512 + F.lane * 8; const v4u raw = *(const GAS v4u*)p; float ss = 0.f;
#pragma unroll
            for (int j = 0; j < 4; ++j) { const float x0 = bflo(raw[j]), x1 = bfhi(raw[j]); ss += x0 * x0 + x1 * x1; }
            const float rstd = 1.f / sqrtf(wave_sum(ss) * (1.f / 512.f) + EPS);
            const f32x4 g0 = *(const GAS f32x4*)(g + gi * 512 + F.lane * 8), g1 = *(const GAS f32x4*)(g + gi * 512 + F.lane * 8 + 4);
            v4u o; o.x = cvtpk(bflo(raw[0]) * rstd * g0[0], bfhi(raw[0]) * rstd * g0[1]); o.y = cvtpk(bflo(raw[1]) * rstd * g0[2], bfhi(raw[1]) * rstd * g0[3]);
            o.z = cvtpk(bflo(raw[2]) * rstd * g1[0], bfhi(raw[2]) * rstd * g1[1]); o.w = cvtpk(bflo(raw[3]) * rstd * g1[2], bfhi(raw[3]) * rstd * g1[3]);
            *(GAS v4u*)p = o; }
    }
}
constexpr int MOE_TAB = 131072;
static_assert(MOE_TAB + (32 + MOE_TILES + 24) * 4 <= SCR_BYTES, "moe lds");
__device__ __forceinline__ void phase_route(const Frame& F, const Args& a, const bf16* X) {
    LAS int* cntS = (LAS int*)F.lds;
    if (F.tid < 8) cntS[F.tid] = 0;
    __syncthreads();
    const float* g = a.in[I_NFFN] + D; const float* router = a.in[I_ROUTER]; unsigned char* XN8 = F.ws + WS_XN8;
    int* tokE = (int*)(F.ws + WS_MOEIDX); float* tokW = (float*)(F.ws + WS_MOEIDX + 1 * MiB);
    const int per = M / F.G;
    for (int i = F.wave; i < per; i += NWAVES) { const int m = F.bid * per + i;
        const GAS v4u* xr = (const GAS v4u*)(X + (size_t)m * D) + F.lane;
        float v[2][8]; float s = 0.f;
#pragma unroll
        for (int k = 0; k < 2; ++k) { const v4u r = xr[64 * k];
#pragma unroll
            for (int j = 0; j < 4; ++j) { v[k][2 * j] = bflo(r[j]); v[k][2 * j + 1] = bfhi(r[j]); s += v[k][2 * j] * v[k][2 * j] + v[k][2 * j + 1] * v[k][2 * j + 1]; } }
        const float rstd = 1.f / sqrtf(wave_sum(s) * (1.f / D) + EPS);
        float lg[8];
#pragma unroll
        for (int e = 0; e < 8; ++e) lg[e] = 0.f;
#pragma unroll
        for (int k = 0; k < 2; ++k) { const int c0 = 512 * k + 8 * F.lane; const f32x4 g0 = *(const GAS f32x4*)(g + c0), g1 = *(const GAS f32x4*)(g + c0 + 4); float hn[8];
#pragma unroll
            for (int q = 0; q < 8; ++q) hn[q] = v[k][q] * rstd * (q < 4 ? g0[q & 3] : g1[q & 3]);
            v2u o; o.x = pk4_fp8(hn[0], hn[1], hn[2], hn[3]); o.y = pk4_fp8(hn[4], hn[5], hn[6], hn[7]);
            *(GAS v2u*)(XN8 + (size_t)m * D + c0) = o;
#pragma unroll
            for (int q = 0; q < 8; ++q) { const f32x4 r0 = *(const GAS f32x4*)(router + (size_t)(c0 + q) * 8), r1 = *(const GAS f32x4*)(router + (size_t)(c0 + q) * 8 + 4);
#pragma unroll
                for (int e = 0; e < 4; ++e) { lg[e] += hn[q] * r0[e]; lg[4 + e] += hn[q] * r1[e]; } } }
#pragma unroll
        for (int e = 0; e < 8; ++e) lg[e] = wave_sum(lg[e]);
        int e1 = 0; float v1 = lg[0];
#pragma unroll
        for (int e = 1; e < 8; ++e) if (lg[e] > v1) { v1 = lg[e]; e1 = e; }
        int e2 = (e1 + 1) & 7; float v2 = -3.0e38f;
#pragma unroll
        for (int e = 0; e < 8; ++e) if (e != e1 && lg[e] > v2) { v2 = lg[e]; e2 = e; }
        if (F.lane == 0) { const float w1 = 1.f / (1.f + __expf(v2 - v1)); tokE[2 * m] = e1; tokE[2 * m + 1] = e2; tokW[2 * m] = w1; tokW[2 * m + 1] = 1.f - w1;
            atomicAdd((int*)cntS + e1, 1); atomicAdd((int*)cntS + e2, 1); }
    }
    __syncthreads();
    if (F.tid < 8) ((int*)(F.ctl + CW_MOECNT))[F.bid * 8 + F.tid] = cntS[F.tid];
    __syncthreads();
}
__device__ __forceinline__ void moe_layout(const Frame& F) {
    LAS int* tab = (LAS int*)(F.lds + MOE_TAB); const int* cnt = (const int*)(F.ctl + CW_MOECNT);
    if (F.tid < 16) tab[F.tid < 8 ? F.tid : 32 + MOE_TILES + F.tid] = 0;
    __syncthreads();
    { const int e = F.tid & 7; int tot = 0, pre = 0;
      for (int wg = F.tid >> 3; wg < F.G; wg += NTHR / 8) { const int c = cnt[wg * 8 + e]; tot += c; if (wg < F.bid) pre += c; }
      atomicAdd((int*)tab + e, tot); atomicAdd((int*)tab + 32 + MOE_TILES + 8 + e, pre); }
    __syncthreads();
    if (F.tid == 0) { int row = 0, tl = 0; for (int e = 0; e < 8; ++e) { const int nt = (tab[e] + 255) >> 8; tab[8 + e] = row; tab[16 + e] = nt; for (int i = 0; i < nt; ++i) tab[32 + tl + i] = e; tl += nt; row += nt * 256; } tab[24] = tl; }
    __syncthreads();
}
__device__ __forceinline__ void phase_scatter(const Frame& F) {
    moe_layout(F);
    LAS int* tab = (LAS int*)(F.lds + MOE_TAB); LAS int* slotS = (LAS int*)F.lds;
    const int per = M / F.G;
    const int* tokE = (const int*)(F.ws + WS_MOEIDX); int* tokS = (int*)(F.ws + WS_MOEIDX + 2 * MiB);
    if (F.wave == 0) { const int E0 = tokE[(size_t)F.bid * per * 2 + F.lane], E1 = tokE[(size_t)F.bid * per * 2 + 64 + F.lane]; int s0 = 0, s1 = 0;
        const unsigned long long lt = (1ull << F.lane) - 1ull;
#pragma unroll
        for (int e = 0; e < 8; ++e) { const unsigned long long m0 = __ballot(E0 == e), m1 = __ballot(E1 == e); const int base = tab[8 + e] + tab[32 + MOE_TILES + 8 + e];
            if (E0 == e) s0 = base + __popcll(m0 & lt); if (E1 == e) s1 = base + __popcll(m0) + __popcll(m1 & lt); }
        slotS[F.lane] = s0; slotS[64 + F.lane] = s1; tokS[(size_t)F.bid * per * 2 + F.lane] = s0; tokS[(size_t)F.bid * per * 2 + 64 + F.lane] = s1; }
    __syncthreads();
    const unsigned char* XN8 = F.ws + WS_XN8; unsigned char* XP = F.ws + WS_XP;
    for (int i = F.wave; i < per * 2; i += NWAVES) { const int m = F.bid * per + (i >> 1); const int sl = slotS[i];
        ((GAS v4u*)(XP + (size_t)sl * D))[F.lane] = ((const GAS v4u*)(XN8 + (size_t)m * D))[F.lane]; }
    __syncthreads();
}
struct MoeOrder {
    int nN, nwg, G, c; const LAS int* texp;
    __device__ __forceinline__ bool next(int i, pg8::Unit& u) const { const long L = (long)i * G + c; if (L >= nwg) return false; u.pm = (int)(L / nN); u.pn = (int)(L % nN); u.bn = texp[u.pm] * nN + u.pn; u.idx = i; return true; }
    __device__ __forceinline__ void a_ready(const pg8::Unit&) const {}
    __device__ __forceinline__ void done(const pg8::Unit&) const {}
};
struct MoeOrderX {
    int nM, nN, nwg, G, c; const LAS int* texp;
    __device__ __forceinline__ bool next(int i, pg8::Unit& u) const { const long L = (long)i * G + c; if (L >= nwg) return false;
        int wgid = (int)L; { const int q = nwg / 8, r = nwg % 8, xcd = wgid % 8, off = wgid / 8; wgid = (xcd < r ? xcd * (q + 1) : r * (q + 1) + (xcd - r) * q) + off; }
        const int nig = 8 * nN, gid = wgid / nig, fm = gid * 8, gsz = (nM - fm) < 8 ? (nM - fm) : 8;
        u.pm = fm + ((wgid % nig) % gsz); u.pn = (wgid % nig) / gsz; u.bn = texp[u.pm] * nN + u.pn; u.idx = i; return true; }
    __device__ __forceinline__ void a_ready(const pg8::Unit&) const {}
    __device__ __forceinline__ void done(const pg8::Unit&) const {}
};
struct MoeTail { int R, Lo, pm_min; bool split; };
__device__ __forceinline__ MoeTail moe_tail(const LAS int* tab, int G) { MoeTail t; const int U = tab[24] * 4; t.R = U / G; t.Lo = U - t.R * G; t.split = (t.Lo > 0 && t.Lo <= 128 && t.R > 0); t.pm_min = t.split ? (t.R * G) / 4 : (1 << 30); return t; }
struct MoeTailOrder { int pm, pn, bn; bool has;
    __device__ __forceinline__ bool next(int i, pg8::Unit& u) const { if (i > 0 || !has) return false; u.pm = pm; u.pn = pn; u.bn = bn; u.idx = 0; return true; }
    __device__ __forceinline__ void a_ready(const pg8::Unit&) const {}
    __device__ __forceinline__ void done(const pg8::Unit&) const {} };
constexpr size_t MOE_PART_STRIDE = (size_t)32 * 256 * 1024;
__device__ __forceinline__ void phase_moe_combine(const Frame& F, const bf16* x, float* xo) {
    moe_layout(F); const MoeTail mt = moe_tail((const LAS int*)(F.lds + MOE_TAB), F.G); const int srow = mt.pm_min == (1 << 30) ? (1 << 30) : mt.pm_min * 256; const float* PART = (const float*)(F.ws + WS_XP);
    const int gw = F.bid * NWAVES + F.wave, NGW = F.G * NWAVES;
    const float* tokW = (const float*)(F.ws + WS_MOEIDX + 1 * MiB); const int* tokS = (const int*)(F.ws + WS_MOEIDX + 2 * MiB); const int* tokE = (const int*)(F.ws + WS_MOEIDX);
    const bf16* YP = (const bf16*)(F.ws + WS_YP);
    for (int m = gw; m < M; m += NGW) { const int s0 = tokS[2 * m], s1 = tokS[2 * m + 1]; const float w0 = tokW[2 * m] * (1.f / MOE_W2_SCALE), w1 = tokW[2 * m + 1] * (1.f / MOE_W2_SCALE)  ; const bool sw = tokE[2 * m] > tokE[2 * m + 1];
        const GAS v2u* xr = (const GAS v2u*)(x + (size_t)m * D) + F.lane; GAS f32x4* xw = (GAS f32x4*)(xo + (size_t)m * D) + F.lane; const GAS v2u* y0 = (const GAS v2u*)(YP + (size_t)s0 * D) + F.lane; const GAS v2u* y1 = (const GAS v2u*)(YP + (size_t)s1 * D) + F.lane;
#pragma unroll
        for (int j = 0; j < 4; ++j) { f32x4 v0, v1;
            if (s0 >= srow) { const GAS f32x4* q = (const GAS f32x4*)(PART + (size_t)(s0 - srow) * D) + F.lane + 64 * j; v0 = q[0] + q[MOE_PART_STRIDE / 4]; } else { const v2u yb = y0[64 * j]; v0 = (f32x4){bflo(yb.x), bfhi(yb.x), bflo(yb.y), bfhi(yb.y)}; }
            if (s1 >= srow) { const GAS f32x4* q = (const GAS f32x4*)(PART + (size_t)(s1 - srow) * D) + F.lane + 64 * j; v1 = q[0] + q[MOE_PART_STRIDE / 4]; } else { const v2u yb = y1[64 * j]; v1 = (f32x4){bflo(yb.x), bfhi(yb.x), bflo(yb.y), bfhi(yb.y)}; }
            const f32x4 a0 = v0 * w0, a1 = v1 * w1; const v2u xb = xr[64 * j]; const f32x4 xv = {bflo(xb.x), bfhi(xb.x), bflo(xb.y), bfhi(xb.y)}; xw[64 * j] = xv + (sw ? (a1 + a0) : (a0 + a1)); } }
}
#ifndef MK_PHMASK
#define MK_PHMASK 0xFFFFFFFFFFFFull
#endif
#ifndef MK_DUPMASK
#define MK_DUPMASK 0ull
#endif
#ifndef MK_SPLIT
#define MK_SPLIT 0
#endif
#ifndef MK_LAST_PHASE
#define MK_LAST_PHASE 29
#endif
constexpr int N_PHASES = 30;
#ifndef MK_LB
#define MK_LB 2
#endif
__global__ void __launch_bounds__(NTHR, MK_LB) mega_fwd(Args args) {
    extern __shared__ __attribute__((aligned(16))) unsigned char lds_raw[];
    Frame F;
    F.lds = (LAS unsigned char*)lds_raw; F.MISC = (volatile LAS unsigned*)(F.lds + MISC_OFF);
    F.tid = threadIdx.x; F.lane = F.tid & 63; F.wave = __builtin_amdgcn_readfirstlane(F.tid >> 6); F.G = gridDim.x; F.bid = blockIdx.x;
    F.ws = args.ws; F.ctl = (gu32*)(args.ws + WS_CTL);
    for (int u = F.tid; u < (LDS_BYTES - MISC_OFF) / 4; u += NTHR) ((LAS unsigned*)(F.lds + MISC_OFF))[u] = 0u;
    __syncthreads();
    XcdBarrier bar; bar.bar = (unsigned*)(F.ctl + CW_BAR); bar.x = 0; bar.st = nullptr;
    if (!MK_SPLIT) bar = xcd_barrier_post((unsigned*)(F.ctl + CW_BAR), F.MISC + 8);
    const int lo = args.ph_lo, hi = args.ph_hi;
#define PF() Frame Fp = F; { int t_ = threadIdx.x; asm volatile("" : "+v"(t_)); Fp.tid = t_; Fp.lane = t_ & 63; int w_ = F.wave, b_ = F.bid; asm volatile("" : "+s"(w_), "+s"(b_)); Fp.wave = w_; Fp.bid = b_; }
#define IN(k) ((((unsigned long long)MK_PHMASK >> (k)) & 1ull) && lo <= (k) && (k) < hi)
#define DUP(k) ((((unsigned long long)MK_DUPMASK >> (k)) & 1ull) ? 2 : 1)
#define SEAM(k) do { if (!MK_SPLIT && IN((k) + 1)) xcd_barrier(bar); } while (0)
    unsigned char* ws = args.ws; float* out = args.out;
    const int gw = F.bid * NWAVES + F.wave, NGW = F.G * NWAVES;
    LAS unsigned char* glds = F.lds;
    bf16* XN = (bf16*)(ws + WS_XN);

    if (IN(0)) { PF();
#pragma unroll 1
        for (int rep = 0; rep < DUP(0); ++rep) p0_prologue(Fp, args);
        SEAM(0); }
    if (IN(1)) {
        PF();
#pragma unroll 1
        for (int rep = 0; rep < DUP(1); ++rep) {
        if (F.bid == 0) { float* part = (float*)(ws + WS_CMPB_PART); float s = 0.f; for (int ic = 0; ic < 64; ++ic) s += part[(size_t)((Fp.tid >> 8) * 64 + ic) * 256 + (Fp.tid & 255)]; ((float*)(ws + WS_CMPB))[Fp.tid] = s; }
        { pg8::Gemm g{XN, (const bf16*)(ws + WS_W_EVIN), M, EV_INP, D, D, D}; pg8::StaticOrder S; S.init(M, EV_INP, F.G, F.bid);
          pg8::EpiEvIn E{(bf16*)(ws + WS_Y0), EV_INP, (bf16*)(ws + WS_KV6), SEQ};
          pg8::gemm_phase<pg8::EpiEvIn, pg8::StaticOrder, PG8_ALIGN, PG8_SP2>(glds, g, S, E); }
#pragma unroll 1
        for (int l = 0; l < 2; ++l) { pg8::Gemm g{(const bf16*)(ws + WS_MEMN) + (size_t)l * MMEM * D, (const bf16*)(ws + WS_W_XKV) + (size_t)l * 1024 * D, MMEM, 1024, D, D, D};
          pg8::ListOrder S; S.init(2, 4, 8, F.bid - 192 - 8 * l);
          pg8::EpiBf16<0> E{(bf16*)(ws + WS_KVM) + (size_t)l * MMEM * 1024, 1024, nullptr, nullptr};
          pg8::gemm_phase<pg8::EpiBf16<0>, pg8::ListOrder, PG8_ALIGN, PG8_SP2>(glds, g, S, E); }
        }
        SEAM(1);
    }
    if (IN(2)) {
        PF();
#pragma unroll 1
        for (int rep = 0; rep < DUP(2); ++rep) {
        if (F.bid < 128) { rglru_unit(Fp, args, F.bid >> 6, (F.bid >> 3) & 7, F.bid & 7);
        }
        else if (F.bid < 144) { const int mm = (F.bid - 128) >> 3;
            pg8::Gemm g{(const bf16*)(ws + WS_KV6) + (size_t)mm * 4 * SEQ * 128, (const bf16*)(ws + (mm ? WS_W_CV1 : WS_W_CK1)), 2048, 256, 4096, 2048, 4096};
            pg8::ListOrder S; S.init(8, 1, 8, (F.bid - 128) & 7);
            pg8::EpiBf16<1> E{(bf16*)(ws + WS_HID) + (size_t)mm * 2048 * 256, 256, (const float*)(ws + WS_CMPB) + mm * 256, nullptr};
            pg8::gemm_phase<pg8::EpiBf16<1>, pg8::ListOrder, PG8_ALIGN, PG8_SP2>(glds, g, S, E);
#ifdef MK_DUP_CMP1
            pg8::gemm_phase<pg8::EpiBf16<1>, pg8::ListOrder, PG8_ALIGN, PG8_SP2>(glds, g, S, E);
#endif
            VM_WAIT(); __syncthreads(); { const int u0 = mm * 64 + ((F.bid - 128) & 7) * 8; phase_cmp2(Fp, args, u0, u0 + 8, 1); }
        }
        else if (rep == 0) { const int gw2 = (F.bid - 144) * NWAVES + F.wave, NGW2 = (F.G - 144) * NWAVES;
            bf16* ks = (bf16*)(ws + WS_KV6) + (size_t)2 * 4 * SEQ * 128; bf16* kw = (bf16*)(ws + WS_KV6) + (size_t)4 * 4 * SEQ * 128;
            norm128_rows(Fp, ks, 128, ks, 128, 4 * SEQ, args.in[I_KNORM] + 128, gw2, NGW2);
            norm128_rows(Fp, kw, 128, kw, 128, 4 * SEQ, args.in[I_KNORM] + 256, gw2, NGW2);
            phase_memk_norm(Fp, args, 0, gw2, NGW2); phase_memk_norm(Fp, args, 1, gw2, NGW2); convert_range(Fp, args, gw2, NGW2, CONV_A, CONV_P2_END);
#ifdef MK_DUP_P2CONV
            convert_range(Fp, args, gw2, NGW2, CONV_A + (CONV_P2_END - CONV_A) / 2, CONV_P2_END);
#endif
        }
        }
        SEAM(2);
    }
    if (IN(4)) { PF();
#pragma unroll 1
        for (int rep = 0; rep < DUP(4); ++rep) phase_nsa(Fp, args);
        SEAM(4); }
    if (IN(5)) {
        pg8::Gemm g{(const bf16*)(ws + WS_MIX), (const bf16*)(ws + WS_W_EVOUT), M, D, 2048, 2048, 2048}; pg8::StaticOrder S; S.init(M, D, F.G, F.bid);
#pragma unroll 1
        for (int rep = 0; rep < DUP(5); ++rep) { pg8::EpiResidB<true> E{args.in[I_X], (rep + 1 < DUP(5)) ? (bf16*)(ws + WS_R + 400 * MiB) : XN, D, (float*)(ws + WS_SSQ)};
        pg8::gemm_phase<pg8::EpiResidB<true>, pg8::StaticOrder, PG8_ALIGN, PG8_SP2>(glds, g, S, E); }
        SEAM(5);
#ifdef MK_PROBE_BARS
#pragma unroll 1
        for (int xb = 0; xb < MK_PROBE_BARS; ++xb) xcd_barrier(bar);
#endif
    }
#pragma unroll 1
    for (int l = 0; l < 2; ++l) {
        const int pb = l == 0 ? 6 : 21;
        if (IN(pb + 1)) { pg8::Gemm g{XN, (const bf16*)(ws + WS_W_XQ) + (size_t)l * 512 * D, M, 512, D, D, D}; pg8::StaticOrder S; S.init(M, 512, F.G, F.bid);
            pg8::fill_rstd_table((LAS float*)(F.lds + MOE_TAB), S, (const float*)(ws + WS_SSQ), F.tid);
            pg8::EpiBf16<0> E{(bf16*)(ws + WS_QX), 512, nullptr, (const LAS float*)(F.lds + MOE_TAB)};
#pragma unroll 1
            for (int rep = 0; rep < DUP(7); ++rep) pg8::gemm_phase<pg8::EpiBf16<0>, pg8::StaticOrder, PG8_ALIGN, PG8_SP2>(glds, g, S, E);
            if (F.bid >= 128) { PF(); const int lo_ = CONV_ALL - (2 - l) * CONV_Q;
                convert_range(Fp, args, (F.bid - 128) * NWAVES + F.wave, (F.G - 128) * NWAVES, lo_, lo_ + CONV_Q); }
            SEAM(pb + 1); }
        if (IN(pb + 2)) { PF();
#pragma unroll 1
            for (int rep = 0; rep < DUP(8); ++rep) phase_cross_attn(Fp, args, l);
            SEAM(pb + 2); }
        if (IN(pb + 3)) { pg8::Gemm g{(const bf16*)(ws + WS_OX), (const bf16*)(ws + WS_W_XO) + (size_t)l * D * 512, M, D, 512, 512, 512}; pg8::StaticOrder S; S.init(M, D, F.G, F.bid);
#pragma unroll 1
            for (int rep = 0; rep < DUP(9); ++rep) { pg8::EpiResidB<false> E{XN, (rep + 1 < DUP(9)) ? (bf16*)(ws + WS_R + 400 * MiB) : XN, D, (float*)(ws + WS_SSQ)};
            pg8::gemm_phase<pg8::EpiResidB<false>, pg8::StaticOrder, PG8_ALIGN, PG8_SP2>(glds, g, S, E); }
            SEAM(pb + 3); }
        if (l == 0) {
            if (IN(11)) { pg8::Gemm g{XN, (const bf16*)(ws + WS_W_FF13), M, 2 * FF, D, D, D}; pg8::StaticOrder S; S.init(M, 2 * FF, F.G, F.bid);
                pg8::fill_rstd_table((LAS float*)(F.lds + MOE_TAB), S, (const float*)(ws + WS_SSQ), F.tid);
                pg8::EpiSwiglu<false> E{(bf16*)(ws + WS_H), FF, (const LAS float*)(F.lds + MOE_TAB)};
#ifdef MK_PROBE_NULLEPI
                { pg8::EpiNull EN; pg8::gemm_phase<pg8::EpiNull, pg8::StaticOrder, PG8_ALIGN, PG8_SP2>(glds, g, S, EN); }
#endif
#pragma unroll 1
                for (int rep = 0; rep < DUP(11); ++rep) pg8::gemm_phase<pg8::EpiSwiglu<false>, pg8::StaticOrder, PG8_ALIGN, PG8_SP2>(glds, g, S, E);
                SEAM(11); }
            if (IN(12)) { pg8::Gemm g{(const bf16*)(ws + WS_H), (const bf16*)(ws + WS_W_FF2), M, D, FF, FF, FF}; pg8::StaticOrder S; S.init(M, D, F.G, F.bid);
#pragma unroll 1
                for (int rep = 0; rep < DUP(12); ++rep) { pg8::EpiResidB<false> E{XN, (rep + 1 < DUP(12)) ? (bf16*)(ws + WS_R + 400 * MiB) : XN, D, (float*)(ws + WS_SSQ)};
                pg8::gemm_phase<pg8::EpiResidB<false>, pg8::StaticOrder, PG8_ALIGN, PG8_SP2>(glds, g, S, E); }
                SEAM(12); }
            if (IN(14)) { pg8::Gemm g{XN, (const bf16*)(ws + WS_W_ODIN), M, 5120, D, D, D}; pg8::StaticOrder S; S.init(M, 5120, F.G, F.bid);
                pg8::fill_rstd_table((LAS float*)(F.lds + MOE_TAB), S, (const float*)(ws + WS_SSQ), F.tid);
                pg8::EpiBf16<0> E{(bf16*)(ws + WS_Y1), OD_INP, nullptr, (const LAS float*)(F.lds + MOE_TAB)};
#pragma unroll 1
                for (int rep = 0; rep < DUP(14); ++rep) pg8::gemm_phase<pg8::EpiBf16<0>, pg8::StaticOrder, PG8_ALIGN, PG8_SP2>(glds, g, S, E);
                od_dt_cols(F, XN, (const bf16*)(ws + WS_W_ODIN), (const float*)(ws + WS_SSQ), (bf16*)(ws + WS_Y1));
                SEAM(14); }
            if (IN(15)) { PF();
#pragma unroll 1
                for (int rep = 0; rep < DUP(15); ++rep) phase_mamba_prep(Fp, args);
                SEAM(15); }
            if (IN(16)) { PF();
#pragma unroll 1
                for (int rep = 0; rep < DUP(16); ++rep) phase_mamba_states(Fp);
                SEAM(16); }
            if (IN(17)) { PF();
#pragma unroll 1
                for (int rep = 0; rep < DUP(17); ++rep) phase_mamba_scan(Fp);
                SEAM(17); }
            if (IN(18)) { PF();
#pragma unroll 1
                for (int rep = 0; rep < DUP(18); ++rep) phase_mamba_out(Fp, args);
                SEAM(18); }
            if (IN(20)) { pg8::Gemm g{(const bf16*)(ws + WS_YG), (const bf16*)(ws + WS_W_ODOUT), M, D, 2048, 2048, 2048}; pg8::StaticOrder S; S.init(M, D, F.G, F.bid);
#pragma unroll 1
                for (int rep = 0; rep < DUP(20); ++rep) { pg8::EpiResidB<false> E{XN, (rep + 1 < DUP(20)) ? (bf16*)(ws + WS_R + 400 * MiB) : XN, D, (float*)(ws + WS_SSQ)};
                pg8::gemm_phase<pg8::EpiResidB<false>, pg8::StaticOrder, PG8_ALIGN, PG8_SP2>(glds, g, S, E); }
                SEAM(20); }
        }
    }
    if (IN(25)) { PF();
#pragma unroll 1
        for (int rep = 0; rep < DUP(25); ++rep) phase_route(Fp, args, XN);
        SEAM(25); }
    if (IN(26)) { PF();
#pragma unroll 1
        for (int rep = 0; rep < DUP(26); ++rep) phase_scatter(Fp);
        SEAM(26); }
    if (IN(27)) { PF(); moe_layout(Fp); const LAS int* tab = (const LAS int*)(F.lds + MOE_TAB);
        pg8::Gemm g{(const bf16*)(ws + WS_XP), (const bf16*)(ws + WS_W_M13), MOE_ROWS, 2 * FFE, D / 2, D / 2, D / 2}  ; MoeOrderX S{tab[24], 2 * FFE / 256, tab[24] * (2 * FFE / 256), F.G, F.bid, tab + 32};
        pg8::EpiSwiglu<true, false, true> E{(bf16*)(ws + WS_HP), FFE, nullptr, 1.f / MOE_W13_SCALE};
#pragma unroll 1
        for (int rep = 0; rep < DUP(27); ++rep) pg8::gemm_phase<pg8::EpiSwiglu<true, false, true>, MoeOrderX, PG8_ALIGN, PG8_SP2, true>(glds, g, S, E);
        SEAM(27); }
    if (IN(28)) { PF(); moe_layout(Fp); const LAS int* tab = (const LAS int*)(F.lds + MOE_TAB);
        const MoeTail mt = moe_tail(tab, F.G);
        pg8::Gemm g{(const bf16*)(ws + WS_HP), (const bf16*)(ws + WS_W_M2), MOE_ROWS, D, FFE / 2, FFE / 2, FFE / 2}  ; MoeOrder S{D / 256, mt.split ? mt.R * F.G : tab[24] * (D / 256), F.G, F.bid, tab + 32};
        pg8::EpiBf16<0> E{(bf16*)(ws + WS_YP), D, nullptr, nullptr};
#pragma unroll 1
        for (int rep = 0; rep < DUP(28); ++rep) pg8::gemm_phase<pg8::EpiBf16<0>, MoeOrder, PG8_ALIGN, PG8_SP2, true>(glds, g, S, E);
        if (mt.split) {
            const int piece = F.bid, L = mt.R * F.G + (piece >> 1), kq = piece & 1, pm = L / 4, pn = L % 4;
            MoeTailOrder S2{pm, pn, piece < mt.Lo * 2 ? tab[32 + pm] * 4 + pn : 0, piece < mt.Lo * 2};
            pg8::Gemm g2{(const bf16*)(ws + WS_HP) + kq * (FFE / 4), (const bf16*)(ws + WS_W_M2) + kq * (FFE / 4), MOE_ROWS, D, FFE / 4, FFE / 2, FFE / 2};
            pg8::EpiF32 E2{(float*)(ws + WS_XP) + (size_t)kq * MOE_PART_STRIDE - (size_t)mt.pm_min * 256 * D, D};
            pg8::gemm_phase<pg8::EpiF32, MoeTailOrder, PG8_ALIGN, PG8_SP2, true>(glds, g2, S2, E2); }
        SEAM(28); }
    if (IN(29)) { PF();
#pragma unroll 1
        for (int rep = 0; rep < DUP(29); ++rep) phase_moe_combine(Fp, XN, (rep + 1 < DUP(29)) ? (float*)(ws + WS_H) : out); }
#undef IN
#undef SEAM
}

extern "C" void kernel_launch(void* const* d_in, const int* in_sizes, int n_in, void* d_out, int out_size, void* d_ws, size_t ws_size, hipStream_t stream) {
    static int grid = 0;
    if (grid == 0) {
        if (n_in != N_IN || in_sizes[0] != M * D || out_size != M * D || ws_size < (WS_M_END > WS_END ? WS_M_END : WS_END)) { fprintf(stderr, "kernel_launch: unexpected problem (n_in %d, in0 %d, out %d, ws %zu < %zu); nothing launched\n", n_in, n_in > 0 ? in_sizes[0] : -1, out_size, ws_size, (size_t)WS_END); grid = -1; return; }
        int dev = 0, cus = 0, per_cu = 0;
        if (hipGetDevice(&dev) != hipSuccess || hipDeviceGetAttribute(&cus, hipDeviceAttributeMultiprocessorCount, dev) != hipSuccess) { fprintf(stderr, "kernel_launch: device query failed\n"); grid = -1; return; }
        if (hipFuncSetAttribute((const void*)mega_fwd, hipFuncAttributeMaxDynamicSharedMemorySize, LDS_BYTES) != hipSuccess) { fprintf(stderr, "kernel_launch: hipFuncSetAttribute(%d B LDS) failed\n", LDS_BYTES); grid = -1; return; }
        if (hipOccupancyMaxActiveBlocksPerMultiprocessor(&per_cu, (const void*)mega_fwd, NTHR, LDS_BYTES) != hipSuccess || per_cu < 1) fprintf(stderr, "kernel_launch: note: occupancy query reports %d workgroups per CU\n", per_cu);
        (void)hipGetLastError();
        if (cus < 256) { fprintf(stderr, "kernel_launch: %d CUs < 256: the persistent grid of 256 workgroups would not be resident; nothing launched\n", cus); grid = -1; return; }
        grid = 256;
    }
    if (grid < 0) return;
    if (hipMemsetAsync((char*)d_ws + WS_CTL, 0, CTL_ZERO_BYTES, stream) != hipSuccess) { fprintf(stderr, "kernel_launch: memset failed\n"); return; }
    Args a{};
    for (int i = 0; i < N_IN; ++i) a.in[i] = (const float*)d_in[i];
    a.out = (float*)d_out; a.ws = (unsigned char*)d_ws;
#if MK_SPLIT
    for (int p = 0; p <= MK_LAST_PHASE && p < N_PHASES; ++p) { a.ph_lo = p; a.ph_hi = p + 1; a.li = p; hipLaunchKernelGGL(mega_fwd, dim3(grid), dim3(NTHR), LDS_BYTES, stream, a); }
#else
    a.ph_lo = 0; a.ph_hi = MK_LAST_PHASE + 1; a.li = 0;
    hipLaunchKernelGGL(mega_fwd, dim3(grid), dim3(NTHR), LDS_BYTES, stream, a);
#endif
    const hipError_t le = hipPeekAtLastError();
    if (le != hipSuccess) fprintf(stderr, "kernel_launch: launch failed: %s\n", hipGetErrorName(le));
}
```

```cpp
#include <hip/hip_runtime.h>
#include <cstdio>
#include <cstdint>

namespace pg8 {
#define PG8_LAS __attribute__((address_space(3)))
typedef unsigned short bf16_t;
typedef short bf16x8 __attribute__((ext_vector_type(8)));
typedef float f32x4 __attribute__((ext_vector_type(4)));
typedef unsigned u32x4 __attribute__((ext_vector_type(4)));
typedef unsigned u32x2 __attribute__((ext_vector_type(2)));
constexpr int BM = 256, BK = 64, HALF = 128, HTB = HALF * BK * 2  , STAGE_BYTES = 8 * HTB, NXCD = 8, WGM = 8;

__host__ __device__ __forceinline__ int lds_byte(int r, int c) { const int st = (r >> 4) * 2 + (c >> 5), rr = r & 15, cc = c & 31, ob = rr * 64 + cc * 2; return st * 1024 + (ob ^ (((ob >> 9) & 1) << 5)); }
__host__ __device__ __forceinline__ void stage_rc(int b, int& R, int& C) { const int st = b / 1024, sb = b % 1024, swz = sb ^ (((sb >> 9) & 1) << 5); R = (st >> 1) * 16 + swz / 64; C = (st & 1) * 32 + (swz % 64) / 2; }
__host__ __device__ __forceinline__ int perm32(int rho) { const int n = rho >> 4, i = rho & 15; return 8 * (i >> 2) + 4 * n + (i & 3); }

typedef int i32x8 __attribute__((ext_vector_type(8)));
typedef int i32x4 __attribute__((ext_vector_type(4)));
__device__ __forceinline__ i32x8 cat8(bf16x8 lo, bf16x8 hi) { const i32x4 a = __builtin_bit_cast(i32x4, lo), b = __builtin_bit_cast(i32x4, hi); return __builtin_shufflevector(a, b, 0, 1, 2, 3, 4, 5, 6, 7); }
__device__ __forceinline__ void mfma_f8_inplace(f32x4& acc, i32x8 a, i32x8 b) { asm volatile("v_mfma_f32_16x16x128_f8f6f4 %0, %1, %2, %0" : "+v"(acc) : "v"(a), "v"(b)); }
struct Unit { int pm, pn, bn, idx; };
struct Gemm { const bf16_t* A; const bf16_t* Bt; int M, N, K, lda, ldb; };

struct StaticOrder {
    int nM, nN, nwg, G, c;
    __host__ __device__ void init(int M, int N, int G_, int c_) { nM = M / BM; nN = N / BM; nwg = nM * nN; G = G_; c = c_; }
    __host__ __device__ bool next(int i, Unit& u) const {
        const long L = (long)i * G + c; if (L >= nwg) return false;
        int wgid = (int)L; { const int q = nwg / NXCD, r = nwg % NXCD, xcd = wgid % NXCD, off = wgid / NXCD; wgid = (xcd < r ? xcd * (q + 1) : r * (q + 1) + (xcd - r) * q) + off; }
        const int nig = WGM * nN, gid = wgid / nig, fm = gid * WGM, gsz = (nM - fm) < WGM ? (nM - fm) : WGM;
        u.pm = fm + ((wgid % nig) % gsz); u.pn = (wgid % nig) / gsz; u.bn = u.pn; u.idx = i; return true;
    }
    __device__ __forceinline__ void a_ready(const Unit&) const {}
    __device__ __forceinline__ void done(const Unit&) const {}
};
struct ListOrder {
    int nN, nwg, G, c;
    __host__ __device__ void init(int nM_, int nN_, int G_, int c_) { nN = nN_; nwg = nM_ * nN_; G = G_; c = c_; }
    __host__ __device__ bool next(int i, Unit& u) const { const long L = (long)i * G + c; if (c < 0 || L >= nwg) return false; u.pm = (int)(L / nN); u.pn = (int)(L % nN); u.bn = u.pn; u.idx = i; return true; }
    __device__ __forceinline__ void a_ready(const Unit&) const {}
    __device__ __forceinline__ void done(const Unit&) const {}
};

__device__ __forceinline__ unsigned cvt_pk_bf16(float lo, float hi) { unsigned r; asm volatile("v_cvt_pk_bf16_f32 %0, %1, %2" : "=v"(r) : "v"(lo), "v"(hi)); return r; }
__device__ __forceinline__ unsigned cvt4_fp8(float a, float b, float c, float d) { int r = __builtin_amdgcn_cvt_pk_fp8_f32(a, b, 0, false); r = __builtin_amdgcn_cvt_pk_fp8_f32(c, d, r, true); return (unsigned)r; }
__device__ __forceinline__ float fsigmoid(float x) { return __builtin_amdgcn_rcpf(1.0f + __expf(-x)); }
__device__ __forceinline__ float gelu_tanh(float x) { const float u = 1.5957691216f * (x + 0.044715f * x * x * x); return x * fsigmoid(u); }
__device__ __forceinline__ float fsilu(float x) { return x * fsigmoid(x); }

__device__ __forceinline__ float row_rstd(const float* ssq, int row) {
    const f32x4 a = *(const f32x4*)(ssq + (size_t)row * 16), b = *(const f32x4*)(ssq + (size_t)row * 16 + 4), c = *(const f32x4*)(ssq + (size_t)row * 16 + 8), d = *(const f32x4*)(ssq + (size_t)row * 16 + 12);
    const f32x4 s = (a + b) + (c + d); return 1.0f / sqrtf(((s[0] + s[1]) + (s[2] + s[3])) * (1.0f / 1024.0f) + 1e-6f);
}
template <class Sched> __device__ __forceinline__ void fill_rstd_table(PG8_LAS float* tab, const Sched& S, const float* ssq, int tid) {
    Unit u; for (int i = 0; S.next(i, u); ++i) if (tid < 256) { const int ai = tid >> 7, wr = (tid >> 6) & 1, m = (tid >> 4) & 3, fr = tid & 15; tab[i * 256 + ((ai * 2 + wr) * 16 + fr) * 4 + m] = row_rstd(ssq, u.pm * BM + tid); }
    __syncthreads();
}
template <int ACT, bool SPLIT_ = false> struct EpiBf16 {
    static constexpr bool PERM = true, AFTER_DRAIN = false, SPLIT = SPLIT_, PACK = false; static constexpr int NST = 16; struct Pk {};
    bf16_t* O; int ldc; const float* bias; const PG8_LAS float* rsT;
    __device__ __forceinline__ void operator()(const f32x4 (&acc)[2][2][4][2], const Unit& u, int wr, int wc, int fr, int fq) const { half<0>(acc, u, wr, wc, fr, fq); half<1>(acc, u, wr, wc, fr, fq); }
    template <int AI> __device__ __forceinline__ void half(const f32x4 (&acc)[2][2][4][2], const Unit& u, int wr, int wc, int fr, int fq) const {
        const int row0 = u.pm * BM + wr * 64 + fr; const int col0 = u.pn * BM + wc * 32 + 8 * fq;
        f32x4 bv[2][2];
#pragma unroll
        for (int bj = 0; bj < 2; ++bj)
#pragma unroll
            for (int n = 0; n < 2; ++n) bv[bj][n] = bias ? *(const f32x4*)(bias + col0 + bj * HALF + 4 * n) : (f32x4){0.f, 0.f, 0.f, 0.f};
        { constexpr int ai = AI; const f32x4 rs4 = rsT ? *(const PG8_LAS f32x4*)(rsT + u.idx * 256 + ((ai * 2 + wr) * 16 + fr) * 4) : (f32x4){1.f, 1.f, 1.f, 1.f};
#pragma unroll
            for (int m = 0; m < 4; ++m) { bf16_t* rowp = O + (size_t)(row0 + ai * HALF + m * 16) * ldc + col0; const float rs = rs4[m];
#pragma unroll
                for (int bj = 0; bj < 2; ++bj) { f32x4 v0 = acc[ai][bj][m][0] * rs + bv[bj][0], v1 = acc[ai][bj][m][1] * rs + bv[bj][1];
                    if (ACT == 1) {
#pragma unroll
                        for (int j = 0; j < 4; ++j) { v0[j] = gelu_tanh(v0[j]); v1[j] = gelu_tanh(v1[j]); } }
                    u32x4 w; w.x = cvt_pk_bf16(v0[0], v0[1]); w.y = cvt_pk_bf16(v0[2], v0[3]); w.z = cvt_pk_bf16(v1[0], v1[1]); w.w = cvt_pk_bf16(v1[2], v1[3]);
                    *(u32x4*)(rowp + bj * HALF) = w; } } }
    }
};
struct EpiEvIn {
    static constexpr bool PERM = true, AFTER_DRAIN = false, SPLIT = true, PACK = false; static constexpr int NST = 16; struct Pk {};
    bf16_t* O; int ldc; bf16_t* KV6; int S;
    __device__ __forceinline__ void operator()(const f32x4 (&acc)[2][2][4][2], const Unit& u, int wr, int wc, int fr, int fq) const { half<0>(acc, u, wr, wc, fr, fq); half<1>(acc, u, wr, wc, fr, fq); }
    template <int AI> __device__ __forceinline__ void half(const f32x4 (&acc)[2][2][4][2], const Unit& u, int wr, int wc, int fr, int fq) const {
        const int row0 = u.pm * BM + wr * 64 + fr; const int col0 = u.pn * BM + wc * 32 + 8 * fq;
        const bool kv = (u.pn >= 12 && u.pn < 18);
        { constexpr int ai = AI;
#pragma unroll
            for (int m = 0; m < 4; ++m) { const int row = row0 + ai * HALF + m * 16;
#pragma unroll
                for (int bj = 0; bj < 2; ++bj) { const f32x4 v0 = acc[ai][bj][m][0], v1 = acc[ai][bj][m][1];
                    u32x4 w; w.x = cvt_pk_bf16(v0[0], v0[1]); w.y = cvt_pk_bf16(v0[2], v0[3]); w.z = cvt_pk_bf16(v1[0], v1[1]); w.w = cvt_pk_bf16(v1[2], v1[3]);
                    if (kv) { const int b = row / S, t = row - b * S;
                        bf16_t* p = KV6 + ((((size_t)(u.pn - 12) * 2 + b) * 2 + bj) * S + t) * 128 + wc * 32 + 8 * fq; *(u32x4*)p = w; }
                    else *(u32x4*)(O + (size_t)row * ldc + col0 + bj * HALF) = w; } } }
    }
};
struct EpiResid {
    static constexpr bool PERM = false, AFTER_DRAIN = false, SPLIT = false, PACK = false; static constexpr int NST = 0; struct Pk {};
    const float* base; float* out; int ldc;
    __device__ __forceinline__ void operator()(const f32x4 (&acc)[2][2][4][2], const Unit& u, int wr, int wc, int fr, int fq) const {
        const int row0 = u.pm * BM + wr * 64 + fr, col0 = u.pn * BM + wc * 32 + 4 * fq;
#pragma unroll
        for (int ai = 0; ai < 2; ++ai)
#pragma unroll
            for (int m = 0; m < 4; ++m) { const size_t off = (size_t)(row0 + ai * HALF + m * 16) * ldc + col0;
#pragma unroll
                for (int bj = 0; bj < 2; ++bj)
#pragma unroll
                    for (int n = 0; n < 2; ++n) { const f32x4 b = *(const f32x4*)(base + off + bj * HALF + n * 16); *(f32x4*)(out + off + bj * HALF + n * 16) = b + acc[ai][bj][m][n]; } }
    }
};
struct EpiResidN {
    static constexpr bool PERM = false, AFTER_DRAIN = false, SPLIT = false, PACK = false; static constexpr int NST = 0; struct Pk {};
    const float* base; float* out; int ldc; bf16_t* XB; float* SSQ;
    __device__ __forceinline__ void operator()(const f32x4 (&acc)[2][2][4][2], const Unit& u, int wr, int wc, int fr, int fq) const {
        const int row0 = u.pm * BM + wr * 64 + fr, col0 = u.pn * BM + wc * 32 + 4 * fq;
#pragma unroll
        for (int ai = 0; ai < 2; ++ai)
#pragma unroll
            for (int m = 0; m < 4; ++m) { const int row = row0 + ai * HALF + m * 16; const size_t off = (size_t)row * ldc + col0; float ss = 0.f;
#pragma unroll
                for (int bj = 0; bj < 2; ++bj)
#pragma unroll
                    for (int n = 0; n < 2; ++n) { const f32x4 b = *(const f32x4*)(base + off + bj * HALF + n * 16); const f32x4 v = b + acc[ai][bj][m][n]; *(f32x4*)(out + off + bj * HALF + n * 16) = v;
                        if (XB) { u32x2 w; w.x = cvt_pk_bf16(v[0], v[1]); w.y = cvt_pk_bf16(v[2], v[3]); *(u32x2*)(XB + off + bj * HALF + n * 16) = w; }
                        ss += (v[0] * v[0] + v[1] * v[1]) + (v[2] * v[2] + v[3] * v[3]); }
                ss += __shfl_xor(ss, 16); ss += __shfl_xor(ss, 32);
                if (XB && fq == 0) SSQ[(size_t)row * 16 + u.pn * 4 + wc] = ss; }
    }
};
template <bool BASE_F32> struct EpiResidB {
    static constexpr bool PERM = true, AFTER_DRAIN = false, SPLIT = false, PACK = false; static constexpr int NST = 0; struct Pk {};
    const void* base; bf16_t* X; int ldc; float* SSQ;
    __device__ __forceinline__ void operator()(const f32x4 (&acc)[2][2][4][2], const Unit& u, int wr, int wc, int fr, int fq) const {
        const int row0 = u.pm * BM + wr * 64 + fr, col0 = u.pn * BM + wc * 32 + 8 * fq;
#pragma unroll
        for (int ai = 0; ai < 2; ++ai)
#pragma unroll
            for (int m = 0; m < 4; ++m) { const int row = row0 + ai * HALF + m * 16; const size_t off = (size_t)row * ldc + col0; float ss = 0.f;
#pragma unroll
                for (int bj = 0; bj < 2; ++bj) { f32x4 b0, b1;
                    if constexpr (BASE_F32) { b0 = *(const f32x4*)((const float*)base + off + bj * HALF); b1 = *(const f32x4*)((const float*)base + off + bj * HALF + 4); }
                    else { const u32x4 r = *(const u32x4*)((const bf16_t*)base + off + bj * HALF);
                        b0 = (f32x4){__builtin_bit_cast(float, r.x << 16), __builtin_bit_cast(float, r.x & 0xffff0000u), __builtin_bit_cast(float, r.y << 16), __builtin_bit_cast(float, r.y & 0xffff0000u)};
                        b1 = (f32x4){__builtin_bit_cast(float, r.z << 16), __builtin_bit_cast(float, r.z & 0xffff0000u), __builtin_bit_cast(float, r.w << 16), __builtin_bit_cast(float, r.w & 0xffff0000u)}; }
                    const f32x4 v0 = b0 + acc[ai][bj][m][0], v1 = b1 + acc[ai][bj][m][1];
                    u32x4 w; w.x = cvt_pk_bf16(v0[0], v0[1]); w.y = cvt_pk_bf16(v0[2], v0[3]); w.z = cvt_pk_bf16(v1[0], v1[1]); w.w = cvt_pk_bf16(v1[2], v1[3]);
                    *(u32x4*)(X + off + bj * HALF) = w;
                    ss += ((v0[0] * v0[0] + v0[1] * v0[1]) + (v0[2] * v0[2] + v0[3] * v0[3])) + ((v1[0] * v1[0] + v1[1] * v1[1]) + (v1[2] * v1[2] + v1[3] * v1[3])); }
                ss += __shfl_xor(ss, 16); ss += __shfl_xor(ss, 32);
                if (fq == 0) SSQ[(size_t)row * 16 + u.pn * 4 + wc] = ss; }
    }
};
struct EpiNull {
    static constexpr bool PERM = false, AFTER_DRAIN = false, SPLIT = false, PACK = false; static constexpr int NST = 0; struct Pk {};
    __device__ __forceinline__ void operator()(const f32x4 (&acc)[2][2][4][2], const Unit&, int, int, int, int) const {
#pragma unroll
        for (int ai = 0; ai < 2; ++ai)
#pragma unroll
            for (int bj = 0; bj < 2; ++bj)
#pragma unroll
                for (int m = 0; m < 4; ++m)
#pragma unroll
                    for (int n = 0; n < 2; ++n) asm volatile("" :: "v"(acc[ai][bj][m][n]));
    }
};
struct EpiF32 {
    static constexpr bool PERM = false, AFTER_DRAIN = false, SPLIT = false, PACK = false; static constexpr int NST = 0; struct Pk {};
    float* C; int ldc;
    __device__ __forceinline__ void operator()(const f32x4 (&acc)[2][2][4][2], const Unit& u, int wr, int wc, int fr, int fq) const {
        const int row0 = u.pm * BM + wr * 64 + fr, col0 = u.pn * BM + wc * 32 + 4 * fq;
#pragma unroll
        for (int ai = 0; ai < 2; ++ai)
#pragma unroll
            for (int m = 0; m < 4; ++m) { float* rowp = C + (size_t)(row0 + ai * HALF + m * 16) * ldc + col0;
#pragma unroll
                for (int bj = 0; bj < 2; ++bj)
#pragma unroll
                    for (int n = 0; n < 2; ++n) *(f32x4*)(rowp + bj * HALF + n * 16) = acc[ai][bj][m][n]; }
    }
};
template <bool SPLIT_, bool PACK_ = false, bool F8O_ = false> struct EpiSwiglu {
    static_assert(!(PACK_ && F8O_), "no packed fp8 form");
    static constexpr bool PERM = true, AFTER_DRAIN = false, SPLIT = SPLIT_, PACK = PACK_; static constexpr int NST = 8;
    bf16_t* H; int ldh; const PG8_LAS float* rsT; float sc = 1.f;
    __device__ __forceinline__ void operator()(const f32x4 (&acc)[2][2][4][2], const Unit& u, int wr, int wc, int fr, int fq) const { half<0>(acc, u, wr, wc, fr, fq); half<1>(acc, u, wr, wc, fr, fq); }
    struct Pk { u32x4 w[4]; };
    __device__ __forceinline__ void pack1(const f32x4 (&acc)[2][2][4][2], const Unit& u, int wr, int fr, Pk& pk) const {
        constexpr int ai = 1; const f32x4 rs4 = rsT ? *(const PG8_LAS f32x4*)(rsT + u.idx * 256 + ((ai * 2 + wr) * 16 + fr) * 4) : (f32x4){1.f, 1.f, 1.f, 1.f};
#pragma unroll
        for (int m = 0; m < 4; ++m) { const float rs = rs4[m] * sc;
            const f32x4 u0 = acc[ai][0][m][0] * rs, u1 = acc[ai][0][m][1] * rs, g0 = acc[ai][1][m][0] * rs, g1 = acc[ai][1][m][1] * rs;
            pk.w[m].x = cvt_pk_bf16(fsilu(g0[0]) * u0[0], fsilu(g0[1]) * u0[1]); pk.w[m].y = cvt_pk_bf16(fsilu(g0[2]) * u0[2], fsilu(g0[3]) * u0[3]);
            pk.w[m].z = cvt_pk_bf16(fsilu(g1[0]) * u1[0], fsilu(g1[1]) * u1[1]); pk.w[m].w = cvt_pk_bf16(fsilu(g1[2]) * u1[2], fsilu(g1[3]) * u1[3]); }
    }
    __device__ __forceinline__ void store1(const Pk& pk, const Unit& u, int wr, int wc, int fr, int fq) const {
        bf16_t* p = H + (size_t)(u.pm * BM + wr * 64 + fr + HALF) * ldh + u.pn * 128 + wc * 32 + 8 * fq;
#pragma unroll
        for (int m = 0; m < 4; ++m) *(u32x4*)(p + (size_t)(m * 16) * ldh) = pk.w[m];
    }
    template <int AI> __device__ __forceinline__ void half(const f32x4 (&acc)[2][2][4][2], const Unit& u, int wr, int wc, int fr, int fq) const {
        const int row0 = u.pm * BM + wr * 64 + fr, col0 = u.pn * 128 + wc * 32 + 8 * fq;
        constexpr int ai = AI; const f32x4 rs4 = rsT ? *(const PG8_LAS f32x4*)(rsT + u.idx * 256 + ((ai * 2 + wr) * 16 + fr) * 4) : (f32x4){1.f, 1.f, 1.f, 1.f};
#pragma unroll
        for (int m = 0; m < 4; ++m) { bf16_t* rowp = H + (size_t)(row0 + ai * HALF + m * 16) * ldh + col0; const float rs = rs4[m] * sc;
            const f32x4 u0 = acc[ai][0][m][0] * rs, u1 = acc[ai][0][m][1] * rs, g0 = acc[ai][1][m][0] * rs, g1 = acc[ai][1][m][1] * rs;
            if constexpr (F8O_) { u32x2 w; w.x = cvt4_fp8(fsilu(g0[0]) * u0[0], fsilu(g0[1]) * u0[1], fsilu(g0[2]) * u0[2], fsilu(g0[3]) * u0[3]);
                w.y = cvt4_fp8(fsilu(g1[0]) * u1[0], fsilu(g1[1]) * u1[1], fsilu(g1[2]) * u1[2], fsilu(g1[3]) * u1[3]);
                *(u32x2*)((unsigned char*)H + (size_t)(row0 + ai * HALF + m * 16) * ldh + col0) = w; }
            else { u32x4 w; w.x = cvt_pk_bf16(fsilu(g0[0]) * u0[0], fsilu(g0[1]) * u0[1]); w.y = cvt_pk_bf16(fsilu(g0[2]) * u0[2], fsilu(g0[3]) * u0[3]);
            w.z = cvt_pk_bf16(fsilu(g1[0]) * u1[0], fsilu(g1[1]) * u1[1]); w.w = cvt_pk_bf16(fsilu(g1[2]) * u1[2], fsilu(g1[3]) * u1[3]);
            *(u32x4*)rowp = w; } }
    }
};
__host__ __device__ __forceinline__ int swiglu_row(int h, int gate) { return (h >> 7) * 256 + gate * 128 + (h & 127); }

template <class Epi, class Sched, bool ALIGN_EPI = false, bool SP2 = false, bool F8 = false>
__device__ __forceinline__ void gemm_phase(PG8_LAS unsigned char* lds, const Gemm g, const Sched& S, const Epi& E) {
    int tid = threadIdx.x; asm volatile("" : "+v"(tid));
    const int wid = __builtin_amdgcn_readfirstlane(tid >> 6), lane = tid & 63, wr = wid >> 2, wc = wid & 3, fr = lane & 15, fq = lane >> 4;
    const int K = g.K, nt = K / BK;
    unsigned voffA, voffB;
    { int R, C; stage_rc(tid * 16, R, C); const int Rb = Epi::PERM ? ((R & ~31) + perm32(R & 31)) : R;
      voffA = (unsigned)(R * g.lda + C) * 2u; voffB = (unsigned)(Rb * g.ldb + C) * 2u; }
    const size_t q64A = (size_t)64 * g.lda * 2, q64B = (size_t)64 * g.ldb * 2;
    const size_t kstep = (size_t)(BK * 2);
    const size_t hstepA = (size_t)HALF * g.lda * 2, hstepB = (size_t)HALF * g.ldb * 2;
    const size_t tstepA = 2 * hstepA, tstepB = 2 * hstepB;
    const unsigned ldsw = (unsigned)wid * 1024u;
    const int aoff = lds_byte(wr * 64 + fr, fq * 8), boff = lds_byte(wc * 32 + fr, fq * 8);
#define PG8_SA(b, h) (((b) * 2 + (h)) * HTB)
#define PG8_SB(b, h) ((4 + (b) * 2 + (h)) * HTB)
#define PG8_STAGE(bufoff, gbase, voff) do { __builtin_amdgcn_global_load_lds((const unsigned*)((const char*)(gbase) + (voff)), (PG8_LAS unsigned*)(lds + (bufoff) + ldsw), 16, 0, 0); \
        __builtin_amdgcn_global_load_lds((const unsigned*)((const char*)(gbase) + PG8_Q64(voff) + (voff)), (PG8_LAS unsigned*)(lds + (bufoff) + ldsw + 8192), 16, 0, 0); } while (0)
#define PG8_Q64(v) PG8_Q64_##v
#define PG8_Q64_voffA q64A
#define PG8_Q64_voffB q64B
#define PG8_LDA(dst, b, h) do { _Pragma("unroll") for (int m = 0; m < 4; ++m) _Pragma("unroll") for (int k = 0; k < 2; ++k) dst[m][k] = *(const PG8_LAS bf16x8*)(lds + PG8_SA(b, h) + aoff + m * 2048 + k * 1024); } while (0)
#define PG8_LDB(dst, b, h) do { _Pragma("unroll") for (int n = 0; n < 2; ++n) _Pragma("unroll") for (int k = 0; k < 2; ++k) dst[n][k] = *(const PG8_LAS bf16x8*)(lds + PG8_SB(b, h) + boff + n * 2048 + k * 1024); } while (0)
#define PG8_MMA(ai, bj, At, Bt) do { __builtin_amdgcn_s_setprio(1); \
        if constexpr (F8) { _Pragma("unroll") for (int m = 0; m < 4; ++m) _Pragma("unroll") for (int n = 0; n < 2; ++n) \
            mfma_f8_inplace(acc[ai][bj][m][n], cat8(Bt[n][0], Bt[n][1]), cat8(At[m][0], At[m][1])); } \
        else { _Pragma("unroll") for (int m = 0; m < 4; ++m) _Pragma("unroll") for (int n = 0; n < 2; ++n) _Pragma("unroll") for (int k = 0; k < 2; ++k) \
            acc[ai][bj][m][n] = __builtin_amdgcn_mfma_f32_16x16x32_bf16(Bt[n][k], At[m][k], acc[ai][bj][m][n], 0, 0, 0); } \
        __builtin_amdgcn_s_setprio(0); } while (0)
#define PG8_WAIT_V(n) asm volatile("s_waitcnt vmcnt(" #n ")" ::: "memory")
#define PG8_WAIT_L(n) asm volatile("s_waitcnt lgkmcnt(" #n ")" ::: "memory")
#define PG8_WAIT_REL(NN) do { if (rel) asm volatile("s_waitcnt vmcnt(%0)" :: "n"(NN) : "memory"); else PG8_WAIT_V(8); } while (0)
#define PG8_BAR __builtin_amdgcn_s_barrier()
#define PG8_SCHED __builtin_amdgcn_sched_barrier(0)
    typename Epi::Pk pk; Unit cur, nxt, pend; int ui = 0; bool pending = false; pend.pm = pend.pn = pend.bn = pend.idx = 0;
    if (!S.next(0, cur)) return;
    f32x4 acc[2][2][4][2];
#pragma unroll
    for (int a = 0; a < 2; ++a)
#pragma unroll
        for (int b = 0; b < 2; ++b)
#pragma unroll
            for (int m = 0; m < 4; ++m)
#pragma unroll
                for (int n = 0; n < 2; ++n) acc[a][b][m][n] = (f32x4){0.f, 0.f, 0.f, 0.f};
    bf16x8 At[4][2], B0[2][2], B1[2][2];
    const char* cA = (const char*)g.A + (size_t)cur.pm * tstepA; const char* cB = (const char*)g.Bt + (size_t)cur.bn * tstepB;
    S.a_ready(cur);
    if constexpr (SP2) {
        PG8_STAGE(PG8_SB(0, 0), cB, voffB); PG8_STAGE(PG8_SB(0, 1), cB + hstepB, voffB); PG8_STAGE(PG8_SA(0, 0), cA, voffA); PG8_STAGE(PG8_SA(0, 1), cA + hstepA, voffA);
        if (wr == 1) PG8_BAR;
        PG8_WAIT_V(2); PG8_BAR;
        PG8_STAGE(PG8_SB(1, 0), cB + kstep, voffB); PG8_STAGE(PG8_SA(1, 0), cA + kstep, voffA); PG8_STAGE(PG8_SB(1, 1), cB + hstepB + kstep, voffB);
        PG8_WAIT_V(6); PG8_BAR;
    } else {
        PG8_STAGE(PG8_SB(0, 0), cB, voffB); PG8_STAGE(PG8_SA(0, 0), cA, voffA); PG8_STAGE(PG8_SB(0, 1), cB + hstepB, voffB); PG8_STAGE(PG8_SA(0, 1), cA + hstepA, voffA);
        if (wr == 1) PG8_BAR;
        PG8_WAIT_V(4); PG8_BAR;
        PG8_STAGE(PG8_SB(1, 0), cB + kstep, voffB); PG8_STAGE(PG8_SA(1, 0), cA + kstep, voffA); PG8_STAGE(PG8_SB(1, 1), cB + hstepB + kstep, voffB);
        PG8_WAIT_V(6); PG8_BAR;
    }
    for (;;) {
        const bool has_next = S.next(ui + 1, nxt);
        const char* nA = has_next ? (const char*)g.A + (size_t)nxt.pm * tstepA : cA; const char* nB = has_next ? (const char*)g.Bt + (size_t)nxt.bn * tstepB : cB;
        for (int t = 0; t < nt; t += 2) {
            const bool last = (t == nt - 2);
            const char* a1 = cA + (size_t)(t + 1) * kstep;
            const char* a2 = last ? nA : cA + (size_t)(t + 2) * kstep; const char* b2 = last ? nB : cB + (size_t)(t + 2) * kstep;
            const char* a3 = a2 + kstep; const char* b3 = b2 + kstep;
            if (last && has_next) S.a_ready(nxt);
            if constexpr (SP2) {
            const bool rel = Epi::SPLIT && pending && t == 0;
            if (rel) { if constexpr (Epi::SPLIT) { PG8_STAGE(PG8_SA(1, 1), a1 + hstepA, voffA); PG8_SCHED;
                if constexpr (Epi::PACK) { E.store1(pk, pend, wr, wc, fr, fq); }
                else { E.template half<1>(acc, pend, wr, wc, fr, fq);
#pragma unroll
                for (int b = 0; b < 2; ++b)
#pragma unroll
                    for (int m = 0; m < 4; ++m)
#pragma unroll
                        for (int n = 0; n < 2; ++n) acc[1][b][m][n] = (f32x4){0.f, 0.f, 0.f, 0.f}; }
                S.done(pend); pending = false;
                PG8_SCHED; PG8_LDB(B0, 0, 0); PG8_LDB(B1, 0, 1); PG8_SCHED; PG8_LDA(At, 0, 0); } }
            else { PG8_LDB(B0, 0, 0); PG8_LDB(B1, 0, 1); PG8_SCHED; PG8_LDA(At, 0, 0); PG8_STAGE(PG8_SA(1, 1), a1 + hstepA, voffA); }
            PG8_WAIT_REL(8 + Epi::NST); PG8_WAIT_L(0); PG8_BAR; PG8_MMA(0, 0, At, B0); PG8_MMA(0, 1, At, B1); PG8_BAR; PG8_SCHED;
            PG8_LDA(At, 0, 1); PG8_STAGE(PG8_SB(0, 0), b2, voffB); PG8_STAGE(PG8_SB(0, 1), b2 + hstepB, voffB); PG8_STAGE(PG8_SA(0, 0), a2, voffA);
            PG8_WAIT_REL(8 + Epi::NST); PG8_WAIT_L(0); PG8_BAR; PG8_MMA(1, 0, At, B0); PG8_MMA(1, 1, At, B1); PG8_BAR; PG8_SCHED;
            PG8_LDB(B0, 1, 0); PG8_LDB(B1, 1, 1); PG8_SCHED; PG8_LDA(At, 1, 0); PG8_STAGE(PG8_SA(0, 1), a2 + hstepA, voffA);
            PG8_WAIT_REL(8 + Epi::NST / 2); PG8_WAIT_L(0); PG8_BAR; PG8_MMA(0, 0, At, B0); PG8_MMA(0, 1, At, B1); PG8_BAR; PG8_SCHED;
            PG8_LDA(At, 1, 1); PG8_STAGE(PG8_SB(1, 0), b3, voffB); PG8_STAGE(PG8_SB(1, 1), b3 + hstepB, voffB); PG8_STAGE(PG8_SA(1, 0), a3, voffA);
            PG8_WAIT_V(8); PG8_WAIT_L(0); PG8_BAR; PG8_MMA(1, 0, At, B0); PG8_MMA(1, 1, At, B1); PG8_BAR; PG8_SCHED;
            } else {
            PG8_LDB(B0, 0, 0); PG8_SCHED; PG8_LDA(At, 0, 0); PG8_STAGE(PG8_SA(1, 1), a1 + hstepA, voffA);
            PG8_WAIT_L(8); PG8_BAR; PG8_WAIT_L(0); PG8_MMA(0, 0, At, B0); PG8_BAR; PG8_SCHED;
            PG8_LDB(B1, 0, 1); PG8_STAGE(PG8_SB(0, 0), b2, voffB);
            PG8_BAR; PG8_WAIT_L(0); PG8_MMA(0, 1, At, B1); PG8_BAR;
            PG8_LDA(At, 0, 1); PG8_STAGE(PG8_SA(0, 0), a2, voffA);
            PG8_BAR; PG8_WAIT_L(0); PG8_MMA(1, 0, At, B0); PG8_BAR; PG8_SCHED;
            PG8_STAGE(PG8_SB(0, 1), b2 + hstepB, voffB);
            PG8_WAIT_V(6); PG8_BAR; PG8_MMA(1, 1, At, B1); PG8_BAR;
            PG8_LDB(B0, 1, 0); PG8_SCHED; PG8_LDA(At, 1, 0); PG8_STAGE(PG8_SA(0, 1), a2 + hstepA, voffA);
            PG8_WAIT_L(8); PG8_BAR; PG8_WAIT_L(0); PG8_MMA(0, 0, At, B0); PG8_BAR; PG8_SCHED;
            PG8_LDB(B1, 1, 1); PG8_STAGE(PG8_SB(1, 0), b3, voffB);
            PG8_BAR; PG8_WAIT_L(0); PG8_MMA(0, 1, At, B1); PG8_BAR;
            PG8_LDA(At, 1, 1); PG8_STAGE(PG8_SA(1, 0), a3, voffA);
            PG8_BAR; PG8_WAIT_L(0); PG8_MMA(1, 0, At, B0); PG8_BAR; PG8_SCHED;
            PG8_STAGE(PG8_SB(1, 1), b3 + hstepB, voffB);
            PG8_WAIT_V(6); PG8_BAR; PG8_MMA(1, 1, At, B1); PG8_BAR;
            }
        }
        if constexpr (F8) asm volatile("s_nop 15\n\ts_nop 15\n\ts_nop 15\n\ts_nop 15" ::: "memory");
        if constexpr (ALIGN_EPI) { if (wr == 0) PG8_BAR; }
        if constexpr (Epi::SPLIT) { static_assert(SP2, "split epilogues need the SP2 loop");
            if (has_next) { E.template half<0>(acc, cur, wr, wc, fr, fq); if constexpr (Epi::PACK) E.pack1(acc, cur, wr, fr, pk); pend = cur; pending = true; }
            else { E.template half<0>(acc, cur, wr, wc, fr, fq); E.template half<1>(acc, cur, wr, wc, fr, fq); S.done(cur); } }
        else if constexpr (!Epi::AFTER_DRAIN) { E(acc, cur, wr, wc, fr, fq); S.done(cur); }
        if (!has_next) break;
#pragma unroll
        for (int a = 0; a < ((Epi::SPLIT && !Epi::PACK) ? 1 : 2); ++a)
#pragma unroll
            for (int b = 0; b < 2; ++b)
#pragma unroll
                for (int m = 0; m < 4; ++m)
#pragma unroll
                    for (int n = 0; n < 2; ++n) acc[a][b][m][n] = (f32x4){0.f, 0.f, 0.f, 0.f};
        cur = nxt; cA = nA; cB = nB; ++ui;
        if constexpr (ALIGN_EPI) { if (wr == 1) PG8_BAR; }
    }
    PG8_WAIT_V(0);
    if constexpr (!ALIGN_EPI) { if (wr == 0) PG8_BAR; }
    PG8_BAR;
    if constexpr (Epi::AFTER_DRAIN) { E.fused(acc, cur, wr, wc, fr, fq, lds, wid, lane); S.done(cur); }
#undef PG8_SA
#undef PG8_SB
#undef PG8_STAGE
#undef PG8_Q64
#undef PG8_Q64_voffA
#undef PG8_Q64_voffB
#undef PG8_LDA
#undef PG8_LDB
#undef PG8_MMA
#undef PG8_WAIT_V
#undef PG8_WAIT_L
#undef PG8_WAIT_REL
#undef PG8_BAR
#undef PG8_SCHED
}
}
#define PG8_SP2 true
#define PG8_ALIGN true
constexpr int NWAVES = 8, NTHR = 512;
constexpr int BATCH = 2, SEQ = 8192, D = 1024, M = BATCH * SEQ;
constexpr int MEMLEN = 256, MMEM = BATCH * MEMLEN;
constexpr int EV_IN = 4632, EV_INP = 4864;
constexpr int OD_IN = 5152, OD_INP = 5376;
constexpr int FF = 2816, FFE = 3584, NEXP = 8;
constexpr float MOE_W2_SCALE = 128.f;
constexpr float MOE_W13_SCALE = 64.f;
constexpr int NQB = SEQ / 64;
constexpr int XH = 4;
constexpr float EPS = 1e-6f;
constexpr int MOE_ROWS = 2 * M + NEXP * 256;
constexpr int MOE_TILES = MOE_ROWS / 256;

constexpr size_t MiB = 1u << 20;
constexpr size_t WS_CTL = 0, CTL_ZERO_BYTES = 1 * MiB;
constexpr size_t WS_SMALL = 1 * MiB;
constexpr size_t WS_CMPB_PART = WS_SMALL;
constexpr size_t WS_CMPB = WS_SMALL + 256 * 1024;
constexpr size_t WS_OV = WS_SMALL + 512 * 1024;
constexpr size_t WS_MEMN = 2 * MiB;
constexpr size_t WS_KVM = 4 * MiB;
constexpr size_t WS_KM = 6 * MiB;
constexpr size_t WS_HID = 7 * MiB;
constexpr size_t WS_KVCMP = 9 * MiB;
constexpr size_t WS_MOEIDX = 10 * MiB;
constexpr size_t WS_SSQ = 14 * MiB;
constexpr size_t WS_W = 16 * MiB;
constexpr size_t WS_W_EVIN = WS_W, WS_W_EVOUT = WS_W_EVIN + 10 * MiB, WS_W_CK1 = WS_W_EVOUT + 4 * MiB, WS_W_CV1 = WS_W_CK1 + 2 * MiB, WS_W_ODIN = WS_W_CV1 + 2 * MiB,
                 WS_W_ODOUT = WS_W_ODIN + 11 * MiB, WS_W_XQ = WS_W_ODOUT + 4 * MiB, WS_W_XKV = WS_W_XQ + 2 * MiB, WS_W_XO = WS_W_XKV + 4 * MiB, WS_W_FF13 = WS_W_XO + 2 * MiB,
                 WS_W_FF2 = WS_W_FF13 + 11 * MiB, WS_W_M13 = WS_W_FF2 + 6 * MiB, WS_W_M2 = WS_W_M13 + 112 * MiB, WS_W_END = WS_W_M2 + 56 * MiB;
constexpr size_t WS_XN = WS_W_END;
constexpr size_t WS_QX = WS_XN + 32 * MiB, WS_OX = WS_QX + 16 * MiB, WS_R = WS_OX + 16 * MiB;
constexpr size_t WS_Y0 = WS_R, WS_KV6 = WS_R + 152 * MiB, WS_MIX = WS_R + 201 * MiB, WS_H = WS_R + 265 * MiB;
constexpr size_t WS_Y1 = WS_R, WS_YG = WS_R + 168 * MiB;
constexpr size_t WS_XN8 = WS_QX;
constexpr size_t WS_XP = WS_R, WS_HP = WS_R + 68 * MiB, WS_YP = WS_R + 306 * MiB, WS_END = WS_R + 442 * MiB;
static_assert(WS_W_END == 242 * MiB && WS_END == 748 * MiB, "ws map");
constexpr int CW_TMO = 0, CW_CODE = 1, CW_CHK = 2;
constexpr int CW_BAR = 4096;
constexpr int CW_MOECNT = 16384;
constexpr int CW_MOEOFF = 20480;

constexpr int LDS_BYTES = 159744;
constexpr int MISC_OFF = LDS_BYTES - 512;
constexpr int SCR_BYTES = MISC_OFF;

#define GAS __attribute__((address_space(1)))
#define LAS __attribute__((address_space(3)))
typedef unsigned short bf16;
typedef unsigned v4u __attribute__((ext_vector_type(4)));
typedef unsigned v2u __attribute__((ext_vector_type(2)));
typedef float f32x4 __attribute__((ext_vector_type(4)));
typedef float f32x16 __attribute__((ext_vector_type(16)));
typedef short bf16x8 __attribute__((ext_vector_type(8)));
typedef short s16x4 __attribute__((ext_vector_type(4)));
typedef GAS unsigned gu32;
#define RLX_AGENT __ATOMIC_RELAXED, __HIP_MEMORY_SCOPE_AGENT
#define LDS_WAIT() asm volatile("s_waitcnt lgkmcnt(0)" ::: "memory")
#define VM_WAIT() asm volatile("s_waitcnt vmcnt(0)" ::: "memory")
#define SBAR() __builtin_amdgcn_sched_barrier(0)
__device__ __forceinline__ int lane_id() { return (int)threadIdx.x & 63; }
__device__ __forceinline__ unsigned f2bf(float f) { unsigned u = __builtin_bit_cast(unsigned, f); return (u + 0x7fffu + ((u >> 16) & 1u)) >> 16; }
__device__ __forceinline__ unsigned pk2(float lo, float hi) { return f2bf(lo) | (f2bf(hi) << 16); }
__device__ __forceinline__ float bf2f(unsigned short b) { return __builtin_bit_cast(float, ((unsigned)b) << 16); }
__device__ __forceinline__ float bflo(unsigned w) { return __builtin_bit_cast(float, w << 16); }
__device__ __forceinline__ float bfhi(unsigned w) { return __builtin_bit_cast(float, w & 0xffff0000u); }
__device__ __forceinline__ unsigned cvtpk(float lo, float hi) { unsigned r; asm volatile("v_cvt_pk_bf16_f32 %0, %1, %2" : "=v"(r) : "v"(lo), "v"(hi)); return r; }
__device__ __forceinline__ float wave_sum(float v) {
#pragma unroll
    for (int o = 1; o < 64; o <<= 1) v += __shfl_xor(v, o);
    return v;
}
using pg8::fsigmoid; using pg8::gelu_tanh; using pg8::fsilu;
__device__ __forceinline__ float fsoftplus(float x) { return x > 20.f ? x : log1pf(__expf(x)); }

#define XB_TMO      128
#define XB_XCNT(j)  (256  + 64 * (j))
#define XB_XSUB(j)  (1280 + 64 * (j))
#define XB_XGEN(j)  (2304 + 64 * (j))
#define XB_TOP      3328
#define XB_TOPGEN   3392
#define XCD_BAR_WORDS 3456
#define XB_SPIN_CAP (1u << 18)

__device__ __forceinline__ unsigned xb_ld(unsigned* p)              { return __hip_atomic_load(p, __ATOMIC_RELAXED, __HIP_MEMORY_SCOPE_AGENT); }
__device__ __forceinline__ unsigned xb_add(unsigned* p, unsigned v) { return __hip_atomic_fetch_add(p, v, __ATOMIC_RELAXED, __HIP_MEMORY_SCOPE_AGENT); }
__device__ __forceinline__ unsigned xb_xcc_id() { return (unsigned)__builtin_amdgcn_s_getreg((3 << 11) | 20) & 0xFu; }
#define XB_SPIN(cond, bar) do { unsigned _sp = 0; while (cond) { __builtin_amdgcn_s_sleep(1); \
    if ((++_sp & 255u) == 0u) { if (xb_ld(&(bar)[XB_TMO])) break; if (_sp > XB_SPIN_CAP) { atomicAdd(&(bar)[XB_TMO], 1u); break; } } } } while (0)

struct XcdBarrier {
    unsigned* bar; unsigned x;
    volatile LAS unsigned* st;
};

__device__ __forceinline__ XcdBarrier xcd_barrier_post(unsigned* bar, volatile LAS unsigned* st) {
    XcdBarrier b; b.bar = bar; b.x = xb_xcc_id(); b.st = st;
    if (threadIdx.x == 0) (void)xb_add(&bar[XB_XCNT(b.x)], 1u);
    return b;
}
__device__ __forceinline__ void xcd_barrier_complete(unsigned* bar, unsigned x, unsigned& nloc, unsigned& nx) {
    const unsigned G = gridDim.x * gridDim.y * gridDim.z;
    unsigned sum, cnt, mine, sp = 0u;
    for (;;) {
        sum = 0u; cnt = 0u; mine = 0u;
#pragma unroll
        for (unsigned j = 0; j < 16; ++j) { const unsigned c = xb_ld(&bar[XB_XCNT(j)]); sum += c; cnt += (c > 0u) ? 1u : 0u; mine = (j == x) ? c : mine; }
        if (sum == G) break;
        __builtin_amdgcn_s_sleep(1);
        if ((++sp & 255u) == 0u) { if (xb_ld(&bar[XB_TMO])) break; if (sp > XB_SPIN_CAP) { atomicAdd(&bar[XB_TMO], 1u); break; } }
    }
    nloc = mine > 0u ? mine : 1u; nx = cnt > 0u ? cnt : 1u;
}

__device__ __forceinline__ void xcd_barrier(const XcdBarrier& b) {
    asm volatile("s_waitcnt vmcnt(0)" ::: "memory");
    __syncthreads();
    if (threadIdx.x == 0) {
        unsigned* bar = b.bar;
        __builtin_amdgcn_s_waitcnt(0);
        unsigned nloc = b.st[0], nx = b.st[1];
        if (nloc == 0u) { xcd_barrier_complete(bar, b.x, nloc, nx); b.st[0] = nloc; b.st[1] = nx; }
        const unsigned old = xb_add(&bar[XB_XSUB(b.x)], 1u);
        const unsigned gen = old / nloc;
        if (old + 1u == (gen + 1u) * nloc) {
            __builtin_amdgcn_fence(__ATOMIC_RELEASE, "agent");
            asm volatile("s_waitcnt vmcnt(0)" ::: "memory");
            const unsigned og = xb_add(&bar[XB_TOP], 1u);
            const unsigned tg = og / nx;
            if (og + 1u == (tg + 1u) * nx) xb_add(&bar[XB_TOPGEN], 1u);
            else XB_SPIN(xb_ld(&bar[XB_TOPGEN]) == tg, bar);
            __builtin_amdgcn_fence(__ATOMIC_ACQUIRE, "agent");
            xb_add(&bar[XB_XGEN(b.x)], 1u);
            asm volatile("s_waitcnt vmcnt(0)" ::: "memory");
        } else {
            XB_SPIN(xb_ld(&bar[XB_XGEN(b.x)]) == gen, bar);
            __builtin_amdgcn_fence(__ATOMIC_ACQUIRE, "agent");
            asm volatile("s_waitcnt vmcnt(0)" ::: "memory");
        }
    }
    __syncthreads();
}

struct Args { const float* in[41]; float* out; unsigned char* ws; int ph_lo, ph_hi, li, pad; };
struct Frame { LAS unsigned char* lds; volatile LAS unsigned* MISC; gu32* ctl; unsigned char* ws; int tid, lane, wave, G, bid; };
enum { I_X = 0, I_MEM, I_NMIX, I_NCROSS, I_NMEM, I_NFFN, I_EVWIN, I_RGCW, I_RGCB, I_RGWA, I_RGBA, I_RGWX, I_RGBX, I_RGLAM, I_GATEB, I_QNORM, I_KNORM, I_CMPPOS,
       I_CKW1, I_CKW2, I_CVW1, I_CVW2, I_EVWOUT, I_ODWIN, I_ODCW, I_ODCB, I_DTB, I_ALOG, I_DSKIP, I_ODNORM, I_ODWOUT, I_XWQ, I_XWKV, I_XQN, I_XKN, I_XWO,
       I_FFW13, I_FFW2, I_ROUTER, I_MW13, I_MW2, N_IN };
static_assert(N_IN == 41, "input count");

template <int MAP>
__device__ __forceinline__ void transpose_item(const float* W, int N, bf16* WT, int ldt, LAS float* scr, int kb, int nb, int lane, int ffs, const float* kg = nullptr) {
    const int k0 = 64 * kb, n0 = 64 * nb; const int c4 = (lane & 15) * 4, r4 = lane >> 4;
    f32x4 tv[16];
    if ((N & 3) == 0) {
#pragma unroll
        for (int i = 0; i < 16; ++i) { const int kk = 4 * i + r4; tv[i] = (n0 + c4 < N) ? *(const GAS f32x4*)(W + (size_t)(k0 + kk) * N + n0 + c4) : (f32x4){0.f, 0.f, 0.f, 0.f}; }
    } else {
#pragma unroll
        for (int i = 0; i < 16; ++i) { const int kk = 4 * i + r4; const float* src = W + (size_t)(k0 + kk) * N + n0 + c4;
#pragma unroll
            for (int j = 0; j < 4; ++j) tv[i][j] = (n0 + c4 + j < N) ? src[j] : 0.f; }
    }
#pragma unroll
    for (int i = 0; i < 16; ++i) { const int kk = 4 * i + r4; const float gk = kg ? kg[k0 + kk] : 1.f;
#pragma unroll
        for (int j = 0; j < 4; ++j) scr[kk * 65 + c4 + j] = tv[i][j] * gk; }
    LDS_WAIT(); asm volatile("" ::: "memory");
    const int c = lane & 7;
#pragma unroll
    for (int j = 0; j < 8; ++j) { const int nl = (lane >> 3) + 8 * j, n = n0 + nl; const LAS float* s = scr + (8 * c) * 65 + nl;
        v4u o; o.x = pk2(s[0 * 65], s[1 * 65]); o.y = pk2(s[2 * 65], s[3 * 65]); o.z = pk2(s[4 * 65], s[5 * 65]); o.w = pk2(s[6 * 65], s[7 * 65]);
        int row = n; if (MAP == 1) row = (n < ffs) ? pg8::swiglu_row(n, 0) : pg8::swiglu_row(n - ffs, 1);
        if (n < ((N + 31) & ~31)) *(GAS v4u*)(WT + (size_t)row * ldt + k0 + 8 * c) = o; }
    LDS_WAIT(); asm volatile("" ::: "memory");
}
__device__ __forceinline__ unsigned pk4_fp8(float a, float b, float c, float d) { int r = __builtin_amdgcn_cvt_pk_fp8_f32(a, b, 0, false); r = __builtin_amdgcn_cvt_pk_fp8_f32(c, d, r, true); return (unsigned)r; }
template <int MAP>
__device__ __forceinline__ void transpose_item_f8(const float* W, int N, unsigned char* WT8, int ldt, LAS float* scr, int kb, int nb, int lane, int ffs, float sc) {
    const int k0 = 64 * kb, n0 = 64 * nb; const int c4 = (lane & 15) * 4, r4 = lane >> 4;
    f32x4 tv[16];
#pragma unroll
    for (int i = 0; i < 16; ++i) { const int kk = 4 * i + r4; tv[i] = *(const GAS f32x4*)(W + (size_t)(k0 + kk) * N + n0 + c4); }
#pragma unroll
    for (int i = 0; i < 16; ++i) { const int kk = 4 * i + r4;
#pragma unroll
        for (int j = 0; j < 4; ++j) scr[kk * 65 + c4 + j] = tv[i][j] * sc; }
    LDS_WAIT(); asm volatile("" ::: "memory");
    const int c = lane & 7;
#pragma unroll
    for (int j = 0; j < 8; ++j) { const int nl = (lane >> 3) + 8 * j, n = n0 + nl; const LAS float* s = scr + (8 * c) * 65 + nl;
        v2u o; o.x = pk4_fp8(s[0 * 65], s[1 * 65], s[2 * 65], s[3 * 65]); o.y = pk4_fp8(s[4 * 65], s[5 * 65], s[6 * 65], s[7 * 65]);
        int row = n; if (MAP == 1) row = (n < ffs) ? pg8::swiglu_row(n, 0) : pg8::swiglu_row(n - ffs, 1);
        *(GAS v2u*)(WT8 + (size_t)row * ldt + k0 + 8 * c) = o; }
    LDS_WAIT(); asm volatile("" ::: "memory");
}
constexpr int MOE_CONV_ITEMS = NEXP * (16 * 112 + 56 * 16);

__device__ __forceinline__ void rms_row_to_bf16(const float* xrow, const float* g, bf16* orow, int lane) {
    const GAS f32x4* xr = (const GAS f32x4*)xrow + lane; const GAS f32x4* gr = (const GAS f32x4*)g + lane;
    f32x4 v[4]; float s = 0.f;
#pragma unroll
    for (int j = 0; j < 4; ++j) { v[j] = xr[64 * j]; s += (v[j].x * v[j].x + v[j].y * v[j].y) + (v[j].z * v[j].z + v[j].w * v[j].w); }
    const float rstd = 1.f / sqrtf(wave_sum(s) * (1.f / D) + EPS);
    GAS unsigned long long* o8 = (GAS unsigned long long*)orow + lane;
#pragma unroll
    for (int j = 0; j < 4; ++j) { const f32x4 gg = gr[64 * j];
        o8[64 * j] = (unsigned long long)pk2(v[j].x * rstd * gg.x, v[j].y * rstd * gg.y) | ((unsigned long long)pk2(v[j].z * rstd * gg.z, v[j].w * rstd * gg.w) << 32); }
}
__device__ __forceinline__ void phase_rmsnorm(const Frame& F, const float* x, const float* g, bf16* xn, int rows) {
    const int gw = F.bid * NWAVES + F.wave, NGW = F.G * NWAVES;
    for (int m = gw; m < rows; m += NGW) rms_row_to_bf16(x + (size_t)m * D, g, xn + (size_t)m * D, F.lane);
}
#define TR_MAT(cnt_, W_, K_, N_, WT_, ldt_, MAPK_, ffs_, kg_) \
    if (r < (cnt_)) { const int nblk_ = ((N_) + 63) / 64; transpose_item<MAPK_>((W_), (N_), (WT_), (ldt_), scr, r / nblk_, r % nblk_, F.lane, (ffs_), (kg_)); continue; } r -= (cnt_);
constexpr int C_EVIN = 16 * 73, C_EVOUT = 32 * 16, C_CW1 = 64 * 4, C_ODIN = 16 * 81, C_ODOUT = 32 * 16, C_XQ = 16 * 8, C_XKV = 16 * 16, C_XO = 8 * 16, C_FF13 = 16 * 88, C_FF2 = 44 * 16;
constexpr int CONV_A = C_EVIN + 2 * C_XKV + 2 * C_CW1, CONV_B = C_EVOUT + 2 * C_XQ + 2 * C_XO + C_FF13 + C_FF2 + C_ODIN + C_ODOUT;
constexpr int CONV_ALL = CONV_A + CONV_B + MOE_CONV_ITEMS, CONV_Q = 4480, CONV_P2_END = CONV_ALL - 2 * CONV_Q;
__device__ __forceinline__ void convert_range(const Frame& F, const Args& a, int gw, int NGW, int it_lo, int it_hi) {
    LAS float* scr = (LAS float*)(F.lds + F.wave * 16640); unsigned char* ws = F.ws;
    for (int it = it_lo + gw; it < it_hi; it += NGW) {
        int r = it;
        TR_MAT(C_EVIN, a.in[I_EVWIN], D, EV_IN, (bf16*)(ws + WS_W_EVIN), D, 0, 0, nullptr)
        TR_MAT(C_XKV, a.in[I_XWKV], D, 1024, (bf16*)(ws + WS_W_XKV), D, 0, 0, nullptr)
        TR_MAT(C_XKV, a.in[I_XWKV] + (size_t)D * 1024, D, 1024, (bf16*)(ws + WS_W_XKV) + (size_t)1024 * D, D, 0, 0, nullptr)
        TR_MAT(C_CW1, a.in[I_CKW1], 4096, 256, (bf16*)(ws + WS_W_CK1), 4096, 0, 0, nullptr)
        TR_MAT(C_CW1, a.in[I_CVW1], 4096, 256, (bf16*)(ws + WS_W_CV1), 4096, 0, 0, nullptr)
        TR_MAT(C_EVOUT, a.in[I_EVWOUT], 2048, D, (bf16*)(ws + WS_W_EVOUT), 2048, 0, 0, nullptr)
        TR_MAT(C_XQ, a.in[I_XWQ], D, 512, (bf16*)(ws + WS_W_XQ), D, 0, 0, a.in[I_NCROSS])
        TR_MAT(C_XO, a.in[I_XWO], 512, D, (bf16*)(ws + WS_W_XO), 512, 0, 0, nullptr)
        TR_MAT(C_FF13, a.in[I_FFW13], D, 2 * FF, (bf16*)(ws + WS_W_FF13), D, 1, FF, a.in[I_NFFN])
        TR_MAT(C_FF2, a.in[I_FFW2], FF, D, (bf16*)(ws + WS_W_FF2), FF, 0, 0, nullptr)
        TR_MAT(C_ODIN, a.in[I_ODWIN], D, OD_IN, (bf16*)(ws + WS_W_ODIN), D, 0, 0, a.in[I_NMIX] + D)
        TR_MAT(C_ODOUT, a.in[I_ODWOUT], 2048, D, (bf16*)(ws + WS_W_ODOUT), 2048, 0, 0, nullptr)
        TR_MAT(C_XQ, a.in[I_XWQ] + (size_t)D * 512, D, 512, (bf16*)(ws + WS_W_XQ) + (size_t)512 * D, D, 0, 0, a.in[I_NCROSS] + D)
        TR_MAT(C_XO, a.in[I_XWO] + (size_t)512 * D, 512, D, (bf16*)(ws + WS_W_XO) + (size_t)D * 512, 512, 0, 0, nullptr)
        { constexpr int C_M13 = 16 * 112, C_M2 = 56 * 16;
          if (r < NEXP * C_M13) { const int e = r / C_M13, q = r % C_M13; transpose_item_f8<1>(a.in[I_MW13] + (size_t)e * D * 2 * FFE, 2 * FFE, ws + WS_W_M13 + (size_t)e * 2 * FFE * D, D, scr, q / 112, q % 112, F.lane, FFE, MOE_W13_SCALE); continue; } r -= NEXP * C_M13;
          { const int e = r / C_M2, q = r % C_M2; transpose_item_f8<0>(a.in[I_MW2] + (size_t)e * FFE * D, D, ws + WS_W_M2 + (size_t)e * D * FFE, FFE, scr, q / 16, q % 16, F.lane, 0, MOE_W2_SCALE); } }
    }
}
__device__ __forceinline__ void p0_prologue(const Frame& F, const Args& a) {
    const int gw = F.bid * NWAVES + F.wave, NGW = F.G * NWAVES;
    unsigned char* ws = F.ws;
    convert_range(F, a, gw, NGW, 0, CONV_A);
    for (int i = F.bid * NTHR + F.tid; i < 2 * 224 * 128; i += F.G * NTHR) { const int w = i / (224 * 128), q = i % (224 * 128);
        bf16* base = w == 0 ? (bf16*)(ws + WS_W_EVIN) + (size_t)4640 * D : (bf16*)(ws + WS_W_ODIN) + (size_t)5152 * D; *(GAS v4u*)(base + (size_t)q * 8) = (v4u){0u, 0u, 0u, 0u}; }
    phase_rmsnorm(F, a.in[I_X], a.in[I_NMIX], (bf16*)(ws + WS_XN), M);
    phase_rmsnorm(F, a.in[I_MEM], a.in[I_NMEM], (bf16*)(ws + WS_MEMN), MMEM);
    phase_rmsnorm(F, a.in[I_MEM], a.in[I_NMEM] + D, (bf16*)(ws + WS_MEMN) + (size_t)MMEM * D, MMEM);
    for (int i = F.bid * NTHR + F.tid; i < 512 * 128; i += F.G * NTHR) { const int n = i >> 7, j = i & 127; ((bf16*)(ws + WS_OV))[i] = (n <= 510 && n >= 4 * j - 1 && n <= 4 * j + 3) ? (bf16)0x3F80 : (bf16)0; }
    for (int it = gw; it < 128; it += NGW) { const int mm = it >> 6, ic = it & 63; const float* w1 = a.in[mm ? I_CVW1 : I_CKW1]; const float* pos = a.in[I_CMPPOS];
        f32x4 acc = {0.f, 0.f, 0.f, 0.f};
        for (int rr = 0; rr < 64; ++rr) { const int i = ic * 64 + rr; const float p = pos[i]; const f32x4 w = *(const GAS f32x4*)(w1 + (size_t)i * 256 + 4 * F.lane); acc += w * p; }
        *(GAS f32x4*)((float*)(ws + WS_CMPB_PART) + (size_t)(mm * 64 + ic) * 256 + 4 * F.lane) = acc; }
}
#undef TR_MAT
namespace att {
constexpr float SCALE = 0.08838834764831845f;
constexpr float THR = 8.f;
constexpr int KVBLK = 64, DH = 128;
constexpr int SHM_V = KVBLK * DH * 2, SHM_K = KVBLK * DH * 2;
constexpr int NSLOT = 3;
constexpr int LDS_ATT = NSLOT * SHM_V + NSLOT * SHM_K + NWAVES * 64 * 4;
#define KSWZ(row, colB) ((row) * 256 + ((colB) ^ (((row) & 7) << 4)))
__device__ __forceinline__ int v_st(int k, int c) { const int kk = (k & ~0xC) | ((k & 4) << 1) | ((k & 8) >> 1); return ((kk >> 3) * 4 + (c >> 5)) * 512 + ((kk & 7) * 32 + (c & 31)) * 2; }
__device__ __forceinline__ int v_rd_base(int lane) { return ((lane & 3) << 3) | (((lane >> 2) & 3) << 6) | (((lane >> 4) & 1) << 5) | (((lane >> 5) & 1) << 8); }
constexpr int v_rd_off(int d0, int ks, int half) { return d0 * 512 + ks * 4096 + half * 2048; }
__device__ __forceinline__ int crow(int r, int hi) { return (r & 3) + 8 * (r >> 2) + 4 * hi; }
__device__ __forceinline__ bf16x8 pack8(f32x4 a, f32x4 b) { v4u w = {cvtpk(a[0], a[1]), cvtpk(a[2], a[3]), cvtpk(b[0], b[1]), cvtpk(b[2], b[3])}; return *reinterpret_cast<bf16x8*>(&w); }

__device__ __forceinline__ void mask_tile(f32x16& p0, f32x16& p1, int dq, unsigned W) {
    asm volatile("" : "+v"(dq));
    const float NEG = -__builtin_inff();
#pragma unroll
    for (int r = 0; r < 16; ++r) { const int c = (r & 3) + 8 * (r >> 2);
        if ((unsigned)(dq - c) >= W) p0[r] = NEG;
        if ((unsigned)(dq - c - 32) >= W) p1[r] = NEG; }
}
__device__ __forceinline__ void mask_all(f32x16& p0, f32x16& p1) { const float NEG = -__builtin_inff();
#pragma unroll
    for (int r = 0; r < 16; ++r) { p0[r] = NEG; p1[r] = NEG; } }
__device__ __forceinline__ void partialSM(f32x16& p0, f32x16& p1, float& m_reg, float& mn, float& alpha, bool keep = true) {
    float pmax = p0[0];
#pragma unroll
    for (int r = 1; r < 16; ++r) pmax = fmaxf(pmax, p0[r]);
#pragma unroll
    for (int r = 0; r < 16; ++r) pmax = fmaxf(pmax, p1[r]);
    pmax = keep ? pmax : -__builtin_inff();
    { auto rr = __builtin_amdgcn_permlane32_swap(__float_as_uint(pmax), __float_as_uint(pmax), false, false);
      pmax = fmaxf(__uint_as_float(rr[0]), __uint_as_float(rr[1])); }
    constexpr float C2 = 1.4426950408889634f * SCALE;
    if (__builtin_expect(__all((pmax - m_reg) * SCALE <= THR), 1)) { mn = m_reg; alpha = 1.f; }
    else { mn = fmaxf(m_reg, pmax); alpha = __builtin_amdgcn_exp2f((m_reg - mn) * C2); m_reg = mn; }
    const float mnL = keep ? -mn * C2 : -__builtin_inff();
#pragma unroll
    for (int r = 0; r < 16; ++r) p0[r] = fmaf(p0[r], C2, mnL);
#pragma unroll
    for (int r = 0; r < 16; ++r) p1[r] = fmaf(p1[r], C2, mnL);
#pragma unroll
    for (int r = 0; r < 16; ++r) p0[r] = __builtin_amdgcn_exp2f(p0[r]);
}
__device__ __forceinline__ void finishSM(f32x16& p0, f32x16& p1, float alpha, float& l_reg, bf16x8& pa0, bf16x8& pa1, bf16x8& pa2, bf16x8& pa3) {
#pragma unroll
    for (int r = 0; r < 16; ++r) p1[r] = __builtin_amdgcn_exp2f(p1[r]);
    float ps = 0;
#pragma unroll
    for (int r = 0; r < 16; ++r) ps += p0[r];
#pragma unroll
    for (int r = 0; r < 16; ++r) ps += p1[r];
    { auto rr = __builtin_amdgcn_permlane32_swap(__float_as_uint(ps), __float_as_uint(ps), false, false);
      ps = __uint_as_float(rr[0]) + __uint_as_float(rr[1]); }
    l_reg = l_reg * alpha + ps;
#define PK4(P, B_, OUT) do { unsigned a0 = cvtpk(P[B_+0], P[B_+1]), a1 = cvtpk(P[B_+2], P[B_+3]);                          \
        unsigned b0 = cvtpk(P[B_+4], P[B_+5]), b1 = cvtpk(P[B_+6], P[B_+7]);                                             \
        auto r0 = __builtin_amdgcn_permlane32_swap(a0, b0, false, false); auto r1 = __builtin_amdgcn_permlane32_swap(a1, b1, false, false); \
        v4u w = {r0[0], r1[0], r0[1], r1[1]}; OUT = *reinterpret_cast<bf16x8*>(&w); } while (0)
    PK4(p0, 0, pa0); PK4(p0, 8, pa1); PK4(p1, 0, pa2); PK4(p1, 8, pa3);
#undef PK4
}
__device__ __forceinline__ void qkt(f32x16& p0, f32x16& p1, const char* Kslot, int r32, int hi, const bf16x8* qr) {
    p0 = f32x16{}; p1 = f32x16{};
    const char* kb[4];
#pragma unroll
    for (int dd = 0; dd < 4; ++dd) kb[dd] = Kslot + KSWZ(r32, (dd * 16 + hi * 8) * 2);
    bf16x8 fa[4], fb[4];
#define KLD(dst, i, d0) do { const char* a_ = kb[(d0) & 3] + ((d0) >> 2) * 128; dst[i] = *reinterpret_cast<const bf16x8*>(a_); dst[i + 1] = *reinterpret_cast<const bf16x8*>(a_ + 32 * 256); } while (0)
#define KMM(src, i, d0) do { p0 = __builtin_amdgcn_mfma_f32_32x32x16_bf16(src[i], qr[d0], p0, 0, 0, 0); p1 = __builtin_amdgcn_mfma_f32_32x32x16_bf16(src[i + 1], qr[d0], p1, 0, 0, 0); } while (0)
    KLD(fa, 0, 0); KLD(fa, 2, 1); KLD(fb, 0, 2); KLD(fb, 2, 3); SBAR();
    KMM(fa, 0, 0); KMM(fa, 2, 1); SBAR(); KLD(fa, 0, 4); KLD(fa, 2, 5); SBAR();
    KMM(fb, 0, 2); KMM(fb, 2, 3); SBAR(); KLD(fb, 0, 6); KLD(fb, 2, 7); SBAR();
    KMM(fa, 0, 4); KMM(fa, 2, 5); SBAR();
    KMM(fb, 0, 6); KMM(fb, 2, 7);
#undef KLD
#undef KMM
}
__device__ __forceinline__ void pv_tile(f32x16* o, int vbs, bf16x8 pa0, bf16x8 pa1, bf16x8 pa2, bf16x8 pa3) {
#define TRRD(dst, off) asm volatile("ds_read_b64_tr_b16 %0, %1 offset:%2" : "=&v"(dst) : "v"(vbs), "i"(off) : "memory")
#define PV_D0(d0) do { s16x4 l0, l1, l2, l3, h0, h1, h2, h3; constexpr int b_ = v_rd_off(d0, 0, 0); \
        TRRD(l0, b_); TRRD(h0, b_ + 2048); TRRD(l1, b_ + 4096); TRRD(h1, b_ + 6144); TRRD(l2, b_ + 8192); TRRD(h2, b_ + 10240); TRRD(l3, b_ + 12288); TRRD(h3, b_ + 14336); \
        asm volatile("s_waitcnt lgkmcnt(0)" ::: "memory"); SBAR();   \
        o[d0] = __builtin_amdgcn_mfma_f32_32x32x16_bf16(pa0, (bf16x8){l0[0], l0[1], l0[2], l0[3], h0[0], h0[1], h0[2], h0[3]}, o[d0], 0, 0, 0);   \
        o[d0] = __builtin_amdgcn_mfma_f32_32x32x16_bf16(pa1, (bf16x8){l1[0], l1[1], l1[2], l1[3], h1[0], h1[1], h1[2], h1[3]}, o[d0], 0, 0, 0);   \
        o[d0] = __builtin_amdgcn_mfma_f32_32x32x16_bf16(pa2, (bf16x8){l2[0], l2[1], l2[2], l2[3], h2[0], h2[1], h2[2], h2[3]}, o[d0], 0, 0, 0);   \
        o[d0] = __builtin_amdgcn_mfma_f32_32x32x16_bf16(pa3, (bf16x8){l3[0], l3[1], l3[2], l3[3], h3[0], h3[1], h3[2], h3[3]}, o[d0], 0, 0, 0); } while (0)
    PV_D0(0); PV_D0(1); PV_D0(2); PV_D0(3);
#undef PV_D0
#undef TRRD
}
__device__ __forceinline__ void q_issue(const bf16* qrow, int hi, v4u (&raw)[8]) {
#pragma unroll
    for (int d0 = 0; d0 < 8; ++d0) raw[d0] = *(const GAS v4u*)(qrow + d0 * 16 + hi * 8);
}
__device__ __forceinline__ void q_finish(const v4u (&raw)[8], const float* g, int hi, bf16x8* qr) {
    float ss = 0.f;
#pragma unroll
    for (int d0 = 0; d0 < 8; ++d0)
#pragma unroll
        for (int j = 0; j < 4; ++j) { const float a = bflo(raw[d0][j]), b = bfhi(raw[d0][j]); ss += a * a + b * b; }
    ss += __shfl_xor(ss, 32);
    const float rstd = 1.f / sqrtf(ss * (1.f / 128.f) + EPS);
#pragma unroll
    for (int d0 = 0; d0 < 8; ++d0) { const f32x4 g0 = *(const GAS f32x4*)(g + d0 * 16 + hi * 8), g1 = *(const GAS f32x4*)(g + d0 * 16 + hi * 8 + 4);
        v4u w; w.x = cvtpk(bflo(raw[d0][0]) * rstd * g0[0], bfhi(raw[d0][0]) * rstd * g0[1]); w.y = cvtpk(bflo(raw[d0][1]) * rstd * g0[2], bfhi(raw[d0][1]) * rstd * g0[3]);
        w.z = cvtpk(bflo(raw[d0][2]) * rstd * g1[0], bfhi(raw[d0][2]) * rstd * g1[1]); w.w = cvtpk(bflo(raw[d0][3]) * rstd * g1[2], bfhi(raw[d0][3]) * rstd * g1[3]);
        qr[d0] = *reinterpret_cast<bf16x8*>(&w); }
}
__device__ __forceinline__ void load_q(const bf16* qrow, const float* g, int hi, bf16x8* qr) { v4u raw[8]; q_issue(qrow, hi, raw); q_finish(raw, g, hi, qr); }
struct PassIO { const bf16* Kp; int ldk; const bf16* Vp; int ldv; int t_lo, t_hi; };
__device__ __forceinline__ void dma_offsets(int wid, int lane, int ldk, int ldv, unsigned& koff, unsigned& voff) {
    const int row = 4 * wid + (lane >> 4); koff = (unsigned)(row * ldk * 2 + (((lane & 15) ^ (row & 7)) << 4));
    const int st = 2 * wid + (lane >> 5), kk = ((st >> 2) << 3) | ((lane & 31) >> 2), k = (kk & ~0xC) | ((kk & 4) << 1) | ((kk & 8) >> 1); voff = (unsigned)(k * ldv * 2 + ((st & 3) * 32 + 8 * (lane & 3)) * 2);
}
#define ATT_DMA(io_, t, slot) do { const char* kt_ = (const char*)(io_).Kp + (size_t)(t) * (KVBLK * 2) * (io_).ldk; const char* vt_ = (const char*)(io_).Vp + (size_t)(t) * (KVBLK * 2) * (io_).ldv;          \
        LAS unsigned* kd_ = (LAS unsigned*)(ldsl + NSLOT * SHM_V + (slot) * SHM_K + wid * 1024); LAS unsigned* vd_ = (LAS unsigned*)(ldsl + (slot) * SHM_V + wid * 1024);                \
        __builtin_amdgcn_global_load_lds((const unsigned*)(kt_ + koff), kd_, 16, 0, 0); __builtin_amdgcn_global_load_lds((const unsigned*)(kt_ + koff + (size_t)64 * (io_).ldk), kd_ + 2048, 16, 0, 0); \
        __builtin_amdgcn_global_load_lds((const unsigned*)(vt_ + voff), vd_, 16, 0, 0); __builtin_amdgcn_global_load_lds((const unsigned*)(vt_ + voff + (size_t)64 * (io_).ldv), vd_ + 2048, 16, 0, 0); } while (0)
__device__ __forceinline__ void attn_prefetch(char* lds, const PassIO& io) {
    int tid = threadIdx.x; asm volatile("" : "+v"(tid));
    const int wid = __builtin_amdgcn_readfirstlane(tid >> 6), lane = tid & 63;
    unsigned koff, voff; dma_offsets(wid, lane, io.ldk, io.ldv, koff, voff);
    LAS unsigned char* ldsl = (LAS unsigned char*)lds;
    ATT_DMA(io, io.t_lo, 0); if (io.t_hi - io.t_lo > 1) ATT_DMA(io, io.t_lo + 1, 1);
}
template <class MaskF>
__device__ __forceinline__ void attn_pass(char* lds, const bf16x8* qr, const PassIO& io, const MaskF& mf, f32x16 (&o)[4], float& l_out) {
    int tid = threadIdx.x; asm volatile("" : "+v"(tid));
    const int wid = __builtin_amdgcn_readfirstlane(tid >> 6), lane = tid & 63, r32 = lane & 31, hi = lane >> 5;
    char* V_lds = lds; char* K_lds = lds + NSLOT * SHM_V;
    float* wsc = (float*)(lds + NSLOT * SHM_V + NSLOT * SHM_K) + wid * 64; float* al_l = wsc + 32;
    float m_reg = -1e30f, l_reg = 0.f;
#pragma unroll
    for (int d = 0; d < 4; ++d) o[d] = f32x16{};
    const int vb0 = (int)(uintptr_t)V_lds + v_rd_base(lane);
    const int t_lo = io.t_lo, NT = io.t_hi - io.t_lo;
    unsigned koff, voff; dma_offsets(wid, lane, io.ldk, io.ldv, koff, voff);
    LAS unsigned char* ldsl = (LAS unsigned char*)lds;
    f32x16 p0, p1; float mn, alpha = 1.f; bf16x8 pa0, pa1, pa2, pa3;
#define A_RESC(a) do { if (__any((a) < 1.f)) { if (hi == 0) al_l[r32] = (a); asm volatile("s_waitcnt lgkmcnt(0)" ::: "memory"); \
        _Pragma("unroll") for (int d_ = 0; d_ < 4; ++d_) _Pragma("unroll") for (int r = 0; r < 16; ++r) o[d_][r] *= al_l[crow(r, hi)]; } } while (0)
#define A_BAR() do { asm volatile("" ::: "memory"); __builtin_amdgcn_s_barrier(); asm volatile("" ::: "memory"); } while (0)
    const bool lead = wid < 4;
    VM_WAIT();
    __syncthreads();
    if (!lead) A_BAR();
    int sK = 0, sV = 2, sW = 1;
    bool act_prev = false;
    for (int i = 0; i < NT; ++i) {
        if (lead && i >= 1 && i + 1 < NT) ATT_DMA(io, t_lo + i + 1, sW);
        const bool act = mf.active(t_lo + i);
        SBAR(); if (act) qkt(p0, p1, K_lds + sK * SHM_K, r32, hi, qr);
        if (i > 0 && act_prev) pv_tile(o, vb0 + sV * SHM_V, pa0, pa1, pa2, pa3);
        if (!lead && i + 1 < NT) VM_WAIT();
        A_BAR();
        if (!lead && i + 2 < NT) ATT_DMA(io, t_lo + i + 2, sV);
        if (act) { mf(p0, p1, t_lo + i); partialSM(p0, p1, m_reg, mn, alpha, mf.keep(t_lo + i)); A_RESC(alpha); finishSM(p0, p1, alpha, l_reg, pa0, pa1, pa2, pa3); }
        act_prev = act;
        if (lead && i + 1 < NT) VM_WAIT();
        A_BAR();
        { const int t_ = sV; sV = sK; sK = sW; sW = t_; }
    }
    if (act_prev) pv_tile(o, vb0 + sV * SHM_V, pa0, pa1, pa2, pa3);
    if (lead) A_BAR();
    __syncthreads();
#undef A_RESC
#undef A_BAR
    l_out = l_reg;
}
__device__ __forceinline__ void row_inv_l(char* lds, float l_reg, float (&rli)[16]) {
    const int tid = threadIdx.x, wid = __builtin_amdgcn_readfirstlane(tid >> 6), lane = tid & 63, r32 = lane & 31, hi = lane >> 5;
    float* wsc = (float*)(lds + NSLOT * SHM_V + NSLOT * SHM_K) + wid * 64;
    if (hi == 0) wsc[r32] = l_reg;
    asm volatile("s_waitcnt lgkmcnt(0)" ::: "memory");
#pragma unroll
    for (int r = 0; r < 16; ++r) { const float l = wsc[crow(r, hi)]; rli[r] = l > 0.f ? __builtin_amdgcn_rcpf(l) : 0.f; }
    asm volatile("s_waitcnt lgkmcnt(0)" ::: "memory");
}
struct NoMask { __device__ __forceinline__ void operator()(f32x16&, f32x16&, int) const {} __device__ __forceinline__ bool active(int) const { return true; } __device__ __forceinline__ bool keep(int) const { return true; } };
}
__device__ __forceinline__ void norm128_rows(const Frame& F, const bf16* src, size_t lds_, bf16* dst, size_t ldd, int nrows, const float* g, int gw, int NGW) {
    const int sub = F.lane >> 4, l16 = F.lane & 15;
    const f32x4 g0 = *(const GAS f32x4*)(g + l16 * 8), g1 = *(const GAS f32x4*)(g + l16 * 8 + 4);
    for (int r0 = gw * 4; r0 < nrows; r0 += NGW * 4) { const int r = r0 + sub;
        const v4u raw = *(const GAS v4u*)(src + (size_t)r * lds_ + l16 * 8);
        float ss = 0.f;
#pragma unroll
        for (int j = 0; j < 4; ++j) { const float a = bflo(raw[j]), b = bfhi(raw[j]); ss += a * a + b * b; }
        ss += __shfl_xor(ss, 1); ss += __shfl_xor(ss, 2); ss += __shfl_xor(ss, 4); ss += __shfl_xor(ss, 8);
        const float rstd = 1.f / sqrtf(ss * (1.f / 128.f) + EPS);
        v4u w; w.x = cvtpk(bflo(raw[0]) * rstd * g0[0], bfhi(raw[0]) * rstd * g0[1]); w.y = cvtpk(bflo(raw[1]) * rstd * g0[2], bfhi(raw[1]) * rstd * g0[3]);
        w.z = cvtpk(bflo(raw[2]) * rstd * g1[0], bfhi(raw[2]) * rstd * g1[1]); w.w = cvtpk(bflo(raw[3]) * rstd * g1[2], bfhi(raw[3]) * rstd * g1[3]);
        *(GAS v4u*)(dst + (size_t)r * ldd + l16 * 8) = w; }
}
__device__ __forceinline__ void phase_memk_norm(const Frame& F, const Args& a, int l, int gw, int NGW) {
    const bf16* kvm = (const bf16*)(F.ws + WS_KVM) + (size_t)l * MMEM * 1024; bf16* km = (bf16*)(F.ws + WS_KM) + (size_t)l * MMEM * 512;
    for (int bh = 0; bh < BATCH * XH; ++bh) { const int b = bh >> 2, h = bh & 3;
        norm128_rows(F, kvm + (size_t)b * MEMLEN * 1024 + h * 128, 1024, km + (size_t)bh * MEMLEN * 128, 128, MEMLEN, a.in[I_XKN] + l * 128, gw, NGW); }
}

__device__ __forceinline__ void phase_cross_attn(const Frame& F, const Args& a, int l) {
    char* lds = (char*)F.lds; const int r32 = F.lane & 31, hi = F.lane >> 5;
    const bf16* QX = (const bf16*)(F.ws + WS_QX); bf16* OX = (bf16*)(F.ws + WS_OX);
    for (int u = F.bid; u < BATCH * XH * (SEQ / 256); u += F.G) {
        const int tb = u % (SEQ / 256), bh = u / (SEQ / 256), b = bh >> 2, h = bh & 3;
        const size_t row0 = (size_t)b * SEQ + tb * 256 + F.wave * 32;
        const bf16* Kp = (const bf16*)(F.ws + WS_KM) + (size_t)l * MMEM * 512 + (size_t)bh * MEMLEN * 128;
        const bf16* Vp = (const bf16*)(F.ws + WS_KVM) + (size_t)l * MMEM * 1024 + (size_t)b * MEMLEN * 1024 + 512 + h * 128;
        const att::PassIO io{Kp, 128, Vp, 1024, 0, MEMLEN / 64}; att::attn_prefetch(lds, io);
        bf16x8 qr[8]; att::load_q(QX + (row0 + r32) * 512 + h * 128, a.in[I_XQN] + l * 128, hi, qr);
        f32x16 o[4]; float l_reg; att::attn_pass(lds, qr, io, att::NoMask{}, o, l_reg);
        float rli[16]; att::row_inv_l(lds, l_reg, rli);
#pragma unroll
        for (int r = 0; r < 16; ++r) { bf16* orow = OX + (row0 + att::crow(r, hi)) * 512 + h * 128;
#pragma unroll
            for (int d0 = 0; d0 < 4; ++d0) { const float v = o[d0][r] * rli[r]; const float vn = __shfl_xor(v, 1);
                if ((r32 & 1) == 0) *(GAS unsigned*)(orow + d0 * 32 + r32) = cvtpk(v, vn); } }
    }
}

constexpr int NSA_GSC = att::LDS_ATT, NSA_IMP = NSA_GSC + NWAVES * 32 * 3 * 4, NSA_SEL = NSA_IMP + NWAVES * 8 * 128 * 4, NSA_SELU = NSA_SEL + 64 * 4 * 4, NSA_LDS_END = NSA_SELU + NWAVES * 4 * 4;
static_assert(NSA_LDS_END <= SCR_BYTES, "nsa lds");
struct CmpMask { int nmax, hi, nmin_wave;
    __device__ __forceinline__ void operator()(f32x16& p0, f32x16& p1, int t) const { if (t * 64 + 63 <= nmin_wave) return; att::mask_tile(p0, p1, nmax - t * 64 - 4 * hi, 0x40000000u); }
    __device__ __forceinline__ bool active(int) const { return true; } __device__ __forceinline__ bool keep(int) const { return true; } };
struct WinMask { int P, hi, qb;
    __device__ __forceinline__ void operator()(f32x16& p0, f32x16& p1, int t) const { if (t == qb || t == qb - 8) att::mask_tile(p0, p1, P - t * 64 - 4 * hi, 512u); }
    __device__ __forceinline__ bool active(int) const { return true; } __device__ __forceinline__ bool keep(int) const { return true; } };
struct SlcMask { const LAS unsigned* selw; const LAS unsigned* uni; int P, hi, qb;
    __device__ __forceinline__ void operator()(f32x16& p0, f32x16& p1, int t) const { if (t == qb) att::mask_tile(p0, p1, P - t * 64 - 4 * hi, 0x40000000u); }
    __device__ __forceinline__ bool keep(int t) const { return (selw[t >> 5] >> (t & 31)) & 1u; }
    __device__ __forceinline__ bool active(int t) const { return (__builtin_amdgcn_readfirstlane(uni[t >> 5]) >> (t & 31)) & 1u; } };

__device__ __forceinline__ void nsa_unit(const Frame& F, const Args& a, int b, int g, int qb, int dry = 0) {
    char* lds = (char*)F.lds; const int w = F.wave; const int t0 = qb * 64;
#define NSA_LANE() int lane = F.lane; asm volatile("" : "+v"(lane)); const int r32 = lane & 31, hi = lane >> 5; const int tok = 8 * w + (r32 >> 2), head = 4 * g + (r32 & 3), P = t0 + tok; (void)head; (void)P; (void)tok
    unsigned char* wsl = F.ws; asm volatile("" : "+s"(wsl));
    const bf16* Y0 = (const bf16*)(wsl + WS_Y0); const bf16* KV6 = (const bf16*)(wsl + WS_KV6);
    const size_t slab = (size_t)SEQ * 128, bg = (size_t)(b * 2 + g);
    LAS float* gsc = (LAS float*)(F.lds + NSA_GSC) + w * 96; LAS float* imp = (LAS float*)(F.lds + NSA_IMP) + w * 1024; LAS unsigned* selm = (LAS unsigned*)(F.lds + NSA_SEL);
    { NSA_LANE();
      if (hi == 0) {
#pragma unroll
        for (int br = 0; br < 3; ++br) gsc[r32 * 3 + br] = fsigmoid(bf2f(Y0[((size_t)b * SEQ + P) * EV_INP + 4608 + head * 3 + br]) + a.in[I_GATEB][head * 3 + br]); }
      LDS_WAIT(); }
    f32x16 o[4]; float l_reg; float rli[16];
    const bf16* KCMP = (const bf16*)(wsl + WS_KVCMP) + bg * 512 * 128; const bf16* VCMP = (const bf16*)(wsl + WS_KVCMP) + (size_t)2048 * 128 + bg * 512 * 128;
    const int ncmp_t = ((4 * qb + 2) >> 6) + 1;
    const att::PassIO io_imp{KCMP, 128, (const bf16*)(wsl + WS_OV), 128, 0, ncmp_t}, io_cmp{KCMP, 128, VCMP, 128, 0, ncmp_t},
                      io_slc{KV6 + (2 * 4 + bg) * slab, 128, KV6 + (3 * 4 + bg) * slab, 128, 0, qb + 1}, io_win{KV6 + (4 * 4 + bg) * slab, 128, KV6 + (5 * 4 + bg) * slab, 128, qb >= 8 ? qb - 8 : 0, qb + 1};
    v4u qraw[8];
#define NSA_QISSUE() do { NSA_LANE(); att::q_issue(Y0 + ((size_t)b * SEQ + P) * EV_INP + 2048 + head * 128, hi, qraw); } while (0)
    att::attn_prefetch(lds, io_imp); NSA_QISSUE();
    { NSA_LANE(); const CmpMask cm{(P - 31) >> 4, hi, (t0 + 8 * w - 31) >> 4};
      bf16x8 qr[8]; att::q_finish(qraw, a.in[I_QNORM], hi, qr);
      if (dry < 2) att::attn_pass(lds, qr, io_imp, cm, o, l_reg); else { VM_WAIT(); __syncthreads(); l_reg = 1.f; } }
    att::attn_prefetch(lds, io_cmp); NSA_QISSUE();
    if (dry < 3) {
    att::row_inv_l(lds, l_reg, rli);
    { NSA_LANE();
#pragma unroll
    for (int q = 0; q < 4; ++q)
#pragma unroll
        for (int d = 0; d < 4; ++d) { float s = 0.f;
#pragma unroll
            for (int i = 0; i < 4; ++i) s += o[d][4 * q + i] * rli[4 * q + i];
            imp[(2 * q + hi) * 128 + d * 32 + r32] = s; }
    LDS_WAIT();
    { const unsigned long long lt = (1ull << lane) - 1ull;
#pragma unroll 1
    for (int tg = 0; tg < 8; tg += 4) { unsigned k0[4], k1[4], T[4];
#pragma unroll
        for (int u = 0; u < 4; ++u) { const int tl = tg + u; const int j0 = lane, j1 = lane + 64; const float v0 = imp[tl * 128 + j0], v1 = imp[tl * 128 + j1];
          const float s0 = v0 + (((j0 == 0) || (j0 == qb) || (j0 == qb - 1)) ? 100.f : 0.f), s1 = v1 + (((j1 == 0) || (j1 == qb) || (j1 == qb - 1)) ? 100.f : 0.f);
          k0[u] = (j0 <= qb) ? __float_as_uint(s0) + 1u : 0u; k1[u] = (j1 <= qb) ? __float_as_uint(s1) + 1u : 0u; T[u] = 0u; }
#pragma unroll 1
        for (int bit = 30; bit >= 0; --bit) {
#pragma unroll
            for (int u = 0; u < 4; ++u) { const unsigned cand = T[u] | (1u << bit);
                const int cnt = __popcll(__ballot(k0[u] >= cand)) + __popcll(__ballot(k1[u] >= cand)); if (cnt >= 16) T[u] = cand; } }
#pragma unroll
        for (int u = 0; u < 4; ++u) { const int tl = tg + u;
        const unsigned long long g0 = __ballot(k0[u] > T[u]), g1 = __ballot(k1[u] > T[u]), e0 = __ballot(k0[u] == T[u]), e1 = __ballot(k1[u] == T[u]);
        const int need = 16 - (__popcll(g0) + __popcll(g1));
        const bool sel0 = (k0[u] > T[u]) || (k0[u] == T[u] && __popcll(e0 & lt) < need), sel1 = (k1[u] > T[u]) || (k1[u] == T[u] && __popcll(e0) + __popcll(e1 & lt) < need);
        const unsigned long long m0 = __ballot(sel0 && lane <= qb), m1 = __ballot(sel1 && lane + 64 <= qb);
        if (lane == 0) { LAS unsigned* sw = selm + (8 * w + tl) * 4; sw[0] = (unsigned)m0; sw[1] = (unsigned)(m0 >> 32); sw[2] = (unsigned)m1; sw[3] = (unsigned)(m1 >> 32); } } } }
    LDS_WAIT();
    if (lane < 4) { unsigned u = 0;
#pragma unroll
        for (int tl = 0; tl < 8; ++tl) u |= selm[(8 * w + tl) * 4 + lane];
        ((LAS unsigned*)(F.lds + NSA_SELU))[w * 4 + lane] = u; }
    LDS_WAIT(); }
    }
    { NSA_LANE(); const CmpMask cm{(P - 31) >> 4, hi, (t0 + 8 * w - 31) >> 4};
      bf16x8 qr[8]; att::q_finish(qraw, a.in[I_QNORM], hi, qr);
#if defined(MK_NSA_DUP) && MK_NSA_DUP == 2
      att::attn_pass(lds, qr, io_cmp, cm, o, l_reg); att::attn_prefetch(lds, io_cmp);
#endif
      if (dry < 2) att::attn_pass(lds, qr, io_cmp, cm, o, l_reg); else { VM_WAIT(); __syncthreads(); l_reg = 1.f; } }
    att::attn_prefetch(lds, io_slc); NSA_QISSUE();
    att::row_inv_l(lds, l_reg, rli);
    unsigned oacc[4][8];
    if (dry < 4) { NSA_LANE();
#pragma unroll
    for (int r = 0; r < 16; ++r) rli[r] *= gsc[att::crow(r, hi) * 3 + 0];
#pragma unroll
    for (int d = 0; d < 4; ++d)
#pragma unroll
        for (int r = 0; r < 16; r += 2) oacc[d][r >> 1] = cvtpk(o[d][r] * rli[r], o[d][r + 1] * rli[r + 1]); }
    { NSA_LANE(); const SlcMask sm{selm + tok * 4, (const LAS unsigned*)(F.lds + NSA_SELU) + w * 4, P, hi, qb};
      bf16x8 qr[8]; att::q_finish(qraw, a.in[I_QNORM], hi, qr);
#if defined(MK_NSA_DUP) && MK_NSA_DUP == 5
      { const size_t bg2 = (bg + 1) & 3; const att::PassIO io_cold{KV6 + (2 * 4 + bg2) * slab, 128, KV6 + (3 * 4 + bg2) * slab, 128, 0, qb + 1};
        att::attn_pass(lds, qr, io_cold, sm, o, l_reg); att::attn_prefetch(lds, io_slc); }
#endif
#if defined(MK_NSA_DUP) && MK_NSA_DUP == 3
      att::attn_pass(lds, qr, io_slc, sm, o, l_reg); att::attn_prefetch(lds, io_slc);
#endif
      if (!dry) att::attn_pass(lds, qr, io_slc, sm, o, l_reg); else { VM_WAIT(); __syncthreads(); } }
    att::attn_prefetch(lds, io_win); NSA_QISSUE();
    att::row_inv_l(lds, l_reg, rli);
    if (dry < 4) { NSA_LANE();
#pragma unroll
    for (int r = 0; r < 16; ++r) rli[r] *= gsc[att::crow(r, hi) * 3 + 1];
#pragma unroll
    for (int d = 0; d < 4; ++d)
#pragma unroll
        for (int r = 0; r < 16; r += 2) oacc[d][r >> 1] = cvtpk(bflo(oacc[d][r >> 1]) + o[d][r] * rli[r], bfhi(oacc[d][r >> 1]) + o[d][r + 1] * rli[r + 1]); }
    { NSA_LANE(); const WinMask wm{P, hi, qb};
      bf16x8 qr[8]; att::q_finish(qraw, a.in[I_QNORM], hi, qr);
#if defined(MK_NSA_DUP) && MK_NSA_DUP == 4
      att::attn_pass(lds, qr, io_win, wm, o, l_reg); att::attn_prefetch(lds, io_win);
#endif
      if (dry < 2) att::attn_pass(lds, qr, io_win, wm, o, l_reg); else { VM_WAIT(); __syncthreads(); l_reg = 1.f; } }
    att::row_inv_l(lds, l_reg, rli);
    if (dry < 4) { NSA_LANE();
    bf16* MIX = dry ? (bf16*)(wsl + WS_R + 400 * MiB) : (bf16*)(wsl + WS_MIX);
#pragma unroll
    for (int r = 0; r < 16; ++r) rli[r] *= gsc[att::crow(r, hi) * 3 + 2];
    bf16* obase = MIX + ((size_t)b * SEQ + t0 + 8 * w) * 2048 + 1024 + 4 * g * 128 + r32;
#pragma unroll
    for (int d0 = 0; d0 < 4; ++d0) {
#pragma unroll
        for (int r = 0; r < 16; ++r) { const int row = att::crow(r, hi); const float v = ((r & 1) ? bfhi(oacc[d0][r >> 1]) : bflo(oacc[d0][r >> 1])) + o[d0][r] * rli[r]; const float vn = __shfl_xor(v, 1);
            if ((r32 & 1) == 0) *(GAS unsigned*)(obase + (size_t)(row >> 2) * 2048 + (row & 3) * 128 + d0 * 32) = cvtpk(v, vn); }
        } }
    __syncthreads();
#undef NSA_QISSUE
#undef NSA_LANE
}
__device__ __forceinline__ void phase_nsa(const Frame& F, const Args& a) {
#pragma unroll 1
    for (int it = F.bid * 2; it < 512; it += F.G * 2)
#pragma unroll 1
        for (int k = 0; k < 2; ++k) { const int p = it >> 1, xcd = p & 7, bg = xcd >> 1, x = (xcd & 1) * 32 + (p >> 3);
#if defined(MK_NSA_DRY)
            nsa_unit(F, a, bg >> 1, bg & 1, k == 0 ? 127 - x : x, MK_NSA_DRY);
#endif
            nsa_unit(F, a, bg >> 1, bg & 1, k == 0 ? 127 - x : x); }
}
__device__ __forceinline__ f32x4 mma16(const LAS bf16* A, int pa, const LAS bf16* B, int pb, int K, f32x4 acc, int fr, int fq) {
    for (int k0 = 0; k0 < K; k0 += 32) { const bf16x8 af = *(const LAS bf16x8*)(A + fr * pa + k0 + 8 * fq); const bf16x8 bfv = *(const LAS bf16x8*)(B + fr * pb + k0 + 8 * fq);
        acc = __builtin_amdgcn_mfma_f32_16x16x32_bf16(af, bfv, acc, 0, 0, 0); }
    return acc;
}

__device__ __forceinline__ f32x4 mma16r(const LAS bf16* Arow, const LAS bf16* Brow, int K, f32x4 acc, int fq) {
    for (int k0 = 0; k0 < K; k0 += 32) { const bf16x8 af = *(const LAS bf16x8*)(Arow + k0 + 8 * fq); const bf16x8 bfv = *(const LAS bf16x8*)(Brow + k0 + 8 * fq);
        acc = __builtin_amdgcn_mfma_f32_16x16x32_bf16(af, bfv, acc, 0, 0, 0); }
    return acc;
}

__device__ __forceinline__ void phase_cmp2(const Frame& F, const Args& a, int u_lo, int u_hi, int u_step) {
    LAS bf16* hidS = (LAS bf16*)F.lds; LAS bf16* w2T = (LAS bf16*)(F.lds + 32 * 264 * 2); LAS float* outS = (LAS float*)(F.lds + 32 * 264 * 2 + 128 * 264 * 2);
    const int fr = F.lane & 15, fq = F.lane >> 4;
    for (int u = u_lo; u < u_hi; u += u_step) { const int mm = u >> 6, rb = u & 63;
        const bf16* hid = (const bf16*)(F.ws + WS_HID) + (size_t)mm * 2048 * 256 + (size_t)rb * 32 * 256; const float* w2 = a.in[mm ? I_CVW2 : I_CKW2];
        for (int i = F.tid; i < 32 * 32; i += NTHR) { const int r = i >> 5, c8 = i & 31; *(LAS v4u*)(hidS + r * 264 + c8 * 8) = *(const GAS v4u*)(hid + r * 256 + c8 * 8); }
        for (int i = F.tid; i < 256 * 128; i += NTHR) { const int k = i >> 7, c = i & 127; w2T[c * 264 + k] = (bf16)f2bf(w2[i]); }
        __syncthreads();
        const int rt = F.wave & 1;
#pragma unroll
        for (int cc = 0; cc < 2; ++cc) { const int ct = (F.wave >> 1) * 2 + cc; f32x4 acc = {0.f, 0.f, 0.f, 0.f};
            acc = mma16(hidS + rt * 16 * 264, 264, w2T + ct * 16 * 264, 264, 256, acc, fr, fq);
#pragma unroll
            for (int e = 0; e < 4; ++e) outS[(rt * 16 + 4 * fq + e) * 132 + ct * 16 + fr] = acc[e]; }
        __syncthreads();
        { const int r = F.wave * 4 + (F.lane >> 4), l16 = F.lane & 15; const int grow = rb * 32 + r, n = grow & 511;
          float v[8]; float ss = 0.f;
#pragma unroll
          for (int j = 0; j < 8; ++j) { v[j] = outS[r * 132 + l16 * 8 + j]; ss += v[j] * v[j]; }
          ss += __shfl_xor(ss, 1); ss += __shfl_xor(ss, 2); ss += __shfl_xor(ss, 4); ss += __shfl_xor(ss, 8);
          if (mm == 0) { const float rstd = 1.f / sqrtf(ss * (1.f / 128.f) + EPS); const float* g = a.in[I_KNORM];
#pragma unroll
              for (int j = 0; j < 8; ++j) v[j] = v[j] * rstd * g[l16 * 8 + j]; }
          if (n == 511) {
#pragma unroll
              for (int j = 0; j < 8; ++j) v[j] = 0.f; }
          v4u w; w.x = cvtpk(v[0], v[1]); w.y = cvtpk(v[2], v[3]); w.z = cvtpk(v[4], v[5]); w.w = cvtpk(v[6], v[7]);
          *(GAS v4u*)((bf16*)(F.ws + WS_KVCMP) + (size_t)mm * 2048 * 128 + (size_t)grow * 128 + l16 * 8) = w; }
        __syncthreads();
    }
}

__device__ __forceinline__ void rglru_unit(const Frame& F, const Args& a, int b, int h, int s) {
    const int w = F.wave, lane = F.lane, fr = lane & 15, fq = lane >> 4;
    LAS bf16* xcs = (LAS bf16*)F.lds + w * (16 * 136); LAS float* summ = (LAS float*)(F.lds + 8 * 16 * 136 * 2);
    const bf16* Y0 = (const bf16*)(F.ws + WS_Y0) + (size_t)b * SEQ * EV_INP; bf16* MIX = (bf16*)(F.ws + WS_MIX) + (size_t)b * SEQ * 2048;
    const int ch = h * 128 + s * 16 + fr;
    bf16x8 ba_f[4], bx_f[4];
    { const float* wa = a.in[I_RGWA] + (size_t)h * 128 * 128 + s * 16 + fr; const float* wx = a.in[I_RGWX] + (size_t)h * 128 * 128 + s * 16 + fr;
#pragma unroll
      for (int kk = 0; kk < 4; ++kk) { v4u ua, ux;
#pragma unroll
          for (int e2 = 0; e2 < 4; ++e2) { const int k = 32 * kk + 8 * fq + 2 * e2; ua[e2] = pk2(wa[(size_t)k * 128], wa[(size_t)(k + 1) * 128]); ux[e2] = pk2(wx[(size_t)k * 128], wx[(size_t)(k + 1) * 128]); }
          ba_f[kk] = *reinterpret_cast<bf16x8*>(&ua); bx_f[kk] = *reinterpret_cast<bf16x8*>(&ux); } }
    const float bias_a = a.in[I_RGBA][ch], bias_x = a.in[I_RGBX][ch], c8 = -8.f * fsoftplus(-a.in[I_RGLAM][ch]);
    const int cg = h * 128 + 2 * lane; float cw0[4], cw1[4];
#pragma unroll
    for (int j = 0; j < 4; ++j) { cw0[j] = a.in[I_RGCW][j * 1024 + cg]; cw1[j] = a.in[I_RGCW][j * 1024 + cg + 1]; }
    const float cb0 = a.in[I_RGCB][cg], cb1 = a.in[I_RGCB][cg + 1];
    float carry = 0.f;
    unsigned raw[19];
#define RG_LOAD(c_) do { const int T0_ = (c_) * 128 + 16 * w; _Pragma("unroll") for (int i = 0; i < 19; ++i) { const int t = T0_ - 3 + i; raw[i] = (t >= 0) ? *(const GAS unsigned*)(Y0 + (size_t)t * EV_INP + cg) : 0u; } } while (0)
    RG_LOAD(0);
#ifdef MK_DUP_RG
    for (int cc = 0; cc < 2 * (SEQ / 128); ++cc) { const int c = cc & (SEQ / 128 - 1); if (cc == SEQ / 128) { carry = 0.f; RG_LOAD(0); }
#else
    for (int c = 0; c < SEQ / 128; ++c) {
#endif
        const int T0 = c * 128 + 16 * w;
#pragma unroll
        for (int tt = 0; tt < 16; ++tt) { float y0 = cb0, y1 = cb1;
#pragma unroll
            for (int j = 0; j < 4; ++j) { y0 += cw0[j] * bflo(raw[tt + j]); y1 += cw1[j] * bfhi(raw[tt + j]); }
            *(LAS unsigned*)(xcs + tt * 136 + 2 * lane) = cvtpk(y0, y1); }
        LDS_WAIT();
        if (c + 1 < SEQ / 128) RG_LOAD(c + 1);
        unsigned short gg[4];
#pragma unroll
        for (int e = 0; e < 4; ++e) gg[e] = Y0[(size_t)(T0 + 4 * fq + e) * EV_INP + 1024 + ch];
        f32x4 acc_a = {0.f, 0.f, 0.f, 0.f}, acc_x = {0.f, 0.f, 0.f, 0.f};
#pragma unroll
        for (int kk = 0; kk < 4; ++kk) { const bf16x8 af = *(const LAS bf16x8*)(xcs + fr * 136 + 32 * kk + 8 * fq);
            acc_a = __builtin_amdgcn_mfma_f32_16x16x32_bf16(af, ba_f[kk], acc_a, 0, 0, 0); acc_x = __builtin_amdgcn_mfma_f32_16x16x32_bf16(af, bx_f[kk], acc_x, 0, 0, 0); }
        float hl[4], pl[4]; float hh = 0.f, pp = 1.f;
#pragma unroll
        for (int e = 0; e < 4; ++e) { const float xv = bf2f(xcs[(4 * fq + e) * 136 + s * 16 + fr]);
            const float r = fsigmoid(acc_a[e] + bias_a), ig = fsigmoid(acc_x[e] + bias_x); const float la = c8 * r; const float av = __expf(la);
            const float uu = __builtin_amdgcn_sqrtf((1.f - av) * (1.f + av)) * (ig * xv);
            hh = av * hh + uu; pp *= av; hl[e] = hh; pl[e] = pp; }
        float Apre = 1.f, Hpre = 0.f, Aw = 1.f, Hw = 0.f;
#pragma unroll
        for (int q = 0; q < 4; ++q) { const float Aq = __shfl(pp, fr + 16 * q), Hq = __shfl(hh, fr + 16 * q);
            if (q < fq) { Hpre = Aq * Hpre + Hq; Apre *= Aq; }
            Hw = Aq * Hw + Hq; Aw *= Aq; }
        LAS float* sm = summ + (c & 1) * 256;
        if (fq == 0) { sm[(w * 16 + fr) * 2] = Aw; sm[(w * 16 + fr) * 2 + 1] = Hw; }
        __syncthreads();
        float cin = carry, call = carry;
#pragma unroll
        for (int q = 0; q < 8; ++q) { const float Aq = sm[(q * 16 + fr) * 2], Hq = sm[(q * 16 + fr) * 2 + 1]; call = Aq * call + Hq; if (q < w) cin = call; }
        carry = call;
        const float cl = Apre * cin + Hpre;
#pragma unroll
        for (int e = 0; e < 4; ++e) { const float hv = hl[e] + pl[e] * cl; MIX[(size_t)(T0 + 4 * fq + e) * 2048 + ch] = (bf16)f2bf(gelu_tanh(bf2f(gg[e])) * hv); }
    }
#undef RG_LOAD
    __syncthreads();
}
constexpr size_t WS_M_CN = WS_R + 168 * MiB + 64 * MiB;
constexpr size_t WS_M_BN = WS_M_CN + 16 * MiB, WS_M_BT = WS_M_BN + 16 * MiB, WS_M_XT = WS_M_BT + 16 * MiB, WS_M_ACS = WS_M_XT + 64 * MiB, WS_M_DTV = WS_M_ACS + 2 * MiB,
                 WS_M_ST = WS_M_DTV + 2 * MiB, WS_M_PV = WS_M_ST + 128 * MiB, WS_M_END = WS_M_PV + 64 * MiB;
static_assert(WS_M_END <= WS_R + 560 * MiB, "mamba ws");
constexpr int MB_P = 136;
__device__ __forceinline__ void conv4_silu(const v4u (&rows)[7], const float* cw, int ldw, const float* cb, float (&out)[4][8]) {
    float wv[4][8], bv[8];
#pragma unroll
    for (int j = 0; j < 4; ++j) { const f32x4 w0 = *(const GAS f32x4*)(cw + (size_t)j * ldw), w1 = *(const GAS f32x4*)(cw + (size_t)j * ldw + 4);
#pragma unroll
        for (int i = 0; i < 4; ++i) { wv[j][i] = w0[i]; wv[j][4 + i] = w1[i]; } }
    { const f32x4 b0 = *(const GAS f32x4*)cb, b1 = *(const GAS f32x4*)(cb + 4);
#pragma unroll
      for (int i = 0; i < 4; ++i) { bv[i] = b0[i]; bv[4 + i] = b1[i]; } }
#pragma unroll
    for (int tt = 0; tt < 4; ++tt)
#pragma unroll
        for (int i2 = 0; i2 < 4; ++i2) { float y0 = bv[2 * i2], y1 = bv[2 * i2 + 1];
#pragma unroll
            for (int j = 0; j < 4; ++j) { y0 += wv[j][2 * i2] * bflo(rows[tt + j][i2]); y1 += wv[j][2 * i2 + 1] * bfhi(rows[tt + j][i2]); }
            out[tt][2 * i2] = fsilu(y0); out[tt][2 * i2 + 1] = fsilu(y1); }
}
__device__ __forceinline__ void od_dt_cols(const Frame& F, const bf16* X, const bf16* Wt, const float* ssq, bf16* Y1) {
    typedef float f32x16_t __attribute__((ext_vector_type(16)));
    int t_ = threadIdx.x; asm volatile("" : "+v"(t_));
    const int wave = __builtin_amdgcn_readfirstlane(t_ >> 6), lane = t_ & 63;
    const int r32 = lane & 31, hi = lane >> 5, kq = wave & 3;
    LAS float* red = (LAS float*)F.lds;
    for (int t0 = F.bid * 2; t0 < M / 32; t0 += F.G * 2) { const int r0 = (t0 + (wave >> 2)) * 32;
        const bf16* xa = X + (size_t)(r0 + r32) * D + 256 * kq + 8 * hi; const bf16* wb = Wt + (size_t)(5120 + r32) * D + 256 * kq + 8 * hi;
        f32x16_t acc;
#pragma unroll
        for (int r = 0; r < 16; ++r) acc[r] = 0.f;
        pg8::bf16x8 av[16], bv[16];
#pragma unroll
        for (int u = 0; u < 16; ++u) { av[u] = *(const GAS pg8::bf16x8*)(xa + 16 * u); bv[u] = *(const GAS pg8::bf16x8*)(wb + 16 * u); }
#pragma unroll
        for (int u = 0; u < 16; ++u) acc = __builtin_amdgcn_mfma_f32_32x32x16_bf16(av[u], bv[u], acc, 0, 0, 0);
        if (kq != 0) {
#pragma unroll
            for (int r = 0; r < 16; ++r) red[(wave * 16 + r) * 64 + lane] = acc[r]; }
        __syncthreads();
        if (kq == 0) { const float rs_l = pg8::row_rstd(ssq, r0 + r32);
#pragma unroll
            for (int r = 0; r < 16; ++r) { const int row = (r & 3) + 8 * (r >> 2) + 4 * hi; const float rs = __shfl(rs_l, row);
                const float v = (acc[r] + red[((wave + 1) * 16 + r) * 64 + lane]) + (red[((wave + 2) * 16 + r) * 64 + lane] + red[((wave + 3) * 16 + r) * 64 + lane]);
                Y1[(size_t)(r0 + row) * OD_INP + 5120 + r32] = (bf16)f2bf(v * rs); } }
        __syncthreads();
    }
}
__device__ __forceinline__ void phase_mamba_prep(const Frame& F, const Args& a) {
    LAS bf16* T = (LAS bf16*)F.lds;
    LAS float* acsS = (LAS float*)(F.lds + 128 * MB_P * 2); LAS float* dtS = acsS + 256;
    const int tid = F.tid, lane = F.lane, w = F.wave, sg = tid >> 4, cv = tid & 15;
    const float* cw = a.in[I_ODCW]; const float* cb = a.in[I_ODCB];
    v4u rows[7];
#define M0_LOAD(u_) do { const int bc_ = (u_) / 24, sl_ = (u_) % 24, T0_ = (bc_ & 63) * 128; const bf16* Y1_ = (const bf16*)(F.ws + WS_Y1) + (size_t)(bc_ >> 6) * SEQ * OD_INP; \
        _Pragma("unroll") for (int i = 0; i < 7; ++i) { const int t = T0_ + 4 * sg - 3 + i; rows[i] = (t >= 0) ? *(const GAS v4u*)(Y1_ + (size_t)t * OD_INP + 2048 + sl_ * 128 + cv * 8) : (v4u){0u, 0u, 0u, 0u}; } } while (0)
    if (F.bid < 128 * 24) M0_LOAD(F.bid);
    for (int u = F.bid; u < 128 * 24; u += F.G) { const int bc = u / 24, sl = u % 24, b = bc >> 6, c = bc & 63, T0 = c * 128;
        const bf16* Y1 = (const bf16*)(F.ws + WS_Y1) + (size_t)b * SEQ * OD_INP; const int ch0 = sl * 128;
        { float vals[4][8];
          conv4_silu(rows, cw + ch0 + cv * 8, 3072, cb + ch0 + cv * 8, vals);
          if (u + F.G < 128 * 24) M0_LOAD(u + F.G);
#pragma unroll
          for (int tt = 0; tt < 4; ++tt) { v4u o; o.x = cvtpk(vals[tt][0], vals[tt][1]); o.y = cvtpk(vals[tt][2], vals[tt][3]); o.z = cvtpk(vals[tt][4], vals[tt][5]); o.w = cvtpk(vals[tt][6], vals[tt][7]);
              *(LAS v4u*)(T + (4 * sg + tt) * MB_P + cv * 8) = o; } }
        if (sl < 16 && w < 2) { const int h = 2 * sl + w;
            const float Ah = -__expf(a.in[I_ALOG][h]), dtb = a.in[I_DTB][h];
            const float d0 = fsoftplus(bf2f(Y1[(size_t)(T0 + 2 * lane) * OD_INP + 5120 + h]) + dtb), d1 = fsoftplus(bf2f(Y1[(size_t)(T0 + 2 * lane + 1) * OD_INP + 5120 + h]) + dtb);
            const float a0 = d0 * Ah, a1 = d1 * Ah; float pr = a0 + a1;
#pragma unroll
            for (int off = 1; off < 64; off <<= 1) { const float t = __shfl_up(pr, off); if (lane >= off) pr += t; }
            const float ex = pr - (a0 + a1); const float c0 = ex + a0, c1 = ex + a0 + a1;
            acsS[w * 128 + 2 * lane] = c0; acsS[w * 128 + 2 * lane + 1] = c1; dtS[w * 128 + 2 * lane] = d0; dtS[w * 128 + 2 * lane + 1] = d1;
            float* ACS = (float*)(F.ws + WS_M_ACS) + ((size_t)bc * 32 + h) * 128; float* DTV = (float*)(F.ws + WS_M_DTV) + ((size_t)bc * 32 + h) * 128;
            typedef float f32x2v __attribute__((ext_vector_type(2))); *(GAS f32x2v*)(ACS + 2 * lane) = (f32x2v){c0, c1}; *(GAS f32x2v*)(DTV + 2 * lane) = (f32x2v){d0, d1}; }
        __syncthreads();
        if (sl < 16) {
            const int cc = tid >> 2, s0 = (tid & 3) * 32, hh = cc >> 6; bf16* XT = (bf16*)(F.ws + WS_M_XT) + (((size_t)bc * 32 + 2 * sl) * 64 + cc) * 128 + s0;
#pragma unroll
            for (int k8 = 0; k8 < 4; ++k8) { float v[8];
#pragma unroll
                for (int k = 0; k < 8; ++k) { const int s = s0 + 8 * k8 + k; v[k] = bf2f(T[s * MB_P + cc]) * dtS[hh * 128 + s]; }
                v4u o; o.x = cvtpk(v[0], v[1]); o.y = cvtpk(v[2], v[3]); o.z = cvtpk(v[4], v[5]); o.w = cvtpk(v[6], v[7]); *(GAS v4u*)(XT + 8 * k8) = o; } }
        else { const int g = (sl - 16) & 3; const bool isB = sl < 20;
            bf16* N = (bf16*)(F.ws + (isB ? WS_M_BN : WS_M_CN)) + ((size_t)b * SEQ + T0) * 512 + g * 128;
            for (int i = tid; i < 128 * 16; i += NTHR) { const int s = i >> 4, c8 = i & 15; *(GAS v4u*)(N + (size_t)s * 512 + c8 * 8) = *(const LAS v4u*)(T + s * MB_P + c8 * 8); }
            if (isB) { const int cc = tid >> 2, s0 = (tid & 3) * 32; bf16* BT = (bf16*)(F.ws + WS_M_BT) + (((size_t)bc * 4 + g) * 128 + cc) * 128 + s0;
#pragma unroll
                for (int k8 = 0; k8 < 4; ++k8) { unsigned short v[8];
#pragma unroll
                    for (int k = 0; k < 8; ++k) v[k] = T[(s0 + 8 * k8 + k) * MB_P + cc];
                    v4u o; o.x = v[0] | ((unsigned)v[1] << 16); o.y = v[2] | ((unsigned)v[3] << 16); o.z = v[4] | ((unsigned)v[5] << 16); o.w = v[6] | ((unsigned)v[7] << 16); *(GAS v4u*)(BT + 8 * k8) = o; } } }
        __syncthreads();
    }
#undef M0_LOAD
}
__device__ __forceinline__ void phase_mamba_states(const Frame& F) {
    LAS bf16* BTs = (LAS bf16*)F.lds; LAS bf16* XW = (LAS bf16*)(F.lds + 128 * MB_P * 2); LAS bf16* STs = (LAS bf16*)(F.lds + 192 * MB_P * 2);
    const int tid = F.tid, lane = F.lane, w = F.wave, fr = lane & 15, fq = lane >> 4;
    for (int u = F.bid; u < 128 * 4; u += F.G) { const int bc = u >> 2, g = u & 3;
        const bf16* BT = (const bf16*)(F.ws + WS_M_BT) + ((size_t)bc * 4 + g) * 128 * 128;
        for (int i = tid; i < 128 * 16; i += NTHR) { const int n = i >> 4, c8 = i & 15; *(LAS v4u*)(BTs + n * MB_P + c8 * 8) = *(const GAS v4u*)(BT + (size_t)n * 128 + c8 * 8); }
#pragma unroll 1
        for (int hh = 0; hh < 8; ++hh) { const int h = g * 8 + hh;
            const bf16* XT = (const bf16*)(F.ws + WS_M_XT) + ((size_t)bc * 32 + h) * 64 * 128; const float* ACS = (const float*)(F.ws + WS_M_ACS) + ((size_t)bc * 32 + h) * 128;
            const float aL = ACS[127];
#pragma unroll
            for (int k = 0; k < 2; ++k) { const int i = tid + k * NTHR, p = i >> 4, c8 = i & 15; const v4u raw = *(const GAS v4u*)(XT + (size_t)p * 128 + c8 * 8);
                const f32x4 a0 = *(const GAS f32x4*)(ACS + c8 * 8), a1 = *(const GAS f32x4*)(ACS + c8 * 8 + 4);
                v4u o; o.x = cvtpk(bflo(raw[0]) * __expf(aL - a0[0]), bfhi(raw[0]) * __expf(aL - a0[1])); o.y = cvtpk(bflo(raw[1]) * __expf(aL - a0[2]), bfhi(raw[1]) * __expf(aL - a0[3]));
                o.z = cvtpk(bflo(raw[2]) * __expf(aL - a1[0]), bfhi(raw[2]) * __expf(aL - a1[1])); o.w = cvtpk(bflo(raw[3]) * __expf(aL - a1[2]), bfhi(raw[3]) * __expf(aL - a1[3]));
                *(LAS v4u*)(XW + p * MB_P + c8 * 8) = o; }
            __syncthreads();
            bf16* ST = (bf16*)(F.ws + WS_M_ST) + ((size_t)bc * 32 + h) * 64 * 128;
#pragma unroll
            for (int pt = 0; pt < 4; ++pt) { f32x4 acc = {0.f, 0.f, 0.f, 0.f}; acc = mma16(XW + pt * 16 * MB_P, MB_P, BTs + w * 16 * MB_P, MB_P, 128, acc, fr, fq);
#pragma unroll
                for (int e = 0; e < 4; ++e) STs[(pt * 16 + 4 * fq + e) * MB_P + w * 16 + fr] = (bf16)f2bf(acc[e]); }
            __syncthreads();
#pragma unroll
            for (int k = 0; k < 2; ++k) { const int i = tid + k * NTHR, pp = i >> 4, c8 = i & 15; *(GAS v4u*)(ST + (size_t)pp * 128 + c8 * 8) = *(const LAS v4u*)(STs + pp * MB_P + c8 * 8); }
        }
    }
}
__device__ __forceinline__ void phase_mamba_scan(const Frame& F) {
    const int gt = F.bid * NTHR + F.tid;
    const bf16* STg = (const bf16*)(F.ws + WS_M_ST); bf16* PVg = (bf16*)(F.ws + WS_M_PV); const float* ACSg = (const float*)(F.ws + WS_M_ACS);
    for (int i = gt; i < BATCH * 32 * 64 * 32; i += F.G * NTHR) { const int n4 = i & 31, p = (i >> 5) & 63, h = (i >> 11) & 31, b = i >> 16;
        f32x4 S = {0.f, 0.f, 0.f, 0.f};
        const size_t off0 = (((size_t)b * 64 * 32 + h) * 64 + p) * 128 + n4 * 4, cstep = (size_t)32 * 64 * 128;
        const float* al = ACSg + ((size_t)b * 64 * 32 + h) * 128 + 127;
#pragma unroll 1
        for (int c0 = 0; c0 < 64; c0 += 16) {
            v2u sr[16]; float dl[16];
#pragma unroll
            for (int j = 0; j < 16; ++j) { sr[j] = *(const GAS v2u*)(STg + off0 + (size_t)(c0 + j) * cstep); dl[j] = al[(size_t)(c0 + j) * 32 * 128]; }
#pragma unroll
            for (int j = 0; j < 16; ++j) { const float dec = __expf(dl[j]); const f32x4 st = {bflo(sr[j].x), bfhi(sr[j].x), bflo(sr[j].y), bfhi(sr[j].y)};
                v2u o; o.x = cvtpk(S[0], S[1]); o.y = cvtpk(S[2], S[3]); *(GAS v2u*)(PVg + off0 + (size_t)(c0 + j) * cstep) = o;
                S = S * dec + st; } } }
}
constexpr int M3_CS = 0, M3_BS = M3_CS + 128 * MB_P * 2, M3_MS = M3_BS + 128 * MB_P * 2, M3_XT = M3_MS + 128 * MB_P * 2, M3_PV = M3_XT + 64 * MB_P * 2, M3_ACS = M3_PV + 64 * MB_P * 2, M3_DT = M3_ACS + 512, M3_END = M3_DT + 512;
static_assert(M3_END <= SCR_BYTES, "mamba lds");
__device__ __forceinline__ void phase_mamba_out(const Frame& F, const Args& a) {
    LAS bf16* Cs = (LAS bf16*)(F.lds + M3_CS); LAS bf16* Bs = (LAS bf16*)(F.lds + M3_BS); LAS bf16* Ms = (LAS bf16*)(F.lds + M3_MS); LAS bf16* XTs = (LAS bf16*)(F.lds + M3_XT); LAS bf16* PVs = (LAS bf16*)(F.lds + M3_PV);
    LAS float* acs = (LAS float*)(F.lds + M3_ACS); LAS float* dtv = (LAS float*)(F.lds + M3_DT);
    const int tid = F.tid, lane = F.lane, w = F.wave, fr = lane & 15, fq = lane >> 4;
    for (int u = F.bid; u < 128 * 4; u += F.G) { const int bc = u >> 2, g = u & 3, b = bc >> 6, T0 = (bc & 63) * 128;
        const bf16* CN = (const bf16*)(F.ws + WS_M_CN) + ((size_t)b * SEQ + T0) * 512 + g * 128; const bf16* BN = (const bf16*)(F.ws + WS_M_BN) + ((size_t)b * SEQ + T0) * 512 + g * 128;
        for (int i = tid; i < 128 * 16; i += NTHR) { const int s = i >> 4, c8 = i & 15;
            *(LAS v4u*)(Cs + s * MB_P + c8 * 8) = *(const GAS v4u*)(CN + (size_t)s * 512 + c8 * 8); *(LAS v4u*)(Bs + s * MB_P + c8 * 8) = *(const GAS v4u*)(BN + (size_t)s * 512 + c8 * 8); }
        __syncthreads();
        f32x4 cbt[8];
#pragma unroll
        for (int st = 0; st < 8; ++st) { cbt[st] = (f32x4){0.f, 0.f, 0.f, 0.f}; if (st <= w) cbt[st] = mma16(Bs + st * 16 * MB_P, MB_P, Cs + w * 16 * MB_P, MB_P, 128, cbt[st], fr, fq); }
        const bf16* Y1 = (const bf16*)(F.ws + WS_Y1) + ((size_t)b * SEQ + T0) * OD_INP; bf16* YG = (bf16*)(F.ws + WS_YG) + ((size_t)b * SEQ + T0) * 2048;
        v4u pfx[2], pfp[2]; float pfa = 0.f, pfd = 0.f;
#define M3_PREFETCH(hh_) do { const int h_ = g * 8 + (hh_); const bf16* XT_ = (const bf16*)(F.ws + WS_M_XT) + ((size_t)bc * 32 + h_) * 64 * 128; const bf16* PV_ = (const bf16*)(F.ws + WS_M_PV) + ((size_t)bc * 32 + h_) * 64 * 128; \
            _Pragma("unroll") for (int k = 0; k < 2; ++k) { const int i = tid + k * NTHR, p = i >> 4, c8 = i & 15; pfx[k] = *(const GAS v4u*)(XT_ + (size_t)p * 128 + c8 * 8); pfp[k] = *(const GAS v4u*)(PV_ + (size_t)p * 128 + c8 * 8); } \
            if (tid < 128) { pfa = ((const float*)(F.ws + WS_M_ACS))[((size_t)bc * 32 + h_) * 128 + tid]; pfd = ((const float*)(F.ws + WS_M_DTV))[((size_t)bc * 32 + h_) * 128 + tid]; } } while (0)
        M3_PREFETCH(0);
#pragma unroll 1
        for (int hh = 0; hh < 8; ++hh) { const int h = g * 8 + hh; const float dsk = a.in[I_DSKIP][h];
#pragma unroll
            for (int k = 0; k < 2; ++k) { const int i = tid + k * NTHR, p = i >> 4, c8 = i & 15; *(LAS v4u*)(XTs + p * MB_P + c8 * 8) = pfx[k]; *(LAS v4u*)(PVs + p * MB_P + c8 * 8) = pfp[k]; }
            if (tid < 128) { acs[tid] = pfa; dtv[tid] = pfd; }
            __syncthreads();
            if (hh + 1 < 8) M3_PREFETCH(hh + 1);
            v4u zz[2];
#pragma unroll
            for (int k = 0; k < 2; ++k) zz[k] = *(const GAS v4u*)(Y1 + (size_t)(16 * w + fr) * OD_INP + h * 64 + 16 * fq + 8 * k);
            const float aq = acs[16 * w + fr];
#pragma unroll
            for (int st = 0; st < 8; ++st) { if (st <= w) { float mv[4];
#pragma unroll
                for (int e = 0; e < 4; ++e) { const int s = 16 * st + 4 * fq + e; mv[e] = (s <= 16 * w + fr) ? cbt[st][e] * __expf(aq - acs[s]) : 0.f; }
                v2u o; o.x = cvtpk(mv[0], mv[1]); o.y = cvtpk(mv[2], mv[3]); *(LAS v2u*)(Ms + (16 * w + fr) * MB_P + 16 * st + 4 * fq) = o; } }
            if ((w & 1) == 0) *(LAS v2u*)(Ms + (16 * w + fr) * MB_P + 16 * (w + 1) + 4 * fq) = (v2u){0u, 0u};
            LDS_WAIT();
            float yv[16]; { const int q = 16 * w + fr; const float eq = __expf(acs[q]), rdt = dsk * __builtin_amdgcn_rcpf(dtv[q]); const int prow = 16 * (fr >> 2) + (fr & 3);
#pragma unroll
            for (int pt = 0; pt < 4; ++pt) { f32x4 yd = {0.f, 0.f, 0.f, 0.f}, yo = {0.f, 0.f, 0.f, 0.f};
                yd = mma16r(XTs + (prow + 4 * pt) * MB_P, Ms + q * MB_P, ((w + 2) >> 1) * 32, yd, fq);
                yo = mma16r(PVs + (prow + 4 * pt) * MB_P, Cs + q * MB_P, 128, yo, fq);
#pragma unroll
                for (int e = 0; e < 4; ++e) { const int pp = 16 * fq + 4 * pt + e; yv[4 * pt + e] = yd[e] + eq * yo[e] + rdt * bf2f(XTs[pp * MB_P + q]); } } }
#pragma unroll
            for (int k = 0; k < 2; ++k) { v4u o;
#pragma unroll
                for (int j = 0; j < 4; ++j) o[j] = cvtpk(yv[8 * k + 2 * j] * fsilu(bflo(zz[k][j])), yv[8 * k + 2 * j + 1] * fsilu(bfhi(zz[k][j])));
                *(GAS v4u*)(YG + (size_t)(16 * w + fr) * 2048 + h * 64 + 16 * fq + 8 * k) = o; }
            __syncthreads();
        }
#undef M3_PREFETCH
        VM_WAIT(); __syncthreads();
        { const float* gn = a.in[I_ODNORM] + g * 512 + lane * 8; const f32x4 g0 = *(const GAS f32x4*)gn, g1 = *(const GAS f32x4*)(gn + 4);
#pragma unroll 4
          for (int t = 0; t < 16; ++t) { bf16* pq = YG + (size_t)(16 * w + t) * 2048 + g * 512 + lane * 8; const v4u raw = *(const GAS v4u*)pq; float ss = 0.f;
#pragma unroll
              for (int j = 0; j < 4; ++j) { const float x0 = bflo(raw[j]), x1 = bfhi(raw[j]); ss += x0 * x0 + x1 * x1; }
              const float rstd = 1.f / sqrtf(wave_sum(ss) * (1.f / 512.f) + EPS);
              v4u o; o.x = cvtpk(bflo(raw[0]) * rstd * g0[0], bfhi(raw[0]) * rstd * g0[1]); o.y = cvtpk(bflo(raw[1]) * rstd * g0[2], bfhi(raw[1]) * rstd * g0[3]);
              o.z = cvtpk(bflo(raw[2]) * rstd * g1[0], bfhi(raw[2]) * rstd * g1[1]); o.w = cvtpk(bflo(raw[3]) * rstd * g1[2], bfhi(raw[3]) * rstd * g1[3]);
              *(GAS v4u*)pq = o; } }
    }
}
__device__ __forceinline__ void phase_group_norm(const Frame& F, const Args& a) {
    const int gw = F.bid * NWAVES + F.wave, NGW = F.G * NWAVES; bf16* YG = (bf16*)(F.ws + WS_YG); const float* g = a.in[I_ODNORM];
    for (int m = gw; m < M; m += NGW) {
#pragma unroll
        for (int gi = 0; gi < 4; ++gi) { bf16* p = YG + (size_t)m * 2048 + gi * 512 + F.lane * 8; const v4u raw = *(const GAS v4u*)p; float ss = 0.f;
#pragma unroll
            for (int j = 0; j < 4; ++j) { const float x0 = bflo(raw[j]), x1 = bfhi(raw[j]); ss += x0 * x0 + x1 * x1; }
            const float rstd = 1.f / sqrtf(wave_sum(ss) * (1.f / 512.f) + EPS);
            const f32x4 g0 = *(const GAS f32x4*)(g + gi * 512 + F.lane * 8), g1 = *(const GAS f32x4*)(g + gi * 512 + F.lane * 8 + 4);
            v4u o; o.x = cvtpk(bflo(raw[0]) * rstd * g0[0], bfhi(raw[0]) * rstd * g0[1]); o.y = cvtpk(bflo(raw[1]) * rstd * g0[2], bfhi(raw[1]) * rstd * g0[3]);
            o.z = cvtpk(bflo(raw[2]) * rstd * g1[0], bfhi(raw[2]) * rstd * g1[1]); o.w = cvtpk(bflo(raw[3]) * rstd * g1[2], bfhi(raw[3]) * rstd * g1[3]);
            *(GAS v4u*)p = o; }
    }
}
constexpr int MOE_TAB = 131072;
static_assert(MOE_TAB + (32 + MOE_TILES + 24) * 4 <= SCR_BYTES, "moe lds");
__device__ __forceinline__ void phase_route(const Frame& F, const Args& a, const bf16* X) {
    LAS int* cntS = (LAS int*)F.lds;
    if (F.tid < 8) cntS[F.tid] = 0;
    __syncthreads();
    const float* g = a.in[I_NFFN] + D; const float* router = a.in[I_ROUTER]; unsigned char* XN8 = F.ws + WS_XN8;
    int* tokE = (int*)(F.ws + WS_MOEIDX); float* tokW = (float*)(F.ws + WS_MOEIDX + 1 * MiB);
    const int per = M / F.G;
    for (int i = F.wave; i < per; i += NWAVES) { const int m = F.bid * per + i;
        const GAS v4u* xr = (const GAS v4u*)(X + (size_t)m * D) + F.lane;
        float v[2][8]; float s = 0.f;
#pragma unroll
        for (int k = 0; k < 2; ++k) { const v4u r = xr[64 * k];
#pragma unroll
            for (int j = 0; j < 4; ++j) { v[k][2 * j] = bflo(r[j]); v[k][2 * j + 1] = bfhi(r[j]); s += v[k][2 * j] * v[k][2 * j] + v[k][2 * j + 1] * v[k][2 * j + 1]; } }
        const float rstd = 1.f / sqrtf(wave_sum(s) * (1.f / D) + EPS);
        float lg[8]; v2u o8[2];
#pragma unroll
        for (int e = 0; e < 8; ++e) lg[e] = 0.f;
#pragma unroll
        for (int k = 0; k < 2; ++k) { const int c0 = 512 * k + 8 * F.lane; const f32x4 g0 = *(const GAS f32x4*)(g + c0), g1 = *(const GAS f32x4*)(g + c0 + 4); float hn[8];
#pragma unroll
            for (int q = 0; q < 8; ++q) hn[q] = v[k][q] * rstd * (q < 4 ? g0[q & 3] : g1[q & 3]);
            o8[k].x = pk4_fp8(hn[0], hn[1], hn[2], hn[3]); o8[k].y = pk4_fp8(hn[4], hn[5], hn[6], hn[7]);
#pragma unroll
            for (int q = 0; q < 8; ++q) { const f32x4 r0 = *(const GAS f32x4*)(router + (size_t)(c0 + q) * 8), r1 = *(const GAS f32x4*)(router + (size_t)(c0 + q) * 8 + 4);
#pragma unroll
                for (int e = 0; e < 4; ++e) { lg[e] += hn[q] * r0[e]; lg[4 + e] += hn[q] * r1[e]; } } }
#pragma unroll
        for (int k = 0; k < 2; ++k) *(GAS v2u*)(XN8 + (size_t)m * D + 512 * k + 8 * F.lane) = o8[k];
#pragma unroll
        for (int e = 0; e < 8; ++e) lg[e] = wave_sum(lg[e]);
        int e1 = 0; float v1 = lg[0];
#pragma unroll
        for (int e = 1; e < 8; ++e) if (lg[e] > v1) { v1 = lg[e]; e1 = e; }
        int e2 = (e1 + 1) & 7; float v2 = -3.0e38f;
#pragma unroll
        for (int e = 0; e < 8; ++e) if (e != e1 && lg[e] > v2) { v2 = lg[e]; e2 = e; }
        if (F.lane == 0) { const float w1 = 1.f / (1.f + __expf(v2 - v1)); tokE[2 * m] = e1; tokE[2 * m + 1] = e2; tokW[2 * m] = w1; tokW[2 * m + 1] = 1.f - w1;
            atomicAdd((int*)cntS + e1, 1); atomicAdd((int*)cntS + e2, 1); }
    }
    __syncthreads();
    if (F.tid < 8) ((int*)(F.ctl + CW_MOECNT))[F.bid * 8 + F.tid] = cntS[F.tid];
    __syncthreads();
}
__device__ __forceinline__ void moe_layout(const Frame& F) {
    LAS int* tab = (LAS int*)(F.lds + MOE_TAB); const int* cnt = (const int*)(F.ctl + CW_MOECNT);
    if (F.tid < 16) tab[F.tid < 8 ? F.tid : 32 + MOE_TILES + F.tid] = 0;
    __syncthreads();
    { const int e = F.tid & 7; int tot = 0, pre = 0;
      for (int wg = F.tid >> 3; wg < F.G; wg += NTHR / 8) { const int c = cnt[wg * 8 + e]; tot += c; if (wg < F.bid) pre += c; }
      atomicAdd((int*)tab + e, tot); atomicAdd((int*)tab + 32 + MOE_TILES + 8 + e, pre); }
    __syncthreads();
    if (F.tid == 0) { int row = 0, tl = 0; for (int e = 0; e < 8; ++e) { const int nt = (tab[e] + 255) >> 8; tab[8 + e] = row; tab[16 + e] = nt; for (int i = 0; i < nt; ++i) tab[32 + tl + i] = e; tl += nt; row += nt * 256; } tab[24] = tl; }
    __syncthreads();
}
__device__ __forceinline__ void phase_scatter(const Frame& F) {
    moe_layout(F);
    LAS int* tab = (LAS int*)(F.lds + MOE_TAB); LAS int* slotS = (LAS int*)F.lds;
    const int per = M / F.G;
    const int* tokE = (const int*)(F.ws + WS_MOEIDX); int* tokS = (int*)(F.ws + WS_MOEIDX + 2 * MiB);
    if (F.wave == 0) { const int E0 = tokE[(size_t)F.bid * per * 2 + F.lane], E1 = tokE[(size_t)F.bid * per * 2 + 64 + F.lane]; int s0 = 0, s1 = 0;
        const unsigned long long lt = (1ull << F.lane) - 1ull;
#pragma unroll
        for (int e = 0; e < 8; ++e) { const unsigned long long m0 = __ballot(E0 == e), m1 = __ballot(E1 == e); const int base = tab[8 + e] + tab[32 + MOE_TILES + 8 + e];
            if (E0 == e) s0 = base + __popcll(m0 & lt); if (E1 == e) s1 = base + __popcll(m0) + __popcll(m1 & lt); }
        slotS[F.lane] = s0; slotS[64 + F.lane] = s1; tokS[(size_t)F.bid * per * 2 + F.lane] = s0; tokS[(size_t)F.bid * per * 2 + 64 + F.lane] = s1; }
    __syncthreads();
    const unsigned char* XN8 = F.ws + WS_XN8; unsigned char* XP = F.ws + WS_XP;
    for (int i0 = F.wave; i0 < per * 2; i0 += NWAVES * 16) {
        v4u rowv[16];
#pragma unroll
        for (int j = 0; j < 16; ++j) { const int i = i0 + j * NWAVES; if (i < per * 2) rowv[j] = ((const GAS v4u*)(XN8 + (size_t)(F.bid * per + (i >> 1)) * D))[F.lane]; }
#pragma unroll
        for (int j = 0; j < 16; ++j) { const int i = i0 + j * NWAVES; if (i < per * 2) ((GAS v4u*)(XP + (size_t)slotS[i] * D))[F.lane] = rowv[j]; } }
    __syncthreads();
}
struct MoeOrder {
    int nN, nwg, G, c; const LAS int* texp;
    __device__ __forceinline__ bool next(int i, pg8::Unit& u) const { const long L = (long)i * G + c; if (L >= nwg) return false; u.pm = (int)(L / nN); u.pn = (int)(L % nN); u.bn = texp[u.pm] * nN + u.pn; u.idx = i; return true; }
    __device__ __forceinline__ void a_ready(const pg8::Unit&) const {}
    __device__ __forceinline__ void done(const pg8::Unit&) const {}
};
struct MoeOrderX {
    int nM, nN, nwg, G, c; const LAS int* texp;
    __device__ __forceinline__ bool next(int i, pg8::Unit& u) const { const long L = (long)i * G + c; if (L >= nwg) return false;
        int wgid = (int)L; { const int q = nwg / 8, r = nwg % 8, xcd = wgid % 8, off = wgid / 8; wgid = (xcd < r ? xcd * (q + 1) : r * (q + 1) + (xcd - r) * q) + off; }
        const int nig = 8 * nN, gid = wgid / nig, fm = gid * 8, gsz = (nM - fm) < 8 ? (nM - fm) : 8;
        u.pm = fm + ((wgid % nig) % gsz); u.pn = (wgid % nig) / gsz; u.bn = texp[u.pm] * nN + u.pn; u.idx = i; return true; }
    __device__ __forceinline__ void a_ready(const pg8::Unit&) const {}
    __device__ __forceinline__ void done(const pg8::Unit&) const {}
};
struct MoeTail { int R, Lo, pm_min; bool split; };
__device__ __forceinline__ MoeTail moe_tail(const LAS int* tab, int G) { MoeTail t; const int U = tab[24] * 4; t.R = U / G; t.Lo = U - t.R * G; t.split = (t.Lo > 0 && t.Lo <= 128 && t.R > 0); t.pm_min = t.split ? (t.R * G) / 4 : (1 << 30); return t; }
struct MoeTailOrder { int pm, pn, bn; bool has;
    __device__ __forceinline__ bool next(int i, pg8::Unit& u) const { if (i > 0 || !has) return false; u.pm = pm; u.pn = pn; u.bn = bn; u.idx = 0; return true; }
    __device__ __forceinline__ void a_ready(const pg8::Unit&) const {}
    __device__ __forceinline__ void done(const pg8::Unit&) const {} };
constexpr size_t MOE_PART_STRIDE = (size_t)32 * 256 * 1024;
__device__ __forceinline__ void phase_moe_combine(const Frame& F, const bf16* x, float* xo) {
    moe_layout(F); const MoeTail mt = moe_tail((const LAS int*)(F.lds + MOE_TAB), F.G); const int srow = mt.pm_min == (1 << 30) ? (1 << 30) : mt.pm_min * 256; const float* PART = (const float*)(F.ws + WS_XP);
    const int gw = F.bid * NWAVES + F.wave, NGW = F.G * NWAVES;
    const float* tokW = (const float*)(F.ws + WS_MOEIDX + 1 * MiB); const int* tokS = (const int*)(F.ws + WS_MOEIDX + 2 * MiB); const int* tokE = (const int*)(F.ws + WS_MOEIDX);
    const bf16* YP = (const bf16*)(F.ws + WS_YP);
    for (int m = gw; m < M; m += NGW) { const int s0 = tokS[2 * m], s1 = tokS[2 * m + 1]; const float w0 = tokW[2 * m] * (1.f / MOE_W2_SCALE), w1 = tokW[2 * m + 1] * (1.f / MOE_W2_SCALE)  ; const bool sw = tokE[2 * m] > tokE[2 * m + 1];
        const GAS v2u* xr = (const GAS v2u*)(x + (size_t)m * D) + F.lane; GAS f32x4* xw = (GAS f32x4*)(xo + (size_t)m * D) + F.lane; const GAS v2u* y0 = (const GAS v2u*)(YP + (size_t)s0 * D) + F.lane; const GAS v2u* y1 = (const GAS v2u*)(YP + (size_t)s1 * D) + F.lane;
#pragma unroll
        for (int j = 0; j < 4; ++j) { f32x4 v0, v1;
            if (s0 >= srow) { const GAS f32x4* q = (const GAS f32x4*)(PART + (size_t)(s0 - srow) * D) + F.lane + 64 * j; v0 = q[0] + q[MOE_PART_STRIDE / 4]; } else { const v2u yb = y0[64 * j]; v0 = (f32x4){bflo(yb.x), bfhi(yb.x), bflo(yb.y), bfhi(yb.y)}; }
            if (s1 >= srow) { const GAS f32x4* q = (const GAS f32x4*)(PART + (size_t)(s1 - srow) * D) + F.lane + 64 * j; v1 = q[0] + q[MOE_PART_STRIDE / 4]; } else { const v2u yb = y1[64 * j]; v1 = (f32x4){bflo(yb.x), bfhi(yb.x), bflo(yb.y), bfhi(yb.y)}; }
            const f32x4 a0 = v0 * w0, a1 = v1 * w1; const v2u xb = xr[64 * j]; const f32x4 xv = {bflo(xb.x), bfhi(xb.x), bflo(xb.y), bfhi(xb.y)}; xw[64 * j] = xv + (sw ? (a1 + a0) : (a0 + a1)); } }
}
#ifndef MK_PHMASK
#define MK_PHMASK 0xFFFFFFFFFFFFull
#endif
#ifndef MK_DUPMASK
#define MK_DUPMASK 0ull
#endif
#ifndef MK_SPLIT
#define MK_SPLIT 0
#endif
#ifndef MK_LAST_PHASE
#define MK_LAST_PHASE 29
#endif
constexpr int N_PHASES = 30;
#ifndef MK_LB
#define MK_LB 2
#endif
__global__ void __launch_bounds__(NTHR, MK_LB) mega_fwd(Args args) {
    extern __shared__ __attribute__((aligned(16))) unsigned char lds_raw[];
    Frame F;
    F.lds = (LAS unsigned char*)lds_raw; F.MISC = (volatile LAS unsigned*)(F.lds + MISC_OFF);
    F.tid = threadIdx.x; F.lane = F.tid & 63; F.wave = __builtin_amdgcn_readfirstlane(F.tid >> 6); F.G = gridDim.x; F.bid = blockIdx.x;
    F.ws = args.ws; F.ctl = (gu32*)(args.ws + WS_CTL);
    for (int u = F.tid; u < (LDS_BYTES - MISC_OFF) / 4; u += NTHR) ((LAS unsigned*)(F.lds + MISC_OFF))[u] = 0u;
    __syncthreads();
    XcdBarrier bar; bar.bar = (unsigned*)(F.ctl + CW_BAR); bar.x = 0; bar.st = nullptr;
    if (!MK_SPLIT) bar = xcd_barrier_post((unsigned*)(F.ctl + CW_BAR), F.MISC + 8);
    const int lo = args.ph_lo, hi = args.ph_hi;
#define PF() Frame Fp = F; { int t_ = threadIdx.x; asm volatile("" : "+v"(t_)); Fp.tid = t_; Fp.lane = t_ & 63; int w_ = F.wave, b_ = F.bid; asm volatile("" : "+s"(w_), "+s"(b_)); Fp.wave = w_; Fp.bid = b_; }
#define IN(k) ((((unsigned long long)MK_PHMASK >> (k)) & 1ull) && lo <= (k) && (k) < hi)
#define DUP(k) ((((unsigned long long)MK_DUPMASK >> (k)) & 1ull) ? 2 : 1)
#define SEAM(k) do { if (!MK_SPLIT && IN((k) + 1)) xcd_barrier(bar); } while (0)
    unsigned char* ws = args.ws; float* out = args.out;
    const int gw = F.bid * NWAVES + F.wave, NGW = F.G * NWAVES;
    LAS unsigned char* glds = F.lds;
    bf16* XN = (bf16*)(ws + WS_XN);

    if (IN(0)) { PF();
#pragma unroll 1
        for (int rep = 0; rep < DUP(0); ++rep) p0_prologue(Fp, args);
        SEAM(0); }
    if (IN(1)) {
        PF();
#pragma unroll 1
        for (int rep = 0; rep < DUP(1); ++rep) {
        if (F.bid == 0) { float* part = (float*)(ws + WS_CMPB_PART); float s = 0.f; for (int ic = 0; ic < 64; ++ic) s += part[(size_t)((Fp.tid >> 8) * 64 + ic) * 256 + (Fp.tid & 255)]; ((float*)(ws + WS_CMPB))[Fp.tid] = s; }
        { pg8::Gemm g{XN, (const bf16*)(ws + WS_W_EVIN), M, EV_INP, D, D, D}; pg8::StaticOrder S; S.init(M, EV_INP, F.G, F.bid);
          pg8::EpiEvIn E{(bf16*)(ws + WS_Y0), EV_INP, (bf16*)(ws + WS_KV6), SEQ};
          pg8::gemm_phase<pg8::EpiEvIn, pg8::StaticOrder, PG8_ALIGN, PG8_SP2>(glds, g, S, E); }
#pragma unroll 1
        for (int l = 0; l < 2; ++l) { pg8::Gemm g{(const bf16*)(ws + WS_MEMN) + (size_t)l * MMEM * D, (const bf16*)(ws + WS_W_XKV) + (size_t)l * 1024 * D, MMEM, 1024, D, D, D};
          pg8::ListOrder S; S.init(2, 4, 8, F.bid - 192 - 8 * l);
          pg8::EpiBf16<0> E{(bf16*)(ws + WS_KVM) + (size_t)l * MMEM * 1024, 1024, nullptr, nullptr};
          pg8::gemm_phase<pg8::EpiBf16<0>, pg8::ListOrder, PG8_ALIGN, PG8_SP2>(glds, g, S, E); }
        }
        SEAM(1);
    }
    if (IN(2)) {
        PF();
#pragma unroll 1
        for (int rep = 0; rep < DUP(2); ++rep) {
        if (F.bid < 128) { rglru_unit(Fp, args, F.bid >> 6, (F.bid >> 3) & 7, F.bid & 7);
        }
        else if (F.bid < 144) { const int mm = (F.bid - 128) >> 3;
            pg8::Gemm g{(const bf16*)(ws + WS_KV6) + (size_t)mm * 4 * SEQ * 128, (const bf16*)(ws + (mm ? WS_W_CV1 : WS_W_CK1)), 2048, 256, 4096, 2048, 4096};
            pg8::ListOrder S; S.init(8, 1, 8, (F.bid - 128) & 7);
            pg8::EpiBf16<1> E{(bf16*)(ws + WS_HID) + (size_t)mm * 2048 * 256, 256, (const float*)(ws + WS_CMPB) + mm * 256, nullptr};
            pg8::gemm_phase<pg8::EpiBf16<1>, pg8::ListOrder, PG8_ALIGN, PG8_SP2>(glds, g, S, E);
#ifdef MK_DUP_CMP1
            pg8::gemm_phase<pg8::EpiBf16<1>, pg8::ListOrder, PG8_ALIGN, PG8_SP2>(glds, g, S, E);
#endif
            VM_WAIT(); __syncthreads(); { const int u0 = mm * 64 + ((F.bid - 128) & 7) * 8; phase_cmp2(Fp, args, u0, u0 + 8, 1); }
        }
        else if (rep == 0) { const int gw2 = (F.bid - 144) * NWAVES + F.wave, NGW2 = (F.G - 144) * NWAVES;
            bf16* ks = (bf16*)(ws + WS_KV6) + (size_t)2 * 4 * SEQ * 128; bf16* kw = (bf16*)(ws + WS_KV6) + (size_t)4 * 4 * SEQ * 128;
            norm128_rows(Fp, ks, 128, ks, 128, 4 * SEQ, args.in[I_KNORM] + 128, gw2, NGW2);
            norm128_rows(Fp, kw, 128, kw, 128, 4 * SEQ, args.in[I_KNORM] + 256, gw2, NGW2);
            phase_memk_norm(Fp, args, 0, gw2, NGW2); phase_memk_norm(Fp, args, 1, gw2, NGW2); convert_range(Fp, args, gw2, NGW2, CONV_A, CONV_P2_END);
#ifdef MK_DUP_P2CONV
            convert_range(Fp, args, gw2, NGW2, CONV_A + (CONV_P2_END - CONV_A) / 2, CONV_P2_END);
#endif
        }
        }
        SEAM(2);
    }
    if (IN(4)) { PF();
#pragma unroll 1
        for (int rep = 0; rep < DUP(4); ++rep) phase_nsa(Fp, args);
        SEAM(4); }
    if (IN(5)) {
        pg8::Gemm g{(const bf16*)(ws + WS_MIX), (const bf16*)(ws + WS_W_EVOUT), M, D, 2048, 2048, 2048}; pg8::StaticOrder S; S.init(M, D, F.G, F.bid);
#pragma unroll 1
        for (int rep = 0; rep < DUP(5); ++rep) { pg8::EpiResidB<true> E{args.in[I_X], (rep + 1 < DUP(5)) ? (bf16*)(ws + WS_R + 400 * MiB) : XN, D, (float*)(ws + WS_SSQ)};
        pg8::gemm_phase<pg8::EpiResidB<true>, pg8::StaticOrder, PG8_ALIGN, PG8_SP2>(glds, g, S, E); }
        SEAM(5);
#ifdef MK_PROBE_BARS
#pragma unroll 1
        for (int xb = 0; xb < MK_PROBE_BARS; ++xb) xcd_barrier(bar);
#endif
    }
#pragma unroll 1
    for (int l = 0; l < 2; ++l) {
        const int pb = l == 0 ? 6 : 21;
        if (IN(pb + 1)) { pg8::Gemm g{XN, (const bf16*)(ws + WS_W_XQ) + (size_t)l * 512 * D, M, 512, D, D, D}; pg8::StaticOrder S; S.init(M, 512, F.G, F.bid);
            pg8::fill_rstd_table((LAS float*)(F.lds + MOE_TAB), S, (const float*)(ws + WS_SSQ), F.tid);
            pg8::EpiBf16<0> E{(bf16*)(ws + WS_QX), 512, nullptr, (const LAS float*)(F.lds + MOE_TAB)};
#pragma unroll 1
            for (int rep = 0; rep < DUP(7); ++rep) pg8::gemm_phase<pg8::EpiBf16<0>, pg8::StaticOrder, PG8_ALIGN, PG8_SP2>(glds, g, S, E);
            if (F.bid >= 128) { PF(); const int lo_ = CONV_ALL - (2 - l) * CONV_Q;
                convert_range(Fp, args, (F.bid - 128) * NWAVES + F.wave, (F.G - 128) * NWAVES, lo_, lo_ + CONV_Q); }
            SEAM(pb + 1); }
        if (IN(pb + 2)) { PF();
#pragma unroll 1
            for (int rep = 0; rep < DUP(8); ++rep) phase_cross_attn(Fp, args, l);
            SEAM(pb + 2); }
        if (IN(pb + 3)) { pg8::Gemm g{(const bf16*)(ws + WS_OX), (const bf16*)(ws + WS_W_XO) + (size_t)l * D * 512, M, D, 512, 512, 512}; pg8::StaticOrder S; S.init(M, D, F.G, F.bid);
#pragma unroll 1
            for (int rep = 0; rep < DUP(9); ++rep) { pg8::EpiResidB<false> E{XN, (rep + 1 < DUP(9)) ? (bf16*)(ws + WS_R + 400 * MiB) : XN, D, (float*)(ws + WS_SSQ)};
            pg8::gemm_phase<pg8::EpiResidB<false>, pg8::StaticOrder, PG8_ALIGN, PG8_SP2>(glds, g, S, E); }
            SEAM(pb + 3); }
        if (l == 0) {
            if (IN(11)) { pg8::Gemm g{XN, (const bf16*)(ws + WS_W_FF13), M, 2 * FF, D, D, D}; pg8::StaticOrder S; S.init(M, 2 * FF, F.G, F.bid);
                pg8::fill_rstd_table((LAS float*)(F.lds + MOE_TAB), S, (const float*)(ws + WS_SSQ), F.tid);
                pg8::EpiSwiglu<false> E{(bf16*)(ws + WS_H), FF, (const LAS float*)(F.lds + MOE_TAB)};
#ifdef MK_PROBE_NULLEPI
                { pg8::EpiNull EN; pg8::gemm_phase<pg8::EpiNull, pg8::StaticOrder, PG8_ALIGN, PG8_SP2>(glds, g, S, EN); }
#endif
#pragma unroll 1
                for (int rep = 0; rep < DUP(11); ++rep) pg8::gemm_phase<pg8::EpiSwiglu<false>, pg8::StaticOrder, PG8_ALIGN, PG8_SP2>(glds, g, S, E);
                SEAM(11); }
            if (IN(12)) { pg8::Gemm g{(const bf16*)(ws + WS_H), (const bf16*)(ws + WS_W_FF2), M, D, FF, FF, FF}; pg8::StaticOrder S; S.init(M, D, F.G, F.bid);
#pragma unroll 1
                for (int rep = 0; rep < DUP(12); ++rep) { pg8::EpiResidB<false> E{XN, (rep + 1 < DUP(12)) ? (bf16*)(ws + WS_R + 400 * MiB) : XN, D, (float*)(ws + WS_SSQ)};
                pg8::gemm_phase<pg8::EpiResidB<false>, pg8::StaticOrder, PG8_ALIGN, PG8_SP2>(glds, g, S, E); }
                SEAM(12); }
            if (IN(14)) { pg8::Gemm g{XN, (const bf16*)(ws + WS_W_ODIN), M, 5120, D, D, D}; pg8::StaticOrder S; S.init(M, 5120, F.G, F.bid);
                pg8::fill_rstd_table((LAS float*)(F.lds + MOE_TAB), S, (const float*)(ws + WS_SSQ), F.tid);
                pg8::EpiBf16<0> E{(bf16*)(ws + WS_Y1), OD_INP, nullptr, (const LAS float*)(F.lds + MOE_TAB)};
#pragma unroll 1
                for (int rep = 0; rep < DUP(14); ++rep) pg8::gemm_phase<pg8::EpiBf16<0>, pg8::StaticOrder, PG8_ALIGN, PG8_SP2>(glds, g, S, E);
                od_dt_cols(F, XN, (const bf16*)(ws + WS_W_ODIN), (const float*)(ws + WS_SSQ), (bf16*)(ws + WS_Y1));
                SEAM(14); }
            if (IN(15)) { PF();
#pragma unroll 1
                for (int rep = 0; rep < DUP(15); ++rep) phase_mamba_prep(Fp, args);
                SEAM(15); }
            if (IN(16)) { PF();
#pragma unroll 1
                for (int rep = 0; rep < DUP(16); ++rep) phase_mamba_states(Fp);
                SEAM(16); }
            if (IN(17)) { PF();
#pragma unroll 1
                for (int rep = 0; rep < DUP(17); ++rep) phase_mamba_scan(Fp);
                SEAM(17); }
            if (IN(18)) { PF();
#pragma unroll 1
                for (int rep = 0; rep < DUP(18); ++rep) phase_mamba_out(Fp, args);
                SEAM(18); }
            if (IN(20)) { pg8::Gemm g{(const bf16*)(ws + WS_YG), (const bf16*)(ws + WS_W_ODOUT), M, D, 2048, 2048, 2048}; pg8::StaticOrder S; S.init(M, D, F.G, F.bid);
#pragma unroll 1
                for (int rep = 0; rep < DUP(20); ++rep) { pg8::EpiResidB<false> E{XN, (rep + 1 < DUP(20)) ? (bf16*)(ws + WS_R + 400 * MiB) : XN, D, (float*)(ws + WS_SSQ)};
                pg8::gemm_phase<pg8::EpiResidB<false>, pg8::StaticOrder, PG8_ALIGN, PG8_SP2>(glds, g, S, E); }
                SEAM(20); }
        }
    }
    if (IN(25)) { PF();
#pragma unroll 1
        for (int rep = 0; rep < DUP(25); ++rep) phase_route(Fp, args, XN);
        SEAM(25); }
    if (IN(26)) { PF();
#pragma unroll 1
        for (int rep = 0; rep < DUP(26); ++rep) phase_scatter(Fp);
        SEAM(26); }
    if (IN(27)) { PF(); moe_layout(Fp); const LAS int* tab = (const LAS int*)(F.lds + MOE_TAB);
        pg8::Gemm g{(const bf16*)(ws + WS_XP), (const bf16*)(ws + WS_W_M13), MOE_ROWS, 2 * FFE, D / 2, D / 2, D / 2}  ; MoeOrderX S{tab[24], 2 * FFE / 256, tab[24] * (2 * FFE / 256), F.G, F.bid, tab + 32};
        pg8::EpiSwiglu<true, false, true> E{(bf16*)(ws + WS_HP), FFE, nullptr, 1.f / MOE_W13_SCALE};
#pragma unroll 1
        for (int rep = 0; rep < DUP(27); ++rep) pg8::gemm_phase<pg8::EpiSwiglu<true, false, true>, MoeOrderX, PG8_ALIGN, PG8_SP2, true>(glds, g, S, E);
        SEAM(27); }
    if (IN(28)) { PF(); moe_layout(Fp); const LAS int* tab = (const LAS int*)(F.lds + MOE_TAB);
        const MoeTail mt = moe_tail(tab, F.G);
        pg8::Gemm g{(const bf16*)(ws + WS_HP), (const bf16*)(ws + WS_W_M2), MOE_ROWS, D, FFE / 2, FFE / 2, FFE / 2}  ; MoeOrder S{D / 256, mt.split ? mt.R * F.G : tab[24] * (D / 256), F.G, F.bid, tab + 32};
        pg8::EpiBf16<0> E{(bf16*)(ws + WS_YP), D, nullptr, nullptr};
#pragma unroll 1
        for (int rep = 0; rep < DUP(28); ++rep) pg8::gemm_phase<pg8::EpiBf16<0>, MoeOrder, PG8_ALIGN, PG8_SP2, true>(glds, g, S, E);
        if (mt.split) {
            const int piece = F.bid, L = mt.R * F.G + (piece >> 1), kq = piece & 1, pm = L / 4, pn = L % 4;
            MoeTailOrder S2{pm, pn, piece < mt.Lo * 2 ? tab[32 + pm] * 4 + pn : 0, piece < mt.Lo * 2};
            pg8::Gemm g2{(const bf16*)(ws + WS_HP) + kq * (FFE / 4), (const bf16*)(ws + WS_W_M2) + kq * (FFE / 4), MOE_ROWS, D, FFE / 4, FFE / 2, FFE / 2};
            pg8::EpiF32 E2{(float*)(ws + WS_XP) + (size_t)kq * MOE_PART_STRIDE - (size_t)mt.pm_min * 256 * D, D};
            pg8::gemm_phase<pg8::EpiF32, MoeTailOrder, PG8_ALIGN, PG8_SP2, true>(glds, g2, S2, E2); }
        SEAM(28); }
    if (IN(29)) { PF();
#pragma unroll 1
        for (int rep = 0; rep < DUP(29); ++rep) phase_moe_combine(Fp, XN, (rep + 1 < DUP(29)) ? (float*)(ws + WS_H) : out); }
#undef IN
#undef SEAM
}

extern "C" void kernel_launch(void* const* d_in, const int* in_sizes, int n_in, void* d_out, int out_size, void* d_ws, size_t ws_size, hipStream_t stream) {
    static int grid = 0;
    if (grid == 0) {
        if (n_in != N_IN || in_sizes[0] != M * D || out_size != M * D || ws_size < (WS_M_END > WS_END ? WS_M_END : WS_END)) { fprintf(stderr, "kernel_launch: unexpected problem (n_in %d, in0 %d, out %d, ws %zu < %zu); nothing launched\n", n_in, n_in > 0 ? in_sizes[0] : -1, out_size, ws_size, (size_t)WS_END); grid = -1; return; }
        int dev = 0, cus = 0, per_cu = 0;
        if (hipGetDevice(&dev) != hipSuccess || hipDeviceGetAttribute(&cus, hipDeviceAttributeMultiprocessorCount, dev) != hipSuccess) { fprintf(stderr, "kernel_launch: device query failed\n"); grid = -1; return; }
        if (hipFuncSetAttribute((const void*)mega_fwd, hipFuncAttributeMaxDynamicSharedMemorySize, LDS_BYTES) != hipSuccess) { fprintf(stderr, "kernel_launch: hipFuncSetAttribute(%d B LDS) failed\n", LDS_BYTES); grid = -1; return; }
        if (hipOccupancyMaxActiveBlocksPerMultiprocessor(&per_cu, (const void*)mega_fwd, NTHR, LDS_BYTES) != hipSuccess || per_cu < 1) fprintf(stderr, "kernel_launch: note: occupancy query reports %d workgroups per CU\n", per_cu);
        (void)hipGetLastError();
        if (cus < 256) { fprintf(stderr, "kernel_launch: %d CUs < 256: the persistent grid of 256 workgroups would not be resident; nothing launched\n", cus); grid = -1; return; }
        grid = 256;
    }
    if (grid < 0) return;
    if (hipMemsetAsync((char*)d_ws + WS_CTL, 0, CTL_ZERO_BYTES, stream) != hipSuccess) { fprintf(stderr, "kernel_launch: memset failed\n"); return; }
    Args a{};
    for (int i = 0; i < N_IN; ++i) a.in[i] = (const float*)d_in[i];
    a.out = (float*)d_out; a.ws = (unsigned char*)d_ws;
#if MK_SPLIT
    for (int p = 0; p <= MK_LAST_PHASE && p < N_PHASES; ++p) { a.ph_lo = p; a.ph_hi = p + 1; a.li = p; hipLaunchKernelGGL(mega_fwd, dim3(grid), dim3(NTHR), LDS_BYTES, stream, a); }
#else
    a.ph_lo = 0; a.ph_hi = MK_LAST_PHASE + 1; a.li = 0;
    hipLaunchKernelGGL(mega_fwd, dim3(grid), dim3(NTHR), LDS_BYTES, stream, a);
#endif
    const hipError_t le = hipPeekAtLastError();
    if (le != hipSuccess) fprintf(stderr, "kernel_launch: launch failed: %s\n", hipGetErrorName(le));
}
```

```cpp
#include <hip/hip_runtime.h>
#include <cstdio>
#include <cstdint>

namespace pg8 {
#define PG8_LAS __attribute__((address_space(3)))
typedef unsigned short bf16_t;
typedef short bf16x8 __attribute__((ext_vector_type(8)));
typedef float f32x4 __attribute__((ext_vector_type(4)));
typedef unsigned u32x4 __attribute__((ext_vector_type(4)));
typedef unsigned u32x2 __attribute__((ext_vector_type(2)));
constexpr int BM = 256, BK = 64, HALF = 128, HTB = HALF * BK * 2  , STAGE_BYTES = 8 * HTB, NXCD = 8, WGM = 8;

__host__ __device__ __forceinline__ int lds_byte(int r, int c) { const int st = (r >> 4) * 2 + (c >> 5), rr = r & 15, cc = c & 31, ob = rr * 64 + cc * 2; return st * 1024 + (ob ^ (((ob >> 9) & 1) << 5)); }
__host__ __device__ __forceinline__ void stage_rc(int b, int& R, int& C) { const int st = b / 1024, sb = b % 1024, swz = sb ^ (((sb >> 9) & 1) << 5); R = (st >> 1) * 16 + swz / 64; C = (st & 1) * 32 + (swz % 64) / 2; }
__host__ __device__ __forceinline__ int perm32(int rho) { const int n = rho >> 4, i = rho & 15; return 8 * (i >> 2) + 4 * n + (i & 3); }

typedef int i32x8 __attribute__((ext_vector_type(8)));
typedef int i32x4 __attribute__((ext_vector_type(4)));
__device__ __forceinline__ i32x8 cat8(bf16x8 lo, bf16x8 hi) { const i32x4 a = __builtin_bit_cast(i32x4, lo), b = __builtin_bit_cast(i32x4, hi); return __builtin_shufflevector(a, b, 0, 1, 2, 3, 4, 5, 6, 7); }
__device__ __forceinline__ void mfma_f8_inplace(f32x4& acc, i32x8 a, i32x8 b) { asm volatile("v_mfma_f32_16x16x128_f8f6f4 %0, %1, %2, %0" : "+v"(acc) : "v"(a), "v"(b)); }
struct Unit { int pm, pn, bn, idx; };
struct Gemm { const bf16_t* A; const bf16_t* Bt; int M, N, K, lda, ldb; };

struct StaticOrder {
    int nM, nN, nwg, G, c;
    __host__ __device__ void init(int M, int N, int G_, int c_) { nM = M / BM; nN = N / BM; nwg = nM * nN; G = G_; c = c_; }
    __host__ __device__ bool next(int i, Unit& u) const {
        const long L = (long)i * G + c; if (L >= nwg) return false;
        int wgid = (int)L; { const int q = nwg / NXCD, r = nwg % NXCD, xcd = wgid % NXCD, off = wgid / NXCD; wgid = (xcd < r ? xcd * (q + 1) : r * (q + 1) + (xcd - r) * q) + off; }
        const int nig = WGM * nN, gid = wgid / nig, fm = gid * WGM, gsz = (nM - fm) < WGM ? (nM - fm) : WGM;
        u.pm = fm + ((wgid % nig) % gsz); u.pn = (wgid % nig) / gsz; u.bn = u.pn; u.idx = i; return true;
    }
    __device__ __forceinline__ void a_ready(const Unit&) const {}
    __device__ __forceinline__ void done(const Unit&) const {}
};
struct ListOrder {
    int nN, nwg, G, c;
    __host__ __device__ void init(int nM_, int nN_, int G_, int c_) { nN = nN_; nwg = nM_ * nN_; G = G_; c = c_; }
    __host__ __device__ bool next(int i, Unit& u) const { const long L = (long)i * G + c; if (c < 0 || L >= nwg) return false; u.pm = (int)(L / nN); u.pn = (int)(L % nN); u.bn = u.pn; u.idx = i; return true; }
    __device__ __forceinline__ void a_ready(const Unit&) const {}
    __device__ __forceinline__ void done(const Unit&) const {}
};

__device__ __forceinline__ unsigned cvt_pk_bf16(float lo, float hi) { unsigned r; asm volatile("v_cvt_pk_bf16_f32 %0, %1, %2" : "=v"(r) : "v"(lo), "v"(hi)); return r; }
__device__ __forceinline__ unsigned cvt4_fp8(float a, float b, float c, float d) { int r = __builtin_amdgcn_cvt_pk_fp8_f32(a, b, 0, false); r = __builtin_amdgcn_cvt_pk_fp8_f32(c, d, r, true); return (unsigned)r; }
__device__ __forceinline__ float fsigmoid(float x) { return __builtin_amdgcn_rcpf(1.0f + __expf(-x)); }
__device__ __forceinline__ float gelu_tanh(float x) { const float u = 1.5957691216f * (x + 0.044715f * x * x * x); return x * fsigmoid(u); }
__device__ __forceinline__ float fsilu(float x) { return x * fsigmoid(x); }

__device__ __forceinline__ float row_rstd(const float* ssq, int row) {
    const f32x4 a = *(const f32x4*)(ssq + (size_t)row * 16), b = *(const f32x4*)(ssq + (size_t)row * 16 + 4), c = *(const f32x4*)(ssq + (size_t)row * 16 + 8), d = *(const f32x4*)(ssq + (size_t)row * 16 + 12);
    const f32x4 s = (a + b) + (c + d); return 1.0f / sqrtf(((s[0] + s[1]) + (s[2] + s[3])) * (1.0f / 1024.0f) + 1e-6f);
}
template <class Sched> __device__ __forceinline__ void fill_rstd_table(PG8_LAS float* tab, const Sched& S, const float* ssq, int tid) {
    Unit u; for (int i = 0; S.next(i, u); ++i) if (tid < 256) { const int ai = tid >> 7, wr = (tid >> 6) & 1, m = (tid >> 4) & 3, fr = tid & 15; tab[i * 256 + ((ai * 2 + wr) * 16 + fr) * 4 + m] = row_rstd(ssq, u.pm * BM + tid); }
    __syncthreads();
}
template <int ACT, bool SPLIT_ = false> struct EpiBf16 {
    static constexpr bool PERM = true, AFTER_DRAIN = false, SPLIT = SPLIT_, PACK = false; static constexpr int NST = 16; struct Pk {};
    bf16_t* O; int ldc; const float* bias; const PG8_LAS float* rsT;
    __device__ __forceinline__ void operator()(const f32x4 (&acc)[2][2][4][2], const Unit& u, int wr, int wc, int fr, int fq) const { half<0>(acc, u, wr, wc, fr, fq); half<1>(acc, u, wr, wc, fr, fq); }
    template <int AI> __device__ __forceinline__ void half(const f32x4 (&acc)[2][2][4][2], const Unit& u, int wr, int wc, int fr, int fq) const {
        const int row0 = u.pm * BM + wr * 64 + fr; const int col0 = u.pn * BM + wc * 32 + 8 * fq;
        f32x4 bv[2][2];
#pragma unroll
        for (int bj = 0; bj < 2; ++bj)
#pragma unroll
            for (int n = 0; n < 2; ++n) bv[bj][n] = bias ? *(const f32x4*)(bias + col0 + bj * HALF + 4 * n) : (f32x4){0.f, 0.f, 0.f, 0.f};
        { constexpr int ai = AI; const f32x4 rs4 = rsT ? *(const PG8_LAS f32x4*)(rsT + u.idx * 256 + ((ai * 2 + wr) * 16 + fr) * 4) : (f32x4){1.f, 1.f, 1.f, 1.f};
#pragma unroll
            for (int m = 0; m < 4; ++m) { bf16_t* rowp = O + (size_t)(row0 + ai * HALF + m * 16) * ldc + col0; const float rs = rs4[m];
#pragma unroll
                for (int bj = 0; bj < 2; ++bj) { f32x4 v0 = acc[ai][bj][m][0] * rs + bv[bj][0], v1 = acc[ai][bj][m][1] * rs + bv[bj][1];
                    if (ACT == 1) {
#pragma unroll
                        for (int j = 0; j < 4; ++j) { v0[j] = gelu_tanh(v0[j]); v1[j] = gelu_tanh(v1[j]); } }
                    u32x4 w; w.x = cvt_pk_bf16(v0[0], v0[1]); w.y = cvt_pk_bf16(v0[2], v0[3]); w.z = cvt_pk_bf16(v1[0], v1[1]); w.w = cvt_pk_bf16(v1[2], v1[3]);
                    *(u32x4*)(rowp + bj * HALF) = w; } } }
    }
};
struct EpiEvIn {
    static constexpr bool PERM = true, AFTER_DRAIN = false, SPLIT = true, PACK = false; static constexpr int NST = 16; struct Pk {};
    bf16_t* O; int ldc; bf16_t* KV6; int S;
    __device__ __forceinline__ void operator()(const f32x4 (&acc)[2][2][4][2], const Unit& u, int wr, int wc, int fr, int fq) const { half<0>(acc, u, wr, wc, fr, fq); half<1>(acc, u, wr, wc, fr, fq); }
    template <int AI> __device__ __forceinline__ void half(const f32x4 (&acc)[2][2][4][2], const Unit& u, int wr, int wc, int fr, int fq) const {
        const int row0 = u.pm * BM + wr * 64 + fr; const int col0 = u.pn * BM + wc * 32 + 8 * fq;
        const bool kv = (u.pn >= 12 && u.pn < 18);
        { constexpr int ai = AI;
#pragma unroll
            for (int m = 0; m < 4; ++m) { const int row = row0 + ai * HALF + m * 16;
#pragma unroll
                for (int bj = 0; bj < 2; ++bj) { const f32x4 v0 = acc[ai][bj][m][0], v1 = acc[ai][bj][m][1];
                    u32x4 w; w.x = cvt_pk_bf16(v0[0], v0[1]); w.y = cvt_pk_bf16(v0[2], v0[3]); w.z = cvt_pk_bf16(v1[0], v1[1]); w.w = cvt_pk_bf16(v1[2], v1[3]);
                    if (kv) { const int b = row / S, t = row - b * S;
                        bf16_t* p = KV6 + ((((size_t)(u.pn - 12) * 2 + b) * 2 + bj) * S + t) * 128 + wc * 32 + 8 * fq; *(u32x4*)p = w; }
                    else *(u32x4*)(O + (size_t)row * ldc + col0 + bj * HALF) = w; } } }
    }
};
struct EpiResid {
    static constexpr bool PERM = false, AFTER_DRAIN = false, SPLIT = false, PACK = false; static constexpr int NST = 0; struct Pk {};
    const float* base; float* out; int ldc;
    __device__ __forceinline__ void operator()(const f32x4 (&acc)[2][2][4][2], const Unit& u, int wr, int wc, int fr, int fq) const {
        const int row0 = u.pm * BM + wr * 64 + fr, col0 = u.pn * BM + wc * 32 + 4 * fq;
#pragma unroll
        for (int ai = 0; ai < 2; ++ai)
#pragma unroll
            for (int m = 0; m < 4; ++m) { const size_t off = (size_t)(row0 + ai * HALF + m * 16) * ldc + col0;
#pragma unroll
                for (int bj = 0; bj < 2; ++bj)
#pragma unroll
                    for (int n = 0; n < 2; ++n) { const f32x4 b = *(const f32x4*)(base + off + bj * HALF + n * 16); *(f32x4*)(out + off + bj * HALF + n * 16) = b + acc[ai][bj][m][n]; } }
    }
};
struct EpiResidN {
    static constexpr bool PERM = false, AFTER_DRAIN = false, SPLIT = false, PACK = false; static constexpr int NST = 0; struct Pk {};
    const float* base; float* out; int ldc; bf16_t* XB; float* SSQ;
    __device__ __forceinline__ void operator()(const f32x4 (&acc)[2][2][4][2], const Unit& u, int wr, int wc, int fr, int fq) const {
        const int row0 = u.pm * BM + wr * 64 + fr, col0 = u.pn * BM + wc * 32 + 4 * fq;
#pragma unroll
        for (int ai = 0; ai < 2; ++ai)
#pragma unroll
            for (int m = 0; m < 4; ++m) { const int row = row0 + ai * HALF + m * 16; const size_t off = (size_t)row * ldc + col0; float ss = 0.f;
#pragma unroll
                for (int bj = 0; bj < 2; ++bj)
#pragma unroll
                    for (int n = 0; n < 2; ++n) { const f32x4 b = *(const f32x4*)(base + off + bj * HALF + n * 16); const f32x4 v = b + acc[ai][bj][m][n]; *(f32x4*)(out + off + bj * HALF + n * 16) = v;
                        if (XB) { u32x2 w; w.x = cvt_pk_bf16(v[0], v[1]); w.y = cvt_pk_bf16(v[2], v[3]); *(u32x2*)(XB + off + bj * HALF + n * 16) = w; }
                        ss += (v[0] * v[0] + v[1] * v[1]) + (v[2] * v[2] + v[3] * v[3]); }
                ss += __shfl_xor(ss, 16); ss += __shfl_xor(ss, 32);
                if (XB && fq == 0) SSQ[(size_t)row * 16 + u.pn * 4 + wc] = ss; }
    }
};
template <bool BASE_F32> struct EpiResidB {
    static constexpr bool PERM = true, AFTER_DRAIN = false, SPLIT = false, PACK = false; static constexpr int NST = 0; struct Pk {};
    const void* base; bf16_t* X; int ldc; float* SSQ;
    __device__ __forceinline__ void operator()(const f32x4 (&acc)[2][2][4][2], const Unit& u, int wr, int wc, int fr, int fq) const {
        const int row0 = u.pm * BM + wr * 64 + fr, col0 = u.pn * BM + wc * 32 + 8 * fq;
#pragma unroll
        for (int ai = 0; ai < 2; ++ai)
#pragma unroll
            for (int m = 0; m < 4; ++m) { const int row = row0 + ai * HALF + m * 16; const size_t off = (size_t)row * ldc + col0; float ss = 0.f;
#pragma unroll
                for (int bj = 0; bj < 2; ++bj) { f32x4 b0, b1;
                    if constexpr (BASE_F32) { b0 = *(const f32x4*)((const float*)base + off + bj * HALF); b1 = *(const f32x4*)((const float*)base + off + bj * HALF + 4); }
                    else { const u32x4 r = *(const u32x4*)((const bf16_t*)base + off + bj * HALF);
                        b0 = (f32x4){__builtin_bit_cast(float, r.x << 16), __builtin_bit_cast(float, r.x & 0xffff0000u), __builtin_bit_cast(float, r.y << 16), __builtin_bit_cast(float, r.y & 0xffff0000u)};
                        b1 = (f32x4){__builtin_bit_cast(float, r.z << 16), __builtin_bit_cast(float, r.z & 0xffff0000u), __builtin_bit_cast(float, r.w << 16), __builtin_bit_cast(float, r.w & 0xffff0000u)}; }
                    const f32x4 v0 = b0 + acc[ai][bj][m][0], v1 = b1 + acc[ai][bj][m][1];
                    u32x4 w; w.x = cvt_pk_bf16(v0[0], v0[1]); w.y = cvt_pk_bf16(v0[2], v0[3]); w.z = cvt_pk_bf16(v1[0], v1[1]); w.w = cvt_pk_bf16(v1[2], v1[3]);
                    *(u32x4*)(X + off + bj * HALF) = w;
                    ss += ((v0[0] * v0[0] + v0[1] * v0[1]) + (v0[2] * v0[2] + v0[3] * v0[3])) + ((v1[0] * v1[0] + v1[1] * v1[1]) + (v1[2] * v1[2] + v1[3] * v1[3])); }
                ss += __shfl_xor(ss, 16); ss += __shfl_xor(ss, 32);
                if (fq == 0) SSQ[(size_t)row * 16 + u.pn * 4 + wc] = ss; }
    }
};
struct EpiNull {
    static constexpr bool PERM = false, AFTER_DRAIN = false, SPLIT = false, PACK = false; static constexpr int NST = 0; struct Pk {};
    __device__ __forceinline__ void operator()(const f32x4 (&acc)[2][2][4][2], const Unit&, int, int, int, int) const {
#pragma unroll
        for (int ai = 0; ai < 2; ++ai)
#pragma unroll
            for (int bj = 0; bj < 2; ++bj)
#pragma unroll
                for (int m = 0; m < 4; ++m)
#pragma unroll
                    for (int n = 0; n < 2; ++n) asm volatile("" :: "v"(acc[ai][bj][m][n]));
    }
};
struct EpiF32 {
    static constexpr bool PERM = false, AFTER_DRAIN = false, SPLIT = false, PACK = false; static constexpr int NST = 0; struct Pk {};
    float* C; int ldc;
    __device__ __forceinline__ void operator()(const f32x4 (&acc)[2][2][4][2], const Unit& u, int wr, int wc, int fr, int fq) const {
        const int row0 = u.pm * BM + wr * 64 + fr, col0 = u.pn * BM + wc * 32 + 4 * fq;
#pragma unroll
        for (int ai = 0; ai < 2; ++ai)
#pragma unroll
            for (int m = 0; m < 4; ++m) { float* rowp = C + (size_t)(row0 + ai * HALF + m * 16) * ldc + col0;
#pragma unroll
                for (int bj = 0; bj < 2; ++bj)
#pragma unroll
                    for (int n = 0; n < 2; ++n) *(f32x4*)(rowp + bj * HALF + n * 16) = acc[ai][bj][m][n]; }
    }
};
template <bool SPLIT_, bool PACK_ = false, bool F8O_ = false> struct EpiSwiglu {
    static_assert(!(PACK_ && F8O_), "no packed fp8 form");
    static constexpr bool PERM = true, AFTER_DRAIN = false, SPLIT = SPLIT_, PACK = PACK_; static constexpr int NST = 8;
    bf16_t* H; int ldh; const PG8_LAS float* rsT; float sc = 1.f;
    __device__ __forceinline__ void operator()(const f32x4 (&acc)[2][2][4][2], const Unit& u, int wr, int wc, int fr, int fq) const { half<0>(acc, u, wr, wc, fr, fq); half<1>(acc, u, wr, wc, fr, fq); }
    struct Pk { u32x4 w[4]; };
    __device__ __forceinline__ void pack1(const f32x4 (&acc)[2][2][4][2], const Unit& u, int wr, int fr, Pk& pk) const {
        constexpr int ai = 1; const f32x4 rs4 = rsT ? *(const PG8_LAS f32x4*)(rsT + u.idx * 256 + ((ai * 2 + wr) * 16 + fr) * 4) : (f32x4){1.f, 1.f, 1.f, 1.f};
#pragma unroll
        for (int m = 0; m < 4; ++m) { const float rs = rs4[m] * sc;
            const f32x4 u0 = acc[ai][0][m][0] * rs, u1 = acc[ai][0][m][1] * rs, g0 = acc[ai][1][m][0] * rs, g1 = acc[ai][1][m][1] * rs;
            pk.w[m].x = cvt_pk_bf16(fsilu(g0[0]) * u0[0], fsilu(g0[1]) * u0[1]); pk.w[m].y = cvt_pk_bf16(fsilu(g0[2]) * u0[2], fsilu(g0[3]) * u0[3]);
            pk.w[m].z = cvt_pk_bf16(fsilu(g1[0]) * u1[0], fsilu(g1[1]) * u1[1]); pk.w[m].w = cvt_pk_bf16(fsilu(g1[2]) * u1[2], fsilu(g1[3]) * u1[3]); }
    }
    __device__ __forceinline__ void store1(const Pk& pk, const Unit& u, int wr, int wc, int fr, int fq) const {
        bf16_t* p = H + (size_t)(u.pm * BM + wr * 64 + fr + HALF) * ldh + u.pn * 128 + wc * 32 + 8 * fq;
#pragma unroll
        for (int m = 0; m < 4; ++m) *(u32x4*)(p + (size_t)(m * 16) * ldh) = pk.w[m];
    }
    template <int AI> __device__ __forceinline__ void half(const f32x4 (&acc)[2][2][4][2], const Unit& u, int wr, int wc, int fr, int fq) const {
        const int row0 = u.pm * BM + wr * 64 + fr, col0 = u.pn * 128 + wc * 32 + 8 * fq;
        constexpr int ai = AI; const f32x4 rs4 = rsT ? *(const PG8_LAS f32x4*)(rsT + u.idx * 256 + ((ai * 2 + wr) * 16 + fr) * 4) : (f32x4){1.f, 1.f, 1.f, 1.f};
#pragma unroll
        for (int m = 0; m < 4; ++m) { bf16_t* rowp = H + (size_t)(row0 + ai * HALF + m * 16) * ldh + col0; const float rs = rs4[m] * sc;
            const f32x4 u0 = acc[ai][0][m][0] * rs, u1 = acc[ai][0][m][1] * rs, g0 = acc[ai][1][m][0] * rs, g1 = acc[ai][1][m][1] * rs;
            if constexpr (F8O_) { u32x2 w; w.x = cvt4_fp8(fsilu(g0[0]) * u0[0], fsilu(g0[1]) * u0[1], fsilu(g0[2]) * u0[2], fsilu(g0[3]) * u0[3]);
                w.y = cvt4_fp8(fsilu(g1[0]) * u1[0], fsilu(g1[1]) * u1[1], fsilu(g1[2]) * u1[2], fsilu(g1[3]) * u1[3]);
                *(u32x2*)((unsigned char*)H + (size_t)(row0 + ai * HALF + m * 16) * ldh + col0) = w; }
            else { u32x4 w; w.x = cvt_pk_bf16(fsilu(g0[0]) * u0[0], fsilu(g0[1]) * u0[1]); w.y = cvt_pk_bf16(fsilu(g0[2]) * u0[2], fsilu(g0[3]) * u0[3]);
            w.z = cvt_pk_bf16(fsilu(g1[0]) * u1[0], fsilu(g1[1]) * u1[1]); w.w = cvt_pk_bf16(fsilu(g1[2]) * u1[2], fsilu(g1[3]) * u1[3]);
            *(u32x4*)rowp = w; } }
    }
};
__host__ __device__ __forceinline__ int swiglu_row(int h, int gate) { return (h >> 7) * 256 + gate * 128 + (h & 127); }

template <class Epi, class Sched, bool ALIGN_EPI = false, bool SP2 = false, bool F8 = false>
__device__ __forceinline__ void gemm_phase(PG8_LAS unsigned char* lds, const Gemm g, const Sched& S, const Epi& E) {
    int tid = threadIdx.x; asm volatile("" : "+v"(tid));
    const int wid = __builtin_amdgcn_readfirstlane(tid >> 6), lane = tid & 63, wr = wid >> 2, wc = wid & 3, fr = lane & 15, fq = lane >> 4;
    const int K = g.K, nt = K / BK;
    unsigned voffA, voffB;
    { int R, C; stage_rc(tid * 16, R, C); const int Rb = Epi::PERM ? ((R & ~31) + perm32(R & 31)) : R;
      voffA = (unsigned)(R * g.lda + C) * 2u; voffB = (unsigned)(Rb * g.ldb + C) * 2u; }
    const size_t q64A = (size_t)64 * g.lda * 2, q64B = (size_t)64 * g.ldb * 2;
    const size_t kstep = (size_t)(BK * 2);
    const size_t hstepA = (size_t)HALF * g.lda * 2, hstepB = (size_t)HALF * g.ldb * 2;
    const size_t tstepA = 2 * hstepA, tstepB = 2 * hstepB;
    const unsigned ldsw = (unsigned)wid * 1024u;
    const int aoff = lds_byte(wr * 64 + fr, fq * 8), boff = lds_byte(wc * 32 + fr, fq * 8);
#define PG8_SA(b, h) (((b) * 2 + (h)) * HTB)
#define PG8_SB(b, h) ((4 + (b) * 2 + (h)) * HTB)
#define PG8_STAGE(bufoff, gbase, voff) do { __builtin_amdgcn_global_load_lds((const unsigned*)((const char*)(gbase) + (voff)), (PG8_LAS unsigned*)(lds + (bufoff) + ldsw), 16, 0, 0); \
        __builtin_amdgcn_global_load_lds((const unsigned*)((const char*)(gbase) + PG8_Q64(voff) + (voff)), (PG8_LAS unsigned*)(lds + (bufoff) + ldsw + 8192), 16, 0, 0); } while (0)
#define PG8_Q64(v) PG8_Q64_##v
#define PG8_Q64_voffA q64A
#define PG8_Q64_voffB q64B
#define PG8_LDA(dst, b, h) do { _Pragma("unroll") for (int m = 0; m < 4; ++m) _Pragma("unroll") for (int k = 0; k < 2; ++k) dst[m][k] = *(const PG8_LAS bf16x8*)(lds + PG8_SA(b, h) + aoff + m * 2048 + k * 1024); } while (0)
#define PG8_LDB(dst, b, h) do { _Pragma("unroll") for (int n = 0; n < 2; ++n) _Pragma("unroll") for (int k = 0; k < 2; ++k) dst[n][k] = *(const PG8_LAS bf16x8*)(lds + PG8_SB(b, h) + boff + n * 2048 + k * 1024); } while (0)
#define PG8_MMA(ai, bj, At, Bt) do { __builtin_amdgcn_s_setprio(1); \
        if constexpr (F8) { _Pragma("unroll") for (int m = 0; m < 4; ++m) _Pragma("unroll") for (int n = 0; n < 2; ++n) \
            mfma_f8_inplace(acc[ai][bj][m][n], cat8(Bt[n][0], Bt[n][1]), cat8(At[m][0], At[m][1])); } \
        else { _Pragma("unroll") for (int m = 0; m < 4; ++m) _Pragma("unroll") for (int n = 0; n < 2; ++n) _Pragma("unroll") for (int k = 0; k < 2; ++k) \
            acc[ai][bj][m][n] = __builtin_amdgcn_mfma_f32_16x16x32_bf16(Bt[n][k], At[m][k], acc[ai][bj][m][n], 0, 0, 0); } \
        __builtin_amdgcn_s_setprio(0); } while (0)
#define PG8_WAIT_V(n) asm volatile("s_waitcnt vmcnt(" #n ")" ::: "memory")
#define PG8_WAIT_L(n) asm volatile("s_waitcnt lgkmcnt(" #n ")" ::: "memory")
#define PG8_WAIT_REL(NN) do { if (rel) asm volatile("s_waitcnt vmcnt(%0)" :: "n"(NN) : "memory"); else PG8_WAIT_V(8); } while (0)
#define PG8_BAR __builtin_amdgcn_s_barrier()
#define PG8_SCHED __builtin_amdgcn_sched_barrier(0)
    typename Epi::Pk pk; Unit cur, nxt, pend; int ui = 0; bool pending = false; pend.pm = pend.pn = pend.bn = pend.idx = 0;
    if (!S.next(0, cur)) return;
    f32x4 acc[2][2][4][2];
#pragma unroll
    for (int a = 0; a < 2; ++a)
#pragma unroll
        for (int b = 0; b < 2; ++b)
#pragma unroll
            for (int m = 0; m < 4; ++m)
#pragma unroll
                for (int n = 0; n < 2; ++n) acc[a][b][m][n] = (f32x4){0.f, 0.f, 0.f, 0.f};
    bf16x8 At[4][2], B0[2][2], B1[2][2];
    const char* cA = (const char*)g.A + (size_t)cur.pm * tstepA; const char* cB = (const char*)g.Bt + (size_t)cur.bn * tstepB;
    S.a_ready(cur);
    if constexpr (SP2) {
        PG8_STAGE(PG8_SB(0, 0), cB, voffB); PG8_STAGE(PG8_SB(0, 1), cB + hstepB, voffB); PG8_STAGE(PG8_SA(0, 0), cA, voffA); PG8_STAGE(PG8_SA(0, 1), cA + hstepA, voffA);
        if (wr == 1) PG8_BAR;
        PG8_WAIT_V(2); PG8_BAR;
        PG8_STAGE(PG8_SB(1, 0), cB + kstep, voffB); PG8_STAGE(PG8_SA(1, 0), cA + kstep, voffA); PG8_STAGE(PG8_SB(1, 1), cB + hstepB + kstep, voffB);
        PG8_WAIT_V(6); PG8_BAR;
    } else {
        PG8_STAGE(PG8_SB(0, 0), cB, voffB); PG8_STAGE(PG8_SA(0, 0), cA, voffA); PG8_STAGE(PG8_SB(0, 1), cB + hstepB, voffB); PG8_STAGE(PG8_SA(0, 1), cA + hstepA, voffA);
        if (wr == 1) PG8_BAR;
        PG8_WAIT_V(4); PG8_BAR;
        PG8_STAGE(PG8_SB(1, 0), cB + kstep, voffB); PG8_STAGE(PG8_SA(1, 0), cA + kstep, voffA); PG8_STAGE(PG8_SB(1, 1), cB + hstepB + kstep, voffB);
        PG8_WAIT_V(6); PG8_BAR;
    }
    for (;;) {
        const bool has_next = S.next(ui + 1, nxt);
        const char* nA = has_next ? (const char*)g.A + (size_t)nxt.pm * tstepA : cA; const char* nB = has_next ? (const char*)g.Bt + (size_t)nxt.bn * tstepB : cB;
        for (int t = 0; t < nt; t += 2) {
            const bool last = (t == nt - 2);
            const char* a1 = cA + (size_t)(t + 1) * kstep;
            const char* a2 = last ? nA : cA + (size_t)(t + 2) * kstep; const char* b2 = last ? nB : cB + (size_t)(t + 2) * kstep;
            const char* a3 = a2 + kstep; const char* b3 = b2 + kstep;
            if (last && has_next) S.a_ready(nxt);
            if constexpr (SP2) {
            const bool rel = Epi::SPLIT && pending && t == 0;
            if (rel) { if constexpr (Epi::SPLIT) { PG8_STAGE(PG8_SA(1, 1), a1 + hstepA, voffA); PG8_SCHED;
                if constexpr (Epi::PACK) { E.store1(pk, pend, wr, wc, fr, fq); }
                else { E.template half<1>(acc, pend, wr, wc, fr, fq);
#pragma unroll
                for (int b = 0; b < 2; ++b)
#pragma unroll
                    for (int m = 0; m < 4; ++m)
#pragma unroll
                        for (int n = 0; n < 2; ++n) acc[1][b][m][n] = (f32x4){0.f, 0.f, 0.f, 0.f}; }
                S.done(pend); pending = false;
                PG8_SCHED; PG8_LDB(B0, 0, 0); PG8_LDB(B1, 0, 1); PG8_SCHED; PG8_LDA(At, 0, 0); } }
            else { PG8_LDB(B0, 0, 0); PG8_LDB(B1, 0, 1); PG8_SCHED; PG8_LDA(At, 0, 0); PG8_STAGE(PG8_SA(1, 1), a1 + hstepA, voffA); }
            PG8_WAIT_REL(8 + Epi::NST); PG8_WAIT_L(0); PG8_BAR; PG8_MMA(0, 0, At, B0); PG8_MMA(0, 1, At, B1); PG8_BAR; PG8_SCHED;
            PG8_LDA(At, 0, 1); PG8_STAGE(PG8_SB(0, 0), b2, voffB); PG8_STAGE(PG8_SB(0, 1), b2 + hstepB, voffB); PG8_STAGE(PG8_SA(0, 0), a2, voffA);
            PG8_WAIT_REL(8 + Epi::NST); PG8_WAIT_L(0); PG8_BAR; PG8_MMA(1, 0, At, B0); PG8_MMA(1, 1, At, B1); PG8_BAR; PG8_SCHED;
            PG8_LDB(B0, 1, 0); PG8_LDB(B1, 1, 1); PG8_SCHED; PG8_LDA(At, 1, 0); PG8_STAGE(PG8_SA(0, 1), a2 + hstepA, voffA);
            PG8_WAIT_REL(8 + Epi::NST / 2); PG8_WAIT_L(0); PG8_BAR; PG8_MMA(0, 0, At, B0); PG8_MMA(0, 1, At, B1); PG8_BAR; PG8_SCHED;
            PG8_LDA(At, 1, 1); PG8_STAGE(PG8_SB(1, 0), b3, voffB); PG8_STAGE(PG8_SB(1, 1), b3 + hstepB, voffB); PG8_STAGE(PG8_SA(1, 0), a3, voffA);
            PG8_WAIT_V(8); PG8_WAIT_L(0); PG8_BAR; PG8_MMA(1, 0, At, B0); PG8_MMA(1, 1, At, B1); PG8_BAR; PG8_SCHED;
            } else {
            PG8_LDB(B0, 0, 0); PG8_SCHED; PG8_LDA(At, 0, 0); PG8_STAGE(PG8_SA(1, 1), a1 + hstepA, voffA);
            PG8_WAIT_L(8); PG8_BAR; PG8_WAIT_L(0); PG8_MMA(0, 0, At, B0); PG8_BAR; PG8_SCHED;
            PG8_LDB(B1, 0, 1); PG8_STAGE(PG8_SB(0, 0), b2, voffB);
            PG8_BAR; PG8_WAIT_L(0); PG8_MMA(0, 1, At, B1); PG8_BAR;
            PG8_LDA(At, 0, 1); PG8_STAGE(PG8_SA(0, 0), a2, voffA);
            PG8_BAR; PG8_WAIT_L(0); PG8_MMA(1, 0, At, B0); PG8_BAR; PG8_SCHED;
            PG8_STAGE(PG8_SB(0, 1), b2 + hstepB, voffB);
            PG8_WAIT_V(6); PG8_BAR; PG8_MMA(1, 1, At, B1); PG8_BAR;
            PG8_LDB(B0, 1, 0); PG8_SCHED; PG8_LDA(At, 1, 0); PG8_STAGE(PG8_SA(0, 1), a2 + hstepA, voffA);
            PG8_WAIT_L(8); PG8_BAR; PG8_WAIT_L(0); PG8_MMA(0, 0, At, B0); PG8_BAR; PG8_SCHED;
            PG8_LDB(B1, 1, 1); PG8_STAGE(PG8_SB(1, 0), b3, voffB);
            PG8_BAR; PG8_WAIT_L(0); PG8_MMA(0, 1, At, B1); PG8_BAR;
            PG8_LDA(At, 1, 1); PG8_STAGE(PG8_SA(1, 0), a3, voffA);
            PG8_BAR; PG8_WAIT_L(0); PG8_MMA(1, 0, At, B0); PG8_BAR; PG8_SCHED;
            PG8_STAGE(PG8_SB(1, 1), b3 + hstepB, voffB);
            PG8_WAIT_V(6); PG8_BAR; PG8_MMA(1, 1, At, B1); PG8_BAR;
            }
        }
        if constexpr (F8) asm volatile("s_nop 15\n\ts_nop 15\n\ts_nop 15\n\ts_nop 15" ::: "memory");
        if constexpr (ALIGN_EPI) { if (wr == 0) PG8_BAR; }
        if constexpr (Epi::SPLIT) { static_assert(SP2, "split epilogues need the SP2 loop");
            if (has_next) { E.template half<0>(acc, cur, wr, wc, fr, fq); if constexpr (Epi::PACK) E.pack1(acc, cur, wr, fr, pk); pend = cur; pending = true; }
            else { E.template half<0>(acc, cur, wr, wc, fr, fq); E.template half<1>(acc, cur, wr, wc, fr, fq); S.done(cur); } }
        else if constexpr (!Epi::AFTER_DRAIN) { E(acc, cur, wr, wc, fr, fq); S.done(cur); }
        if (!has_next) break;
#pragma unroll
        for (int a = 0; a < ((Epi::SPLIT && !Epi::PACK) ? 1 : 2); ++a)
#pragma unroll
            for (int b = 0; b < 2; ++b)
#pragma unroll
                for (int m = 0; m < 4; ++m)
#pragma unroll
                    for (int n = 0; n < 2; ++n) acc[a][b][m][n] = (f32x4){0.f, 0.f, 0.f, 0.f};
        cur = nxt; cA = nA; cB = nB; ++ui;
        if constexpr (ALIGN_EPI) { if (wr == 1) PG8_BAR; }
    }
    PG8_WAIT_V(0);
    if constexpr (!ALIGN_EPI) { if (wr == 0) PG8_BAR; }
    PG8_BAR;
    if constexpr (Epi::AFTER_DRAIN) { E.fused(acc, cur, wr, wc, fr, fq, lds, wid, lane); S.done(cur); }
#undef PG8_SA
#undef PG8_SB
#undef PG8_STAGE
#undef PG8_Q64
#undef PG8_Q64_voffA
#undef PG8_Q64_voffB
#undef PG8_LDA
#undef PG8_LDB
#undef PG8_MMA
#undef PG8_WAIT_V
#undef PG8_WAIT_L
#undef PG8_WAIT_REL
#undef PG8_BAR
#undef PG8_SCHED
}
}
#define PG8_SP2 true
#define PG8_ALIGN true
constexpr int NWAVES = 8, NTHR = 512;
constexpr int BATCH = 2, SEQ = 8192, D = 1024, M = BATCH * SEQ;
constexpr int MEMLEN = 256, MMEM = BATCH * MEMLEN;
constexpr int EV_IN = 4632, EV_INP = 4864;
constexpr int OD_IN = 5152, OD_INP = 5376;
constexpr int FF = 2816, FFE = 3584, NEXP = 8;
constexpr float MOE_W2_SCALE = 128.f;
constexpr float MOE_W13_SCALE = 64.f;
constexpr int NQB = SEQ / 64;
constexpr int XH = 4;
constexpr float EPS = 1e-6f;
constexpr int MOE_ROWS = 2 * M + NEXP * 256;
constexpr int MOE_TILES = MOE_ROWS / 256;

constexpr size_t MiB = 1u << 20;
constexpr size_t WS_CTL = 0, CTL_ZERO_BYTES = 1 * MiB;
constexpr size_t WS_SMALL = 1 * MiB;
constexpr size_t WS_CMPB_PART = WS_SMALL;
constexpr size_t WS_CMPB = WS_SMALL + 256 * 1024;
constexpr size_t WS_OV = WS_SMALL + 512 * 1024;
constexpr size_t WS_MEMN = 2 * MiB;
constexpr size_t WS_KVM = 4 * MiB;
constexpr size_t WS_KM = 6 * MiB;
constexpr size_t WS_HID = 7 * MiB;
constexpr size_t WS_KVCMP = 9 * MiB;
constexpr size_t WS_MOEIDX = 10 * MiB;
constexpr size_t WS_SSQ = 14 * MiB;
constexpr size_t WS_W = 16 * MiB;
constexpr size_t WS_W_EVIN = WS_W, WS_W_EVOUT = WS_W_EVIN + 10 * MiB, WS_W_CK1 = WS_W_EVOUT + 4 * MiB, WS_W_CV1 = WS_W_CK1 + 2 * MiB, WS_W_ODIN = WS_W_CV1 + 2 * MiB,
                 WS_W_ODOUT = WS_W_ODIN + 11 * MiB, WS_W_XQ = WS_W_ODOUT + 4 * MiB, WS_W_XKV = WS_W_XQ + 2 * MiB, WS_W_XO = WS_W_XKV + 4 * MiB, WS_W_FF13 = WS_W_XO + 2 * MiB,
                 WS_W_FF2 = WS_W_FF13 + 11 * MiB, WS_W_M13 = WS_W_FF2 + 6 * MiB, WS_W_M2 = WS_W_M13 + 112 * MiB, WS_W_END = WS_W_M2 + 56 * MiB;
constexpr size_t WS_XN = WS_W_END;
constexpr size_t WS_QX = WS_XN + 32 * MiB, WS_OX = WS_QX + 16 * MiB, WS_R = WS_OX + 16 * MiB;
constexpr size_t WS_Y0 = WS_R, WS_KV6 = WS_R + 152 * MiB, WS_MIX = WS_R + 201 * MiB, WS_H = WS_R + 265 * MiB;
constexpr size_t WS_Y1 = WS_R, WS_YG = WS_R + 168 * MiB;
constexpr size_t WS_XN8 = WS_QX;
constexpr size_t WS_XP = WS_R, WS_HP = WS_R + 68 * MiB, WS_YP = WS_R + 306 * MiB, WS_END = WS_R + 442 * MiB;
static_assert(WS_W_END == 242 * MiB && WS_END == 748 * MiB, "ws map");
constexpr int CW_TMO = 0, CW_CODE = 1, CW_CHK = 2;
constexpr int CW_BAR = 4096;
constexpr int CW_MOECNT = 16384;
constexpr int CW_MOEOFF = 20480;

constexpr int LDS_BYTES = 159744;
constexpr int MISC_OFF = LDS_BYTES - 512;
constexpr int SCR_BYTES = MISC_OFF;

#define GAS __attribute__((address_space(1)))
#define LAS __attribute__((address_space(3)))
typedef unsigned short bf16;
typedef unsigned v4u __attribute__((ext_vector_type(4)));
typedef unsigned v2u __attribute__((ext_vector_type(2)));
typedef float f32x4 __attribute__((ext_vector_type(4)));
typedef float f32x16 __attribute__((ext_vector_type(16)));
typedef short bf16x8 __attribute__((ext_vector_type(8)));
typedef short s16x4 __attribute__((ext_vector_type(4)));
typedef GAS unsigned gu32;
#define RLX_AGENT __ATOMIC_RELAXED, __HIP_MEMORY_SCOPE_AGENT
#define LDS_WAIT() asm volatile("s_waitcnt lgkmcnt(0)" ::: "memory")
#define VM_WAIT() asm volatile("s_waitcnt vmcnt(0)" ::: "memory")
#define SBAR() __builtin_amdgcn_sched_barrier(0)
__device__ __forceinline__ int lane_id() { return (int)threadIdx.x & 63; }
__device__ __forceinline__ unsigned f2bf(float f) { unsigned u = __builtin_bit_cast(unsigned, f); return (u + 0x7fffu + ((u >> 16) & 1u)) >> 16; }
__device__ __forceinline__ unsigned pk2(float lo, float hi) { return f2bf(lo) | (f2bf(hi) << 16); }
__device__ __forceinline__ float bf2f(unsigned short b) { return __builtin_bit_cast(float, ((unsigned)b) << 16); }
__device__ __forceinline__ float bflo(unsigned w) { return __builtin_bit_cast(float, w << 16); }
__device__ __forceinline__ float bfhi(unsigned w) { return __builtin_bit_cast(float, w & 0xffff0000u); }
__device__ __forceinline__ unsigned cvtpk(float lo, float hi) { unsigned r; asm volatile("v_cvt_pk_bf16_f32 %0, %1, %2" : "=v"(r) : "v"(lo), "v"(hi)); return r; }
__device__ __forceinline__ float wave_sum(float v) {
#pragma unroll
    for (int o = 1; o < 64; o <<= 1) v += __shfl_xor(v, o);
    return v;
}
using pg8::fsigmoid; using pg8::gelu_tanh; using pg8::fsilu;
__device__ __forceinline__ float fsoftplus(float x) { return x > 20.f ? x : log1pf(__expf(x)); }

#define XB_TMO      128
#define XB_XCNT(j)  (256  + 64 * (j))
#define XB_XSUB(j)  (1280 + 64 * (j))
#define XB_XGEN(j)  (2304 + 64 * (j))
#define XB_TOP      3328
#define XB_TOPGEN   3392
#define XCD_BAR_WORDS 3456
#define XB_SPIN_CAP (1u << 18)

__device__ __forceinline__ unsigned xb_ld(unsigned* p)              { return __hip_atomic_load(p, __ATOMIC_RELAXED, __HIP_MEMORY_SCOPE_AGENT); }
__device__ __forceinline__ unsigned xb_add(unsigned* p, unsigned v) { return __hip_atomic_fetch_add(p, v, __ATOMIC_RELAXED, __HIP_MEMORY_SCOPE_AGENT); }
__device__ __forceinline__ unsigned xb_xcc_id() { return (unsigned)__builtin_amdgcn_s_getreg((3 << 11) | 20) & 0xFu; }
#define XB_SPIN(cond, bar) do { unsigned _sp = 0; while (cond) { __builtin_amdgcn_s_sleep(1); \
    if ((++_sp & 255u) == 0u) { if (xb_ld(&(bar)[XB_TMO])) break; if (_sp > XB_SPIN_CAP) { atomicAdd(&(bar)[XB_TMO], 1u); break; } } } } while (0)

struct XcdBarrier {
    unsigned* bar; unsigned x;
    volatile LAS unsigned* st;
};

__device__ __forceinline__ XcdBarrier xcd_barrier_post(unsigned* bar, volatile LAS unsigned* st) {
    XcdBarrier b; b.bar = bar; b.x = xb_xcc_id(); b.st = st;
    if (threadIdx.x == 0) (void)xb_add(&bar[XB_XCNT(b.x)], 1u);
    return b;
}
__device__ __forceinline__ void xcd_barrier_complete(unsigned* bar, unsigned x, unsigned& nloc, unsigned& nx) {
    const unsigned G = gridDim.x * gridDim.y * gridDim.z;
    unsigned sum, cnt, mine, sp = 0u;
    for (;;) {
        sum = 0u; cnt = 0u; mine = 0u;
#pragma unroll
        for (unsigned j = 0; j < 16; ++j) { const unsigned c = xb_ld(&bar[XB_XCNT(j)]); sum += c; cnt += (c > 0u) ? 1u : 0u; mine = (j == x) ? c : mine; }
        if (sum == G) break;
        __builtin_amdgcn_s_sleep(1);
        if ((++sp & 255u) == 0u) { if (xb_ld(&bar[XB_TMO])) break; if (sp > XB_SPIN_CAP) { atomicAdd(&bar[XB_TMO], 1u); break; } }
    }
    nloc = mine > 0u ? mine : 1u; nx = cnt > 0u ? cnt : 1u;
}

__device__ __forceinline__ void xcd_barrier(const XcdBarrier& b) {
    asm volatile("s_waitcnt vmcnt(0)" ::: "memory");
    __syncthreads();
    if (threadIdx.x == 0) {
        unsigned* bar = b.bar;
        __builtin_amdgcn_s_waitcnt(0);
        unsigned nloc = b.st[0], nx = b.st[1];
        if (nloc == 0u) { xcd_barrier_complete(bar, b.x, nloc, nx); b.st[0] = nloc; b.st[1] = nx; }
        const unsigned old = xb_add(&bar[XB_XSUB(b.x)], 1u);
        const unsigned gen = old / nloc;
        if (old + 1u == (gen + 1u) * nloc) {
            __builtin_amdgcn_fence(__ATOMIC_RELEASE, "agent");
            asm volatile("s_waitcnt vmcnt(0)" ::: "memory");
            const unsigned og = xb_add(&bar[XB_TOP], 1u);
            const unsigned tg = og / nx;
            if (og + 1u == (tg + 1u) * nx) xb_add(&bar[XB_TOPGEN], 1u);
            else XB_SPIN(xb_ld(&bar[XB_TOPGEN]) == tg, bar);
            __builtin_amdgcn_fence(__ATOMIC_ACQUIRE, "agent");
            xb_add(&bar[XB_XGEN(b.x)], 1u);
            asm volatile("s_waitcnt vmcnt(0)" ::: "memory");
        } else {
            XB_SPIN(xb_ld(&bar[XB_XGEN(b.x)]) == gen, bar);
            __builtin_amdgcn_fence(__ATOMIC_ACQUIRE, "agent");
            asm volatile("s_waitcnt vmcnt(0)" ::: "memory");
        }
    }
    __syncthreads();
}

struct Args { const float* in[41]; float* out; unsigned char* ws; int ph_lo, ph_hi, li, pad; };
struct Frame { LAS unsigned char* lds; volatile LAS unsigned* MISC; gu32* ctl; unsigned char* ws; int tid, lane, wave, G, bid; };
enum { I_X = 0, I_MEM, I_NMIX, I_NCROSS, I_NMEM, I_NFFN, I_EVWIN, I_RGCW, I_RGCB, I_RGWA, I_RGBA, I_RGWX, I_RGBX, I_RGLAM, I_GATEB, I_QNORM, I_KNORM, I_CMPPOS,
       I_CKW1, I_CKW2, I_CVW1, I_CVW2, I_EVWOUT, I_ODWIN, I_ODCW, I_ODCB, I_DTB, I_ALOG, I_DSKIP, I_ODNORM, I_ODWOUT, I_XWQ, I_XWKV, I_XQN, I_XKN, I_XWO,
       I_FFW13, I_FFW2, I_ROUTER, I_MW13, I_MW2, N_IN };
static_assert(N_IN == 41, "input count");

template <int MAP>
__device__ __forceinline__ void transpose_item(const float* W, int N, bf16* WT, int ldt, LAS float* scr, int kb, int nb, int lane, int ffs, const float* kg = nullptr) {
    const int k0 = 64 * kb, n0 = 64 * nb; const int c4 = (lane & 15) * 4, r4 = lane >> 4;
    f32x4 tv[16];
    if ((N & 3) == 0) {
#pragma unroll
        for (int i = 0; i < 16; ++i) { const int kk = 4 * i + r4; tv[i] = (n0 + c4 < N) ? *(const GAS f32x4*)(W + (size_t)(k0 + kk) * N + n0 + c4) : (f32x4){0.f, 0.f, 0.f, 0.f}; }
    } else {
#pragma unroll
        for (int i = 0; i < 16; ++i) { const int kk = 4 * i + r4; const float* src = W + (size_t)(k0 + kk) * N + n0 + c4;
#pragma unroll
            for (int j = 0; j < 4; ++j) tv[i][j] = (n0 + c4 + j < N) ? src[j] : 0.f; }
    }
#pragma unroll
    for (int i = 0; i < 16; ++i) { const int kk = 4 * i + r4; const float gk = kg ? kg[k0 + kk] : 1.f;
#pragma unroll
        for (int j = 0; j < 4; ++j) scr[kk * 65 + c4 + j] = tv[i][j] * gk; }
    LDS_WAIT(); asm volatile("" ::: "memory");
    const int c = lane & 7;
#pragma unroll
    for (int j = 0; j < 8; ++j) { const int nl = (lane >> 3) + 8 * j, n = n0 + nl; const LAS float* s = scr + (8 * c) * 65 + nl;
        v4u o; o.x = pk2(s[0 * 65], s[1 * 65]); o.y = pk2(s[2 * 65], s[3 * 65]); o.z = pk2(s[4 * 65], s[5 * 65]); o.w = pk2(s[6 * 65], s[7 * 65]);
        int row = n; if (MAP == 1) row = (n < ffs) ? pg8::swiglu_row(n, 0) : pg8::swiglu_row(n - ffs, 1);
        if (n < ((N + 31) & ~31)) *(GAS v4u*)(WT + (size_t)row * ldt + k0 + 8 * c) = o; }
    LDS_WAIT(); asm volatile("" ::: "memory");
}
__device__ __forceinline__ unsigned pk4_fp8(float a, float b, float c, float d) { int r = __builtin_amdgcn_cvt_pk_fp8_f32(a, b, 0, false); r = __builtin_amdgcn_cvt_pk_fp8_f32(c, d, r, true); return (unsigned)r; }
template <int MAP>
__device__ __forceinline__ void transpose_item_f8(const float* W, int N, unsigned char* WT8, int ldt, LAS float* scr, int kb, int nb, int lane, int ffs, float sc) {
    const int k0 = 64 * kb, n0 = 64 * nb; const int c4 = (lane & 15) * 4, r4 = lane >> 4;
    f32x4 tv[16];
#pragma unroll
    for (int i = 0; i < 16; ++i) { const int kk = 4 * i + r4; tv[i] = *(const GAS f32x4*)(W + (size_t)(k0 + kk) * N + n0 + c4); }
#pragma unroll
    for (int i = 0; i < 16; ++i) { const int kk = 4 * i + r4;
#pragma unroll
        for (int j = 0; j < 4; ++j) scr[kk * 65 + c4 + j] = tv[i][j] * sc; }
    LDS_WAIT(); asm volatile("" ::: "memory");
    const int c = lane & 7;
#pragma unroll
    for (int j = 0; j < 8; ++j) { const int nl = (lane >> 3) + 8 * j, n = n0 + nl; const LAS float* s = scr + (8 * c) * 65 + nl;
        v2u o; o.x = pk4_fp8(s[0 * 65], s[1 * 65], s[2 * 65], s[3 * 65]); o.y = pk4_fp8(s[4 * 65], s[5 * 65], s[6 * 65], s[7 * 65]);
        int row = n; if (MAP == 1) row = (n < ffs) ? pg8::swiglu_row(n, 0) : pg8::swiglu_row(n - ffs, 1);
        *(GAS v2u*)(WT8 + (size_t)row * ldt + k0 + 8 * c) = o; }
    LDS_WAIT(); asm volatile("" ::: "memory");
}
constexpr int MOE_CONV_ITEMS = NEXP * (16 * 112 + 56 * 16);

__device__ __forceinline__ void rms_row_to_bf16(const float* xrow, const float* g, bf16* orow, int lane) {
    const GAS f32x4* xr = (const GAS f32x4*)xrow + lane; const GAS f32x4* gr = (const GAS f32x4*)g + lane;
    f32x4 v[4]; float s = 0.f;
#pragma unroll
    for (int j = 0; j < 4; ++j) { v[j] = xr[64 * j]; s += (v[j].x * v[j].x + v[j].y * v[j].y) + (v[j].z * v[j].z + v[j].w * v[j].w); }
    const float rstd = 1.f / sqrtf(wave_sum(s) * (1.f / D) + EPS);
    GAS unsigned long long* o8 = (GAS unsigned long long*)orow + lane;
#pragma unroll
    for (int j = 0; j < 4; ++j) { const f32x4 gg = gr[64 * j];
        o8[64 * j] = (unsigned long long)pk2(v[j].x * rstd * gg.x, v[j].y * rstd * gg.y) | ((unsigned long long)pk2(v[j].z * rstd * gg.z, v[j].w * rstd * gg.w) << 32); }
}
__device__ __forceinline__ void phase_rmsnorm(const Frame& F, const float* x, const float* g, bf16* xn, int rows) {
    const int gw = F.bid * NWAVES + F.wave, NGW = F.G * NWAVES;
    for (int m = gw; m < rows; m += NGW) rms_row_to_bf16(x + (size_t)m * D, g, xn + (size_t)m * D, F.lane);
}
#define TR_MAT(cnt_, W_, K_, N_, WT_, ldt_, MAPK_, ffs_, kg_) \
    if (r < (cnt_)) { const int nblk_ = ((N_) + 63) / 64; transpose_item<MAPK_>((W_), (N_), (WT_), (ldt_), scr, r / nblk_, r % nblk_, F.lane, (ffs_), (kg_)); continue; } r -= (cnt_);
constexpr int C_EVIN = 16 * 73, C_EVOUT = 32 * 16, C_CW1 = 64 * 4, C_ODIN = 16 * 81, C_ODOUT = 32 * 16, C_XQ = 16 * 8, C_XKV = 16 * 16, C_XO = 8 * 16, C_FF13 = 16 * 88, C_FF2 = 44 * 16;
constexpr int CONV_A = C_EVIN + 2 * C_XKV + 2 * C_CW1, CONV_B = C_EVOUT + 2 * C_XQ + 2 * C_XO + C_FF13 + C_FF2 + C_ODIN + C_ODOUT;
constexpr int CONV_ALL = CONV_A + CONV_B + MOE_CONV_ITEMS, CONV_Q = 4480, CONV_P2_END = CONV_ALL - 2 * CONV_Q;
__device__ __forceinline__ void convert_range(const Frame& F, const Args& a, int gw, int NGW, int it_lo, int it_hi) {
    LAS float* scr = (LAS float*)(F.lds + F.wave * 16640); unsigned char* ws = F.ws;
    for (int it = it_lo + gw; it < it_hi; it += NGW) {
        int r = it;
        TR_MAT(C_EVIN, a.in[I_EVWIN], D, EV_IN, (bf16*)(ws + WS_W_EVIN), D, 0, 0, nullptr)
        TR_MAT(C_XKV, a.in[I_XWKV], D, 1024, (bf16*)(ws + WS_W_XKV), D, 0, 0, nullptr)
        TR_MAT(C_XKV, a.in[I_XWKV] + (size_t)D * 1024, D, 1024, (bf16*)(ws + WS_W_XKV) + (size_t)1024 * D, D, 0, 0, nullptr)
        TR_MAT(C_CW1, a.in[I_CKW1], 4096, 256, (bf16*)(ws + WS_W_CK1), 4096, 0, 0, nullptr)
        TR_MAT(C_CW1, a.in[I_CVW1], 4096, 256, (bf16*)(ws + WS_W_CV1), 4096, 0, 0, nullptr)
        TR_MAT(C_EVOUT, a.in[I_EVWOUT], 2048, D, (bf16*)(ws + WS_W_EVOUT), 2048, 0, 0, nullptr)
        TR_MAT(C_XQ, a.in[I_XWQ], D, 512, (bf16*)(ws + WS_W_XQ), D, 0, 0, a.in[I_NCROSS])
        TR_MAT(C_XO, a.in[I_XWO], 512, D, (bf16*)(ws + WS_W_XO), 512, 0, 0, nullptr)
        TR_MAT(C_FF13, a.in[I_FFW13], D, 2 * FF, (bf16*)(ws + WS_W_FF13), D, 1, FF, a.in[I_NFFN])
        TR_MAT(C_FF2, a.in[I_FFW2], FF, D, (bf16*)(ws + WS_W_FF2), FF, 0, 0, nullptr)
        TR_MAT(C_ODIN, a.in[I_ODWIN], D, OD_IN, (bf16*)(ws + WS_W_ODIN), D, 0, 0, a.in[I_NMIX] + D)
        TR_MAT(C_ODOUT, a.in[I_ODWOUT], 2048, D, (bf16*)(ws + WS_W_ODOUT), 2048, 0, 0, nullptr)
        TR_MAT(C_XQ, a.in[I_XWQ] + (size_t)D * 512, D, 512, (bf16*)(ws + WS_W_XQ) + (size_t)512 * D, D, 0, 0, a.in[I_NCROSS] + D)
        TR_MAT(C_XO, a.in[I_XWO] + (size_t)512 * D, 512, D, (bf16*)(ws + WS_W_XO) + (size_t)D * 512, 512, 0, 0, nullptr)
        { constexpr int C_M13 = 16 * 112, C_M2 = 56 * 16;
          if (r < NEXP * C_M13) { const int e = r / C_M13, q = r % C_M13; transpose_item_f8<1>(a.in[I_MW13] + (size_t)e * D * 2 * FFE, 2 * FFE, ws + WS_W_M13 + (size_t)e * 2 * FFE * D, D, scr, q / 112, q % 112, F.lane, FFE, MOE_W13_SCALE); continue; } r -= NEXP * C_M13;
          { const int e = r / C_M2, q = r % C_M2; transpose_item_f8<0>(a.in[I_MW2] + (size_t)e * FFE * D, D, ws + WS_W_M2 + (size_t)e * D * FFE, FFE, scr, q / 16, q % 16, F.lane, 0, MOE_W2_SCALE); } }
    }
}
__device__ __forceinline__ void p0_prologue(const Frame& F, const Args& a) {
    const int gw = F.bid * NWAVES + F.wave, NGW = F.G * NWAVES;
    unsigned char* ws = F.ws;
    convert_range(F, a, gw, NGW, 0, CONV_A);
    for (int i = F.bid * NTHR + F.tid; i < 2 * 224 * 128; i += F.G * NTHR) { const int w = i / (224 * 128), q = i % (224 * 128);
        bf16* base = w == 0 ? (bf16*)(ws + WS_W_EVIN) + (size_t)4640 * D : (bf16*)(ws + WS_W_ODIN) + (size_t)5152 * D; *(GAS v4u*)(base + (size_t)q * 8) = (v4u){0u, 0u, 0u, 0u}; }
    phase_rmsnorm(F, a.in[I_X], a.in[I_NMIX], (bf16*)(ws + WS_XN), M);
    phase_rmsnorm(F, a.in[I_MEM], a.in[I_NMEM], (bf16*)(ws + WS_MEMN), MMEM);
    phase_rmsnorm(F, a.in[I_MEM], a.in[I_NMEM] + D, (bf16*)(ws + WS_MEMN) + (size_t)MMEM * D, MMEM);
    for (int i = F.bid * NTHR + F.tid; i < 512 * 128; i += F.G * NTHR) { const int n = i >> 7, j = i & 127; ((bf16*)(ws + WS_OV))[i] = (n <= 510 && n >= 4 * j - 1 && n <= 4 * j + 3) ? (bf16)0x3F80 : (bf16)0; }
    for (int it = gw; it < 128; it += NGW) { const int mm = it >> 6, ic = it & 63; const float* w1 = a.in[mm ? I_CVW1 : I_CKW1]; const float* pos = a.in[I_CMPPOS];
        f32x4 acc = {0.f, 0.f, 0.f, 0.f};
        for (int rr = 0; rr < 64; ++rr) { const int i = ic * 64 + rr; const float p = pos[i]; const f32x4 w = *(const GAS f32x4*)(w1 + (size_t)i * 256 + 4 * F.lane); acc += w * p; }
        *(GAS f32x4*)((float*)(ws + WS_CMPB_PART) + (size_t)(mm * 64 + ic) * 256 + 4 * F.lane) = acc; }
}
#undef TR_MAT
namespace att {
constexpr float SCALE = 0.08838834764831845f;
constexpr float THR = 8.f;
constexpr int KVBLK = 64, DH = 128;
constexpr int SHM_V = KVBLK * DH * 2, SHM_K = KVBLK * DH * 2;
constexpr int NSLOT = 3;
constexpr int LDS_ATT = NSLOT * SHM_V + NSLOT * SHM_K + NWAVES * 64 * 4;
#define KSWZ(row, colB) ((row) * 256 + ((colB) ^ (((row) & 7) << 4)))
__device__ __forceinline__ int v_st(int k, int c) { const int kk = (k & ~0xC) | ((k & 4) << 1) | ((k & 8) >> 1); return ((kk >> 3) * 4 + (c >> 5)) * 512 + ((kk & 7) * 32 + (c & 31)) * 2; }
__device__ __forceinline__ int v_rd_base(int lane) { return ((lane & 3) << 3) | (((lane >> 2) & 3) << 6) | (((lane >> 4) & 1) << 5) | (((lane >> 5) & 1) << 8); }
constexpr int v_rd_off(int d0, int ks, int half) { return d0 * 512 + ks * 4096 + half * 2048; }
__device__ __forceinline__ int crow(int r, int hi) { return (r & 3) + 8 * (r >> 2) + 4 * hi; }
__device__ __forceinline__ bf16x8 pack8(f32x4 a, f32x4 b) { v4u w = {cvtpk(a[0], a[1]), cvtpk(a[2], a[3]), cvtpk(b[0], b[1]), cvtpk(b[2], b[3])}; return *reinterpret_cast<bf16x8*>(&w); }

__device__ __forceinline__ void mask_tile(f32x16& p0, f32x16& p1, int dq, unsigned W) {
    asm volatile("" : "+v"(dq));
    const float NEG = -__builtin_inff();
#pragma unroll
    for (int r = 0; r < 16; ++r) { const int c = (r & 3) + 8 * (r >> 2);
        if ((unsigned)(dq - c) >= W) p0[r] = NEG;
        if ((unsigned)(dq - c - 32) >= W) p1[r] = NEG; }
}
__device__ __forceinline__ void mask_all(f32x16& p0, f32x16& p1) { const float NEG = -__builtin_inff();
#pragma unroll
    for (int r = 0; r < 16; ++r) { p0[r] = NEG; p1[r] = NEG; } }
__device__ __forceinline__ void partialSM(f32x16& p0, f32x16& p1, float& m_reg, float& mn, float& alpha, bool keep = true) {
    float pmax = p0[0];
#pragma unroll
    for (int r = 1; r < 16; ++r) pmax = fmaxf(pmax, p0[r]);
#pragma unroll
    for (int r = 0; r < 16; ++r) pmax = fmaxf(pmax, p1[r]);
    pmax = keep ? pmax : -__builtin_inff();
    { auto rr = __builtin_amdgcn_permlane32_swap(__float_as_uint(pmax), __float_as_uint(pmax), false, false);
      pmax = fmaxf(__uint_as_float(rr[0]), __uint_as_float(rr[1])); }
    constexpr float C2 = 1.4426950408889634f * SCALE;
    if (__builtin_expect(__all((pmax - m_reg) * SCALE <= THR), 1)) { mn = m_reg; alpha = 1.f; }
    else { mn = fmaxf(m_reg, pmax); alpha = __builtin_amdgcn_exp2f((m_reg - mn) * C2); m_reg = mn; }
    const float mnL = keep ? -mn * C2 : -__builtin_inff();
#pragma unroll
    for (int r = 0; r < 16; ++r) p0[r] = fmaf(p0[r], C2, mnL);
#pragma unroll
    for (int r = 0; r < 16; ++r) p1[r] = fmaf(p1[r], C2, mnL);
#pragma unroll
    for (int r = 0; r < 16; ++r) p0[r] = __builtin_amdgcn_exp2f(p0[r]);
}
__device__ __forceinline__ void finishSM(f32x16& p0, f32x16& p1, float alpha, float& l_reg, bf16x8& pa0, bf16x8& pa1, bf16x8& pa2, bf16x8& pa3) {
#pragma unroll
    for (int r = 0; r < 16; ++r) p1[r] = __builtin_amdgcn_exp2f(p1[r]);
    float ps = 0;
#pragma unroll
    for (int r = 0; r < 16; ++r) ps += p0[r];
#pragma unroll
    for (int r = 0; r < 16; ++r) ps += p1[r];
    { auto rr = __builtin_amdgcn_permlane32_swap(__float_as_uint(ps), __float_as_uint(ps), false, false);
      ps = __uint_as_float(rr[0]) + __uint_as_float(rr[1]); }
    l_reg = l_reg * alpha + ps;
#define PK4(P, B_, OUT) do { unsigned a0 = cvtpk(P[B_+0], P[B_+1]), a1 = cvtpk(P[B_+2], P[B_+3]);                          \
        unsigned b0 = cvtpk(P[B_+4], P[B_+5]), b1 = cvtpk(P[B_+6], P[B_+7]);                                             \
        auto r0 = __builtin_amdgcn_permlane32_swap(a0, b0, false, false); auto r1 = __builtin_amdgcn_permlane32_swap(a1, b1, false, false); \
        v4u w = {r0[0], r1[0], r0[1], r1[1]}; OUT = *reinterpret_cast<bf16x8*>(&w); } while (0)
    PK4(p0, 0, pa0); PK4(p0, 8, pa1); PK4(p1, 0, pa2); PK4(p1, 8, pa3);
#undef PK4
}
__device__ __forceinline__ void qkt(f32x16& p0, f32x16& p1, const char* Kslot, int r32, int hi, const bf16x8* qr) {
    p0 = f32x16{}; p1 = f32x16{};
    const char* kb[4];
#pragma unroll
    for (int dd = 0; dd < 4; ++dd) kb[dd] = Kslot + KSWZ(r32, (dd * 16 + hi * 8) * 2);
    bf16x8 fa[4], fb[4];
#define KLD(dst, i, d0) do { const char* a_ = kb[(d0) & 3] + ((d0) >> 2) * 128; dst[i] = *reinterpret_cast<const bf16x8*>(a_); dst[i + 1] = *reinterpret_cast<const bf16x8*>(a_ + 32 * 256); } while (0)
#define KMM(src, i, d0) do { p0 = __builtin_amdgcn_mfma_f32_32x32x16_bf16(src[i], qr[d0], p0, 0, 0, 0); p1 = __builtin_amdgcn_mfma_f32_32x32x16_bf16(src[i + 1], qr[d0], p1, 0, 0, 0); } while (0)
    KLD(fa, 0, 0); KLD(fa, 2, 1); KLD(fb, 0, 2); KLD(fb, 2, 3); SBAR();
    KMM(fa, 0, 0); KMM(fa, 2, 1); SBAR(); KLD(fa, 0, 4); KLD(fa, 2, 5); SBAR();
    KMM(fb, 0, 2); KMM(fb, 2, 3); SBAR(); KLD(fb, 0, 6); KLD(fb, 2, 7); SBAR();
    KMM(fa, 0, 4); KMM(fa, 2, 5); SBAR();
    KMM(fb, 0, 6); KMM(fb, 2, 7);
#undef KLD
#undef KMM
}
__device__ __forceinline__ void pv_tile(f32x16* o, int vbs, bf16x8 pa0, bf16x8 pa1, bf16x8 pa2, bf16x8 pa3) {
#define TRRD(dst, off) asm volatile("ds_read_b64_tr_b16 %0, %1 offset:%2" : "=&v"(dst) : "v"(vbs), "i"(off) : "memory")
#define PV_D0(d0) do { s16x4 l0, l1, l2, l3, h0, h1, h2, h3; constexpr int b_ = v_rd_off(d0, 0, 0); \
        TRRD(l0, b_); TRRD(h0, b_ + 2048); TRRD(l1, b_ + 4096); TRRD(h1, b_ + 6144); TRRD(l2, b_ + 8192); TRRD(h2, b_ + 10240); TRRD(l3, b_ + 12288); TRRD(h3, b_ + 14336); \
        asm volatile("s_waitcnt lgkmcnt(0)" ::: "memory"); SBAR();   \
        o[d0] = __builtin_amdgcn_mfma_f32_32x32x16_bf16(pa0, (bf16x8){l0[0], l0[1], l0[2], l0[3], h0[0], h0[1], h0[2], h0[3]}, o[d0], 0, 0, 0);   \
        o[d0] = __builtin_amdgcn_mfma_f32_32x32x16_bf16(pa1, (bf16x8){l1[0], l1[1], l1[2], l1[3], h1[0], h1[1], h1[2], h1[3]}, o[d0], 0, 0, 0);   \
        o[d0] = __builtin_amdgcn_mfma_f32_32x32x16_bf16(pa2, (bf16x8){l2[0], l2[1], l2[2], l2[3], h2[0], h2[1], h2[2], h2[3]}, o[d0], 0, 0, 0);   \
        o[d0] = __builtin_amdgcn_mfma_f32_32x32x16_bf16(pa3, (bf16x8){l3[0], l3[1], l3[2], l3[3], h3[0], h3[1], h3[2], h3[3]}, o[d0], 0, 0, 0); } while (0)
    PV_D0(0); PV_D0(1); PV_D0(2); PV_D0(3);
#undef PV_D0
#undef TRRD
}
__device__ __forceinline__ void q_issue(const bf16* qrow, int hi, v4u (&raw)[8]) {
#pragma unroll
    for (int d0 = 0; d0 < 8; ++d0) raw[d0] = *(const GAS v4u*)(qrow + d0 * 16 + hi * 8);
}
__device__ __forceinline__ void q_finish(const v4u (&raw)[8], const float* g, int hi, bf16x8* qr) {
    float ss = 0.f;
#pragma unroll
    for (int d0 = 0; d0 < 8; ++d0)
#pragma unroll
        for (int j = 0; j < 4; ++j) { const float a = bflo(raw[d0][j]), b = bfhi(raw[d0][j]); ss += a * a + b * b; }
    ss += __shfl_xor(ss, 32);
    const float rstd = 1.f / sqrtf(ss * (1.f / 128.f) + EPS);
#pragma unroll
    for (int d0 = 0; d0 < 8; ++d0) { const f32x4 g0 = *(const GAS f32x4*)(g + d0 * 16 + hi * 8), g1 = *(const GAS f32x4*)(g + d0 * 16 + hi * 8 + 4);
        v4u w; w.x = cvtpk(bflo(raw[d0][0]) * rstd * g0[0], bfhi(raw[d0][0]) * rstd * g0[1]); w.y = cvtpk(bflo(raw[d0][1]) * rstd * g0[2], bfhi(raw[d0][1]) * rstd * g0[3]);
        w.z = cvtpk(bflo(raw[d0][2]) * rstd * g1[0], bfhi(raw[d0][2]) * rstd * g1[1]); w.w = cvtpk(bflo(raw[d0][3]) * rstd * g1[2], bfhi(raw[d0][3]) * rstd * g1[3]);
        qr[d0] = *reinterpret_cast<bf16x8*>(&w); }
}
__device__ __forceinline__ void load_q(const bf16* qrow, const float* g, int hi, bf16x8* qr) { v4u raw[8]; q_issue(qrow, hi, raw); q_finish(raw, g, hi, qr); }
struct PassIO { const bf16* Kp; int ldk; const bf16* Vp; int ldv; int t_lo, t_hi; };
__device__ __forceinline__ void dma_offsets(int wid, int lane, int ldk, int ldv, unsigned& koff, unsigned& voff) {
    const int row = 4 * wid + (lane >> 4); koff = (unsigned)(row * ldk * 2 + (((lane & 15) ^ (row & 7)) << 4));
    const int st = 2 * wid + (lane >> 5), kk = ((st >> 2) << 3) | ((lane & 31) >> 2), k = (kk & ~0xC) | ((kk & 4) << 1) | ((kk & 8) >> 1); voff = (unsigned)(k * ldv * 2 + ((st & 3) * 32 + 8 * (lane & 3)) * 2);
}
#define ATT_DMA(io_, t, slot) do { const char* kt_ = (const char*)(io_).Kp + (size_t)(t) * (KVBLK * 2) * (io_).ldk; const char* vt_ = (const char*)(io_).Vp + (size_t)(t) * (KVBLK * 2) * (io_).ldv;          \
        LAS unsigned* kd_ = (LAS unsigned*)(ldsl + NSLOT * SHM_V + (slot) * SHM_K + wid * 1024); LAS unsigned* vd_ = (LAS unsigned*)(ldsl + (slot) * SHM_V + wid * 1024);                \
        __builtin_amdgcn_global_load_lds((const unsigned*)(kt_ + koff), kd_, 16, 0, 0); __builtin_amdgcn_global_load_lds((const unsigned*)(kt_ + koff + (size_t)64 * (io_).ldk), kd_ + 2048, 16, 0, 0); \
        __builtin_amdgcn_global_load_lds((const unsigned*)(vt_ + voff), vd_, 16, 0, 0); __builtin_amdgcn_global_load_lds((const unsigned*)(vt_ + voff + (size_t)64 * (io_).ldv), vd_ + 2048, 16, 0, 0); } while (0)
__device__ __forceinline__ void attn_prefetch(char* lds, const PassIO& io) {
    int tid = threadIdx.x; asm volatile("" : "+v"(tid));
    const int wid = __builtin_amdgcn_readfirstlane(tid >> 6), lane = tid & 63;
    unsigned koff, voff; dma_offsets(wid, lane, io.ldk, io.ldv, koff, voff);
    LAS unsigned char* ldsl = (LAS unsigned char*)lds;
    ATT_DMA(io, io.t_lo, 0); if (io.t_hi - io.t_lo > 1) ATT_DMA(io, io.t_lo + 1, 1);
}
template <class MaskF>
__device__ __forceinline__ void attn_pass(char* lds, const bf16x8* qr, const PassIO& io, const MaskF& mf, f32x16 (&o)[4], float& l_out) {
    int tid = threadIdx.x; asm volatile("" : "+v"(tid));
    const int wid = __builtin_amdgcn_readfirstlane(tid >> 6), lane = tid & 63, r32 = lane & 31, hi = lane >> 5;
    char* V_lds = lds; char* K_lds = lds + NSLOT * SHM_V;
    float* wsc = (float*)(lds + NSLOT * SHM_V + NSLOT * SHM_K) + wid * 64; float* al_l = wsc + 32;
    float m_reg = -1e30f, l_reg = 0.f;
#pragma unroll
    for (int d = 0; d < 4; ++d) o[d] = f32x16{};
    const int vb0 = (int)(uintptr_t)V_lds + v_rd_base(lane);
    const int t_lo = io.t_lo, NT = io.t_hi - io.t_lo;
    unsigned koff, voff; dma_offsets(wid, lane, io.ldk, io.ldv, koff, voff);
    LAS unsigned char* ldsl = (LAS unsigned char*)lds;
    f32x16 p0, p1; float mn, alpha = 1.f; bf16x8 pa0, pa1, pa2, pa3;
#define A_RESC(a) do { if (__any((a) < 1.f)) { if (hi == 0) al_l[r32] = (a); asm volatile("s_waitcnt lgkmcnt(0)" ::: "memory"); \
        _Pragma("unroll") for (int d_ = 0; d_ < 4; ++d_) _Pragma("unroll") for (int r = 0; r < 16; ++r) o[d_][r] *= al_l[crow(r, hi)]; } } while (0)
#define A_BAR() do { asm volatile("" ::: "memory"); __builtin_amdgcn_s_barrier(); asm volatile("" ::: "memory"); } while (0)
    const bool lead = wid < 4;
    VM_WAIT();
    __syncthreads();
    if (!lead) A_BAR();
    int sK = 0, sV = 2, sW = 1;
    bool act_prev = false;
    for (int i = 0; i < NT; ++i) {
        if (lead && i >= 1 && i + 1 < NT) ATT_DMA(io, t_lo + i + 1, sW);
        const bool act = mf.active(t_lo + i);
        SBAR(); if (act) qkt(p0, p1, K_lds + sK * SHM_K, r32, hi, qr);
        if (i > 0 && act_prev) pv_tile(o, vb0 + sV * SHM_V, pa0, pa1, pa2, pa3);
        if (!lead && i + 1 < NT) VM_WAIT();
        A_BAR();
        if (!lead && i + 2 < NT) ATT_DMA(io, t_lo + i + 2, sV);
        if (act) { mf(p0, p1, t_lo + i); partialSM(p0, p1, m_reg, mn, alpha, mf.keep(t_lo + i)); A_RESC(alpha); finishSM(p0, p1, alpha, l_reg, pa0, pa1, pa2, pa3); }
        act_prev = act;
        if (lead && i + 1 < NT) VM_WAIT();
        A_BAR();
        { const int t_ = sV; sV = sK; sK = sW; sW = t_; }
    }
    if (act_prev) pv_tile(o, vb0 + sV * SHM_V, pa0, pa1, pa2, pa3);
    if (lead) A_BAR();
    __syncthreads();
#undef A_RESC
#undef A_BAR
    l_out = l_reg;
}
__device__ __forceinline__ void row_inv_l(char* lds, float l_reg, float (&rli)[16]) {
    const int tid = threadIdx.x, wid = __builtin_amdgcn_readfirstlane(tid >> 6), lane = tid & 63, r32 = lane & 31, hi = lane >> 5;
    float* wsc = (float*)(lds + NSLOT * SHM_V + NSLOT * SHM_K) + wid * 64;
    if (hi == 0) wsc[r32] = l_reg;
    asm volatile("s_waitcnt lgkmcnt(0)" ::: "memory");
#pragma unroll
    for (int r = 0; r < 16; ++r) { const float l = wsc[crow(r, hi)]; rli[r] = l > 0.f ? __builtin_amdgcn_rcpf(l) : 0.f; }
    asm volatile("s_waitcnt lgkmcnt(0)" ::: "memory");
}
struct NoMask { __device__ __forceinline__ void operator()(f32x16&, f32x16&, int) const {} __device__ __forceinline__ bool active(int) const { return true; } __device__ __forceinline__ bool keep(int) const { return true; } };
}
__device__ __forceinline__ void norm128_rows(const Frame& F, const bf16* src, size_t lds_, bf16* dst, size_t ldd, int nrows, const float* g, int gw, int NGW) {
    const int sub = F.lane >> 4, l16 = F.lane & 15;
    const f32x4 g0 = *(const GAS f32x4*)(g + l16 * 8), g1 = *(const GAS f32x4*)(g + l16 * 8 + 4);
    for (int r0 = gw * 4; r0 < nrows; r0 += NGW * 4) { const int r = r0 + sub;
        const v4u raw = *(const GAS v4u*)(src + (size_t)r * lds_ + l16 * 8);
        float ss = 0.f;
#pragma unroll
        for (int j = 0; j < 4; ++j) { const float a = bflo(raw[j]), b = bfhi(raw[j]); ss += a * a + b * b; }
        ss += __shfl_xor(ss, 1); ss += __shfl_xor(ss, 2); ss += __shfl_xor(ss, 4); ss += __shfl_xor(ss, 8);
        const float rstd = 1.f / sqrtf(ss * (1.f / 128.f) + EPS);
        v4u w; w.x = cvtpk(bflo(raw[0]) * rstd * g0[0], bfhi(raw[0]) * rstd * g0[1]); w.y = cvtpk(bflo(raw[1]) * rstd * g0[2], bfhi(raw[1]) * rstd * g0[3]);
        w.z = cvtpk(bflo(raw[2]) * rstd * g1[0], bfhi(raw[2]) * rstd * g1[1]); w.w = cvtpk(bflo(raw[3]) * rstd * g1[2], bfhi(raw[3]) * rstd * g1[3]);
        *(GAS v4u*)(dst + (size_t)r * ldd + l16 * 8) = w; }
}
__device__ __forceinline__ void phase_memk_norm(const Frame& F, const Args& a, int l, int gw, int NGW) {
    const bf16* kvm = (const bf16*)(F.ws + WS_KVM) + (size_t)l * MMEM * 1024; bf16* km = (bf16*)(F.ws + WS_KM) + (size_t)l * MMEM * 512;
    for (int bh = 0; bh < BATCH * XH; ++bh) { const int b = bh >> 2, h = bh & 3;
        norm128_rows(F, kvm + (size_t)b * MEMLEN * 1024 + h * 128, 1024, km + (size_t)bh * MEMLEN * 128, 128, MEMLEN, a.in[I_XKN] + l * 128, gw, NGW); }
}

__device__ __forceinline__ void phase_cross_attn(const Frame& F, const Args& a, int l) {
    char* lds = (char*)F.lds; const int r32 = F.lane & 31, hi = F.lane >> 5;
    const bf16* QX = (const bf16*)(F.ws + WS_QX); bf16* OX = (bf16*)(F.ws + WS_OX);
    for (int u = F.bid; u < BATCH * XH * (SEQ / 256); u += F.G) {
        const int tb = u % (SEQ / 256), bh = u / (SEQ / 256), b = bh >> 2, h = bh & 3;
        const size_t row0 = (size_t)b * SEQ + tb * 256 + F.wave * 32;
        const bf16* Kp = (const bf16*)(F.ws + WS_KM) + (size_t)l * MMEM * 512 + (size_t)bh * MEMLEN * 128;
        const bf16* Vp = (const bf16*)(F.ws + WS_KVM) + (size_t)l * MMEM * 1024 + (size_t)b * MEMLEN * 1024 + 512 + h * 128;
        const att::PassIO io{Kp, 128, Vp, 1024, 0, MEMLEN / 64}; att::attn_prefetch(lds, io);
        bf16x8 qr[8]; att::load_q(QX + (row0 + r32) * 512 + h * 128, a.in[I_XQN] + l * 128, hi, qr);
        f32x16 o[4]; float l_reg; att::attn_pass(lds, qr, io, att::NoMask{}, o, l_reg);
        float rli[16]; att::row_inv_l(lds, l_reg, rli);
#pragma unroll
        for (int r = 0; r < 16; ++r) { bf16* orow = OX + (row0 + att::crow(r, hi)) * 512 + h * 128;
#pragma unroll
            for (int d0 = 0; d0 < 4; ++d0) { const float v = o[d0][r] * rli[r]; const float vn = __shfl_xor(v, 1);
                if ((r32 & 1) == 0) *(GAS unsigned*)(orow + d0 * 32 + r32) = cvtpk(v, vn); } }
    }
}

constexpr int NSA_GSC = att::LDS_ATT, NSA_IMP = NSA_GSC + NWAVES * 32 * 3 * 4, NSA_SEL = NSA_IMP + NWAVES * 8 * 128 * 4, NSA_SELU = NSA_SEL + 64 * 4 * 4, NSA_LDS_END = NSA_SELU + NWAVES * 4 * 4;
static_assert(NSA_LDS_END <= SCR_BYTES, "nsa lds");
struct CmpMask { int nmax, hi, nmin_wave;
    __device__ __forceinline__ void operator()(f32x16& p0, f32x16& p1, int t) const { if (t * 64 + 63 <= nmin_wave) return; att::mask_tile(p0, p1, nmax - t * 64 - 4 * hi, 0x40000000u); }
    __device__ __forceinline__ bool active(int) const { return true; } __device__ __forceinline__ bool keep(int) const { return true; } };
struct WinMask { int P, hi, qb;
    __device__ __forceinline__ void operator()(f32x16& p0, f32x16& p1, int t) const { if (t == qb || t == qb - 8) att::mask_tile(p0, p1, P - t * 64 - 4 * hi, 512u); }
    __device__ __forceinline__ bool active(int) const { return true; } __device__ __forceinline__ bool keep(int) const { return true; } };
struct SlcMask { const LAS unsigned* selw; const LAS unsigned* uni; int P, hi, qb;
    __device__ __forceinline__ void operator()(f32x16& p0, f32x16& p1, int t) const { if (t == qb) att::mask_tile(p0, p1, P - t * 64 - 4 * hi, 0x40000000u); }
    __device__ __forceinline__ bool keep(int t) const { return (selw[t >> 5] >> (t & 31)) & 1u; }
    __device__ __forceinline__ bool active(int t) const { return (__builtin_amdgcn_readfirstlane(uni[t >> 5]) >> (t & 31)) & 1u; } };

__device__ __forceinline__ void nsa_unit(const Frame& F, const Args& a, int b, int g, int qb, int dry = 0) {
    char* lds = (char*)F.lds; const int w = F.wave; const int t0 = qb * 64;
#define NSA_LANE() int lane = F.lane; asm volatile("" : "+v"(lane)); const int r32 = lane & 31, hi = lane >> 5; const int tok = 8 * w + (r32 >> 2), head = 4 * g + (r32 & 3), P = t0 + tok; (void)head; (void)P; (void)tok
    unsigned char* wsl = F.ws; asm volatile("" : "+s"(wsl));
    const bf16* Y0 = (const bf16*)(wsl + WS_Y0); const bf16* KV6 = (const bf16*)(wsl + WS_KV6);
    const size_t slab = (size_t)SEQ * 128, bg = (size_t)(b * 2 + g);
    LAS float* gsc = (LAS float*)(F.lds + NSA_GSC) + w * 96; LAS float* imp = (LAS float*)(F.lds + NSA_IMP) + w * 1024; LAS unsigned* selm = (LAS unsigned*)(F.lds + NSA_SEL);
    { NSA_LANE();
      if (hi == 0) {
#pragma unroll
        for (int br = 0; br < 3; ++br) gsc[r32 * 3 + br] = fsigmoid(bf2f(Y0[((size_t)b * SEQ + P) * EV_INP + 4608 + head * 3 + br]) + a.in[I_GATEB][head * 3 + br]); }
      LDS_WAIT(); }
    f32x16 o[4]; float l_reg; float rli[16];
    const bf16* KCMP = (const bf16*)(wsl + WS_KVCMP) + bg * 512 * 128; const bf16* VCMP = (const bf16*)(wsl + WS_KVCMP) + (size_t)2048 * 128 + bg * 512 * 128;
    const int ncmp_t = ((4 * qb + 2) >> 6) + 1;
    const att::PassIO io_imp{KCMP, 128, (const bf16*)(wsl + WS_OV), 128, 0, ncmp_t}, io_cmp{KCMP, 128, VCMP, 128, 0, ncmp_t},
                      io_slc{KV6 + (2 * 4 + bg) * slab, 128, KV6 + (3 * 4 + bg) * slab, 128, 0, qb + 1}, io_win{KV6 + (4 * 4 + bg) * slab, 128, KV6 + (5 * 4 + bg) * slab, 128, qb >= 8 ? qb - 8 : 0, qb + 1};
    v4u qraw[8];
#define NSA_QISSUE() do { NSA_LANE(); att::q_issue(Y0 + ((size_t)b * SEQ + P) * EV_INP + 2048 + head * 128, hi, qraw); } while (0)
    att::attn_prefetch(lds, io_imp); NSA_QISSUE();
    { NSA_LANE(); const CmpMask cm{(P - 31) >> 4, hi, (t0 + 8 * w - 31) >> 4};
      bf16x8 qr[8]; att::q_finish(qraw, a.in[I_QNORM], hi, qr);
      if (dry < 2) att::attn_pass(lds, qr, io_imp, cm, o, l_reg); else { VM_WAIT(); __syncthreads(); l_reg = 1.f; } }
    att::attn_prefetch(lds, io_cmp); NSA_QISSUE();
    if (dry < 3) {
    att::row_inv_l(lds, l_reg, rli);
    { NSA_LANE();
#pragma unroll
    for (int q = 0; q < 4; ++q)
#pragma unroll
        for (int d = 0; d < 4; ++d) { float s = 0.f;
#pragma unroll
            for (int i = 0; i < 4; ++i) s += o[d][4 * q + i] * rli[4 * q + i];
            imp[(2 * q + hi) * 128 + d * 32 + r32] = s; }
    LDS_WAIT();
    { const unsigned long long lt = (1ull << lane) - 1ull;
#pragma unroll 1
    for (int tg = 0; tg < 8; tg += 4) { unsigned k0[4], k1[4], T[4];
#pragma unroll
        for (int u = 0; u < 4; ++u) { const int tl = tg + u; const int j0 = lane, j1 = lane + 64; const float v0 = imp[tl * 128 + j0], v1 = imp[tl * 128 + j1];
          const float s0 = v0 + (((j0 == 0) || (j0 == qb) || (j0 == qb - 1)) ? 100.f : 0.f), s1 = v1 + (((j1 == 0) || (j1 == qb) || (j1 == qb - 1)) ? 100.f : 0.f);
          k0[u] = (j0 <= qb) ? __float_as_uint(s0) + 1u : 0u; k1[u] = (j1 <= qb) ? __float_as_uint(s1) + 1u : 0u; T[u] = 0u; }
#pragma unroll 1
        for (int bit = 30; bit >= 0; --bit) {
#pragma unroll
            for (int u = 0; u < 4; ++u) { const unsigned cand = T[u] | (1u << bit);
                const int cnt = __popcll(__ballot(k0[u] >= cand)) + __popcll(__ballot(k1[u] >= cand)); if (cnt >= 16) T[u] = cand; } }
#pragma unroll
        for (int u = 0; u < 4; ++u) { const int tl = tg + u;
        const unsigned long long g0 = __ballot(k0[u] > T[u]), g1 = __ballot(k1[u] > T[u]), e0 = __ballot(k0[u] == T[u]), e1 = __ballot(k1[u] == T[u]);
        const int need = 16 - (__popcll(g0) + __popcll(g1));
        const bool sel0 = (k0[u] > T[u]) || (k0[u] == T[u] && __popcll(e0 & lt) < need), sel1 = (k1[u] > T[u]) || (k1[u] == T[u] && __popcll(e0) + __popcll(e1 & lt) < need);
        const unsigned long long m0 = __ballot(sel0 && lane <= qb), m1 = __ballot(sel1 && lane + 64 <= qb);
        if (lane == 0) { LAS unsigned* sw = selm + (8 * w + tl) * 4; sw[0] = (unsigned)m0; sw[1] = (unsigned)(m0 >> 32); sw[2] = (unsigned)m1; sw[3] = (unsigned)(m1 >> 32); } } } }
    LDS_WAIT();
    if (lane < 4) { unsigned u = 0;
#pragma unroll
        for (int tl = 0; tl < 8; ++tl) u |= selm[(8 * w + tl) * 4 + lane];
        ((LAS unsigned*)(F.lds + NSA_SELU))[w * 4 + lane] = u; }
    LDS_WAIT(); }
    }
    { NSA_LANE(); const CmpMask cm{(P - 31) >> 4, hi, (t0 + 8 * w - 31) >> 4};
      bf16x8 qr[8]; att::q_finish(qraw, a.in[I_QNORM], hi, qr);
#if defined(MK_NSA_DUP) && MK_NSA_DUP == 2
      att::attn_pass(lds, qr, io_cmp, cm, o, l_reg); att::attn_prefetch(lds, io_cmp);
#endif
      if (dry < 2) att::attn_pass(lds, qr, io_cmp, cm, o, l_reg); else { VM_WAIT(); __syncthreads(); l_reg = 1.f; } }
    att::attn_prefetch(lds, io_slc); NSA_QISSUE();
    att::row_inv_l(lds, l_reg, rli);
    unsigned oacc[4][8];
    if (dry < 4) { NSA_LANE();
#pragma unroll
    for (int r = 0; r < 16; ++r) rli[r] *= gsc[att::crow(r, hi) * 3 + 0];
#pragma unroll
    for (int d = 0; d < 4; ++d)
#pragma unroll
        for (int r = 0; r < 16; r += 2) oacc[d][r >> 1] = cvtpk(o[d][r] * rli[r], o[d][r + 1] * rli[r + 1]); }
    { NSA_LANE(); const SlcMask sm{selm + tok * 4, (const LAS unsigned*)(F.lds + NSA_SELU) + w * 4, P, hi, qb};
      bf16x8 qr[8]; att::q_finish(qraw, a.in[I_QNORM], hi, qr);
#if defined(MK_NSA_DUP) && MK_NSA_DUP == 5
      { const size_t bg2 = (bg + 1) & 3; const att::PassIO io_cold{KV6 + (2 * 4 + bg2) * slab, 128, KV6 + (3 * 4 + bg2) * slab, 128, 0, qb + 1};
        att::attn_pass(lds, qr, io_cold, sm, o, l_reg); att::attn_prefetch(lds, io_slc); }
#endif
#if defined(MK_NSA_DUP) && MK_NSA_DUP == 3
      att::attn_pass(lds, qr, io_slc, sm, o, l_reg); att::attn_prefetch(lds, io_slc);
#endif
      if (!dry) att::attn_pass(lds, qr, io_slc, sm, o, l_reg); else { VM_WAIT(); __syncthreads(); } }
    att::attn_prefetch(lds, io_win); NSA_QISSUE();
    att::row_inv_l(lds, l_reg, rli);
    if (dry < 4) { NSA_LANE();
#pragma unroll
    for (int r = 0; r < 16; ++r) rli[r] *= gsc[att::crow(r, hi) * 3 + 1];
#pragma unroll
    for (int d = 0; d < 4; ++d)
#pragma unroll
        for (int r = 0; r < 16; r += 2) oacc[d][r >> 1] = cvtpk(bflo(oacc[d][r >> 1]) + o[d][r] * rli[r], bfhi(oacc[d][r >> 1]) + o[d][r + 1] * rli[r + 1]); }
    { NSA_LANE(); const WinMask wm{P, hi, qb};
      bf16x8 qr[8]; att::q_finish(qraw, a.in[I_QNORM], hi, qr);
#if defined(MK_NSA_DUP) && MK_NSA_DUP == 4
      att::attn_pass(lds, qr, io_win, wm, o, l_reg); att::attn_prefetch(lds, io_win);
#endif
      if (dry < 2) att::attn_pass(lds, qr, io_win, wm, o, l_reg); else { VM_WAIT(); __syncthreads(); l_reg = 1.f; } }
    att::row_inv_l(lds, l_reg, rli);
    if (dry < 4) { NSA_LANE();
    bf16* MIX = dry ? (bf16*)(wsl + WS_R + 400 * MiB) : (bf16*)(wsl + WS_MIX);
#pragma unroll
    for (int r = 0; r < 16; ++r) rli[r] *= gsc[att::crow(r, hi) * 3 + 2];
    bf16* obase = MIX + ((size_t)b * SEQ + t0 + 8 * w) * 2048 + 1024 + 4 * g * 128 + r32;
#pragma unroll
    for (int d0 = 0; d0 < 4; ++d0) {
#pragma unroll
        for (int r = 0; r < 16; ++r) { const int row = att::crow(r, hi); const float v = ((r & 1) ? bfhi(oacc[d0][r >> 1]) : bflo(oacc[d0][r >> 1])) + o[d0][r] * rli[r]; const float vn = __shfl_xor(v, 1);
            if ((r32 & 1) == 0) *(GAS unsigned*)(obase + (size_t)(row >> 2) * 2048 + (row & 3) * 128 + d0 * 32) = cvtpk(v, vn); }
        } }
    __syncthreads();
#undef NSA_QISSUE
#undef NSA_LANE
}
__device__ __forceinline__ void phase_nsa(const Frame& F, const Args& a) {
#pragma unroll 1
    for (int it = F.bid * 2; it < 512; it += F.G * 2)
#pragma unroll 1
        for (int k = 0; k < 2; ++k) { const int p = it >> 1, xcd = p & 7, bg = xcd >> 1, x = (xcd & 1) * 32 + (p >> 3);
#if defined(MK_NSA_DRY)
            nsa_unit(F, a, bg >> 1, bg & 1, k == 0 ? 127 - x : x, MK_NSA_DRY);
#endif
            nsa_unit(F, a, bg >> 1, bg & 1, k == 0 ? 127 - x : x); }
}
__device__ __forceinline__ f32x4 mma16(const LAS bf16* A, int pa, const LAS bf16* B, int pb, int K, f32x4 acc, int fr, int fq) {
    for (int k0 = 0; k0 < K; k0 += 32) { const bf16x8 af = *(const LAS bf16x8*)(A + fr * pa + k0 + 8 * fq); const bf16x8 bfv = *(const LAS bf16x8*)(B + fr * pb + k0 + 8 * fq);
        acc = __builtin_amdgcn_mfma_f32_16x16x32_bf16(af, bfv, acc, 0, 0, 0); }
    return acc;
}

__device__ __forceinline__ f32x4 mma16r(const LAS bf16* Arow, const LAS bf16* Brow, int K, f32x4 acc, int fq) {
    for (int k0 = 0; k0 < K; k0 += 32) { const bf16x8 af = *(const LAS bf16x8*)(Arow + k0 + 8 * fq); const bf16x8 bfv = *(const LAS bf16x8*)(Brow + k0 + 8 * fq);
        acc = __builtin_amdgcn_mfma_f32_16x16x32_bf16(af, bfv, acc, 0, 0, 0); }
    return acc;
}

__device__ __forceinline__ void phase_cmp2(const Frame& F, const Args& a, int u_lo, int u_hi, int u_step) {
    LAS bf16* hidS = (LAS bf16*)F.lds; LAS bf16* w2T = (LAS bf16*)(F.lds + 32 * 264 * 2); LAS float* outS = (LAS float*)(F.lds + 32 * 264 * 2 + 128 * 264 * 2);
    const int fr = F.lane & 15, fq = F.lane >> 4;
    for (int u = u_lo; u < u_hi; u += u_step) { const int mm = u >> 6, rb = u & 63;
        const bf16* hid = (const bf16*)(F.ws + WS_HID) + (size_t)mm * 2048 * 256 + (size_t)rb * 32 * 256; const float* w2 = a.in[mm ? I_CVW2 : I_CKW2];
        for (int i = F.tid; i < 32 * 32; i += NTHR) { const int r = i >> 5, c8 = i & 31; *(LAS v4u*)(hidS + r * 264 + c8 * 8) = *(const GAS v4u*)(hid + r * 256 + c8 * 8); }
        for (int i = F.tid; i < 256 * 128; i += NTHR) { const int k = i >> 7, c = i & 127; w2T[c * 264 + k] = (bf16)f2bf(w2[i]); }
        __syncthreads();
        const int rt = F.wave & 1;
#pragma unroll
        for (int cc = 0; cc < 2; ++cc) { const int ct = (F.wave >> 1) * 2 + cc; f32x4 acc = {0.f, 0.f, 0.f, 0.f};
            acc = mma16(hidS + rt * 16 * 264, 264, w2T + ct * 16 * 264, 264, 256, acc, fr, fq);
#pragma unroll
            for (int e = 0; e < 4; ++e) outS[(rt * 16 + 4 * fq + e) * 132 + ct * 16 + fr] = acc[e]; }
        __syncthreads();
        { const int r = F.wave * 4 + (F.lane >> 4), l16 = F.lane & 15; const int grow = rb * 32 + r, n = grow & 511;
          float v[8]; float ss = 0.f;
#pragma unroll
          for (int j = 0; j < 8; ++j) { v[j] = outS[r * 132 + l16 * 8 + j]; ss += v[j] * v[j]; }
          ss += __shfl_xor(ss, 1); ss += __shfl_xor(ss, 2); ss += __shfl_xor(ss, 4); ss += __shfl_xor(ss, 8);
          if (mm == 0) { const float rstd = 1.f / sqrtf(ss * (1.f / 128.f) + EPS); const float* g = a.in[I_KNORM];
#pragma unroll
              for (int j = 0; j < 8; ++j) v[j] = v[j] * rstd * g[l16 * 8 + j]; }
          if (n == 511) {
#pragma unroll
              for (int j = 0; j < 8; ++j) v[j] = 0.f; }
          v4u w; w.x = cvtpk(v[0], v[1]); w.y = cvtpk(v[2], v[3]); w.z = cvtpk(v[4], v[5]); w.w = cvtpk(v[6], v[7]);
          *(GAS v4u*)((bf16*)(F.ws + WS_KVCMP) + (size_t)mm * 2048 * 128 + (size_t)grow * 128 + l16 * 8) = w; }
        __syncthreads();
    }
}

__device__ __forceinline__ void rglru_unit(const Frame& F, const Args& a, int b, int h, int s) {
    const int w = F.wave, lane = F.lane, fr = lane & 15, fq = lane >> 4;
    LAS bf16* xcs = (LAS bf16*)F.lds + w * (16 * 136); LAS float* summ = (LAS float*)(F.lds + 8 * 16 * 136 * 2);
    const bf16* Y0 = (const bf16*)(F.ws + WS_Y0) + (size_t)b * SEQ * EV_INP; bf16* MIX = (bf16*)(F.ws + WS_MIX) + (size_t)b * SEQ * 2048;
    const int ch = h * 128 + s * 16 + fr;
    bf16x8 ba_f[4], bx_f[4];
    { const float* wa = a.in[I_RGWA] + (size_t)h * 128 * 128 + s * 16 + fr; const float* wx = a.in[I_RGWX] + (size_t)h * 128 * 128 + s * 16 + fr;
#pragma unroll
      for (int kk = 0; kk < 4; ++kk) { v4u ua, ux;
#pragma unroll
          for (int e2 = 0; e2 < 4; ++e2) { const int k = 32 * kk + 8 * fq + 2 * e2; ua[e2] = pk2(wa[(size_t)k * 128], wa[(size_t)(k + 1) * 128]); ux[e2] = pk2(wx[(size_t)k * 128], wx[(size_t)(k + 1) * 128]); }
          ba_f[kk] = *reinterpret_cast<bf16x8*>(&ua); bx_f[kk] = *reinterpret_cast<bf16x8*>(&ux); } }
    const float bias_a = a.in[I_RGBA][ch], bias_x = a.in[I_RGBX][ch], c8 = -8.f * fsoftplus(-a.in[I_RGLAM][ch]);
    const int cg = h * 128 + 2 * lane; float cw0[4], cw1[4];
#pragma unroll
    for (int j = 0; j < 4; ++j) { cw0[j] = a.in[I_RGCW][j * 1024 + cg]; cw1[j] = a.in[I_RGCW][j * 1024 + cg + 1]; }
    const float cb0 = a.in[I_RGCB][cg], cb1 = a.in[I_RGCB][cg + 1];
    float carry = 0.f;
    unsigned raw[19];
#define RG_LOAD(c_) do { const int T0_ = (c_) * 128 + 16 * w; _Pragma("unroll") for (int i = 0; i < 19; ++i) { const int t = T0_ - 3 + i; raw[i] = (t >= 0) ? *(const GAS unsigned*)(Y0 + (size_t)t * EV_INP + cg) : 0u; } } while (0)
    RG_LOAD(0);
#ifdef MK_DUP_RG
    for (int cc = 0; cc < 2 * (SEQ / 128); ++cc) { const int c = cc & (SEQ / 128 - 1); if (cc == SEQ / 128) { carry = 0.f; RG_LOAD(0); }
#else
    for (int c = 0; c < SEQ / 128; ++c) {
#endif
        const int T0 = c * 128 + 16 * w;
#pragma unroll
        for (int tt = 0; tt < 16; ++tt) { float y0 = cb0, y1 = cb1;
#pragma unroll
            for (int j = 0; j < 4; ++j) { y0 += cw0[j] * bflo(raw[tt + j]); y1 += cw1[j] * bfhi(raw[tt + j]); }
            *(LAS unsigned*)(xcs + tt * 136 + 2 * lane) = cvtpk(y0, y1); }
        LDS_WAIT();
        if (c + 1 < SEQ / 128) RG_LOAD(c + 1);
        unsigned short gg[4];
#pragma unroll
        for (int e = 0; e < 4; ++e) gg[e] = Y0[(size_t)(T0 + 4 * fq + e) * EV_INP + 1024 + ch];
        f32x4 acc_a = {0.f, 0.f, 0.f, 0.f}, acc_x = {0.f, 0.f, 0.f, 0.f};
#pragma unroll
        for (int kk = 0; kk < 4; ++kk) { const bf16x8 af = *(const LAS bf16x8*)(xcs + fr * 136 + 32 * kk + 8 * fq);
            acc_a = __builtin_amdgcn_mfma_f32_16x16x32_bf16(af, ba_f[kk], acc_a, 0, 0, 0); acc_x = __builtin_amdgcn_mfma_f32_16x16x32_bf16(af, bx_f[kk], acc_x, 0, 0, 0); }
        float hl[4], pl[4]; float hh = 0.f, pp = 1.f;
#pragma unroll
        for (int e = 0; e < 4; ++e) { const float xv = bf2f(xcs[(4 * fq + e) * 136 + s * 16 + fr]);
            const float r = fsigmoid(acc_a[e] + bias_a), ig = fsigmoid(acc_x[e] + bias_x); const float la = c8 * r; const float av = __expf(la);
            const float uu = __builtin_amdgcn_sqrtf((1.f - av) * (1.f + av)) * (ig * xv);
            hh = av * hh + uu; pp *= av; hl[e] = hh; pl[e] = pp; }
        float Apre = 1.f, Hpre = 0.f, Aw = 1.f, Hw = 0.f;
#pragma unroll
        for (int q = 0; q < 4; ++q) { const float Aq = __shfl(pp, fr + 16 * q), Hq = __shfl(hh, fr + 16 * q);
            if (q < fq) { Hpre = Aq * Hpre + Hq; Apre *= Aq; }
            Hw = Aq * Hw + Hq; Aw *= Aq; }
        LAS float* sm = summ + (c & 1) * 256;
        if (fq == 0) { sm[(w * 16 + fr) * 2] = Aw; sm[(w * 16 + fr) * 2 + 1] = Hw; }
        __syncthreads();
        float cin = carry, call = carry;
#pragma unroll
        for (int q = 0; q < 8; ++q) { const float Aq = sm[(q * 16 + fr) * 2], Hq = sm[(q * 16 + fr) * 2 + 1]; call = Aq * call + Hq; if (q < w) cin = call; }
        carry = call;
        const float cl = Apre * cin + Hpre;
#pragma unroll
        for (int e = 0; e < 4; ++e) { const float hv = hl[e] + pl[e] * cl; MIX[(size_t)(T0 + 4 * fq + e) * 2048 + ch] = (bf16)f2bf(gelu_tanh(bf2f(gg[e])) * hv); }
    }
#undef RG_LOAD
    __syncthreads();
}
constexpr size_t WS_M_CN = WS_R + 168 * MiB + 64 * MiB;
constexpr size_t WS_M_BN = WS_M_CN + 16 * MiB, WS_M_BT = WS_M_BN + 16 * MiB, WS_M_XT = WS_M_BT + 16 * MiB, WS_M_ACS = WS_M_XT + 64 * MiB, WS_M_DTV = WS_M_ACS + 2 * MiB,
                 WS_M_ST = WS_M_DTV + 2 * MiB, WS_M_PV = WS_M_ST + 128 * MiB, WS_M_END = WS_M_PV + 64 * MiB;
static_assert(WS_M_END <= WS_R + 560 * MiB, "mamba ws");
constexpr int MB_P = 136;
__device__ __forceinline__ void conv4_silu(const v4u (&rows)[7], const float* cw, int ldw, const float* cb, float (&out)[4][8]) {
    float wv[4][8], bv[8];
#pragma unroll
    for (int j = 0; j < 4; ++j) { const f32x4 w0 = *(const GAS f32x4*)(cw + (size_t)j * ldw), w1 = *(const GAS f32x4*)(cw + (size_t)j * ldw + 4);
#pragma unroll
        for (int i = 0; i < 4; ++i) { wv[j][i] = w0[i]; wv[j][4 + i] = w1[i]; } }
    { const f32x4 b0 = *(const GAS f32x4*)cb, b1 = *(const GAS f32x4*)(cb + 4);
#pragma unroll
      for (int i = 0; i < 4; ++i) { bv[i] = b0[i]; bv[4 + i] = b1[i]; } }
#pragma unroll
    for (int tt = 0; tt < 4; ++tt)
#pragma unroll
        for (int i2 = 0; i2 < 4; ++i2) { float y0 = bv[2 * i2], y1 = bv[2 * i2 + 1];
#pragma unroll
            for (int j = 0; j < 4; ++j) { y0 += wv[j][2 * i2] * bflo(rows[tt + j][i2]); y1 += wv[j][2 * i2 + 1] * bfhi(rows[tt + j][i2]); }
            out[tt][2 * i2] = fsilu(y0); out[tt][2 * i2 + 1] = fsilu(y1); }
}
__device__ __forceinline__ void od_dt_cols(const Frame& F, const bf16* X, const bf16* Wt, const float* ssq, bf16* Y1) {
    typedef float f32x16_t __attribute__((ext_vector_type(16)));
    int t_ = threadIdx.x; asm volatile("" : "+v"(t_));
    const int wave = __builtin_amdgcn_readfirstlane(t_ >> 6), lane = t_ & 63;
    const int r32 = lane & 31, hi = lane >> 5, kq = wave & 3;
    LAS float* red = (LAS float*)F.lds;
    for (int t0 = F.bid * 2; t0 < M / 32; t0 += F.G * 2) { const int r0 = (t0 + (wave >> 2)) * 32;
        const bf16* xa = X + (size_t)(r0 + r32) * D + 256 * kq + 8 * hi; const bf16* wb = Wt + (size_t)(5120 + r32) * D + 256 * kq + 8 * hi;
        f32x16_t acc;
#pragma unroll
        for (int r = 0; r < 16; ++r) acc[r] = 0.f;
        pg8::bf16x8 av[16], bv[16];
#pragma unroll
        for (int u = 0; u < 16; ++u) { av[u] = *(const GAS pg8::bf16x8*)(xa + 16 * u); bv[u] = *(const GAS pg8::bf16x8*)(wb + 16 * u); }
#pragma unroll
        for (int u = 0; u < 16; ++u) acc = __builtin_amdgcn_mfma_f32_32x32x16_bf16(av[u], bv[u], acc, 0, 0, 0);
        if (kq != 0) {
#pragma unroll
            for (int r = 0; r < 16; ++r) red[(wave * 16 + r) * 64 + lane] = acc[r]; }
        __syncthreads();
        if (kq == 0) { const float rs_l = pg8::row_rstd(ssq, r0 + r32);
#pragma unroll
            for (int r = 0; r < 16; ++r) { const int row = (r & 3) + 8 * (r >> 2) + 4 * hi; const float rs = __shfl(rs_l, row);
                const float v = (acc[r] + red[((wave + 1) * 16 + r) * 64 + lane]) + (red[((wave + 2) * 16 + r) * 64 + lane] + red[((wave + 3) * 16 + r) * 64 + lane]);
                Y1[(size_t)(r0 + row) * OD_INP + 5120 + r32] = (bf16)f2bf(v * rs); } }
        __syncthreads();
    }
}
__device__ __forceinline__ void phase_mamba_prep(const Frame& F, const Args& a) {
    LAS bf16* T = (LAS bf16*)F.lds;
    LAS float* acsS = (LAS float*)(F.lds + 128 * MB_P * 2); LAS float* dtS = acsS + 256;
    const int tid = F.tid, lane = F.lane, w = F.wave, sg = tid >> 4, cv = tid & 15;
    const float* cw = a.in[I_ODCW]; const float* cb = a.in[I_ODCB];
    v4u rows[7];
#define M0_LOAD(u_) do { const int bc_ = (u_) / 24, sl_ = (u_) % 24, T0_ = (bc_ & 63) * 128; const bf16* Y1_ = (const bf16*)(F.ws + WS_Y1) + (size_t)(bc_ >> 6) * SEQ * OD_INP; \
        _Pragma("unroll") for (int i = 0; i < 7; ++i) { const int t = T0_ + 4 * sg - 3 + i; rows[i] = (t >= 0) ? *(const GAS v4u*)(Y1_ + (size_t)t * OD_INP + 2048 + sl_ * 128 + cv * 8) : (v4u){0u, 0u, 0u, 0u}; } } while (0)
    if (F.bid < 128 * 24) M0_LOAD(F.bid);
    for (int u = F.bid; u < 128 * 24; u += F.G) { const int bc = u / 24, sl = u % 24, b = bc >> 6, c = bc & 63, T0 = c * 128;
        const bf16* Y1 = (const bf16*)(F.ws + WS_Y1) + (size_t)b * SEQ * OD_INP; const int ch0 = sl * 128;
        { float vals[4][8];
          conv4_silu(rows, cw + ch0 + cv * 8, 3072, cb + ch0 + cv * 8, vals);
          if (u + F.G < 128 * 24) M0_LOAD(u + F.G);
#pragma unroll
          for (int tt = 0; tt < 4; ++tt) { v4u o; o.x = cvtpk(vals[tt][0], vals[tt][1]); o.y = cvtpk(vals[tt][2], vals[tt][3]); o.z = cvtpk(vals[tt][4], vals[tt][5]); o.w = cvtpk(vals[tt][6], vals[tt][7]);
              *(LAS v4u*)(T + (4 * sg + tt) * MB_P + cv * 8) = o; } }
        if (sl < 16 && w < 2) { const int h = 2 * sl + w;
            const float Ah = -__expf(a.in[I_ALOG][h]), dtb = a.in[I_DTB][h];
            const float d0 = fsoftplus(bf2f(Y1[(size_t)(T0 + 2 * lane) * OD_INP + 5120 + h]) + dtb), d1 = fsoftplus(bf2f(Y1[(size_t)(T0 + 2 * lane + 1) * OD_INP + 5120 + h]) + dtb);
            const float a0 = d0 * Ah, a1 = d1 * Ah; float pr = a0 + a1;
#pragma unroll
            for (int off = 1; off < 64; off <<= 1) { const float t = __shfl_up(pr, off); if (lane >= off) pr += t; }
            const float ex = pr - (a0 + a1); const float c0 = ex + a0, c1 = ex + a0 + a1;
            acsS[w * 128 + 2 * lane] = c0; acsS[w * 128 + 2 * lane + 1] = c1; dtS[w * 128 + 2 * lane] = d0; dtS[w * 128 + 2 * lane + 1] = d1;
            float* ACS = (float*)(F.ws + WS_M_ACS) + ((size_t)bc * 32 + h) * 128; float* DTV = (float*)(F.ws + WS_M_DTV) + ((size_t)bc * 32 + h) * 128;
            typedef float f32x2v __attribute__((ext_vector_type(2))); *(GAS f32x2v*)(ACS + 2 * lane) = (f32x2v){c0, c1}; *(GAS f32x2v*)(DTV + 2 * lane) = (f32x2v){d0, d1}; }
        __syncthreads();
        if (sl < 16) {
            const int cc = tid >> 2, s0 = (tid & 3) * 32, hh = cc >> 6; bf16* XT = (bf16*)(F.ws + WS_M_XT) + (((size_t)bc * 32 + 2 * sl) * 64 + cc) * 128 + s0;
#pragma unroll
            for (int k8 = 0; k8 < 4; ++k8) { float v[8];
#pragma unroll
                for (int k = 0; k < 8; ++k) { const int s = s0 + 8 * k8 + k; v[k] = bf2f(T[s * MB_P + cc]) * dtS[hh * 128 + s]; }
                v4u o; o.x = cvtpk(v[0], v[1]); o.y = cvtpk(v[2], v[3]); o.z = cvtpk(v[4], v[5]); o.w = cvtpk(v[6], v[7]); *(GAS v4u*)(XT + 8 * k8) = o; } }
        else { const int g = (sl - 16) & 3; const bool isB = sl < 20;
            bf16* N = (bf16*)(F.ws + (isB ? WS_M_BN : WS_M_CN)) + ((size_t)b * SEQ + T0) * 512 + g * 128;
            for (int i = tid; i < 128 * 16; i += NTHR) { const int s = i >> 4, c8 = i & 15; *(GAS v4u*)(N + (size_t)s * 512 + c8 * 8) = *(const LAS v4u*)(T + s * MB_P + c8 * 8); }
            if (isB) { const int cc = tid >> 2, s0 = (tid & 3) * 32; bf16* BT = (bf16*)(F.ws + WS_M_BT) + (((size_t)bc * 4 + g) * 128 + cc) * 128 + s0;
#pragma unroll
                for (int k8 = 0; k8 < 4; ++k8) { unsigned short v[8];
#pragma unroll
                    for (int k = 0; k < 8; ++k) v[k] = T[(s0 + 8 * k8 + k) * MB_P + cc];
                    v4u o; o.x = v[0] | ((unsigned)v[1] << 16); o.y = v[2] | ((unsigned)v[3] << 16); o.z = v[4] | ((unsigned)v[5] << 16); o.w = v[6] | ((unsigned)v[7] << 16); *(GAS v4u*)(BT + 8 * k8) = o; } } }
        __syncthreads();
    }
#undef M0_LOAD
}
__device__ __forceinline__ void phase_mamba_states(const Frame& F) {
    LAS bf16* BTs = (LAS bf16*)F.lds; LAS bf16* XW = (LAS bf16*)(F.lds + 128 * MB_P * 2); LAS bf16* STs = (LAS bf16*)(F.lds + 192 * MB_P * 2);
    const int tid = F.tid, lane = F.lane, w = F.wave, fr = lane & 15, fq = lane >> 4;
    for (int u = F.bid; u < 128 * 4; u += F.G) { const int bc = u >> 2, g = u & 3;
        const bf16* BT = (const bf16*)(F.ws + WS_M_BT) + ((size_t)bc * 4 + g) * 128 * 128;
        for (int i = tid; i < 128 * 16; i += NTHR) { const int n = i >> 4, c8 = i & 15; *(LAS v4u*)(BTs + n * MB_P + c8 * 8) = *(const GAS v4u*)(BT + (size_t)n * 128 + c8 * 8); }
#pragma unroll 1
        for (int hh = 0; hh < 8; ++hh) { const int h = g * 8 + hh;
            const bf16* XT = (const bf16*)(F.ws + WS_M_XT) + ((size_t)bc * 32 + h) * 64 * 128; const float* ACS = (const float*)(F.ws + WS_M_ACS) + ((size_t)bc * 32 + h) * 128;
            const float aL = ACS[127];
#pragma unroll
            for (int k = 0; k < 2; ++k) { const int i = tid + k * NTHR, p = i >> 4, c8 = i & 15; const v4u raw = *(const GAS v4u*)(XT + (size_t)p * 128 + c8 * 8);
                const f32x4 a0 = *(const GAS f32x4*)(ACS + c8 * 8), a1 = *(const GAS f32x4*)(ACS + c8 * 8 + 4);
                v4u o; o.x = cvtpk(bflo(raw[0]) * __expf(aL - a0[0]), bfhi(raw[0]) * __expf(aL - a0[1])); o.y = cvtpk(bflo(raw[1]) * __expf(aL - a0[2]), bfhi(raw[1]) * __expf(aL - a0[3]));
                o.z = cvtpk(bflo(raw[2]) * __expf(aL - a1[0]), bfhi(raw[2]) * __expf(aL - a1[1])); o.w = cvtpk(bflo(raw[3]) * __expf(aL - a1[2]), bfhi(raw[3]) * __expf(aL - a1[3]));
                *(LAS v4u*)(XW + p * MB_P + c8 * 8) = o; }
            __syncthreads();
            bf16* ST = (bf16*)(F.ws + WS_M_ST) + ((size_t)bc * 32 + h) * 64 * 128;
#pragma unroll
            for (int pt = 0; pt < 4; ++pt) { f32x4 acc = {0.f, 0.f, 0.f, 0.f}; acc = mma16(XW + pt * 16 * MB_P, MB_P, BTs + w * 16 * MB_P, MB_P, 128, acc, fr, fq);
#pragma unroll
                for (int e = 0; e < 4; ++e) STs[(pt * 16 + 4 * fq + e) * MB_P + w * 16 + fr] = (bf16)f2bf(acc[e]); }
            __syncthreads();
#pragma unroll
            for (int k = 0; k < 2; ++k) { const int i = tid + k * NTHR, pp = i >> 4, c8 = i & 15; *(GAS v4u*)(ST + (size_t)pp * 128 + c8 * 8) = *(const LAS v4u*)(STs + pp * MB_P + c8 * 8); }
        }
    }
}
__device__ __forceinline__ void phase_mamba_scan(const Frame& F) {
    const int gt = F.bid * NTHR + F.tid;
    const bf16* STg = (const bf16*)(F.ws + WS_M_ST); bf16* PVg = (bf16*)(F.ws + WS_M_PV); const float* ACSg = (const float*)(F.ws + WS_M_ACS);
    for (int i = gt; i < BATCH * 32 * 64 * 32; i += F.G * NTHR) { const int n4 = i & 31, p = (i >> 5) & 63, h = (i >> 11) & 31, b = i >> 16;
        f32x4 S = {0.f, 0.f, 0.f, 0.f};
        const size_t off0 = (((size_t)b * 64 * 32 + h) * 64 + p) * 128 + n4 * 4, cstep = (size_t)32 * 64 * 128;
        const float* al = ACSg + ((size_t)b * 64 * 32 + h) * 128 + 127;
#pragma unroll 1
        for (int c0 = 0; c0 < 64; c0 += 16) {
            v2u sr[16]; float dl[16];
#pragma unroll
            for (int j = 0; j < 16; ++j) { sr[j] = *(const GAS v2u*)(STg + off0 + (size_t)(c0 + j) * cstep); dl[j] = al[(size_t)(c0 + j) * 32 * 128]; }
#pragma unroll
            for (int j = 0; j < 16; ++j) { const float dec = __expf(dl[j]); const f32x4 st = {bflo(sr[j].x), bfhi(sr[j].x), bflo(sr[j].y), bfhi(sr[j].y)};
                v2u o; o.x = cvtpk(S[0], S[1]); o.y = cvtpk(S[2], S[3]); *(GAS v2u*)(PVg + off0 + (size_t)(c0 + j) * cstep) = o;
                S = S * dec + st; } } }
}
constexpr int M3_CS = 0, M3_BS = M3_CS + 128 * MB_P * 2, M3_MS = M3_BS + 128 * MB_P * 2, M3_XT = M3_MS + 128 * MB_P * 2, M3_PV = M3_XT + 64 * MB_P * 2, M3_ACS = M3_PV + 64 * MB_P * 2, M3_DT = M3_ACS + 512, M3_END = M3_DT + 512;
static_assert(M3_END <= SCR_BYTES, "mamba lds");
__device__ __forceinline__ void phase_mamba_out(const Frame& F, const Args& a) {
    LAS bf16* Cs = (LAS bf16*)(F.lds + M3_CS); LAS bf16* Bs = (LAS bf16*)(F.lds + M3_BS); LAS bf16* Ms = (LAS bf16*)(F.lds + M3_MS); LAS bf16* XTs = (LAS bf16*)(F.lds + M3_XT); LAS bf16* PVs = (LAS bf16*)(F.lds + M3_PV);
    LAS float* acs = (LAS float*)(F.lds + M3_ACS); LAS float* dtv = (LAS float*)(F.lds + M3_DT);
    const int tid = F.tid, lane = F.lane, w = F.wave, fr = lane & 15, fq = lane >> 4;
    for (int u = F.bid; u < 128 * 4; u += F.G) { const int bc = u >> 2, g = u & 3, b = bc >> 6, T0 = (bc & 63) * 128;
        const bf16* CN = (const bf16*)(F.ws + WS_M_CN) + ((size_t)b * SEQ + T0) * 512 + g * 128; const bf16* BN = (const bf16*)(F.ws + WS_M_BN) + ((size_t)b * SEQ + T0) * 512 + g * 128;
        for (int i = tid; i < 128 * 16; i += NTHR) { const int s = i >> 4, c8 = i & 15;
            *(LAS v4u*)(Cs + s * MB_P + c8 * 8) = *(const GAS v4u*)(CN + (size_t)s * 512 + c8 * 8); *(LAS v4u*)(Bs + s * MB_P + c8 * 8) = *(const GAS v4u*)(BN + (size_t)s * 512 + c8 * 8); }
        __syncthreads();
        f32x4 cbt[8];
#pragma unroll
        for (int st = 0; st < 8; ++st) { cbt[st] = (f32x4){0.f, 0.f, 0.f, 0.f}; if (st <= w) cbt[st] = mma16(Bs + st * 16 * MB_P, MB_P, Cs + w * 16 * MB_P, MB_P, 128, cbt[st], fr, fq); }
        const bf16* Y1 = (const bf16*)(F.ws + WS_Y1) + ((size_t)b * SEQ + T0) * OD_INP; bf16* YG = (bf16*)(F.ws + WS_YG) + ((size_t)b * SEQ + T0) * 2048;
        v4u pfx[2], pfp[2]; float pfa = 0.f, pfd = 0.f;
#define M3_PREFETCH(hh_) do { const int h_ = g * 8 + (hh_); const bf16* XT_ = (const bf16*)(F.ws + WS_M_XT) + ((size_t)bc * 32 + h_) * 64 * 128; const bf16* PV_ = (const bf16*)(F.ws + WS_M_PV) + ((size_t)bc * 32 + h_) * 64 * 128; \
            _Pragma("unroll") for (int k = 0; k < 2; ++k) { const int i = tid + k * NTHR, p = i >> 4, c8 = i & 15; pfx[k] = *(const GAS v4u*)(XT_ + (size_t)p * 128 + c8 * 8); pfp[k] = *(const GAS v4u*)(PV_ + (size_t)p * 128 + c8 * 8); } \
            if (tid < 128) { pfa = ((const float*)(F.ws + WS_M_ACS))[((size_t)bc * 32 + h_) * 128 + tid]; pfd = ((const float*)(F.ws + WS_M_DTV))[((size_t)bc * 32 + h_) * 128 + tid]; } } while (0)
        M3_PREFETCH(0);
#pragma unroll 1
        for (int hh = 0; hh < 8; ++hh) { const int h = g * 8 + hh; const float dsk = a.in[I_DSKIP][h];
#pragma unroll
            for (int k = 0; k < 2; ++k) { const int i = tid + k * NTHR, p = i >> 4, c8 = i & 15; *(LAS v4u*)(XTs + p * MB_P + c8 * 8) = pfx[k]; *(LAS v4u*)(PVs + p * MB_P + c8 * 8) = pfp[k]; }
            if (tid < 128) { acs[tid] = pfa; dtv[tid] = pfd; }
            __syncthreads();
            if (hh + 1 < 8) M3_PREFETCH(hh + 1);
            v4u zz[2];
#pragma unroll
            for (int k = 0; k < 2; ++k) zz[k] = *(const GAS v4u*)(Y1 + (size_t)(16 * w + fr) * OD_INP + h * 64 + 16 * fq + 8 * k);
            const float aq = acs[16 * w + fr];
#pragma unroll
            for (int st = 0; st < 8; ++st) { if (st <= w) { float mv[4];
#pragma unroll
                for (int e = 0; e < 4; ++e) { const int s = 16 * st + 4 * fq + e; mv[e] = (s <= 16 * w + fr) ? cbt[st][e] * __expf(aq - acs[s]) : 0.f; }
                v2u o; o.x = cvtpk(mv[0], mv[1]); o.y = cvtpk(mv[2], mv[3]); *(LAS v2u*)(Ms + (16 * w + fr) * MB_P + 16 * st + 4 * fq) = o; } }
            if ((w & 1) == 0) *(LAS v2u*)(Ms + (16 * w + fr) * MB_P + 16 * (w + 1) + 4 * fq) = (v2u){0u, 0u};
            LDS_WAIT();
            float yv[16]; { const int q = 16 * w + fr; const float eq = __expf(acs[q]), rdt = dsk * __builtin_amdgcn_rcpf(dtv[q]); const int prow = 16 * (fr >> 2) + (fr & 3);
#pragma unroll
            for (int pt = 0; pt < 4; ++pt) { f32x4 yd = {0.f, 0.f, 0.f, 0.f}, yo = {0.f, 0.f, 0.f, 0.f};
                yd = mma16r(XTs + (prow + 4 * pt) * MB_P, Ms + q * MB_P, ((w + 2) >> 1) * 32, yd, fq);
                yo = mma16r(PVs + (prow + 4 * pt) * MB_P, Cs + q * MB_P, 128, yo, fq);
#pragma unroll
                for (int e = 0; e < 4; ++e) { const int pp = 16 * fq + 4 * pt + e; yv[4 * pt + e] = yd[e] + eq * yo[e] + rdt * bf2f(XTs[pp * MB_P + q]); } } }
#pragma unroll
            for (int k = 0; k < 2; ++k) { v4u o;
#pragma unroll
                for (int j = 0; j < 4; ++j) o[j] = cvtpk(yv[8 * k + 2 * j] * fsilu(bflo(zz[k][j])), yv[8 * k + 2 * j + 1] * fsilu(bfhi(zz[k][j])));
                *(GAS v4u*)(YG + (size_t)(16 * w + fr) * 2048 + h * 64 + 16 * fq + 8 * k) = o; }
            __syncthreads();
        }
#undef M3_PREFETCH
        VM_WAIT(); __syncthreads();
        { const float* gn = a.in[I_ODNORM] + g * 512 + lane * 8; const f32x4 g0 = *(const GAS f32x4*)gn, g1 = *(const GAS f32x4*)(gn + 4);
#pragma unroll 4
          for (int t = 0; t < 16; ++t) { bf16* pq = YG + (size_t)(16 * w + t) * 2048 + g * 512 + lane * 8; const v4u raw = *(const GAS v4u*)pq; float ss = 0.f;
#pragma unroll
              for (int j = 0; j < 4; ++j) { const float x0 = bflo(raw[j]), x1 = bfhi(raw[j]); ss += x0 * x0 + x1 * x1; }
              const float rstd = 1.f / sqrtf(wave_sum(ss) * (1.f / 512.f) + EPS);
              v4u o; o.x = cvtpk(bflo(raw[0]) * rstd * g0[0], bfhi(raw[0]) * rstd * g0[1]); o.y = cvtpk(bflo(raw[1]) * rstd * g0[2], bfhi(raw[1]) * rstd * g0[3]);
              o.z = cvtpk(bflo(raw[2]) * rstd * g1[0], bfhi(raw[2]) * rstd * g1[1]); o.w = cvtpk(bflo(raw[3]) * rstd * g1[2], bfhi(raw[3]) * rstd * g1[3]);
              *(GAS v4u*)pq = o; } }
    }
}
__device__ __forceinline__ void phase_group_norm(const Frame& F, const Args& a) {
    const int gw = F.bid * NWAVES + F.wave, NGW = F.G * NWAVES; bf16* YG = (bf16*)(F.ws + WS_YG); const float* g = a.in[I_ODNORM];
    for (int m = gw; m < M; m += NGW) {
#pragma unroll
        for (int gi = 0; gi < 4; ++gi) { bf16* p = YG + (size_t)m * 2048 + gi * 512 + F.lane * 8; const v4u raw = *(const GAS v4u*)p; float ss = 0.f;
#pragma unroll
            for (int j = 0; j < 4; ++j) { const float x0 = bflo(raw[j]), x1 = bfhi(raw[j]); ss += x0 * x0 + x1 * x1; }
            const float rstd = 1.f / sqrtf(wave_sum(ss) * (1.f / 512.f) + EPS);
            const f32x4 g0 = *(const GAS f32x4*)(g + gi * 512 + F.lane * 8), g1 = *(const GAS f32x4*)(g + gi * 512 + F.lane * 8 + 4);
            v4u o; o.x = cvtpk(bflo(raw[0]) * rstd * g0[0], bfhi(raw[0]) * rstd * g0[1]); o.y = cvtpk(bflo(raw[1]) * rstd * g0[2], bfhi(raw[1]) * rstd * g0[3]);
            o.z = cvtpk(bflo(raw[2]) * rstd * g1[0], bfhi(raw[2]) * rstd * g1[1]); o.w = cvtpk(bflo(raw[3]) * rstd * g1[2], bfhi(raw[3]) * rstd * g1[3]);
            *(GAS v4u*)p = o; }
    }
}
constexpr int MOE_TAB = 131072;
static_assert(MOE_TAB + (32 + MOE_TILES + 24) * 4 <= SCR_BYTES, "moe lds");
__device__ __forceinline__ void phase_route(const Frame& F, const Args& a, const bf16* X) {
    LAS int* cntS = (LAS int*)F.lds;
    if (F.tid < 8) cntS[F.tid] = 0;
    LAS float* rtS = (LAS float*)(F.lds + 256);
    for (int i = F.tid; i < D * 2; i += NTHR) { const int r = i >> 1, hf = i & 1; *(LAS f32x4*)(rtS + r * 8 + (r >> 3) * 4 + hf * 4) = *(const GAS f32x4*)(a.in[I_ROUTER] + (size_t)r * 8 + hf * 4); }
    __syncthreads();
    const float* g = a.in[I_NFFN] + D; unsigned char* XN8 = F.ws + WS_XN8;
    int* tokE = (int*)(F.ws + WS_MOEIDX); float* tokW = (float*)(F.ws + WS_MOEIDX + 1 * MiB);
    const int per = M / F.G;
    for (int i = F.wave; i < per; i += NWAVES) { const int m = F.bid * per + i;
        const GAS v4u* xr = (const GAS v4u*)(X + (size_t)m * D) + F.lane;
        float v[2][8]; float s = 0.f;
#pragma unroll
        for (int k = 0; k < 2; ++k) { const v4u r = xr[64 * k];
#pragma unroll
            for (int j = 0; j < 4; ++j) { v[k][2 * j] = bflo(r[j]); v[k][2 * j + 1] = bfhi(r[j]); s += v[k][2 * j] * v[k][2 * j] + v[k][2 * j + 1] * v[k][2 * j + 1]; } }
        const float rstd = 1.f / sqrtf(wave_sum(s) * (1.f / D) + EPS);
        float lg[8]; v2u o8[2];
#pragma unroll
        for (int e = 0; e < 8; ++e) lg[e] = 0.f;
#pragma unroll
        for (int k = 0; k < 2; ++k) { const int c0 = 512 * k + 8 * F.lane; const f32x4 g0 = *(const GAS f32x4*)(g + c0), g1 = *(const GAS f32x4*)(g + c0 + 4); float hn[8];
#pragma unroll
            for (int q = 0; q < 8; ++q) hn[q] = v[k][q] * rstd * (q < 4 ? g0[q & 3] : g1[q & 3]);
            o8[k].x = pk4_fp8(hn[0], hn[1], hn[2], hn[3]); o8[k].y = pk4_fp8(hn[4], hn[5], hn[6], hn[7]);
#pragma unroll
            for (int q = 0; q < 8; ++q) { const LAS float* rr = rtS + (c0 + q) * 8 + ((c0 + q) >> 3) * 4; const f32x4 r0 = *(const LAS f32x4*)rr, r1 = *(const LAS f32x4*)(rr + 4);
#pragma unroll
                for (int e = 0; e < 4; ++e) { lg[e] += hn[q] * r0[e]; lg[4 + e] += hn[q] * r1[e]; } } }
#pragma unroll
        for (int k = 0; k < 2; ++k) *(GAS v2u*)(XN8 + (size_t)m * D + 512 * k + 8 * F.lane) = o8[k];
#pragma unroll
        for (int e = 0; e < 8; ++e) lg[e] = wave_sum(lg[e]);
        int e1 = 0; float v1 = lg[0];
#pragma unroll
        for (int e = 1; e < 8; ++e) if (lg[e] > v1) { v1 = lg[e]; e1 = e; }
        int e2 = (e1 + 1) & 7; float v2 = -3.0e38f;
#pragma unroll
        for (int e = 0; e < 8; ++e) if (e != e1 && lg[e] > v2) { v2 = lg[e]; e2 = e; }
        if (F.lane == 0) { const float w1 = 1.f / (1.f + __expf(v2 - v1)); tokE[2 * m] = e1; tokE[2 * m + 1] = e2; tokW[2 * m] = w1; tokW[2 * m + 1] = 1.f - w1;
            atomicAdd((int*)cntS + e1, 1); atomicAdd((int*)cntS + e2, 1); }
    }
    __syncthreads();
    if (F.tid < 8) ((int*)(F.ctl + CW_MOECNT))[F.bid * 8 + F.tid] = cntS[F.tid];
    __syncthreads();
}
__device__ __forceinline__ void moe_layout(const Frame& F) {
    LAS int* tab = (LAS int*)(F.lds + MOE_TAB); const int* cnt = (const int*)(F.ctl + CW_MOECNT);
    if (F.tid < 16) tab[F.tid < 8 ? F.tid : 32 + MOE_TILES + F.tid] = 0;
    __syncthreads();
    { const int e = F.tid & 7; int tot = 0, pre = 0;
      for (int wg = F.tid >> 3; wg < F.G; wg += NTHR / 8) { const int c = cnt[wg * 8 + e]; tot += c; if (wg < F.bid) pre += c; }
      atomicAdd((int*)tab + e, tot); atomicAdd((int*)tab + 32 + MOE_TILES + 8 + e, pre); }
    __syncthreads();
    if (F.tid == 0) { int row = 0, tl = 0; for (int e = 0; e < 8; ++e) { const int nt = (tab[e] + 255) >> 8; tab[8 + e] = row; tab[16 + e] = nt; for (int i = 0; i < nt; ++i) tab[32 + tl + i] = e; tl += nt; row += nt * 256; } tab[24] = tl; }
    __syncthreads();
}
__device__ __forceinline__ void phase_scatter(const Frame& F) {
    moe_layout(F);
    LAS int* tab = (LAS int*)(F.lds + MOE_TAB); LAS int* slotS = (LAS int*)F.lds;
    const int per = M / F.G;
    const int* tokE = (const int*)(F.ws + WS_MOEIDX); int* tokS = (int*)(F.ws + WS_MOEIDX + 2 * MiB);
    if (F.wave == 0) { const int E0 = tokE[(size_t)F.bid * per * 2 + F.lane], E1 = tokE[(size_t)F.bid * per * 2 + 64 + F.lane]; int s0 = 0, s1 = 0;
        const unsigned long long lt = (1ull << F.lane) - 1ull;
#pragma unroll
        for (int e = 0; e < 8; ++e) { const unsigned long long m0 = __ballot(E0 == e), m1 = __ballot(E1 == e); const int base = tab[8 + e] + tab[32 + MOE_TILES + 8 + e];
            if (E0 == e) s0 = base + __popcll(m0 & lt); if (E1 == e) s1 = base + __popcll(m0) + __popcll(m1 & lt); }
        slotS[F.lane] = s0; slotS[64 + F.lane] = s1; tokS[(size_t)F.bid * per * 2 + F.lane] = s0; tokS[(size_t)F.bid * per * 2 + 64 + F.lane] = s1; }
    __syncthreads();
    const unsigned char* XN8 = F.ws + WS_XN8; unsigned char* XP = F.ws + WS_XP;
    for (int i0 = F.wave; i0 < per * 2; i0 += NWAVES * 16) {
        v4u rowv[16];
#pragma unroll
        for (int j = 0; j < 16; ++j) { const int i = i0 + j * NWAVES; if (i < per * 2) rowv[j] = ((const GAS v4u*)(XN8 + (size_t)(F.bid * per + (i >> 1)) * D))[F.lane]; }
#pragma unroll
        for (int j = 0; j < 16; ++j) { const int i = i0 + j * NWAVES; if (i < per * 2) ((GAS v4u*)(XP + (size_t)slotS[i] * D))[F.lane] = rowv[j]; } }
    __syncthreads();
}
struct MoeOrder {
    int nN, nwg, G, c; const LAS int* texp;
    __device__ __forceinline__ bool next(int i, pg8::Unit& u) const { const long L = (long)i * G + c; if (L >= nwg) return false; u.pm = (int)(L / nN); u.pn = (int)(L % nN); u.bn = texp[u.pm] * nN + u.pn; u.idx = i; return true; }
    __device__ __forceinline__ void a_ready(const pg8::Unit&) const {}
    __device__ __forceinline__ void done(const pg8::Unit&) const {}
};
struct MoeOrderX {
    int nM, nN, nwg, G, c; const LAS int* texp;
    __device__ __forceinline__ bool next(int i, pg8::Unit& u) const { const long L = (long)i * G + c; if (L >= nwg) return false;
        int wgid = (int)L; { const int q = nwg / 8, r = nwg % 8, xcd = wgid % 8, off = wgid / 8; wgid = (xcd < r ? xcd * (q + 1) : r * (q + 1) + (xcd - r) * q) + off; }
        const int nig = 8 * nN, gid = wgid / nig, fm = gid * 8, gsz = (nM - fm) < 8 ? (nM - fm) : 8;
        u.pm = fm + ((wgid % nig) % gsz); u.pn = (wgid % nig) / gsz; u.bn = texp[u.pm] * nN + u.pn; u.idx = i; return true; }
    __device__ __forceinline__ void a_ready(const pg8::Unit&) const {}
    __device__ __forceinline__ void done(const pg8::Unit&) const {}
};
struct MoeTail { int R, Lo, pm_min; bool split; };
__device__ __forceinline__ MoeTail moe_tail(const LAS int* tab, int G) { MoeTail t; const int U = tab[24] * 4; t.R = U / G; t.Lo = U - t.R * G; t.split = (t.Lo > 0 && t.Lo <= 128 && t.R > 0); t.pm_min = t.split ? (t.R * G) / 4 : (1 << 30); return t; }
struct MoeTailOrder { int pm, pn, bn; bool has;
    __device__ __forceinline__ bool next(int i, pg8::Unit& u) const { if (i > 0 || !has) return false; u.pm = pm; u.pn = pn; u.bn = bn; u.idx = 0; return true; }
    __device__ __forceinline__ void a_ready(const pg8::Unit&) const {}
    __device__ __forceinline__ void done(const pg8::Unit&) const {} };
constexpr size_t MOE_PART_STRIDE = (size_t)32 * 256 * 1024;
__device__ __forceinline__ void phase_moe_combine(const Frame& F, const bf16* x, float* xo) {
    moe_layout(F); const MoeTail mt = moe_tail((const LAS int*)(F.lds + MOE_TAB), F.G); const int srow = mt.pm_min == (1 << 30) ? (1 << 30) : mt.pm_min * 256; const float* PART = (const float*)(F.ws + WS_XP);
    const int gw = F.bid * NWAVES + F.wave, NGW = F.G * NWAVES;
    const float* tokW = (const float*)(F.ws + WS_MOEIDX + 1 * MiB); const int* tokS = (const int*)(F.ws + WS_MOEIDX + 2 * MiB); const int* tokE = (const int*)(F.ws + WS_MOEIDX);
    const bf16* YP = (const bf16*)(F.ws + WS_YP);
    for (int m = gw; m < M; m += NGW) { const int s0 = tokS[2 * m], s1 = tokS[2 * m + 1]; const float w0 = tokW[2 * m] * (1.f / MOE_W2_SCALE), w1 = tokW[2 * m + 1] * (1.f / MOE_W2_SCALE)  ; const bool sw = tokE[2 * m] > tokE[2 * m + 1];
        const GAS v2u* xr = (const GAS v2u*)(x + (size_t)m * D) + F.lane; GAS f32x4* xw = (GAS f32x4*)(xo + (size_t)m * D) + F.lane; const GAS v2u* y0 = (const GAS v2u*)(YP + (size_t)s0 * D) + F.lane; const GAS v2u* y1 = (const GAS v2u*)(YP + (size_t)s1 * D) + F.lane;
#pragma unroll
        for (int j = 0; j < 4; ++j) { f32x4 v0, v1;
            if (s0 >= srow) { const GAS f32x4* q = (const GAS f32x4*)(PART + (size_t)(s0 - srow) * D) + F.lane + 64 * j; v0 = q[0] + q[MOE_PART_STRIDE / 4]; } else { const v2u yb = y0[64 * j]; v0 = (f32x4){bflo(yb.x), bfhi(yb.x), bflo(yb.y), bfhi(yb.y)}; }
            if (s1 >= srow) { const GAS f32x4* q = (const GAS f32x4*)(PART + (size_t)(s1 - srow) * D) + F.lane + 64 * j; v1 = q[0] + q[MOE_PART_STRIDE / 4]; } else { const v2u yb = y1[64 * j]; v1 = (f32x4){bflo(yb.x), bfhi(yb.x), bflo(yb.y), bfhi(yb.y)}; }
            const f32x4 a0 = v0 * w0, a1 = v1 * w1; const v2u xb = xr[64 * j]; const f32x4 xv = {bflo(xb.x), bfhi(xb.x), bflo(xb.y), bfhi(xb.y)}; xw[64 * j] = xv + (sw ? (a1 + a0) : (a0 + a1)); } }
}
#ifndef MK_PHMASK
#define MK_PHMASK 0xFFFFFFFFFFFFull
#endif
#ifndef MK_DUPMASK
#define MK_DUPMASK 0ull
#endif
#ifndef MK_SPLIT
#define MK_SPLIT 0
#endif
#ifndef MK_LAST_PHASE
#define MK_LAST_PHASE 29
#endif
constexpr int N_PHASES = 30;
#ifndef MK_LB
#define MK_LB 2
#endif
__global__ void __launch_bounds__(NTHR, MK_LB) mega_fwd(Args args) {
    extern __shared__ __attribute__((aligned(16))) unsigned char lds_raw[];
    Frame F;
    F.lds = (LAS unsigned char*)lds_raw; F.MISC = (volatile LAS unsigned*)(F.lds + MISC_OFF);
    F.tid = threadIdx.x; F.lane = F.tid & 63; F.wave = __builtin_amdgcn_readfirstlane(F.tid >> 6); F.G = gridDim.x; F.bid = blockIdx.x;
    F.ws = args.ws; F.ctl = (gu32*)(args.ws + WS_CTL);
    for (int u = F.tid; u < (LDS_BYTES - MISC_OFF) / 4; u += NTHR) ((LAS unsigned*)(F.lds + MISC_OFF))[u] = 0u;
    __syncthreads();
    XcdBarrier bar; bar.bar = (unsigned*)(F.ctl + CW_BAR); bar.x = 0; bar.st = nullptr;
    if (!MK_SPLIT) bar = xcd_barrier_post((unsigned*)(F.ctl + CW_BAR), F.MISC + 8);
    const int lo = args.ph_lo, hi = args.ph_hi;
#define PF() Frame Fp = F; { int t_ = threadIdx.x; asm volatile("" : "+v"(t_)); Fp.tid = t_; Fp.lane = t_ & 63; int w_ = F.wave, b_ = F.bid; asm volatile("" : "+s"(w_), "+s"(b_)); Fp.wave = w_; Fp.bid = b_; }
#define IN(k) ((((unsigned long long)MK_PHMASK >> (k)) & 1ull) && lo <= (k) && (k) < hi)
#define DUP(k) ((((unsigned long long)MK_DUPMASK >> (k)) & 1ull) ? 2 : 1)
#define SEAM(k) do { if (!MK_SPLIT && IN((k) + 1)) xcd_barrier(bar); } while (0)
    unsigned char* ws = args.ws; float* out = args.out;
    const int gw = F.bid * NWAVES + F.wave, NGW = F.G * NWAVES;
    LAS unsigned char* glds = F.lds;
    bf16* XN = (bf16*)(ws + WS_XN);

    if (IN(0)) { PF();
#pragma unroll 1
        for (int rep = 0; rep < DUP(0); ++rep) p0_prologue(Fp, args);
        SEAM(0); }
    if (IN(1)) {
        PF();
#pragma unroll 1
        for (int rep = 0; rep < DUP(1); ++rep) {
        if (F.bid == 0) { float* part = (float*)(ws + WS_CMPB_PART); float s = 0.f; for (int ic = 0; ic < 64; ++ic) s += part[(size_t)((Fp.tid >> 8) * 64 + ic) * 256 + (Fp.tid & 255)]; ((float*)(ws + WS_CMPB))[Fp.tid] = s; }
        { pg8::Gemm g{XN, (const bf16*)(ws + WS_W_EVIN), M, EV_INP, D, D, D}; pg8::StaticOrder S; S.init(M, EV_INP, F.G, F.bid);
          pg8::EpiEvIn E{(bf16*)(ws + WS_Y0), EV_INP, (bf16*)(ws + WS_KV6), SEQ};
          pg8::gemm_phase<pg8::EpiEvIn, pg8::StaticOrder, PG8_ALIGN, PG8_SP2>(glds, g, S, E); }
#pragma unroll 1
        for (int l = 0; l < 2; ++l) { pg8::Gemm g{(const bf16*)(ws + WS_MEMN) + (size_t)l * MMEM * D, (const bf16*)(ws + WS_W_XKV) + (size_t)l * 1024 * D, MMEM, 1024, D, D, D};
          pg8::ListOrder S; S.init(2, 4, 8, F.bid - 192 - 8 * l);
          pg8::EpiBf16<0> E{(bf16*)(ws + WS_KVM) + (size_t)l * MMEM * 1024, 1024, nullptr, nullptr};
          pg8::gemm_phase<pg8::EpiBf16<0>, pg8::ListOrder, PG8_ALIGN, PG8_SP2>(glds, g, S, E); }
        }
        SEAM(1);
    }
    if (IN(2)) {
        PF();
#pragma unroll 1
        for (int rep = 0; rep < DUP(2); ++rep) {
        if (F.bid < 128) { rglru_unit(Fp, args, F.bid >> 6, (F.bid >> 3) & 7, F.bid & 7);
        }
        else if (F.bid < 144) { const int mm = (F.bid - 128) >> 3;
            pg8::Gemm g{(const bf16*)(ws + WS_KV6) + (size_t)mm * 4 * SEQ * 128, (const bf16*)(ws + (mm ? WS_W_CV1 : WS_W_CK1)), 2048, 256, 4096, 2048, 4096};
            pg8::ListOrder S; S.init(8, 1, 8, (F.bid - 128) & 7);
            pg8::EpiBf16<1> E{(bf16*)(ws + WS_HID) + (size_t)mm * 2048 * 256, 256, (const float*)(ws + WS_CMPB) + mm * 256, nullptr};
            pg8::gemm_phase<pg8::EpiBf16<1>, pg8::ListOrder, PG8_ALIGN, PG8_SP2>(glds, g, S, E);
#ifdef MK_DUP_CMP1
            pg8::gemm_phase<pg8::EpiBf16<1>, pg8::ListOrder, PG8_ALIGN, PG8_SP2>(glds, g, S, E);
#endif
            VM_WAIT(); __syncthreads(); { const int u0 = mm * 64 + ((F.bid - 128) & 7) * 8; phase_cmp2(Fp, args, u0, u0 + 8, 1); }
        }
        else if (rep == 0) { const int gw2 = (F.bid - 144) * NWAVES + F.wave, NGW2 = (F.G - 144) * NWAVES;
            bf16* ks = (bf16*)(ws + WS_KV6) + (size_t)2 * 4 * SEQ * 128; bf16* kw = (bf16*)(ws + WS_KV6) + (size_t)4 * 4 * SEQ * 128;
            norm128_rows(Fp, ks, 128, ks, 128, 4 * SEQ, args.in[I_KNORM] + 128, gw2, NGW2);
            norm128_rows(Fp, kw, 128, kw, 128, 4 * SEQ, args.in[I_KNORM] + 256, gw2, NGW2);
            phase_memk_norm(Fp, args, 0, gw2, NGW2); phase_memk_norm(Fp, args, 1, gw2, NGW2); convert_range(Fp, args, gw2, NGW2, CONV_A, CONV_P2_END);
#ifdef MK_DUP_P2CONV
            convert_range(Fp, args, gw2, NGW2, CONV_A + (CONV_P2_END - CONV_A) / 2, CONV_P2_END);
#endif
        }
        }
        SEAM(2);
    }
    if (IN(4)) { PF();
#pragma unroll 1
        for (int rep = 0; rep < DUP(4); ++rep) phase_nsa(Fp, args);
        SEAM(4); }
    if (IN(5)) {
        pg8::Gemm g{(const bf16*)(ws + WS_MIX), (const bf16*)(ws + WS_W_EVOUT), M, D, 2048, 2048, 2048}; pg8::StaticOrder S; S.init(M, D, F.G, F.bid);
#pragma unroll 1
        for (int rep = 0; rep < DUP(5); ++rep) { pg8::EpiResidB<true> E{args.in[I_X], (rep + 1 < DUP(5)) ? (bf16*)(ws + WS_R + 400 * MiB) : XN, D, (float*)(ws + WS_SSQ)};
        pg8::gemm_phase<pg8::EpiResidB<true>, pg8::StaticOrder, PG8_ALIGN, PG8_SP2>(glds, g, S, E); }
        SEAM(5);
#ifdef MK_PROBE_BARS
#pragma unroll 1
        for (int xb = 0; xb < MK_PROBE_BARS; ++xb) xcd_barrier(bar);
#endif
    }
#pragma unroll 1
    for (int l = 0; l < 2; ++l) {
        const int pb = l == 0 ? 6 : 21;
        if (IN(pb + 1)) { pg8::Gemm g{XN, (const bf16*)(ws + WS_W_XQ) + (size_t)l * 512 * D, M, 512, D, D, D}; pg8::StaticOrder S; S.init(M, 512, F.G, F.bid);
            pg8::fill_rstd_table((LAS float*)(F.lds + MOE_TAB), S, (const float*)(ws + WS_SSQ), F.tid);
            pg8::EpiBf16<0> E{(bf16*)(ws + WS_QX), 512, nullptr, (const LAS float*)(F.lds + MOE_TAB)};
#pragma unroll 1
            for (int rep = 0; rep < DUP(7); ++rep) pg8::gemm_phase<pg8::EpiBf16<0>, pg8::StaticOrder, PG8_ALIGN, PG8_SP2>(glds, g, S, E);
            if (F.bid >= 128) { PF(); const int lo_ = CONV_ALL - (2 - l) * CONV_Q;
                convert_range(Fp, args, (F.bid - 128) * NWAVES + F.wave, (F.G - 128) * NWAVES, lo_, lo_ + CONV_Q); }
            SEAM(pb + 1); }
        if (IN(pb + 2)) { PF();
#pragma unroll 1
            for (int rep = 0; rep < DUP(8); ++rep) phase_cross_attn(Fp, args, l);
            SEAM(pb + 2); }
        if (IN(pb + 3)) { pg8::Gemm g{(const bf16*)(ws + WS_OX), (const bf16*)(ws + WS_W_XO) + (size_t)l * D * 512, M, D, 512, 512, 512}; pg8::StaticOrder S; S.init(M, D, F.G, F.bid);
#pragma unroll 1
            for (int rep = 0; rep < DUP(9); ++rep) { pg8::EpiResidB<false> E{XN, (rep + 1 < DUP(9)) ? (bf16*)(ws + WS_R + 400 * MiB) : XN, D, (float*)(ws + WS_SSQ)};
            pg8::gemm_phase<pg8::EpiResidB<false>, pg8::StaticOrder, PG8_ALIGN, PG8_SP2>(glds, g, S, E); }
            SEAM(pb + 3); }
        if (l == 0) {
            if (IN(11)) { pg8::Gemm g{XN, (const bf16*)(ws + WS_W_FF13), M, 2 * FF, D, D, D}; pg8::StaticOrder S; S.init(M, 2 * FF, F.G, F.bid);
                pg8::fill_rstd_table((LAS float*)(F.lds + MOE_TAB), S, (const float*)(ws + WS_SSQ), F.tid);
                pg8::EpiSwiglu<false> E{(bf16*)(ws + WS_H), FF, (const LAS float*)(F.lds + MOE_TAB)};
#ifdef MK_PROBE_NULLEPI
                { pg8::EpiNull EN; pg8::gemm_phase<pg8::EpiNull, pg8::StaticOrder, PG8_ALIGN, PG8_SP2>(glds, g, S, EN); }
#endif
#pragma unroll 1
                for (int rep = 0; rep < DUP(11); ++rep) pg8::gemm_phase<pg8::EpiSwiglu<false>, pg8::StaticOrder, PG8_ALIGN, PG8_SP2>(glds, g, S, E);
                SEAM(11); }
            if (IN(12)) { pg8::Gemm g{(const bf16*)(ws + WS_H), (const bf16*)(ws + WS_W_FF2), M, D, FF, FF, FF}; pg8::StaticOrder S; S.init(M, D, F.G, F.bid);
#pragma unroll 1
                for (int rep = 0; rep < DUP(12); ++rep) { pg8::EpiResidB<false> E{XN, (rep + 1 < DUP(12)) ? (bf16*)(ws + WS_R + 400 * MiB) : XN, D, (float*)(ws + WS_SSQ)};
                pg8::gemm_phase<pg8::EpiResidB<false>, pg8::StaticOrder, PG8_ALIGN, PG8_SP2>(glds, g, S, E); }
                SEAM(12); }
            if (IN(14)) { pg8::Gemm g{XN, (const bf16*)(ws + WS_W_ODIN), M, 5120, D, D, D}; pg8::StaticOrder S; S.init(M, 5120, F.G, F.bid);
                pg8::fill_rstd_table((LAS float*)(F.lds + MOE_TAB), S, (const float*)(ws + WS_SSQ), F.tid);
                pg8::EpiBf16<0> E{(bf16*)(ws + WS_Y1), OD_INP, nullptr, (const LAS float*)(F.lds + MOE_TAB)};
#pragma unroll 1
                for (int rep = 0; rep < DUP(14); ++rep) pg8::gemm_phase<pg8::EpiBf16<0>, pg8::StaticOrder, PG8_ALIGN, PG8_SP2>(glds, g, S, E);
                od_dt_cols(F, XN, (const bf16*)(ws + WS_W_ODIN), (const float*)(ws + WS_SSQ), (bf16*)(ws + WS_Y1));
                SEAM(14); }
            if (IN(15)) { PF();
#pragma unroll 1
                for (int rep = 0; rep < DUP(15); ++rep) phase_mamba_prep(Fp, args);
                SEAM(15); }
            if (IN(16)) { PF();
#pragma unroll 1
                for (int rep = 0; rep < DUP(16); ++rep) phase_mamba_states(Fp);
                SEAM(16); }
            if (IN(17)) { PF();
#pragma unroll 1
                for (int rep = 0; rep < DUP(17); ++rep) phase_mamba_scan(Fp);
                SEAM(17); }
            if (IN(18)) { PF();
#pragma unroll 1
                for (int rep = 0; rep < DUP(18); ++rep) phase_mamba_out(Fp, args);
                SEAM(18); }
            if (IN(20)) { pg8::Gemm g{(const bf16*)(ws + WS_YG), (const bf16*)(ws + WS_W_ODOUT), M, D, 2048, 2048, 2048}; pg8::StaticOrder S; S.init(M, D, F.G, F.bid);
#pragma unroll 1
                for (int rep = 0; rep < DUP(20); ++rep) { pg8::EpiResidB<false> E{XN, (rep + 1 < DUP(20)) ? (bf16*)(ws + WS_R + 400 * MiB) : XN, D, (float*)(ws + WS_SSQ)};
                pg8::gemm_phase<pg8::EpiResidB<false>, pg8::StaticOrder, PG8_ALIGN, PG8_SP2>(glds, g, S, E); }
                SEAM(20); }
        }
    }
    if (IN(25)) { PF();
#pragma unroll 1
        for (int rep = 0; rep < DUP(25); ++rep) phase_route(Fp, args, XN);
        SEAM(25); }
    if (IN(26)) { PF();
#pragma unroll 1
        for (int rep = 0; rep < DUP(26); ++rep) phase_scatter(Fp);
        SEAM(26); }
    if (IN(27)) { PF(); moe_layout(Fp); const LAS int* tab = (const LAS int*)(F.lds + MOE_TAB);
        pg8::Gemm g{(const bf16*)(ws + WS_XP), (const bf16*)(ws + WS_W_M13), MOE_ROWS, 2 * FFE, D / 2, D / 2, D / 2}  ; MoeOrderX S{tab[24], 2 * FFE / 256, tab[24] * (2 * FFE / 256), F.G, F.bid, tab + 32};
        pg8::EpiSwiglu<true, false, true> E{(bf16*)(ws + WS_HP), FFE, nullptr, 1.f / MOE_W13_SCALE};
#pragma unroll 1
        for (int rep = 0; rep < DUP(27); ++rep) pg8::gemm_phase<pg8::EpiSwiglu<true, false, true>, MoeOrderX, PG8_ALIGN, PG8_SP2, true>(glds, g, S, E);
        SEAM(27); }
    if (IN(28)) { PF(); moe_layout(Fp); const LAS int* tab = (const LAS int*)(F.lds + MOE_TAB);
        const MoeTail mt = moe_tail(tab, F.G);
        pg8::Gemm g{(const bf16*)(ws + WS_HP), (const bf16*)(ws + WS_W_M2), MOE_ROWS, D, FFE / 2, FFE / 2, FFE / 2}  ; MoeOrder S{D / 256, mt.split ? mt.R * F.G : tab[24] * (D / 256), F.G, F.bid, tab + 32};
        pg8::EpiBf16<0> E{(bf16*)(ws + WS_YP), D, nullptr, nullptr};
#pragma unroll 1
        for (int rep = 0; rep < DUP(28); ++rep) pg8::gemm_phase<pg8::EpiBf16<0>, MoeOrder, PG8_ALIGN, PG8_SP2, true>(glds, g, S, E);
        if (mt.split) {
            const int piece = F.bid, L = mt.R * F.G + (piece >> 1), kq = piece & 1, pm = L / 4, pn = L % 4;
            MoeTailOrder S2{pm, pn, piece < mt.Lo * 2 ? tab[32 + pm] * 4 + pn : 0, piece < mt.Lo * 2};
            pg8::Gemm g2{(const bf16*)(ws + WS_HP) + kq * (FFE / 4), (const bf16*)(ws + WS_W_M2) + kq * (FFE / 4), MOE_ROWS, D, FFE / 4, FFE / 2, FFE / 2};
            pg8::EpiF32 E2{(float*)(ws + WS_XP) + (size_t)kq * MOE_PART_STRIDE - (size_t)mt.pm_min * 256 * D, D};
            pg8::gemm_phase<pg8::EpiF32, MoeTailOrder, PG8_ALIGN, PG8_SP2, true>(glds, g2, S2, E2); }
        SEAM(28); }
    if (IN(29)) { PF();
#pragma unroll 1
        for (int rep = 0; rep < DUP(29); ++rep) phase_moe_combine(Fp, XN, (rep + 1 < DUP(29)) ? (float*)(ws + WS_R + 400 * MiB) : out); }
#undef IN
#undef SEAM
}

extern "C" void kernel_launch(void* const* d_in, const int* in_sizes, int n_in, void* d_out, int out_size, void* d_ws, size_t ws_size, hipStream_t stream) {
    static int grid = 0;
    if (grid == 0) {
        if (n_in != N_IN || in_sizes[0] != M * D || out_size != M * D || ws_size < (WS_M_END > WS_END ? WS_M_END : WS_END)) { fprintf(stderr, "kernel_launch: unexpected problem (n_in %d, in0 %d, out %d, ws %zu < %zu); nothing launched\n", n_in, n_in > 0 ? in_sizes[0] : -1, out_size, ws_size, (size_t)WS_END); grid = -1; return; }
        int dev = 0, cus = 0, per_cu = 0;
        if (hipGetDevice(&dev) != hipSuccess || hipDeviceGetAttribute(&cus, hipDeviceAttributeMultiprocessorCount, dev) != hipSuccess) { fprintf(stderr, "kernel_launch: device query failed\n"); grid = -1; return; }
        if (hipFuncSetAttribute((const void*)mega_fwd, hipFuncAttributeMaxDynamicSharedMemorySize, LDS_BYTES) != hipSuccess) { fprintf(stderr, "kernel_launch: hipFuncSetAttribute(%d B LDS) failed\n", LDS_BYTES); grid = -1; return; }
        if (hipOccupancyMaxActiveBlocksPerMultiprocessor(&per_cu, (const void*)mega_fwd, NTHR, LDS_BYTES) != hipSuccess || per_cu < 1) fprintf(stderr, "kernel_launch: note: occupancy query reports %d workgroups per CU\n", per_cu);
        (void)hipGetLastError();
        if (cus < 256) { fprintf(stderr, "kernel_launch: %d CUs < 256: the persistent grid of 256 workgroups would not be resident; nothing launched\n", cus); grid = -1; return; }
        grid = 256;
    }
    if (grid < 0) return;
    if (hipMemsetAsync((char*)d_ws + WS_CTL, 0, CTL_ZERO_BYTES, stream) != hipSuccess) { fprintf(stderr, "kernel_launch: memset failed\n"); return; }
    Args a{};
    for (int i = 0; i < N_IN; ++i) a.in[i] = (const float*)d_in[i];
    a.out = (float*)d_out; a.ws = (unsigned char*)d_ws;
#if MK_SPLIT
    for (int p = 0; p <= MK_LAST_PHASE && p < N_PHASES; ++p) { a.ph_lo = p; a.ph_hi = p + 1; a.li = p; hipLaunchKernelGGL(mega_fwd, dim3(grid), dim3(NTHR), LDS_BYTES, stream, a); }
#else
    a.ph_lo = 0; a.ph_hi = MK_LAST_PHASE + 1; a.li = 0;
    hipLaunchKernelGGL(mega_fwd, dim3(grid), dim3(NTHR), LDS_BYTES, stream, a);
#endif
    const hipError_t le = hipPeekAtLastError();
    if (le != hipSuccess) fprintf(stderr, "kernel_launch: launch failed: %s\n", hipGetErrorName(le));
}
```

```cpp
#include <hip/hip_runtime.h>
#include <cstdio>
#include <cstdint>

namespace pg8 {
#define PG8_LAS __attribute__((address_space(3)))
typedef unsigned short bf16_t;
typedef short bf16x8 __attribute__((ext_vector_type(8)));
typedef float f32x4 __attribute__((ext_vector_type(4)));
typedef unsigned u32x4 __attribute__((ext_vector_type(4)));
typedef unsigned u32x2 __attribute__((ext_vector_type(2)));
constexpr int BM = 256, BK = 64, HALF = 128, HTB = HALF * BK * 2  , STAGE_BYTES = 8 * HTB, NXCD = 8, WGM = 8;

__host__ __device__ __forceinline__ int lds_byte(int r, int c) { const int st = (r >> 4) * 2 + (c >> 5), rr = r & 15, cc = c & 31, ob = rr * 64 + cc * 2; return st * 1024 + (ob ^ (((ob >> 9) & 1) << 5)); }
__host__ __device__ __forceinline__ void stage_rc(int b, int& R, int& C) { const int st = b / 1024, sb = b % 1024, swz = sb ^ (((sb >> 9) & 1) << 5); R = (st >> 1) * 16 + swz / 64; C = (st & 1) * 32 + (swz % 64) / 2; }
__host__ __device__ __forceinline__ int perm32(int rho) { const int n = rho >> 4, i = rho & 15; return 8 * (i >> 2) + 4 * n + (i & 3); }

typedef int i32x8 __attribute__((ext_vector_type(8)));
typedef int i32x4 __attribute__((ext_vector_type(4)));
__device__ __forceinline__ i32x8 cat8(bf16x8 lo, bf16x8 hi) { const i32x4 a = __builtin_bit_cast(i32x4, lo), b = __builtin_bit_cast(i32x4, hi); return __builtin_shufflevector(a, b, 0, 1, 2, 3, 4, 5, 6, 7); }
__device__ __forceinline__ void mfma_f8_inplace(f32x4& acc, i32x8 a, i32x8 b) { asm volatile("v_mfma_f32_16x16x128_f8f6f4 %0, %1, %2, %0" : "+v"(acc) : "v"(a), "v"(b)); }
struct Unit { int pm, pn, bn, idx; };
struct Gemm { const bf16_t* A; const bf16_t* Bt; int M, N, K, lda, ldb; };

struct StaticOrder {
    int nM, nN, nwg, G, c;
    __host__ __device__ void init(int M, int N, int G_, int c_) { nM = M / BM; nN = N / BM; nwg = nM * nN; G = G_; c = c_; }
    __host__ __device__ bool next(int i, Unit& u) const {
        const long L = (long)i * G + c; if (L >= nwg) return false;
        int wgid = (int)L; { const int q = nwg / NXCD, r = nwg % NXCD, xcd = wgid % NXCD, off = wgid / NXCD; wgid = (xcd < r ? xcd * (q + 1) : r * (q + 1) + (xcd - r) * q) + off; }
        const int nig = WGM * nN, gid = wgid / nig, fm = gid * WGM, gsz = (nM - fm) < WGM ? (nM - fm) : WGM;
        u.pm = fm + ((wgid % nig) % gsz); u.pn = (wgid % nig) / gsz; u.bn = u.pn; u.idx = i; return true;
    }
    __device__ __forceinline__ void a_ready(const Unit&) const {}
    __device__ __forceinline__ void done(const Unit&) const {}
};
struct ListOrder {
    int nN, nwg, G, c;
    __host__ __device__ void init(int nM_, int nN_, int G_, int c_) { nN = nN_; nwg = nM_ * nN_; G = G_; c = c_; }
    __host__ __device__ bool next(int i, Unit& u) const { const long L = (long)i * G + c; if (c < 0 || L >= nwg) return false; u.pm = (int)(L / nN); u.pn = (int)(L % nN); u.bn = u.pn; u.idx = i; return true; }
    __device__ __forceinline__ void a_ready(const Unit&) const {}
    __device__ __forceinline__ void done(const Unit&) const {}
};

__device__ __forceinline__ unsigned cvt_pk_bf16(float lo, float hi) { unsigned r; asm volatile("v_cvt_pk_bf16_f32 %0, %1, %2" : "=v"(r) : "v"(lo), "v"(hi)); return r; }
__device__ __forceinline__ unsigned cvt4_fp8(float a, float b, float c, float d) { int r = __builtin_amdgcn_cvt_pk_fp8_f32(a, b, 0, false); r = __builtin_amdgcn_cvt_pk_fp8_f32(c, d, r, true); return (unsigned)r; }
__device__ __forceinline__ float fsigmoid(float x) { return __builtin_amdgcn_rcpf(1.0f + __expf(-x)); }
__device__ __forceinline__ float gelu_tanh(float x) { const float u = 1.5957691216f * (x + 0.044715f * x * x * x); return x * fsigmoid(u); }
__device__ __forceinline__ float fsilu(float x) { return x * fsigmoid(x); }

__device__ __forceinline__ float row_rstd(const float* ssq, int row) {
    const f32x4 a = *(const f32x4*)(ssq + (size_t)row * 16), b = *(const f32x4*)(ssq + (size_t)row * 16 + 4), c = *(const f32x4*)(ssq + (size_t)row * 16 + 8), d = *(const f32x4*)(ssq + (size_t)row * 16 + 12);
    const f32x4 s = (a + b) + (c + d); return 1.0f / sqrtf(((s[0] + s[1]) + (s[2] + s[3])) * (1.0f / 1024.0f) + 1e-6f);
}
template <class Sched> __device__ __forceinline__ void fill_rstd_table(PG8_LAS float* tab, const Sched& S, const float* ssq, int tid) {
    Unit u; for (int i = 0; S.next(i, u); ++i) if (tid < 256) { const int ai = tid >> 7, wr = (tid >> 6) & 1, m = (tid >> 4) & 3, fr = tid & 15; tab[i * 256 + ((ai * 2 + wr) * 16 + fr) * 4 + m] = row_rstd(ssq, u.pm * BM + tid); }
    __syncthreads();
}
template <int ACT, bool SPLIT_ = false> struct EpiBf16 {
    static constexpr bool PERM = true, AFTER_DRAIN = false, SPLIT = SPLIT_, PACK = false; static constexpr int NST = 16; struct Pk {};
    bf16_t* O; int ldc; const float* bias; const PG8_LAS float* rsT;
    __device__ __forceinline__ void operator()(const f32x4 (&acc)[2][2][4][2], const Unit& u, int wr, int wc, int fr, int fq) const { half<0>(acc, u, wr, wc, fr, fq); half<1>(acc, u, wr, wc, fr, fq); }
    template <int AI> __device__ __forceinline__ void half(const f32x4 (&acc)[2][2][4][2], const Unit& u, int wr, int wc, int fr, int fq) const {
        const int row0 = u.pm * BM + wr * 64 + fr; const int col0 = u.pn * BM + wc * 32 + 8 * fq;
        f32x4 bv[2][2];
#pragma unroll
        for (int bj = 0; bj < 2; ++bj)
#pragma unroll
            for (int n = 0; n < 2; ++n) bv[bj][n] = bias ? *(const f32x4*)(bias + col0 + bj * HALF + 4 * n) : (f32x4){0.f, 0.f, 0.f, 0.f};
        { constexpr int ai = AI; const f32x4 rs4 = rsT ? *(const PG8_LAS f32x4*)(rsT + u.idx * 256 + ((ai * 2 + wr) * 16 + fr) * 4) : (f32x4){1.f, 1.f, 1.f, 1.f};
#pragma unroll
            for (int m = 0; m < 4; ++m) { bf16_t* rowp = O + (size_t)(row0 + ai * HALF + m * 16) * ldc + col0; const float rs = rs4[m];
#pragma unroll
                for (int bj = 0; bj < 2; ++bj) { f32x4 v0 = acc[ai][bj][m][0] * rs + bv[bj][0], v1 = acc[ai][bj][m][1] * rs + bv[bj][1];
                    if (ACT == 1) {
#pragma unroll
                        for (int j = 0; j < 4; ++j) { v0[j] = gelu_tanh(v0[j]); v1[j] = gelu_tanh(v1[j]); } }
                    u32x4 w; w.x = cvt_pk_bf16(v0[0], v0[1]); w.y = cvt_pk_bf16(v0[2], v0[3]); w.z = cvt_pk_bf16(v1[0], v1[1]); w.w = cvt_pk_bf16(v1[2], v1[3]);
                    *(u32x4*)(rowp + bj * HALF) = w; } } }
    }
};
struct EpiEvIn {
    static constexpr bool PERM = true, AFTER_DRAIN = false, SPLIT = true, PACK = false; static constexpr int NST = 16; struct Pk {};
    bf16_t* O; int ldc; bf16_t* KV6; int S;
    __device__ __forceinline__ void operator()(const f32x4 (&acc)[2][2][4][2], const Unit& u, int wr, int wc, int fr, int fq) const { half<0>(acc, u, wr, wc, fr, fq); half<1>(acc, u, wr, wc, fr, fq); }
    template <int AI> __device__ __forceinline__ void half(const f32x4 (&acc)[2][2][4][2], const Unit& u, int wr, int wc, int fr, int fq) const {
        const int row0 = u.pm * BM + wr * 64 + fr; const int col0 = u.pn * BM + wc * 32 + 8 * fq;
        const bool kv = (u.pn >= 12 && u.pn < 18);
        { constexpr int ai = AI;
#pragma unroll
            for (int m = 0; m < 4; ++m) { const int row = row0 + ai * HALF + m * 16;
#pragma unroll
                for (int bj = 0; bj < 2; ++bj) { const f32x4 v0 = acc[ai][bj][m][0], v1 = acc[ai][bj][m][1];
                    u32x4 w; w.x = cvt_pk_bf16(v0[0], v0[1]); w.y = cvt_pk_bf16(v0[2], v0[3]); w.z = cvt_pk_bf16(v1[0], v1[1]); w.w = cvt_pk_bf16(v1[2], v1[3]);
                    if (kv) { const int b = row / S, t = row - b * S;
                        bf16_t* p = KV6 + ((((size_t)(u.pn - 12) * 2 + b) * 2 + bj) * S + t) * 128 + wc * 32 + 8 * fq; *(u32x4*)p = w; }
                    else *(u32x4*)(O + (size_t)row * ldc + col0 + bj * HALF) = w; } } }
    }
};
struct EpiResid {
    static constexpr bool PERM = false, AFTER_DRAIN = false, SPLIT = false, PACK = false; static constexpr int NST = 0; struct Pk {};
    const float* base; float* out; int ldc;
    __device__ __forceinline__ void operator()(const f32x4 (&acc)[2][2][4][2], const Unit& u, int wr, int wc, int fr, int fq) const {
        const int row0 = u.pm * BM + wr * 64 + fr, col0 = u.pn * BM + wc * 32 + 4 * fq;
#pragma unroll
        for (int ai = 0; ai < 2; ++ai)
#pragma unroll
            for (int m = 0; m < 4; ++m) { const size_t off = (size_t)(row0 + ai * HALF + m * 16) * ldc + col0;
#pragma unroll
                for (int bj = 0; bj < 2; ++bj)
#pragma unroll
                    for (int n = 0; n < 2; ++n) { const f32x4 b = *(const f32x4*)(base + off + bj * HALF + n * 16); *(f32x4*)(out + off + bj * HALF + n * 16) = b + acc[ai][bj][m][n]; } }
    }
};
struct EpiResidN {
    static constexpr bool PERM = false, AFTER_DRAIN = false, SPLIT = false, PACK = false; static constexpr int NST = 0; struct Pk {};
    const float* base; float* out; int ldc; bf16_t* XB; float* SSQ;
    __device__ __forceinline__ void operator()(const f32x4 (&acc)[2][2][4][2], const Unit& u, int wr, int wc, int fr, int fq) const {
        const int row0 = u.pm * BM + wr * 64 + fr, col0 = u.pn * BM + wc * 32 + 4 * fq;
#pragma unroll
        for (int ai = 0; ai < 2; ++ai)
#pragma unroll
            for (int m = 0; m < 4; ++m) { const int row = row0 + ai * HALF + m * 16; const size_t off = (size_t)row * ldc + col0; float ss = 0.f;
#pragma unroll
                for (int bj = 0; bj < 2; ++bj)
#pragma unroll
                    for (int n = 0; n < 2; ++n) { const f32x4 b = *(const f32x4*)(base + off + bj * HALF + n * 16); const f32x4 v = b + acc[ai][bj][m][n]; *(f32x4*)(out + off + bj * HALF + n * 16) = v;
                        if (XB) { u32x2 w; w.x = cvt_pk_bf16(v[0], v[1]); w.y = cvt_pk_bf16(v[2], v[3]); *(u32x2*)(XB + off + bj * HALF + n * 16) = w; }
                        ss += (v[0] * v[0] + v[1] * v[1]) + (v[2] * v[2] + v[3] * v[3]); }
                ss += __shfl_xor(ss, 16); ss += __shfl_xor(ss, 32);
                if (XB && fq == 0) SSQ[(size_t)row * 16 + u.pn * 4 + wc] = ss; }
    }
};
template <bool BASE_F32> struct EpiResidB {
    static constexpr bool PERM = true, AFTER_DRAIN = false, SPLIT = false, PACK = false; static constexpr int NST = 0; struct Pk {};
    const void* base; bf16_t* X; int ldc; float* SSQ;
    __device__ __forceinline__ void operator()(const f32x4 (&acc)[2][2][4][2], const Unit& u, int wr, int wc, int fr, int fq) const {
        const int row0 = u.pm * BM + wr * 64 + fr, col0 = u.pn * BM + wc * 32 + 8 * fq;
#pragma unroll
        for (int ai = 0; ai < 2; ++ai) {
            f32x4 bq[4][2][2]; u32x4 br[4][2];
#pragma unroll
            for (int m = 0; m < 4; ++m)
#pragma unroll
                for (int bj = 0; bj < 2; ++bj) { const size_t off = (size_t)(row0 + ai * HALF + m * 16) * ldc + col0 + bj * HALF;
                    if constexpr (BASE_F32) { bq[m][bj][0] = *(const f32x4*)((const float*)base + off); bq[m][bj][1] = *(const f32x4*)((const float*)base + off + 4); }
                    else br[m][bj] = *(const u32x4*)((const bf16_t*)base + off); }
#pragma unroll
            for (int m = 0; m < 4; ++m) { const int row = row0 + ai * HALF + m * 16; const size_t off = (size_t)row * ldc + col0; float ss = 0.f;
#pragma unroll
                for (int bj = 0; bj < 2; ++bj) { f32x4 b0, b1;
                    if constexpr (BASE_F32) { b0 = bq[m][bj][0]; b1 = bq[m][bj][1]; }
                    else { const u32x4 r = br[m][bj];
                        b0 = (f32x4){__builtin_bit_cast(float, r.x << 16), __builtin_bit_cast(float, r.x & 0xffff0000u), __builtin_bit_cast(float, r.y << 16), __builtin_bit_cast(float, r.y & 0xffff0000u)};
                        b1 = (f32x4){__builtin_bit_cast(float, r.z << 16), __builtin_bit_cast(float, r.z & 0xffff0000u), __builtin_bit_cast(float, r.w << 16), __builtin_bit_cast(float, r.w & 0xffff0000u)}; }
                    const f32x4 v0 = b0 + acc[ai][bj][m][0], v1 = b1 + acc[ai][bj][m][1];
                    u32x4 w; w.x = cvt_pk_bf16(v0[0], v0[1]); w.y = cvt_pk_bf16(v0[2], v0[3]); w.z = cvt_pk_bf16(v1[0], v1[1]); w.w = cvt_pk_bf16(v1[2], v1[3]);
                    *(u32x4*)(X + off + bj * HALF) = w;
                    ss += ((v0[0] * v0[0] + v0[1] * v0[1]) + (v0[2] * v0[2] + v0[3] * v0[3])) + ((v1[0] * v1[0] + v1[1] * v1[1]) + (v1[2] * v1[2] + v1[3] * v1[3])); }
                ss += __shfl_xor(ss, 16); ss += __shfl_xor(ss, 32);
                if (fq == 0) SSQ[(size_t)row * 16 + u.pn * 4 + wc] = ss; } }
    }
};
struct EpiNull {
    static constexpr bool PERM = false, AFTER_DRAIN = false, SPLIT = false, PACK = false; static constexpr int NST = 0; struct Pk {};
    __device__ __forceinline__ void operator()(const f32x4 (&acc)[2][2][4][2], const Unit&, int, int, int, int) const {
#pragma unroll
        for (int ai = 0; ai < 2; ++ai)
#pragma unroll
            for (int bj = 0; bj < 2; ++bj)
#pragma unroll
                for (int m = 0; m < 4; ++m)
#pragma unroll
                    for (int n = 0; n < 2; ++n) asm volatile("" :: "v"(acc[ai][bj][m][n]));
    }
};
struct EpiF32 {
    static constexpr bool PERM = false, AFTER_DRAIN = false, SPLIT = false, PACK = false; static constexpr int NST = 0; struct Pk {};
    float* C; int ldc;
    __device__ __forceinline__ void operator()(const f32x4 (&acc)[2][2][4][2], const Unit& u, int wr, int wc, int fr, int fq) const {
        const int row0 = u.pm * BM + wr * 64 + fr, col0 = u.pn * BM + wc * 32 + 4 * fq;
#pragma unroll
        for (int ai = 0; ai < 2; ++ai)
#pragma unroll
            for (int m = 0; m < 4; ++m) { float* rowp = C + (size_t)(row0 + ai * HALF + m * 16) * ldc + col0;
#pragma unroll
                for (int bj = 0; bj < 2; ++bj)
#pragma unroll
                    for (int n = 0; n < 2; ++n) *(f32x4*)(rowp + bj * HALF + n * 16) = acc[ai][bj][m][n]; }
    }
};
template <bool SPLIT_, bool PACK_ = false, bool F8O_ = false> struct EpiSwiglu {
    static_assert(!(PACK_ && F8O_), "no packed fp8 form");
    static constexpr bool PERM = true, AFTER_DRAIN = false, SPLIT = SPLIT_, PACK = PACK_; static constexpr int NST = 8;
    bf16_t* H; int ldh; const PG8_LAS float* rsT; float sc = 1.f;
    __device__ __forceinline__ void operator()(const f32x4 (&acc)[2][2][4][2], const Unit& u, int wr, int wc, int fr, int fq) const { half<0>(acc, u, wr, wc, fr, fq); half<1>(acc, u, wr, wc, fr, fq); }
    struct Pk { u32x4 w[4]; };
    __device__ __forceinline__ void pack1(const f32x4 (&acc)[2][2][4][2], const Unit& u, int wr, int fr, Pk& pk) const {
        constexpr int ai = 1; const f32x4 rs4 = rsT ? *(const PG8_LAS f32x4*)(rsT + u.idx * 256 + ((ai * 2 + wr) * 16 + fr) * 4) : (f32x4){1.f, 1.f, 1.f, 1.f};
#pragma unroll
        for (int m = 0; m < 4; ++m) { const float rs = rs4[m] * sc;
            const f32x4 u0 = acc[ai][0][m][0] * rs, u1 = acc[ai][0][m][1] * rs, g0 = acc[ai][1][m][0] * rs, g1 = acc[ai][1][m][1] * rs;
            pk.w[m].x = cvt_pk_bf16(fsilu(g0[0]) * u0[0], fsilu(g0[1]) * u0[1]); pk.w[m].y = cvt_pk_bf16(fsilu(g0[2]) * u0[2], fsilu(g0[3]) * u0[3]);
            pk.w[m].z = cvt_pk_bf16(fsilu(g1[0]) * u1[0], fsilu(g1[1]) * u1[1]); pk.w[m].w = cvt_pk_bf16(fsilu(g1[2]) * u1[2], fsilu(g1[3]) * u1[3]); }
    }
    __device__ __forceinline__ void store1(const Pk& pk, const Unit& u, int wr, int wc, int fr, int fq) const {
        bf16_t* p = H + (size_t)(u.pm * BM + wr * 64 + fr + HALF) * ldh + u.pn * 128 + wc * 32 + 8 * fq;
#pragma unroll
        for (int m = 0; m < 4; ++m) *(u32x4*)(p + (size_t)(m * 16) * ldh) = pk.w[m];
    }
    template <int AI> __device__ __forceinline__ void half(const f32x4 (&acc)[2][2][4][2], const Unit& u, int wr, int wc, int fr, int fq) const {
        const int row0 = u.pm * BM + wr * 64 + fr, col0 = u.pn * 128 + wc * 32 + 8 * fq;
        constexpr int ai = AI; const f32x4 rs4 = rsT ? *(const PG8_LAS f32x4*)(rsT + u.idx * 256 + ((ai * 2 + wr) * 16 + fr) * 4) : (f32x4){1.f, 1.f, 1.f, 1.f};
#pragma unroll
        for (int m = 0; m < 4; ++m) { bf16_t* rowp = H + (size_t)(row0 + ai * HALF + m * 16) * ldh + col0; const float rs = rs4[m] * sc;
            const f32x4 u0 = acc[ai][0][m][0] * rs, u1 = acc[ai][0][m][1] * rs, g0 = acc[ai][1][m][0] * rs, g1 = acc[ai][1][m][1] * rs;
            if constexpr (F8O_) { u32x2 w; w.x = cvt4_fp8(fsilu(g0[0]) * u0[0], fsilu(g0[1]) * u0[1], fsilu(g0[2]) * u0[2], fsilu(g0[3]) * u0[3]);
                w.y = cvt4_fp8(fsilu(g1[0]) * u1[0], fsilu(g1[1]) * u1[1], fsilu(g1[2]) * u1[2], fsilu(g1[3]) * u1[3]);
                *(u32x2*)((unsigned char*)H + (size_t)(row0 + ai * HALF + m * 16) * ldh + col0) = w; }
            else { u32x4 w; w.x = cvt_pk_bf16(fsilu(g0[0]) * u0[0], fsilu(g0[1]) * u0[1]); w.y = cvt_pk_bf16(fsilu(g0[2]) * u0[2], fsilu(g0[3]) * u0[3]);
            w.z = cvt_pk_bf16(fsilu(g1[0]) * u1[0], fsilu(g1[1]) * u1[1]); w.w = cvt_pk_bf16(fsilu(g1[2]) * u1[2], fsilu(g1[3]) * u1[3]);
            *(u32x4*)rowp = w; } }
    }
};
__host__ __device__ __forceinline__ int swiglu_row(int h, int gate) { return (h >> 7) * 256 + gate * 128 + (h & 127); }

template <class Epi, class Sched, bool ALIGN_EPI = false, bool SP2 = false, bool F8 = false>
__device__ __forceinline__ void gemm_phase(PG8_LAS unsigned char* lds, const Gemm g, const Sched& S, const Epi& E) {
    int tid = threadIdx.x; asm volatile("" : "+v"(tid));
    const int wid = __builtin_amdgcn_readfirstlane(tid >> 6), lane = tid & 63, wr = wid >> 2, wc = wid & 3, fr = lane & 15, fq = lane >> 4;
    const int K = g.K, nt = K / BK;
    unsigned voffA, voffB;
    { int R, C; stage_rc(tid * 16, R, C); const int Rb = Epi::PERM ? ((R & ~31) + perm32(R & 31)) : R;
      voffA = (unsigned)(R * g.lda + C) * 2u; voffB = (unsigned)(Rb * g.ldb + C) * 2u; }
    const size_t q64A = (size_t)64 * g.lda * 2, q64B = (size_t)64 * g.ldb * 2;
    const size_t kstep = (size_t)(BK * 2);
    const size_t hstepA = (size_t)HALF * g.lda * 2, hstepB = (size_t)HALF * g.ldb * 2;
    const size_t tstepA = 2 * hstepA, tstepB = 2 * hstepB;
    const unsigned ldsw = (unsigned)wid * 1024u;
    const int aoff = lds_byte(wr * 64 + fr, fq * 8), boff = lds_byte(wc * 32 + fr, fq * 8);
#define PG8_SA(b, h) (((b) * 2 + (h)) * HTB)
#define PG8_SB(b, h) ((4 + (b) * 2 + (h)) * HTB)
#define PG8_STAGE(bufoff, gbase, voff) do { __builtin_amdgcn_global_load_lds((const unsigned*)((const char*)(gbase) + (voff)), (PG8_LAS unsigned*)(lds + (bufoff) + ldsw), 16, 0, 0); \
        __builtin_amdgcn_global_load_lds((const unsigned*)((const char*)(gbase) + PG8_Q64(voff) + (voff)), (PG8_LAS unsigned*)(lds + (bufoff) + ldsw + 8192), 16, 0, 0); } while (0)
#define PG8_Q64(v) PG8_Q64_##v
#define PG8_Q64_voffA q64A
#define PG8_Q64_voffB q64B
#define PG8_LDA(dst, b, h) do { _Pragma("unroll") for (int m = 0; m < 4; ++m) _Pragma("unroll") for (int k = 0; k < 2; ++k) dst[m][k] = *(const PG8_LAS bf16x8*)(lds + PG8_SA(b, h) + aoff + m * 2048 + k * 1024); } while (0)
#define PG8_LDB(dst, b, h) do { _Pragma("unroll") for (int n = 0; n < 2; ++n) _Pragma("unroll") for (int k = 0; k < 2; ++k) dst[n][k] = *(const PG8_LAS bf16x8*)(lds + PG8_SB(b, h) + boff + n * 2048 + k * 1024); } while (0)
#define PG8_MMA(ai, bj, At, Bt) do { __builtin_amdgcn_s_setprio(1); \
        if constexpr (F8) { _Pragma("unroll") for (int m = 0; m < 4; ++m) _Pragma("unroll") for (int n = 0; n < 2; ++n) \
            mfma_f8_inplace(acc[ai][bj][m][n], cat8(Bt[n][0], Bt[n][1]), cat8(At[m][0], At[m][1])); } \
        else { _Pragma("unroll") for (int m = 0; m < 4; ++m) _Pragma("unroll") for (int n = 0; n < 2; ++n) _Pragma("unroll") for (int k = 0; k < 2; ++k) \
            acc[ai][bj][m][n] = __builtin_amdgcn_mfma_f32_16x16x32_bf16(Bt[n][k], At[m][k], acc[ai][bj][m][n], 0, 0, 0); } \
        __builtin_amdgcn_s_setprio(0); } while (0)
#define PG8_WAIT_V(n) asm volatile("s_waitcnt vmcnt(" #n ")" ::: "memory")
#define PG8_WAIT_L(n) asm volatile("s_waitcnt lgkmcnt(" #n ")" ::: "memory")
#define PG8_WAIT_REL(NN) do { if (rel) asm volatile("s_waitcnt vmcnt(%0)" :: "n"(NN) : "memory"); else PG8_WAIT_V(8); } while (0)
#define PG8_BAR __builtin_amdgcn_s_barrier()
#define PG8_SCHED __builtin_amdgcn_sched_barrier(0)
    typename Epi::Pk pk; Unit cur, nxt, pend; int ui = 0; bool pending = false; pend.pm = pend.pn = pend.bn = pend.idx = 0;
    if (!S.next(0, cur)) return;
    f32x4 acc[2][2][4][2];
#pragma unroll
    for (int a = 0; a < 2; ++a)
#pragma unroll
        for (int b = 0; b < 2; ++b)
#pragma unroll
            for (int m = 0; m < 4; ++m)
#pragma unroll
                for (int n = 0; n < 2; ++n) acc[a][b][m][n] = (f32x4){0.f, 0.f, 0.f, 0.f};
    bf16x8 At[4][2], B0[2][2], B1[2][2];
    const char* cA = (const char*)g.A + (size_t)cur.pm * tstepA; const char* cB = (const char*)g.Bt + (size_t)cur.bn * tstepB;
    S.a_ready(cur);
    if constexpr (SP2) {
        PG8_STAGE(PG8_SB(0, 0), cB, voffB); PG8_STAGE(PG8_SB(0, 1), cB + hstepB, voffB); PG8_STAGE(PG8_SA(0, 0), cA, voffA); PG8_STAGE(PG8_SA(0, 1), cA + hstepA, voffA);
        if (wr == 1) PG8_BAR;
        PG8_WAIT_V(2); PG8_BAR;
        PG8_STAGE(PG8_SB(1, 0), cB + kstep, voffB); PG8_STAGE(PG8_SA(1, 0), cA + kstep, voffA); PG8_STAGE(PG8_SB(1, 1), cB + hstepB + kstep, voffB);
        PG8_WAIT_V(6); PG8_BAR;
    } else {
        PG8_STAGE(PG8_SB(0, 0), cB, voffB); PG8_STAGE(PG8_SA(0, 0), cA, voffA); PG8_STAGE(PG8_SB(0, 1), cB + hstepB, voffB); PG8_STAGE(PG8_SA(0, 1), cA + hstepA, voffA);
        if (wr == 1) PG8_BAR;
        PG8_WAIT_V(4); PG8_BAR;
        PG8_STAGE(PG8_SB(1, 0), cB + kstep, voffB); PG8_STAGE(PG8_SA(1, 0), cA + kstep, voffA); PG8_STAGE(PG8_SB(1, 1), cB + hstepB + kstep, voffB);
        PG8_WAIT_V(6); PG8_BAR;
    }
    for (;;) {
        const bool has_next = S.next(ui + 1, nxt);
        const char* nA = has_next ? (const char*)g.A + (size_t)nxt.pm * tstepA : cA; const char* nB = has_next ? (const char*)g.Bt + (size_t)nxt.bn * tstepB : cB;
        for (int t = 0; t < nt; t += 2) {
            const bool last = (t == nt - 2);
            const char* a1 = cA + (size_t)(t + 1) * kstep;
            const char* a2 = last ? nA : cA + (size_t)(t + 2) * kstep; const char* b2 = last ? nB : cB + (size_t)(t + 2) * kstep;
            const char* a3 = a2 + kstep; const char* b3 = b2 + kstep;
            if (last && has_next) S.a_ready(nxt);
            if constexpr (SP2) {
            const bool rel = Epi::SPLIT && pending && t == 0;
            if (rel) { if constexpr (Epi::SPLIT) { PG8_STAGE(PG8_SA(1, 1), a1 + hstepA, voffA); PG8_SCHED;
                if constexpr (Epi::PACK) { E.store1(pk, pend, wr, wc, fr, fq); }
                else { E.template half<1>(acc, pend, wr, wc, fr, fq);
#pragma unroll
                for (int b = 0; b < 2; ++b)
#pragma unroll
                    for (int m = 0; m < 4; ++m)
#pragma unroll
                        for (int n = 0; n < 2; ++n) acc[1][b][m][n] = (f32x4){0.f, 0.f, 0.f, 0.f}; }
                S.done(pend); pending = false;
                PG8_SCHED; PG8_LDB(B0, 0, 0); PG8_LDB(B1, 0, 1); PG8_SCHED; PG8_LDA(At, 0, 0); } }
            else { PG8_LDB(B0, 0, 0); PG8_LDB(B1, 0, 1); PG8_SCHED; PG8_LDA(At, 0, 0); PG8_STAGE(PG8_SA(1, 1), a1 + hstepA, voffA); }
            PG8_WAIT_REL(8 + Epi::NST); PG8_WAIT_L(0); PG8_BAR; PG8_MMA(0, 0, At, B0); PG8_MMA(0, 1, At, B1); PG8_BAR; PG8_SCHED;
            PG8_LDA(At, 0, 1); PG8_STAGE(PG8_SB(0, 0), b2, voffB); PG8_STAGE(PG8_SB(0, 1), b2 + hstepB, voffB); PG8_STAGE(PG8_SA(0, 0), a2, voffA);
            PG8_WAIT_REL(8 + Epi::NST); PG8_WAIT_L(0); PG8_BAR; PG8_MMA(1, 0, At, B0); PG8_MMA(1, 1, At, B1); PG8_BAR; PG8_SCHED;
            PG8_LDB(B0, 1, 0); PG8_LDB(B1, 1, 1); PG8_SCHED; PG8_LDA(At, 1, 0); PG8_STAGE(PG8_SA(0, 1), a2 + hstepA, voffA);
            PG8_WAIT_REL(8 + Epi::NST / 2); PG8_WAIT_L(0); PG8_BAR; PG8_MMA(0, 0, At, B0); PG8_MMA(0, 1, At, B1); PG8_BAR; PG8_SCHED;
            PG8_LDA(At, 1, 1); PG8_STAGE(PG8_SB(1, 0), b3, voffB); PG8_STAGE(PG8_SB(1, 1), b3 + hstepB, voffB); PG8_STAGE(PG8_SA(1, 0), a3, voffA);
            PG8_WAIT_V(8); PG8_WAIT_L(0); PG8_BAR; PG8_MMA(1, 0, At, B0); PG8_MMA(1, 1, At, B1); PG8_BAR; PG8_SCHED;
            } else {
            PG8_LDB(B0, 0, 0); PG8_SCHED; PG8_LDA(At, 0, 0); PG8_STAGE(PG8_SA(1, 1), a1 + hstepA, voffA);
            PG8_WAIT_L(8); PG8_BAR; PG8_WAIT_L(0); PG8_MMA(0, 0, At, B0); PG8_BAR; PG8_SCHED;
            PG8_LDB(B1, 0, 1); PG8_STAGE(PG8_SB(0, 0), b2, voffB);
            PG8_BAR; PG8_WAIT_L(0); PG8_MMA(0, 1, At, B1); PG8_BAR;
            PG8_LDA(At, 0, 1); PG8_STAGE(PG8_SA(0, 0), a2, voffA);
            PG8_BAR; PG8_WAIT_L(0); PG8_MMA(1, 0, At, B0); PG8_BAR; PG8_SCHED;
            PG8_STAGE(PG8_SB(0, 1), b2 + hstepB, voffB);
            PG8_WAIT_V(6); PG8_BAR; PG8_MMA(1, 1, At, B1); PG8_BAR;
            PG8_LDB(B0, 1, 0); PG8_SCHED; PG8_LDA(At, 1, 0); PG8_STAGE(PG8_SA(0, 1), a2 + hstepA, voffA);
            PG8_WAIT_L(8); PG8_BAR; PG8_WAIT_L(0); PG8_MMA(0, 0, At, B0); PG8_BAR; PG8_SCHED;
            PG8_LDB(B1, 1, 1); PG8_STAGE(PG8_SB(1, 0), b3, voffB);
            PG8_BAR; PG8_WAIT_L(0); PG8_MMA(0, 1, At, B1); PG8_BAR;
            PG8_LDA(At, 1, 1); PG8_STAGE(PG8_SA(1, 0), a3, voffA);
            PG8_BAR; PG8_WAIT_L(0); PG8_MMA(1, 0, At, B0); PG8_BAR; PG8_SCHED;
            PG8_STAGE(PG8_SB(1, 1), b3 + hstepB, voffB);
            PG8_WAIT_V(6); PG8_BAR; PG8_MMA(1, 1, At, B1); PG8_BAR;
            }
        }
        if constexpr (F8) asm volatile("s_nop 15\n\ts_nop 15\n\ts_nop 15\n\ts_nop 15" ::: "memory");
        if constexpr (ALIGN_EPI) { if (wr == 0) PG8_BAR; }
        if constexpr (Epi::SPLIT) { static_assert(SP2, "split epilogues need the SP2 loop");
            if (has_next) { E.template half<0>(acc, cur, wr, wc, fr, fq); if constexpr (Epi::PACK) E.pack1(acc, cur, wr, fr, pk); pend = cur; pending = true; }
            else { E.template half<0>(acc, cur, wr, wc, fr, fq); E.template half<1>(acc, cur, wr, wc, fr, fq); S.done(cur); } }
        else if constexpr (!Epi::AFTER_DRAIN) { E(acc, cur, wr, wc, fr, fq); S.done(cur); }
        if (!has_next) break;
#pragma unroll
        for (int a = 0; a < ((Epi::SPLIT && !Epi::PACK) ? 1 : 2); ++a)
#pragma unroll
            for (int b = 0; b < 2; ++b)
#pragma unroll
                for (int m = 0; m < 4; ++m)
#pragma unroll
                    for (int n = 0; n < 2; ++n) acc[a][b][m][n] = (f32x4){0.f, 0.f, 0.f, 0.f};
        cur = nxt; cA = nA; cB = nB; ++ui;
        if constexpr (ALIGN_EPI) { if (wr == 1) PG8_BAR; }
    }
    PG8_WAIT_V(0);
    if constexpr (!ALIGN_EPI) { if (wr == 0) PG8_BAR; }
    PG8_BAR;
    if constexpr (Epi::AFTER_DRAIN) { E.fused(acc, cur, wr, wc, fr, fq, lds, wid, lane); S.done(cur); }
#undef PG8_SA
#undef PG8_SB
#undef PG8_STAGE
#undef PG8_Q64
#undef PG8_Q64_voffA
#undef PG8_Q64_voffB
#undef PG8_LDA
#undef PG8_LDB
#undef PG8_MMA
#undef PG8_WAIT_V
#undef PG8_WAIT_L
#undef PG8_WAIT_REL
#undef PG8_BAR
#undef PG8_SCHED
}
}
#define PG8_SP2 true
#define PG8_ALIGN true
constexpr int NWAVES = 8, NTHR = 512;
constexpr int BATCH = 2, SEQ = 8192, D = 1024, M = BATCH * SEQ;
constexpr int MEMLEN = 256, MMEM = BATCH * MEMLEN;
constexpr int EV_IN = 4632, EV_INP = 4864;
constexpr int OD_IN = 5152, OD_INP = 5376;
constexpr int FF = 2816, FFE = 3584, NEXP = 8;
constexpr float MOE_W2_SCALE = 128.f;
constexpr float MOE_W13_SCALE = 64.f;
constexpr int NQB = SEQ / 64;
constexpr int XH = 4;
constexpr float EPS = 1e-6f;
constexpr int MOE_ROWS = 2 * M + NEXP * 256;
constexpr int MOE_TILES = MOE_ROWS / 256;

constexpr size_t MiB = 1u << 20;
constexpr size_t WS_CTL = 0, CTL_ZERO_BYTES = 1 * MiB;
constexpr size_t WS_SMALL = 1 * MiB;
constexpr size_t WS_CMPB_PART = WS_SMALL;
constexpr size_t WS_CMPB = WS_SMALL + 256 * 1024;
constexpr size_t WS_OV = WS_SMALL + 512 * 1024;
constexpr size_t WS_MEMN = 2 * MiB;
constexpr size_t WS_KVM = 4 * MiB;
constexpr size_t WS_KM = 6 * MiB;
constexpr size_t WS_HID = 7 * MiB;
constexpr size_t WS_KVCMP = 9 * MiB;
constexpr size_t WS_MOEIDX = 10 * MiB;
constexpr size_t WS_SSQ = 14 * MiB;
constexpr size_t WS_W = 16 * MiB;
constexpr size_t WS_W_EVIN = WS_W, WS_W_EVOUT = WS_W_EVIN + 10 * MiB, WS_W_CK1 = WS_W_EVOUT + 4 * MiB, WS_W_CV1 = WS_W_CK1 + 2 * MiB, WS_W_ODIN = WS_W_CV1 + 2 * MiB,
                 WS_W_ODOUT = WS_W_ODIN + 11 * MiB, WS_W_XQ = WS_W_ODOUT + 4 * MiB, WS_W_XKV = WS_W_XQ + 2 * MiB, WS_W_XO = WS_W_XKV + 4 * MiB, WS_W_FF13 = WS_W_XO + 2 * MiB,
                 WS_W_FF2 = WS_W_FF13 + 11 * MiB, WS_W_M13 = WS_W_FF2 + 6 * MiB, WS_W_M2 = WS_W_M13 + 112 * MiB, WS_W_END = WS_W_M2 + 56 * MiB;
constexpr size_t WS_XN = WS_W_END;
constexpr size_t WS_QX = WS_XN + 32 * MiB, WS_OX = WS_QX + 16 * MiB, WS_R = WS_OX + 16 * MiB;
constexpr size_t WS_Y0 = WS_R, WS_KV6 = WS_R + 152 * MiB, WS_MIX = WS_R + 201 * MiB, WS_H = WS_R + 265 * MiB;
constexpr size_t WS_Y1 = WS_R, WS_YG = WS_R + 168 * MiB;
constexpr size_t WS_XN8 = WS_QX;
constexpr size_t WS_XP = WS_R, WS_HP = WS_R + 68 * MiB, WS_YP = WS_R + 306 * MiB, WS_END = WS_R + 442 * MiB;
static_assert(WS_W_END == 242 * MiB && WS_END == 748 * MiB, "ws map");
constexpr int CW_TMO = 0, CW_CODE = 1, CW_CHK = 2;
constexpr int CW_BAR = 4096;
constexpr int CW_MOECNT = 16384;
constexpr int CW_MOEOFF = 20480;

constexpr int LDS_BYTES = 159744;
constexpr int MISC_OFF = LDS_BYTES - 512;
constexpr int SCR_BYTES = MISC_OFF;

#define GAS __attribute__((address_space(1)))
#define LAS __attribute__((address_space(3)))
typedef unsigned short bf16;
typedef unsigned v4u __attribute__((ext_vector_type(4)));
typedef unsigned v2u __attribute__((ext_vector_type(2)));
typedef float f32x4 __attribute__((ext_vector_type(4)));
typedef float f32x16 __attribute__((ext_vector_type(16)));
typedef short bf16x8 __attribute__((ext_vector_type(8)));
typedef short s16x4 __attribute__((ext_vector_type(4)));
typedef GAS unsigned gu32;
#define RLX_AGENT __ATOMIC_RELAXED, __HIP_MEMORY_SCOPE_AGENT
#define LDS_WAIT() asm volatile("s_waitcnt lgkmcnt(0)" ::: "memory")
#define VM_WAIT() asm volatile("s_waitcnt vmcnt(0)" ::: "memory")
#define SBAR() __builtin_amdgcn_sched_barrier(0)
__device__ __forceinline__ int lane_id() { return (int)threadIdx.x & 63; }
__device__ __forceinline__ unsigned f2bf(float f) { unsigned u = __builtin_bit_cast(unsigned, f); return (u + 0x7fffu + ((u >> 16) & 1u)) >> 16; }
__device__ __forceinline__ unsigned pk2(float lo, float hi) { return f2bf(lo) | (f2bf(hi) << 16); }
__device__ __forceinline__ float bf2f(unsigned short b) { return __builtin_bit_cast(float, ((unsigned)b) << 16); }
__device__ __forceinline__ float bflo(unsigned w) { return __builtin_bit_cast(float, w << 16); }
__device__ __forceinline__ float bfhi(unsigned w) { return __builtin_bit_cast(float, w & 0xffff0000u); }
__device__ __forceinline__ unsigned cvtpk(float lo, float hi) { unsigned r; asm volatile("v_cvt_pk_bf16_f32 %0, %1, %2" : "=v"(r) : "v"(lo), "v"(hi)); return r; }
__device__ __forceinline__ float wave_sum(float v) {
#pragma unroll
    for (int o = 1; o < 64; o <<= 1) v += __shfl_xor(v, o);
    return v;
}
using pg8::fsigmoid; using pg8::gelu_tanh; using pg8::fsilu;
__device__ __forceinline__ float fsoftplus(float x) { return x > 20.f ? x : log1pf(__expf(x)); }

#define XB_TMO      128
#define XB_XCNT(j)  (256  + 64 * (j))
#define XB_XSUB(j)  (1280 + 64 * (j))
#define XB_XGEN(j)  (2304 + 64 * (j))
#define XB_TOP      3328
#define XB_TOPGEN   3392
#define XCD_BAR_WORDS 3456
#define XB_SPIN_CAP (1u << 18)

__device__ __forceinline__ unsigned xb_ld(unsigned* p)              { return __hip_atomic_load(p, __ATOMIC_RELAXED, __HIP_MEMORY_SCOPE_AGENT); }
__device__ __forceinline__ unsigned xb_add(unsigned* p, unsigned v) { return __hip_atomic_fetch_add(p, v, __ATOMIC_RELAXED, __HIP_MEMORY_SCOPE_AGENT); }
__device__ __forceinline__ unsigned xb_xcc_id() { return (unsigned)__builtin_amdgcn_s_getreg((3 << 11) | 20) & 0xFu; }
#define XB_SPIN(cond, bar) do { unsigned _sp = 0; while (cond) { __builtin_amdgcn_s_sleep(1); \
    if ((++_sp & 255u) == 0u) { if (xb_ld(&(bar)[XB_TMO])) break; if (_sp > XB_SPIN_CAP) { atomicAdd(&(bar)[XB_TMO], 1u); break; } } } } while (0)

struct XcdBarrier {
    unsigned* bar; unsigned x;
    volatile LAS unsigned* st;
};

__device__ __forceinline__ XcdBarrier xcd_barrier_post(unsigned* bar, volatile LAS unsigned* st) {
    XcdBarrier b; b.bar = bar; b.x = xb_xcc_id(); b.st = st;
    if (threadIdx.x == 0) (void)xb_add(&bar[XB_XCNT(b.x)], 1u);
    return b;
}
__device__ __forceinline__ void xcd_barrier_complete(unsigned* bar, unsigned x, unsigned& nloc, unsigned& nx) {
    const unsigned G = gridDim.x * gridDim.y * gridDim.z;
    unsigned sum, cnt, mine, sp = 0u;
    for (;;) {
        sum = 0u; cnt = 0u; mine = 0u;
#pragma unroll
        for (unsigned j = 0; j < 16; ++j) { const unsigned c = xb_ld(&bar[XB_XCNT(j)]); sum += c; cnt += (c > 0u) ? 1u : 0u; mine = (j == x) ? c : mine; }
        if (sum == G) break;
        __builtin_amdgcn_s_sleep(1);
        if ((++sp & 255u) == 0u) { if (xb_ld(&bar[XB_TMO])) break; if (sp > XB_SPIN_CAP) { atomicAdd(&bar[XB_TMO], 1u); break; } }
    }
    nloc = mine > 0u ? mine : 1u; nx = cnt > 0u ? cnt : 1u;
}

__device__ __forceinline__ void xcd_barrier(const XcdBarrier& b) {
    asm volatile("s_waitcnt vmcnt(0)" ::: "memory");
    __syncthreads();
    if (threadIdx.x == 0) {
        unsigned* bar = b.bar;
        __builtin_amdgcn_s_waitcnt(0);
        unsigned nloc = b.st[0], nx = b.st[1];
        if (nloc == 0u) { xcd_barrier_complete(bar, b.x, nloc, nx); b.st[0] = nloc; b.st[1] = nx; }
        const unsigned old = xb_add(&bar[XB_XSUB(b.x)], 1u);
        const unsigned gen = old / nloc;
        if (old + 1u == (gen + 1u) * nloc) {
            __builtin_amdgcn_fence(__ATOMIC_RELEASE, "agent");
            asm volatile("s_waitcnt vmcnt(0)" ::: "memory");
            const unsigned og = xb_add(&bar[XB_TOP], 1u);
            const unsigned tg = og / nx;
            if (og + 1u == (tg + 1u) * nx) xb_add(&bar[XB_TOPGEN], 1u);
            else XB_SPIN(xb_ld(&bar[XB_TOPGEN]) == tg, bar);
            __builtin_amdgcn_fence(__ATOMIC_ACQUIRE, "agent");
            xb_add(&bar[XB_XGEN(b.x)], 1u);
            asm volatile("s_waitcnt vmcnt(0)" ::: "memory");
        } else {
            XB_SPIN(xb_ld(&bar[XB_XGEN(b.x)]) == gen, bar);
            __builtin_amdgcn_fence(__ATOMIC_ACQUIRE, "agent");
            asm volatile("s_waitcnt vmcnt(0)" ::: "memory");
        }
    }
    __syncthreads();
}

struct Args { const float* in[41]; float* out; unsigned char* ws; int ph_lo, ph_hi, li, pad; };
struct Frame { LAS unsigned char* lds; volatile LAS unsigned* MISC; gu32* ctl; unsigned char* ws; int tid, lane, wave, G, bid; };
enum { I_X = 0, I_MEM, I_NMIX, I_NCROSS, I_NMEM, I_NFFN, I_EVWIN, I_RGCW, I_RGCB, I_RGWA, I_RGBA, I_RGWX, I_RGBX, I_RGLAM, I_GATEB, I_QNORM, I_KNORM, I_CMPPOS,
       I_CKW1, I_CKW2, I_CVW1, I_CVW2, I_EVWOUT, I_ODWIN, I_ODCW, I_ODCB, I_DTB, I_ALOG, I_DSKIP, I_ODNORM, I_ODWOUT, I_XWQ, I_XWKV, I_XQN, I_XKN, I_XWO,
       I_FFW13, I_FFW2, I_ROUTER, I_MW13, I_MW2, N_IN };
static_assert(N_IN == 41, "input count");

template <int MAP>
__device__ __forceinline__ void transpose_item(const float* W, int N, bf16* WT, int ldt, LAS float* scr, int kb, int nb, int lane, int ffs, const float* kg = nullptr) {
    const int k0 = 64 * kb, n0 = 64 * nb; const int c4 = (lane & 15) * 4, r4 = lane >> 4;
    f32x4 tv[16];
    if ((N & 3) == 0) {
#pragma unroll
        for (int i = 0; i < 16; ++i) { const int kk = 4 * i + r4; tv[i] = (n0 + c4 < N) ? *(const GAS f32x4*)(W + (size_t)(k0 + kk) * N + n0 + c4) : (f32x4){0.f, 0.f, 0.f, 0.f}; }
    } else {
#pragma unroll
        for (int i = 0; i < 16; ++i) { const int kk = 4 * i + r4; const float* src = W + (size_t)(k0 + kk) * N + n0 + c4;
#pragma unroll
            for (int j = 0; j < 4; ++j) tv[i][j] = (n0 + c4 + j < N) ? src[j] : 0.f; }
    }
#pragma unroll
    for (int i = 0; i < 16; ++i) { const int kk = 4 * i + r4; const float gk = kg ? kg[k0 + kk] : 1.f;
#pragma unroll
        for (int j = 0; j < 4; ++j) scr[kk * 65 + c4 + j] = tv[i][j] * gk; }
    LDS_WAIT(); asm volatile("" ::: "memory");
    const int c = lane & 7;
#pragma unroll
    for (int j = 0; j < 8; ++j) { const int nl = (lane >> 3) + 8 * j, n = n0 + nl; const LAS float* s = scr + (8 * c) * 65 + nl;
        v4u o; o.x = pk2(s[0 * 65], s[1 * 65]); o.y = pk2(s[2 * 65], s[3 * 65]); o.z = pk2(s[4 * 65], s[5 * 65]); o.w = pk2(s[6 * 65], s[7 * 65]);
        int row = n; if (MAP == 1) row = (n < ffs) ? pg8::swiglu_row(n, 0) : pg8::swiglu_row(n - ffs, 1);
        if (n < ((N + 31) & ~31)) *(GAS v4u*)(WT + (size_t)row * ldt + k0 + 8 * c) = o; }
    LDS_WAIT(); asm volatile("" ::: "memory");
}
__device__ __forceinline__ unsigned pk4_fp8(float a, float b, float c, float d) { int r = __builtin_amdgcn_cvt_pk_fp8_f32(a, b, 0, false); r = __builtin_amdgcn_cvt_pk_fp8_f32(c, d, r, true); return (unsigned)r; }
template <int MAP>
__device__ __forceinline__ void transpose_item_f8(const float* W, int N, unsigned char* WT8, int ldt, LAS float* scr, int kb, int nb, int lane, int ffs, float sc) {
    const int k0 = 64 * kb, n0 = 64 * nb; const int c4 = (lane & 15) * 4, r4 = lane >> 4;
    f32x4 tv[16];
#pragma unroll
    for (int i = 0; i < 16; ++i) { const int kk = 4 * i + r4; tv[i] = *(const GAS f32x4*)(W + (size_t)(k0 + kk) * N + n0 + c4); }
#pragma unroll
    for (int i = 0; i < 16; ++i) { const int kk = 4 * i + r4;
#pragma unroll
        for (int j = 0; j < 4; ++j) scr[kk * 65 + c4 + j] = tv[i][j] * sc; }
    LDS_WAIT(); asm volatile("" ::: "memory");
    const int c = lane & 7;
#pragma unroll
    for (int j = 0; j < 8; ++j) { const int nl = (lane >> 3) + 8 * j, n = n0 + nl; const LAS float* s = scr + (8 * c) * 65 + nl;
        v2u o; o.x = pk4_fp8(s[0 * 65], s[1 * 65], s[2 * 65], s[3 * 65]); o.y = pk4_fp8(s[4 * 65], s[5 * 65], s[6 * 65], s[7 * 65]);
        int row = n; if (MAP == 1) row = (n < ffs) ? pg8::swiglu_row(n, 0) : pg8::swiglu_row(n - ffs, 1);
        *(GAS v2u*)(WT8 + (size_t)row * ldt + k0 + 8 * c) = o; }
    LDS_WAIT(); asm volatile("" ::: "memory");
}
constexpr int MOE_CONV_ITEMS = NEXP * (16 * 112 + 56 * 16);

__device__ __forceinline__ void rms_row_to_bf16(const float* xrow, const float* g, bf16* orow, int lane) {
    const GAS f32x4* xr = (const GAS f32x4*)xrow + lane; const GAS f32x4* gr = (const GAS f32x4*)g + lane;
    f32x4 v[4]; float s = 0.f;
#pragma unroll
    for (int j = 0; j < 4; ++j) { v[j] = xr[64 * j]; s += (v[j].x * v[j].x + v[j].y * v[j].y) + (v[j].z * v[j].z + v[j].w * v[j].w); }
    const float rstd = 1.f / sqrtf(wave_sum(s) * (1.f / D) + EPS);
    GAS unsigned long long* o8 = (GAS unsigned long long*)orow + lane;
#pragma unroll
    for (int j = 0; j < 4; ++j) { const f32x4 gg = gr[64 * j];
        o8[64 * j] = (unsigned long long)pk2(v[j].x * rstd * gg.x, v[j].y * rstd * gg.y) | ((unsigned long long)pk2(v[j].z * rstd * gg.z, v[j].w * rstd * gg.w) << 32); }
}
__device__ __forceinline__ void phase_rmsnorm(const Frame& F, const float* x, const float* g, bf16* xn, int rows) {
    const int gw = F.bid * NWAVES + F.wave, NGW = F.G * NWAVES;
    for (int m = gw; m < rows; m += NGW) rms_row_to_bf16(x + (size_t)m * D, g, xn + (size_t)m * D, F.lane);
}
#define TR_MAT(cnt_, W_, K_, N_, WT_, ldt_, MAPK_, ffs_, kg_) \
    if (r < (cnt_)) { const int nblk_ = ((N_) + 63) / 64; transpose_item<MAPK_>((W_), (N_), (WT_), (ldt_), scr, r / nblk_, r % nblk_, F.lane, (ffs_), (kg_)); continue; } r -= (cnt_);
constexpr int C_EVIN = 16 * 73, C_EVOUT = 32 * 16, C_CW1 = 64 * 4, C_ODIN = 16 * 81, C_ODOUT = 32 * 16, C_XQ = 16 * 8, C_XKV = 16 * 16, C_XO = 8 * 16, C_FF13 = 16 * 88, C_FF2 = 44 * 16;
constexpr int CONV_A = C_EVIN + 2 * C_XKV + 2 * C_CW1, CONV_B = C_EVOUT + 2 * C_XQ + 2 * C_XO + C_FF13 + C_FF2 + C_ODIN + C_ODOUT;
constexpr int CONV_ALL = CONV_A + CONV_B + MOE_CONV_ITEMS, CONV_Q = 4480, CONV_P2_END = CONV_ALL - 2 * CONV_Q;
__device__ __forceinline__ void convert_range(const Frame& F, const Args& a, int gw, int NGW, int it_lo, int it_hi) {
    LAS float* scr = (LAS float*)(F.lds + F.wave * 16640); unsigned char* ws = F.ws;
    for (int it = it_lo + gw; it < it_hi; it += NGW) {
        int r = it;
        TR_MAT(C_EVIN, a.in[I_EVWIN], D, EV_IN, (bf16*)(ws + WS_W_EVIN), D, 0, 0, nullptr)
        TR_MAT(C_XKV, a.in[I_XWKV], D, 1024, (bf16*)(ws + WS_W_XKV), D, 0, 0, nullptr)
        TR_MAT(C_XKV, a.in[I_XWKV] + (size_t)D * 1024, D, 1024, (bf16*)(ws + WS_W_XKV) + (size_t)1024 * D, D, 0, 0, nullptr)
        TR_MAT(C_CW1, a.in[I_CKW1], 4096, 256, (bf16*)(ws + WS_W_CK1), 4096, 0, 0, nullptr)
        TR_MAT(C_CW1, a.in[I_CVW1], 4096, 256, (bf16*)(ws + WS_W_CV1), 4096, 0, 0, nullptr)
        TR_MAT(C_EVOUT, a.in[I_EVWOUT], 2048, D, (bf16*)(ws + WS_W_EVOUT), 2048, 0, 0, nullptr)
        TR_MAT(C_XQ, a.in[I_XWQ], D, 512, (bf16*)(ws + WS_W_XQ), D, 0, 0, a.in[I_NCROSS])
        TR_MAT(C_XO, a.in[I_XWO], 512, D, (bf16*)(ws + WS_W_XO), 512, 0, 0, nullptr)
        TR_MAT(C_FF13, a.in[I_FFW13], D, 2 * FF, (bf16*)(ws + WS_W_FF13), D, 1, FF, a.in[I_NFFN])
        TR_MAT(C_FF2, a.in[I_FFW2], FF, D, (bf16*)(ws + WS_W_FF2), FF, 0, 0, nullptr)
        TR_MAT(C_ODIN, a.in[I_ODWIN], D, OD_IN, (bf16*)(ws + WS_W_ODIN), D, 0, 0, a.in[I_NMIX] + D)
        TR_MAT(C_ODOUT, a.in[I_ODWOUT], 2048, D, (bf16*)(ws + WS_W_ODOUT), 2048, 0, 0, nullptr)
        TR_MAT(C_XQ, a.in[I_XWQ] + (size_t)D * 512, D, 512, (bf16*)(ws + WS_W_XQ) + (size_t)512 * D, D, 0, 0, a.in[I_NCROSS] + D)
        TR_MAT(C_XO, a.in[I_XWO] + (size_t)512 * D, 512, D, (bf16*)(ws + WS_W_XO) + (size_t)D * 512, 512, 0, 0, nullptr)
        { constexpr int C_M13 = 16 * 112, C_M2 = 56 * 16;
          if (r < NEXP * C_M13) { const int e = r / C_M13, q = r % C_M13; transpose_item_f8<1>(a.in[I_MW13] + (size_t)e * D * 2 * FFE, 2 * FFE, ws + WS_W_M13 + (size_t)e * 2 * FFE * D, D, scr, q / 112, q % 112, F.lane, FFE, MOE_W13_SCALE); continue; } r -= NEXP * C_M13;
          { const int e = r / C_M2, q = r % C_M2; transpose_item_f8<0>(a.in[I_MW2] + (size_t)e * FFE * D, D, ws + WS_W_M2 + (size_t)e * D * FFE, FFE, scr, q / 16, q % 16, F.lane, 0, MOE_W2_SCALE); } }
    }
}
__device__ __forceinline__ void p0_prologue(const Frame& F, const Args& a) {
    const int gw = F.bid * NWAVES + F.wave, NGW = F.G * NWAVES;
    unsigned char* ws = F.ws;
    convert_range(F, a, gw, NGW, 0, CONV_A);
    for (int i = F.bid * NTHR + F.tid; i < 2 * 224 * 128; i += F.G * NTHR) { const int w = i / (224 * 128), q = i % (224 * 128);
        bf16* base = w == 0 ? (bf16*)(ws + WS_W_EVIN) + (size_t)4640 * D : (bf16*)(ws + WS_W_ODIN) + (size_t)5152 * D; *(GAS v4u*)(base + (size_t)q * 8) = (v4u){0u, 0u, 0u, 0u}; }
    phase_rmsnorm(F, a.in[I_X], a.in[I_NMIX], (bf16*)(ws + WS_XN), M);
    phase_rmsnorm(F, a.in[I_MEM], a.in[I_NMEM], (bf16*)(ws + WS_MEMN), MMEM);
    phase_rmsnorm(F, a.in[I_MEM], a.in[I_NMEM] + D, (bf16*)(ws + WS_MEMN) + (size_t)MMEM * D, MMEM);
    for (int i = F.bid * NTHR + F.tid; i < 512 * 128; i += F.G * NTHR) { const int n = i >> 7, j = i & 127; ((bf16*)(ws + WS_OV))[i] = (n <= 510 && n >= 4 * j - 1 && n <= 4 * j + 3) ? (bf16)0x3F80 : (bf16)0; }
    for (int it = gw; it < 128; it += NGW) { const int mm = it >> 6, ic = it & 63; const float* w1 = a.in[mm ? I_CVW1 : I_CKW1]; const float* pos = a.in[I_CMPPOS];
        f32x4 acc = {0.f, 0.f, 0.f, 0.f};
        for (int rr = 0; rr < 64; ++rr) { const int i = ic * 64 + rr; const float p = pos[i]; const f32x4 w = *(const GAS f32x4*)(w1 + (size_t)i * 256 + 4 * F.lane); acc += w * p; }
        *(GAS f32x4*)((float*)(ws + WS_CMPB_PART) + (size_t)(mm * 64 + ic) * 256 + 4 * F.lane) = acc; }
}
#undef TR_MAT
namespace att {
constexpr float SCALE = 0.08838834764831845f;
constexpr float THR = 8.f;
constexpr int KVBLK = 64, DH = 128;
constexpr int SHM_V = KVBLK * DH * 2, SHM_K = KVBLK * DH * 2;
constexpr int NSLOT = 3;
constexpr int LDS_ATT = NSLOT * SHM_V + NSLOT * SHM_K + NWAVES * 64 * 4;
#define KSWZ(row, colB) ((row) * 256 + ((colB) ^ (((row) & 7) << 4)))
__device__ __forceinline__ int v_st(int k, int c) { const int kk = (k & ~0xC) | ((k & 4) << 1) | ((k & 8) >> 1); return ((kk >> 3) * 4 + (c >> 5)) * 512 + ((kk & 7) * 32 + (c & 31)) * 2; }
__device__ __forceinline__ int v_rd_base(int lane) { return ((lane & 3) << 3) | (((lane >> 2) & 3) << 6) | (((lane >> 4) & 1) << 5) | (((lane >> 5) & 1) << 8); }
constexpr int v_rd_off(int d0, int ks, int half) { return d0 * 512 + ks * 4096 + half * 2048; }
__device__ __forceinline__ int crow(int r, int hi) { return (r & 3) + 8 * (r >> 2) + 4 * hi; }
__device__ __forceinline__ bf16x8 pack8(f32x4 a, f32x4 b) { v4u w = {cvtpk(a[0], a[1]), cvtpk(a[2], a[3]), cvtpk(b[0], b[1]), cvtpk(b[2], b[3])}; return *reinterpret_cast<bf16x8*>(&w); }

__device__ __forceinline__ void mask_tile(f32x16& p0, f32x16& p1, int dq, unsigned W) {
    asm volatile("" : "+v"(dq));
    const float NEG = -__builtin_inff();
#pragma unroll
    for (int r = 0; r < 16; ++r) { const int c = (r & 3) + 8 * (r >> 2);
        if ((unsigned)(dq - c) >= W) p0[r] = NEG;
        if ((unsigned)(dq - c - 32) >= W) p1[r] = NEG; }
}
__device__ __forceinline__ void mask_all(f32x16& p0, f32x16& p1) { const float NEG = -__builtin_inff();
#pragma unroll
    for (int r = 0; r < 16; ++r) { p0[r] = NEG; p1[r] = NEG; } }
__device__ __forceinline__ void partialSM(f32x16& p0, f32x16& p1, float& m_reg, float& mn, float& alpha, bool keep = true) {
    float pmax = p0[0];
#pragma unroll
    for (int r = 1; r < 16; ++r) pmax = fmaxf(pmax, p0[r]);
#pragma unroll
    for (int r = 0; r < 16; ++r) pmax = fmaxf(pmax, p1[r]);
    pmax = keep ? pmax : -__builtin_inff();
    { auto rr = __builtin_amdgcn_permlane32_swap(__float_as_uint(pmax), __float_as_uint(pmax), false, false);
      pmax = fmaxf(__uint_as_float(rr[0]), __uint_as_float(rr[1])); }
    constexpr float C2 = 1.4426950408889634f * SCALE;
    if (__builtin_expect(__all((pmax - m_reg) * SCALE <= THR), 1)) { mn = m_reg; alpha = 1.f; }
    else { mn = fmaxf(m_reg, pmax); alpha = __builtin_amdgcn_exp2f((m_reg - mn) * C2); m_reg = mn; }
    const float mnL = keep ? -mn * C2 : -__builtin_inff();
#pragma unroll
    for (int r = 0; r < 16; ++r) p0[r] = fmaf(p0[r], C2, mnL);
#pragma unroll
    for (int r = 0; r < 16; ++r) p1[r] = fmaf(p1[r], C2, mnL);
#pragma unroll
    for (int r = 0; r < 16; ++r) p0[r] = __builtin_amdgcn_exp2f(p0[r]);
}
__device__ __forceinline__ void finishSM(f32x16& p0, f32x16& p1, float alpha, float& l_reg, bf16x8& pa0, bf16x8& pa1, bf16x8& pa2, bf16x8& pa3) {
#pragma unroll
    for (int r = 0; r < 16; ++r) p1[r] = __builtin_amdgcn_exp2f(p1[r]);
    float ps = 0;
#pragma unroll
    for (int r = 0; r < 16; ++r) ps += p0[r];
#pragma unroll
    for (int r = 0; r < 16; ++r) ps += p1[r];
    { auto rr = __builtin_amdgcn_permlane32_swap(__float_as_uint(ps), __float_as_uint(ps), false, false);
      ps = __uint_as_float(rr[0]) + __uint_as_float(rr[1]); }
    l_reg = l_reg * alpha + ps;
#define PK4(P, B_, OUT) do { unsigned a0 = cvtpk(P[B_+0], P[B_+1]), a1 = cvtpk(P[B_+2], P[B_+3]);                          \
        unsigned b0 = cvtpk(P[B_+4], P[B_+5]), b1 = cvtpk(P[B_+6], P[B_+7]);                                             \
        auto r0 = __builtin_amdgcn_permlane32_swap(a0, b0, false, false); auto r1 = __builtin_amdgcn_permlane32_swap(a1, b1, false, false); \
        v4u w = {r0[0], r1[0], r0[1], r1[1]}; OUT = *reinterpret_cast<bf16x8*>(&w); } while (0)
    PK4(p0, 0, pa0); PK4(p0, 8, pa1); PK4(p1, 0, pa2); PK4(p1, 8, pa3);
#undef PK4
}
__device__ __forceinline__ void qkt(f32x16& p0, f32x16& p1, const char* Kslot, int r32, int hi, const bf16x8* qr) {
    p0 = f32x16{}; p1 = f32x16{};
    const char* kb[4];
#pragma unroll
    for (int dd = 0; dd < 4; ++dd) kb[dd] = Kslot + KSWZ(r32, (dd * 16 + hi * 8) * 2);
    bf16x8 fa[4], fb[4];
#define KLD(dst, i, d0) do { const char* a_ = kb[(d0) & 3] + ((d0) >> 2) * 128; dst[i] = *reinterpret_cast<const bf16x8*>(a_); dst[i + 1] = *reinterpret_cast<const bf16x8*>(a_ + 32 * 256); } while (0)
#define KMM(src, i, d0) do { p0 = __builtin_amdgcn_mfma_f32_32x32x16_bf16(src[i], qr[d0], p0, 0, 0, 0); p1 = __builtin_amdgcn_mfma_f32_32x32x16_bf16(src[i + 1], qr[d0], p1, 0, 0, 0); } while (0)
    KLD(fa, 0, 0); KLD(fa, 2, 1); KLD(fb, 0, 2); KLD(fb, 2, 3); SBAR();
    KMM(fa, 0, 0); KMM(fa, 2, 1); SBAR(); KLD(fa, 0, 4); KLD(fa, 2, 5); SBAR();
    KMM(fb, 0, 2); KMM(fb, 2, 3); SBAR(); KLD(fb, 0, 6); KLD(fb, 2, 7); SBAR();
    KMM(fa, 0, 4); KMM(fa, 2, 5); SBAR();
    KMM(fb, 0, 6); KMM(fb, 2, 7);
#undef KLD
#undef KMM
}
__device__ __forceinline__ void pv_tile(f32x16* o, int vbs, bf16x8 pa0, bf16x8 pa1, bf16x8 pa2, bf16x8 pa3) {
#define TRRD(dst, off) asm volatile("ds_read_b64_tr_b16 %0, %1 offset:%2" : "=&v"(dst) : "v"(vbs), "i"(off) : "memory")
#define PV_D0(d0) do { s16x4 l0, l1, l2, l3, h0, h1, h2, h3; constexpr int b_ = v_rd_off(d0, 0, 0); \
        TRRD(l0, b_); TRRD(h0, b_ + 2048); TRRD(l1, b_ + 4096); TRRD(h1, b_ + 6144); TRRD(l2, b_ + 8192); TRRD(h2, b_ + 10240); TRRD(l3, b_ + 12288); TRRD(h3, b_ + 14336); \
        asm volatile("s_waitcnt lgkmcnt(0)" ::: "memory"); SBAR();   \
        o[d0] = __builtin_amdgcn_mfma_f32_32x32x16_bf16(pa0, (bf16x8){l0[0], l0[1], l0[2], l0[3], h0[0], h0[1], h0[2], h0[3]}, o[d0], 0, 0, 0);   \
        o[d0] = __builtin_amdgcn_mfma_f32_32x32x16_bf16(pa1, (bf16x8){l1[0], l1[1], l1[2], l1[3], h1[0], h1[1], h1[2], h1[3]}, o[d0], 0, 0, 0);   \
        o[d0] = __builtin_amdgcn_mfma_f32_32x32x16_bf16(pa2, (bf16x8){l2[0], l2[1], l2[2], l2[3], h2[0], h2[1], h2[2], h2[3]}, o[d0], 0, 0, 0);   \
        o[d0] = __builtin_amdgcn_mfma_f32_32x32x16_bf16(pa3, (bf16x8){l3[0], l3[1], l3[2], l3[3], h3[0], h3[1], h3[2], h3[3]}, o[d0], 0, 0, 0); } while (0)
    PV_D0(0); PV_D0(1); PV_D0(2); PV_D0(3);
#undef PV_D0
#undef TRRD
}
__device__ __forceinline__ void q_issue(const bf16* qrow, int hi, v4u (&raw)[8]) {
#pragma unroll
    for (int d0 = 0; d0 < 8; ++d0) raw[d0] = *(const GAS v4u*)(qrow + d0 * 16 + hi * 8);
}
__device__ __forceinline__ void q_finish(const v4u (&raw)[8], const float* g, int hi, bf16x8* qr) {
    float ss = 0.f;
#pragma unroll
    for (int d0 = 0; d0 < 8; ++d0)
#pragma unroll
        for (int j = 0; j < 4; ++j) { const float a = bflo(raw[d0][j]), b = bfhi(raw[d0][j]); ss += a * a + b * b; }
    ss += __shfl_xor(ss, 32);
    const float rstd = 1.f / sqrtf(ss * (1.f / 128.f) + EPS);
#pragma unroll
    for (int d0 = 0; d0 < 8; ++d0) { const f32x4 g0 = *(const GAS f32x4*)(g + d0 * 16 + hi * 8), g1 = *(const GAS f32x4*)(g + d0 * 16 + hi * 8 + 4);
        v4u w; w.x = cvtpk(bflo(raw[d0][0]) * rstd * g0[0], bfhi(raw[d0][0]) * rstd * g0[1]); w.y = cvtpk(bflo(raw[d0][1]) * rstd * g0[2], bfhi(raw[d0][1]) * rstd * g0[3]);
        w.z = cvtpk(bflo(raw[d0][2]) * rstd * g1[0], bfhi(raw[d0][2]) * rstd * g1[1]); w.w = cvtpk(bflo(raw[d0][3]) * rstd * g1[2], bfhi(raw[d0][3]) * rstd * g1[3]);
        qr[d0] = *reinterpret_cast<bf16x8*>(&w); }
}
__device__ __forceinline__ void load_q(const bf16* qrow, const float* g, int hi, bf16x8* qr) { v4u raw[8]; q_issue(qrow, hi, raw); q_finish(raw, g, hi, qr); }
struct PassIO { const bf16* Kp; int ldk; const bf16* Vp; int ldv; int t_lo, t_hi; };
__device__ __forceinline__ void dma_offsets(int wid, int lane, int ldk, int ldv, unsigned& koff, unsigned& voff) {
    const int row = 4 * wid + (lane >> 4); koff = (unsigned)(row * ldk * 2 + (((lane & 15) ^ (row & 7)) << 4));
    const int st = 2 * wid + (lane >> 5), kk = ((st >> 2) << 3) | ((lane & 31) >> 2), k = (kk & ~0xC) | ((kk & 4) << 1) | ((kk & 8) >> 1); voff = (unsigned)(k * ldv * 2 + ((st & 3) * 32 + 8 * (lane & 3)) * 2);
}
#define ATT_DMA(io_, t, slot) do { const char* kt_ = (const char*)(io_).Kp + (size_t)(t) * (KVBLK * 2) * (io_).ldk; const char* vt_ = (const char*)(io_).Vp + (size_t)(t) * (KVBLK * 2) * (io_).ldv;          \
        LAS unsigned* kd_ = (LAS unsigned*)(ldsl + NSLOT * SHM_V + (slot) * SHM_K + wid * 1024); LAS unsigned* vd_ = (LAS unsigned*)(ldsl + (slot) * SHM_V + wid * 1024);                \
        __builtin_amdgcn_global_load_lds((const unsigned*)(kt_ + koff), kd_, 16, 0, 0); __builtin_amdgcn_global_load_lds((const unsigned*)(kt_ + koff + (size_t)64 * (io_).ldk), kd_ + 2048, 16, 0, 0); \
        __builtin_amdgcn_global_load_lds((const unsigned*)(vt_ + voff), vd_, 16, 0, 0); __builtin_amdgcn_global_load_lds((const unsigned*)(vt_ + voff + (size_t)64 * (io_).ldv), vd_ + 2048, 16, 0, 0); } while (0)
__device__ __forceinline__ void attn_prefetch(char* lds, const PassIO& io) {
    int tid = threadIdx.x; asm volatile("" : "+v"(tid));
    const int wid = __builtin_amdgcn_readfirstlane(tid >> 6), lane = tid & 63;
    unsigned koff, voff; dma_offsets(wid, lane, io.ldk, io.ldv, koff, voff);
    LAS unsigned char* ldsl = (LAS unsigned char*)lds;
    ATT_DMA(io, io.t_lo, 0); if (io.t_hi - io.t_lo > 1) ATT_DMA(io, io.t_lo + 1, 1);
}
template <class MaskF>
__device__ __forceinline__ void attn_pass(char* lds, const bf16x8* qr, const PassIO& io, const MaskF& mf, f32x16 (&o)[4], float& l_out) {
    int tid = threadIdx.x; asm volatile("" : "+v"(tid));
    const int wid = __builtin_amdgcn_readfirstlane(tid >> 6), lane = tid & 63, r32 = lane & 31, hi = lane >> 5;
    char* V_lds = lds; char* K_lds = lds + NSLOT * SHM_V;
    float* wsc = (float*)(lds + NSLOT * SHM_V + NSLOT * SHM_K) + wid * 64; float* al_l = wsc + 32;
    float m_reg = -1e30f, l_reg = 0.f;
#pragma unroll
    for (int d = 0; d < 4; ++d) o[d] = f32x16{};
    const int vb0 = (int)(uintptr_t)V_lds + v_rd_base(lane);
    const int t_lo = io.t_lo, NT = io.t_hi - io.t_lo;
    unsigned koff, voff; dma_offsets(wid, lane, io.ldk, io.ldv, koff, voff);
    LAS unsigned char* ldsl = (LAS unsigned char*)lds;
    f32x16 p0, p1; float mn, alpha = 1.f; bf16x8 pa0, pa1, pa2, pa3;
#define A_RESC(a) do { if (__any((a) < 1.f)) { if (hi == 0) al_l[r32] = (a); asm volatile("s_waitcnt lgkmcnt(0)" ::: "memory"); \
        _Pragma("unroll") for (int d_ = 0; d_ < 4; ++d_) _Pragma("unroll") for (int r = 0; r < 16; ++r) o[d_][r] *= al_l[crow(r, hi)]; } } while (0)
#define A_BAR() do { asm volatile("" ::: "memory"); __builtin_amdgcn_s_barrier(); asm volatile("" ::: "memory"); } while (0)
    const bool lead = wid < 4;
    VM_WAIT();
    __syncthreads();
    if (!lead) A_BAR();
    int sK = 0, sV = 2, sW = 1;
    bool act_prev = false;
    for (int i = 0; i < NT; ++i) {
        if (lead && i >= 1 && i + 1 < NT) ATT_DMA(io, t_lo + i + 1, sW);
        const bool act = mf.active(t_lo + i);
        SBAR(); if (act) qkt(p0, p1, K_lds + sK * SHM_K, r32, hi, qr);
        if (i > 0 && act_prev) pv_tile(o, vb0 + sV * SHM_V, pa0, pa1, pa2, pa3);
        if (!lead && i + 1 < NT) VM_WAIT();
        A_BAR();
        if (!lead && i + 2 < NT) ATT_DMA(io, t_lo + i + 2, sV);
        if (act) { mf(p0, p1, t_lo + i); partialSM(p0, p1, m_reg, mn, alpha, mf.keep(t_lo + i)); A_RESC(alpha); finishSM(p0, p1, alpha, l_reg, pa0, pa1, pa2, pa3); }
        act_prev = act;
        if (lead && i + 1 < NT) VM_WAIT();
        A_BAR();
        { const int t_ = sV; sV = sK; sK = sW; sW = t_; }
    }
    if (act_prev) pv_tile(o, vb0 + sV * SHM_V, pa0, pa1, pa2, pa3);
    if (lead) A_BAR();
    __syncthreads();
#undef A_RESC
#undef A_BAR
    l_out = l_reg;
}
__device__ __forceinline__ void row_inv_l(char* lds, float l_reg, float (&rli)[16]) {
    const int tid = threadIdx.x, wid = __builtin_amdgcn_readfirstlane(tid >> 6), lane = tid & 63, r32 = lane & 31, hi = lane >> 5;
    float* wsc = (float*)(lds + NSLOT * SHM_V + NSLOT * SHM_K) + wid * 64;
    if (hi == 0) wsc[r32] = l_reg;
    asm volatile("s_waitcnt lgkmcnt(0)" ::: "memory");
#pragma unroll
    for (int r = 0; r < 16; ++r) { const float l = wsc[crow(r, hi)]; rli[r] = l > 0.f ? __builtin_amdgcn_rcpf(l) : 0.f; }
    asm volatile("s_waitcnt lgkmcnt(0)" ::: "memory");
}
struct NoMask { __device__ __forceinline__ void operator()(f32x16&, f32x16&, int) const {} __device__ __forceinline__ bool active(int) const { return true; } __device__ __forceinline__ bool keep(int) const { return true; } };
}
__device__ __forceinline__ void norm128_rows(const Frame& F, const bf16* src, size_t lds_, bf16* dst, size_t ldd, int nrows, const float* g, int gw, int NGW) {
    const int sub = F.lane >> 4, l16 = F.lane & 15;
    const f32x4 g0 = *(const GAS f32x4*)(g + l16 * 8), g1 = *(const GAS f32x4*)(g + l16 * 8 + 4);
    for (int r0 = gw * 4; r0 < nrows; r0 += NGW * 4) { const int r = r0 + sub;
        const v4u raw = *(const GAS v4u*)(src + (size_t)r * lds_ + l16 * 8);
        float ss = 0.f;
#pragma unroll
        for (int j = 0; j < 4; ++j) { const float a = bflo(raw[j]), b = bfhi(raw[j]); ss += a * a + b * b; }
        ss += __shfl_xor(ss, 1); ss += __shfl_xor(ss, 2); ss += __shfl_xor(ss, 4); ss += __shfl_xor(ss, 8);
        const float rstd = 1.f / sqrtf(ss * (1.f / 128.f) + EPS);
        v4u w; w.x = cvtpk(bflo(raw[0]) * rstd * g0[0], bfhi(raw[0]) * rstd * g0[1]); w.y = cvtpk(bflo(raw[1]) * rstd * g0[2], bfhi(raw[1]) * rstd * g0[3]);
        w.z = cvtpk(bflo(raw[2]) * rstd * g1[0], bfhi(raw[2]) * rstd * g1[1]); w.w = cvtpk(bflo(raw[3]) * rstd * g1[2], bfhi(raw[3]) * rstd * g1[3]);
        *(GAS v4u*)(dst + (size_t)r * ldd + l16 * 8) = w; }
}
__device__ __forceinline__ void phase_memk_norm(const Frame& F, const Args& a, int l, int gw, int NGW) {
    const bf16* kvm = (const bf16*)(F.ws + WS_KVM) + (size_t)l * MMEM * 1024; bf16* km = (bf16*)(F.ws + WS_KM) + (size_t)l * MMEM * 512;
    for (int bh = 0; bh < BATCH * XH; ++bh) { const int b = bh >> 2, h = bh & 3;
        norm128_rows(F, kvm + (size_t)b * MEMLEN * 1024 + h * 128, 1024, km + (size_t)bh * MEMLEN * 128, 128, MEMLEN, a.in[I_XKN] + l * 128, gw, NGW); }
}

__device__ __forceinline__ void phase_cross_attn(const Frame& F, const Args& a, int l) {
    char* lds = (char*)F.lds; const int r32 = F.lane & 31, hi = F.lane >> 5;
    const bf16* QX = (const bf16*)(F.ws + WS_QX); bf16* OX = (bf16*)(F.ws + WS_OX);
    for (int u = F.bid; u < BATCH * XH * (SEQ / 256); u += F.G) {
        const int tb = u % (SEQ / 256), bh = u / (SEQ / 256), b = bh >> 2, h = bh & 3;
        const size_t row0 = (size_t)b * SEQ + tb * 256 + F.wave * 32;
        const bf16* Kp = (const bf16*)(F.ws + WS_KM) + (size_t)l * MMEM * 512 + (size_t)bh * MEMLEN * 128;
        const bf16* Vp = (const bf16*)(F.ws + WS_KVM) + (size_t)l * MMEM * 1024 + (size_t)b * MEMLEN * 1024 + 512 + h * 128;
        const att::PassIO io{Kp, 128, Vp, 1024, 0, MEMLEN / 64}; att::attn_prefetch(lds, io);
        bf16x8 qr[8]; att::load_q(QX + (row0 + r32) * 512 + h * 128, a.in[I_XQN] + l * 128, hi, qr);
        f32x16 o[4]; float l_reg; att::attn_pass(lds, qr, io, att::NoMask{}, o, l_reg);
        float rli[16]; att::row_inv_l(lds, l_reg, rli);
#pragma unroll
        for (int r = 0; r < 16; ++r) { bf16* orow = OX + (row0 + att::crow(r, hi)) * 512 + h * 128;
#pragma unroll
            for (int d0 = 0; d0 < 4; ++d0) { const float v = o[d0][r] * rli[r]; const float vn = __shfl_xor(v, 1);
                if ((r32 & 1) == 0) *(GAS unsigned*)(orow + d0 * 32 + r32) = cvtpk(v, vn); } }
    }
}

constexpr int NSA_GSC = att::LDS_ATT, NSA_IMP = NSA_GSC + NWAVES * 32 * 3 * 4, NSA_SEL = NSA_IMP + NWAVES * 8 * 128 * 4, NSA_SELU = NSA_SEL + 64 * 4 * 4, NSA_LDS_END = NSA_SELU + NWAVES * 4 * 4;
static_assert(NSA_LDS_END <= SCR_BYTES, "nsa lds");
struct CmpMask { int nmax, hi, nmin_wave;
    __device__ __forceinline__ void operator()(f32x16& p0, f32x16& p1, int t) const { if (t * 64 + 63 <= nmin_wave) return; att::mask_tile(p0, p1, nmax - t * 64 - 4 * hi, 0x40000000u); }
    __device__ __forceinline__ bool active(int) const { return true; } __device__ __forceinline__ bool keep(int) const { return true; } };
struct WinMask { int P, hi, qb;
    __device__ __forceinline__ void operator()(f32x16& p0, f32x16& p1, int t) const { if (t == qb || t == qb - 8) att::mask_tile(p0, p1, P - t * 64 - 4 * hi, 512u); }
    __device__ __forceinline__ bool active(int) const { return true; } __device__ __forceinline__ bool keep(int) const { return true; } };
struct SlcMask { const LAS unsigned* selw; const LAS unsigned* uni; int P, hi, qb;
    __device__ __forceinline__ void operator()(f32x16& p0, f32x16& p1, int t) const { if (t == qb) att::mask_tile(p0, p1, P - t * 64 - 4 * hi, 0x40000000u); }
    __device__ __forceinline__ bool keep(int t) const { return (selw[t >> 5] >> (t & 31)) & 1u; }
    __device__ __forceinline__ bool active(int t) const { return (__builtin_amdgcn_readfirstlane(uni[t >> 5]) >> (t & 31)) & 1u; } };

__device__ __forceinline__ void nsa_unit(const Frame& F, const Args& a, int b, int g, int qb, int dry = 0) {
    char* lds = (char*)F.lds; const int w = F.wave; const int t0 = qb * 64;
#define NSA_LANE() int lane = F.lane; asm volatile("" : "+v"(lane)); const int r32 = lane & 31, hi = lane >> 5; const int tok = 8 * w + (r32 >> 2), head = 4 * g + (r32 & 3), P = t0 + tok; (void)head; (void)P; (void)tok
    unsigned char* wsl = F.ws; asm volatile("" : "+s"(wsl));
    const bf16* Y0 = (const bf16*)(wsl + WS_Y0); const bf16* KV6 = (const bf16*)(wsl + WS_KV6);
    const size_t slab = (size_t)SEQ * 128, bg = (size_t)(b * 2 + g);
    LAS float* gsc = (LAS float*)(F.lds + NSA_GSC) + w * 96; LAS float* imp = (LAS float*)(F.lds + NSA_IMP) + w * 1024; LAS unsigned* selm = (LAS unsigned*)(F.lds + NSA_SEL);
    f32x16 o[4]; float l_reg; float rli[16];
    const bf16* KCMP = (const bf16*)(wsl + WS_KVCMP) + bg * 512 * 128; const bf16* VCMP = (const bf16*)(wsl + WS_KVCMP) + (size_t)2048 * 128 + bg * 512 * 128;
    const int ncmp_t = ((4 * qb + 2) >> 6) + 1;
    const att::PassIO io_imp{KCMP, 128, (const bf16*)(wsl + WS_OV), 128, 0, ncmp_t}, io_cmp{KCMP, 128, VCMP, 128, 0, ncmp_t},
                      io_slc{KV6 + (2 * 4 + bg) * slab, 128, KV6 + (3 * 4 + bg) * slab, 128, 0, qb + 1}, io_win{KV6 + (4 * 4 + bg) * slab, 128, KV6 + (5 * 4 + bg) * slab, 128, qb >= 8 ? qb - 8 : 0, qb + 1};
    v4u qraw[8];
#define NSA_QISSUE() do { NSA_LANE(); att::q_issue(Y0 + ((size_t)b * SEQ + P) * EV_INP + 2048 + head * 128, hi, qraw); } while (0)
    att::attn_prefetch(lds, io_imp); NSA_QISSUE();
    { NSA_LANE();
      if (hi == 0) {
#pragma unroll
        for (int br = 0; br < 3; ++br) gsc[r32 * 3 + br] = fsigmoid(bf2f(Y0[((size_t)b * SEQ + P) * EV_INP + 4608 + head * 3 + br]) + a.in[I_GATEB][head * 3 + br]); }
      LDS_WAIT(); }
    { NSA_LANE(); const CmpMask cm{(P - 31) >> 4, hi, (t0 + 8 * w - 31) >> 4};
      bf16x8 qr[8]; att::q_finish(qraw, a.in[I_QNORM], hi, qr);
      if (dry < 2) att::attn_pass(lds, qr, io_imp, cm, o, l_reg); else { VM_WAIT(); __syncthreads(); l_reg = 1.f; } }
    att::attn_prefetch(lds, io_cmp); NSA_QISSUE();
    if (dry < 3) {
    att::row_inv_l(lds, l_reg, rli);
    { NSA_LANE();
#pragma unroll
    for (int q = 0; q < 4; ++q)
#pragma unroll
        for (int d = 0; d < 4; ++d) { float s = 0.f;
#pragma unroll
            for (int i = 0; i < 4; ++i) s += o[d][4 * q + i] * rli[4 * q + i];
            imp[(2 * q + hi) * 128 + d * 32 + r32] = s; }
    LDS_WAIT();
    { const unsigned long long lt = (1ull << lane) - 1ull;
#pragma unroll 1
    for (int tg = 0; tg < 8; tg += 4) { unsigned k0[4], k1[4], T[4];
#pragma unroll
        for (int u = 0; u < 4; ++u) { const int tl = tg + u; const int j0 = lane, j1 = lane + 64; const float v0 = imp[tl * 128 + j0], v1 = imp[tl * 128 + j1];
          const float s0 = v0 + (((j0 == 0) || (j0 == qb) || (j0 == qb - 1)) ? 100.f : 0.f), s1 = v1 + (((j1 == 0) || (j1 == qb) || (j1 == qb - 1)) ? 100.f : 0.f);
          k0[u] = (j0 <= qb) ? __float_as_uint(s0) + 1u : 0u; k1[u] = (j1 <= qb) ? __float_as_uint(s1) + 1u : 0u; T[u] = 0u; }
#pragma unroll 1
        for (int bit = 30; bit >= 0; --bit) {
#pragma unroll
            for (int u = 0; u < 4; ++u) { const unsigned cand = T[u] | (1u << bit);
                const int cnt = __popcll(__ballot(k0[u] >= cand)) + __popcll(__ballot(k1[u] >= cand)); if (cnt >= 16) T[u] = cand; } }
#pragma unroll
        for (int u = 0; u < 4; ++u) { const int tl = tg + u;
        const unsigned long long g0 = __ballot(k0[u] > T[u]), g1 = __ballot(k1[u] > T[u]), e0 = __ballot(k0[u] == T[u]), e1 = __ballot(k1[u] == T[u]);
        const int need = 16 - (__popcll(g0) + __popcll(g1));
        const bool sel0 = (k0[u] > T[u]) || (k0[u] == T[u] && __popcll(e0 & lt) < need), sel1 = (k1[u] > T[u]) || (k1[u] == T[u] && __popcll(e0) + __popcll(e1 & lt) < need);
        const unsigned long long m0 = __ballot(sel0 && lane <= qb), m1 = __ballot(sel1 && lane + 64 <= qb);
        if (lane == 0) { LAS unsigned* sw = selm + (8 * w + tl) * 4; sw[0] = (unsigned)m0; sw[1] = (unsigned)(m0 >> 32); sw[2] = (unsigned)m1; sw[3] = (unsigned)(m1 >> 32); } } } }
    LDS_WAIT();
    if (lane < 4) { unsigned u = 0;
#pragma unroll
        for (int tl = 0; tl < 8; ++tl) u |= selm[(8 * w + tl) * 4 + lane];
        ((LAS unsigned*)(F.lds + NSA_SELU))[w * 4 + lane] = u; }
    LDS_WAIT(); }
    }
    { NSA_LANE(); const CmpMask cm{(P - 31) >> 4, hi, (t0 + 8 * w - 31) >> 4};
      bf16x8 qr[8]; att::q_finish(qraw, a.in[I_QNORM], hi, qr);
#if defined(MK_NSA_DUP) && MK_NSA_DUP == 2
      att::attn_pass(lds, qr, io_cmp, cm, o, l_reg); att::attn_prefetch(lds, io_cmp);
#endif
      if (dry < 2) att::attn_pass(lds, qr, io_cmp, cm, o, l_reg); else { VM_WAIT(); __syncthreads(); l_reg = 1.f; } }
    att::attn_prefetch(lds, io_slc); NSA_QISSUE();
    att::row_inv_l(lds, l_reg, rli);
    unsigned oacc[4][8];
    if (dry < 4) { NSA_LANE();
#pragma unroll
    for (int r = 0; r < 16; ++r) rli[r] *= gsc[att::crow(r, hi) * 3 + 0];
#pragma unroll
    for (int d = 0; d < 4; ++d)
#pragma unroll
        for (int r = 0; r < 16; r += 2) oacc[d][r >> 1] = cvtpk(o[d][r] * rli[r], o[d][r + 1] * rli[r + 1]); }
    { NSA_LANE(); const SlcMask sm{selm + tok * 4, (const LAS unsigned*)(F.lds + NSA_SELU) + w * 4, P, hi, qb};
      bf16x8 qr[8]; att::q_finish(qraw, a.in[I_QNORM], hi, qr);
#if defined(MK_NSA_DUP) && MK_NSA_DUP == 5
      { const size_t bg2 = (bg + 1) & 3; const att::PassIO io_cold{KV6 + (2 * 4 + bg2) * slab, 128, KV6 + (3 * 4 + bg2) * slab, 128, 0, qb + 1};
        att::attn_pass(lds, qr, io_cold, sm, o, l_reg); att::attn_prefetch(lds, io_slc); }
#endif
#if defined(MK_NSA_DUP) && MK_NSA_DUP == 3
      att::attn_pass(lds, qr, io_slc, sm, o, l_reg); att::attn_prefetch(lds, io_slc);
#endif
      if (!dry) att::attn_pass(lds, qr, io_slc, sm, o, l_reg); else { VM_WAIT(); __syncthreads(); } }
    att::attn_prefetch(lds, io_win); NSA_QISSUE();
    att::row_inv_l(lds, l_reg, rli);
    if (dry < 4) { NSA_LANE();
#pragma unroll
    for (int r = 0; r < 16; ++r) rli[r] *= gsc[att::crow(r, hi) * 3 + 1];
#pragma unroll
    for (int d = 0; d < 4; ++d)
#pragma unroll
        for (int r = 0; r < 16; r += 2) oacc[d][r >> 1] = cvtpk(bflo(oacc[d][r >> 1]) + o[d][r] * rli[r], bfhi(oacc[d][r >> 1]) + o[d][r + 1] * rli[r + 1]); }
    { NSA_LANE(); const WinMask wm{P, hi, qb};
      bf16x8 qr[8]; att::q_finish(qraw, a.in[I_QNORM], hi, qr);
#if defined(MK_NSA_DUP) && MK_NSA_DUP == 4
      att::attn_pass(lds, qr, io_win, wm, o, l_reg); att::attn_prefetch(lds, io_win);
#endif
      if (dry < 2) att::attn_pass(lds, qr, io_win, wm, o, l_reg); else { VM_WAIT(); __syncthreads(); l_reg = 1.f; } }
    att::row_inv_l(lds, l_reg, rli);
    if (dry < 4) { NSA_LANE();
    bf16* MIX = dry ? (bf16*)(wsl + WS_R + 400 * MiB) : (bf16*)(wsl + WS_MIX);
#pragma unroll
    for (int r = 0; r < 16; ++r) rli[r] *= gsc[att::crow(r, hi) * 3 + 2];
    bf16* obase = MIX + ((size_t)b * SEQ + t0 + 8 * w) * 2048 + 1024 + 4 * g * 128 + r32;
#pragma unroll
    for (int d0 = 0; d0 < 4; ++d0) {
#pragma unroll
        for (int r = 0; r < 16; ++r) { const int row = att::crow(r, hi); const float v = ((r & 1) ? bfhi(oacc[d0][r >> 1]) : bflo(oacc[d0][r >> 1])) + o[d0][r] * rli[r]; const float vn = __shfl_xor(v, 1);
            if ((r32 & 1) == 0) *(GAS unsigned*)(obase + (size_t)(row >> 2) * 2048 + (row & 3) * 128 + d0 * 32) = cvtpk(v, vn); }
        } }
    __syncthreads();
#undef NSA_QISSUE
#undef NSA_LANE
}
__device__ __forceinline__ void phase_nsa(const Frame& F, const Args& a) {
#pragma unroll 1
    for (int it = F.bid * 2; it < 512; it += F.G * 2)
#pragma unroll 1
        for (int k = 0; k < 2; ++k) { const int p = it >> 1, xcd = p & 7, bg = xcd >> 1, x = (xcd & 1) * 32 + (p >> 3);
#if defined(MK_NSA_DRY)
            nsa_unit(F, a, bg >> 1, bg & 1, k == 0 ? 127 - x : x, MK_NSA_DRY);
#endif
            nsa_unit(F, a, bg >> 1, bg & 1, k == 0 ? 127 - x : x); }
}
__device__ __forceinline__ f32x4 mma16(const LAS bf16* A, int pa, const LAS bf16* B, int pb, int K, f32x4 acc, int fr, int fq) {
    for (int k0 = 0; k0 < K; k0 += 32) { const bf16x8 af = *(const LAS bf16x8*)(A + fr * pa + k0 + 8 * fq); const bf16x8 bfv = *(const LAS bf16x8*)(B + fr * pb + k0 + 8 * fq);
        acc = __builtin_amdgcn_mfma_f32_16x16x32_bf16(af, bfv, acc, 0, 0, 0); }
    return acc;
}

__device__ __forceinline__ f32x4 mma16r(const LAS bf16* Arow, const LAS bf16* Brow, int K, f32x4 acc, int fq) {
    for (int k0 = 0; k0 < K; k0 += 32) { const bf16x8 af = *(const LAS bf16x8*)(Arow + k0 + 8 * fq); const bf16x8 bfv = *(const LAS bf16x8*)(Brow + k0 + 8 * fq);
        acc = __builtin_amdgcn_mfma_f32_16x16x32_bf16(af, bfv, acc, 0, 0, 0); }
    return acc;
}

__device__ __forceinline__ void phase_cmp2(const Frame& F, const Args& a, int u_lo, int u_hi, int u_step) {
    LAS bf16* hidS = (LAS bf16*)F.lds; LAS bf16* w2T = (LAS bf16*)(F.lds + 32 * 264 * 2); LAS float* outS = (LAS float*)(F.lds + 32 * 264 * 2 + 128 * 264 * 2);
    const int fr = F.lane & 15, fq = F.lane >> 4;
    for (int u = u_lo; u < u_hi; u += u_step) { const int mm = u >> 6, rb = u & 63;
        const bf16* hid = (const bf16*)(F.ws + WS_HID) + (size_t)mm * 2048 * 256 + (size_t)rb * 32 * 256; const float* w2 = a.in[mm ? I_CVW2 : I_CKW2];
        for (int i = F.tid; i < 32 * 32; i += NTHR) { const int r = i >> 5, c8 = i & 31; *(LAS v4u*)(hidS + r * 264 + c8 * 8) = *(const GAS v4u*)(hid + r * 256 + c8 * 8); }
        for (int i = F.tid; i < 256 * 128; i += NTHR) { const int k = i >> 7, c = i & 127; w2T[c * 264 + k] = (bf16)f2bf(w2[i]); }
        __syncthreads();
        const int rt = F.wave & 1;
#pragma unroll
        for (int cc = 0; cc < 2; ++cc) { const int ct = (F.wave >> 1) * 2 + cc; f32x4 acc = {0.f, 0.f, 0.f, 0.f};
            acc = mma16(hidS + rt * 16 * 264, 264, w2T + ct * 16 * 264, 264, 256, acc, fr, fq);
#pragma unroll
            for (int e = 0; e < 4; ++e) outS[(rt * 16 + 4 * fq + e) * 132 + ct * 16 + fr] = acc[e]; }
        __syncthreads();
        { const int r = F.wave * 4 + (F.lane >> 4), l16 = F.lane & 15; const int grow = rb * 32 + r, n = grow & 511;
          float v[8]; float ss = 0.f;
#pragma unroll
          for (int j = 0; j < 8; ++j) { v[j] = outS[r * 132 + l16 * 8 + j]; ss += v[j] * v[j]; }
          ss += __shfl_xor(ss, 1); ss += __shfl_xor(ss, 2); ss += __shfl_xor(ss, 4); ss += __shfl_xor(ss, 8);
          if (mm == 0) { const float rstd = 1.f / sqrtf(ss * (1.f / 128.f) + EPS); const float* g = a.in[I_KNORM];
#pragma unroll
              for (int j = 0; j < 8; ++j) v[j] = v[j] * rstd * g[l16 * 8 + j]; }
          if (n == 511) {
#pragma unroll
              for (int j = 0; j < 8; ++j) v[j] = 0.f; }
          v4u w; w.x = cvtpk(v[0], v[1]); w.y = cvtpk(v[2], v[3]); w.z = cvtpk(v[4], v[5]); w.w = cvtpk(v[6], v[7]);
          *(GAS v4u*)((bf16*)(F.ws + WS_KVCMP) + (size_t)mm * 2048 * 128 + (size_t)grow * 128 + l16 * 8) = w; }
        __syncthreads();
    }
}

__device__ __forceinline__ void rglru_unit(const Frame& F, const Args& a, int b, int h, int s) {
    const int w = F.wave, lane = F.lane, fr = lane & 15, fq = lane >> 4;
    LAS bf16* xcs = (LAS bf16*)F.lds + w * (16 * 136); LAS float* summ = (LAS float*)(F.lds + 8 * 16 * 136 * 2);
    const bf16* Y0 = (const bf16*)(F.ws + WS_Y0) + (size_t)b * SEQ * EV_INP; bf16* MIX = (bf16*)(F.ws + WS_MIX) + (size_t)b * SEQ * 2048;
    const int ch = h * 128 + s * 16 + fr;
    bf16x8 ba_f[4], bx_f[4];
    { const float* wa = a.in[I_RGWA] + (size_t)h * 128 * 128 + s * 16 + fr; const float* wx = a.in[I_RGWX] + (size_t)h * 128 * 128 + s * 16 + fr;
#pragma unroll
      for (int kk = 0; kk < 4; ++kk) { v4u ua, ux;
#pragma unroll
          for (int e2 = 0; e2 < 4; ++e2) { const int k = 32 * kk + 8 * fq + 2 * e2; ua[e2] = pk2(wa[(size_t)k * 128], wa[(size_t)(k + 1) * 128]); ux[e2] = pk2(wx[(size_t)k * 128], wx[(size_t)(k + 1) * 128]); }
          ba_f[kk] = *reinterpret_cast<bf16x8*>(&ua); bx_f[kk] = *reinterpret_cast<bf16x8*>(&ux); } }
    const float bias_a = a.in[I_RGBA][ch], bias_x = a.in[I_RGBX][ch], c8 = -8.f * fsoftplus(-a.in[I_RGLAM][ch]);
    const int cg = h * 128 + 2 * lane; float cw0[4], cw1[4];
#pragma unroll
    for (int j = 0; j < 4; ++j) { cw0[j] = a.in[I_RGCW][j * 1024 + cg]; cw1[j] = a.in[I_RGCW][j * 1024 + cg + 1]; }
    const float cb0 = a.in[I_RGCB][cg], cb1 = a.in[I_RGCB][cg + 1];
    float carry = 0.f;
    unsigned raw[19];
#define RG_LOAD(c_) do { const int T0_ = (c_) * 128 + 16 * w; _Pragma("unroll") for (int i = 0; i < 19; ++i) { const int t = T0_ - 3 + i; raw[i] = (t >= 0) ? *(const GAS unsigned*)(Y0 + (size_t)t * EV_INP + cg) : 0u; } } while (0)
    RG_LOAD(0);
#ifdef MK_DUP_RG
    for (int cc = 0; cc < 2 * (SEQ / 128); ++cc) { const int c = cc & (SEQ / 128 - 1); if (cc == SEQ / 128) { carry = 0.f; RG_LOAD(0); }
#else
    for (int c = 0; c < SEQ / 128; ++c) {
#endif
        const int T0 = c * 128 + 16 * w;
#pragma unroll
        for (int tt = 0; tt < 16; ++tt) { float y0 = cb0, y1 = cb1;
#pragma unroll
            for (int j = 0; j < 4; ++j) { y0 += cw0[j] * bflo(raw[tt + j]); y1 += cw1[j] * bfhi(raw[tt + j]); }
            *(LAS unsigned*)(xcs + tt * 136 + 2 * lane) = cvtpk(y0, y1); }
        LDS_WAIT();
        if (c + 1 < SEQ / 128) RG_LOAD(c + 1);
        unsigned short gg[4];
#pragma unroll
        for (int e = 0; e < 4; ++e) gg[e] = Y0[(size_t)(T0 + 4 * fq + e) * EV_INP + 1024 + ch];
        f32x4 acc_a = {0.f, 0.f, 0.f, 0.f}, acc_x = {0.f, 0.f, 0.f, 0.f};
#pragma unroll
        for (int kk = 0; kk < 4; ++kk) { const bf16x8 af = *(const LAS bf16x8*)(xcs + fr * 136 + 32 * kk + 8 * fq);
            acc_a = __builtin_amdgcn_mfma_f32_16x16x32_bf16(af, ba_f[kk], acc_a, 0, 0, 0); acc_x = __builtin_amdgcn_mfma_f32_16x16x32_bf16(af, bx_f[kk], acc_x, 0, 0, 0); }
        float hl[4], pl[4]; float hh = 0.f, pp = 1.f;
#pragma unroll
        for (int e = 0; e < 4; ++e) { const float xv = bf2f(xcs[(4 * fq + e) * 136 + s * 16 + fr]);
            const float r = fsigmoid(acc_a[e] + bias_a), ig = fsigmoid(acc_x[e] + bias_x); const float la = c8 * r; const float av = __expf(la);
            const float uu = __builtin_amdgcn_sqrtf((1.f - av) * (1.f + av)) * (ig * xv);
            hh = av * hh + uu; pp *= av; hl[e] = hh; pl[e] = pp; }
        float Apre = 1.f, Hpre = 0.f, Aw = 1.f, Hw = 0.f;
#pragma unroll
        for (int q = 0; q < 4; ++q) { const float Aq = __shfl(pp, fr + 16 * q), Hq = __shfl(hh, fr + 16 * q);
            if (q < fq) { Hpre = Aq * Hpre + Hq; Apre *= Aq; }
            Hw = Aq * Hw + Hq; Aw *= Aq; }
        LAS float* sm = summ + (c & 1) * 256;
        if (fq == 0) { sm[(w * 16 + fr) * 2] = Aw; sm[(w * 16 + fr) * 2 + 1] = Hw; }
        __syncthreads();
        float cin = carry, call = carry;
#pragma unroll
        for (int q = 0; q < 8; ++q) { const float Aq = sm[(q * 16 + fr) * 2], Hq = sm[(q * 16 + fr) * 2 + 1]; call = Aq * call + Hq; if (q < w) cin = call; }
        carry = call;
        const float cl = Apre * cin + Hpre;
#pragma unroll
        for (int e = 0; e < 4; ++e) { const float hv = hl[e] + pl[e] * cl; MIX[(size_t)(T0 + 4 * fq + e) * 2048 + ch] = (bf16)f2bf(gelu_tanh(bf2f(gg[e])) * hv); }
    }
#undef RG_LOAD
    __syncthreads();
}
constexpr size_t WS_M_CN = WS_R + 168 * MiB + 64 * MiB;
constexpr size_t WS_M_BN = WS_M_CN + 16 * MiB, WS_M_BT = WS_M_BN + 16 * MiB, WS_M_XT = WS_M_BT + 16 * MiB, WS_M_ACS = WS_M_XT + 64 * MiB, WS_M_DTV = WS_M_ACS + 2 * MiB,
                 WS_M_ST = WS_M_DTV + 2 * MiB, WS_M_PV = WS_M_ST + 128 * MiB, WS_M_END = WS_M_PV + 64 * MiB;
static_assert(WS_M_END <= WS_R + 560 * MiB, "mamba ws");
constexpr int MB_P = 136;
__device__ __forceinline__ void conv4_silu(const v4u (&rows)[7], const float* cw, int ldw, const float* cb, float (&out)[4][8]) {
    float wv[4][8], bv[8];
#pragma unroll
    for (int j = 0; j < 4; ++j) { const f32x4 w0 = *(const GAS f32x4*)(cw + (size_t)j * ldw), w1 = *(const GAS f32x4*)(cw + (size_t)j * ldw + 4);
#pragma unroll
        for (int i = 0; i < 4; ++i) { wv[j][i] = w0[i]; wv[j][4 + i] = w1[i]; } }
    { const f32x4 b0 = *(const GAS f32x4*)cb, b1 = *(const GAS f32x4*)(cb + 4);
#pragma unroll
      for (int i = 0; i < 4; ++i) { bv[i] = b0[i]; bv[4 + i] = b1[i]; } }
#pragma unroll
    for (int tt = 0; tt < 4; ++tt)
#pragma unroll
        for (int i2 = 0; i2 < 4; ++i2) { float y0 = bv[2 * i2], y1 = bv[2 * i2 + 1];
#pragma unroll
            for (int j = 0; j < 4; ++j) { y0 += wv[j][2 * i2] * bflo(rows[tt + j][i2]); y1 += wv[j][2 * i2 + 1] * bfhi(rows[tt + j][i2]); }
            out[tt][2 * i2] = fsilu(y0); out[tt][2 * i2 + 1] = fsilu(y1); }
}
__device__ __forceinline__ void od_dt_cols(const Frame& F, const bf16* X, const bf16* Wt, const float* ssq, bf16* Y1) {
    typedef float f32x16_t __attribute__((ext_vector_type(16)));
    int t_ = threadIdx.x; asm volatile("" : "+v"(t_));
    const int wave = __builtin_amdgcn_readfirstlane(t_ >> 6), lane = t_ & 63;
    const int r32 = lane & 31, hi = lane >> 5, kq = wave & 3;
    LAS float* red = (LAS float*)F.lds;
    for (int t0 = F.bid * 2; t0 < M / 32; t0 += F.G * 2) { const int r0 = (t0 + (wave >> 2)) * 32;
        const bf16* xa = X + (size_t)(r0 + r32) * D + 256 * kq + 8 * hi; const bf16* wb = Wt + (size_t)(5120 + r32) * D + 256 * kq + 8 * hi;
        f32x16_t acc;
#pragma unroll
        for (int r = 0; r < 16; ++r) acc[r] = 0.f;
        pg8::bf16x8 av[16], bv[16];
#pragma unroll
        for (int u = 0; u < 16; ++u) { av[u] = *(const GAS pg8::bf16x8*)(xa + 16 * u); bv[u] = *(const GAS pg8::bf16x8*)(wb + 16 * u); }
#pragma unroll
        for (int u = 0; u < 16; ++u) acc = __builtin_amdgcn_mfma_f32_32x32x16_bf16(av[u], bv[u], acc, 0, 0, 0);
        if (kq != 0) {
#pragma unroll
            for (int r = 0; r < 16; ++r) red[(wave * 16 + r) * 64 + lane] = acc[r]; }
        __syncthreads();
        if (kq == 0) { const float rs_l = pg8::row_rstd(ssq, r0 + r32);
#pragma unroll
            for (int r = 0; r < 16; ++r) { const int row = (r & 3) + 8 * (r >> 2) + 4 * hi; const float rs = __shfl(rs_l, row);
                const float v = (acc[r] + red[((wave + 1) * 16 + r) * 64 + lane]) + (red[((wave + 2) * 16 + r) * 64 + lane] + red[((wave + 3) * 16 + r) * 64 + lane]);
                Y1[(size_t)(r0 + row) * OD_INP + 5120 + r32] = (bf16)f2bf(v * rs); } }
        __syncthreads();
    }
}
__device__ __forceinline__ void phase_mamba_prep(const Frame& F, const Args& a) {
    LAS bf16* T = (LAS bf16*)F.lds;
    LAS float* acsS = (LAS float*)(F.lds + 128 * MB_P * 2); LAS float* dtS = acsS + 256;
    const int tid = F.tid, lane = F.lane, w = F.wave, sg = tid >> 4, cv = tid & 15;
    const float* cw = a.in[I_ODCW]; const float* cb = a.in[I_ODCB];
    v4u rows[7]; unsigned short dtr0 = 0, dtr1 = 0;
#define M0_LOAD(u_) do { const int bc_ = (u_) / 24, sl_ = (u_) % 24, T0_ = (bc_ & 63) * 128; const bf16* Y1_ = (const bf16*)(F.ws + WS_Y1) + (size_t)(bc_ >> 6) * SEQ * OD_INP; \
        _Pragma("unroll") for (int i = 0; i < 7; ++i) { const int t = T0_ + 4 * sg - 3 + i; rows[i] = (t >= 0) ? *(const GAS v4u*)(Y1_ + (size_t)t * OD_INP + 2048 + sl_ * 128 + cv * 8) : (v4u){0u, 0u, 0u, 0u}; } \
        if (sl_ < 16 && w < 2) { dtr0 = Y1_[(size_t)(T0_ + 2 * lane) * OD_INP + 5120 + 2 * sl_ + w]; dtr1 = Y1_[(size_t)(T0_ + 2 * lane + 1) * OD_INP + 5120 + 2 * sl_ + w]; } } while (0)
    if (F.bid < 128 * 24) M0_LOAD(F.bid);
    for (int u = F.bid; u < 128 * 24; u += F.G) { const int bc = u / 24, sl = u % 24, b = bc >> 6, c = bc & 63, T0 = c * 128;
        const bf16* Y1 = (const bf16*)(F.ws + WS_Y1) + (size_t)b * SEQ * OD_INP; const int ch0 = sl * 128;
        const unsigned short dc0 = dtr0, dc1 = dtr1;
        { float vals[4][8];
          conv4_silu(rows, cw + ch0 + cv * 8, 3072, cb + ch0 + cv * 8, vals);
          if (u + F.G < 128 * 24) M0_LOAD(u + F.G);
#pragma unroll
          for (int tt = 0; tt < 4; ++tt) { v4u o; o.x = cvtpk(vals[tt][0], vals[tt][1]); o.y = cvtpk(vals[tt][2], vals[tt][3]); o.z = cvtpk(vals[tt][4], vals[tt][5]); o.w = cvtpk(vals[tt][6], vals[tt][7]);
              *(LAS v4u*)(T + (4 * sg + tt) * MB_P + cv * 8) = o; } }
        if (sl < 16 && w < 2) { const int h = 2 * sl + w;
            const float Ah = -__expf(a.in[I_ALOG][h]), dtb = a.in[I_DTB][h];
            const float d0 = fsoftplus(bf2f(dc0) + dtb), d1 = fsoftplus(bf2f(dc1) + dtb);
            const float a0 = d0 * Ah, a1 = d1 * Ah; float pr = a0 + a1;
#pragma unroll
            for (int off = 1; off < 64; off <<= 1) { const float t = __shfl_up(pr, off); if (lane >= off) pr += t; }
            const float ex = pr - (a0 + a1); const float c0 = ex + a0, c1 = ex + a0 + a1;
            acsS[w * 128 + 2 * lane] = c0; acsS[w * 128 + 2 * lane + 1] = c1; dtS[w * 128 + 2 * lane] = d0; dtS[w * 128 + 2 * lane + 1] = d1;
            float* ACS = (float*)(F.ws + WS_M_ACS) + ((size_t)bc * 32 + h) * 128; float* DTV = (float*)(F.ws + WS_M_DTV) + ((size_t)bc * 32 + h) * 128;
            typedef float f32x2v __attribute__((ext_vector_type(2))); *(GAS f32x2v*)(ACS + 2 * lane) = (f32x2v){c0, c1}; *(GAS f32x2v*)(DTV + 2 * lane) = (f32x2v){d0, d1}; }
        __syncthreads();
        if (sl < 16) {
            const int cc = tid >> 2, s0 = (tid & 3) * 32, hh = cc >> 6; bf16* XT = (bf16*)(F.ws + WS_M_XT) + (((size_t)bc * 32 + 2 * sl) * 64 + cc) * 128 + s0;
#pragma unroll
            for (int k8 = 0; k8 < 4; ++k8) { float v[8];
#pragma unroll
                for (int k = 0; k < 8; ++k) { const int s = s0 + 8 * k8 + k; v[k] = bf2f(T[s * MB_P + cc]) * dtS[hh * 128 + s]; }
                v4u o; o.x = cvtpk(v[0], v[1]); o.y = cvtpk(v[2], v[3]); o.z = cvtpk(v[4], v[5]); o.w = cvtpk(v[6], v[7]); *(GAS v4u*)(XT + 8 * k8) = o; } }
        else { const int g = (sl - 16) & 3; const bool isB = sl < 20;
            bf16* N = (bf16*)(F.ws + (isB ? WS_M_BN : WS_M_CN)) + ((size_t)b * SEQ + T0) * 512 + g * 128;
            for (int i = tid; i < 128 * 16; i += NTHR) { const int s = i >> 4, c8 = i & 15; *(GAS v4u*)(N + (size_t)s * 512 + c8 * 8) = *(const LAS v4u*)(T + s * MB_P + c8 * 8); }
            if (isB) { const int cc = tid >> 2, s0 = (tid & 3) * 32; bf16* BT = (bf16*)(F.ws + WS_M_BT) + (((size_t)bc * 4 + g) * 128 + cc) * 128 + s0;
#pragma unroll
                for (int k8 = 0; k8 < 4; ++k8) { unsigned short v[8];
#pragma unroll
                    for (int k = 0; k < 8; ++k) v[k] = T[(s0 + 8 * k8 + k) * MB_P + cc];
                    v4u o; o.x = v[0] | ((unsigned)v[1] << 16); o.y = v[2] | ((unsigned)v[3] << 16); o.z = v[4] | ((unsigned)v[5] << 16); o.w = v[6] | ((unsigned)v[7] << 16); *(GAS v4u*)(BT + 8 * k8) = o; } } }
        __syncthreads();
    }
#undef M0_LOAD
}
__device__ __forceinline__ void phase_mamba_states(const Frame& F) {
    LAS bf16* BTs = (LAS bf16*)F.lds; LAS bf16* XW = (LAS bf16*)(F.lds + 128 * MB_P * 2); LAS bf16* STs = (LAS bf16*)(F.lds + 192 * MB_P * 2);
    const int tid = F.tid, lane = F.lane, w = F.wave, fr = lane & 15, fq = lane >> 4;
    for (int u = F.bid; u < 128 * 4; u += F.G) { const int bc = u >> 2, g = u & 3;
        const bf16* BT = (const bf16*)(F.ws + WS_M_BT) + ((size_t)bc * 4 + g) * 128 * 128;
        for (int i = tid; i < 128 * 16; i += NTHR) { const int n = i >> 4, c8 = i & 15; *(LAS v4u*)(BTs + n * MB_P + c8 * 8) = *(const GAS v4u*)(BT + (size_t)n * 128 + c8 * 8); }
        v4u pr[2]; f32x4 pa0, pa1; float paL;
#define M1_PF(hh_) do { const int h_ = g * 8 + (hh_); const bf16* XT_ = (const bf16*)(F.ws + WS_M_XT) + ((size_t)bc * 32 + h_) * 64 * 128; const float* ACS_ = (const float*)(F.ws + WS_M_ACS) + ((size_t)bc * 32 + h_) * 128; \
            paL = ACS_[127]; pa0 = *(const GAS f32x4*)(ACS_ + (tid & 15) * 8); pa1 = *(const GAS f32x4*)(ACS_ + (tid & 15) * 8 + 4); \
            _Pragma("unroll") for (int k = 0; k < 2; ++k) { const int i = tid + k * NTHR, p_ = i >> 4, c8 = i & 15; pr[k] = *(const GAS v4u*)(XT_ + (size_t)p_ * 128 + c8 * 8); } } while (0)
        M1_PF(0);
#pragma unroll 1
        for (int hh = 0; hh < 8; ++hh) { const int h = g * 8 + hh;
            { const float aL = paL; const f32x4 a0 = pa0, a1 = pa1;
#pragma unroll
            for (int k = 0; k < 2; ++k) { const int i = tid + k * NTHR, p = i >> 4, c8 = i & 15; const v4u raw = pr[k];
                v4u o; o.x = cvtpk(bflo(raw[0]) * __expf(aL - a0[0]), bfhi(raw[0]) * __expf(aL - a0[1])); o.y = cvtpk(bflo(raw[1]) * __expf(aL - a0[2]), bfhi(raw[1]) * __expf(aL - a0[3]));
                o.z = cvtpk(bflo(raw[2]) * __expf(aL - a1[0]), bfhi(raw[2]) * __expf(aL - a1[1])); o.w = cvtpk(bflo(raw[3]) * __expf(aL - a1[2]), bfhi(raw[3]) * __expf(aL - a1[3]));
                *(LAS v4u*)(XW + p * MB_P + c8 * 8) = o; } }
            __syncthreads();
            if (hh + 1 < 8) M1_PF(hh + 1);
            bf16* ST = (bf16*)(F.ws + WS_M_ST) + ((size_t)bc * 32 + h) * 64 * 128;
#pragma unroll
            for (int pt = 0; pt < 4; ++pt) { f32x4 acc = {0.f, 0.f, 0.f, 0.f}; acc = mma16(XW + pt * 16 * MB_P, MB_P, BTs + w * 16 * MB_P, MB_P, 128, acc, fr, fq);
#pragma unroll
                for (int e = 0; e < 4; ++e) STs[(pt * 16 + 4 * fq + e) * MB_P + w * 16 + fr] = (bf16)f2bf(acc[e]); }
            __syncthreads();
#pragma unroll
            for (int k = 0; k < 2; ++k) { const int i = tid + k * NTHR, pp = i >> 4, c8 = i & 15; *(GAS v4u*)(ST + (size_t)pp * 128 + c8 * 8) = *(const LAS v4u*)(STs + pp * MB_P + c8 * 8); }
        }
#undef M1_PF
    }
}
__device__ __forceinline__ void phase_mamba_scan(const Frame& F) {
    const int gt = F.bid * NTHR + F.tid;
    const bf16* STg = (const bf16*)(F.ws + WS_M_ST); bf16* PVg = (bf16*)(F.ws + WS_M_PV); const float* ACSg = (const float*)(F.ws + WS_M_ACS);
    for (int i = gt; i < BATCH * 32 * 64 * 32; i += F.G * NTHR) { const int n4 = i & 31, p = (i >> 5) & 63, h = (i >> 11) & 31, b = i >> 16;
        f32x4 S = {0.f, 0.f, 0.f, 0.f};
        const size_t off0 = (((size_t)b * 64 * 32 + h) * 64 + p) * 128 + n4 * 4, cstep = (size_t)32 * 64 * 128;
        const float* al = ACSg + ((size_t)b * 64 * 32 + h) * 128 + 127;
#pragma unroll 1
        for (int c0 = 0; c0 < 64; c0 += 16) {
            v2u sr[16]; float dl[16];
#pragma unroll
            for (int j = 0; j < 16; ++j) { sr[j] = *(const GAS v2u*)(STg + off0 + (size_t)(c0 + j) * cstep); dl[j] = al[(size_t)(c0 + j) * 32 * 128]; }
#pragma unroll
            for (int j = 0; j < 16; ++j) { const float dec = __expf(dl[j]); const f32x4 st = {bflo(sr[j].x), bfhi(sr[j].x), bflo(sr[j].y), bfhi(sr[j].y)};
                v2u o; o.x = cvtpk(S[0], S[1]); o.y = cvtpk(S[2], S[3]); *(GAS v2u*)(PVg + off0 + (size_t)(c0 + j) * cstep) = o;
                S = S * dec + st; } } }
}
constexpr int M3_CS = 0, M3_BS = M3_CS + 128 * MB_P * 2, M3_MS = M3_BS + 128 * MB_P * 2, M3_XT = M3_MS + 128 * MB_P * 2, M3_PV = M3_XT + 64 * MB_P * 2, M3_ACS = M3_PV + 64 * MB_P * 2, M3_DT = M3_ACS + 512, M3_END = M3_DT + 512;
static_assert(M3_END <= SCR_BYTES, "mamba lds");
__device__ __forceinline__ void phase_mamba_out(const Frame& F, const Args& a) {
    LAS bf16* Cs = (LAS bf16*)(F.lds + M3_CS); LAS bf16* Bs = (LAS bf16*)(F.lds + M3_BS); LAS bf16* Ms = (LAS bf16*)(F.lds + M3_MS); LAS bf16* XTs = (LAS bf16*)(F.lds + M3_XT); LAS bf16* PVs = (LAS bf16*)(F.lds + M3_PV);
    LAS float* acs = (LAS float*)(F.lds + M3_ACS); LAS float* dtv = (LAS float*)(F.lds + M3_DT);
    const int tid = F.tid, lane = F.lane, w = F.wave, fr = lane & 15, fq = lane >> 4;
    for (int u = F.bid; u < 128 * 4; u += F.G) { const int bc = u >> 2, g = u & 3, b = bc >> 6, T0 = (bc & 63) * 128;
        const bf16* CN = (const bf16*)(F.ws + WS_M_CN) + ((size_t)b * SEQ + T0) * 512 + g * 128; const bf16* BN = (const bf16*)(F.ws + WS_M_BN) + ((size_t)b * SEQ + T0) * 512 + g * 128;
        for (int i = tid; i < 128 * 16; i += NTHR) { const int s = i >> 4, c8 = i & 15;
            *(LAS v4u*)(Cs + s * MB_P + c8 * 8) = *(const GAS v4u*)(CN + (size_t)s * 512 + c8 * 8); *(LAS v4u*)(Bs + s * MB_P + c8 * 8) = *(const GAS v4u*)(BN + (size_t)s * 512 + c8 * 8); }
        __syncthreads();
        f32x4 cbt[8];
#pragma unroll
        for (int st = 0; st < 8; ++st) { cbt[st] = (f32x4){0.f, 0.f, 0.f, 0.f}; if (st <= w) cbt[st] = mma16(Bs + st * 16 * MB_P, MB_P, Cs + w * 16 * MB_P, MB_P, 128, cbt[st], fr, fq); }
        const bf16* Y1 = (const bf16*)(F.ws + WS_Y1) + ((size_t)b * SEQ + T0) * OD_INP; bf16* YG = (bf16*)(F.ws + WS_YG) + ((size_t)b * SEQ + T0) * 2048;
        v4u pfx[2], pfp[2]; float pfa = 0.f, pfd = 0.f;
#define M3_PREFETCH(hh_) do { const int h_ = g * 8 + (hh_); const bf16* XT_ = (const bf16*)(F.ws + WS_M_XT) + ((size_t)bc * 32 + h_) * 64 * 128; const bf16* PV_ = (const bf16*)(F.ws + WS_M_PV) + ((size_t)bc * 32 + h_) * 64 * 128; \
            _Pragma("unroll") for (int k = 0; k < 2; ++k) { const int i = tid + k * NTHR, p = i >> 4, c8 = i & 15; pfx[k] = *(const GAS v4u*)(XT_ + (size_t)p * 128 + c8 * 8); pfp[k] = *(const GAS v4u*)(PV_ + (size_t)p * 128 + c8 * 8); } \
            if (tid < 128) { pfa = ((const float*)(F.ws + WS_M_ACS))[((size_t)bc * 32 + h_) * 128 + tid]; pfd = ((const float*)(F.ws + WS_M_DTV))[((size_t)bc * 32 + h_) * 128 + tid]; } } while (0)
        M3_PREFETCH(0);
#pragma unroll 1
        for (int hh = 0; hh < 8; ++hh) { const int h = g * 8 + hh; const float dsk = a.in[I_DSKIP][h];
#pragma unroll
            for (int k = 0; k < 2; ++k) { const int i = tid + k * NTHR, p = i >> 4, c8 = i & 15; *(LAS v4u*)(XTs + p * MB_P + c8 * 8) = pfx[k]; *(LAS v4u*)(PVs + p * MB_P + c8 * 8) = pfp[k]; }
            if (tid < 128) { acs[tid] = pfa; dtv[tid] = pfd; }
            __syncthreads();
            if (hh + 1 < 8) M3_PREFETCH(hh + 1);
            v4u zz[2];
#pragma unroll
            for (int k = 0; k < 2; ++k) zz[k] = *(const GAS v4u*)(Y1 + (size_t)(16 * w + fr) * OD_INP + h * 64 + 16 * fq + 8 * k);
            const float aq = acs[16 * w + fr];
#pragma unroll
            for (int st = 0; st < 8; ++st) { if (st <= w) { float mv[4];
#pragma unroll
                for (int e = 0; e < 4; ++e) { const int s = 16 * st + 4 * fq + e; mv[e] = (s <= 16 * w + fr) ? cbt[st][e] * __expf(aq - acs[s]) : 0.f; }
                v2u o; o.x = cvtpk(mv[0], mv[1]); o.y = cvtpk(mv[2], mv[3]); *(LAS v2u*)(Ms + (16 * w + fr) * MB_P + 16 * st + 4 * fq) = o; } }
            if ((w & 1) == 0) *(LAS v2u*)(Ms + (16 * w + fr) * MB_P + 16 * (w + 1) + 4 * fq) = (v2u){0u, 0u};
            LDS_WAIT();
            float yv[16]; { const int q = 16 * w + fr; const float eq = __expf(acs[q]), rdt = dsk * __builtin_amdgcn_rcpf(dtv[q]); const int prow = 16 * (fr >> 2) + (fr & 3);
#pragma unroll
            for (int pt = 0; pt < 4; ++pt) { f32x4 yd = {0.f, 0.f, 0.f, 0.f}, yo = {0.f, 0.f, 0.f, 0.f};
                yd = mma16r(XTs + (prow + 4 * pt) * MB_P, Ms + q * MB_P, ((w + 2) >> 1) * 32, yd, fq);
                yo = mma16r(PVs + (prow + 4 * pt) * MB_P, Cs + q * MB_P, 128, yo, fq);
#pragma unroll
                for (int e = 0; e < 4; ++e) { const int pp = 16 * fq + 4 * pt + e; yv[4 * pt + e] = yd[e] + eq * yo[e] + rdt * bf2f(XTs[pp * MB_P + q]); } } }
#pragma unroll
            for (int k = 0; k < 2; ++k) { v4u o;
#pragma unroll
                for (int j = 0; j < 4; ++j) o[j] = cvtpk(yv[8 * k + 2 * j] * fsilu(bflo(zz[k][j])), yv[8 * k + 2 * j + 1] * fsilu(bfhi(zz[k][j])));
                *(GAS v4u*)(YG + (size_t)(16 * w + fr) * 2048 + h * 64 + 16 * fq + 8 * k) = o; }
            __syncthreads();
        }
#undef M3_PREFETCH
        VM_WAIT(); __syncthreads();
        { const float* gn = a.in[I_ODNORM] + g * 512 + lane * 8; const f32x4 g0 = *(const GAS f32x4*)gn, g1 = *(const GAS f32x4*)(gn + 4);
          v4u rawt[16];
#pragma unroll
          for (int t = 0; t < 16; ++t) rawt[t] = *(const GAS v4u*)(YG + (size_t)(16 * w + t) * 2048 + g * 512 + lane * 8);
#pragma unroll
          for (int t = 0; t < 16; ++t) { bf16* pq = YG + (size_t)(16 * w + t) * 2048 + g * 512 + lane * 8; const v4u raw = rawt[t]; float ss = 0.f;
#pragma unroll
              for (int j = 0; j < 4; ++j) { const float x0 = bflo(raw[j]), x1 = bfhi(raw[j]); ss += x0 * x0 + x1 * x1; }
              const float rstd = 1.f / sqrtf(wave_sum(ss) * (1.f / 512.f) + EPS);
              v4u o; o.x = cvtpk(bflo(raw[0]) * rstd * g0[0], bfhi(raw[0]) * rstd * g0[1]); o.y = cvtpk(bflo(raw[1]) * rstd * g0[2], bfhi(raw[1]) * rstd * g0[3]);
              o.z = cvtpk(bflo(raw[2]) * rstd * g1[0], bfhi(raw[2]) * rstd * g1[1]); o.w = cvtpk(bflo(raw[3]) * rstd * g1[2], bfhi(raw[3]) * rstd * g1[3]);
              *(GAS v4u*)pq = o; } }
    }
}
__device__ __forceinline__ void phase_group_norm(const Frame& F, const Args& a) {
    const int gw = F.bid * NWAVES + F.wave, NGW = F.G * NWAVES; bf16* YG = (bf16*)(F.ws + WS_YG); const float* g = a.in[I_ODNORM];
    for (int m = gw; m < M; m += NGW) {
#pragma unroll
        for (int gi = 0; gi < 4; ++gi) { bf16* p = YG + (size_t)m * 2048 + gi * 512 + F.lane * 8; const v4u raw = *(const GAS v4u*)p; float ss = 0.f;
#pragma unroll
            for (int j = 0; j < 4; ++j) { const float x0 = bflo(raw[j]), x1 = bfhi(raw[j]); ss += x0 * x0 + x1 * x1; }
            const float rstd = 1.f / sqrtf(wave_sum(ss) * (1.f / 512.f) + EPS);
            const f32x4 g0 = *(const GAS f32x4*)(g + gi * 512 + F.lane * 8), g1 = *(const GAS f32x4*)(g + gi * 512 + F.lane * 8 + 4);
            v4u o; o.x = cvtpk(bflo(raw[0]) * rstd * g0[0], bfhi(raw[0]) * rstd * g0[1]); o.y = cvtpk(bflo(raw[1]) * rstd * g0[2], bfhi(raw[1]) * rstd * g0[3]);
            o.z = cvtpk(bflo(raw[2]) * rstd * g1[0], bfhi(raw[2]) * rstd * g1[1]); o.w = cvtpk(bflo(raw[3]) * rstd * g1[2], bfhi(raw[3]) * rstd * g1[3]);
            *(GAS v4u*)p = o; }
    }
}
constexpr int MOE_TAB = 131072;
static_assert(MOE_TAB + (32 + MOE_TILES + 24) * 4 <= SCR_BYTES, "moe lds");
__device__ __forceinline__ void phase_route(const Frame& F, const Args& a, const bf16* X) {
    LAS int* cntS = (LAS int*)F.lds;
    if (F.tid < 8) cntS[F.tid] = 0;
    LAS float* rtS = (LAS float*)(F.lds + 256);
    for (int i = F.tid; i < D * 2; i += NTHR) { const int r = i >> 1, hf = i & 1; *(LAS f32x4*)(rtS + r * 8 + (r >> 3) * 4 + hf * 4) = *(const GAS f32x4*)(a.in[I_ROUTER] + (size_t)r * 8 + hf * 4); }
    __syncthreads();
    const float* g = a.in[I_NFFN] + D; unsigned char* XN8 = F.ws + WS_XN8;
    int* tokE = (int*)(F.ws + WS_MOEIDX); float* tokW = (float*)(F.ws + WS_MOEIDX + 1 * MiB);
    const int per = M / F.G;
    for (int i = F.wave; i < per; i += NWAVES) { const int m = F.bid * per + i;
        const GAS v4u* xr = (const GAS v4u*)(X + (size_t)m * D) + F.lane;
        float v[2][8]; float s = 0.f;
#pragma unroll
        for (int k = 0; k < 2; ++k) { const v4u r = xr[64 * k];
#pragma unroll
            for (int j = 0; j < 4; ++j) { v[k][2 * j] = bflo(r[j]); v[k][2 * j + 1] = bfhi(r[j]); s += v[k][2 * j] * v[k][2 * j] + v[k][2 * j + 1] * v[k][2 * j + 1]; } }
        const float rstd = 1.f / sqrtf(wave_sum(s) * (1.f / D) + EPS);
        float lg[8]; v2u o8[2];
#pragma unroll
        for (int e = 0; e < 8; ++e) lg[e] = 0.f;
#pragma unroll
        for (int k = 0; k < 2; ++k) { const int c0 = 512 * k + 8 * F.lane; const f32x4 g0 = *(const GAS f32x4*)(g + c0), g1 = *(const GAS f32x4*)(g + c0 + 4); float hn[8];
#pragma unroll
            for (int q = 0; q < 8; ++q) hn[q] = v[k][q] * rstd * (q < 4 ? g0[q & 3] : g1[q & 3]);
            o8[k].x = pk4_fp8(hn[0], hn[1], hn[2], hn[3]); o8[k].y = pk4_fp8(hn[4], hn[5], hn[6], hn[7]);
#pragma unroll
            for (int q = 0; q < 8; ++q) { const LAS float* rr = rtS + (c0 + q) * 8 + ((c0 + q) >> 3) * 4; const f32x4 r0 = *(const LAS f32x4*)rr, r1 = *(const LAS f32x4*)(rr + 4);
#pragma unroll
                for (int e = 0; e < 4; ++e) { lg[e] += hn[q] * r0[e]; lg[4 + e] += hn[q] * r1[e]; } } }
#pragma unroll
        for (int k = 0; k < 2; ++k) *(GAS v2u*)(XN8 + (size_t)m * D + 512 * k + 8 * F.lane) = o8[k];
#pragma unroll
        for (int e = 0; e < 8; ++e) lg[e] = wave_sum(lg[e]);
        int e1 = 0; float v1 = lg[0];
#pragma unroll
        for (int e = 1; e < 8; ++e) if (lg[e] > v1) { v1 = lg[e]; e1 = e; }
        int e2 = (e1 + 1) & 7; float v2 = -3.0e38f;
#pragma unroll
        for (int e = 0; e < 8; ++e) if (e != e1 && lg[e] > v2) { v2 = lg[e]; e2 = e; }
        if (F.lane == 0) { const float w1 = 1.f / (1.f + __expf(v2 - v1)); tokE[2 * m] = e1; tokE[2 * m + 1] = e2; tokW[2 * m] = w1; tokW[2 * m + 1] = 1.f - w1;
            atomicAdd((int*)cntS + e1, 1); atomicAdd((int*)cntS + e2, 1); }
    }
    __syncthreads();
    if (F.tid < 8) ((int*)(F.ctl + CW_MOECNT))[F.bid * 8 + F.tid] = cntS[F.tid];
    __syncthreads();
}
__device__ __forceinline__ void moe_layout(const Frame& F) {
    LAS int* tab = (LAS int*)(F.lds + MOE_TAB); const int* cnt = (const int*)(F.ctl + CW_MOECNT);
    if (F.tid < 16) tab[F.tid < 8 ? F.tid : 32 + MOE_TILES + F.tid] = 0;
    __syncthreads();
    { const int e = F.tid & 7; int tot = 0, pre = 0;
      for (int wg = F.tid >> 3; wg < F.G; wg += NTHR / 8) { const int c = cnt[wg * 8 + e]; tot += c; if (wg < F.bid) pre += c; }
      atomicAdd((int*)tab + e, tot); atomicAdd((int*)tab + 32 + MOE_TILES + 8 + e, pre); }
    __syncthreads();
    if (F.tid == 0) { int row = 0, tl = 0; for (int e = 0; e < 8; ++e) { const int nt = (tab[e] + 255) >> 8; tab[8 + e] = row; tab[16 + e] = nt; for (int i = 0; i < nt; ++i) tab[32 + tl + i] = e; tl += nt; row += nt * 256; } tab[24] = tl; }
    __syncthreads();
}
__device__ __forceinline__ void phase_scatter(const Frame& F) {
    moe_layout(F);
    LAS int* tab = (LAS int*)(F.lds + MOE_TAB); LAS int* slotS = (LAS int*)F.lds;
    const int per = M / F.G;
    const int* tokE = (const int*)(F.ws + WS_MOEIDX); int* tokS = (int*)(F.ws + WS_MOEIDX + 2 * MiB);
    if (F.wave == 0) { const int E0 = tokE[(size_t)F.bid * per * 2 + F.lane], E1 = tokE[(size_t)F.bid * per * 2 + 64 + F.lane]; int s0 = 0, s1 = 0;
        const unsigned long long lt = (1ull << F.lane) - 1ull;
#pragma unroll
        for (int e = 0; e < 8; ++e) { const unsigned long long m0 = __ballot(E0 == e), m1 = __ballot(E1 == e); const int base = tab[8 + e] + tab[32 + MOE_TILES + 8 + e];
            if (E0 == e) s0 = base + __popcll(m0 & lt); if (E1 == e) s1 = base + __popcll(m0) + __popcll(m1 & lt); }
        slotS[F.lane] = s0; slotS[64 + F.lane] = s1; tokS[(size_t)F.bid * per * 2 + F.lane] = s0; tokS[(size_t)F.bid * per * 2 + 64 + F.lane] = s1; }
    __syncthreads();
    const unsigned char* XN8 = F.ws + WS_XN8; unsigned char* XP = F.ws + WS_XP;
    for (int i0 = F.wave; i0 < per * 2; i0 += NWAVES * 16) {
        v4u rowv[16];
#pragma unroll
        for (int j = 0; j < 16; ++j) { const int i = i0 + j * NWAVES; if (i < per * 2) rowv[j] = ((const GAS v4u*)(XN8 + (size_t)(F.bid * per + (i >> 1)) * D))[F.lane]; }
#pragma unroll
        for (int j = 0; j < 16; ++j) { const int i = i0 + j * NWAVES; if (i < per * 2) ((GAS v4u*)(XP + (size_t)slotS[i] * D))[F.lane] = rowv[j]; } }
    __syncthreads();
}
struct MoeOrder {
    int nN, nwg, G, c; const LAS int* texp;
    __device__ __forceinline__ bool next(int i, pg8::Unit& u) const { const long L = (long)i * G + c; if (L >= nwg) return false; u.pm = (int)(L / nN); u.pn = (int)(L % nN); u.bn = texp[u.pm] * nN + u.pn; u.idx = i; return true; }
    __device__ __forceinline__ void a_ready(const pg8::Unit&) const {}
    __device__ __forceinline__ void done(const pg8::Unit&) const {}
};
struct MoeOrderX {
    int nM, nN, nwg, G, c; const LAS int* texp;
    __device__ __forceinline__ bool next(int i, pg8::Unit& u) const { const long L = (long)i * G + c; if (L >= nwg) return false;
        int wgid = (int)L; { const int q = nwg / 8, r = nwg % 8, xcd = wgid % 8, off = wgid / 8; wgid = (xcd < r ? xcd * (q + 1) : r * (q + 1) + (xcd - r) * q) + off; }
        const int nig = 8 * nN, gid = wgid / nig, fm = gid * 8, gsz = (nM - fm) < 8 ? (nM - fm) : 8;
        u.pm = fm + ((wgid % nig) % gsz); u.pn = (wgid % nig) / gsz; u.bn = texp[u.pm] * nN + u.pn; u.idx = i; return true; }
    __device__ __forceinline__ void a_ready(const pg8::Unit&) const {}
    __device__ __forceinline__ void done(const pg8::Unit&) const {}
};
struct MoeTail { int R, Lo, pm_min; bool split; };
__device__ __forceinline__ MoeTail moe_tail(const LAS int* tab, int G) { MoeTail t; const int U = tab[24] * 4; t.R = U / G; t.Lo = U - t.R * G; t.split = (t.Lo > 0 && t.Lo <= 128 && t.R > 0); t.pm_min = t.split ? (t.R * G) / 4 : (1 << 30); return t; }
struct MoeTailOrder { int pm, pn, bn; bool has;
    __device__ __forceinline__ bool next(int i, pg8::Unit& u) const { if (i > 0 || !has) return false; u.pm = pm; u.pn = pn; u.bn = bn; u.idx = 0; return true; }
    __device__ __forceinline__ void a_ready(const pg8::Unit&) const {}
    __device__ __forceinline__ void done(const pg8::Unit&) const {} };
constexpr size_t MOE_PART_STRIDE = (size_t)32 * 256 * 1024;
__device__ __forceinline__ void phase_moe_combine(const Frame& F, const bf16* x, float* xo) {
    moe_layout(F); const MoeTail mt = moe_tail((const LAS int*)(F.lds + MOE_TAB), F.G); const int srow = mt.pm_min == (1 << 30) ? (1 << 30) : mt.pm_min * 256; const float* PART = (const float*)(F.ws + WS_XP);
    const int gw = F.bid * NWAVES + F.wave, NGW = F.G * NWAVES;
    const float* tokW = (const float*)(F.ws + WS_MOEIDX + 1 * MiB); const int* tokS = (const int*)(F.ws + WS_MOEIDX + 2 * MiB); const int* tokE = (const int*)(F.ws + WS_MOEIDX);
    const bf16* YP = (const bf16*)(F.ws + WS_YP);
    int s0 = 0, s1 = 0, e0 = 0, e1 = 0; float w0 = 0.f, w1 = 0.f;
    if (gw < M) { s0 = tokS[2 * gw]; s1 = tokS[2 * gw + 1]; w0 = tokW[2 * gw]; w1 = tokW[2 * gw + 1]; e0 = tokE[2 * gw]; e1 = tokE[2 * gw + 1]; }
    for (int m = gw; m < M; m += NGW) {
        const GAS v2u* xr = (const GAS v2u*)(x + (size_t)m * D) + F.lane; GAS f32x4* xw = (GAS f32x4*)(xo + (size_t)m * D) + F.lane; const GAS v2u* y0 = (const GAS v2u*)(YP + (size_t)s0 * D) + F.lane; const GAS v2u* y1 = (const GAS v2u*)(YP + (size_t)s1 * D) + F.lane;
        const bool p0 = s0 >= srow, p1 = s1 >= srow; v2u xb[4], r0[4], r1[4]; f32x4 v0[4], v1[4];
#pragma unroll
        for (int j = 0; j < 4; ++j) xb[j] = xr[64 * j];
        if (!p0) {
#pragma unroll
            for (int j = 0; j < 4; ++j) r0[j] = y0[64 * j]; }
        else {
#pragma unroll
            for (int j = 0; j < 4; ++j) { const GAS f32x4* q = (const GAS f32x4*)(PART + (size_t)(s0 - srow) * D) + F.lane + 64 * j; v0[j] = q[0] + q[MOE_PART_STRIDE / 4]; } }
        if (!p1) {
#pragma unroll
            for (int j = 0; j < 4; ++j) r1[j] = y1[64 * j]; }
        else {
#pragma unroll
            for (int j = 0; j < 4; ++j) { const GAS f32x4* q = (const GAS f32x4*)(PART + (size_t)(s1 - srow) * D) + F.lane + 64 * j; v1[j] = q[0] + q[MOE_PART_STRIDE / 4]; } }
        const int mn = m + NGW; int s0n = 0, s1n = 0, e0n = 0, e1n = 0; float w0n = 0.f, w1n = 0.f;
        if (mn < M) { s0n = tokS[2 * mn]; s1n = tokS[2 * mn + 1]; w0n = tokW[2 * mn]; w1n = tokW[2 * mn + 1]; e0n = tokE[2 * mn]; e1n = tokE[2 * mn + 1]; }
        const float ws0 = w0 * (1.f / MOE_W2_SCALE), ws1 = w1 * (1.f / MOE_W2_SCALE)  ; const bool sw = e0 > e1;
#pragma unroll
        for (int j = 0; j < 4; ++j) {
            if (!p0) v0[j] = (f32x4){bflo(r0[j].x), bfhi(r0[j].x), bflo(r0[j].y), bfhi(r0[j].y)};
            if (!p1) v1[j] = (f32x4){bflo(r1[j].x), bfhi(r1[j].x), bflo(r1[j].y), bfhi(r1[j].y)};
            const f32x4 a0 = v0[j] * ws0, a1 = v1[j] * ws1; const f32x4 xv = {bflo(xb[j].x), bfhi(xb[j].x), bflo(xb[j].y), bfhi(xb[j].y)}; xw[64 * j] = xv + (sw ? (a1 + a0) : (a0 + a1)); }
        s0 = s0n; s1 = s1n; w0 = w0n; w1 = w1n; e0 = e0n; e1 = e1n; }
}
#ifndef MK_PHMASK
#define MK_PHMASK 0xFFFFFFFFFFFFull
#endif
#ifndef MK_DUPMASK
#define MK_DUPMASK 0ull
#endif
#ifndef MK_SPLIT
#define MK_SPLIT 0
#endif
#ifndef MK_LAST_PHASE
#define MK_LAST_PHASE 29
#endif
constexpr int N_PHASES = 30;
#ifndef MK_LB
#define MK_LB 2
#endif
__global__ void __launch_bounds__(NTHR, MK_LB) mega_fwd(Args args) {
    extern __shared__ __attribute__((aligned(16))) unsigned char lds_raw[];
    Frame F;
    F.lds = (LAS unsigned char*)lds_raw; F.MISC = (volatile LAS unsigned*)(F.lds + MISC_OFF);
    F.tid = threadIdx.x; F.lane = F.tid & 63; F.wave = __builtin_amdgcn_readfirstlane(F.tid >> 6); F.G = gridDim.x; F.bid = blockIdx.x;
    F.ws = args.ws; F.ctl = (gu32*)(args.ws + WS_CTL);
    for (int u = F.tid; u < (LDS_BYTES - MISC_OFF) / 4; u += NTHR) ((LAS unsigned*)(F.lds + MISC_OFF))[u] = 0u;
    __syncthreads();
    XcdBarrier bar; bar.bar = (unsigned*)(F.ctl + CW_BAR); bar.x = 0; bar.st = nullptr;
    if (!MK_SPLIT) bar = xcd_barrier_post((unsigned*)(F.ctl + CW_BAR), F.MISC + 8);
    const int lo = args.ph_lo, hi = args.ph_hi;
#define PF() Frame Fp = F; { int t_ = threadIdx.x; asm volatile("" : "+v"(t_)); Fp.tid = t_; Fp.lane = t_ & 63; int w_ = F.wave, b_ = F.bid; asm volatile("" : "+s"(w_), "+s"(b_)); Fp.wave = w_; Fp.bid = b_; }
#define IN(k) ((((unsigned long long)MK_PHMASK >> (k)) & 1ull) && lo <= (k) && (k) < hi)
#define DUP(k) ((((unsigned long long)MK_DUPMASK >> (k)) & 1ull) ? 2 : 1)
#define SEAM(k) do { if (!MK_SPLIT && IN((k) + 1)) xcd_barrier(bar); } while (0)
    unsigned char* ws = args.ws; float* out = args.out;
    const int gw = F.bid * NWAVES + F.wave, NGW = F.G * NWAVES;
    LAS unsigned char* glds = F.lds;
    bf16* XN = (bf16*)(ws + WS_XN);

    if (IN(0)) { PF();
#pragma unroll 1
        for (int rep = 0; rep < DUP(0); ++rep) p0_prologue(Fp, args);
        SEAM(0); }
    if (IN(1)) {
        PF();
#pragma unroll 1
        for (int rep = 0; rep < DUP(1); ++rep) {
        if (F.bid == 0) { float* part = (float*)(ws + WS_CMPB_PART); float s = 0.f; for (int ic = 0; ic < 64; ++ic) s += part[(size_t)((Fp.tid >> 8) * 64 + ic) * 256 + (Fp.tid & 255)]; ((float*)(ws + WS_CMPB))[Fp.tid] = s; }
        { pg8::Gemm g{XN, (const bf16*)(ws + WS_W_EVIN), M, EV_INP, D, D, D}; pg8::StaticOrder S; S.init(M, EV_INP, F.G, F.bid);
          pg8::EpiEvIn E{(bf16*)(ws + WS_Y0), EV_INP, (bf16*)(ws + WS_KV6), SEQ};
          pg8::gemm_phase<pg8::EpiEvIn, pg8::StaticOrder, PG8_ALIGN, PG8_SP2>(glds, g, S, E); }
#pragma unroll 1
        for (int l = 0; l < 2; ++l) { pg8::Gemm g{(const bf16*)(ws + WS_MEMN) + (size_t)l * MMEM * D, (const bf16*)(ws + WS_W_XKV) + (size_t)l * 1024 * D, MMEM, 1024, D, D, D};
          pg8::ListOrder S; S.init(2, 4, 8, F.bid - 192 - 8 * l);
          pg8::EpiBf16<0> E{(bf16*)(ws + WS_KVM) + (size_t)l * MMEM * 1024, 1024, nullptr, nullptr};
          pg8::gemm_phase<pg8::EpiBf16<0>, pg8::ListOrder, PG8_ALIGN, PG8_SP2>(glds, g, S, E); }
        }
        SEAM(1);
    }
    if (IN(2)) {
        PF();
#pragma unroll 1
        for (int rep = 0; rep < DUP(2); ++rep) {
        if (F.bid < 128) { rglru_unit(Fp, args, F.bid >> 6, (F.bid >> 3) & 7, F.bid & 7);
        }
        else if (F.bid < 144) { const int mm = (F.bid - 128) >> 3;
            pg8::Gemm g{(const bf16*)(ws + WS_KV6) + (size_t)mm * 4 * SEQ * 128, (const bf16*)(ws + (mm ? WS_W_CV1 : WS_W_CK1)), 2048, 256, 4096, 2048, 4096};
            pg8::ListOrder S; S.init(8, 1, 8, (F.bid - 128) & 7);
            pg8::EpiBf16<1> E{(bf16*)(ws + WS_HID) + (size_t)mm * 2048 * 256, 256, (const float*)(ws + WS_CMPB) + mm * 256, nullptr};
            pg8::gemm_phase<pg8::EpiBf16<1>, pg8::ListOrder, PG8_ALIGN, PG8_SP2>(glds, g, S, E);
#ifdef MK_DUP_CMP1
            pg8::gemm_phase<pg8::EpiBf16<1>, pg8::ListOrder, PG8_ALIGN, PG8_SP2>(glds, g, S, E);
#endif
            VM_WAIT(); __syncthreads(); { const int u0 = mm * 64 + ((F.bid - 128) & 7) * 8; phase_cmp2(Fp, args, u0, u0 + 8, 1); }
        }
        else if (rep == 0) { const int gw2 = (F.bid - 144) * NWAVES + F.wave, NGW2 = (F.G - 144) * NWAVES;
            bf16* ks = (bf16*)(ws + WS_KV6) + (size_t)2 * 4 * SEQ * 128; bf16* kw = (bf16*)(ws + WS_KV6) + (size_t)4 * 4 * SEQ * 128;
            norm128_rows(Fp, ks, 128, ks, 128, 4 * SEQ, args.in[I_KNORM] + 128, gw2, NGW2);
            norm128_rows(Fp, kw, 128, kw, 128, 4 * SEQ, args.in[I_KNORM] + 256, gw2, NGW2);
            phase_memk_norm(Fp, args, 0, gw2, NGW2); phase_memk_norm(Fp, args, 1, gw2, NGW2); convert_range(Fp, args, gw2, NGW2, CONV_A, CONV_P2_END);
#ifdef MK_DUP_P2CONV
            convert_range(Fp, args, gw2, NGW2, CONV_A + (CONV_P2_END - CONV_A) / 2, CONV_P2_END);
#endif
        }
        }
        SEAM(2);
    }
    if (IN(4)) { PF();
#pragma unroll 1
        for (int rep = 0; rep < DUP(4); ++rep) phase_nsa(Fp, args);
        SEAM(4); }
    if (IN(5)) {
        pg8::Gemm g{(const bf16*)(ws + WS_MIX), (const bf16*)(ws + WS_W_EVOUT), M, D, 2048, 2048, 2048}; pg8::StaticOrder S; S.init(M, D, F.G, F.bid);
#pragma unroll 1
        for (int rep = 0; rep < DUP(5); ++rep) { pg8::EpiResidB<true> E{args.in[I_X], (rep + 1 < DUP(5)) ? (bf16*)(ws + WS_R + 400 * MiB) : XN, D, (float*)(ws + WS_SSQ)};
        pg8::gemm_phase<pg8::EpiResidB<true>, pg8::StaticOrder, PG8_ALIGN, PG8_SP2>(glds, g, S, E); }
        SEAM(5);
#ifdef MK_PROBE_BARS
#pragma unroll 1
        for (int xb = 0; xb < MK_PROBE_BARS; ++xb) xcd_barrier(bar);
#endif
    }
#pragma unroll 1
    for (int l = 0; l < 2; ++l) {
        const int pb = l == 0 ? 6 : 21;
        if (IN(pb + 1)) { pg8::Gemm g{XN, (const bf16*)(ws + WS_W_XQ) + (size_t)l * 512 * D, M, 512, D, D, D}; pg8::StaticOrder S; S.init(M, 512, F.G, F.bid);
            pg8::fill_rstd_table((LAS float*)(F.lds + MOE_TAB), S, (const float*)(ws + WS_SSQ), F.tid);
            pg8::EpiBf16<0> E{(bf16*)(ws + WS_QX), 512, nullptr, (const LAS float*)(F.lds + MOE_TAB)};
#pragma unroll 1
            for (int rep = 0; rep < DUP(7); ++rep) pg8::gemm_phase<pg8::EpiBf16<0>, pg8::StaticOrder, PG8_ALIGN, PG8_SP2>(glds, g, S, E);
            if (F.bid >= 128) { PF(); const int lo_ = CONV_ALL - (2 - l) * CONV_Q;
                convert_range(Fp, args, (F.bid - 128) * NWAVES + F.wave, (F.G - 128) * NWAVES, lo_, lo_ + CONV_Q); }
            SEAM(pb + 1); }
        if (IN(pb + 2)) { PF();
#pragma unroll 1
            for (int rep = 0; rep < DUP(8); ++rep) phase_cross_attn(Fp, args, l);
            SEAM(pb + 2); }
        if (IN(pb + 3)) { pg8::Gemm g{(const bf16*)(ws + WS_OX), (const bf16*)(ws + WS_W_XO) + (size_t)l * D * 512, M, D, 512, 512, 512}; pg8::StaticOrder S; S.init(M, D, F.G, F.bid);
#pragma unroll 1
            for (int rep = 0; rep < DUP(9); ++rep) { pg8::EpiResidB<false> E{XN, (rep + 1 < DUP(9)) ? (bf16*)(ws + WS_R + 400 * MiB) : XN, D, (float*)(ws + WS_SSQ)};
            pg8::gemm_phase<pg8::EpiResidB<false>, pg8::StaticOrder, PG8_ALIGN, PG8_SP2>(glds, g, S, E); }
            SEAM(pb + 3); }
        if (l == 0) {
            if (IN(11)) { pg8::Gemm g{XN, (const bf16*)(ws + WS_W_FF13), M, 2 * FF, D, D, D}; pg8::StaticOrder S; S.init(M, 2 * FF, F.G, F.bid);
                pg8::fill_rstd_table((LAS float*)(F.lds + MOE_TAB), S, (const float*)(ws + WS_SSQ), F.tid);
                pg8::EpiSwiglu<false> E{(bf16*)(ws + WS_H), FF, (const LAS float*)(F.lds + MOE_TAB)};
#ifdef MK_PROBE_NULLEPI
                { pg8::EpiNull EN; pg8::gemm_phase<pg8::EpiNull, pg8::StaticOrder, PG8_ALIGN, PG8_SP2>(glds, g, S, EN); }
#endif
#pragma unroll 1
                for (int rep = 0; rep < DUP(11); ++rep) pg8::gemm_phase<pg8::EpiSwiglu<false>, pg8::StaticOrder, PG8_ALIGN, PG8_SP2>(glds, g, S, E);
                SEAM(11); }
            if (IN(12)) { pg8::Gemm g{(const bf16*)(ws + WS_H), (const bf16*)(ws + WS_W_FF2), M, D, FF, FF, FF}; pg8::StaticOrder S; S.init(M, D, F.G, F.bid);
#pragma unroll 1
                for (int rep = 0; rep < DUP(12); ++rep) { pg8::EpiResidB<false> E{XN, (rep + 1 < DUP(12)) ? (bf16*)(ws + WS_R + 400 * MiB) : XN, D, (float*)(ws + WS_SSQ)};
                pg8::gemm_phase<pg8::EpiResidB<false>, pg8::StaticOrder, PG8_ALIGN, PG8_SP2>(glds, g, S, E); }
                SEAM(12); }
            if (IN(14)) { pg8::Gemm g{XN, (const bf16*)(ws + WS_W_ODIN), M, 5120, D, D, D}; pg8::StaticOrder S; S.init(M, 5120, F.G, F.bid);
                pg8::fill_rstd_table((LAS float*)(F.lds + MOE_TAB), S, (const float*)(ws + WS_SSQ), F.tid);
                pg8::EpiBf16<0> E{(bf16*)(ws + WS_Y1), OD_INP, nullptr, (const LAS float*)(F.lds + MOE_TAB)};
#pragma unroll 1
                for (int rep = 0; rep < DUP(14); ++rep) pg8::gemm_phase<pg8::EpiBf16<0>, pg8::StaticOrder, PG8_ALIGN, PG8_SP2>(glds, g, S, E);
                od_dt_cols(F, XN, (const bf16*)(ws + WS_W_ODIN), (const float*)(ws + WS_SSQ), (bf16*)(ws + WS_Y1));
                SEAM(14); }
            if (IN(15)) { PF();
#pragma unroll 1
                for (int rep = 0; rep < DUP(15); ++rep) phase_mamba_prep(Fp, args);
                SEAM(15); }
            if (IN(16)) { PF();
#pragma unroll 1
                for (int rep = 0; rep < DUP(16); ++rep) phase_mamba_states(Fp);
                SEAM(16); }
            if (IN(17)) { PF();
#pragma unroll 1
                for (int rep = 0; rep < DUP(17); ++rep) phase_mamba_scan(Fp);
                SEAM(17); }
            if (IN(18)) { PF();
#pragma unroll 1
                for (int rep = 0; rep < DUP(18); ++rep) phase_mamba_out(Fp, args);
                SEAM(18); }
            if (IN(20)) { pg8::Gemm g{(const bf16*)(ws + WS_YG), (const bf16*)(ws + WS_W_ODOUT), M, D, 2048, 2048, 2048}; pg8::StaticOrder S; S.init(M, D, F.G, F.bid);
#pragma unroll 1
                for (int rep = 0; rep < DUP(20); ++rep) { pg8::EpiResidB<false> E{XN, (rep + 1 < DUP(20)) ? (bf16*)(ws + WS_R + 400 * MiB) : XN, D, (float*)(ws + WS_SSQ)};
                pg8::gemm_phase<pg8::EpiResidB<false>, pg8::StaticOrder, PG8_ALIGN, PG8_SP2>(glds, g, S, E); }
                SEAM(20); }
        }
    }
    if (IN(25)) { PF();
#pragma unroll 1
        for (int rep = 0; rep < DUP(25); ++rep) phase_route(Fp, args, XN);
        SEAM(25); }
    if (IN(26)) { PF();
#pragma unroll 1
        for (int rep = 0; rep < DUP(26); ++rep) phase_scatter(Fp);
        SEAM(26); }
    if (IN(27)) { PF(); moe_layout(Fp); const LAS int* tab = (const LAS int*)(F.lds + MOE_TAB);
        pg8::Gemm g{(const bf16*)(ws + WS_XP), (const bf16*)(ws + WS_W_M13), MOE_ROWS, 2 * FFE, D / 2, D / 2, D / 2}  ; MoeOrderX S{tab[24], 2 * FFE / 256, tab[24] * (2 * FFE / 256), F.G, F.bid, tab + 32};
        pg8::EpiSwiglu<true, false, true> E{(bf16*)(ws + WS_HP), FFE, nullptr, 1.f / MOE_W13_SCALE};
#pragma unroll 1
        for (int rep = 0; rep < DUP(27); ++rep) pg8::gemm_phase<pg8::EpiSwiglu<true, false, true>, MoeOrderX, PG8_ALIGN, PG8_SP2, true>(glds, g, S, E);
        SEAM(27); }
    if (IN(28)) { PF(); moe_layout(Fp); const LAS int* tab = (const LAS int*)(F.lds + MOE_TAB);
        const MoeTail mt = moe_tail(tab, F.G);
        pg8::Gemm g{(const bf16*)(ws + WS_HP), (const bf16*)(ws + WS_W_M2), MOE_ROWS, D, FFE / 2, FFE / 2, FFE / 2}  ; MoeOrder S{D / 256, mt.split ? mt.R * F.G : tab[24] * (D / 256), F.G, F.bid, tab + 32};
        pg8::EpiBf16<0> E{(bf16*)(ws + WS_YP), D, nullptr, nullptr};
#pragma unroll 1
        for (int rep = 0; rep < DUP(28); ++rep) pg8::gemm_phase<pg8::EpiBf16<0>, MoeOrder, PG8_ALIGN, PG8_SP2, true>(glds, g, S, E);
        if (mt.split) {
            const int piece = F.bid, L = mt.R * F.G + (piece >> 1), kq = piece & 1, pm = L / 4, pn = L % 4;
            MoeTailOrder S2{pm, pn, piece < mt.Lo * 2 ? tab[32 + pm] * 4 + pn : 0, piece < mt.Lo * 2};
            pg8::Gemm g2{(const bf16*)(ws + WS_HP) + kq * (FFE / 4), (const bf16*)(ws + WS_W_M2) + kq * (FFE / 4), MOE_ROWS, D, FFE / 4, FFE / 2, FFE / 2};
            pg8::EpiF32 E2{(float*)(ws + WS_XP) + (size_t)kq * MOE_PART_STRIDE - (size_t)mt.pm_min * 256 * D, D};
            pg8::gemm_phase<pg8::EpiF32, MoeTailOrder, PG8_ALIGN, PG8_SP2, true>(glds, g2, S2, E2); }
        SEAM(28); }
    if (IN(29)) { PF();
#pragma unroll 1
        for (int rep = 0; rep < DUP(29); ++rep) phase_moe_combine(Fp, XN, (rep + 1 < DUP(29)) ? (float*)(ws + WS_R + 400 * MiB) : out); }
#undef IN
#undef SEAM
}

extern "C" void kernel_launch(void* const* d_in, const int* in_sizes, int n_in, void* d_out, int out_size, void* d_ws, size_t ws_size, hipStream_t stream) {
    static int grid = 0;
    if (grid == 0) {
        if (n_in != N_IN || in_sizes[0] != M * D || out_size != M * D || ws_size < (WS_M_END > WS_END ? WS_M_END : WS_END)) { fprintf(stderr, "kernel_launch: unexpected problem (n_in %d, in0 %d, out %d, ws %zu < %zu); nothing launched\n", n_in, n_in > 0 ? in_sizes[0] : -1, out_size, ws_size, (size_t)WS_END); grid = -1; return; }
        int dev = 0, cus = 0, per_cu = 0;
        if (hipGetDevice(&dev) != hipSuccess || hipDeviceGetAttribute(&cus, hipDeviceAttributeMultiprocessorCount, dev) != hipSuccess) { fprintf(stderr, "kernel_launch: device query failed\n"); grid = -1; return; }
        if (hipFuncSetAttribute((const void*)mega_fwd, hipFuncAttributeMaxDynamicSharedMemorySize, LDS_BYTES) != hipSuccess) { fprintf(stderr, "kernel_launch: hipFuncSetAttribute(%d B LDS) failed\n", LDS_BYTES); grid = -1; return; }
        if (hipOccupancyMaxActiveBlocksPerMultiprocessor(&per_cu, (const void*)mega_fwd, NTHR, LDS_BYTES) != hipSuccess || per_cu < 1) fprintf(stderr, "kernel_launch: note: occupancy query reports %d workgroups per CU\n", per_cu);
        (void)hipGetLastError();
        if (cus < 256) { fprintf(stderr, "kernel_launch: %d CUs < 256: the persistent grid of 256 workgroups would not be resident; nothing launched\n", cus); grid = -1; return; }
        grid = 256;
    }
    if (grid < 0) return;
    if (hipMemsetAsync((char*)d_ws + WS_CTL, 0, CTL_ZERO_BYTES, stream) != hipSuccess) { fprintf(stderr, "kernel_launch: memset failed\n"); return; }
    Args a{};
    for (int i = 0; i < N_IN; ++i) a.in[i] = (const float*)d_in[i];
    a.out = (float*)d_out; a.ws = (unsigned char*)d_ws;
#if MK_SPLIT
    for (int p = 0; p <= MK_LAST_PHASE && p < N_PHASES; ++p) { a.ph_lo = p; a.ph_hi = p + 1; a.li = p; hipLaunchKernelGGL(mega_fwd, dim3(grid), dim3(NTHR), LDS_BYTES, stream, a); }
#else
    a.ph_lo = 0; a.ph_hi = MK_LAST_PHASE + 1; a.li = 0;
    hipLaunchKernelGGL(mega_fwd, dim3(grid), dim3(NTHR), LDS_BYTES, stream, a);
#endif
    const hipError_t le = hipPeekAtLastError();
    if (le != hipSuccess) fprintf(stderr, "kernel_launch: launch failed: %s\n", hipGetErrorName(le));
}
```
